# Optimizing an MI355X kernel written in HIP

```python
import math
import jax
import jax.numpy as jnp
from jax import lax
import numpy as np

D_MODEL = 1024
BATCH = 8
SEQ = 2048
DEPTH = 2

N_BRANCH = 4
MIX_W = D_MODEL // 2
RMS_EPS = 1e-6
HG_DK = 128
HG_HEADS = MIX_W // HG_DK
HG_DV = MIX_W // HG_HEADS
HG_CHUNK = 64
HG_TINY = 1e-30
RW_HEAD = 64
RW_HEADS = MIX_W // RW_HEAD
RW_DECAY_LORA = 64
RW_A_LORA = 64
RW_V_LORA = 32
RW_G_LORA = 128
RW_LN_EPS = 64e-5
S5_GROUP = 16
S5_GROUPS = MIX_W // S5_GROUP
S5_STATE = 64
MB_HEADDIM = 64
MB_HEADS = MIX_W // MB_HEADDIM
MB_GROUPS = 2
MB_STATE = 128
MB_CONV = 4
MB_CHUNK = 128
FF_HIDDEN = -(-8 * D_MODEL // (3 * 256)) * 256
GATE_COLS = N_BRANCH * D_MODEL
HG_COLS = 4 * MIX_W
RW_COLS = 3 * MIX_W + RW_DECAY_LORA + RW_A_LORA + RW_G_LORA
S5_COLS = MIX_W
MB_XBC = MIX_W + 2 * MB_GROUPS * MB_STATE
MB_COLS = MIX_W + MB_XBC + MB_HEADS
IN_COLS = GATE_COLS + HG_COLS + RW_COLS + S5_COLS + MB_COLS

kernel_name = 'hybrid_hgrn2_rwkv7_s5_mamba2_block'


def rmsnorm(x, w):
    xf = x.astype(jnp.float32)
    y = xf * lax.rsqrt(jnp.mean(xf * xf, axis=-1, keepdims=True) + RMS_EPS)
    return (y * w.astype(jnp.float32)).astype(x.dtype)


def causal_shift(z):
    return jnp.pad(z, ((0, 0), (1, 0), (0, 0)))[:, :-1]


def segsum_exp(a):
    T = a.shape[-1]
    rep = jnp.broadcast_to(a[..., :, None], a.shape + (T,))
    strict = jnp.tril(jnp.ones((T, T), dtype=bool), -1)
    cs = jnp.cumsum(jnp.where(strict, rep, 0.0), axis=-2)
    return jnp.where(jnp.tril(jnp.ones((T, T), dtype=bool)), jnp.exp(cs), 0.0)


def hgrn2_mixer(z, lower_bound, norm_w):
    bsz, seq, _ = z.shape
    nc = seq // HG_CHUNK
    q, f, i, g = jnp.split(z.astype(jnp.float32), 4, axis=-1)
    lb = lower_bound.astype(jnp.float32)
    q = jax.nn.silu(q)
    log_f = jnp.log(jnp.maximum(lb + (1.0 - lb) * jax.nn.sigmoid(f), HG_TINY))
    k = (1.0 - lb) * jax.nn.sigmoid(-f)

    def to_chunks(t):
        return t.reshape(bsz, nc, HG_CHUNK, HG_HEADS, -1).transpose(1, 0, 3, 2, 4)

    causal = jnp.tril(jnp.ones((HG_CHUNK, HG_CHUNK), dtype=bool))[None, None, :, :, None]

    def chunk_step(state, inp):
        qc, kc, vc, lfc = inp
        b = jnp.cumsum(lfc, axis=2)
        diff = b[:, :, :, None, :] - b[:, :, None, :, :]
        decay = jnp.where(causal, jnp.exp(jnp.where(causal, diff, 0.0)), 0.0)
        att = jnp.sum(qc[:, :, :, None, :] * kc[:, :, None, :, :] * decay, axis=-1)
        o = jnp.einsum('bhts,bhsv->bhtv', att, vc) + jnp.einsum('bhtk,bhkv->bhtv', qc * jnp.exp(b), state)
        b_last = b[:, :, -1:, :]
        state = (jnp.exp(b_last[:, :, 0, :])[..., None] * state
                 + jnp.einsum('bhsk,bhsv->bhkv', kc * jnp.exp(b_last - b), vc))
        return state, o

    state0 = jnp.zeros((bsz, HG_HEADS, HG_DK, HG_DV), jnp.float32)
    _, o = lax.scan(chunk_step, state0, (to_chunks(q), to_chunks(k), to_chunks(i), to_chunks(log_f)))
    o = o.transpose(1, 0, 3, 2, 4).reshape(bsz, seq, HG_HEADS, HG_DV)
    o = rmsnorm(o, norm_w.reshape(HG_HEADS, HG_DV)).reshape(bsz, seq, MIX_W)
    return (o * jax.nn.silu(g)).astype(z.dtype)


def rwkv7_recurrence(r, w, k, v, a, b):
    bsz, _, h, n = r.shape

    def step(state, inp):
        r_t, w_t, k_t, v_t, a_t, b_t = inp
        sa = jnp.einsum('bhvk,bhk->bhv', state, a_t)
        state = (state * w_t[:, :, None, :] + sa[..., None] * b_t[:, :, None, :]
                 + v_t[..., None] * k_t[:, :, None, :])
        return state, jnp.einsum('bhvk,bhk->bhv', state, r_t)

    xs = (jnp.moveaxis(r, 1, 0), jnp.moveaxis(w, 1, 0), jnp.moveaxis(k, 1, 0),
          jnp.moveaxis(v, 1, 0), jnp.moveaxis(a, 1, 0), jnp.moveaxis(b, 1, 0))
    _, y = lax.scan(step, jnp.zeros((bsz, h, n, n), jnp.float32), xs)
    return jnp.moveaxis(y, 0, 1)


def rwkv7_mixer(z, v_first, vres, mu, w0, w2, a0, a2, g2, k_k, k_a, r_k, ln_w, ln_b):
    bsz, seq, _ = z.shape
    zf = z.astype(jnp.float32)
    zs = zf + (causal_shift(zf) - zf) * mu
    r, k, v, xw, xa, xg = jnp.split(
        zs, [MIX_W, 2 * MIX_W, 3 * MIX_W, 3 * MIX_W + RW_DECAY_LORA,
             3 * MIX_W + RW_DECAY_LORA + RW_A_LORA], axis=-1)
    w_log = -jax.nn.softplus(-(w0 + jnp.tanh(xw) @ w2)) - 0.5
    decay = jnp.exp(-jnp.exp(w_log))
    if vres is None:
        v_first = v
    else:
        v0, v1, v2 = vres
        v = v + (v_first - v) * jax.nn.sigmoid(v0 + (v @ v1) @ v2)
    a = jax.nn.sigmoid(a0 + xa @ a2)
    g = jax.nn.sigmoid(xg) @ g2

    def heads(t):
        return t.reshape(bsz, seq, RW_HEADS, RW_HEAD)

    kk = heads(k * k_k)
    kk = kk / jnp.maximum(jnp.sqrt(jnp.sum(kk * kk, axis=-1, keepdims=True)), 1e-12)
    k = heads(k * (1.0 + (a - 1.0) * k_a))
    r, vh, ah = heads(r), heads(v), heads(a)
    y = rwkv7_recurrence(r, heads(decay), k, vh, -kk, kk * ah)
    mean = jnp.mean(y, axis=-1, keepdims=True)
    var = jnp.mean(jnp.square(y - mean), axis=-1, keepdims=True)
    y = ((y - mean) * lax.rsqrt(var + RW_LN_EPS) * ln_w.reshape(RW_HEADS, RW_HEAD)
         + ln_b.reshape(RW_HEADS, RW_HEAD))
    y = y + jnp.sum(r * k * r_k, axis=-1, keepdims=True) * vh
    y = y.reshape(bsz, seq, MIX_W) * g
    return y.astype(z.dtype), v_first


def complex_affine_combine(e1, e2):
    a1r, a1i, b1r, b1i = e1
    a2r, a2i, b2r, b2i = e2
    return (a2r * a1r - a2i * a1i, a2r * a1i + a2i * a1r,
            a2r * b1r - a2i * b1i + b2r, a2r * b1i + a2i * b1r + b2i)


def s5_mixer(z, a_re, a_im, b_re, b_im, c_re, c_im, d_skip, log_dt, w_glu, b_glu):
    bsz, seq, _ = z.shape
    u = z.astype(jnp.float32)
    ug = u.reshape(bsz, seq, S5_GROUPS, S5_GROUP)
    dt = jnp.exp(log_dt)[:, None]
    mag = jnp.exp(dt * a_re)
    lam_re, lam_im = mag * jnp.cos(dt * a_im), mag * jnp.sin(dt * a_im)
    den = a_re * a_re + a_im * a_im
    coef_re = ((lam_re - 1.0) * a_re + lam_im * a_im) / den
    coef_im = (lam_im * a_re - (lam_re - 1.0) * a_im) / den
    bb_re = coef_re[..., None] * b_re - coef_im[..., None] * b_im
    bb_im = coef_re[..., None] * b_im + coef_im[..., None] * b_re
    bu_re = jnp.einsum('bsgc,gnc->bsgn', ug, bb_re)
    bu_im = jnp.einsum('bsgc,gnc->bsgn', ug, bb_im)
    elems = (jnp.broadcast_to(lam_re, bu_re.shape), jnp.broadcast_to(lam_im, bu_re.shape), bu_re, bu_im)
    _, _, h_re, h_im = lax.associative_scan(complex_affine_combine, elems, axis=1)
    y = jnp.einsum('bsgn,gcn->bsgc', h_re, c_re) - jnp.einsum('bsgn,gcn->bsgc', h_im, c_im)
    y = y.reshape(bsz, seq, MIX_W) + d_skip * u
    y = jax.nn.gelu(y)
    y = y * jax.nn.sigmoid(y @ w_glu + b_glu)
    return y.astype(z.dtype)


def ssd_chunked(x, a, b, c):
    bsz, seq, h, p = x.shape
    nc = seq // MB_CHUNK
    x = x.reshape(bsz, nc, MB_CHUNK, h, p)
    b = b.reshape(bsz, nc, MB_CHUNK, h, -1)
    c = c.reshape(bsz, nc, MB_CHUNK, h, -1)
    a = a.reshape(bsz, nc, MB_CHUNK, h).transpose(0, 3, 1, 2)
    a_cum = jnp.cumsum(a, axis=-1)
    scores = jnp.einsum('bclhn,bcshn->bhcls', c, b) * segsum_exp(a)
    y_diag = jnp.einsum('bhcls,bcshp->bclhp', scores, x)
    decay_states = jnp.exp(a_cum[..., -1:] - a_cum)
    states = jnp.einsum('bclhn,bhcl,bclhp->bchpn', b, decay_states, x)
    states = jnp.concatenate([jnp.zeros_like(states[:, :1]), states], axis=1)
    decay_chunk = segsum_exp(jnp.pad(a_cum[..., -1], ((0, 0), (0, 0), (1, 0))))
    states = jnp.einsum('bhzc,bchpn->bzhpn', decay_chunk, states)[:, :-1]
    y_off = jnp.einsum('bclhn,bchpn,bhcl->bclhp', c, states, jnp.exp(a_cum))
    return (y_diag + y_off).reshape(bsz, seq, h, p)


def mamba2_mixer(z, conv_w, conv_b, dt_bias, a_log, d_skip, norm_w):
    bsz, seq, _ = z.shape
    zf = z.astype(jnp.float32)
    gate, xbc, dt_raw = jnp.split(zf, [MIX_W, MIX_W + MB_XBC], axis=-1)
    xp = jnp.pad(xbc, ((0, 0), (MB_CONV - 1, 0), (0, 0)))
    conv = conv_b
    for j in range(MB_CONV):
        conv = conv + xp[:, j:j + seq] * conv_w[j]
    xbc = jax.nn.silu(conv)
    xs, bm, cm = jnp.split(xbc, [MIX_W, MIX_W + MB_GROUPS * MB_STATE], axis=-1)
    rep = MB_HEADS // MB_GROUPS
    bm = jnp.repeat(bm.reshape(bsz, seq, MB_GROUPS, MB_STATE), rep, axis=2)
    cm = jnp.repeat(cm.reshape(bsz, seq, MB_GROUPS, MB_STATE), rep, axis=2)
    xs = xs.reshape(bsz, seq, MB_HEADS, MB_HEADDIM)
    dt = jax.nn.softplus(dt_raw + dt_bias)
    a = -jnp.exp(a_log.astype(jnp.float32))
    y = ssd_chunked(xs * dt[..., None], a * dt, bm, cm) + d_skip[:, None] * xs
    y = rmsnorm(y.reshape(bsz, seq, MIX_W) * jax.nn.silu(gate), norm_w)
    return y.astype(z.dtype)


def swiglu(h, w_in, w_out):
    gate, up = jnp.split(h @ w_in, 2, axis=-1)
    return (jax.nn.silu(gate) * up) @ w_out


def setup_inputs(seed: int = 0) -> dict:
    key = jax.random.key(seed)
    keys = jax.random.split(key, 48)
    counter = [0]

    def nk():
        counter[0] += 1
        return keys[counter[0] - 1]

    def nrm(shape, scale):
        return scale * jax.random.normal(nk(), shape, jnp.float32)

    def unif(shape, lo, hi):
        return jax.random.uniform(nk(), shape, jnp.float32, lo, hi)

    L = DEPTH
    Lv = DEPTH - 1
    dt_mb = jnp.exp(unif((L, MB_HEADS), math.log(1e-3), math.log(1e-1)))
    return {
        'x': nrm((BATCH, SEQ, D_MODEL), 1.0),
        'norm_mix_w': 1.0 + nrm((L, D_MODEL), 0.02),
        'w_in': nrm((L, D_MODEL, IN_COLS), D_MODEL ** -0.5),
        'w_branch': nrm((L, N_BRANCH, MIX_W, D_MODEL), MIX_W ** -0.5),
        'w_out': nrm((L, D_MODEL, D_MODEL), D_MODEL ** -0.5),
        'norm_ffn_w': 1.0 + nrm((L, D_MODEL), 0.02),
        'w_ffn_in': nrm((L, D_MODEL, 2 * FF_HIDDEN), D_MODEL ** -0.5),
        'w_ffn_out': nrm((L, FF_HIDDEN, D_MODEL), FF_HIDDEN ** -0.5),
        'norm_final_w': 1.0 + nrm((D_MODEL,), 0.02),
        'hgrn_lower_bounds': nrm((L, MIX_W), 0.5),
        'hgrn_norm_w': 1.0 + nrm((L, MIX_W), 0.02),
        'rwkv_mu': unif((L, RW_COLS), 0.0, 1.0),
        'rwkv_w0': unif((L, MIX_W), -6.0, 1.0),
        'rwkv_w2': nrm((L, RW_DECAY_LORA, MIX_W), 0.1 * RW_DECAY_LORA ** -0.5),
        'rwkv_a0': nrm((L, MIX_W), 0.1),
        'rwkv_a2': nrm((L, RW_A_LORA, MIX_W), 0.1 * RW_A_LORA ** -0.5),
        'rwkv_g2': nrm((L, RW_G_LORA, MIX_W), RW_G_LORA ** -0.5),
        'rwkv_k_k': 0.85 + nrm((L, MIX_W), 0.05),
        'rwkv_k_a': 1.0 + nrm((L, MIX_W), 0.05),
        'rwkv_r_k': nrm((L, RW_HEADS, RW_HEAD), 0.1),
        'rwkv_ln_w': 1.0 + nrm((L, MIX_W), 0.02),
        'rwkv_ln_b': nrm((L, MIX_W), 0.02),
        'rwkv_v0': 1.0 + nrm((Lv, MIX_W), 0.1),
        'rwkv_v1': nrm((Lv, MIX_W, RW_V_LORA), MIX_W ** -0.5),
        'rwkv_v2': nrm((Lv, RW_V_LORA, MIX_W), 0.1 * RW_V_LORA ** -0.5),
        's5_a_re': -0.5 + nrm((L, S5_GROUPS, S5_STATE), 0.01),
        's5_a_im': math.pi * jnp.arange(S5_STATE, dtype=jnp.float32) + nrm((L, S5_GROUPS, S5_STATE), 0.01),
        's5_b_re': nrm((L, S5_GROUPS, S5_STATE, S5_GROUP), (2 * S5_GROUP) ** -0.5),
        's5_b_im': nrm((L, S5_GROUPS, S5_STATE, S5_GROUP), (2 * S5_GROUP) ** -0.5),
        's5_c_re': nrm((L, S5_GROUPS, S5_GROUP, S5_STATE), S5_STATE ** -0.5),
        's5_c_im': nrm((L, S5_GROUPS, S5_GROUP, S5_STATE), S5_STATE ** -0.5),
        's5_d': 1.0 + nrm((L, MIX_W), 0.1),
        's5_log_dt': unif((L, S5_GROUPS), math.log(1e-3), math.log(1e-1)),
        's5_w_glu': nrm((L, MIX_W, MIX_W), MIX_W ** -0.5),
        's5_b_glu': nrm((L, MIX_W), 0.02),
        'mamba_conv_w': nrm((L, MB_CONV, MB_XBC), MB_CONV ** -0.5),
        'mamba_conv_b': nrm((L, MB_XBC), 0.02),
        'mamba_dt_bias': dt_mb + jnp.log(-jnp.expm1(-dt_mb)),
        'mamba_a_log': jnp.log(unif((L, MB_HEADS), 1.0, 16.0)),
        'mamba_d': 1.0 + nrm((L, MB_HEADS), 0.1),
        'mamba_norm_w': 1.0 + nrm((L, MIX_W), 0.02),
    }


def reference(x, norm_mix_w, w_in, w_branch, w_out, norm_ffn_w, w_ffn_in, w_ffn_out, norm_final_w,
              hgrn_lower_bounds, hgrn_norm_w,
              rwkv_mu, rwkv_w0, rwkv_w2, rwkv_a0, rwkv_a2, rwkv_g2, rwkv_k_k, rwkv_k_a, rwkv_r_k,
              rwkv_ln_w, rwkv_ln_b, rwkv_v0, rwkv_v1, rwkv_v2,
              s5_a_re, s5_a_im, s5_b_re, s5_b_im, s5_c_re, s5_c_im, s5_d, s5_log_dt, s5_w_glu, s5_b_glu,
              mamba_conv_w, mamba_conv_b, mamba_dt_bias, mamba_a_log, mamba_d, mamba_norm_w):
    bsz, seq, _ = x.shape
    p = jax.nn.softmax(hgrn_lower_bounds.astype(jnp.float32), axis=0)
    lower_bounds = jnp.cumsum(p, axis=0) - p[0]
    offs = [GATE_COLS, GATE_COLS + HG_COLS, GATE_COLS + HG_COLS + RW_COLS,
            GATE_COLS + HG_COLS + RW_COLS + S5_COLS]
    v_first = None
    for l in range(DEPTH):
        u = rmsnorm(x, norm_mix_w[l])
        z_gate, z_hg, z_rw, z_s5, z_mb = jnp.split(u @ w_in[l], offs, axis=-1)
        y_hg = hgrn2_mixer(z_hg, lower_bounds[l], hgrn_norm_w[l])
        vres = None if l == 0 else (rwkv_v0[l - 1], rwkv_v1[l - 1], rwkv_v2[l - 1])
        y_rw, v_first = rwkv7_mixer(z_rw, v_first, vres, rwkv_mu[l], rwkv_w0[l], rwkv_w2[l],
                                    rwkv_a0[l], rwkv_a2[l], rwkv_g2[l], rwkv_k_k[l], rwkv_k_a[l],
                                    rwkv_r_k[l], rwkv_ln_w[l], rwkv_ln_b[l])
        y_s5 = s5_mixer(z_s5, s5_a_re[l], s5_a_im[l], s5_b_re[l], s5_b_im[l], s5_c_re[l], s5_c_im[l],
                        s5_d[l], s5_log_dt[l], s5_w_glu[l], s5_b_glu[l])
        y_mb = mamba2_mixer(z_mb, mamba_conv_w[l], mamba_conv_b[l], mamba_dt_bias[l], mamba_a_log[l],
                            mamba_d[l], mamba_norm_w[l])
        branches = jnp.stack([y_hg, y_rw, y_s5, y_mb], axis=2)
        proj = jnp.einsum('bskw,kwd->bskd', branches, w_branch[l])
        gates = jax.nn.sigmoid(z_gate).reshape(bsz, seq, N_BRANCH, D_MODEL)
        x = x + jnp.sum(gates * proj, axis=2) @ w_out[l]
        x = x + swiglu(rmsnorm(x, norm_ffn_w[l]), w_ffn_in[l], w_ffn_out[l])
    return rmsnorm(x, norm_final_w)
```

```cpp
#include <hip/hip_runtime.h>
#include <hip/hip_cooperative_groups.h>
#include <cstdio>
#include <cstdint>
namespace cg = cooperative_groups;

#ifndef COOP
#define COOP 1
#endif

typedef unsigned short bf16_t;
typedef __attribute__((ext_vector_type(8))) short bf16x8;
typedef __attribute__((ext_vector_type(4))) float f32x4;

constexpr int T_TOK = 16384, SEQ = 2048, DM = 1024;
constexpr int IN_COLS = 9992, NZ = 5896, ZS = 5904;
constexpr int ZHG = 0, ZRW = 2048, ZS5 = 3840, ZMB = 4352;
constexpr int FFH = 2816;
constexpr int NPH_LAYER = 10, NPHASES = 21;

constexpr size_t OFF_WTIN   = 0;
constexpr size_t OFF_WTGATE = OFF_WTIN + (size_t)5896 * 1024 * 2;
constexpr size_t OFF_WTBR   = OFF_WTGATE + (size_t)4096 * 1024 * 2;
constexpr size_t OFF_WTOUT  = OFF_WTBR + (size_t)4 * 1024 * 512 * 2;
constexpr size_t OFF_WTF1   = OFF_WTOUT + (size_t)1024 * 1024 * 2;
constexpr size_t OFF_WTF2   = OFF_WTF1 + (size_t)5632 * 1024 * 2;
constexpr size_t OFF_WTGLU  = OFF_WTF2 + (size_t)1024 * 2816 * 2;
constexpr size_t OFF_U      = OFF_WTGLU + (size_t)512 * 512 * 2;
constexpr size_t OFF_Z      = OFF_U + (size_t)T_TOK * 1024 * 2;
constexpr size_t OFF_VF     = OFF_Z + (size_t)T_TOK * ZS * 2;
constexpr size_t WS_NEED    = OFF_VF + (size_t)T_TOK * 512 * 2;

struct Params {
  const float* in[41];
  float* out;
  char* ws;
};

enum { I_X = 0, I_NORM_MIX, I_W_IN, I_W_BRANCH, I_W_OUT, I_NORM_FFN, I_W_FFN_IN, I_W_FFN_OUT, I_NORM_FINAL,
       I_HG_LB, I_HG_NW, I_RW_MU, I_RW_W0, I_RW_W2, I_RW_A0, I_RW_A2, I_RW_G2, I_RW_KK, I_RW_KA, I_RW_RK,
       I_RW_LNW, I_RW_LNB, I_RW_V0, I_RW_V1, I_RW_V2, I_S5_ARE, I_S5_AIM, I_S5_BRE, I_S5_BIM, I_S5_CRE,
       I_S5_CIM, I_S5_D, I_S5_LOGDT, I_S5_WGLU, I_S5_BGLU, I_MB_CONVW, I_MB_CONVB, I_MB_DTB, I_MB_ALOG,
       I_MB_D, I_MB_NW };

__device__ __forceinline__ float bf2f(bf16_t v) { return __uint_as_float(((unsigned)v) << 16); }
__device__ __forceinline__ bf16_t f2bf(float f) {
  unsigned u = __float_as_uint(f);
  u += 0x7fffu + ((u >> 16) & 1u);
  return (bf16_t)(u >> 16);
}
__device__ __forceinline__ unsigned pack2(float a, float b) { return (unsigned)f2bf(a) | ((unsigned)f2bf(b) << 16); }
__device__ __forceinline__ float sigmoidf_(float x) { return 1.f / (1.f + __expf(-x)); }
__device__ __forceinline__ float siluf_(float x) { return x / (1.f + __expf(-x)); }
__device__ __forceinline__ float softplusf_(float x) { return x > 20.f ? x : log1pf(__expf(x)); }
__device__ __forceinline__ float gelu_tanh(float x) {
  float u = 0.7978845608028654f * (x + 0.044715f * x * x * x);
  return 0.5f * x * (1.f + tanhf(u));
}
__device__ __forceinline__ float quad_sum(float x) {
  x += __builtin_bit_cast(float, __builtin_amdgcn_update_dpp(0, __builtin_bit_cast(int, x), 0xB1, 0xF, 0xF, true));
  x += __builtin_bit_cast(float, __builtin_amdgcn_update_dpp(0, __builtin_bit_cast(int, x), 0x4E, 0xF, 0xF, true));
  return x;
}
__device__ __forceinline__ float sum16(float x) {
  x += __shfl_xor(x, 1); x += __shfl_xor(x, 2); x += __shfl_xor(x, 4); x += __shfl_xor(x, 8);
  return x;
}
__device__ __forceinline__ float sum64(float x) {
  x = sum16(x); x += __shfl_xor(x, 16); x += __shfl_xor(x, 32);
  return x;
}

__device__ __forceinline__ int opaque_tid() {
  int t = threadIdx.x;
  asm volatile("" : "+v"(t));
  return t;
}

template <int ROWS>
__device__ __forceinline__ void g_load(uint4 (&r)[ROWS / 32], const bf16_t* base, int ld, int row0, int rowmax, int k0, const int tid) {
  const int q = tid & 7, r0 = tid >> 3;
#pragma unroll
  for (int i = 0; i < ROWS / 32; ++i) {
    int row = row0 + r0 + 32 * i;
    row = row < rowmax ? row : rowmax;
    r[i] = *reinterpret_cast<const uint4*>(base + (size_t)row * ld + k0 + q * 8);
  }
}
template <int ROWS>
__device__ __forceinline__ void s_store(const uint4 (&r)[ROWS / 32], char* s, const int tid) {
  const int q = tid & 7, r0 = tid >> 3;
#pragma unroll
  for (int i = 0; i < ROWS / 32; ++i) {
    int row = r0 + 32 * i;
    *reinterpret_cast<uint4*>(s + row * 128 + ((q ^ ((row >> 1) & 7)) << 4)) = r[i];
  }
}

template <int BN>
__device__ __forceinline__ void gemm_mainloop(f32x4 (&acc)[4][BN / 32], const bf16_t* A, int lda, int m0,
                                              const bf16_t* Bt, int ldb, int n0, int nmax, int K, char* smem, const int tid) {
  const int lane = tid & 63, wid = tid >> 6, wm = wid >> 1, wn = wid & 1;
  uint4 ra[4], rb[BN / 32];
  const int nk = K >> 6;
  g_load<128>(ra, A, lda, m0, 0x7fffffff, 0, tid);
  g_load<BN>(rb, Bt, ldb, n0, nmax, 0, tid);
  s_store<128>(ra, smem, tid);
  s_store<BN>(rb, smem + 32768, tid);
  __syncthreads();
  for (int kt = 0; kt < nk; ++kt) {
    const int buf = kt & 1;
    if (kt + 1 < nk) {
      g_load<128>(ra, A, lda, m0, 0x7fffffff, (kt + 1) * 64, tid);
      g_load<BN>(rb, Bt, ldb, n0, nmax, (kt + 1) * 64, tid);
    }
    const char* a_s = smem + buf * 16384;
    const char* b_s = smem + 32768 + buf * (BN * 128);
#pragma unroll
    for (int ks = 0; ks < 2; ++ks) {
      bf16x8 af[4], bfr[BN / 32];
      const int kc = ks * 4 + (lane >> 4);
#pragma unroll
      for (int mi = 0; mi < 4; ++mi) {
        int row = wm * 64 + mi * 16 + (lane & 15);
        af[mi] = *reinterpret_cast<const bf16x8*>(a_s + row * 128 + ((kc ^ ((row >> 1) & 7)) << 4));
      }
#pragma unroll
      for (int ni = 0; ni < BN / 32; ++ni) {
        int row = wn * (BN / 2) + ni * 16 + (lane & 15);
        bfr[ni] = *reinterpret_cast<const bf16x8*>(b_s + row * 128 + ((kc ^ ((row >> 1) & 7)) << 4));
      }
#pragma unroll
      for (int mi = 0; mi < 4; ++mi)
#pragma unroll
        for (int ni = 0; ni < BN / 32; ++ni)
          acc[mi][ni] = __builtin_amdgcn_mfma_f32_16x16x32_bf16(af[mi], bfr[ni], acc[mi][ni], 0, 0, 0);
    }
    if (kt + 1 < nk) {
      s_store<128>(ra, smem + (buf ^ 1) * 16384, tid);
      s_store<BN>(rb, smem + 32768 + (buf ^ 1) * (BN * 128), tid);
    }
    __syncthreads();
  }
}

template <int BN>
__device__ __forceinline__ void zero_acc(f32x4 (&acc)[4][BN / 32]) {
#pragma unroll
  for (int mi = 0; mi < 4; ++mi)
#pragma unroll
    for (int ni = 0; ni < BN / 32; ++ni) acc[mi][ni] = f32x4{0.f, 0.f, 0.f, 0.f};
}

__device__ __forceinline__ void conv_tile(const float* src, int ld, int nlimit, int k0, int n0, bf16_t* dst, int Kd, int mode,
                                          char* smem, const int tid) {
  float* sT = reinterpret_cast<float*>(smem);
#pragma unroll
  for (int i = 0; i < 16; ++i) {
    int kk = i * 4 + (tid >> 6), nn = tid & 63;
    float v = (n0 + nn < nlimit) ? src[(size_t)(k0 + kk) * ld + n0 + nn] : 0.f;
    sT[kk * 65 + nn] = v;
  }
  __syncthreads();
  {
    int nn = tid >> 2, kq = tid & 3;
    int n = n0 + nn;
    if (n < nlimit) {
      int drow = n;
      if (mode == 1) {
        if (n < FFH) drow = (n >> 4) * 32 + (n & 15);
        else { int j = n - FFH; drow = (j >> 4) * 32 + 16 + (j & 15); }
      }
      unsigned pk[8];
#pragma unroll
      for (int j = 0; j < 8; ++j) pk[j] = pack2(sT[(kq * 16 + 2 * j) * 65 + nn], sT[(kq * 16 + 2 * j + 1) * 65 + nn]);
      uint4* d = reinterpret_cast<uint4*>(dst + (size_t)drow * Kd + k0 + kq * 16);
      d[0] = uint4{pk[0], pk[1], pk[2], pk[3]};
      d[1] = uint4{pk[4], pk[5], pk[6], pk[7]};
    }
  }
  __syncthreads();
}

__device__ __forceinline__ void rmsnorm_row_to_bf16(const float* x, const float* w, bf16_t* out, const int lane) {
  float4 v[4];
  float ss = 0.f;
#pragma unroll
  for (int i = 0; i < 4; ++i) {
    v[i] = *reinterpret_cast<const float4*>(x + i * 256 + lane * 4);
    ss += v[i].x * v[i].x + v[i].y * v[i].y + v[i].z * v[i].z + v[i].w * v[i].w;
  }
  ss = sum64(ss);
  float rstd = rsqrtf(ss * (1.f / 1024.f) + 1e-6f);
#pragma unroll
  for (int i = 0; i < 4; ++i) {
    float4 ww = *reinterpret_cast<const float4*>(w + i * 256 + lane * 4);
    uint2 o;
    o.x = pack2(v[i].x * rstd * ww.x, v[i].y * rstd * ww.y);
    o.y = pack2(v[i].z * rstd * ww.z, v[i].w * rstd * ww.w);
    *reinterpret_cast<uint2*>(out + i * 256 + lane * 4) = o;
  }
}

constexpr int CT_IN = 157 * 16, CT_BR = 512, CT_OUT = 256, CT_F1 = 88 * 16, CT_F2 = 44 * 16, CT_GLU = 64;
constexpr int CT_TOTAL = CT_IN + CT_BR + CT_OUT + CT_F1 + CT_F2 + CT_GLU;

__device__ void phase_convert_norm(const Params& p, int l, char* smem) {
  const int tid = opaque_tid();
  char* ws = p.ws;
  const int ntask = CT_TOTAL + T_TOK / 4;
  const float* xsrc = (l == 0) ? p.in[I_X] : p.out;
  for (int t = blockIdx.x; t < ntask; t += gridDim.x) {
    if (t < CT_TOTAL) {
      int c = t;
      if (c < CT_IN) {
        int nt = c >> 4, kt = c & 15;
        const float* src = p.in[I_W_IN] + (size_t)l * 1024 * IN_COLS;
        if (nt < 64) conv_tile(src, IN_COLS, IN_COLS, kt * 64, nt * 64, (bf16_t*)(ws + OFF_WTGATE), 1024, 0, smem, tid);
        else conv_tile(src + 4096, IN_COLS, IN_COLS - 4096, kt * 64, (nt - 64) * 64, (bf16_t*)(ws + OFF_WTIN), 1024, 0, smem, tid);
        continue;
      }
      c -= CT_IN;
      if (c < CT_BR) {
        int kb = c >> 7, r = c & 127, nt = r >> 3, kt = r & 7;
        const float* src = p.in[I_W_BRANCH] + ((size_t)l * 4 + kb) * 512 * 1024;
        conv_tile(src, 1024, 1024, kt * 64, nt * 64, (bf16_t*)(ws + OFF_WTBR) + (size_t)kb * 1024 * 512, 512, 0, smem, tid);
        continue;
      }
      c -= CT_BR;
      if (c < CT_OUT) {
        int nt = c >> 4, kt = c & 15;
        conv_tile(p.in[I_W_OUT] + (size_t)l * 1024 * 1024, 1024, 1024, kt * 64, nt * 64, (bf16_t*)(ws + OFF_WTOUT), 1024, 0, smem, tid);
        continue;
      }
      c -= CT_OUT;
      if (c < CT_F1) {
        int nt = c >> 4, kt = c & 15;
        conv_tile(p.in[I_W_FFN_IN] + (size_t)l * 1024 * 5632, 5632, 5632, kt * 64, nt * 64, (bf16_t*)(ws + OFF_WTF1), 1024, 1, smem, tid);
        continue;
      }
      c -= CT_F1;
      if (c < CT_F2) {
        int nt = c / 44, kt = c % 44;
        conv_tile(p.in[I_W_FFN_OUT] + (size_t)l * FFH * 1024, 1024, 1024, kt * 64, nt * 64, (bf16_t*)(ws + OFF_WTF2), FFH, 0, smem, tid);
        continue;
      }
      c -= CT_F2;
      {
        int nt = c >> 3, kt = c & 7;
        conv_tile(p.in[I_S5_WGLU] + (size_t)l * 512 * 512, 512, 512, kt * 64, nt * 64, (bf16_t*)(ws + OFF_WTGLU), 512, 0, smem, tid);
      }
    } else {
      int row = (t - CT_TOTAL) * 4 + (tid >> 6);
      rmsnorm_row_to_bf16(xsrc + (size_t)row * DM, p.in[I_NORM_MIX] + l * DM, (bf16_t*)(ws + OFF_U) + (size_t)row * DM, tid & 63);
    }
  }
}

__device__ void phase_norm_only(const Params& p, const float* xsrc, const float* w) {
  const int tid = opaque_tid();
  for (int t = blockIdx.x; t < T_TOK / 4; t += gridDim.x) {
    int row = t * 4 + (tid >> 6);
    rmsnorm_row_to_bf16(xsrc + (size_t)row * DM, w, (bf16_t*)(p.ws + OFF_U) + (size_t)row * DM, tid & 63);
  }
}

__device__ void phase_inproj(const Params& p, char* smem) {
  const bf16_t* U = (const bf16_t*)(p.ws + OFF_U);
  const bf16_t* Wt = (const bf16_t*)(p.ws + OFF_WTIN);
  bf16_t* Z = (bf16_t*)(p.ws + OFF_Z);
  const int tid = opaque_tid();
  const int lane = tid & 63, wid = tid >> 6, wm = wid >> 1, wn = wid & 1;
  constexpr int NT = 47;
  for (int t = blockIdx.x; t < 128 * NT; t += gridDim.x) {
    int mt = t / NT, nt = t % NT;
    f32x4 acc[4][4];
    zero_acc<128>(acc);
    gemm_mainloop<128>(acc, U, 1024, mt * 128, Wt, 1024, nt * 128, NZ - 1, 1024, smem, tid);
#pragma unroll
    for (int mi = 0; mi < 4; ++mi)
#pragma unroll
      for (int ni = 0; ni < 4; ++ni) {
        int col = nt * 128 + wn * 64 + ni * 16 + (lane & 15);
        if (col < NZ) {
#pragma unroll
          for (int j = 0; j < 4; ++j) {
            int row = mt * 128 + wm * 64 + mi * 16 + (lane >> 4) * 4 + j;
            Z[(size_t)row * ZS + col] = f2bf(acc[mi][ni][j]);
          }
        }
      }
  }
}

template <int J>
__device__ __forceinline__ void lora_mm(const float* sIn, const float* W, float (&a0)[16], float (&a1)[16], const int tid) {
#pragma unroll
  for (int i = 0; i < 16; ++i) { a0[i] = 0.f; a1[i] = 0.f; }
#pragma unroll 2
  for (int j = 0; j < J; ++j) {
    float w0 = W[j * 512 + tid], w1 = W[j * 512 + tid + 256];
    const float4* x4 = reinterpret_cast<const float4*>(sIn + j * 16);
#pragma unroll
    for (int q = 0; q < 4; ++q) {
      float4 x = x4[q];
      a0[q * 4 + 0] = fmaf(w0, x.x, a0[q * 4 + 0]); a1[q * 4 + 0] = fmaf(w1, x.x, a1[q * 4 + 0]);
      a0[q * 4 + 1] = fmaf(w0, x.y, a0[q * 4 + 1]); a1[q * 4 + 1] = fmaf(w1, x.y, a1[q * 4 + 1]);
      a0[q * 4 + 2] = fmaf(w0, x.z, a0[q * 4 + 2]); a1[q * 4 + 2] = fmaf(w1, x.z, a1[q * 4 + 2]);
      a0[q * 4 + 3] = fmaf(w0, x.w, a0[q * 4 + 3]); a1[q * 4 + 3] = fmaf(w1, x.w, a1[q * 4 + 3]);
    }
  }
}

__device__ __forceinline__ float rw_shift(const bf16_t* Z, int row, int s, int rc, float mu) {
  float cur = bf2f(Z[(size_t)row * ZS + ZRW + rc]);
  float prev = (s > 0) ? bf2f(Z[(size_t)(row - 1) * ZS + ZRW + rc]) : 0.f;
  return cur + (prev - cur) * mu;
}

__device__ void phase_rwprep(const Params& p, int l, char* smem) {
  const bf16_t* Z = (const bf16_t*)(p.ws + OFF_Z);
  bf16_t* LW = (bf16_t*)(p.ws + OFF_U);
  bf16_t* LA = LW + (size_t)T_TOK * 512;
  bf16_t* VF = (bf16_t*)(p.ws + OFF_VF);
  float* sXw = reinterpret_cast<float*>(smem);
  float* sXa = sXw + 64 * 16;
  float* sTmp = sXa + 64 * 16;
  float* sZv = sTmp + 32 * 16;
  const float* mu = p.in[I_RW_MU] + l * 1792;
  const int tid = opaque_tid();
  for (int t = blockIdx.x; t < T_TOK / 16; t += gridDim.x) {
    const int row0 = t * 16;
    for (int e = tid; e < 2048; e += 256) {
      int which = e >> 10, r = e & 1023, j = r >> 4, tok = r & 15;
      int row = row0 + tok, s = row & (SEQ - 1);
      int rc = 1536 + which * 64 + j;
      float z = rw_shift(Z, row, s, rc, mu[rc]);
      if (which == 0) sXw[j * 16 + tok] = tanhf(z); else sXa[j * 16 + tok] = z;
    }
    float zv0[16], zv1[16];
    {
      float m0 = mu[1024 + tid], m1 = mu[1024 + tid + 256];
#pragma unroll
      for (int tok = 0; tok < 16; ++tok) {
        int row = row0 + tok, s = row & (SEQ - 1);
        zv0[tok] = rw_shift(Z, row, s, 1024 + tid, m0);
        zv1[tok] = rw_shift(Z, row, s, 1024 + tid + 256, m1);
      }
    }
    if (l > 0) {
#pragma unroll
      for (int tok = 0; tok < 16; ++tok) { sZv[tid * 16 + tok] = zv0[tok]; sZv[(tid + 256) * 16 + tok] = zv1[tok]; }
    }
    __syncthreads();
    float a0[16], a1[16];
    lora_mm<64>(sXw, p.in[I_RW_W2] + (size_t)l * 64 * 512, a0, a1, tid);
#pragma unroll
    for (int tok = 0; tok < 16; ++tok) {
      LW[(size_t)(row0 + tok) * 512 + tid] = f2bf(a0[tok]);
      LW[(size_t)(row0 + tok) * 512 + tid + 256] = f2bf(a1[tok]);
    }
    lora_mm<64>(sXa, p.in[I_RW_A2] + (size_t)l * 64 * 512, a0, a1, tid);
#pragma unroll
    for (int tok = 0; tok < 16; ++tok) {
      LA[(size_t)(row0 + tok) * 512 + tid] = f2bf(a0[tok]);
      LA[(size_t)(row0 + tok) * 512 + tid + 256] = f2bf(a1[tok]);
    }
    if (l == 0) {
#pragma unroll
      for (int tok = 0; tok < 16; ++tok) {
        VF[(size_t)(row0 + tok) * 512 + tid] = f2bf(zv0[tok]);
        VF[(size_t)(row0 + tok) * 512 + tid + 256] = f2bf(zv1[tok]);
      }
    } else {
      const float* v1 = p.in[I_RW_V1] + (size_t)(l - 1) * 512 * 32;
      const float* v2 = p.in[I_RW_V2] + (size_t)(l - 1) * 32 * 512;
      const float* v0 = p.in[I_RW_V0] + (size_t)(l - 1) * 512;
      {
        int r = tid & 31, tg = tid >> 5;
        float t0 = 0.f, t1 = 0.f;
#pragma unroll 4
        for (int c = 0; c < 512; ++c) {
          float w = v1[c * 32 + r];
          float2 x = *reinterpret_cast<const float2*>(sZv + c * 16 + tg * 2);
          t0 = fmaf(w, x.x, t0); t1 = fmaf(w, x.y, t1);
        }
        sTmp[r * 16 + tg * 2] = t0; sTmp[r * 16 + tg * 2 + 1] = t1;
      }
      __syncthreads();
      lora_mm<32>(sTmp, v2, a0, a1, tid);
      float b0 = v0[tid], b1 = v0[tid + 256];
#pragma unroll
      for (int tok = 0; tok < 16; ++tok) {
        size_t i0 = (size_t)(row0 + tok) * 512 + tid;
        float vf0 = bf2f(VF[i0]), vf1 = bf2f(VF[i0 + 256]);
        VF[i0] = f2bf(zv0[tok] + (vf0 - zv0[tok]) * sigmoidf_(b0 + a0[tok]));
        VF[i0 + 256] = f2bf(zv1[tok] + (vf1 - zv1[tok]) * sigmoidf_(b1 + a1[tok]));
      }
    }
    __syncthreads();
  }
}

__device__ void hg_scan(const Params& p, int l, int task, char* smem) {
  const int b = task >> 3, h = (task >> 1) & 3, vg = task & 1;
  float* sFg = reinterpret_cast<float*>(smem);
  float* sQs = sFg + 16 * 128;
  float* sO = sQs + 16 * 128;
  float* sVv = sO + 4 * 16 * 64;
  const int tid = opaque_tid(), w = tid >> 6, lane = tid & 63;
  bf16_t* Z = (bf16_t*)(p.ws + OFF_Z) + (size_t)b * SEQ * ZS;
  const int ks = tid & 127;
  float lb = 0.f;
  if (l > 0) {
    float x0 = p.in[I_HG_LB][h * 128 + ks], x1 = p.in[I_HG_LB][512 + h * 128 + ks];
    float m = fmaxf(x0, x1), e0 = expf(x0 - m), e1 = expf(x1 - m);
    lb = e1 / (e0 + e1);
  }
  float s[32];
#pragma unroll
  for (int j = 0; j < 32; ++j) s[j] = 0.f;
  const int vcol = ZHG + 1024 + h * 128 + vg * 64;
  for (int c = 0; c < SEQ / 16; ++c) {
    const int t0 = c * 16;
#pragma unroll
    for (int i = 0; i < 8; ++i) {
      int t = (tid >> 7) + 2 * i;
      size_t ro = (size_t)(t0 + t) * ZS;
      float qv = bf2f(Z[ro + ZHG + h * 128 + ks]);
      float fv = bf2f(Z[ro + ZHG + 512 + h * 128 + ks]);
      float fg = fmaxf(lb + (1.f - lb) * sigmoidf_(fv), 1e-30f);
      sFg[t * 128 + ks] = fg;
      sQs[t * 128 + ks] = siluf_(qv);
    }
#pragma unroll
    for (int i = 0; i < 4; ++i) {
      int t = w + 4 * i;
      sVv[t * 64 + lane] = bf2f(Z[(size_t)(t0 + t) * ZS + vcol + lane]);
    }
    __syncthreads();
#pragma unroll 2
    for (int t = 0; t < 16; ++t) {
      const float v = sVv[t * 64 + lane];
      float o = 0.f;
      const float4* f4p = reinterpret_cast<const float4*>(sFg + t * 128 + w * 32);
      const float4* q4p = reinterpret_cast<const float4*>(sQs + t * 128 + w * 32);
#pragma unroll
      for (int j4 = 0; j4 < 8; ++j4) {
        float4 f4 = f4p[j4], q4 = q4p[j4];
        float fg, kv;
        fg = f4.x; kv = fmaf(-fg, v, v); s[j4 * 4 + 0] = fmaf(s[j4 * 4 + 0], fg, kv); o = fmaf(q4.x, s[j4 * 4 + 0], o);
        fg = f4.y; kv = fmaf(-fg, v, v); s[j4 * 4 + 1] = fmaf(s[j4 * 4 + 1], fg, kv); o = fmaf(q4.y, s[j4 * 4 + 1], o);
        fg = f4.z; kv = fmaf(-fg, v, v); s[j4 * 4 + 2] = fmaf(s[j4 * 4 + 2], fg, kv); o = fmaf(q4.z, s[j4 * 4 + 2], o);
        fg = f4.w; kv = fmaf(-fg, v, v); s[j4 * 4 + 3] = fmaf(s[j4 * 4 + 3], fg, kv); o = fmaf(q4.w, s[j4 * 4 + 3], o);
      }
      sO[(w * 16 + t) * 64 + lane] = o;
    }
    __syncthreads();
    {
      int t = tid >> 4, v4 = (tid & 15) * 4;
      float4 a = *reinterpret_cast<const float4*>(sO + (0 * 16 + t) * 64 + v4);
      float4 bq = *reinterpret_cast<const float4*>(sO + (1 * 16 + t) * 64 + v4);
      float4 cq = *reinterpret_cast<const float4*>(sO + (2 * 16 + t) * 64 + v4);
      float4 d = *reinterpret_cast<const float4*>(sO + (3 * 16 + t) * 64 + v4);
      uint2 o;
      o.x = pack2(a.x + bq.x + cq.x + d.x, a.y + bq.y + cq.y + d.y);
      o.y = pack2(a.z + bq.z + cq.z + d.z, a.w + bq.w + cq.w + d.w);
      *reinterpret_cast<uint2*>(Z + (size_t)(t0 + t) * ZS + vcol + v4) = o;
    }
  }
}

__device__ void mb_scan(const Params& p, int l, int task, char* smem) {
  const int b = task >> 3, hd = task & 7, g = hd >> 2;
  float* sB = reinterpret_cast<float*>(smem);
  float* sC = sB + 16 * 128;
  float* sX = sC + 16 * 128;
  float* sDt = sX + 16 * 64;
  float* sDA = sDt + 16;
  float* sO = sDA + 16;
  const int tid = opaque_tid(), w = tid >> 6, lane = tid & 63;
  bf16_t* Z = (bf16_t*)(p.ws + OFF_Z) + (size_t)b * SEQ * ZS;
  const float* cw = p.in[I_MB_CONVW] + (size_t)l * 4 * 1024;
  const float* cb = p.in[I_MB_CONVB] + (size_t)l * 1024;
  int ci0, ci1;
  {
    int ch = tid;
    ci0 = (ch < 64) ? hd * 64 + ch : (ch < 192 ? 512 + g * 128 + (ch - 64) : 768 + g * 128 + (ch - 192));
    ci1 = 768 + g * 128 + 64 + (tid & 63);
  }
  float w0a = cw[ci0], w1a = cw[1024 + ci0], w2a = cw[2048 + ci0], w3a = cw[3072 + ci0], ba = cb[ci0];
  float w0b = cw[ci1], w1b = cw[1024 + ci1], w2b = cw[2048 + ci1], w3b = cw[3072 + ci1], bb = cb[ci1];
  const float Aneg = -expf(p.in[I_MB_ALOG][l * 8 + hd]);
  const float dtb = p.in[I_MB_DTB][l * 8 + hd];
  const float Dsk = p.in[I_MB_D][l * 8 + hd];
  float s[32];
#pragma unroll
  for (int j = 0; j < 32; ++j) s[j] = 0.f;
  float pa1 = 0.f, pa2 = 0.f, pa3 = 0.f;
  float pb1 = 0.f, pb2 = 0.f, pb3 = 0.f;
  const int xcol = ZMB + 512;
  for (int c = 0; c < SEQ / 16; ++c) {
    const int t0 = c * 16;
#pragma unroll 4
    for (int t = 0; t < 16; ++t) {
      size_t ro = (size_t)(t0 + t) * ZS + xcol;
      float xa = bf2f(Z[ro + ci0]);
      float va = siluf_(ba + w0a * pa3 + w1a * pa2 + w2a * pa1 + w3a * xa);
      pa3 = pa2; pa2 = pa1; pa1 = xa;
      if (tid < 64) sX[t * 64 + tid] = va;
      else if (tid < 192) sB[t * 128 + (tid - 64)] = va;
      else sC[t * 128 + (tid - 192)] = va;
      if (tid < 64) {
        float xb = bf2f(Z[ro + ci1]);
        float vb = siluf_(bb + w0b * pb3 + w1b * pb2 + w2b * pb1 + w3b * xb);
        pb3 = pb2; pb2 = pb1; pb1 = xb;
        sC[t * 128 + 64 + tid] = vb;
      }
    }
    if (tid < 16) {
      float dr = bf2f(Z[(size_t)(t0 + tid) * ZS + ZMB + 1536 + hd]);
      float dt = softplusf_(dr + dtb);
      sDt[tid] = dt;
      sDA[tid] = __expf(Aneg * dt);
    }
    __syncthreads();
#pragma unroll 2
    for (int t = 0; t < 16; ++t) {
      const float dA = sDA[t];
      const float xdt = sX[t * 64 + lane] * sDt[t];
      float y = 0.f;
      const float4* b4p = reinterpret_cast<const float4*>(sB + t * 128 + w * 32);
      const float4* c4p = reinterpret_cast<const float4*>(sC + t * 128 + w * 32);
#pragma unroll
      for (int j4 = 0; j4 < 8; ++j4) {
        float4 b4 = b4p[j4], c4 = c4p[j4];
        s[j4 * 4 + 0] = fmaf(s[j4 * 4 + 0], dA, b4.x * xdt); y = fmaf(c4.x, s[j4 * 4 + 0], y);
        s[j4 * 4 + 1] = fmaf(s[j4 * 4 + 1], dA, b4.y * xdt); y = fmaf(c4.y, s[j4 * 4 + 1], y);
        s[j4 * 4 + 2] = fmaf(s[j4 * 4 + 2], dA, b4.z * xdt); y = fmaf(c4.z, s[j4 * 4 + 2], y);
        s[j4 * 4 + 3] = fmaf(s[j4 * 4 + 3], dA, b4.w * xdt); y = fmaf(c4.w, s[j4 * 4 + 3], y);
      }
      sO[(w * 16 + t) * 64 + lane] = y;
    }
    __syncthreads();
    {
      int t = tid >> 4, p4 = (tid & 15) * 4;
      float4 a = *reinterpret_cast<const float4*>(sO + (0 * 16 + t) * 64 + p4);
      float4 bq = *reinterpret_cast<const float4*>(sO + (1 * 16 + t) * 64 + p4);
      float4 cq = *reinterpret_cast<const float4*>(sO + (2 * 16 + t) * 64 + p4);
      float4 d = *reinterpret_cast<const float4*>(sO + (3 * 16 + t) * 64 + p4);
      float4 xs = *reinterpret_cast<const float4*>(sX + t * 64 + p4);
      bf16_t* gp = Z + (size_t)(t0 + t) * ZS + ZMB + hd * 64 + p4;
      uint2 gv = *reinterpret_cast<const uint2*>(gp);
      float g0 = bf2f((bf16_t)(gv.x & 0xffff)), g1 = bf2f((bf16_t)(gv.x >> 16));
      float g2 = bf2f((bf16_t)(gv.y & 0xffff)), g3 = bf2f((bf16_t)(gv.y >> 16));
      float y0 = a.x + bq.x + cq.x + d.x + Dsk * xs.x;
      float y1 = a.y + bq.y + cq.y + d.y + Dsk * xs.y;
      float y2 = a.z + bq.z + cq.z + d.z + Dsk * xs.z;
      float y3 = a.w + bq.w + cq.w + d.w + Dsk * xs.w;
      uint2 o;
      o.x = pack2(y0 * siluf_(g0), y1 * siluf_(g1));
      o.y = pack2(y2 * siluf_(g2), y3 * siluf_(g3));
      *reinterpret_cast<uint2*>(gp) = o;
    }
    __syncthreads();
  }
}

__device__ void s5_scan(const Params& p, int l, int task, char* smem) {
  const int tid = opaque_tid(), w = tid >> 6, lane = tid & 63;
  const int b = task >> 3, g = (task & 7) * 4 + w;
  float* base = reinterpret_cast<float*>(smem) + w * 3264;
  float* sU = base;
  float* sH = sU + 128;
  float* sC = sH + 8 * 65 * 2;
  bf16_t* Z = (bf16_t*)(p.ws + OFF_Z) + (size_t)b * SEQ * ZS + ZS5 + g * 16;
  const int n = lane;
  float lr, li, bbr[16], bbi[16];
  {
    float dt = expf(p.in[I_S5_LOGDT][l * 32 + g]);
    float are = p.in[I_S5_ARE][(l * 32 + g) * 64 + n], aim = p.in[I_S5_AIM][(l * 32 + g) * 64 + n];
    float mag = expf(dt * are);
    lr = mag * cosf(dt * aim); li = mag * sinf(dt * aim);
    float den = are * are + aim * aim;
    float cr = ((lr - 1.f) * are + li * aim) / den;
    float ci = (li * are - (lr - 1.f) * aim) / den;
    const float* bre = p.in[I_S5_BRE] + ((size_t)(l * 32 + g) * 64 + n) * 16;
    const float* bim = p.in[I_S5_BIM] + ((size_t)(l * 32 + g) * 64 + n) * 16;
#pragma unroll
    for (int c = 0; c < 16; ++c) {
      float br = bre[c], bi = bim[c];
      bbr[c] = cr * br - ci * bi;
      bbi[c] = cr * bi + ci * br;
    }
    const float* cre = p.in[I_S5_CRE] + (size_t)(l * 32 + g) * 16 * 64;
    const float* cim = p.in[I_S5_CIM] + (size_t)(l * 32 + g) * 16 * 64;
#pragma unroll
    for (int cp = 0; cp < 8; ++cp) {
      float4 v;
      v.x = cre[(2 * cp) * 64 + n]; v.y = cre[(2 * cp + 1) * 64 + n];
      v.z = cim[(2 * cp) * 64 + n]; v.w = cim[(2 * cp + 1) * 64 + n];
      *reinterpret_cast<float4*>(sC + (n * 8 + cp) * 4) = v;
    }
  }
  const int ot = lane >> 3, ocp = lane & 7;
  const float d0 = p.in[I_S5_D][l * 512 + g * 16 + 2 * ocp], d1 = p.in[I_S5_D][l * 512 + g * 16 + 2 * ocp + 1];
  float hr = 0.f, hi = 0.f;
  for (int c = 0; c < SEQ / 8; ++c) {
    const int t0 = c * 8;
    unsigned uraw = *reinterpret_cast<const unsigned*>(Z + (size_t)(t0 + ot) * ZS + 2 * ocp);
    float u0 = bf2f((bf16_t)(uraw & 0xffff)), u1 = bf2f((bf16_t)(uraw >> 16));
    *reinterpret_cast<float2*>(sU + ot * 16 + 2 * ocp) = float2{u0, u1};
    __syncthreads();
#pragma unroll 2
    for (int t = 0; t < 8; ++t) {
      const float4* u4 = reinterpret_cast<const float4*>(sU + t * 16);
      float bur = 0.f, bui = 0.f;
#pragma unroll
      for (int q = 0; q < 4; ++q) {
        float4 u = u4[q];
        bur = fmaf(bbr[q * 4 + 0], u.x, bur); bui = fmaf(bbi[q * 4 + 0], u.x, bui);
        bur = fmaf(bbr[q * 4 + 1], u.y, bur); bui = fmaf(bbi[q * 4 + 1], u.y, bui);
        bur = fmaf(bbr[q * 4 + 2], u.z, bur); bui = fmaf(bbi[q * 4 + 2], u.z, bui);
        bur = fmaf(bbr[q * 4 + 3], u.w, bur); bui = fmaf(bbi[q * 4 + 3], u.w, bui);
      }
      float nr = lr * hr - li * hi + bur;
      float ni = lr * hi + li * hr + bui;
      hr = nr; hi = ni;
      *reinterpret_cast<float2*>(sH + (t * 65 + n) * 2) = float2{hr, hi};
    }
    __syncthreads();
    {
      float y0 = 0.f, y1 = 0.f;
#pragma unroll 8
      for (int nn = 0; nn < 64; ++nn) {
        float2 hh = *reinterpret_cast<const float2*>(sH + (ot * 65 + nn) * 2);
        float4 cc = *reinterpret_cast<const float4*>(sC + (nn * 8 + ocp) * 4);
        y0 = fmaf(cc.x, hh.x, y0); y0 = fmaf(-cc.z, hh.y, y0);
        y1 = fmaf(cc.y, hh.x, y1); y1 = fmaf(-cc.w, hh.y, y1);
      }
      y0 = gelu_tanh(y0 + d0 * u0);
      y1 = gelu_tanh(y1 + d1 * u1);
      *reinterpret_cast<unsigned*>(Z + (size_t)(t0 + ot) * ZS + 2 * ocp) = pack2(y0, y1);
    }
    __syncthreads();
  }
}

__device__ void rw_scan(const Params& p, int l, int task, char* smem) {
  const int b = task >> 3, h = task & 7;
  float* sR = reinterpret_cast<float*>(smem);
  float* sW = sR + 1024;
  float* sK = sW + 1024;
  float* sA = sK + 1024;
  float* sBb = sA + 1024;
  float* sV = sBb + 1024;
  float* sY = sV + 1024;
  float* sBonus = sY + 1024;
  const int tid = opaque_tid(), w = tid >> 6, lane = tid & 63;
  const size_t tokbase = (size_t)b * SEQ;
  bf16_t* Z = (bf16_t*)(p.ws + OFF_Z) + tokbase * ZS;
  const bf16_t* LW = (const bf16_t*)(p.ws + OFF_U) + tokbase * 512;
  const bf16_t* LA = LW + (size_t)T_TOK * 512;
  const bf16_t* VF = (const bf16_t*)(p.ws + OFF_VF) + tokbase * 512;
  const int st = tid >> 4, c4 = (tid & 15) * 4, ch = h * 64 + c4;
  float mur[4], muk[4], w0[4], a0[4], kk_[4], ka_[4], rk_[4], lnw[4], lnb[4];
#pragma unroll
  for (int e = 0; e < 4; ++e) {
    mur[e] = p.in[I_RW_MU][l * 1792 + ch + e];
    muk[e] = p.in[I_RW_MU][l * 1792 + 512 + ch + e];
    w0[e] = p.in[I_RW_W0][l * 512 + ch + e];
    a0[e] = p.in[I_RW_A0][l * 512 + ch + e];
    kk_[e] = p.in[I_RW_KK][l * 512 + ch + e];
    ka_[e] = p.in[I_RW_KA][l * 512 + ch + e];
    rk_[e] = p.in[I_RW_RK][l * 512 + ch + e];
    lnw[e] = p.in[I_RW_LNW][l * 512 + ch + e];
    lnb[e] = p.in[I_RW_LNB][l * 512 + ch + e];
  }
  const int rl = lane >> 2, kq = lane & 3, vrow = w * 16 + rl;
  float S[16];
#pragma unroll
  for (int j = 0; j < 16; ++j) S[j] = 0.f;
  for (int c = 0; c < SEQ / 16; ++c) {
    const int t0 = c * 16;
    {
      const int s = t0 + st;
      const bf16_t* zr = Z + (size_t)s * ZS + ZRW + ch;
      uint2 rc = *reinterpret_cast<const uint2*>(zr);
      uint2 kc = *reinterpret_cast<const uint2*>(zr + 512);
      uint2 rp = uint2{0u, 0u}, kp = uint2{0u, 0u};
      if (s > 0) { rp = *reinterpret_cast<const uint2*>(zr - ZS); kp = *reinterpret_cast<const uint2*>(zr - ZS + 512); }
      uint2 lwv = *reinterpret_cast<const uint2*>(LW + (size_t)s * 512 + ch);
      uint2 lav = *reinterpret_cast<const uint2*>(LA + (size_t)s * 512 + ch);
      uint2 vfv = *reinterpret_cast<const uint2*>(VF + (size_t)s * 512 + ch);
      float r4[4], k4[4], kkv[4], av[4], wv[4], vv[4];
      float n2 = 0.f;
#pragma unroll
      for (int e = 0; e < 4; ++e) {
        unsigned rcw = (e < 2) ? rc.x : rc.y, kcw = (e < 2) ? kc.x : kc.y, rpw = (e < 2) ? rp.x : rp.y, kpw = (e < 2) ? kp.x : kp.y;
        unsigned lww = (e < 2) ? lwv.x : lwv.y, law = (e < 2) ? lav.x : lav.y, vfw = (e < 2) ? vfv.x : vfv.y;
        int sh = (e & 1) * 16;
        float rcur = bf2f((bf16_t)((rcw >> sh) & 0xffff)), rprev = bf2f((bf16_t)((rpw >> sh) & 0xffff));
        float kcur = bf2f((bf16_t)((kcw >> sh) & 0xffff)), kprev = bf2f((bf16_t)((kpw >> sh) & 0xffff));
        float lwf = bf2f((bf16_t)((lww >> sh) & 0xffff)), laf = bf2f((bf16_t)((law >> sh) & 0xffff));
        vv[e] = bf2f((bf16_t)((vfw >> sh) & 0xffff));
        r4[e] = rcur + (rprev - rcur) * mur[e];
        k4[e] = kcur + (kprev - kcur) * muk[e];
        float wlog = -softplusf_(-(w0[e] + lwf)) - 0.5f;
        wv[e] = __expf(-__expf(wlog));
        av[e] = sigmoidf_(a0[e] + laf);
        kkv[e] = k4[e] * kk_[e];
        n2 += kkv[e] * kkv[e];
      }
      n2 = sum16(n2);
      float inv = 1.f / fmaxf(sqrtf(n2), 1e-12f);
      float bon = 0.f;
      float kt4[4], ap4[4], bp4[4];
#pragma unroll
      for (int e = 0; e < 4; ++e) {
        float kkn = kkv[e] * inv;
        kt4[e] = k4[e] * (1.f + (av[e] - 1.f) * ka_[e]);
        ap4[e] = -kkn;
        bp4[e] = kkn * av[e];
        bon += r4[e] * kt4[e] * rk_[e];
      }
      bon = sum16(bon);
      *reinterpret_cast<float4*>(sR + st * 64 + c4) = float4{r4[0], r4[1], r4[2], r4[3]};
      *reinterpret_cast<float4*>(sW + st * 64 + c4) = float4{wv[0], wv[1], wv[2], wv[3]};
      *reinterpret_cast<float4*>(sK + st * 64 + c4) = float4{kt4[0], kt4[1], kt4[2], kt4[3]};
      *reinterpret_cast<float4*>(sA + st * 64 + c4) = float4{ap4[0], ap4[1], ap4[2], ap4[3]};
      *reinterpret_cast<float4*>(sBb + st * 64 + c4) = float4{bp4[0], bp4[1], bp4[2], bp4[3]};
      *reinterpret_cast<float4*>(sV + st * 64 + c4) = float4{vv[0], vv[1], vv[2], vv[3]};
      if ((tid & 15) == 0) sBonus[st] = bon;
    }
    __syncthreads();
#pragma unroll 2
    for (int t = 0; t < 16; ++t) {
      const float4* a4p = reinterpret_cast<const float4*>(sA + t * 64 + kq * 16);
      const float4* w4p = reinterpret_cast<const float4*>(sW + t * 64 + kq * 16);
      const float4* b4p = reinterpret_cast<const float4*>(sBb + t * 64 + kq * 16);
      const float4* k4p = reinterpret_cast<const float4*>(sK + t * 64 + kq * 16);
      const float4* r4p = reinterpret_cast<const float4*>(sR + t * 64 + kq * 16);
      const float vv = sV[t * 64 + vrow];
      float sa = 0.f;
#pragma unroll
      for (int q = 0; q < 4; ++q) {
        float4 a = a4p[q];
        sa = fmaf(S[q * 4 + 0], a.x, sa); sa = fmaf(S[q * 4 + 1], a.y, sa);
        sa = fmaf(S[q * 4 + 2], a.z, sa); sa = fmaf(S[q * 4 + 3], a.w, sa);
      }
      sa = quad_sum(sa);
      float y = 0.f;
#pragma unroll
      for (int q = 0; q < 4; ++q) {
        float4 ww = w4p[q], bb = b4p[q], kk = k4p[q], rr = r4p[q];
        S[q * 4 + 0] = fmaf(S[q * 4 + 0], ww.x, fmaf(sa, bb.x, vv * kk.x)); y = fmaf(S[q * 4 + 0], rr.x, y);
        S[q * 4 + 1] = fmaf(S[q * 4 + 1], ww.y, fmaf(sa, bb.y, vv * kk.y)); y = fmaf(S[q * 4 + 1], rr.y, y);
        S[q * 4 + 2] = fmaf(S[q * 4 + 2], ww.z, fmaf(sa, bb.z, vv * kk.z)); y = fmaf(S[q * 4 + 2], rr.z, y);
        S[q * 4 + 3] = fmaf(S[q * 4 + 3], ww.w, fmaf(sa, bb.w, vv * kk.w)); y = fmaf(S[q * 4 + 3], rr.w, y);
      }
      y = quad_sum(y);
      if (kq == 0) sY[t * 64 + vrow] = y;
    }
    __syncthreads();
    {
      float4 y4 = *reinterpret_cast<const float4*>(sY + st * 64 + c4);
      float4 v4 = *reinterpret_cast<const float4*>(sV + st * 64 + c4);
      float bon = sBonus[st];
      float mean = sum16(y4.x + y4.y + y4.z + y4.w) * (1.f / 64.f);
      float dx = y4.x - mean, dy = y4.y - mean, dz = y4.z - mean, dw = y4.w - mean;
      float var = sum16(dx * dx + dy * dy + dz * dz + dw * dw) * (1.f / 64.f);
      float rs = rsqrtf(var + 64e-5f);
      float o0 = dx * rs * lnw[0] + lnb[0] + bon * v4.x;
      float o1 = dy * rs * lnw[1] + lnb[1] + bon * v4.y;
      float o2 = dz * rs * lnw[2] + lnb[2] + bon * v4.z;
      float o3 = dw * rs * lnw[3] + lnb[3] + bon * v4.w;
      uint2 o;
      o.x = pack2(o0, o1); o.y = pack2(o2, o3);
      *reinterpret_cast<uint2*>(Z + (size_t)(t0 + st) * ZS + ZRW + 1024 + ch) = o;
    }
  }
}

__device__ void phase_scans(const Params& p, int l, char* smem) {
  for (int t = blockIdx.x; t < 256; t += gridDim.x) {
    int type = t & 3, idx = t >> 2;
#ifndef SCM
#define SCM 15
#endif
    if (type == 0) { if (SCM & 1) rw_scan(p, l, idx, smem); }
    else if (type == 1) { if (SCM & 2) hg_scan(p, l, idx, smem); }
    else if (type == 2) { if (SCM & 4) mb_scan(p, l, idx, smem); }
    else { if (SCM & 8) s5_scan(p, l, idx, smem); }
    __syncthreads();
  }
}

__device__ __forceinline__ void unpack8(const uint4& v, float (&f)[8]) {
  f[0] = bf2f((bf16_t)(v.x & 0xffff)); f[1] = bf2f((bf16_t)(v.x >> 16));
  f[2] = bf2f((bf16_t)(v.y & 0xffff)); f[3] = bf2f((bf16_t)(v.y >> 16));
  f[4] = bf2f((bf16_t)(v.z & 0xffff)); f[5] = bf2f((bf16_t)(v.z >> 16));
  f[6] = bf2f((bf16_t)(v.w & 0xffff)); f[7] = bf2f((bf16_t)(v.w >> 16));
}

__device__ void phase_post(const Params& p, int l, char* smem) {
  bf16_t* Z = (bf16_t*)(p.ws + OFF_Z);
  const int tid = opaque_tid(), lane = tid & 63, wid = tid >> 6;
  constexpr int N_ROWT = T_TOK / 4, N_RWT = T_TOK / 16, N_GLU = 128 * 4, N_NORM = T_TOK / 4;
  const float* xsrc = (l == 0) ? p.in[I_X] : p.out;
  for (int t = blockIdx.x; t < N_ROWT + N_RWT + N_GLU + N_NORM; t += gridDim.x) {
    if (t < N_ROWT) {
      const int row = t * 4 + wid;
      {
        bf16_t* op = Z + (size_t)row * ZS + ZHG + 1024 + lane * 8;
        uint4 ov = *reinterpret_cast<const uint4*>(op);
        uint4 gv = *reinterpret_cast<const uint4*>(op + 512);
        float o[8], g[8];
        unpack8(ov, o); unpack8(gv, g);
        float ss = 0.f;
#pragma unroll
        for (int e = 0; e < 8; ++e) ss += o[e] * o[e];
        ss = sum16(ss);
        float rstd = rsqrtf(ss * (1.f / 128.f) + 1e-6f);
        const float* nw = p.in[I_HG_NW] + l * 512 + lane * 8;
        float r[8];
#pragma unroll
        for (int e = 0; e < 8; ++e) r[e] = o[e] * rstd * nw[e] * siluf_(g[e]);
        *reinterpret_cast<uint4*>(op) = uint4{pack2(r[0], r[1]), pack2(r[2], r[3]), pack2(r[4], r[5]), pack2(r[6], r[7])};
      }
      {
        bf16_t* op = Z + (size_t)row * ZS + ZMB + lane * 8;
        uint4 ov = *reinterpret_cast<const uint4*>(op);
        float o[8];
        unpack8(ov, o);
        float ss = 0.f;
#pragma unroll
        for (int e = 0; e < 8; ++e) ss += o[e] * o[e];
        ss = sum64(ss);
        float rstd = rsqrtf(ss * (1.f / 512.f) + 1e-6f);
        const float* nw = p.in[I_MB_NW] + l * 512 + lane * 8;
        float r[8];
#pragma unroll
        for (int e = 0; e < 8; ++e) r[e] = o[e] * rstd * nw[e];
        *reinterpret_cast<uint4*>(op) = uint4{pack2(r[0], r[1]), pack2(r[2], r[3]), pack2(r[4], r[5]), pack2(r[6], r[7])};
      }
    } else if (t < N_ROWT + N_RWT) {
      const int row0 = (t - N_ROWT) * 16;
      float* sXg = reinterpret_cast<float*>(smem);
      const float* mu = p.in[I_RW_MU] + l * 1792 + 1664;
      for (int e = tid; e < 2048; e += 256) {
        int j = e >> 4, tok = e & 15;
        int row = row0 + tok, s = row & (SEQ - 1);
        sXg[j * 16 + tok] = sigmoidf_(rw_shift(Z, row, s, 1664 + j, mu[j]));
      }
      __syncthreads();
      float a0[16], a1[16];
      lora_mm<128>(sXg, p.in[I_RW_G2] + (size_t)l * 128 * 512, a0, a1, tid);
#pragma unroll
      for (int tok = 0; tok < 16; ++tok) {
        bf16_t* yp = Z + (size_t)(row0 + tok) * ZS + ZRW + 1024 + tid;
        yp[0] = f2bf(bf2f(yp[0]) * a0[tok]);
        yp[256] = f2bf(bf2f(yp[256]) * a1[tok]);
      }
      __syncthreads();
    } else if (t < N_ROWT + N_RWT + N_GLU) {
      const int tt = t - N_ROWT - N_RWT, mt = tt >> 2, nt = tt & 3;
      const int wm = wid >> 1, wn = wid & 1;
      f32x4 acc[4][4];
      zero_acc<128>(acc);
      gemm_mainloop<128>(acc, Z + ZS5, ZS, mt * 128, (const bf16_t*)(p.ws + OFF_WTGLU), 512, nt * 128, 511, 512, smem, tid);
      const float* bg = p.in[I_S5_BGLU] + l * 512;
#pragma unroll
      for (int mi = 0; mi < 4; ++mi)
#pragma unroll
        for (int ni = 0; ni < 4; ++ni) {
          int col = nt * 128 + wn * 64 + ni * 16 + (lane & 15);
          float bgc = bg[col];
#pragma unroll
          for (int j = 0; j < 4; ++j) {
            int row = mt * 128 + wm * 64 + mi * 16 + (lane >> 4) * 4 + j;
            float y = bf2f(Z[(size_t)row * ZS + ZS5 + col]);
            Z[(size_t)row * ZS + ZMB + 1024 + col] = f2bf(y * sigmoidf_(acc[mi][ni][j] + bgc));
          }
        }
    } else {
      const int row = (t - N_ROWT - N_RWT - N_GLU) * 4 + wid;
      rmsnorm_row_to_bf16(xsrc + (size_t)row * DM, p.in[I_NORM_MIX] + l * DM, (bf16_t*)(p.ws + OFF_U) + (size_t)row * DM, tid & 63);
    }
  }
}

__device__ void phase_merge(const Params& p, char* smem) {
  bf16_t* Z = (bf16_t*)(p.ws + OFF_Z);
  const bf16_t* U = (const bf16_t*)(p.ws + OFF_U);
  const bf16_t* Wg = (const bf16_t*)(p.ws + OFF_WTGATE);
  const bf16_t* Wb = (const bf16_t*)(p.ws + OFF_WTBR);
  const int tid = opaque_tid();
  const int lane = tid & 63, wid = tid >> 6, wm = wid >> 1, wn = wid & 1;
  for (int t = blockIdx.x; t < 128 * 16; t += gridDim.x) {
    const int mt = t >> 4, nt = t & 15;
    f32x4 accm[4][2];
    zero_acc<64>(accm);
    for (int kb = 0; kb < 4; ++kb) {
      f32x4 g[4][2], pr[4][2];
      zero_acc<64>(g);
      zero_acc<64>(pr);
      gemm_mainloop<64>(g, U, 1024, mt * 128, Wg + (size_t)kb * 1024 * 1024, 1024, nt * 64, 1023, 1024, smem, tid);
      const int ycol = (kb == 0) ? (ZHG + 1024) : (kb == 1) ? (ZRW + 1024) : (kb == 2) ? (ZMB + 1024) : ZMB;
      gemm_mainloop<64>(pr, Z + ycol, ZS, mt * 128, Wb + (size_t)kb * 1024 * 512, 512, nt * 64, 1023, 512, smem, tid);
#pragma unroll
      for (int mi = 0; mi < 4; ++mi)
#pragma unroll
        for (int ni = 0; ni < 2; ++ni)
#pragma unroll
          for (int j = 0; j < 4; ++j) accm[mi][ni][j] = fmaf(sigmoidf_(g[mi][ni][j]), pr[mi][ni][j], accm[mi][ni][j]);
    }
#pragma unroll
    for (int mi = 0; mi < 4; ++mi)
#pragma unroll
      for (int ni = 0; ni < 2; ++ni) {
        int col = nt * 64 + wn * 32 + ni * 16 + (lane & 15);
#pragma unroll
        for (int j = 0; j < 4; ++j) {
          int row = mt * 128 + wm * 64 + mi * 16 + (lane >> 4) * 4 + j;
          Z[(size_t)row * ZS + col] = f2bf(accm[mi][ni][j]);
        }
      }
  }
}

__device__ void phase_resid_gemm(const Params& p, const bf16_t* A, int lda, const bf16_t* Wt, int K, const float* xold, char* smem) {
  const int tid = opaque_tid();
  const int lane = tid & 63, wid = tid >> 6, wm = wid >> 1, wn = wid & 1;
  for (int t = blockIdx.x; t < 128 * 8; t += gridDim.x) {
    const int mt = t >> 3, nt = t & 7;
    f32x4 acc[4][4];
    zero_acc<128>(acc);
    gemm_mainloop<128>(acc, A, lda, mt * 128, Wt, K, nt * 128, 1023, K, smem, tid);
#pragma unroll
    for (int mi = 0; mi < 4; ++mi)
#pragma unroll
      for (int ni = 0; ni < 4; ++ni) {
        int col = nt * 128 + wn * 64 + ni * 16 + (lane & 15);
#pragma unroll
        for (int j = 0; j < 4; ++j) {
          int row = mt * 128 + wm * 64 + mi * 16 + (lane >> 4) * 4 + j;
          size_t o = (size_t)row * DM + col;
          p.out[o] = xold[o] + acc[mi][ni][j];
        }
      }
  }
}

__device__ void phase_ffn_in(const Params& p, char* smem) {
  const bf16_t* U = (const bf16_t*)(p.ws + OFF_U);
  const bf16_t* Wt = (const bf16_t*)(p.ws + OFF_WTF1);
  bf16_t* H = (bf16_t*)(p.ws + OFF_Z);
  const int tid = opaque_tid();
  const int lane = tid & 63, wid = tid >> 6, wm = wid >> 1, wn = wid & 1;
  for (int t = blockIdx.x; t < 128 * 44; t += gridDim.x) {
    const int mt = t / 44, nt = t % 44;
    f32x4 acc[4][4];
    zero_acc<128>(acc);
    gemm_mainloop<128>(acc, U, 1024, mt * 128, Wt, 1024, nt * 128, 5631, 1024, smem, tid);
#pragma unroll
    for (int mi = 0; mi < 4; ++mi)
#pragma unroll
      for (int q = 0; q < 2; ++q) {
        int hcol = ((nt * 128 + wn * 64 + q * 32) >> 1) + (lane & 15);
#pragma unroll
        for (int j = 0; j < 4; ++j) {
          int row = mt * 128 + wm * 64 + mi * 16 + (lane >> 4) * 4 + j;
          H[(size_t)row * FFH + hcol] = f2bf(siluf_(acc[mi][2 * q][j]) * acc[mi][2 * q + 1][j]);
        }
      }
  }
}

__device__ void phase_final(const Params& p) {
  const int tid = opaque_tid();
  const int lane = tid & 63;
  const float* w = p.in[I_NORM_FINAL];
  for (int t = blockIdx.x; t < T_TOK / 4; t += gridDim.x) {
    int row = t * 4 + (tid >> 6);
    float* x = p.out + (size_t)row * DM;
    float4 v[4];
    float ss = 0.f;
#pragma unroll
    for (int i = 0; i < 4; ++i) {
      v[i] = *reinterpret_cast<const float4*>(x + i * 256 + lane * 4);
      ss += v[i].x * v[i].x + v[i].y * v[i].y + v[i].z * v[i].z + v[i].w * v[i].w;
    }
    ss = sum64(ss);
    float rstd = rsqrtf(ss * (1.f / 1024.f) + 1e-6f);
#pragma unroll
    for (int i = 0; i < 4; ++i) {
      float4 ww = *reinterpret_cast<const float4*>(w + i * 256 + lane * 4);
      float4 o = float4{v[i].x * rstd * ww.x, v[i].y * rstd * ww.y, v[i].z * rstd * ww.z, v[i].w * rstd * ww.w};
      *reinterpret_cast<float4*>(x + i * 256 + lane * 4) = o;
    }
  }
}

template <int SUB>
__device__ __forceinline__ void run_phase(const Params& p, int l, char* smem) {
  if (SUB == 0) phase_convert_norm(p, l, smem);
  else if (SUB == 1) phase_inproj(p, smem);
  else if (SUB == 2) phase_rwprep(p, l, smem);
  else if (SUB == 3) phase_scans(p, l, smem);
  else if (SUB == 4) phase_post(p, l, smem);
  else if (SUB == 5) phase_merge(p, smem);
  else if (SUB == 6) phase_resid_gemm(p, (const bf16_t*)(p.ws + OFF_Z), ZS, (const bf16_t*)(p.ws + OFF_WTOUT), 1024,
                                      (l == 0) ? p.in[I_X] : p.out, smem);
  else if (SUB == 7) phase_norm_only(p, p.out, p.in[I_NORM_FFN] + l * DM);
  else if (SUB == 8) phase_ffn_in(p, smem);
  else if (SUB == 9) phase_resid_gemm(p, (const bf16_t*)(p.ws + OFF_Z), FFH, (const bf16_t*)(p.ws + OFF_WTF2), FFH, p.out, smem);
  else phase_final(p);
}

#ifndef PHM
#define PHM 0xFFFF
#endif
#if COOP
__global__ void __launch_bounds__(256, 2) fwd_kernel(Params p, int ph0, int ph1) {
  __shared__ __attribute__((aligned(16))) char smem[65536];
  cg::grid_group grid = cg::this_grid();
  for (int ph = ph0; ph < ph1; ++ph) {
    if (ph == NPHASES - 1) {
      phase_final(p);
    } else {
      const int l = ph / NPH_LAYER, sub = ph % NPH_LAYER;
      switch (sub) {
        case 0: if (PHM & (1<<0)) run_phase<0>(p, l, smem); break;
        case 1: if (PHM & (1<<1)) run_phase<1>(p, l, smem); break;
        case 2: if (PHM & (1<<2)) run_phase<2>(p, l, smem); break;
        case 3: if (PHM & (1<<3)) run_phase<3>(p, l, smem); break;
        case 4: if (PHM & (1<<4)) run_phase<4>(p, l, smem); break;
        case 5: if (PHM & (1<<5)) run_phase<5>(p, l, smem); break;
        case 6: if (PHM & (1<<6)) run_phase<6>(p, l, smem); break;
        case 7: if (PHM & (1<<7)) run_phase<7>(p, l, smem); break;
        case 8: if (PHM & (1<<8)) run_phase<8>(p, l, smem); break;
        case 9: if (PHM & (1<<9)) run_phase<9>(p, l, smem); break;
      }
    }
    if (ph + 1 < ph1) grid.sync();
  }
}
#else
template <int SUB>
__global__ void __launch_bounds__(256, 2) k_phase(Params p, int l) {
  __shared__ __attribute__((aligned(16))) char smem[65536];
  run_phase<SUB>(p, l, smem);
}
#endif

extern "C" void kernel_launch(void* const* d_in, const int* in_sizes, int n_in, void* d_out, int out_size, void* d_ws,
                              size_t ws_size, hipStream_t stream) {
  if (n_in < 41 || ws_size < WS_NEED) {
    fprintf(stderr, "kernel_launch: bad args n_in=%d ws=%zu need=%zu\n", n_in, ws_size, (size_t)WS_NEED);
    return;
  }
  Params p{};
  for (int i = 0; i < 41; ++i) p.in[i] = (const float*)d_in[i];
  p.out = (float*)d_out;
  p.ws = (char*)d_ws;
#if COOP
  static int grid_blocks = 0;
  if (!grid_blocks) {
    int dev = 0, cus = 0, per_cu = 0;
    hipGetDevice(&dev);
    hipDeviceGetAttribute(&cus, hipDeviceAttributeMultiprocessorCount, dev);
    hipOccupancyMaxActiveBlocksPerMultiprocessor(&per_cu, fwd_kernel, 256, 0);
    if (per_cu > 2) per_cu = 2;
    grid_blocks = cus * per_cu;
  }
  int ph0 = 0, ph1 = NPHASES;
  void* args[] = {&p, &ph0, &ph1};
  hipError_t e = hipLaunchCooperativeKernel((void*)fwd_kernel, dim3(grid_blocks), dim3(256), args, 0, stream);
  if (e != hipSuccess) fprintf(stderr, "cooperative launch failed: %s (grid %d)\n", hipGetErrorString(e), grid_blocks);
#else
  const dim3 g(512), b(256);
  for (int l = 0; l < 2; ++l) {
    k_phase<0><<<g, b, 0, stream>>>(p, l);
    k_phase<1><<<g, b, 0, stream>>>(p, l);
    k_phase<2><<<g, b, 0, stream>>>(p, l);
    k_phase<3><<<g, b, 0, stream>>>(p, l);
    k_phase<4><<<g, b, 0, stream>>>(p, l);
    k_phase<5><<<g, b, 0, stream>>>(p, l);
    k_phase<6><<<g, b, 0, stream>>>(p, l);
    k_phase<7><<<g, b, 0, stream>>>(p, l);
    k_phase<8><<<g, b, 0, stream>>>(p, l);
    k_phase<9><<<g, b, 0, stream>>>(p, l);
  }
  k_phase<10><<<g, b, 0, stream>>>(p, 0);
#endif
}
```

```cpp
#include <hip/hip_runtime.h>
#include <hip/hip_cooperative_groups.h>
#include <cstdio>
#include <cstdint>
namespace cg = cooperative_groups;

#ifndef COOP
#define COOP 1
#endif

typedef unsigned short bf16_t;
typedef __attribute__((ext_vector_type(8))) short bf16x8;
typedef __attribute__((ext_vector_type(4))) float f32x4;
typedef __attribute__((ext_vector_type(4))) unsigned u32x4;

constexpr int T_TOK = 16384, SEQ = 2048, DM = 1024;
constexpr int IN_COLS = 9992, NZ = 5896, ZS = 5904;
constexpr int ZHG = 0, ZRW = 2048, ZS5 = 3840, ZMB = 4352;
constexpr int FFH = 2816;
constexpr int NPH_LAYER = 10, NPHASES = 21;

constexpr size_t OFF_WTIN   = 0;
constexpr size_t OFF_WTGATE = OFF_WTIN + (size_t)5896 * 1024 * 2;
constexpr size_t OFF_WTBR   = OFF_WTGATE + (size_t)4096 * 1024 * 2;
constexpr size_t OFF_WTOUT  = OFF_WTBR + (size_t)4 * 1024 * 512 * 2;
constexpr size_t OFF_WTF1   = OFF_WTOUT + (size_t)1024 * 1024 * 2;
constexpr size_t OFF_WTF2   = OFF_WTF1 + (size_t)5632 * 1024 * 2;
constexpr size_t OFF_WTGLU  = OFF_WTF2 + (size_t)1024 * 2816 * 2;
constexpr size_t OFF_U      = OFF_WTGLU + (size_t)512 * 512 * 2;
constexpr size_t OFF_Z      = OFF_U + (size_t)T_TOK * 1024 * 2;
constexpr size_t OFF_VF     = OFF_Z + (size_t)T_TOK * ZS * 2;
constexpr size_t WS_NEED    = OFF_VF + (size_t)T_TOK * 512 * 2;

struct Params {
  const float* in[41];
  float* out;
  char* ws;
};

enum { I_X = 0, I_NORM_MIX, I_W_IN, I_W_BRANCH, I_W_OUT, I_NORM_FFN, I_W_FFN_IN, I_W_FFN_OUT, I_NORM_FINAL,
       I_HG_LB, I_HG_NW, I_RW_MU, I_RW_W0, I_RW_W2, I_RW_A0, I_RW_A2, I_RW_G2, I_RW_KK, I_RW_KA, I_RW_RK,
       I_RW_LNW, I_RW_LNB, I_RW_V0, I_RW_V1, I_RW_V2, I_S5_ARE, I_S5_AIM, I_S5_BRE, I_S5_BIM, I_S5_CRE,
       I_S5_CIM, I_S5_D, I_S5_LOGDT, I_S5_WGLU, I_S5_BGLU, I_MB_CONVW, I_MB_CONVB, I_MB_DTB, I_MB_ALOG,
       I_MB_D, I_MB_NW };

__device__ __forceinline__ float bf2f(bf16_t v) { return __uint_as_float(((unsigned)v) << 16); }
__device__ __forceinline__ bf16_t f2bf(float f) {
  unsigned u = __float_as_uint(f);
  u += 0x7fffu + ((u >> 16) & 1u);
  return (bf16_t)(u >> 16);
}
__device__ __forceinline__ unsigned pack2(float a, float b) { return (unsigned)f2bf(a) | ((unsigned)f2bf(b) << 16); }
__device__ __forceinline__ float sigmoidf_(float x) { return 1.f / (1.f + __expf(-x)); }
__device__ __forceinline__ float siluf_(float x) { return x / (1.f + __expf(-x)); }
__device__ __forceinline__ float softplusf_(float x) { return x > 20.f ? x : log1pf(__expf(x)); }
__device__ __forceinline__ float gelu_tanh(float x) {
  float u = 0.7978845608028654f * (x + 0.044715f * x * x * x);
  return 0.5f * x * (1.f + tanhf(u));
}
__device__ __forceinline__ float quad_sum(float x) {
  x += __builtin_bit_cast(float, __builtin_amdgcn_update_dpp(0, __builtin_bit_cast(int, x), 0xB1, 0xF, 0xF, true));
  x += __builtin_bit_cast(float, __builtin_amdgcn_update_dpp(0, __builtin_bit_cast(int, x), 0x4E, 0xF, 0xF, true));
  return x;
}
__device__ __forceinline__ float sum16(float x) {
  x += __shfl_xor(x, 1); x += __shfl_xor(x, 2); x += __shfl_xor(x, 4); x += __shfl_xor(x, 8);
  return x;
}
__device__ __forceinline__ float sum64(float x) {
  x = sum16(x); x += __shfl_xor(x, 16); x += __shfl_xor(x, 32);
  return x;
}

__device__ __forceinline__ int opaque_tid() {
  int t = threadIdx.x;
  asm volatile("" : "+v"(t));
  return t;
}

template <int BN>
__device__ __forceinline__ void gemm_mainloop(f32x4 (&acc)[4][BN / 32], const bf16_t* A, int lda, int m0,
                                              const bf16_t* Bt, int ldb, int n0, int nmax, int K, char* smem, const int tid) {
  const int lane = tid & 63, wid = tid >> 6, wm = wid >> 1, wn = wid & 1;
  const int q = tid & 7, r0 = tid >> 3;
  unsigned offA[4], offB[BN / 32];
#pragma unroll
  for (int i = 0; i < 4; ++i) offA[i] = ((unsigned)(m0 + r0 + 32 * i) * (unsigned)lda + (unsigned)q * 8u) * 2u;
#pragma unroll
  for (int i = 0; i < BN / 32; ++i) {
    int row = n0 + r0 + 32 * i;
    row = row < nmax ? row : nmax;
    offB[i] = ((unsigned)row * (unsigned)ldb + (unsigned)q * 8u) * 2u;
  }
  const unsigned sto = (unsigned)r0 * 128u + (unsigned)((q ^ ((r0 >> 1) & 7)) << 4);
  unsigned aoff[4], boff[BN / 32];
#pragma unroll
  for (int mi = 0; mi < 4; ++mi) {
    int row = wm * 64 + mi * 16 + (lane & 15);
    aoff[mi] = (unsigned)row * 128u + (unsigned)(((lane >> 4) ^ ((row >> 1) & 7)) << 4);
  }
#pragma unroll
  for (int ni = 0; ni < BN / 32; ++ni) {
    int row = wn * (BN / 2) + ni * 16 + (lane & 15);
    boff[ni] = (unsigned)row * 128u + (unsigned)(((lane >> 4) ^ ((row >> 1) & 7)) << 4);
  }
  const char* Ab = reinterpret_cast<const char*>(A);
  const char* Bb = reinterpret_cast<const char*>(Bt);
  const int nk = K >> 6;
  constexpr bool WIDE = (BN == 128);
  u32x4 ra0, ra1, ra2, ra3, rb0, rb1, rb2, rb3;
#define GLOAD_ALL()                                                        \
  ra0 = *reinterpret_cast<const u32x4*>(Ab + offA[0]);                     \
  ra1 = *reinterpret_cast<const u32x4*>(Ab + offA[1]);                     \
  ra2 = *reinterpret_cast<const u32x4*>(Ab + offA[2]);                     \
  ra3 = *reinterpret_cast<const u32x4*>(Ab + offA[3]);                     \
  rb0 = *reinterpret_cast<const u32x4*>(Bb + offB[0]);                     \
  rb1 = *reinterpret_cast<const u32x4*>(Bb + offB[1]);                     \
  if (WIDE) {                                                              \
    rb2 = *reinterpret_cast<const u32x4*>(Bb + offB[BN / 32 - 2]);         \
    rb3 = *reinterpret_cast<const u32x4*>(Bb + offB[BN / 32 - 1]);         \
  }
#define SSTORE_ALL(AD, BD)                                                 \
  *reinterpret_cast<u32x4*>((AD)) = ra0;                                   \
  *reinterpret_cast<u32x4*>((AD) + 4096) = ra1;                            \
  *reinterpret_cast<u32x4*>((AD) + 8192) = ra2;                            \
  *reinterpret_cast<u32x4*>((AD) + 12288) = ra3;                           \
  *reinterpret_cast<u32x4*>((BD)) = rb0;                                   \
  *reinterpret_cast<u32x4*>((BD) + 4096) = rb1;                            \
  if (WIDE) {                                                              \
    *reinterpret_cast<u32x4*>((BD) + 8192) = rb2;                          \
    *reinterpret_cast<u32x4*>((BD) + 12288) = rb3;                         \
  }
  GLOAD_ALL();
  SSTORE_ALL(smem + sto, smem + 32768 + sto);
  __syncthreads();
#pragma unroll 1
  for (int kt = 0; kt < nk; ++kt) {
    const int buf = kt & 1;
    const bool more = (kt + 1 < nk);
    if (more) {
      Ab += 128; Bb += 128;
      GLOAD_ALL();
    }
    __builtin_amdgcn_sched_barrier(0);
    const char* a_s = smem + buf * 16384;
    const char* b_s = smem + 32768 + buf * (BN * 128);
#pragma unroll
    for (int ks = 0; ks < 2; ++ks) {
      bf16x8 af[4], bfr[BN / 32];
#pragma unroll
      for (int mi = 0; mi < 4; ++mi) af[mi] = *reinterpret_cast<const bf16x8*>(a_s + (aoff[mi] ^ (ks * 64)));
#pragma unroll
      for (int ni = 0; ni < BN / 32; ++ni) bfr[ni] = *reinterpret_cast<const bf16x8*>(b_s + (boff[ni] ^ (ks * 64)));
#pragma unroll
      for (int mi = 0; mi < 4; ++mi)
#pragma unroll
        for (int ni = 0; ni < BN / 32; ++ni)
          acc[mi][ni] = __builtin_amdgcn_mfma_f32_16x16x32_bf16(bfr[ni], af[mi], acc[mi][ni], 0, 0, 0);
    }
    __builtin_amdgcn_sched_barrier(0);
    if (more) {
      char* a_d = smem + (buf ^ 1) * 16384 + sto;
      char* b_d = smem + 32768 + (buf ^ 1) * (BN * 128) + sto;
      SSTORE_ALL(a_d, b_d);
    }
    __syncthreads();
  }
#undef GLOAD_ALL
#undef SSTORE_ALL
}

template <int BN>
__device__ __forceinline__ void zero_acc(f32x4 (&acc)[4][BN / 32]) {
#pragma unroll
  for (int mi = 0; mi < 4; ++mi)
#pragma unroll
    for (int ni = 0; ni < BN / 32; ++ni) acc[mi][ni] = f32x4{0.f, 0.f, 0.f, 0.f};
}

__device__ __forceinline__ void conv_tile(const float* src, int ld, int nlimit, int k0, int n0, bf16_t* dst, int Kd, int mode,
                                          char* smem, const int tid) {
  float* sT = reinterpret_cast<float*>(smem);
#pragma unroll
  for (int i = 0; i < 16; ++i) {
    int kk = i * 4 + (tid >> 6), nn = tid & 63;
    float v = (n0 + nn < nlimit) ? src[(size_t)(k0 + kk) * ld + n0 + nn] : 0.f;
    sT[kk * 65 + nn] = v;
  }
  __syncthreads();
  {
    int nn = tid >> 2, kq = tid & 3;
    int n = n0 + nn;
    if (n < nlimit) {
      int drow = n;
      if (mode == 1) {
        if (n < FFH) drow = (n >> 4) * 32 + (n & 15);
        else { int j = n - FFH; drow = (j >> 4) * 32 + 16 + (j & 15); }
      }
      unsigned pk[8];
#pragma unroll
      for (int j = 0; j < 8; ++j) pk[j] = pack2(sT[(kq * 16 + 2 * j) * 65 + nn], sT[(kq * 16 + 2 * j + 1) * 65 + nn]);
      uint4* d = reinterpret_cast<uint4*>(dst + (size_t)drow * Kd + k0 + kq * 16);
      d[0] = uint4{pk[0], pk[1], pk[2], pk[3]};
      d[1] = uint4{pk[4], pk[5], pk[6], pk[7]};
    }
  }
  __syncthreads();
}

__device__ __forceinline__ void rmsnorm_row_to_bf16(const float* x, const float* w, bf16_t* out, const int lane) {
  float4 v[4];
  float ss = 0.f;
#pragma unroll
  for (int i = 0; i < 4; ++i) {
    v[i] = *reinterpret_cast<const float4*>(x + i * 256 + lane * 4);
    ss += v[i].x * v[i].x + v[i].y * v[i].y + v[i].z * v[i].z + v[i].w * v[i].w;
  }
  ss = sum64(ss);
  float rstd = rsqrtf(ss * (1.f / 1024.f) + 1e-6f);
#pragma unroll
  for (int i = 0; i < 4; ++i) {
    float4 ww = *reinterpret_cast<const float4*>(w + i * 256 + lane * 4);
    uint2 o;
    o.x = pack2(v[i].x * rstd * ww.x, v[i].y * rstd * ww.y);
    o.y = pack2(v[i].z * rstd * ww.z, v[i].w * rstd * ww.w);
    *reinterpret_cast<uint2*>(out + i * 256 + lane * 4) = o;
  }
}

constexpr int CT_IN = 157 * 16, CT_BR = 512, CT_OUT = 256, CT_F1 = 88 * 16, CT_F2 = 44 * 16, CT_GLU = 64;
constexpr int CT_TOTAL = CT_IN + CT_BR + CT_OUT + CT_F1 + CT_F2 + CT_GLU;

__device__ void phase_convert_norm(const Params& p, int l, char* smem) {
  const int tid = opaque_tid();
  char* ws = p.ws;
  const int ntask = CT_TOTAL + T_TOK / 4;
  const float* xsrc = (l == 0) ? p.in[I_X] : p.out;
  for (int t = blockIdx.x; t < ntask; t += gridDim.x) {
    if (t < CT_TOTAL) {
      int c = t;
      if (c < CT_IN) {
        int nt = c >> 4, kt = c & 15;
        const float* src = p.in[I_W_IN] + (size_t)l * 1024 * IN_COLS;
        if (nt < 64) conv_tile(src, IN_COLS, IN_COLS, kt * 64, nt * 64, (bf16_t*)(ws + OFF_WTGATE), 1024, 0, smem, tid);
        else conv_tile(src + 4096, IN_COLS, IN_COLS - 4096, kt * 64, (nt - 64) * 64, (bf16_t*)(ws + OFF_WTIN), 1024, 0, smem, tid);
        continue;
      }
      c -= CT_IN;
      if (c < CT_BR) {
        int kb = c >> 7, r = c & 127, nt = r >> 3, kt = r & 7;
        const float* src = p.in[I_W_BRANCH] + ((size_t)l * 4 + kb) * 512 * 1024;
        conv_tile(src, 1024, 1024, kt * 64, nt * 64, (bf16_t*)(ws + OFF_WTBR) + (size_t)kb * 1024 * 512, 512, 0, smem, tid);
        continue;
      }
      c -= CT_BR;
      if (c < CT_OUT) {
        int nt = c >> 4, kt = c & 15;
        conv_tile(p.in[I_W_OUT] + (size_t)l * 1024 * 1024, 1024, 1024, kt * 64, nt * 64, (bf16_t*)(ws + OFF_WTOUT), 1024, 0, smem, tid);
        continue;
      }
      c -= CT_OUT;
      if (c < CT_F1) {
        int nt = c >> 4, kt = c & 15;
        conv_tile(p.in[I_W_FFN_IN] + (size_t)l * 1024 * 5632, 5632, 5632, kt * 64, nt * 64, (bf16_t*)(ws + OFF_WTF1), 1024, 1, smem, tid);
        continue;
      }
      c -= CT_F1;
      if (c < CT_F2) {
        int nt = c / 44, kt = c % 44;
        conv_tile(p.in[I_W_FFN_OUT] + (size_t)l * FFH * 1024, 1024, 1024, kt * 64, nt * 64, (bf16_t*)(ws + OFF_WTF2), FFH, 0, smem, tid);
        continue;
      }
      c -= CT_F2;
      {
        int nt = c >> 3, kt = c & 7;
        conv_tile(p.in[I_S5_WGLU] + (size_t)l * 512 * 512, 512, 512, kt * 64, nt * 64, (bf16_t*)(ws + OFF_WTGLU), 512, 0, smem, tid);
      }
    } else {
      int row = (t - CT_TOTAL) * 4 + (tid >> 6);
      rmsnorm_row_to_bf16(xsrc + (size_t)row * DM, p.in[I_NORM_MIX] + l * DM, (bf16_t*)(ws + OFF_U) + (size_t)row * DM, tid & 63);
    }
  }
}

__device__ void phase_norm_only(const Params& p, const float* xsrc, const float* w) {
  const int tid = opaque_tid();
  for (int t = blockIdx.x; t < T_TOK / 4; t += gridDim.x) {
    int row = t * 4 + (tid >> 6);
    rmsnorm_row_to_bf16(xsrc + (size_t)row * DM, w, (bf16_t*)(p.ws + OFF_U) + (size_t)row * DM, tid & 63);
  }
}

__device__ void phase_inproj(const Params& p, char* smem) {
  const bf16_t* U = (const bf16_t*)(p.ws + OFF_U);
  const bf16_t* Wt = (const bf16_t*)(p.ws + OFF_WTIN);
  bf16_t* Z = (bf16_t*)(p.ws + OFF_Z);
  const int tid = opaque_tid();
  const int lane = tid & 63, wid = tid >> 6, wm = wid >> 1, wn = wid & 1;
  constexpr int NT = 47;
  for (int t = blockIdx.x; t < 128 * NT; t += gridDim.x) {
    int mt = t / NT, nt = t % NT;
    f32x4 acc[4][4];
    zero_acc<128>(acc);
    gemm_mainloop<128>(acc, U, 1024, mt * 128, Wt, 1024, nt * 128, NZ - 1, 1024, smem, tid);
#pragma unroll
    for (int mi = 0; mi < 4; ++mi)
#pragma unroll
      for (int ni = 0; ni < 4; ++ni) {
        int col = nt * 128 + wn * 64 + ni * 16 + (lane >> 4) * 4;
        int row = mt * 128 + wm * 64 + mi * 16 + (lane & 15);
        if (col < NZ) {
          uint2 o;
          o.x = pack2(acc[mi][ni][0], acc[mi][ni][1]);
          o.y = pack2(acc[mi][ni][2], acc[mi][ni][3]);
          *reinterpret_cast<uint2*>(Z + (size_t)row * ZS + col) = o;
        }
      }
  }
}

template <int J>
__device__ __forceinline__ void lora_mm(const float* sIn, const float* W, float (&a0)[16], float (&a1)[16], const int tid) {
#pragma unroll
  for (int i = 0; i < 16; ++i) { a0[i] = 0.f; a1[i] = 0.f; }
#pragma unroll 2
  for (int j = 0; j < J; ++j) {
    float w0 = W[j * 512 + tid], w1 = W[j * 512 + tid + 256];
    const float4* x4 = reinterpret_cast<const float4*>(sIn + j * 16);
#pragma unroll
    for (int q = 0; q < 4; ++q) {
      float4 x = x4[q];
      a0[q * 4 + 0] = fmaf(w0, x.x, a0[q * 4 + 0]); a1[q * 4 + 0] = fmaf(w1, x.x, a1[q * 4 + 0]);
      a0[q * 4 + 1] = fmaf(w0, x.y, a0[q * 4 + 1]); a1[q * 4 + 1] = fmaf(w1, x.y, a1[q * 4 + 1]);
      a0[q * 4 + 2] = fmaf(w0, x.z, a0[q * 4 + 2]); a1[q * 4 + 2] = fmaf(w1, x.z, a1[q * 4 + 2]);
      a0[q * 4 + 3] = fmaf(w0, x.w, a0[q * 4 + 3]); a1[q * 4 + 3] = fmaf(w1, x.w, a1[q * 4 + 3]);
    }
  }
}

__device__ __forceinline__ float rw_shift(const bf16_t* Z, int row, int s, int rc, float mu) {
  float cur = bf2f(Z[(size_t)row * ZS + ZRW + rc]);
  float prev = (s > 0) ? bf2f(Z[(size_t)(row - 1) * ZS + ZRW + rc]) : 0.f;
  return cur + (prev - cur) * mu;
}

__device__ void phase_rwprep(const Params& p, int l, char* smem) {
  const bf16_t* Z = (const bf16_t*)(p.ws + OFF_Z);
  bf16_t* LW = (bf16_t*)(p.ws + OFF_U);
  bf16_t* LA = LW + (size_t)T_TOK * 512;
  bf16_t* VF = (bf16_t*)(p.ws + OFF_VF);
  float* sXw = reinterpret_cast<float*>(smem);
  float* sXa = sXw + 64 * 16;
  float* sTmp = sXa + 64 * 16;
  float* sZv = sTmp + 32 * 16;
  const float* mu = p.in[I_RW_MU] + l * 1792;
  const int tid = opaque_tid();
  for (int t = blockIdx.x; t < T_TOK / 16; t += gridDim.x) {
    const int row0 = t * 16;
    for (int e = tid; e < 2048; e += 256) {
      int which = e >> 10, r = e & 1023, j = r >> 4, tok = r & 15;
      int row = row0 + tok, s = row & (SEQ - 1);
      int rc = 1536 + which * 64 + j;
      float z = rw_shift(Z, row, s, rc, mu[rc]);
      if (which == 0) sXw[j * 16 + tok] = tanhf(z); else sXa[j * 16 + tok] = z;
    }
    float zv0[16], zv1[16];
    {
      float m0 = mu[1024 + tid], m1 = mu[1024 + tid + 256];
#pragma unroll
      for (int tok = 0; tok < 16; ++tok) {
        int row = row0 + tok, s = row & (SEQ - 1);
        zv0[tok] = rw_shift(Z, row, s, 1024 + tid, m0);
        zv1[tok] = rw_shift(Z, row, s, 1024 + tid + 256, m1);
      }
    }
    if (l > 0) {
#pragma unroll
      for (int tok = 0; tok < 16; ++tok) { sZv[tid * 16 + tok] = zv0[tok]; sZv[(tid + 256) * 16 + tok] = zv1[tok]; }
    }
    __syncthreads();
    float a0[16], a1[16];
    lora_mm<64>(sXw, p.in[I_RW_W2] + (size_t)l * 64 * 512, a0, a1, tid);
#pragma unroll
    for (int tok = 0; tok < 16; ++tok) {
      LW[(size_t)(row0 + tok) * 512 + tid] = f2bf(a0[tok]);
      LW[(size_t)(row0 + tok) * 512 + tid + 256] = f2bf(a1[tok]);
    }
    lora_mm<64>(sXa, p.in[I_RW_A2] + (size_t)l * 64 * 512, a0, a1, tid);
#pragma unroll
    for (int tok = 0; tok < 16; ++tok) {
      LA[(size_t)(row0 + tok) * 512 + tid] = f2bf(a0[tok]);
      LA[(size_t)(row0 + tok) * 512 + tid + 256] = f2bf(a1[tok]);
    }
    if (l == 0) {
#pragma unroll
      for (int tok = 0; tok < 16; ++tok) {
        VF[(size_t)(row0 + tok) * 512 + tid] = f2bf(zv0[tok]);
        VF[(size_t)(row0 + tok) * 512 + tid + 256] = f2bf(zv1[tok]);
      }
    } else {
      const float* v1 = p.in[I_RW_V1] + (size_t)(l - 1) * 512 * 32;
      const float* v2 = p.in[I_RW_V2] + (size_t)(l - 1) * 32 * 512;
      const float* v0 = p.in[I_RW_V0] + (size_t)(l - 1) * 512;
      {
        int r = tid & 31, tg = tid >> 5;
        float t0 = 0.f, t1 = 0.f;
#pragma unroll 4
        for (int c = 0; c < 512; ++c) {
          float w = v1[c * 32 + r];
          float2 x = *reinterpret_cast<const float2*>(sZv + c * 16 + tg * 2);
          t0 = fmaf(w, x.x, t0); t1 = fmaf(w, x.y, t1);
        }
        sTmp[r * 16 + tg * 2] = t0; sTmp[r * 16 + tg * 2 + 1] = t1;
      }
      __syncthreads();
      lora_mm<32>(sTmp, v2, a0, a1, tid);
      float b0 = v0[tid], b1 = v0[tid + 256];
#pragma unroll
      for (int tok = 0; tok < 16; ++tok) {
        size_t i0 = (size_t)(row0 + tok) * 512 + tid;
        float vf0 = bf2f(VF[i0]), vf1 = bf2f(VF[i0 + 256]);
        VF[i0] = f2bf(zv0[tok] + (vf0 - zv0[tok]) * sigmoidf_(b0 + a0[tok]));
        VF[i0 + 256] = f2bf(zv1[tok] + (vf1 - zv1[tok]) * sigmoidf_(b1 + a1[tok]));
      }
    }
    __syncthreads();
  }
}

__device__ __forceinline__ float frcp(float x) { return __builtin_amdgcn_rcpf(x); }
__device__ __forceinline__ float fsigmoid(float x) { return frcp(1.f + __expf(-x)); }
__device__ __forceinline__ float fsilu(float x) { return x * frcp(1.f + __expf(-x)); }
__device__ __forceinline__ float fsoftplus(float x) { return x > 20.f ? x : __logf(1.f + __expf(x)); }
__device__ __forceinline__ float ftanh(float x) {
  float e = __expf(2.f * fminf(fmaxf(x, -15.f), 15.f));
  return (e - 1.f) * frcp(e + 1.f);
}
__device__ __forceinline__ float fgelu(float x) {
  float u = 0.7978845608028654f * (x + 0.044715f * x * x * x);
  return 0.5f * x * (1.f + ftanh(u));
}

__device__ void hg_scan(const Params& p, int l, int task, char* smem) {
  const int b = task >> 3, h = (task >> 1) & 3, vg = task & 1;
  float* sFg = reinterpret_cast<float*>(smem);
  float* sQs = sFg + 16 * 128;
  float* sO = sQs + 16 * 128;
  float* sVv = sO + 4 * 16 * 64;
  const int tid = opaque_tid(), w = tid >> 6, lane = tid & 63;
  bf16_t* Z = (bf16_t*)(p.ws + OFF_Z) + (size_t)b * SEQ * ZS;
  const int ks = tid & 127;
  float lb = 0.f;
  if (l > 0) {
    float x0 = p.in[I_HG_LB][h * 128 + ks], x1 = p.in[I_HG_LB][512 + h * 128 + ks];
    float m = fmaxf(x0, x1), e0 = expf(x0 - m), e1 = expf(x1 - m);
    lb = e1 / (e0 + e1);
  }
  float s[32];
#pragma unroll
  for (int j = 0; j < 32; ++j) s[j] = 0.f;
  const int vcol = ZHG + 1024 + h * 128 + vg * 64;
  const int qcol = ZHG + h * 128 + ks;
  bf16_t rq0, rq1, rq2, rq3, rq4, rq5, rq6, rq7, rf0, rf1, rf2, rf3, rf4, rf5, rf6, rf7, rv0, rv1, rv2, rv3;
#define HG_LOAD(T0)                                                                                \
  {                                                                                                \
    const bf16_t* zb = Z + (size_t)((T0) + (tid >> 7)) * ZS + qcol;                                \
    rq0 = zb[0]; rf0 = zb[512]; zb += 2 * ZS; rq1 = zb[0]; rf1 = zb[512]; zb += 2 * ZS;            \
    rq2 = zb[0]; rf2 = zb[512]; zb += 2 * ZS; rq3 = zb[0]; rf3 = zb[512]; zb += 2 * ZS;            \
    rq4 = zb[0]; rf4 = zb[512]; zb += 2 * ZS; rq5 = zb[0]; rf5 = zb[512]; zb += 2 * ZS;            \
    rq6 = zb[0]; rf6 = zb[512]; zb += 2 * ZS; rq7 = zb[0]; rf7 = zb[512];                          \
    const bf16_t* zv = Z + (size_t)((T0) + w) * ZS + vcol + lane;                                  \
    rv0 = zv[0]; rv1 = zv[4 * ZS]; rv2 = zv[8 * ZS]; rv3 = zv[12 * ZS];                            \
  }
#define HG_PUT1(I, RQ, RF)                                                                         \
  {                                                                                                \
    int t = (tid >> 7) + 2 * (I);                                                                  \
    sFg[t * 128 + ks] = fmaxf(lb + (1.f - lb) * fsigmoid(bf2f(RF)), 1e-30f);                       \
    sQs[t * 128 + ks] = fsilu(bf2f(RQ));                                                           \
  }
#define HG_PROCESS()                                                                               \
  {                                                                                                \
    HG_PUT1(0, rq0, rf0) HG_PUT1(1, rq1, rf1) HG_PUT1(2, rq2, rf2) HG_PUT1(3, rq3, rf3)            \
    HG_PUT1(4, rq4, rf4) HG_PUT1(5, rq5, rf5) HG_PUT1(6, rq6, rf6) HG_PUT1(7, rq7, rf7)            \
    sVv[(w)*64 + lane] = bf2f(rv0); sVv[(w + 4) * 64 + lane] = bf2f(rv1);                          \
    sVv[(w + 8) * 64 + lane] = bf2f(rv2); sVv[(w + 12) * 64 + lane] = bf2f(rv3);                   \
  }
  HG_LOAD(0);
  HG_PROCESS();
  __syncthreads();
  constexpr int NCH = SEQ / 16;
#pragma unroll 1
  for (int c = 0; c < NCH; ++c) {
    const int t0 = c * 16;
    const int tn = (c + 1 < NCH) ? t0 + 16 : t0;
    HG_LOAD(tn);
    __builtin_amdgcn_sched_barrier(0);
#pragma unroll 2
    for (int t = 0; t < 16; ++t) {
      const float v = sVv[t * 64 + lane];
      float o = 0.f;
      const float4* f4p = reinterpret_cast<const float4*>(sFg + t * 128 + w * 32);
      const float4* q4p = reinterpret_cast<const float4*>(sQs + t * 128 + w * 32);
#pragma unroll
      for (int j4 = 0; j4 < 8; ++j4) {
        float4 f4 = f4p[j4], q4 = q4p[j4];
        float fg, kv;
        fg = f4.x; kv = fmaf(-fg, v, v); s[j4 * 4 + 0] = fmaf(s[j4 * 4 + 0], fg, kv); o = fmaf(q4.x, s[j4 * 4 + 0], o);
        fg = f4.y; kv = fmaf(-fg, v, v); s[j4 * 4 + 1] = fmaf(s[j4 * 4 + 1], fg, kv); o = fmaf(q4.y, s[j4 * 4 + 1], o);
        fg = f4.z; kv = fmaf(-fg, v, v); s[j4 * 4 + 2] = fmaf(s[j4 * 4 + 2], fg, kv); o = fmaf(q4.z, s[j4 * 4 + 2], o);
        fg = f4.w; kv = fmaf(-fg, v, v); s[j4 * 4 + 3] = fmaf(s[j4 * 4 + 3], fg, kv); o = fmaf(q4.w, s[j4 * 4 + 3], o);
      }
      sO[(w * 16 + t) * 64 + lane] = o;
    }
    __builtin_amdgcn_sched_barrier(0);
    __syncthreads();
    {
      int t = tid >> 4, v4 = (tid & 15) * 4;
      float4 a = *reinterpret_cast<const float4*>(sO + (0 * 16 + t) * 64 + v4);
      float4 bq = *reinterpret_cast<const float4*>(sO + (1 * 16 + t) * 64 + v4);
      float4 cq = *reinterpret_cast<const float4*>(sO + (2 * 16 + t) * 64 + v4);
      float4 d = *reinterpret_cast<const float4*>(sO + (3 * 16 + t) * 64 + v4);
      uint2 o;
      o.x = pack2(a.x + bq.x + cq.x + d.x, a.y + bq.y + cq.y + d.y);
      o.y = pack2(a.z + bq.z + cq.z + d.z, a.w + bq.w + cq.w + d.w);
      *reinterpret_cast<uint2*>(Z + (size_t)(t0 + t) * ZS + vcol + v4) = o;
    }
    HG_PROCESS();
    __syncthreads();
  }
#undef HG_LOAD
#undef HG_PUT1
#undef HG_PROCESS
}

__device__ void mb_scan(const Params& p, int l, int task, char* smem) {
  const int b = task >> 3, hd = task & 7, g = hd >> 2;
  float* sB = reinterpret_cast<float*>(smem);
  float* sC = sB + 16 * 128;
  float* sX = sC + 16 * 128;
  float* sDt = sX + 16 * 64;
  float* sDA = sDt + 16;
  float* sO = sDA + 16;
  const int tid = opaque_tid(), w = tid >> 6, lane = tid & 63;
  bf16_t* Z = (bf16_t*)(p.ws + OFF_Z) + (size_t)b * SEQ * ZS;
  const float* cw = p.in[I_MB_CONVW] + (size_t)l * 4 * 1024;
  const float* cb = p.in[I_MB_CONVB] + (size_t)l * 1024;
  int ci0, ci1;
  {
    int ch = tid;
    ci0 = (ch < 64) ? hd * 64 + ch : (ch < 192 ? 512 + g * 128 + (ch - 64) : 768 + g * 128 + (ch - 192));
    ci1 = 768 + g * 128 + 64 + (tid & 63);
  }
  float* dstA = (tid < 64) ? (sX + tid) : (tid < 192 ? (sB + (tid - 64)) : (sC + (tid - 192)));
  const int strideA = (tid < 64) ? 64 : 128;
  const float w0a = cw[ci0], w1a = cw[1024 + ci0], w2a = cw[2048 + ci0], w3a = cw[3072 + ci0], ba = cb[ci0];
  const float w0b = cw[ci1], w1b = cw[1024 + ci1], w2b = cw[2048 + ci1], w3b = cw[3072 + ci1], bb = cb[ci1];
  const float Aneg = -expf(p.in[I_MB_ALOG][l * 8 + hd]);
  const float dtb = p.in[I_MB_DTB][l * 8 + hd];
  const float Dsk = p.in[I_MB_D][l * 8 + hd];
  float s[32];
#pragma unroll
  for (int j = 0; j < 32; ++j) s[j] = 0.f;
  float pa1 = 0.f, pa2 = 0.f, pa3 = 0.f, pb1 = 0.f, pb2 = 0.f, pb3 = 0.f;
  const int xcol = ZMB + 512;
  const int rt = tid >> 4, rp4 = (tid & 15) * 4;
  bf16_t xa0, xa1, xa2, xa3, xa4, xa5, xa6, xa7, xa8, xa9, xa10, xa11, xa12, xa13, xa14, xa15;
  bf16_t xb0, xb1, xb2, xb3, xb4, xb5, xb6, xb7, xb8, xb9, xb10, xb11, xb12, xb13, xb14, xb15;
  bf16_t rdt;
  uint2 gcur, gnext;
#define MB_LOAD(T0)                                                                                 \
  {                                                                                                 \
    const bf16_t* za = Z + (size_t)(T0) * ZS + xcol + ci0;                                          \
    xa0 = za[0]; xa1 = za[ZS]; xa2 = za[2 * ZS]; xa3 = za[3 * ZS]; xa4 = za[4 * ZS]; xa5 = za[5 * ZS];        \
    xa6 = za[6 * ZS]; xa7 = za[7 * ZS]; xa8 = za[8 * ZS]; xa9 = za[9 * ZS]; xa10 = za[10 * ZS];     \
    xa11 = za[11 * ZS]; xa12 = za[12 * ZS]; xa13 = za[13 * ZS]; xa14 = za[14 * ZS]; xa15 = za[15 * ZS];       \
    if (tid < 64) {                                                                                 \
      const bf16_t* zb = Z + (size_t)(T0) * ZS + xcol + ci1;                                        \
      xb0 = zb[0]; xb1 = zb[ZS]; xb2 = zb[2 * ZS]; xb3 = zb[3 * ZS]; xb4 = zb[4 * ZS]; xb5 = zb[5 * ZS];      \
      xb6 = zb[6 * ZS]; xb7 = zb[7 * ZS]; xb8 = zb[8 * ZS]; xb9 = zb[9 * ZS]; xb10 = zb[10 * ZS];   \
      xb11 = zb[11 * ZS]; xb12 = zb[12 * ZS]; xb13 = zb[13 * ZS]; xb14 = zb[14 * ZS]; xb15 = zb[15 * ZS];     \
    }                                                                                               \
    rdt = Z[(size_t)((T0) + (tid & 15)) * ZS + ZMB + 1536 + hd];                                    \
    gnext = *reinterpret_cast<const uint2*>(Z + (size_t)((T0) + rt) * ZS + ZMB + hd * 64 + rp4);    \
  }
#define MB_CONV_A(T, XR)                                                                            \
  {                                                                                                 \
    float xv = bf2f(XR);                                                                            \
    dstA[(T)*strideA] = fsilu(ba + w0a * pa3 + w1a * pa2 + w2a * pa1 + w3a * xv);                   \
    pa3 = pa2; pa2 = pa1; pa1 = xv;                                                                 \
  }
#define MB_CONV_B(T, XR)                                                                            \
  {                                                                                                 \
    float xv = bf2f(XR);                                                                            \
    sC[(T)*128 + 64 + tid] = fsilu(bb + w0b * pb3 + w1b * pb2 + w2b * pb1 + w3b * xv);              \
    pb3 = pb2; pb2 = pb1; pb1 = xv;                                                                 \
  }
#define MB_PROCESS()                                                                                \
  {                                                                                                 \
    MB_CONV_A(0, xa0) MB_CONV_A(1, xa1) MB_CONV_A(2, xa2) MB_CONV_A(3, xa3) MB_CONV_A(4, xa4)       \
    MB_CONV_A(5, xa5) MB_CONV_A(6, xa6) MB_CONV_A(7, xa7) MB_CONV_A(8, xa8) MB_CONV_A(9, xa9)       \
    MB_CONV_A(10, xa10) MB_CONV_A(11, xa11) MB_CONV_A(12, xa12) MB_CONV_A(13, xa13)                 \
    MB_CONV_A(14, xa14) MB_CONV_A(15, xa15)                                                         \
    if (tid < 64) {                                                                                 \
      MB_CONV_B(0, xb0) MB_CONV_B(1, xb1) MB_CONV_B(2, xb2) MB_CONV_B(3, xb3) MB_CONV_B(4, xb4)     \
      MB_CONV_B(5, xb5) MB_CONV_B(6, xb6) MB_CONV_B(7, xb7) MB_CONV_B(8, xb8) MB_CONV_B(9, xb9)     \
      MB_CONV_B(10, xb10) MB_CONV_B(11, xb11) MB_CONV_B(12, xb12) MB_CONV_B(13, xb13)               \
      MB_CONV_B(14, xb14) MB_CONV_B(15, xb15)                                                       \
    }                                                                                               \
    if (tid < 16) {                                                                                 \
      float dt = fsoftplus(bf2f(rdt) + dtb);                                                        \
      sDt[tid] = dt;                                                                                \
      sDA[tid] = __expf(Aneg * dt);                                                                 \
    }                                                                                               \
    gcur = gnext;                                                                                   \
  }
  MB_LOAD(0);
  MB_PROCESS();
  __syncthreads();
  constexpr int NCH = SEQ / 16;
#pragma unroll 1
  for (int c = 0; c < NCH; ++c) {
    const int t0 = c * 16;
    const bool more = (c + 1 < NCH);
    const int tn = more ? t0 + 16 : t0;
    MB_LOAD(tn);
    __builtin_amdgcn_sched_barrier(0);
#pragma unroll 2
    for (int t = 0; t < 16; ++t) {
      const float dA = sDA[t];
      const float xdt = sX[t * 64 + lane] * sDt[t];
      float y = 0.f;
      const float4* b4p = reinterpret_cast<const float4*>(sB + t * 128 + w * 32);
      const float4* c4p = reinterpret_cast<const float4*>(sC + t * 128 + w * 32);
#pragma unroll
      for (int j4 = 0; j4 < 8; ++j4) {
        float4 b4 = b4p[j4], c4 = c4p[j4];
        s[j4 * 4 + 0] = fmaf(s[j4 * 4 + 0], dA, b4.x * xdt); y = fmaf(c4.x, s[j4 * 4 + 0], y);
        s[j4 * 4 + 1] = fmaf(s[j4 * 4 + 1], dA, b4.y * xdt); y = fmaf(c4.y, s[j4 * 4 + 1], y);
        s[j4 * 4 + 2] = fmaf(s[j4 * 4 + 2], dA, b4.z * xdt); y = fmaf(c4.z, s[j4 * 4 + 2], y);
        s[j4 * 4 + 3] = fmaf(s[j4 * 4 + 3], dA, b4.w * xdt); y = fmaf(c4.w, s[j4 * 4 + 3], y);
      }
      sO[(w * 16 + t) * 64 + lane] = y;
    }
    __builtin_amdgcn_sched_barrier(0);
    __syncthreads();
    {
      float4 a = *reinterpret_cast<const float4*>(sO + (0 * 16 + rt) * 64 + rp4);
      float4 bq = *reinterpret_cast<const float4*>(sO + (1 * 16 + rt) * 64 + rp4);
      float4 cq = *reinterpret_cast<const float4*>(sO + (2 * 16 + rt) * 64 + rp4);
      float4 d = *reinterpret_cast<const float4*>(sO + (3 * 16 + rt) * 64 + rp4);
      float4 xs = *reinterpret_cast<const float4*>(sX + rt * 64 + rp4);
      bf16_t* gp = Z + (size_t)(t0 + rt) * ZS + ZMB + hd * 64 + rp4;
      float g0 = bf2f((bf16_t)(gcur.x & 0xffff)), g1 = bf2f((bf16_t)(gcur.x >> 16));
      float g2 = bf2f((bf16_t)(gcur.y & 0xffff)), g3 = bf2f((bf16_t)(gcur.y >> 16));
      float y0 = a.x + bq.x + cq.x + d.x + Dsk * xs.x;
      float y1 = a.y + bq.y + cq.y + d.y + Dsk * xs.y;
      float y2 = a.z + bq.z + cq.z + d.z + Dsk * xs.z;
      float y3 = a.w + bq.w + cq.w + d.w + Dsk * xs.w;
      uint2 o;
      o.x = pack2(y0 * fsilu(g0), y1 * fsilu(g1));
      o.y = pack2(y2 * fsilu(g2), y3 * fsilu(g3));
      *reinterpret_cast<uint2*>(gp) = o;
    }
    __syncthreads();
    if (more) MB_PROCESS();
    __syncthreads();
  }
#undef MB_LOAD
#undef MB_CONV_A
#undef MB_CONV_B
#undef MB_PROCESS
}

__device__ void s5_scan(const Params& p, int l, int task, char* smem) {
  const int tid = opaque_tid(), w = tid >> 6, lane = tid & 63;
  const int b = task >> 3, g = (task & 7) * 4 + w;
  float* base = reinterpret_cast<float*>(smem) + w * 3264;
  float* sU = base;
  float* sH = sU + 128;
  float* sC = sH + 8 * 65 * 2;
  bf16_t* Z = (bf16_t*)(p.ws + OFF_Z) + (size_t)b * SEQ * ZS + ZS5 + g * 16;
  const int n = lane;
  float lr, li, bbr[16], bbi[16];
  {
    float dt = expf(p.in[I_S5_LOGDT][l * 32 + g]);
    float are = p.in[I_S5_ARE][(l * 32 + g) * 64 + n], aim = p.in[I_S5_AIM][(l * 32 + g) * 64 + n];
    float mag = expf(dt * are);
    lr = mag * cosf(dt * aim); li = mag * sinf(dt * aim);
    float den = are * are + aim * aim;
    float cr = ((lr - 1.f) * are + li * aim) / den;
    float ci = (li * are - (lr - 1.f) * aim) / den;
    const float* bre = p.in[I_S5_BRE] + ((size_t)(l * 32 + g) * 64 + n) * 16;
    const float* bim = p.in[I_S5_BIM] + ((size_t)(l * 32 + g) * 64 + n) * 16;
#pragma unroll
    for (int c = 0; c < 16; ++c) {
      float br = bre[c], bi = bim[c];
      bbr[c] = cr * br - ci * bi;
      bbi[c] = cr * bi + ci * br;
    }
    const float* cre = p.in[I_S5_CRE] + (size_t)(l * 32 + g) * 16 * 64;
    const float* cim = p.in[I_S5_CIM] + (size_t)(l * 32 + g) * 16 * 64;
#pragma unroll
    for (int cp = 0; cp < 8; ++cp) {
      float4 v;
      v.x = cre[(2 * cp) * 64 + n]; v.y = cre[(2 * cp + 1) * 64 + n];
      v.z = cim[(2 * cp) * 64 + n]; v.w = cim[(2 * cp + 1) * 64 + n];
      *reinterpret_cast<float4*>(sC + (n * 8 + cp) * 4) = v;
    }
  }
  const int ot = lane >> 3, ocp = lane & 7;
  const float d0 = p.in[I_S5_D][l * 512 + g * 16 + 2 * ocp], d1 = p.in[I_S5_D][l * 512 + g * 16 + 2 * ocp + 1];
  float hr = 0.f, hi = 0.f;
  unsigned unext = *reinterpret_cast<const unsigned*>(Z + (size_t)ot * ZS + 2 * ocp);
  constexpr int NCH = SEQ / 8;
#pragma unroll 1
  for (int c = 0; c < NCH; ++c) {
    const int t0 = c * 8;
    const unsigned uraw = unext;
    const float u0 = bf2f((bf16_t)(uraw & 0xffff)), u1 = bf2f((bf16_t)(uraw >> 16));
    *reinterpret_cast<float2*>(sU + ot * 16 + 2 * ocp) = float2{u0, u1};
    {
      const int tn = (c + 1 < NCH) ? t0 + 8 : t0;
      unext = *reinterpret_cast<const unsigned*>(Z + (size_t)(tn + ot) * ZS + 2 * ocp);
    }
    __builtin_amdgcn_sched_barrier(0);
    __syncthreads();
#pragma unroll 2
    for (int t = 0; t < 8; ++t) {
      const float4* u4 = reinterpret_cast<const float4*>(sU + t * 16);
      float bur = 0.f, bui = 0.f;
#pragma unroll
      for (int q = 0; q < 4; ++q) {
        float4 u = u4[q];
        bur = fmaf(bbr[q * 4 + 0], u.x, bur); bui = fmaf(bbi[q * 4 + 0], u.x, bui);
        bur = fmaf(bbr[q * 4 + 1], u.y, bur); bui = fmaf(bbi[q * 4 + 1], u.y, bui);
        bur = fmaf(bbr[q * 4 + 2], u.z, bur); bui = fmaf(bbi[q * 4 + 2], u.z, bui);
        bur = fmaf(bbr[q * 4 + 3], u.w, bur); bui = fmaf(bbi[q * 4 + 3], u.w, bui);
      }
      float nr = lr * hr - li * hi + bur;
      float ni = lr * hi + li * hr + bui;
      hr = nr; hi = ni;
      *reinterpret_cast<float2*>(sH + (t * 65 + n) * 2) = float2{hr, hi};
    }
    __syncthreads();
    {
      float y0 = 0.f, y1 = 0.f, y2 = 0.f, y3 = 0.f;
#pragma unroll 8
      for (int nn = 0; nn < 64; nn += 2) {
        float2 hh = *reinterpret_cast<const float2*>(sH + (ot * 65 + nn) * 2);
        float4 cc = *reinterpret_cast<const float4*>(sC + (nn * 8 + ocp) * 4);
        float2 hh2 = *reinterpret_cast<const float2*>(sH + (ot * 65 + nn + 1) * 2);
        float4 cc2 = *reinterpret_cast<const float4*>(sC + ((nn + 1) * 8 + ocp) * 4);
        y0 = fmaf(cc.x, hh.x, y0); y0 = fmaf(-cc.z, hh.y, y0);
        y1 = fmaf(cc.y, hh.x, y1); y1 = fmaf(-cc.w, hh.y, y1);
        y2 = fmaf(cc2.x, hh2.x, y2); y2 = fmaf(-cc2.z, hh2.y, y2);
        y3 = fmaf(cc2.y, hh2.x, y3); y3 = fmaf(-cc2.w, hh2.y, y3);
      }
      y0 = fgelu(y0 + y2 + d0 * u0);
      y1 = fgelu(y1 + y3 + d1 * u1);
      *reinterpret_cast<unsigned*>(Z + (size_t)(t0 + ot) * ZS + 2 * ocp) = pack2(y0, y1);
    }
    __syncthreads();
  }
}

__device__ void rw_scan(const Params& p, int l, int task, char* smem) {
  const int b = task >> 3, h = task & 7;
  float* sR = reinterpret_cast<float*>(smem);
  float* sW = sR + 1024;
  float* sK = sW + 1024;
  float* sA = sK + 1024;
  float* sBb = sA + 1024;
  float* sV = sBb + 1024;
  float* sY = sV + 1024;
  float* sBonus = sY + 1024;
  const int tid = opaque_tid(), w = tid >> 6, lane = tid & 63;
  const size_t tokbase = (size_t)b * SEQ;
  bf16_t* Z = (bf16_t*)(p.ws + OFF_Z) + tokbase * ZS;
  const bf16_t* LW = (const bf16_t*)(p.ws + OFF_U) + tokbase * 512;
  const bf16_t* LA = LW + (size_t)T_TOK * 512;
  const bf16_t* VF = (const bf16_t*)(p.ws + OFF_VF) + tokbase * 512;
  const int st = tid >> 4, c4 = (tid & 15) * 4, ch = h * 64 + c4;
  float mur[4], muk[4], w0[4], a0[4], kk_[4], ka_[4], rk_[4], lnw[4], lnb[4];
#pragma unroll
  for (int e = 0; e < 4; ++e) {
    mur[e] = p.in[I_RW_MU][l * 1792 + ch + e];
    muk[e] = p.in[I_RW_MU][l * 1792 + 512 + ch + e];
    w0[e] = p.in[I_RW_W0][l * 512 + ch + e];
    a0[e] = p.in[I_RW_A0][l * 512 + ch + e];
    kk_[e] = p.in[I_RW_KK][l * 512 + ch + e];
    ka_[e] = p.in[I_RW_KA][l * 512 + ch + e];
    rk_[e] = p.in[I_RW_RK][l * 512 + ch + e];
    lnw[e] = p.in[I_RW_LNW][l * 512 + ch + e];
    lnb[e] = p.in[I_RW_LNB][l * 512 + ch + e];
  }
  const int rl = lane >> 2, kq = lane & 3, vrow = w * 16 + rl;
  float S[16];
#pragma unroll
  for (int j = 0; j < 16; ++j) S[j] = 0.f;
  uint2 rc, kc, rp, kp, lwv, lav, vfv;
#define RW_LOAD(T0)                                                                                 \
  {                                                                                                 \
    const int s_ = (T0) + st;                                                                       \
    const bf16_t* zr = Z + (size_t)s_ * ZS + ZRW + ch;                                              \
    rc = *reinterpret_cast<const uint2*>(zr);                                                       \
    kc = *reinterpret_cast<const uint2*>(zr + 512);                                                 \
    rp = uint2{0u, 0u}; kp = uint2{0u, 0u};                                                         \
    if (s_ > 0) { rp = *reinterpret_cast<const uint2*>(zr - ZS); kp = *reinterpret_cast<const uint2*>(zr - ZS + 512); } \
    lwv = *reinterpret_cast<const uint2*>(LW + (size_t)s_ * 512 + ch);                              \
    lav = *reinterpret_cast<const uint2*>(LA + (size_t)s_ * 512 + ch);                              \
    vfv = *reinterpret_cast<const uint2*>(VF + (size_t)s_ * 512 + ch);                              \
  }
#define RW_PROCESS()                                                                                \
  {                                                                                                 \
    float r4[4], k4[4], kkv[4], av[4], wv[4], vv[4];                                                \
    float n2 = 0.f;                                                                                 \
    _Pragma("unroll") for (int e = 0; e < 4; ++e) {                                                 \
      unsigned rcw = (e < 2) ? rc.x : rc.y, kcw = (e < 2) ? kc.x : kc.y, rpw = (e < 2) ? rp.x : rp.y, kpw = (e < 2) ? kp.x : kp.y; \
      unsigned lww = (e < 2) ? lwv.x : lwv.y, law = (e < 2) ? lav.x : lav.y, vfw = (e < 2) ? vfv.x : vfv.y; \
      int sh = (e & 1) * 16;                                                                        \
      float rcur = bf2f((bf16_t)((rcw >> sh) & 0xffff)), rprev = bf2f((bf16_t)((rpw >> sh) & 0xffff)); \
      float kcur = bf2f((bf16_t)((kcw >> sh) & 0xffff)), kprev = bf2f((bf16_t)((kpw >> sh) & 0xffff)); \
      float lwf = bf2f((bf16_t)((lww >> sh) & 0xffff)), laf = bf2f((bf16_t)((law >> sh) & 0xffff)); \
      vv[e] = bf2f((bf16_t)((vfw >> sh) & 0xffff));                                                 \
      r4[e] = rcur + (rprev - rcur) * mur[e];                                                       \
      k4[e] = kcur + (kprev - kcur) * muk[e];                                                       \
      float wlog = -fsoftplus(-(w0[e] + lwf)) - 0.5f;                                               \
      wv[e] = __expf(-__expf(wlog));                                                                \
      av[e] = fsigmoid(a0[e] + laf);                                                                \
      kkv[e] = k4[e] * kk_[e];                                                                      \
      n2 += kkv[e] * kkv[e];                                                                        \
    }                                                                                               \
    n2 = sum16(n2);                                                                                 \
    float inv = 1.f / fmaxf(sqrtf(n2), 1e-12f);                                                     \
    float bon = 0.f;                                                                                \
    float kt4[4], ap4[4], bp4[4];                                                                   \
    _Pragma("unroll") for (int e = 0; e < 4; ++e) {                                                 \
      float kkn = kkv[e] * inv;                                                                     \
      kt4[e] = k4[e] * (1.f + (av[e] - 1.f) * ka_[e]);                                              \
      ap4[e] = -kkn;                                                                                \
      bp4[e] = kkn * av[e];                                                                         \
      bon += r4[e] * kt4[e] * rk_[e];                                                               \
    }                                                                                               \
    bon = sum16(bon);                                                                               \
    *reinterpret_cast<float4*>(sR + st * 64 + c4) = float4{r4[0], r4[1], r4[2], r4[3]};             \
    *reinterpret_cast<float4*>(sW + st * 64 + c4) = float4{wv[0], wv[1], wv[2], wv[3]};             \
    *reinterpret_cast<float4*>(sK + st * 64 + c4) = float4{kt4[0], kt4[1], kt4[2], kt4[3]};         \
    *reinterpret_cast<float4*>(sA + st * 64 + c4) = float4{ap4[0], ap4[1], ap4[2], ap4[3]};         \
    *reinterpret_cast<float4*>(sBb + st * 64 + c4) = float4{bp4[0], bp4[1], bp4[2], bp4[3]};        \
    *reinterpret_cast<float4*>(sV + st * 64 + c4) = float4{vv[0], vv[1], vv[2], vv[3]};             \
    if ((tid & 15) == 0) sBonus[st] = bon;                                                          \
  }
  RW_LOAD(0);
  RW_PROCESS();
  __syncthreads();
  constexpr int NCH = SEQ / 16;
#pragma unroll 1
  for (int c = 0; c < NCH; ++c) {
    const int t0 = c * 16;
    const int tn = (c + 1 < NCH) ? t0 + 16 : t0;
    RW_LOAD(tn);
    __builtin_amdgcn_sched_barrier(0);
#pragma unroll 2
    for (int t = 0; t < 16; ++t) {
      const float4* a4p = reinterpret_cast<const float4*>(sA + t * 64 + kq * 16);
      const float4* w4p = reinterpret_cast<const float4*>(sW + t * 64 + kq * 16);
      const float4* b4p = reinterpret_cast<const float4*>(sBb + t * 64 + kq * 16);
      const float4* k4p = reinterpret_cast<const float4*>(sK + t * 64 + kq * 16);
      const float4* r4p = reinterpret_cast<const float4*>(sR + t * 64 + kq * 16);
      const float vv = sV[t * 64 + vrow];
      float sa0 = 0.f, sa1 = 0.f;
#pragma unroll
      for (int q = 0; q < 4; ++q) {
        float4 a = a4p[q];
        sa0 = fmaf(S[q * 4 + 0], a.x, sa0); sa1 = fmaf(S[q * 4 + 1], a.y, sa1);
        sa0 = fmaf(S[q * 4 + 2], a.z, sa0); sa1 = fmaf(S[q * 4 + 3], a.w, sa1);
      }
      const float sa = quad_sum(sa0 + sa1);
      float y0 = 0.f, y1 = 0.f;
#pragma unroll
      for (int q = 0; q < 4; ++q) {
        float4 ww = w4p[q], bb = b4p[q], kk = k4p[q], rr = r4p[q];
        S[q * 4 + 0] = fmaf(S[q * 4 + 0], ww.x, fmaf(sa, bb.x, vv * kk.x)); y0 = fmaf(S[q * 4 + 0], rr.x, y0);
        S[q * 4 + 1] = fmaf(S[q * 4 + 1], ww.y, fmaf(sa, bb.y, vv * kk.y)); y1 = fmaf(S[q * 4 + 1], rr.y, y1);
        S[q * 4 + 2] = fmaf(S[q * 4 + 2], ww.z, fmaf(sa, bb.z, vv * kk.z)); y0 = fmaf(S[q * 4 + 2], rr.z, y0);
        S[q * 4 + 3] = fmaf(S[q * 4 + 3], ww.w, fmaf(sa, bb.w, vv * kk.w)); y1 = fmaf(S[q * 4 + 3], rr.w, y1);
      }
      const float y = quad_sum(y0 + y1);
      if (kq == 0) sY[t * 64 + vrow] = y;
    }
    __builtin_amdgcn_sched_barrier(0);
    __syncthreads();
    {
      float4 y4 = *reinterpret_cast<const float4*>(sY + st * 64 + c4);
      float4 v4 = *reinterpret_cast<const float4*>(sV + st * 64 + c4);
      float bon = sBonus[st];
      float mean = sum16(y4.x + y4.y + y4.z + y4.w) * (1.f / 64.f);
      float dx = y4.x - mean, dy = y4.y - mean, dz = y4.z - mean, dw = y4.w - mean;
      float var = sum16(dx * dx + dy * dy + dz * dz + dw * dw) * (1.f / 64.f);
      float rs = rsqrtf(var + 64e-5f);
      float o0 = dx * rs * lnw[0] + lnb[0] + bon * v4.x;
      float o1 = dy * rs * lnw[1] + lnb[1] + bon * v4.y;
      float o2 = dz * rs * lnw[2] + lnb[2] + bon * v4.z;
      float o3 = dw * rs * lnw[3] + lnb[3] + bon * v4.w;
      uint2 o;
      o.x = pack2(o0, o1); o.y = pack2(o2, o3);
      *reinterpret_cast<uint2*>(Z + (size_t)(t0 + st) * ZS + ZRW + 1024 + ch) = o;
    }
    RW_PROCESS();
    __syncthreads();
  }
#undef RW_LOAD
#undef RW_PROCESS
}

__device__ void phase_scans(const Params& p, int l, char* smem) {
  for (int t = blockIdx.x; t < 256; t += gridDim.x) {
    int type = t & 3, idx = t >> 2;
#ifndef SCM
#define SCM 15
#endif
    if (type == 0) { if (SCM & 1) rw_scan(p, l, idx, smem); }
    else if (type == 1) { if (SCM & 2) hg_scan(p, l, idx, smem); }
    else if (type == 2) { if (SCM & 4) mb_scan(p, l, idx, smem); }
    else { if (SCM & 8) s5_scan(p, l, idx, smem); }
    __syncthreads();
  }
}

__device__ __forceinline__ void unpack8(const uint4& v, float (&f)[8]) {
  f[0] = bf2f((bf16_t)(v.x & 0xffff)); f[1] = bf2f((bf16_t)(v.x >> 16));
  f[2] = bf2f((bf16_t)(v.y & 0xffff)); f[3] = bf2f((bf16_t)(v.y >> 16));
  f[4] = bf2f((bf16_t)(v.z & 0xffff)); f[5] = bf2f((bf16_t)(v.z >> 16));
  f[6] = bf2f((bf16_t)(v.w & 0xffff)); f[7] = bf2f((bf16_t)(v.w >> 16));
}

__device__ void phase_post(const Params& p, int l, char* smem) {
  bf16_t* Z = (bf16_t*)(p.ws + OFF_Z);
  const int tid = opaque_tid(), lane = tid & 63, wid = tid >> 6;
  constexpr int N_ROWT = T_TOK / 4, N_RWT = T_TOK / 16, N_GLU = 128 * 4, N_NORM = T_TOK / 4;
  const float* xsrc = (l == 0) ? p.in[I_X] : p.out;
  for (int t = blockIdx.x; t < N_ROWT + N_RWT + N_GLU + N_NORM; t += gridDim.x) {
    if (t < N_ROWT) {
      const int row = t * 4 + wid;
      {
        bf16_t* op = Z + (size_t)row * ZS + ZHG + 1024 + lane * 8;
        uint4 ov = *reinterpret_cast<const uint4*>(op);
        uint4 gv = *reinterpret_cast<const uint4*>(op + 512);
        float o[8], g[8];
        unpack8(ov, o); unpack8(gv, g);
        float ss = 0.f;
#pragma unroll
        for (int e = 0; e < 8; ++e) ss += o[e] * o[e];
        ss = sum16(ss);
        float rstd = rsqrtf(ss * (1.f / 128.f) + 1e-6f);
        const float* nw = p.in[I_HG_NW] + l * 512 + lane * 8;
        float r[8];
#pragma unroll
        for (int e = 0; e < 8; ++e) r[e] = o[e] * rstd * nw[e] * siluf_(g[e]);
        *reinterpret_cast<uint4*>(op) = uint4{pack2(r[0], r[1]), pack2(r[2], r[3]), pack2(r[4], r[5]), pack2(r[6], r[7])};
      }
      {
        bf16_t* op = Z + (size_t)row * ZS + ZMB + lane * 8;
        uint4 ov = *reinterpret_cast<const uint4*>(op);
        float o[8];
        unpack8(ov, o);
        float ss = 0.f;
#pragma unroll
        for (int e = 0; e < 8; ++e) ss += o[e] * o[e];
        ss = sum64(ss);
        float rstd = rsqrtf(ss * (1.f / 512.f) + 1e-6f);
        const float* nw = p.in[I_MB_NW] + l * 512 + lane * 8;
        float r[8];
#pragma unroll
        for (int e = 0; e < 8; ++e) r[e] = o[e] * rstd * nw[e];
        *reinterpret_cast<uint4*>(op) = uint4{pack2(r[0], r[1]), pack2(r[2], r[3]), pack2(r[4], r[5]), pack2(r[6], r[7])};
      }
    } else if (t < N_ROWT + N_RWT) {
      const int row0 = (t - N_ROWT) * 16;
      float* sXg = reinterpret_cast<float*>(smem);
      const float* mu = p.in[I_RW_MU] + l * 1792 + 1664;
      for (int e = tid; e < 2048; e += 256) {
        int j = e >> 4, tok = e & 15;
        int row = row0 + tok, s = row & (SEQ - 1);
        sXg[j * 16 + tok] = sigmoidf_(rw_shift(Z, row, s, 1664 + j, mu[j]));
      }
      __syncthreads();
      float a0[16], a1[16];
      lora_mm<128>(sXg, p.in[I_RW_G2] + (size_t)l * 128 * 512, a0, a1, tid);
#pragma unroll
      for (int tok = 0; tok < 16; ++tok) {
        bf16_t* yp = Z + (size_t)(row0 + tok) * ZS + ZRW + 1024 + tid;
        yp[0] = f2bf(bf2f(yp[0]) * a0[tok]);
        yp[256] = f2bf(bf2f(yp[256]) * a1[tok]);
      }
      __syncthreads();
    } else if (t < N_ROWT + N_RWT + N_GLU) {
      const int tt = t - N_ROWT - N_RWT, mt = tt >> 2, nt = tt & 3;
      const int wm = wid >> 1, wn = wid & 1;
      f32x4 acc[4][4];
      zero_acc<128>(acc);
      gemm_mainloop<128>(acc, Z + ZS5, ZS, mt * 128, (const bf16_t*)(p.ws + OFF_WTGLU), 512, nt * 128, 511, 512, smem, tid);
      const float* bg = p.in[I_S5_BGLU] + l * 512;
#pragma unroll
      for (int mi = 0; mi < 4; ++mi)
#pragma unroll
        for (int ni = 0; ni < 4; ++ni) {
          int col = nt * 128 + wn * 64 + ni * 16 + (lane >> 4) * 4;
          int row = mt * 128 + wm * 64 + mi * 16 + (lane & 15);
          float4 b4 = *reinterpret_cast<const float4*>(bg + col);
          uint2 yv = *reinterpret_cast<const uint2*>(Z + (size_t)row * ZS + ZS5 + col);
          float y0 = bf2f((bf16_t)(yv.x & 0xffff)), y1 = bf2f((bf16_t)(yv.x >> 16));
          float y2 = bf2f((bf16_t)(yv.y & 0xffff)), y3 = bf2f((bf16_t)(yv.y >> 16));
          uint2 o;
          o.x = pack2(y0 * sigmoidf_(acc[mi][ni][0] + b4.x), y1 * sigmoidf_(acc[mi][ni][1] + b4.y));
          o.y = pack2(y2 * sigmoidf_(acc[mi][ni][2] + b4.z), y3 * sigmoidf_(acc[mi][ni][3] + b4.w));
          *reinterpret_cast<uint2*>(Z + (size_t)row * ZS + ZMB + 1024 + col) = o;
        }
    } else {
      const int row = (t - N_ROWT - N_RWT - N_GLU) * 4 + wid;
      rmsnorm_row_to_bf16(xsrc + (size_t)row * DM, p.in[I_NORM_MIX] + l * DM, (bf16_t*)(p.ws + OFF_U) + (size_t)row * DM, tid & 63);
    }
  }
}

__device__ void phase_merge(const Params& p, char* smem) {
  bf16_t* Z = (bf16_t*)(p.ws + OFF_Z);
  const bf16_t* U = (const bf16_t*)(p.ws + OFF_U);
  const bf16_t* Wg = (const bf16_t*)(p.ws + OFF_WTGATE);
  const bf16_t* Wb = (const bf16_t*)(p.ws + OFF_WTBR);
  const int tid = opaque_tid();
  const int lane = tid & 63, wid = tid >> 6, wm = wid >> 1, wn = wid & 1;
  for (int t = blockIdx.x; t < 128 * 16; t += gridDim.x) {
    const int mt = t >> 4, nt = t & 15;
    f32x4 accm[4][2];
    zero_acc<64>(accm);
    for (int kb = 0; kb < 4; ++kb) {
      f32x4 g[4][2], pr[4][2];
      zero_acc<64>(g);
      zero_acc<64>(pr);
      gemm_mainloop<64>(g, U, 1024, mt * 128, Wg + (size_t)kb * 1024 * 1024, 1024, nt * 64, 1023, 1024, smem, tid);
      const int ycol = (kb == 0) ? (ZHG + 1024) : (kb == 1) ? (ZRW + 1024) : (kb == 2) ? (ZMB + 1024) : ZMB;
      gemm_mainloop<64>(pr, Z + ycol, ZS, mt * 128, Wb + (size_t)kb * 1024 * 512, 512, nt * 64, 1023, 512, smem, tid);
#pragma unroll
      for (int mi = 0; mi < 4; ++mi)
#pragma unroll
        for (int ni = 0; ni < 2; ++ni)
#pragma unroll
          for (int j = 0; j < 4; ++j) accm[mi][ni][j] = fmaf(sigmoidf_(g[mi][ni][j]), pr[mi][ni][j], accm[mi][ni][j]);
    }
#pragma unroll
    for (int mi = 0; mi < 4; ++mi)
#pragma unroll
      for (int ni = 0; ni < 2; ++ni) {
        int col = nt * 64 + wn * 32 + ni * 16 + (lane >> 4) * 4;
        int row = mt * 128 + wm * 64 + mi * 16 + (lane & 15);
        uint2 o;
        o.x = pack2(accm[mi][ni][0], accm[mi][ni][1]);
        o.y = pack2(accm[mi][ni][2], accm[mi][ni][3]);
        *reinterpret_cast<uint2*>(Z + (size_t)row * ZS + col) = o;
      }
  }
}

__device__ void phase_resid_gemm(const Params& p, const bf16_t* A, int lda, const bf16_t* Wt, int K, const float* xold, char* smem) {
  const int tid = opaque_tid();
  const int lane = tid & 63, wid = tid >> 6, wm = wid >> 1, wn = wid & 1;
  for (int t = blockIdx.x; t < 128 * 8; t += gridDim.x) {
    const int mt = t >> 3, nt = t & 7;
    f32x4 acc[4][4];
    zero_acc<128>(acc);
    gemm_mainloop<128>(acc, A, lda, mt * 128, Wt, K, nt * 128, 1023, K, smem, tid);
#pragma unroll
    for (int mi = 0; mi < 4; ++mi)
#pragma unroll
      for (int ni = 0; ni < 4; ++ni) {
        int col = nt * 128 + wn * 64 + ni * 16 + (lane >> 4) * 4;
        int row = mt * 128 + wm * 64 + mi * 16 + (lane & 15);
        size_t o = (size_t)row * DM + col;
        float4 xo = *reinterpret_cast<const float4*>(xold + o);
        float4 r = float4{xo.x + acc[mi][ni][0], xo.y + acc[mi][ni][1], xo.z + acc[mi][ni][2], xo.w + acc[mi][ni][3]};
        *reinterpret_cast<float4*>(p.out + o) = r;
      }
  }
}

__device__ void phase_ffn_in(const Params& p, char* smem) {
  const bf16_t* U = (const bf16_t*)(p.ws + OFF_U);
  const bf16_t* Wt = (const bf16_t*)(p.ws + OFF_WTF1);
  bf16_t* H = (bf16_t*)(p.ws + OFF_Z);
  const int tid = opaque_tid();
  const int lane = tid & 63, wid = tid >> 6, wm = wid >> 1, wn = wid & 1;
  for (int t = blockIdx.x; t < 128 * 44; t += gridDim.x) {
    const int mt = t / 44, nt = t % 44;
    f32x4 acc[4][4];
    zero_acc<128>(acc);
    gemm_mainloop<128>(acc, U, 1024, mt * 128, Wt, 1024, nt * 128, 5631, 1024, smem, tid);
#pragma unroll
    for (int mi = 0; mi < 4; ++mi)
#pragma unroll
      for (int q = 0; q < 2; ++q) {
        int hcol = ((nt * 128 + wn * 64 + q * 32) >> 1) + (lane >> 4) * 4;
        int row = mt * 128 + wm * 64 + mi * 16 + (lane & 15);
        uint2 o;
        o.x = pack2(siluf_(acc[mi][2 * q][0]) * acc[mi][2 * q + 1][0], siluf_(acc[mi][2 * q][1]) * acc[mi][2 * q + 1][1]);
        o.y = pack2(siluf_(acc[mi][2 * q][2]) * acc[mi][2 * q + 1][2], siluf_(acc[mi][2 * q][3]) * acc[mi][2 * q + 1][3]);
        *reinterpret_cast<uint2*>(H + (size_t)row * FFH + hcol) = o;
      }
  }
}

__device__ void phase_final(const Params& p) {
  const int tid = opaque_tid();
  const int lane = tid & 63;
  const float* w = p.in[I_NORM_FINAL];
  for (int t = blockIdx.x; t < T_TOK / 4; t += gridDim.x) {
    int row = t * 4 + (tid >> 6);
    float* x = p.out + (size_t)row * DM;
    float4 v[4];
    float ss = 0.f;
#pragma unroll
    for (int i = 0; i < 4; ++i) {
      v[i] = *reinterpret_cast<const float4*>(x + i * 256 + lane * 4);
      ss += v[i].x * v[i].x + v[i].y * v[i].y + v[i].z * v[i].z + v[i].w * v[i].w;
    }
    ss = sum64(ss);
    float rstd = rsqrtf(ss * (1.f / 1024.f) + 1e-6f);
#pragma unroll
    for (int i = 0; i < 4; ++i) {
      float4 ww = *reinterpret_cast<const float4*>(w + i * 256 + lane * 4);
      float4 o = float4{v[i].x * rstd * ww.x, v[i].y * rstd * ww.y, v[i].z * rstd * ww.z, v[i].w * rstd * ww.w};
      *reinterpret_cast<float4*>(x + i * 256 + lane * 4) = o;
    }
  }
}

template <int SUB>
__device__ __forceinline__ void run_phase(const Params& p, int l, char* smem) {
  if (SUB == 0) phase_convert_norm(p, l, smem);
  else if (SUB == 1) phase_inproj(p, smem);
  else if (SUB == 2) phase_rwprep(p, l, smem);
  else if (SUB == 3) phase_scans(p, l, smem);
  else if (SUB == 4) phase_post(p, l, smem);
  else if (SUB == 5) phase_merge(p, smem);
  else if (SUB == 6) phase_resid_gemm(p, (const bf16_t*)(p.ws + OFF_Z), ZS, (const bf16_t*)(p.ws + OFF_WTOUT), 1024,
                                      (l == 0) ? p.in[I_X] : p.out, smem);
  else if (SUB == 7) phase_norm_only(p, p.out, p.in[I_NORM_FFN] + l * DM);
  else if (SUB == 8) phase_ffn_in(p, smem);
  else if (SUB == 9) phase_resid_gemm(p, (const bf16_t*)(p.ws + OFF_Z), FFH, (const bf16_t*)(p.ws + OFF_WTF2), FFH, p.out, smem);
  else phase_final(p);
}

#ifndef PHM
#define PHM 0xFFFF
#endif
#if COOP
__global__ void __launch_bounds__(256, 2) fwd_kernel(Params p, int ph0, int ph1) {
  __shared__ __attribute__((aligned(16))) char smem[65536];
  cg::grid_group grid = cg::this_grid();
  for (int ph = ph0; ph < ph1; ++ph) {
    if (ph == NPHASES - 1) {
      phase_final(p);
    } else {
      const int l = ph / NPH_LAYER, sub = ph % NPH_LAYER;
      switch (sub) {
        case 0: if (PHM & (1<<0)) run_phase<0>(p, l, smem); break;
        case 1: if (PHM & (1<<1)) run_phase<1>(p, l, smem); break;
        case 2: if (PHM & (1<<2)) run_phase<2>(p, l, smem); break;
        case 3: if (PHM & (1<<3)) run_phase<3>(p, l, smem); break;
        case 4: if (PHM & (1<<4)) run_phase<4>(p, l, smem); break;
        case 5: if (PHM & (1<<5)) run_phase<5>(p, l, smem); break;
        case 6: if (PHM & (1<<6)) run_phase<6>(p, l, smem); break;
        case 7: if (PHM & (1<<7)) run_phase<7>(p, l, smem); break;
        case 8: if (PHM & (1<<8)) run_phase<8>(p, l, smem); break;
        case 9: if (PHM & (1<<9)) run_phase<9>(p, l, smem); break;
      }
    }
    if (ph + 1 < ph1) grid.sync();
  }
}
#else
template <int SUB>
__global__ void __launch_bounds__(256, 2) k_phase(Params p, int l) {
  __shared__ __attribute__((aligned(16))) char smem[65536];
  run_phase<SUB>(p, l, smem);
}
#endif

extern "C" void kernel_launch(void* const* d_in, const int* in_sizes, int n_in, void* d_out, int out_size, void* d_ws,
                              size_t ws_size, hipStream_t stream) {
  if (n_in < 41 || ws_size < WS_NEED) {
    fprintf(stderr, "kernel_launch: bad args n_in=%d ws=%zu need=%zu\n", n_in, ws_size, (size_t)WS_NEED);
    return;
  }
  Params p{};
  for (int i = 0; i < 41; ++i) p.in[i] = (const float*)d_in[i];
  p.out = (float*)d_out;
  p.ws = (char*)d_ws;
#if COOP
  static int grid_blocks = 0;
  if (!grid_blocks) {
    int dev = 0, cus = 0, per_cu = 0;
    hipGetDevice(&dev);
    hipDeviceGetAttribute(&cus, hipDeviceAttributeMultiprocessorCount, dev);
    hipOccupancyMaxActiveBlocksPerMultiprocessor(&per_cu, fwd_kernel, 256, 0);
    if (per_cu > 2) per_cu = 2;
    grid_blocks = cus * per_cu;
  }
#ifdef HYBRID
  for (int ph = 0; ph < NPHASES; ++ph) fwd_kernel<<<grid_blocks, 256, 0, stream>>>(p, ph, ph + 1);
#else
  int ph0 = 0, ph1 = NPHASES;
  void* args[] = {&p, &ph0, &ph1};
  hipError_t e = hipLaunchCooperativeKernel((void*)fwd_kernel, dim3(grid_blocks), dim3(256), args, 0, stream);
  if (e != hipSuccess) fprintf(stderr, "cooperative launch failed: %s (grid %d)\n", hipGetErrorString(e), grid_blocks);
#endif
#else
  const dim3 g(512), b(256);
  for (int l = 0; l < 2; ++l) {
    k_phase<0><<<g, b, 0, stream>>>(p, l);
    k_phase<1><<<g, b, 0, stream>>>(p, l);
    k_phase<2><<<g, b, 0, stream>>>(p, l);
    k_phase<3><<<g, b, 0, stream>>>(p, l);
    k_phase<4><<<g, b, 0, stream>>>(p, l);
    k_phase<5><<<g, b, 0, stream>>>(p, l);
    k_phase<6><<<g, b, 0, stream>>>(p, l);
    k_phase<7><<<g, b, 0, stream>>>(p, l);
    k_phase<8><<<g, b, 0, stream>>>(p, l);
    k_phase<9><<<g, b, 0, stream>>>(p, l);
  }
  k_phase<10><<<g, b, 0, stream>>>(p, 0);
#endif
}
```

```cpp
#include <hip/hip_runtime.h>
#include <hip/hip_cooperative_groups.h>
#include <cstdio>
#include <cstdint>
namespace cg = cooperative_groups;

#ifndef COOP
#define COOP 1
#endif

typedef unsigned short bf16_t;
typedef __attribute__((ext_vector_type(8))) short bf16x8;
typedef __attribute__((ext_vector_type(4))) float f32x4;
typedef __attribute__((ext_vector_type(4))) unsigned u32x4;

constexpr int T_TOK = 16384, SEQ = 2048, DM = 1024;
constexpr int IN_COLS = 9992, NZ = 5896, ZS = 5904;
constexpr int ZHG = 0, ZRW = 2048, ZS5 = 3840, ZMB = 4352;
constexpr int FFH = 2816;
constexpr int NPH_LAYER = 10, NPHASES = 21;

constexpr size_t OFF_WTIN   = 0;
constexpr size_t OFF_WTGATE = OFF_WTIN + (size_t)5896 * 1024 * 2;
constexpr size_t OFF_WTBR   = OFF_WTGATE + (size_t)4096 * 1024 * 2;
constexpr size_t OFF_WTOUT  = OFF_WTBR + (size_t)4 * 1024 * 512 * 2;
constexpr size_t OFF_WTF1   = OFF_WTOUT + (size_t)1024 * 1024 * 2;
constexpr size_t OFF_WTF2   = OFF_WTF1 + (size_t)5632 * 1024 * 2;
constexpr size_t OFF_WTGLU  = OFF_WTF2 + (size_t)1024 * 2816 * 2;
constexpr size_t OFF_U      = OFF_WTGLU + (size_t)512 * 512 * 2;
constexpr size_t OFF_Z      = OFF_U + (size_t)T_TOK * 1024 * 2;
constexpr size_t OFF_VF     = OFF_Z + (size_t)T_TOK * ZS * 2;
constexpr size_t OFF_BAR    = OFF_VF + (size_t)T_TOK * 512 * 2;
constexpr size_t WS_NEED    = OFF_BAR + 256;

struct Params {
  const float* in[41];
  float* out;
  char* ws;
};

enum { I_X = 0, I_NORM_MIX, I_W_IN, I_W_BRANCH, I_W_OUT, I_NORM_FFN, I_W_FFN_IN, I_W_FFN_OUT, I_NORM_FINAL,
       I_HG_LB, I_HG_NW, I_RW_MU, I_RW_W0, I_RW_W2, I_RW_A0, I_RW_A2, I_RW_G2, I_RW_KK, I_RW_KA, I_RW_RK,
       I_RW_LNW, I_RW_LNB, I_RW_V0, I_RW_V1, I_RW_V2, I_S5_ARE, I_S5_AIM, I_S5_BRE, I_S5_BIM, I_S5_CRE,
       I_S5_CIM, I_S5_D, I_S5_LOGDT, I_S5_WGLU, I_S5_BGLU, I_MB_CONVW, I_MB_CONVB, I_MB_DTB, I_MB_ALOG,
       I_MB_D, I_MB_NW };

__device__ __forceinline__ float bf2f(bf16_t v) { return __uint_as_float(((unsigned)v) << 16); }
__device__ __forceinline__ bf16_t f2bf(float f) {
  unsigned u = __float_as_uint(f);
  u += 0x7fffu + ((u >> 16) & 1u);
  return (bf16_t)(u >> 16);
}
__device__ __forceinline__ unsigned pack2(float a, float b) { return (unsigned)f2bf(a) | ((unsigned)f2bf(b) << 16); }
__device__ __forceinline__ float sigmoidf_(float x) { return 1.f / (1.f + __expf(-x)); }
__device__ __forceinline__ float siluf_(float x) { return x / (1.f + __expf(-x)); }
__device__ __forceinline__ float softplusf_(float x) { return x > 20.f ? x : log1pf(__expf(x)); }
__device__ __forceinline__ float gelu_tanh(float x) {
  float u = 0.7978845608028654f * (x + 0.044715f * x * x * x);
  return 0.5f * x * (1.f + tanhf(u));
}
__device__ __forceinline__ float quad_sum(float x) {
  x += __builtin_bit_cast(float, __builtin_amdgcn_update_dpp(0, __builtin_bit_cast(int, x), 0xB1, 0xF, 0xF, true));
  x += __builtin_bit_cast(float, __builtin_amdgcn_update_dpp(0, __builtin_bit_cast(int, x), 0x4E, 0xF, 0xF, true));
  return x;
}
__device__ __forceinline__ float sum16(float x) {
  x += __shfl_xor(x, 1); x += __shfl_xor(x, 2); x += __shfl_xor(x, 4); x += __shfl_xor(x, 8);
  return x;
}
__device__ __forceinline__ float sum64(float x) {
  x = sum16(x); x += __shfl_xor(x, 16); x += __shfl_xor(x, 32);
  return x;
}

__device__ __forceinline__ int opaque_tid() {
  int t = threadIdx.x;
  asm volatile("" : "+v"(t));
  return t;
}

template <int BN>
__device__ __forceinline__ void gemm_mainloop(f32x4 (&acc)[4][BN / 32], const bf16_t* A, int lda, int m0,
                                              const bf16_t* Bt, int ldb, int n0, int nmax, int K, char* smem, const int tid) {
  const int lane = tid & 63, wid = tid >> 6, wm = wid >> 1, wn = wid & 1;
  const int q = tid & 7, r0 = tid >> 3;
  unsigned offA[4], offB[BN / 32];
#pragma unroll
  for (int i = 0; i < 4; ++i) offA[i] = ((unsigned)(m0 + r0 + 32 * i) * (unsigned)lda + (unsigned)q * 8u) * 2u;
#pragma unroll
  for (int i = 0; i < BN / 32; ++i) {
    int row = n0 + r0 + 32 * i;
    row = row < nmax ? row : nmax;
    offB[i] = ((unsigned)row * (unsigned)ldb + (unsigned)q * 8u) * 2u;
  }
  const unsigned sto = (unsigned)r0 * 128u + (unsigned)((q ^ ((r0 >> 1) & 7)) << 4);
  unsigned aoff[4], boff[BN / 32];
#pragma unroll
  for (int mi = 0; mi < 4; ++mi) {
    int row = wm * 64 + mi * 16 + (lane & 15);
    aoff[mi] = (unsigned)row * 128u + (unsigned)(((lane >> 4) ^ ((row >> 1) & 7)) << 4);
  }
#pragma unroll
  for (int ni = 0; ni < BN / 32; ++ni) {
    int row = wn * (BN / 2) + ni * 16 + (lane & 15);
    boff[ni] = (unsigned)row * 128u + (unsigned)(((lane >> 4) ^ ((row >> 1) & 7)) << 4);
  }
  const char* Ab = reinterpret_cast<const char*>(A);
  const char* Bb = reinterpret_cast<const char*>(Bt);
  const int nk = K >> 6;
  constexpr bool WIDE = (BN == 128);
  u32x4 ra0, ra1, ra2, ra3, rb0, rb1, rb2, rb3;
#define GLOAD_ALL()                                                        \
  ra0 = *reinterpret_cast<const u32x4*>(Ab + offA[0]);                     \
  ra1 = *reinterpret_cast<const u32x4*>(Ab + offA[1]);                     \
  ra2 = *reinterpret_cast<const u32x4*>(Ab + offA[2]);                     \
  ra3 = *reinterpret_cast<const u32x4*>(Ab + offA[3]);                     \
  rb0 = *reinterpret_cast<const u32x4*>(Bb + offB[0]);                     \
  rb1 = *reinterpret_cast<const u32x4*>(Bb + offB[1]);                     \
  if (WIDE) {                                                              \
    rb2 = *reinterpret_cast<const u32x4*>(Bb + offB[BN / 32 - 2]);         \
    rb3 = *reinterpret_cast<const u32x4*>(Bb + offB[BN / 32 - 1]);         \
  }
#define SSTORE_ALL(AD, BD)                                                 \
  *reinterpret_cast<u32x4*>((AD)) = ra0;                                   \
  *reinterpret_cast<u32x4*>((AD) + 4096) = ra1;                            \
  *reinterpret_cast<u32x4*>((AD) + 8192) = ra2;                            \
  *reinterpret_cast<u32x4*>((AD) + 12288) = ra3;                           \
  *reinterpret_cast<u32x4*>((BD)) = rb0;                                   \
  *reinterpret_cast<u32x4*>((BD) + 4096) = rb1;                            \
  if (WIDE) {                                                              \
    *reinterpret_cast<u32x4*>((BD) + 8192) = rb2;                          \
    *reinterpret_cast<u32x4*>((BD) + 12288) = rb3;                         \
  }
  GLOAD_ALL();
  SSTORE_ALL(smem + sto, smem + 32768 + sto);
  __syncthreads();
#pragma unroll 1
  for (int kt = 0; kt < nk; ++kt) {
    const int buf = kt & 1;
    const bool more = (kt + 1 < nk);
    if (more) {
      Ab += 128; Bb += 128;
      GLOAD_ALL();
    }
    __builtin_amdgcn_sched_barrier(0);
    const char* a_s = smem + buf * 16384;
    const char* b_s = smem + 32768 + buf * (BN * 128);
#pragma unroll
    for (int ks = 0; ks < 2; ++ks) {
      bf16x8 af[4], bfr[BN / 32];
#pragma unroll
      for (int mi = 0; mi < 4; ++mi) af[mi] = *reinterpret_cast<const bf16x8*>(a_s + (aoff[mi] ^ (ks * 64)));
#pragma unroll
      for (int ni = 0; ni < BN / 32; ++ni) bfr[ni] = *reinterpret_cast<const bf16x8*>(b_s + (boff[ni] ^ (ks * 64)));
#pragma unroll
      for (int mi = 0; mi < 4; ++mi)
#pragma unroll
        for (int ni = 0; ni < BN / 32; ++ni)
          acc[mi][ni] = __builtin_amdgcn_mfma_f32_16x16x32_bf16(bfr[ni], af[mi], acc[mi][ni], 0, 0, 0);
    }
    __builtin_amdgcn_sched_barrier(0);
    if (more) {
      char* a_d = smem + (buf ^ 1) * 16384 + sto;
      char* b_d = smem + 32768 + (buf ^ 1) * (BN * 128) + sto;
      SSTORE_ALL(a_d, b_d);
    }
    __syncthreads();
  }
#undef GLOAD_ALL
#undef SSTORE_ALL
}

template <int BN>
__device__ __forceinline__ void zero_acc(f32x4 (&acc)[4][BN / 32]) {
#pragma unroll
  for (int mi = 0; mi < 4; ++mi)
#pragma unroll
    for (int ni = 0; ni < BN / 32; ++ni) acc[mi][ni] = f32x4{0.f, 0.f, 0.f, 0.f};
}

__device__ __forceinline__ void conv_tile(const float* src, int ld, int nlimit, int k0, int n0, bf16_t* dst, int Kd, int mode,
                                          char* smem, const int tid) {
  float* sT = reinterpret_cast<float*>(smem);
#pragma unroll
  for (int i = 0; i < 16; ++i) {
    int kk = i * 4 + (tid >> 6), nn = tid & 63;
    float v = (n0 + nn < nlimit) ? src[(size_t)(k0 + kk) * ld + n0 + nn] : 0.f;
    sT[kk * 65 + nn] = v;
  }
  __syncthreads();
  {
    int nn = tid >> 2, kq = tid & 3;
    int n = n0 + nn;
    if (n < nlimit) {
      int drow = n;
      if (mode == 1) {
        if (n < FFH) drow = (n >> 4) * 32 + (n & 15);
        else { int j = n - FFH; drow = (j >> 4) * 32 + 16 + (j & 15); }
      }
      unsigned pk[8];
#pragma unroll
      for (int j = 0; j < 8; ++j) pk[j] = pack2(sT[(kq * 16 + 2 * j) * 65 + nn], sT[(kq * 16 + 2 * j + 1) * 65 + nn]);
      uint4* d = reinterpret_cast<uint4*>(dst + (size_t)drow * Kd + k0 + kq * 16);
      d[0] = uint4{pk[0], pk[1], pk[2], pk[3]};
      d[1] = uint4{pk[4], pk[5], pk[6], pk[7]};
    }
  }
  __syncthreads();
}

__device__ __forceinline__ void rmsnorm_row_to_bf16(const float* x, const float* w, bf16_t* out, const int lane) {
  float4 v[4];
  float ss = 0.f;
#pragma unroll
  for (int i = 0; i < 4; ++i) {
    v[i] = *reinterpret_cast<const float4*>(x + i * 256 + lane * 4);
    ss += v[i].x * v[i].x + v[i].y * v[i].y + v[i].z * v[i].z + v[i].w * v[i].w;
  }
  ss = sum64(ss);
  float rstd = rsqrtf(ss * (1.f / 1024.f) + 1e-6f);
#pragma unroll
  for (int i = 0; i < 4; ++i) {
    float4 ww = *reinterpret_cast<const float4*>(w + i * 256 + lane * 4);
    uint2 o;
    o.x = pack2(v[i].x * rstd * ww.x, v[i].y * rstd * ww.y);
    o.y = pack2(v[i].z * rstd * ww.z, v[i].w * rstd * ww.w);
    *reinterpret_cast<uint2*>(out + i * 256 + lane * 4) = o;
  }
}

constexpr int CT_IN = 157 * 16, CT_BR = 512, CT_OUT = 256, CT_F1 = 88 * 16, CT_F2 = 44 * 16, CT_GLU = 64;
constexpr int CT_TOTAL = CT_IN + CT_BR + CT_OUT + CT_F1 + CT_F2 + CT_GLU;

__device__ void phase_convert_norm(const Params& p, int l, char* smem) {
  const int tid = opaque_tid();
  char* ws = p.ws;
  const int ntask = CT_TOTAL + T_TOK / 4;
  const float* xsrc = (l == 0) ? p.in[I_X] : p.out;
  for (int t = blockIdx.x; t < ntask; t += gridDim.x) {
    if (t < CT_TOTAL) {
      int c = t;
      if (c < CT_IN) {
        int nt = c >> 4, kt = c & 15;
        const float* src = p.in[I_W_IN] + (size_t)l * 1024 * IN_COLS;
        if (nt < 64) conv_tile(src, IN_COLS, IN_COLS, kt * 64, nt * 64, (bf16_t*)(ws + OFF_WTGATE), 1024, 0, smem, tid);
        else conv_tile(src + 4096, IN_COLS, IN_COLS - 4096, kt * 64, (nt - 64) * 64, (bf16_t*)(ws + OFF_WTIN), 1024, 0, smem, tid);
        continue;
      }
      c -= CT_IN;
      if (c < CT_BR) {
        int kb = c >> 7, r = c & 127, nt = r >> 3, kt = r & 7;
        const float* src = p.in[I_W_BRANCH] + ((size_t)l * 4 + kb) * 512 * 1024;
        conv_tile(src, 1024, 1024, kt * 64, nt * 64, (bf16_t*)(ws + OFF_WTBR) + (size_t)kb * 1024 * 512, 512, 0, smem, tid);
        continue;
      }
      c -= CT_BR;
      if (c < CT_OUT) {
        int nt = c >> 4, kt = c & 15;
        conv_tile(p.in[I_W_OUT] + (size_t)l * 1024 * 1024, 1024, 1024, kt * 64, nt * 64, (bf16_t*)(ws + OFF_WTOUT), 1024, 0, smem, tid);
        continue;
      }
      c -= CT_OUT;
      if (c < CT_F1) {
        int nt = c >> 4, kt = c & 15;
        conv_tile(p.in[I_W_FFN_IN] + (size_t)l * 1024 * 5632, 5632, 5632, kt * 64, nt * 64, (bf16_t*)(ws + OFF_WTF1), 1024, 1, smem, tid);
        continue;
      }
      c -= CT_F1;
      if (c < CT_F2) {
        int nt = c / 44, kt = c % 44;
        conv_tile(p.in[I_W_FFN_OUT] + (size_t)l * FFH * 1024, 1024, 1024, kt * 64, nt * 64, (bf16_t*)(ws + OFF_WTF2), FFH, 0, smem, tid);
        continue;
      }
      c -= CT_F2;
      {
        int nt = c >> 3, kt = c & 7;
        conv_tile(p.in[I_S5_WGLU] + (size_t)l * 512 * 512, 512, 512, kt * 64, nt * 64, (bf16_t*)(ws + OFF_WTGLU), 512, 0, smem, tid);
      }
    } else {
      int row = (t - CT_TOTAL) * 4 + (tid >> 6);
      rmsnorm_row_to_bf16(xsrc + (size_t)row * DM, p.in[I_NORM_MIX] + l * DM, (bf16_t*)(ws + OFF_U) + (size_t)row * DM, tid & 63);
    }
  }
}

__device__ void phase_norm_only(const Params& p, const float* xsrc, const float* w) {
  const int tid = opaque_tid();
  for (int t = blockIdx.x; t < T_TOK / 4; t += gridDim.x) {
    int row = t * 4 + (tid >> 6);
    rmsnorm_row_to_bf16(xsrc + (size_t)row * DM, w, (bf16_t*)(p.ws + OFF_U) + (size_t)row * DM, tid & 63);
  }
}

__device__ void phase_inproj(const Params& p, char* smem) {
  const bf16_t* U = (const bf16_t*)(p.ws + OFF_U);
  const bf16_t* Wt = (const bf16_t*)(p.ws + OFF_WTIN);
  bf16_t* Z = (bf16_t*)(p.ws + OFF_Z);
  const int tid = opaque_tid();
  const int lane = tid & 63, wid = tid >> 6, wm = wid >> 1, wn = wid & 1;
  constexpr int NT = 47;
  for (int t = blockIdx.x; t < 128 * NT; t += gridDim.x) {
    int mt = t / NT, nt = t % NT;
    f32x4 acc[4][4];
    zero_acc<128>(acc);
    gemm_mainloop<128>(acc, U, 1024, mt * 128, Wt, 1024, nt * 128, NZ - 1, 1024, smem, tid);
#pragma unroll
    for (int mi = 0; mi < 4; ++mi)
#pragma unroll
      for (int ni = 0; ni < 4; ++ni) {
        int col = nt * 128 + wn * 64 + ni * 16 + (lane >> 4) * 4;
        int row = mt * 128 + wm * 64 + mi * 16 + (lane & 15);
        if (col < NZ) {
          uint2 o;
          o.x = pack2(acc[mi][ni][0], acc[mi][ni][1]);
          o.y = pack2(acc[mi][ni][2], acc[mi][ni][3]);
          *reinterpret_cast<uint2*>(Z + (size_t)row * ZS + col) = o;
        }
      }
  }
}

template <int J>
__device__ __forceinline__ void lora_mm(const float* sIn, const float* W, float (&a0)[16], float (&a1)[16], const int tid) {
#pragma unroll
  for (int i = 0; i < 16; ++i) { a0[i] = 0.f; a1[i] = 0.f; }
#pragma unroll 2
  for (int j = 0; j < J; ++j) {
    float w0 = W[j * 512 + tid], w1 = W[j * 512 + tid + 256];
    const float4* x4 = reinterpret_cast<const float4*>(sIn + j * 16);
#pragma unroll
    for (int q = 0; q < 4; ++q) {
      float4 x = x4[q];
      a0[q * 4 + 0] = fmaf(w0, x.x, a0[q * 4 + 0]); a1[q * 4 + 0] = fmaf(w1, x.x, a1[q * 4 + 0]);
      a0[q * 4 + 1] = fmaf(w0, x.y, a0[q * 4 + 1]); a1[q * 4 + 1] = fmaf(w1, x.y, a1[q * 4 + 1]);
      a0[q * 4 + 2] = fmaf(w0, x.z, a0[q * 4 + 2]); a1[q * 4 + 2] = fmaf(w1, x.z, a1[q * 4 + 2]);
      a0[q * 4 + 3] = fmaf(w0, x.w, a0[q * 4 + 3]); a1[q * 4 + 3] = fmaf(w1, x.w, a1[q * 4 + 3]);
    }
  }
}

__device__ __forceinline__ float rw_shift(const bf16_t* Z, int row, int s, int rc, float mu) {
  float cur = bf2f(Z[(size_t)row * ZS + ZRW + rc]);
  float prev = (s > 0) ? bf2f(Z[(size_t)(row - 1) * ZS + ZRW + rc]) : 0.f;
  return cur + (prev - cur) * mu;
}

__device__ void phase_rwprep(const Params& p, int l, char* smem) {
  const bf16_t* Z = (const bf16_t*)(p.ws + OFF_Z);
  bf16_t* LW = (bf16_t*)(p.ws + OFF_U);
  bf16_t* LA = LW + (size_t)T_TOK * 512;
  bf16_t* VF = (bf16_t*)(p.ws + OFF_VF);
  float* sXw = reinterpret_cast<float*>(smem);
  float* sXa = sXw + 64 * 16;
  float* sTmp = sXa + 64 * 16;
  float* sZv = sTmp + 32 * 16;
  const float* mu = p.in[I_RW_MU] + l * 1792;
  const int tid = opaque_tid();
  for (int t = blockIdx.x; t < T_TOK / 16; t += gridDim.x) {
    const int row0 = t * 16;
    for (int e = tid; e < 2048; e += 256) {
      int which = e >> 10, r = e & 1023, j = r >> 4, tok = r & 15;
      int row = row0 + tok, s = row & (SEQ - 1);
      int rc = 1536 + which * 64 + j;
      float z = rw_shift(Z, row, s, rc, mu[rc]);
      if (which == 0) sXw[j * 16 + tok] = tanhf(z); else sXa[j * 16 + tok] = z;
    }
    float zv0[16], zv1[16];
    {
      float m0 = mu[1024 + tid], m1 = mu[1024 + tid + 256];
#pragma unroll
      for (int tok = 0; tok < 16; ++tok) {
        int row = row0 + tok, s = row & (SEQ - 1);
        zv0[tok] = rw_shift(Z, row, s, 1024 + tid, m0);
        zv1[tok] = rw_shift(Z, row, s, 1024 + tid + 256, m1);
      }
    }
    if (l > 0) {
#pragma unroll
      for (int tok = 0; tok < 16; ++tok) { sZv[tid * 16 + tok] = zv0[tok]; sZv[(tid + 256) * 16 + tok] = zv1[tok]; }
    }
    __syncthreads();
    float a0[16], a1[16];
    lora_mm<64>(sXw, p.in[I_RW_W2] + (size_t)l * 64 * 512, a0, a1, tid);
#pragma unroll
    for (int tok = 0; tok < 16; ++tok) {
      LW[(size_t)(row0 + tok) * 512 + tid] = f2bf(a0[tok]);
      LW[(size_t)(row0 + tok) * 512 + tid + 256] = f2bf(a1[tok]);
    }
    lora_mm<64>(sXa, p.in[I_RW_A2] + (size_t)l * 64 * 512, a0, a1, tid);
#pragma unroll
    for (int tok = 0; tok < 16; ++tok) {
      LA[(size_t)(row0 + tok) * 512 + tid] = f2bf(a0[tok]);
      LA[(size_t)(row0 + tok) * 512 + tid + 256] = f2bf(a1[tok]);
    }
    if (l == 0) {
#pragma unroll
      for (int tok = 0; tok < 16; ++tok) {
        VF[(size_t)(row0 + tok) * 512 + tid] = f2bf(zv0[tok]);
        VF[(size_t)(row0 + tok) * 512 + tid + 256] = f2bf(zv1[tok]);
      }
    } else {
      const float* v1 = p.in[I_RW_V1] + (size_t)(l - 1) * 512 * 32;
      const float* v2 = p.in[I_RW_V2] + (size_t)(l - 1) * 32 * 512;
      const float* v0 = p.in[I_RW_V0] + (size_t)(l - 1) * 512;
      {
        int r = tid & 31, tg = tid >> 5;
        float t0 = 0.f, t1 = 0.f;
#pragma unroll 4
        for (int c = 0; c < 512; ++c) {
          float w = v1[c * 32 + r];
          float2 x = *reinterpret_cast<const float2*>(sZv + c * 16 + tg * 2);
          t0 = fmaf(w, x.x, t0); t1 = fmaf(w, x.y, t1);
        }
        sTmp[r * 16 + tg * 2] = t0; sTmp[r * 16 + tg * 2 + 1] = t1;
      }
      __syncthreads();
      lora_mm<32>(sTmp, v2, a0, a1, tid);
      float b0 = v0[tid], b1 = v0[tid + 256];
#pragma unroll
      for (int tok = 0; tok < 16; ++tok) {
        size_t i0 = (size_t)(row0 + tok) * 512 + tid;
        float vf0 = bf2f(VF[i0]), vf1 = bf2f(VF[i0 + 256]);
        VF[i0] = f2bf(zv0[tok] + (vf0 - zv0[tok]) * sigmoidf_(b0 + a0[tok]));
        VF[i0 + 256] = f2bf(zv1[tok] + (vf1 - zv1[tok]) * sigmoidf_(b1 + a1[tok]));
      }
    }
    __syncthreads();
  }
}

__device__ __forceinline__ float frcp(float x) { return __builtin_amdgcn_rcpf(x); }
__device__ __forceinline__ float fsigmoid(float x) { return frcp(1.f + __expf(-x)); }
__device__ __forceinline__ float fsilu(float x) { return x * frcp(1.f + __expf(-x)); }
__device__ __forceinline__ float fsoftplus(float x) { return x > 20.f ? x : __logf(1.f + __expf(x)); }
__device__ __forceinline__ float ftanh(float x) {
  float e = __expf(2.f * fminf(fmaxf(x, -15.f), 15.f));
  return (e - 1.f) * frcp(e + 1.f);
}
__device__ __forceinline__ float fgelu(float x) {
  float u = 0.7978845608028654f * (x + 0.044715f * x * x * x);
  return 0.5f * x * (1.f + ftanh(u));
}

__device__ void hg_scan(const Params& p, int l, int task, char* smem) {
  const int b = task >> 3, h = (task >> 1) & 3, vg = task & 1;
  float* sFg = reinterpret_cast<float*>(smem);
  float* sQs = sFg + 16 * 128;
  float* sO = sQs + 16 * 128;
  float* sVv = sO + 4 * 16 * 64;
  const int tid = opaque_tid(), w = tid >> 6, lane = tid & 63;
  bf16_t* Z = (bf16_t*)(p.ws + OFF_Z) + (size_t)b * SEQ * ZS;
  const int ks = tid & 127;
  float lb = 0.f;
  if (l > 0) {
    float x0 = p.in[I_HG_LB][h * 128 + ks], x1 = p.in[I_HG_LB][512 + h * 128 + ks];
    float m = fmaxf(x0, x1), e0 = expf(x0 - m), e1 = expf(x1 - m);
    lb = e1 / (e0 + e1);
  }
  float s[32];
#pragma unroll
  for (int j = 0; j < 32; ++j) s[j] = 0.f;
  const int vcol = ZHG + 1024 + h * 128 + vg * 64;
  const int qcol = ZHG + h * 128 + ks;
  bf16_t rq0, rq1, rq2, rq3, rq4, rq5, rq6, rq7, rf0, rf1, rf2, rf3, rf4, rf5, rf6, rf7, rv0, rv1, rv2, rv3;
#define HG_LOAD(T0)                                                                                \
  {                                                                                                \
    const bf16_t* zb = Z + (size_t)((T0) + (tid >> 7)) * ZS + qcol;                                \
    rq0 = zb[0]; rf0 = zb[512]; zb += 2 * ZS; rq1 = zb[0]; rf1 = zb[512]; zb += 2 * ZS;            \
    rq2 = zb[0]; rf2 = zb[512]; zb += 2 * ZS; rq3 = zb[0]; rf3 = zb[512]; zb += 2 * ZS;            \
    rq4 = zb[0]; rf4 = zb[512]; zb += 2 * ZS; rq5 = zb[0]; rf5 = zb[512]; zb += 2 * ZS;            \
    rq6 = zb[0]; rf6 = zb[512]; zb += 2 * ZS; rq7 = zb[0]; rf7 = zb[512];                          \
    const bf16_t* zv = Z + (size_t)((T0) + w) * ZS + vcol + lane;                                  \
    rv0 = zv[0]; rv1 = zv[4 * ZS]; rv2 = zv[8 * ZS]; rv3 = zv[12 * ZS];                            \
  }
#define HG_PUT1(I, RQ, RF)                                                                         \
  {                                                                                                \
    int t = (tid >> 7) + 2 * (I);                                                                  \
    sFg[t * 128 + ks] = fmaxf(lb + (1.f - lb) * fsigmoid(bf2f(RF)), 1e-30f);                       \
    sQs[t * 128 + ks] = fsilu(bf2f(RQ));                                                           \
  }
#define HG_PROCESS()                                                                               \
  {                                                                                                \
    HG_PUT1(0, rq0, rf0) HG_PUT1(1, rq1, rf1) HG_PUT1(2, rq2, rf2) HG_PUT1(3, rq3, rf3)            \
    HG_PUT1(4, rq4, rf4) HG_PUT1(5, rq5, rf5) HG_PUT1(6, rq6, rf6) HG_PUT1(7, rq7, rf7)            \
    sVv[(w)*64 + lane] = bf2f(rv0); sVv[(w + 4) * 64 + lane] = bf2f(rv1);                          \
    sVv[(w + 8) * 64 + lane] = bf2f(rv2); sVv[(w + 12) * 64 + lane] = bf2f(rv3);                   \
  }
  HG_LOAD(0);
  HG_PROCESS();
  __syncthreads();
  constexpr int NCH = SEQ / 16;
#pragma unroll 1
  for (int c = 0; c < NCH; ++c) {
    const int t0 = c * 16;
    const int tn = (c + 1 < NCH) ? t0 + 16 : t0;
    HG_LOAD(tn);
    __builtin_amdgcn_sched_barrier(0);
#pragma unroll 2
    for (int t = 0; t < 16; ++t) {
      const float v = sVv[t * 64 + lane];
      float o = 0.f;
      const float4* f4p = reinterpret_cast<const float4*>(sFg + t * 128 + w * 32);
      const float4* q4p = reinterpret_cast<const float4*>(sQs + t * 128 + w * 32);
#pragma unroll
      for (int j4 = 0; j4 < 8; ++j4) {
        float4 f4 = f4p[j4], q4 = q4p[j4];
        float fg, kv;
        fg = f4.x; kv = fmaf(-fg, v, v); s[j4 * 4 + 0] = fmaf(s[j4 * 4 + 0], fg, kv); o = fmaf(q4.x, s[j4 * 4 + 0], o);
        fg = f4.y; kv = fmaf(-fg, v, v); s[j4 * 4 + 1] = fmaf(s[j4 * 4 + 1], fg, kv); o = fmaf(q4.y, s[j4 * 4 + 1], o);
        fg = f4.z; kv = fmaf(-fg, v, v); s[j4 * 4 + 2] = fmaf(s[j4 * 4 + 2], fg, kv); o = fmaf(q4.z, s[j4 * 4 + 2], o);
        fg = f4.w; kv = fmaf(-fg, v, v); s[j4 * 4 + 3] = fmaf(s[j4 * 4 + 3], fg, kv); o = fmaf(q4.w, s[j4 * 4 + 3], o);
      }
      sO[(w * 16 + t) * 64 + lane] = o;
    }
    __builtin_amdgcn_sched_barrier(0);
    __syncthreads();
    {
      int t = tid >> 4, v4 = (tid & 15) * 4;
      float4 a = *reinterpret_cast<const float4*>(sO + (0 * 16 + t) * 64 + v4);
      float4 bq = *reinterpret_cast<const float4*>(sO + (1 * 16 + t) * 64 + v4);
      float4 cq = *reinterpret_cast<const float4*>(sO + (2 * 16 + t) * 64 + v4);
      float4 d = *reinterpret_cast<const float4*>(sO + (3 * 16 + t) * 64 + v4);
      uint2 o;
      o.x = pack2(a.x + bq.x + cq.x + d.x, a.y + bq.y + cq.y + d.y);
      o.y = pack2(a.z + bq.z + cq.z + d.z, a.w + bq.w + cq.w + d.w);
      *reinterpret_cast<uint2*>(Z + (size_t)(t0 + t) * ZS + vcol + v4) = o;
    }
    HG_PROCESS();
    __syncthreads();
  }
#undef HG_LOAD
#undef HG_PUT1
#undef HG_PROCESS
}

__device__ void mb_scan(const Params& p, int l, int task, char* smem) {
  const int b = task >> 3, hd = task & 7, g = hd >> 2;
  float* sB = reinterpret_cast<float*>(smem);
  float* sC = sB + 16 * 128;
  float* sX = sC + 16 * 128;
  float* sDt = sX + 16 * 64;
  float* sDA = sDt + 16;
  float* sO = sDA + 16;
  const int tid = opaque_tid(), w = tid >> 6, lane = tid & 63;
  bf16_t* Z = (bf16_t*)(p.ws + OFF_Z) + (size_t)b * SEQ * ZS;
  const float* cw = p.in[I_MB_CONVW] + (size_t)l * 4 * 1024;
  const float* cb = p.in[I_MB_CONVB] + (size_t)l * 1024;
  int ci0, ci1;
  {
    int ch = tid;
    ci0 = (ch < 64) ? hd * 64 + ch : (ch < 192 ? 512 + g * 128 + (ch - 64) : 768 + g * 128 + (ch - 192));
    ci1 = 768 + g * 128 + 64 + (tid & 63);
  }
  float* dstA = (tid < 64) ? (sX + tid) : (tid < 192 ? (sB + (tid - 64)) : (sC + (tid - 192)));
  const int strideA = (tid < 64) ? 64 : 128;
  const float w0a = cw[ci0], w1a = cw[1024 + ci0], w2a = cw[2048 + ci0], w3a = cw[3072 + ci0], ba = cb[ci0];
  const float w0b = cw[ci1], w1b = cw[1024 + ci1], w2b = cw[2048 + ci1], w3b = cw[3072 + ci1], bb = cb[ci1];
  const float Aneg = -expf(p.in[I_MB_ALOG][l * 8 + hd]);
  const float dtb = p.in[I_MB_DTB][l * 8 + hd];
  const float Dsk = p.in[I_MB_D][l * 8 + hd];
  float s[32];
#pragma unroll
  for (int j = 0; j < 32; ++j) s[j] = 0.f;
  float pa1 = 0.f, pa2 = 0.f, pa3 = 0.f, pb1 = 0.f, pb2 = 0.f, pb3 = 0.f;
  const int xcol = ZMB + 512;
  const int rt = tid >> 4, rp4 = (tid & 15) * 4;
  bf16_t xa0, xa1, xa2, xa3, xa4, xa5, xa6, xa7, xa8, xa9, xa10, xa11, xa12, xa13, xa14, xa15;
  bf16_t xb0, xb1, xb2, xb3, xb4, xb5, xb6, xb7, xb8, xb9, xb10, xb11, xb12, xb13, xb14, xb15;
  bf16_t rdt;
  uint2 gcur, gnext;
#define MB_LOAD(T0)                                                                                 \
  {                                                                                                 \
    const bf16_t* za = Z + (size_t)(T0) * ZS + xcol + ci0;                                          \
    xa0 = za[0]; xa1 = za[ZS]; xa2 = za[2 * ZS]; xa3 = za[3 * ZS]; xa4 = za[4 * ZS]; xa5 = za[5 * ZS];        \
    xa6 = za[6 * ZS]; xa7 = za[7 * ZS]; xa8 = za[8 * ZS]; xa9 = za[9 * ZS]; xa10 = za[10 * ZS];     \
    xa11 = za[11 * ZS]; xa12 = za[12 * ZS]; xa13 = za[13 * ZS]; xa14 = za[14 * ZS]; xa15 = za[15 * ZS];       \
    if (tid < 64) {                                                                                 \
      const bf16_t* zb = Z + (size_t)(T0) * ZS + xcol + ci1;                                        \
      xb0 = zb[0]; xb1 = zb[ZS]; xb2 = zb[2 * ZS]; xb3 = zb[3 * ZS]; xb4 = zb[4 * ZS]; xb5 = zb[5 * ZS];      \
      xb6 = zb[6 * ZS]; xb7 = zb[7 * ZS]; xb8 = zb[8 * ZS]; xb9 = zb[9 * ZS]; xb10 = zb[10 * ZS];   \
      xb11 = zb[11 * ZS]; xb12 = zb[12 * ZS]; xb13 = zb[13 * ZS]; xb14 = zb[14 * ZS]; xb15 = zb[15 * ZS];     \
    }                                                                                               \
    rdt = Z[(size_t)((T0) + (tid & 15)) * ZS + ZMB + 1536 + hd];                                    \
    gnext = *reinterpret_cast<const uint2*>(Z + (size_t)((T0) + rt) * ZS + ZMB + hd * 64 + rp4);    \
  }
#define MB_CONV_A(T, XR)                                                                            \
  {                                                                                                 \
    float xv = bf2f(XR);                                                                            \
    dstA[(T)*strideA] = fsilu(ba + w0a * pa3 + w1a * pa2 + w2a * pa1 + w3a * xv);                   \
    pa3 = pa2; pa2 = pa1; pa1 = xv;                                                                 \
  }
#define MB_CONV_B(T, XR)                                                                            \
  {                                                                                                 \
    float xv = bf2f(XR);                                                                            \
    sC[(T)*128 + 64 + tid] = fsilu(bb + w0b * pb3 + w1b * pb2 + w2b * pb1 + w3b * xv);              \
    pb3 = pb2; pb2 = pb1; pb1 = xv;                                                                 \
  }
#define MB_PROCESS()                                                                                \
  {                                                                                                 \
    MB_CONV_A(0, xa0) MB_CONV_A(1, xa1) MB_CONV_A(2, xa2) MB_CONV_A(3, xa3) MB_CONV_A(4, xa4)       \
    MB_CONV_A(5, xa5) MB_CONV_A(6, xa6) MB_CONV_A(7, xa7) MB_CONV_A(8, xa8) MB_CONV_A(9, xa9)       \
    MB_CONV_A(10, xa10) MB_CONV_A(11, xa11) MB_CONV_A(12, xa12) MB_CONV_A(13, xa13)                 \
    MB_CONV_A(14, xa14) MB_CONV_A(15, xa15)                                                         \
    if (tid < 64) {                                                                                 \
      MB_CONV_B(0, xb0) MB_CONV_B(1, xb1) MB_CONV_B(2, xb2) MB_CONV_B(3, xb3) MB_CONV_B(4, xb4)     \
      MB_CONV_B(5, xb5) MB_CONV_B(6, xb6) MB_CONV_B(7, xb7) MB_CONV_B(8, xb8) MB_CONV_B(9, xb9)     \
      MB_CONV_B(10, xb10) MB_CONV_B(11, xb11) MB_CONV_B(12, xb12) MB_CONV_B(13, xb13)               \
      MB_CONV_B(14, xb14) MB_CONV_B(15, xb15)                                                       \
    }                                                                                               \
    if (tid < 16) {                                                                                 \
      float dt = fsoftplus(bf2f(rdt) + dtb);                                                        \
      sDt[tid] = dt;                                                                                \
      sDA[tid] = __expf(Aneg * dt);                                                                 \
    }                                                                                               \
    gcur = gnext;                                                                                   \
  }
  MB_LOAD(0);
  MB_PROCESS();
  __syncthreads();
  constexpr int NCH = SEQ / 16;
#pragma unroll 1
  for (int c = 0; c < NCH; ++c) {
    const int t0 = c * 16;
    const bool more = (c + 1 < NCH);
    const int tn = more ? t0 + 16 : t0;
    MB_LOAD(tn);
    __builtin_amdgcn_sched_barrier(0);
#pragma unroll 2
    for (int t = 0; t < 16; ++t) {
      const float dA = sDA[t];
      const float xdt = sX[t * 64 + lane] * sDt[t];
      float y = 0.f;
      const float4* b4p = reinterpret_cast<const float4*>(sB + t * 128 + w * 32);
      const float4* c4p = reinterpret_cast<const float4*>(sC + t * 128 + w * 32);
#pragma unroll
      for (int j4 = 0; j4 < 8; ++j4) {
        float4 b4 = b4p[j4], c4 = c4p[j4];
        s[j4 * 4 + 0] = fmaf(s[j4 * 4 + 0], dA, b4.x * xdt); y = fmaf(c4.x, s[j4 * 4 + 0], y);
        s[j4 * 4 + 1] = fmaf(s[j4 * 4 + 1], dA, b4.y * xdt); y = fmaf(c4.y, s[j4 * 4 + 1], y);
        s[j4 * 4 + 2] = fmaf(s[j4 * 4 + 2], dA, b4.z * xdt); y = fmaf(c4.z, s[j4 * 4 + 2], y);
        s[j4 * 4 + 3] = fmaf(s[j4 * 4 + 3], dA, b4.w * xdt); y = fmaf(c4.w, s[j4 * 4 + 3], y);
      }
      sO[(w * 16 + t) * 64 + lane] = y;
    }
    __builtin_amdgcn_sched_barrier(0);
    __syncthreads();
    {
      float4 a = *reinterpret_cast<const float4*>(sO + (0 * 16 + rt) * 64 + rp4);
      float4 bq = *reinterpret_cast<const float4*>(sO + (1 * 16 + rt) * 64 + rp4);
      float4 cq = *reinterpret_cast<const float4*>(sO + (2 * 16 + rt) * 64 + rp4);
      float4 d = *reinterpret_cast<const float4*>(sO + (3 * 16 + rt) * 64 + rp4);
      float4 xs = *reinterpret_cast<const float4*>(sX + rt * 64 + rp4);
      bf16_t* gp = Z + (size_t)(t0 + rt) * ZS + ZMB + hd * 64 + rp4;
      float g0 = bf2f((bf16_t)(gcur.x & 0xffff)), g1 = bf2f((bf16_t)(gcur.x >> 16));
      float g2 = bf2f((bf16_t)(gcur.y & 0xffff)), g3 = bf2f((bf16_t)(gcur.y >> 16));
      float y0 = a.x + bq.x + cq.x + d.x + Dsk * xs.x;
      float y1 = a.y + bq.y + cq.y + d.y + Dsk * xs.y;
      float y2 = a.z + bq.z + cq.z + d.z + Dsk * xs.z;
      float y3 = a.w + bq.w + cq.w + d.w + Dsk * xs.w;
      uint2 o;
      o.x = pack2(y0 * fsilu(g0), y1 * fsilu(g1));
      o.y = pack2(y2 * fsilu(g2), y3 * fsilu(g3));
      *reinterpret_cast<uint2*>(gp) = o;
    }
    __syncthreads();
    if (more) MB_PROCESS();
    __syncthreads();
  }
#undef MB_LOAD
#undef MB_CONV_A
#undef MB_CONV_B
#undef MB_PROCESS
}

__device__ void s5_scan(const Params& p, int l, int task, char* smem) {
  const int tid = opaque_tid(), w = tid >> 6, lane = tid & 63;
  const int b = task >> 3, g = (task & 7) * 4 + w;
  float* base = reinterpret_cast<float*>(smem) + w * 3264;
  float* sU = base;
  float* sH = sU + 128;
  float* sC = sH + 8 * 65 * 2;
  bf16_t* Z = (bf16_t*)(p.ws + OFF_Z) + (size_t)b * SEQ * ZS + ZS5 + g * 16;
  const int n = lane;
  float lr, li, bbr[16], bbi[16];
  {
    float dt = expf(p.in[I_S5_LOGDT][l * 32 + g]);
    float are = p.in[I_S5_ARE][(l * 32 + g) * 64 + n], aim = p.in[I_S5_AIM][(l * 32 + g) * 64 + n];
    float mag = expf(dt * are);
    lr = mag * cosf(dt * aim); li = mag * sinf(dt * aim);
    float den = are * are + aim * aim;
    float cr = ((lr - 1.f) * are + li * aim) / den;
    float ci = (li * are - (lr - 1.f) * aim) / den;
    const float* bre = p.in[I_S5_BRE] + ((size_t)(l * 32 + g) * 64 + n) * 16;
    const float* bim = p.in[I_S5_BIM] + ((size_t)(l * 32 + g) * 64 + n) * 16;
#pragma unroll
    for (int c = 0; c < 16; ++c) {
      float br = bre[c], bi = bim[c];
      bbr[c] = cr * br - ci * bi;
      bbi[c] = cr * bi + ci * br;
    }
    const float* cre = p.in[I_S5_CRE] + (size_t)(l * 32 + g) * 16 * 64;
    const float* cim = p.in[I_S5_CIM] + (size_t)(l * 32 + g) * 16 * 64;
#pragma unroll
    for (int cp = 0; cp < 8; ++cp) {
      float4 v;
      v.x = cre[(2 * cp) * 64 + n]; v.y = cre[(2 * cp + 1) * 64 + n];
      v.z = cim[(2 * cp) * 64 + n]; v.w = cim[(2 * cp + 1) * 64 + n];
      *reinterpret_cast<float4*>(sC + (n * 8 + cp) * 4) = v;
    }
  }
  const int ot = lane >> 3, ocp = lane & 7;
  const float d0 = p.in[I_S5_D][l * 512 + g * 16 + 2 * ocp], d1 = p.in[I_S5_D][l * 512 + g * 16 + 2 * ocp + 1];
  float hr = 0.f, hi = 0.f;
  unsigned unext = *reinterpret_cast<const unsigned*>(Z + (size_t)ot * ZS + 2 * ocp);
  constexpr int NCH = SEQ / 8;
#pragma unroll 1
  for (int c = 0; c < NCH; ++c) {
    const int t0 = c * 8;
    const unsigned uraw = unext;
    const float u0 = bf2f((bf16_t)(uraw & 0xffff)), u1 = bf2f((bf16_t)(uraw >> 16));
    *reinterpret_cast<float2*>(sU + ot * 16 + 2 * ocp) = float2{u0, u1};
    {
      const int tn = (c + 1 < NCH) ? t0 + 8 : t0;
      unext = *reinterpret_cast<const unsigned*>(Z + (size_t)(tn + ot) * ZS + 2 * ocp);
    }
    __builtin_amdgcn_sched_barrier(0);
    __syncthreads();
#pragma unroll 2
    for (int t = 0; t < 8; ++t) {
      const float4* u4 = reinterpret_cast<const float4*>(sU + t * 16);
      float bur = 0.f, bui = 0.f;
#pragma unroll
      for (int q = 0; q < 4; ++q) {
        float4 u = u4[q];
        bur = fmaf(bbr[q * 4 + 0], u.x, bur); bui = fmaf(bbi[q * 4 + 0], u.x, bui);
        bur = fmaf(bbr[q * 4 + 1], u.y, bur); bui = fmaf(bbi[q * 4 + 1], u.y, bui);
        bur = fmaf(bbr[q * 4 + 2], u.z, bur); bui = fmaf(bbi[q * 4 + 2], u.z, bui);
        bur = fmaf(bbr[q * 4 + 3], u.w, bur); bui = fmaf(bbi[q * 4 + 3], u.w, bui);
      }
      float nr = lr * hr - li * hi + bur;
      float ni = lr * hi + li * hr + bui;
      hr = nr; hi = ni;
      *reinterpret_cast<float2*>(sH + (t * 65 + n) * 2) = float2{hr, hi};
    }
    __syncthreads();
    {
      float y0 = 0.f, y1 = 0.f, y2 = 0.f, y3 = 0.f;
#pragma unroll 8
      for (int nn = 0; nn < 64; nn += 2) {
        float2 hh = *reinterpret_cast<const float2*>(sH + (ot * 65 + nn) * 2);
        float4 cc = *reinterpret_cast<const float4*>(sC + (nn * 8 + ocp) * 4);
        float2 hh2 = *reinterpret_cast<const float2*>(sH + (ot * 65 + nn + 1) * 2);
        float4 cc2 = *reinterpret_cast<const float4*>(sC + ((nn + 1) * 8 + ocp) * 4);
        y0 = fmaf(cc.x, hh.x, y0); y0 = fmaf(-cc.z, hh.y, y0);
        y1 = fmaf(cc.y, hh.x, y1); y1 = fmaf(-cc.w, hh.y, y1);
        y2 = fmaf(cc2.x, hh2.x, y2); y2 = fmaf(-cc2.z, hh2.y, y2);
        y3 = fmaf(cc2.y, hh2.x, y3); y3 = fmaf(-cc2.w, hh2.y, y3);
      }
      y0 = fgelu(y0 + y2 + d0 * u0);
      y1 = fgelu(y1 + y3 + d1 * u1);
      *reinterpret_cast<unsigned*>(Z + (size_t)(t0 + ot) * ZS + 2 * ocp) = pack2(y0, y1);
    }
    __syncthreads();
  }
}

__device__ void rw_scan(const Params& p, int l, int task, char* smem) {
  const int b = task >> 3, h = task & 7;
  float* sR = reinterpret_cast<float*>(smem);
  float* sW = sR + 1024;
  float* sK = sW + 1024;
  float* sA = sK + 1024;
  float* sBb = sA + 1024;
  float* sV = sBb + 1024;
  float* sY = sV + 1024;
  float* sBonus = sY + 1024;
  const int tid = opaque_tid(), w = tid >> 6, lane = tid & 63;
  const size_t tokbase = (size_t)b * SEQ;
  bf16_t* Z = (bf16_t*)(p.ws + OFF_Z) + tokbase * ZS;
  const bf16_t* LW = (const bf16_t*)(p.ws + OFF_U) + tokbase * 512;
  const bf16_t* LA = LW + (size_t)T_TOK * 512;
  const bf16_t* VF = (const bf16_t*)(p.ws + OFF_VF) + tokbase * 512;
  const int st = tid >> 4, c4 = (tid & 15) * 4, ch = h * 64 + c4;
  float mur[4], muk[4], w0[4], a0[4], kk_[4], ka_[4], rk_[4], lnw[4], lnb[4];
#pragma unroll
  for (int e = 0; e < 4; ++e) {
    mur[e] = p.in[I_RW_MU][l * 1792 + ch + e];
    muk[e] = p.in[I_RW_MU][l * 1792 + 512 + ch + e];
    w0[e] = p.in[I_RW_W0][l * 512 + ch + e];
    a0[e] = p.in[I_RW_A0][l * 512 + ch + e];
    kk_[e] = p.in[I_RW_KK][l * 512 + ch + e];
    ka_[e] = p.in[I_RW_KA][l * 512 + ch + e];
    rk_[e] = p.in[I_RW_RK][l * 512 + ch + e];
    lnw[e] = p.in[I_RW_LNW][l * 512 + ch + e];
    lnb[e] = p.in[I_RW_LNB][l * 512 + ch + e];
  }
  const int rl = lane >> 2, kq = lane & 3, vrow = w * 16 + rl;
  float S[16];
#pragma unroll
  for (int j = 0; j < 16; ++j) S[j] = 0.f;
  uint2 rc, kc, rp, kp, lwv, lav, vfv;
#define RW_LOAD(T0)                                                                                 \
  {                                                                                                 \
    const int s_ = (T0) + st;                                                                       \
    const bf16_t* zr = Z + (size_t)s_ * ZS + ZRW + ch;                                              \
    rc = *reinterpret_cast<const uint2*>(zr);                                                       \
    kc = *reinterpret_cast<const uint2*>(zr + 512);                                                 \
    rp = uint2{0u, 0u}; kp = uint2{0u, 0u};                                                         \
    if (s_ > 0) { rp = *reinterpret_cast<const uint2*>(zr - ZS); kp = *reinterpret_cast<const uint2*>(zr - ZS + 512); } \
    lwv = *reinterpret_cast<const uint2*>(LW + (size_t)s_ * 512 + ch);                              \
    lav = *reinterpret_cast<const uint2*>(LA + (size_t)s_ * 512 + ch);                              \
    vfv = *reinterpret_cast<const uint2*>(VF + (size_t)s_ * 512 + ch);                              \
  }
#define RW_PROCESS()                                                                                \
  {                                                                                                 \
    float r4[4], k4[4], kkv[4], av[4], wv[4], vv[4];                                                \
    float n2 = 0.f;                                                                                 \
    _Pragma("unroll") for (int e = 0; e < 4; ++e) {                                                 \
      unsigned rcw = (e < 2) ? rc.x : rc.y, kcw = (e < 2) ? kc.x : kc.y, rpw = (e < 2) ? rp.x : rp.y, kpw = (e < 2) ? kp.x : kp.y; \
      unsigned lww = (e < 2) ? lwv.x : lwv.y, law = (e < 2) ? lav.x : lav.y, vfw = (e < 2) ? vfv.x : vfv.y; \
      int sh = (e & 1) * 16;                                                                        \
      float rcur = bf2f((bf16_t)((rcw >> sh) & 0xffff)), rprev = bf2f((bf16_t)((rpw >> sh) & 0xffff)); \
      float kcur = bf2f((bf16_t)((kcw >> sh) & 0xffff)), kprev = bf2f((bf16_t)((kpw >> sh) & 0xffff)); \
      float lwf = bf2f((bf16_t)((lww >> sh) & 0xffff)), laf = bf2f((bf16_t)((law >> sh) & 0xffff)); \
      vv[e] = bf2f((bf16_t)((vfw >> sh) & 0xffff));                                                 \
      r4[e] = rcur + (rprev - rcur) * mur[e];                                                       \
      k4[e] = kcur + (kprev - kcur) * muk[e];                                                       \
      float wlog = -fsoftplus(-(w0[e] + lwf)) - 0.5f;                                               \
      wv[e] = __expf(-__expf(wlog));                                                                \
      av[e] = fsigmoid(a0[e] + laf);                                                                \
      kkv[e] = k4[e] * kk_[e];                                                                      \
      n2 += kkv[e] * kkv[e];                                                                        \
    }                                                                                               \
    n2 = sum16(n2);                                                                                 \
    float inv = 1.f / fmaxf(sqrtf(n2), 1e-12f);                                                     \
    float bon = 0.f;                                                                                \
    float kt4[4], ap4[4], bp4[4];                                                                   \
    _Pragma("unroll") for (int e = 0; e < 4; ++e) {                                                 \
      float kkn = kkv[e] * inv;                                                                     \
      kt4[e] = k4[e] * (1.f + (av[e] - 1.f) * ka_[e]);                                              \
      ap4[e] = -kkn;                                                                                \
      bp4[e] = kkn * av[e];                                                                         \
      bon += r4[e] * kt4[e] * rk_[e];                                                               \
    }                                                                                               \
    bon = sum16(bon);                                                                               \
    *reinterpret_cast<float4*>(sR + st * 64 + c4) = float4{r4[0], r4[1], r4[2], r4[3]};             \
    *reinterpret_cast<float4*>(sW + st * 64 + c4) = float4{wv[0], wv[1], wv[2], wv[3]};             \
    *reinterpret_cast<float4*>(sK + st * 64 + c4) = float4{kt4[0], kt4[1], kt4[2], kt4[3]};         \
    *reinterpret_cast<float4*>(sA + st * 64 + c4) = float4{ap4[0], ap4[1], ap4[2], ap4[3]};         \
    *reinterpret_cast<float4*>(sBb + st * 64 + c4) = float4{bp4[0], bp4[1], bp4[2], bp4[3]};        \
    *reinterpret_cast<float4*>(sV + st * 64 + c4) = float4{vv[0], vv[1], vv[2], vv[3]};             \
    if ((tid & 15) == 0) sBonus[st] = bon;                                                          \
  }
  RW_LOAD(0);
  RW_PROCESS();
  __syncthreads();
  constexpr int NCH = SEQ / 16;
#pragma unroll 1
  for (int c = 0; c < NCH; ++c) {
    const int t0 = c * 16;
    const int tn = (c + 1 < NCH) ? t0 + 16 : t0;
    RW_LOAD(tn);
    __builtin_amdgcn_sched_barrier(0);
#pragma unroll 2
    for (int t = 0; t < 16; ++t) {
      const float4* a4p = reinterpret_cast<const float4*>(sA + t * 64 + kq * 16);
      const float4* w4p = reinterpret_cast<const float4*>(sW + t * 64 + kq * 16);
      const float4* b4p = reinterpret_cast<const float4*>(sBb + t * 64 + kq * 16);
      const float4* k4p = reinterpret_cast<const float4*>(sK + t * 64 + kq * 16);
      const float4* r4p = reinterpret_cast<const float4*>(sR + t * 64 + kq * 16);
      const float vv = sV[t * 64 + vrow];
      float sa0 = 0.f, sa1 = 0.f;
#pragma unroll
      for (int q = 0; q < 4; ++q) {
        float4 a = a4p[q];
        sa0 = fmaf(S[q * 4 + 0], a.x, sa0); sa1 = fmaf(S[q * 4 + 1], a.y, sa1);
        sa0 = fmaf(S[q * 4 + 2], a.z, sa0); sa1 = fmaf(S[q * 4 + 3], a.w, sa1);
      }
      const float sa = quad_sum(sa0 + sa1);
      float y0 = 0.f, y1 = 0.f;
#pragma unroll
      for (int q = 0; q < 4; ++q) {
        float4 ww = w4p[q], bb = b4p[q], kk = k4p[q], rr = r4p[q];
        S[q * 4 + 0] = fmaf(S[q * 4 + 0], ww.x, fmaf(sa, bb.x, vv * kk.x)); y0 = fmaf(S[q * 4 + 0], rr.x, y0);
        S[q * 4 + 1] = fmaf(S[q * 4 + 1], ww.y, fmaf(sa, bb.y, vv * kk.y)); y1 = fmaf(S[q * 4 + 1], rr.y, y1);
        S[q * 4 + 2] = fmaf(S[q * 4 + 2], ww.z, fmaf(sa, bb.z, vv * kk.z)); y0 = fmaf(S[q * 4 + 2], rr.z, y0);
        S[q * 4 + 3] = fmaf(S[q * 4 + 3], ww.w, fmaf(sa, bb.w, vv * kk.w)); y1 = fmaf(S[q * 4 + 3], rr.w, y1);
      }
      const float y = quad_sum(y0 + y1);
      if (kq == 0) sY[t * 64 + vrow] = y;
    }
    __builtin_amdgcn_sched_barrier(0);
    __syncthreads();
    {
      float4 y4 = *reinterpret_cast<const float4*>(sY + st * 64 + c4);
      float4 v4 = *reinterpret_cast<const float4*>(sV + st * 64 + c4);
      float bon = sBonus[st];
      float mean = sum16(y4.x + y4.y + y4.z + y4.w) * (1.f / 64.f);
      float dx = y4.x - mean, dy = y4.y - mean, dz = y4.z - mean, dw = y4.w - mean;
      float var = sum16(dx * dx + dy * dy + dz * dz + dw * dw) * (1.f / 64.f);
      float rs = rsqrtf(var + 64e-5f);
      float o0 = dx * rs * lnw[0] + lnb[0] + bon * v4.x;
      float o1 = dy * rs * lnw[1] + lnb[1] + bon * v4.y;
      float o2 = dz * rs * lnw[2] + lnb[2] + bon * v4.z;
      float o3 = dw * rs * lnw[3] + lnb[3] + bon * v4.w;
      uint2 o;
      o.x = pack2(o0, o1); o.y = pack2(o2, o3);
      *reinterpret_cast<uint2*>(Z + (size_t)(t0 + st) * ZS + ZRW + 1024 + ch) = o;
    }
    RW_PROCESS();
    __syncthreads();
  }
#undef RW_LOAD
#undef RW_PROCESS
}

__device__ void phase_scans(const Params& p, int l, char* smem) {
  for (int t = blockIdx.x; t < 256; t += gridDim.x) {
    int type = t & 3, idx = t >> 2;
#ifndef SCM
#define SCM 15
#endif
    if (type == 0) { if (SCM & 1) rw_scan(p, l, idx, smem); }
    else if (type == 1) { if (SCM & 2) hg_scan(p, l, idx, smem); }
    else if (type == 2) { if (SCM & 4) mb_scan(p, l, idx, smem); }
    else { if (SCM & 8) s5_scan(p, l, idx, smem); }
    __syncthreads();
  }
}

__device__ __forceinline__ void unpack8(const uint4& v, float (&f)[8]) {
  f[0] = bf2f((bf16_t)(v.x & 0xffff)); f[1] = bf2f((bf16_t)(v.x >> 16));
  f[2] = bf2f((bf16_t)(v.y & 0xffff)); f[3] = bf2f((bf16_t)(v.y >> 16));
  f[4] = bf2f((bf16_t)(v.z & 0xffff)); f[5] = bf2f((bf16_t)(v.z >> 16));
  f[6] = bf2f((bf16_t)(v.w & 0xffff)); f[7] = bf2f((bf16_t)(v.w >> 16));
}

__device__ void phase_post(const Params& p, int l, char* smem) {
  bf16_t* Z = (bf16_t*)(p.ws + OFF_Z);
  const int tid = opaque_tid(), lane = tid & 63, wid = tid >> 6;
  constexpr int N_ROWT = T_TOK / 4, N_RWT = T_TOK / 16, N_GLU = 128 * 4, N_NORM = T_TOK / 4;
  const float* xsrc = (l == 0) ? p.in[I_X] : p.out;
  for (int t = blockIdx.x; t < N_ROWT + N_RWT + N_GLU + N_NORM; t += gridDim.x) {
    if (t < N_ROWT) {
      const int row = t * 4 + wid;
      {
        bf16_t* op = Z + (size_t)row * ZS + ZHG + 1024 + lane * 8;
        uint4 ov = *reinterpret_cast<const uint4*>(op);
        uint4 gv = *reinterpret_cast<const uint4*>(op + 512);
        float o[8], g[8];
        unpack8(ov, o); unpack8(gv, g);
        float ss = 0.f;
#pragma unroll
        for (int e = 0; e < 8; ++e) ss += o[e] * o[e];
        ss = sum16(ss);
        float rstd = rsqrtf(ss * (1.f / 128.f) + 1e-6f);
        const float* nw = p.in[I_HG_NW] + l * 512 + lane * 8;
        float r[8];
#pragma unroll
        for (int e = 0; e < 8; ++e) r[e] = o[e] * rstd * nw[e] * siluf_(g[e]);
        *reinterpret_cast<uint4*>(op) = uint4{pack2(r[0], r[1]), pack2(r[2], r[3]), pack2(r[4], r[5]), pack2(r[6], r[7])};
      }
      {
        bf16_t* op = Z + (size_t)row * ZS + ZMB + lane * 8;
        uint4 ov = *reinterpret_cast<const uint4*>(op);
        float o[8];
        unpack8(ov, o);
        float ss = 0.f;
#pragma unroll
        for (int e = 0; e < 8; ++e) ss += o[e] * o[e];
        ss = sum64(ss);
        float rstd = rsqrtf(ss * (1.f / 512.f) + 1e-6f);
        const float* nw = p.in[I_MB_NW] + l * 512 + lane * 8;
        float r[8];
#pragma unroll
        for (int e = 0; e < 8; ++e) r[e] = o[e] * rstd * nw[e];
        *reinterpret_cast<uint4*>(op) = uint4{pack2(r[0], r[1]), pack2(r[2], r[3]), pack2(r[4], r[5]), pack2(r[6], r[7])};
      }
    } else if (t < N_ROWT + N_RWT) {
      const int row0 = (t - N_ROWT) * 16;
      float* sXg = reinterpret_cast<float*>(smem);
      const float* mu = p.in[I_RW_MU] + l * 1792 + 1664;
      for (int e = tid; e < 2048; e += 256) {
        int j = e >> 4, tok = e & 15;
        int row = row0 + tok, s = row & (SEQ - 1);
        sXg[j * 16 + tok] = sigmoidf_(rw_shift(Z, row, s, 1664 + j, mu[j]));
      }
      __syncthreads();
      float a0[16], a1[16];
      lora_mm<128>(sXg, p.in[I_RW_G2] + (size_t)l * 128 * 512, a0, a1, tid);
#pragma unroll
      for (int tok = 0; tok < 16; ++tok) {
        bf16_t* yp = Z + (size_t)(row0 + tok) * ZS + ZRW + 1024 + tid;
        yp[0] = f2bf(bf2f(yp[0]) * a0[tok]);
        yp[256] = f2bf(bf2f(yp[256]) * a1[tok]);
      }
      __syncthreads();
    } else if (t < N_ROWT + N_RWT + N_GLU) {
      const int tt = t - N_ROWT - N_RWT, mt = tt >> 2, nt = tt & 3;
      const int wm = wid >> 1, wn = wid & 1;
      f32x4 acc[4][4];
      zero_acc<128>(acc);
      gemm_mainloop<128>(acc, Z + ZS5, ZS, mt * 128, (const bf16_t*)(p.ws + OFF_WTGLU), 512, nt * 128, 511, 512, smem, tid);
      const float* bg = p.in[I_S5_BGLU] + l * 512;
#pragma unroll
      for (int mi = 0; mi < 4; ++mi)
#pragma unroll
        for (int ni = 0; ni < 4; ++ni) {
          int col = nt * 128 + wn * 64 + ni * 16 + (lane >> 4) * 4;
          int row = mt * 128 + wm * 64 + mi * 16 + (lane & 15);
          float4 b4 = *reinterpret_cast<const float4*>(bg + col);
          uint2 yv = *reinterpret_cast<const uint2*>(Z + (size_t)row * ZS + ZS5 + col);
          float y0 = bf2f((bf16_t)(yv.x & 0xffff)), y1 = bf2f((bf16_t)(yv.x >> 16));
          float y2 = bf2f((bf16_t)(yv.y & 0xffff)), y3 = bf2f((bf16_t)(yv.y >> 16));
          uint2 o;
          o.x = pack2(y0 * sigmoidf_(acc[mi][ni][0] + b4.x), y1 * sigmoidf_(acc[mi][ni][1] + b4.y));
          o.y = pack2(y2 * sigmoidf_(acc[mi][ni][2] + b4.z), y3 * sigmoidf_(acc[mi][ni][3] + b4.w));
          *reinterpret_cast<uint2*>(Z + (size_t)row * ZS + ZMB + 1024 + col) = o;
        }
    } else {
      const int row = (t - N_ROWT - N_RWT - N_GLU) * 4 + wid;
      rmsnorm_row_to_bf16(xsrc + (size_t)row * DM, p.in[I_NORM_MIX] + l * DM, (bf16_t*)(p.ws + OFF_U) + (size_t)row * DM, tid & 63);
    }
  }
}

__device__ void phase_merge(const Params& p, char* smem) {
  bf16_t* Z = (bf16_t*)(p.ws + OFF_Z);
  const bf16_t* U = (const bf16_t*)(p.ws + OFF_U);
  const bf16_t* Wg = (const bf16_t*)(p.ws + OFF_WTGATE);
  const bf16_t* Wb = (const bf16_t*)(p.ws + OFF_WTBR);
  const int tid = opaque_tid();
  const int lane = tid & 63, wid = tid >> 6, wm = wid >> 1, wn = wid & 1;
  for (int t = blockIdx.x; t < 128 * 16; t += gridDim.x) {
    const int mt = t >> 4, nt = t & 15;
    f32x4 accm[4][2];
    zero_acc<64>(accm);
    for (int kb = 0; kb < 4; ++kb) {
      f32x4 g[4][2], pr[4][2];
      zero_acc<64>(g);
      zero_acc<64>(pr);
      gemm_mainloop<64>(g, U, 1024, mt * 128, Wg + (size_t)kb * 1024 * 1024, 1024, nt * 64, 1023, 1024, smem, tid);
      const int ycol = (kb == 0) ? (ZHG + 1024) : (kb == 1) ? (ZRW + 1024) : (kb == 2) ? (ZMB + 1024) : ZMB;
      gemm_mainloop<64>(pr, Z + ycol, ZS, mt * 128, Wb + (size_t)kb * 1024 * 512, 512, nt * 64, 1023, 512, smem, tid);
#pragma unroll
      for (int mi = 0; mi < 4; ++mi)
#pragma unroll
        for (int ni = 0; ni < 2; ++ni)
#pragma unroll
          for (int j = 0; j < 4; ++j) accm[mi][ni][j] = fmaf(sigmoidf_(g[mi][ni][j]), pr[mi][ni][j], accm[mi][ni][j]);
    }
#pragma unroll
    for (int mi = 0; mi < 4; ++mi)
#pragma unroll
      for (int ni = 0; ni < 2; ++ni) {
        int col = nt * 64 + wn * 32 + ni * 16 + (lane >> 4) * 4;
        int row = mt * 128 + wm * 64 + mi * 16 + (lane & 15);
        uint2 o;
        o.x = pack2(accm[mi][ni][0], accm[mi][ni][1]);
        o.y = pack2(accm[mi][ni][2], accm[mi][ni][3]);
        *reinterpret_cast<uint2*>(Z + (size_t)row * ZS + col) = o;
      }
  }
}

__device__ void phase_resid_gemm(const Params& p, const bf16_t* A, int lda, const bf16_t* Wt, int K, const float* xold, char* smem) {
  const int tid = opaque_tid();
  const int lane = tid & 63, wid = tid >> 6, wm = wid >> 1, wn = wid & 1;
  for (int t = blockIdx.x; t < 128 * 8; t += gridDim.x) {
    const int mt = t >> 3, nt = t & 7;
    f32x4 acc[4][4];
    zero_acc<128>(acc);
    gemm_mainloop<128>(acc, A, lda, mt * 128, Wt, K, nt * 128, 1023, K, smem, tid);
#pragma unroll
    for (int mi = 0; mi < 4; ++mi)
#pragma unroll
      for (int ni = 0; ni < 4; ++ni) {
        int col = nt * 128 + wn * 64 + ni * 16 + (lane >> 4) * 4;
        int row = mt * 128 + wm * 64 + mi * 16 + (lane & 15);
        size_t o = (size_t)row * DM + col;
        float4 xo = *reinterpret_cast<const float4*>(xold + o);
        float4 r = float4{xo.x + acc[mi][ni][0], xo.y + acc[mi][ni][1], xo.z + acc[mi][ni][2], xo.w + acc[mi][ni][3]};
        *reinterpret_cast<float4*>(p.out + o) = r;
      }
  }
}

__device__ void phase_ffn_in(const Params& p, char* smem) {
  const bf16_t* U = (const bf16_t*)(p.ws + OFF_U);
  const bf16_t* Wt = (const bf16_t*)(p.ws + OFF_WTF1);
  bf16_t* H = (bf16_t*)(p.ws + OFF_Z);
  const int tid = opaque_tid();
  const int lane = tid & 63, wid = tid >> 6, wm = wid >> 1, wn = wid & 1;
  for (int t = blockIdx.x; t < 128 * 44; t += gridDim.x) {
    const int mt = t / 44, nt = t % 44;
    f32x4 acc[4][4];
    zero_acc<128>(acc);
    gemm_mainloop<128>(acc, U, 1024, mt * 128, Wt, 1024, nt * 128, 5631, 1024, smem, tid);
#pragma unroll
    for (int mi = 0; mi < 4; ++mi)
#pragma unroll
      for (int q = 0; q < 2; ++q) {
        int hcol = ((nt * 128 + wn * 64 + q * 32) >> 1) + (lane >> 4) * 4;
        int row = mt * 128 + wm * 64 + mi * 16 + (lane & 15);
        uint2 o;
        o.x = pack2(siluf_(acc[mi][2 * q][0]) * acc[mi][2 * q + 1][0], siluf_(acc[mi][2 * q][1]) * acc[mi][2 * q + 1][1]);
        o.y = pack2(siluf_(acc[mi][2 * q][2]) * acc[mi][2 * q + 1][2], siluf_(acc[mi][2 * q][3]) * acc[mi][2 * q + 1][3]);
        *reinterpret_cast<uint2*>(H + (size_t)row * FFH + hcol) = o;
      }
  }
}

__device__ void phase_final(const Params& p) {
  const int tid = opaque_tid();
  const int lane = tid & 63;
  const float* w = p.in[I_NORM_FINAL];
  for (int t = blockIdx.x; t < T_TOK / 4; t += gridDim.x) {
    int row = t * 4 + (tid >> 6);
    float* x = p.out + (size_t)row * DM;
    float4 v[4];
    float ss = 0.f;
#pragma unroll
    for (int i = 0; i < 4; ++i) {
      v[i] = *reinterpret_cast<const float4*>(x + i * 256 + lane * 4);
      ss += v[i].x * v[i].x + v[i].y * v[i].y + v[i].z * v[i].z + v[i].w * v[i].w;
    }
    ss = sum64(ss);
    float rstd = rsqrtf(ss * (1.f / 1024.f) + 1e-6f);
#pragma unroll
    for (int i = 0; i < 4; ++i) {
      float4 ww = *reinterpret_cast<const float4*>(w + i * 256 + lane * 4);
      float4 o = float4{v[i].x * rstd * ww.x, v[i].y * rstd * ww.y, v[i].z * rstd * ww.z, v[i].w * rstd * ww.w};
      *reinterpret_cast<float4*>(x + i * 256 + lane * 4) = o;
    }
  }
}

template <int SUB>
__device__ __forceinline__ void run_phase(const Params& p, int l, char* smem) {
  if (SUB == 0) phase_convert_norm(p, l, smem);
  else if (SUB == 1) phase_inproj(p, smem);
  else if (SUB == 2) phase_rwprep(p, l, smem);
  else if (SUB == 3) phase_scans(p, l, smem);
  else if (SUB == 4) phase_post(p, l, smem);
  else if (SUB == 5) phase_merge(p, smem);
  else if (SUB == 6) phase_resid_gemm(p, (const bf16_t*)(p.ws + OFF_Z), ZS, (const bf16_t*)(p.ws + OFF_WTOUT), 1024,
                                      (l == 0) ? p.in[I_X] : p.out, smem);
  else if (SUB == 7) phase_norm_only(p, p.out, p.in[I_NORM_FFN] + l * DM);
  else if (SUB == 8) phase_ffn_in(p, smem);
  else if (SUB == 9) phase_resid_gemm(p, (const bf16_t*)(p.ws + OFF_Z), FFH, (const bf16_t*)(p.ws + OFF_WTF2), FFH, p.out, smem);
  else phase_final(p);
}

#ifndef PHM
#define PHM 0xFFFF
#endif
__device__ __forceinline__ void grid_bar(unsigned* ctr, unsigned& target) {
  asm volatile("s_waitcnt vmcnt(0)" ::: "memory");
  __syncthreads();
  if (threadIdx.x == 0) {
    target += gridDim.x;
    __builtin_amdgcn_fence(__ATOMIC_RELEASE, "agent");
    __hip_atomic_fetch_add(ctr, 1u, __ATOMIC_RELAXED, __HIP_MEMORY_SCOPE_AGENT);
    while (__hip_atomic_load(ctr, __ATOMIC_RELAXED, __HIP_MEMORY_SCOPE_AGENT) < target) __builtin_amdgcn_s_sleep(32);
    __builtin_amdgcn_fence(__ATOMIC_ACQUIRE, "agent");
    asm volatile("s_waitcnt vmcnt(0)" ::: "memory");
  }
  __syncthreads();
}

#if COOP
__global__ void __launch_bounds__(256, 2) fwd_kernel(Params p, int ph0, int ph1) {
  __shared__ __attribute__((aligned(16))) char smem[65536];
  cg::grid_group grid = cg::this_grid();
  unsigned* bar_ctr = reinterpret_cast<unsigned*>(p.ws + OFF_BAR);
  unsigned bar_target = 0;
  for (int ph = ph0; ph < ph1; ++ph) {
    if (ph == NPHASES - 1) {
      phase_final(p);
    } else {
      const int l = ph / NPH_LAYER, sub = ph % NPH_LAYER;
      switch (sub) {
        case 0: if (PHM & (1<<0)) run_phase<0>(p, l, smem); break;
        case 1: if (PHM & (1<<1)) run_phase<1>(p, l, smem); break;
        case 2: if (PHM & (1<<2)) run_phase<2>(p, l, smem); break;
        case 3: if (PHM & (1<<3)) run_phase<3>(p, l, smem); break;
        case 4: if (PHM & (1<<4)) run_phase<4>(p, l, smem); break;
        case 5: if (PHM & (1<<5)) run_phase<5>(p, l, smem); break;
        case 6: if (PHM & (1<<6)) run_phase<6>(p, l, smem); break;
        case 7: if (PHM & (1<<7)) run_phase<7>(p, l, smem); break;
        case 8: if (PHM & (1<<8)) run_phase<8>(p, l, smem); break;
        case 9: if (PHM & (1<<9)) run_phase<9>(p, l, smem); break;
      }
    }
    if (ph + 1 < ph1) {
      if (ph == ph0) grid.sync();
      else grid_bar(bar_ctr, bar_target);
    }
  }
}
#else
template <int SUB>
__global__ void __launch_bounds__(256, 2) k_phase(Params p, int l) {
  __shared__ __attribute__((aligned(16))) char smem[65536];
  run_phase<SUB>(p, l, smem);
}
#endif

extern "C" void kernel_launch(void* const* d_in, const int* in_sizes, int n_in, void* d_out, int out_size, void* d_ws,
                              size_t ws_size, hipStream_t stream) {
  if (n_in < 41 || ws_size < WS_NEED) {
    fprintf(stderr, "kernel_launch: bad args n_in=%d ws=%zu need=%zu\n", n_in, ws_size, (size_t)WS_NEED);
    return;
  }
  Params p{};
  for (int i = 0; i < 41; ++i) p.in[i] = (const float*)d_in[i];
  p.out = (float*)d_out;
  p.ws = (char*)d_ws;
#if COOP
  static int grid_blocks = 0;
  if (!grid_blocks) {
    int dev = 0, cus = 0, per_cu = 0;
    hipGetDevice(&dev);
    hipDeviceGetAttribute(&cus, hipDeviceAttributeMultiprocessorCount, dev);
    hipOccupancyMaxActiveBlocksPerMultiprocessor(&per_cu, fwd_kernel, 256, 0);
    if (per_cu > 2) per_cu = 2;
    grid_blocks = cus * per_cu;
  }
#ifdef HYBRID
  for (int ph = 0; ph < NPHASES; ++ph) fwd_kernel<<<grid_blocks, 256, 0, stream>>>(p, ph, ph + 1);
#else
  hipMemsetAsync((char*)d_ws + OFF_BAR, 0, 256, stream);
  int ph0 = 0, ph1 = NPHASES;
  void* args[] = {&p, &ph0, &ph1};
  hipError_t e = hipLaunchCooperativeKernel((void*)fwd_kernel, dim3(grid_blocks), dim3(256), args, 0, stream);
  if (e != hipSuccess) fprintf(stderr, "cooperative launch failed: %s (grid %d)\n", hipGetErrorString(e), grid_blocks);
#endif
#else
  const dim3 g(512), b(256);
  for (int l = 0; l < 2; ++l) {
    k_phase<0><<<g, b, 0, stream>>>(p, l);
    k_phase<1><<<g, b, 0, stream>>>(p, l);
    k_phase<2><<<g, b, 0, stream>>>(p, l);
    k_phase<3><<<g, b, 0, stream>>>(p, l);
    k_phase<4><<<g, b, 0, stream>>>(p, l);
    k_phase<5><<<g, b, 0, stream>>>(p, l);
    k_phase<6><<<g, b, 0, stream>>>(p, l);
    k_phase<7><<<g, b, 0, stream>>>(p, l);
    k_phase<8><<<g, b, 0, stream>>>(p, l);
    k_phase<9><<<g, b, 0, stream>>>(p, l);
  }
  k_phase<10><<<g, b, 0, stream>>>(p, 0);
#endif
}
```

```cpp
#include <hip/hip_runtime.h>
#include <hip/hip_cooperative_groups.h>
#include <cstdio>
#include <cstdint>
namespace cg = cooperative_groups;

#ifndef COOP
#define COOP 1
#endif

typedef unsigned short bf16_t;
typedef __attribute__((ext_vector_type(8))) short bf16x8;
typedef __attribute__((ext_vector_type(4))) float f32x4;
typedef __attribute__((ext_vector_type(4))) unsigned u32x4;

constexpr int T_TOK = 16384, SEQ = 2048, DM = 1024;
constexpr int IN_COLS = 9992, NZ = 5896, ZS = 5904;
constexpr int ZHG = 0, ZRW = 2048, ZS5 = 3840, ZMB = 4352;
constexpr int FFH = 2816;
constexpr int NPH_LAYER = 10, NPHASES = 21;

constexpr size_t OFF_WTIN   = 0;
constexpr size_t OFF_WTGATE = OFF_WTIN + (size_t)5896 * 1024 * 2;
constexpr size_t OFF_WTBR   = OFF_WTGATE + (size_t)4096 * 1024 * 2;
constexpr size_t OFF_WTOUT  = OFF_WTBR + (size_t)4 * 1024 * 512 * 2;
constexpr size_t OFF_WTF1   = OFF_WTOUT + (size_t)1024 * 1024 * 2;
constexpr size_t OFF_WTF2   = OFF_WTF1 + (size_t)5632 * 1024 * 2;
constexpr size_t OFF_WTGLU  = OFF_WTF2 + (size_t)1024 * 2816 * 2;
constexpr size_t OFF_U      = OFF_WTGLU + (size_t)512 * 512 * 2;
constexpr size_t OFF_Z      = OFF_U + (size_t)T_TOK * 1024 * 2;
constexpr size_t OFF_VF     = OFF_Z + (size_t)T_TOK * ZS * 2;
constexpr size_t OFF_BAR    = OFF_VF + (size_t)T_TOK * 512 * 2;
constexpr size_t WS_NEED    = OFF_BAR + 256;

struct Params {
  const float* in[41];
  float* out;
  char* ws;
};

enum { I_X = 0, I_NORM_MIX, I_W_IN, I_W_BRANCH, I_W_OUT, I_NORM_FFN, I_W_FFN_IN, I_W_FFN_OUT, I_NORM_FINAL,
       I_HG_LB, I_HG_NW, I_RW_MU, I_RW_W0, I_RW_W2, I_RW_A0, I_RW_A2, I_RW_G2, I_RW_KK, I_RW_KA, I_RW_RK,
       I_RW_LNW, I_RW_LNB, I_RW_V0, I_RW_V1, I_RW_V2, I_S5_ARE, I_S5_AIM, I_S5_BRE, I_S5_BIM, I_S5_CRE,
       I_S5_CIM, I_S5_D, I_S5_LOGDT, I_S5_WGLU, I_S5_BGLU, I_MB_CONVW, I_MB_CONVB, I_MB_DTB, I_MB_ALOG,
       I_MB_D, I_MB_NW };

__device__ __forceinline__ float bf2f(bf16_t v) { return __uint_as_float(((unsigned)v) << 16); }
__device__ __forceinline__ bf16_t f2bf(float f) {
  unsigned u = __float_as_uint(f);
  u += 0x7fffu + ((u >> 16) & 1u);
  return (bf16_t)(u >> 16);
}
__device__ __forceinline__ unsigned pack2(float a, float b) { return (unsigned)f2bf(a) | ((unsigned)f2bf(b) << 16); }
__device__ __forceinline__ float sigmoidf_(float x) { return 1.f / (1.f + __expf(-x)); }
__device__ __forceinline__ float siluf_(float x) { return x / (1.f + __expf(-x)); }
__device__ __forceinline__ float softplusf_(float x) { return x > 20.f ? x : log1pf(__expf(x)); }
__device__ __forceinline__ float gelu_tanh(float x) {
  float u = 0.7978845608028654f * (x + 0.044715f * x * x * x);
  return 0.5f * x * (1.f + tanhf(u));
}
__device__ __forceinline__ float quad_sum(float x) {
  x += __builtin_bit_cast(float, __builtin_amdgcn_update_dpp(0, __builtin_bit_cast(int, x), 0xB1, 0xF, 0xF, true));
  x += __builtin_bit_cast(float, __builtin_amdgcn_update_dpp(0, __builtin_bit_cast(int, x), 0x4E, 0xF, 0xF, true));
  return x;
}
__device__ __forceinline__ float oct_sum(float x) {
  x = quad_sum(x);
  x += __builtin_bit_cast(float, __builtin_amdgcn_update_dpp(0, __builtin_bit_cast(int, x), 0x141, 0xF, 0xF, true));
  return x;
}
__device__ __forceinline__ float sum16(float x) {
  x += __shfl_xor(x, 1); x += __shfl_xor(x, 2); x += __shfl_xor(x, 4); x += __shfl_xor(x, 8);
  return x;
}
__device__ __forceinline__ float sum64(float x) {
  x = sum16(x); x += __shfl_xor(x, 16); x += __shfl_xor(x, 32);
  return x;
}

__device__ __forceinline__ int opaque_tid() {
  int t = threadIdx.x;
  asm volatile("" : "+v"(t));
  return t;
}

template <int BN>
__device__ __forceinline__ void gemm_mainloop(f32x4 (&acc)[4][BN / 32], const bf16_t* A, int lda, int m0,
                                              const bf16_t* Bt, int ldb, int n0, int nmax, int K, char* smem, const int tid) {
  const int lane = tid & 63, wid = tid >> 6, wm = wid >> 1, wn = wid & 1;
  const int q = tid & 7, r0 = tid >> 3;
  unsigned offA[4], offB[BN / 32];
#pragma unroll
  for (int i = 0; i < 4; ++i) offA[i] = ((unsigned)(m0 + r0 + 32 * i) * (unsigned)lda + (unsigned)q * 8u) * 2u;
#pragma unroll
  for (int i = 0; i < BN / 32; ++i) {
    int row = n0 + r0 + 32 * i;
    row = row < nmax ? row : nmax;
    offB[i] = ((unsigned)row * (unsigned)ldb + (unsigned)q * 8u) * 2u;
  }
  const unsigned sto = (unsigned)r0 * 128u + (unsigned)((q ^ ((r0 >> 1) & 7)) << 4);
  unsigned aoff[4], boff[BN / 32];
#pragma unroll
  for (int mi = 0; mi < 4; ++mi) {
    int row = wm * 64 + mi * 16 + (lane & 15);
    aoff[mi] = (unsigned)row * 128u + (unsigned)(((lane >> 4) ^ ((row >> 1) & 7)) << 4);
  }
#pragma unroll
  for (int ni = 0; ni < BN / 32; ++ni) {
    int row = wn * (BN / 2) + ni * 16 + (lane & 15);
    boff[ni] = (unsigned)row * 128u + (unsigned)(((lane >> 4) ^ ((row >> 1) & 7)) << 4);
  }
  const char* Ab = reinterpret_cast<const char*>(A);
  const char* Bb = reinterpret_cast<const char*>(Bt);
  const int nk = K >> 6;
  constexpr bool WIDE = (BN == 128);
  u32x4 ra0, ra1, ra2, ra3, rb0, rb1, rb2, rb3;
#define GLOAD_ALL()                                                        \
  ra0 = *reinterpret_cast<const u32x4*>(Ab + offA[0]);                     \
  ra1 = *reinterpret_cast<const u32x4*>(Ab + offA[1]);                     \
  ra2 = *reinterpret_cast<const u32x4*>(Ab + offA[2]);                     \
  ra3 = *reinterpret_cast<const u32x4*>(Ab + offA[3]);                     \
  rb0 = *reinterpret_cast<const u32x4*>(Bb + offB[0]);                     \
  rb1 = *reinterpret_cast<const u32x4*>(Bb + offB[1]);                     \
  if (WIDE) {                                                              \
    rb2 = *reinterpret_cast<const u32x4*>(Bb + offB[BN / 32 - 2]);         \
    rb3 = *reinterpret_cast<const u32x4*>(Bb + offB[BN / 32 - 1]);         \
  }
#define SSTORE_ALL(AD, BD)                                                 \
  *reinterpret_cast<u32x4*>((AD)) = ra0;                                   \
  *reinterpret_cast<u32x4*>((AD) + 4096) = ra1;                            \
  *reinterpret_cast<u32x4*>((AD) + 8192) = ra2;                            \
  *reinterpret_cast<u32x4*>((AD) + 12288) = ra3;                           \
  *reinterpret_cast<u32x4*>((BD)) = rb0;                                   \
  *reinterpret_cast<u32x4*>((BD) + 4096) = rb1;                            \
  if (WIDE) {                                                              \
    *reinterpret_cast<u32x4*>((BD) + 8192) = rb2;                          \
    *reinterpret_cast<u32x4*>((BD) + 12288) = rb3;                         \
  }
  GLOAD_ALL();
  SSTORE_ALL(smem + sto, smem + 32768 + sto);
  __syncthreads();
#pragma unroll 1
  for (int kt = 0; kt < nk; ++kt) {
    const int buf = kt & 1;
    const bool more = (kt + 1 < nk);
    if (more) {
      Ab += 128; Bb += 128;
      GLOAD_ALL();
    }
    __builtin_amdgcn_sched_barrier(0);
    const char* a_s = smem + buf * 16384;
    const char* b_s = smem + 32768 + buf * (BN * 128);
#pragma unroll
    for (int ks = 0; ks < 2; ++ks) {
      bf16x8 af[4], bfr[BN / 32];
#pragma unroll
      for (int mi = 0; mi < 4; ++mi) af[mi] = *reinterpret_cast<const bf16x8*>(a_s + (aoff[mi] ^ (ks * 64)));
#pragma unroll
      for (int ni = 0; ni < BN / 32; ++ni) bfr[ni] = *reinterpret_cast<const bf16x8*>(b_s + (boff[ni] ^ (ks * 64)));
#pragma unroll
      for (int mi = 0; mi < 4; ++mi)
#pragma unroll
        for (int ni = 0; ni < BN / 32; ++ni)
          acc[mi][ni] = __builtin_amdgcn_mfma_f32_16x16x32_bf16(bfr[ni], af[mi], acc[mi][ni], 0, 0, 0);
    }
    __builtin_amdgcn_sched_barrier(0);
    if (more) {
      char* a_d = smem + (buf ^ 1) * 16384 + sto;
      char* b_d = smem + 32768 + (buf ^ 1) * (BN * 128) + sto;
      SSTORE_ALL(a_d, b_d);
    }
    __syncthreads();
  }
#undef GLOAD_ALL
#undef SSTORE_ALL
}

template <int BN>
__device__ __forceinline__ void zero_acc(f32x4 (&acc)[4][BN / 32]) {
#pragma unroll
  for (int mi = 0; mi < 4; ++mi)
#pragma unroll
    for (int ni = 0; ni < BN / 32; ++ni) acc[mi][ni] = f32x4{0.f, 0.f, 0.f, 0.f};
}

__device__ __forceinline__ void conv_tile(const float* src, int ld, int nlimit, int k0, int n0, bf16_t* dst, int Kd, int mode,
                                          char* smem, const int tid) {
  float* sT = reinterpret_cast<float*>(smem);
#pragma unroll
  for (int i = 0; i < 16; ++i) {
    int kk = i * 4 + (tid >> 6), nn = tid & 63;
    float v = (n0 + nn < nlimit) ? src[(size_t)(k0 + kk) * ld + n0 + nn] : 0.f;
    sT[kk * 65 + nn] = v;
  }
  __syncthreads();
  {
    int nn = tid >> 2, kq = tid & 3;
    int n = n0 + nn;
    if (n < nlimit) {
      int drow = n;
      if (mode == 1) {
        if (n < FFH) drow = (n >> 4) * 32 + (n & 15);
        else { int j = n - FFH; drow = (j >> 4) * 32 + 16 + (j & 15); }
      }
      unsigned pk[8];
#pragma unroll
      for (int j = 0; j < 8; ++j) pk[j] = pack2(sT[(kq * 16 + 2 * j) * 65 + nn], sT[(kq * 16 + 2 * j + 1) * 65 + nn]);
      uint4* d = reinterpret_cast<uint4*>(dst + (size_t)drow * Kd + k0 + kq * 16);
      d[0] = uint4{pk[0], pk[1], pk[2], pk[3]};
      d[1] = uint4{pk[4], pk[5], pk[6], pk[7]};
    }
  }
  __syncthreads();
}

__device__ __forceinline__ void rmsnorm_row_to_bf16(const float* x, const float* w, bf16_t* out, const int lane) {
  float4 v[4];
  float ss = 0.f;
#pragma unroll
  for (int i = 0; i < 4; ++i) {
    v[i] = *reinterpret_cast<const float4*>(x + i * 256 + lane * 4);
    ss += v[i].x * v[i].x + v[i].y * v[i].y + v[i].z * v[i].z + v[i].w * v[i].w;
  }
  ss = sum64(ss);
  float rstd = rsqrtf(ss * (1.f / 1024.f) + 1e-6f);
#pragma unroll
  for (int i = 0; i < 4; ++i) {
    float4 ww = *reinterpret_cast<const float4*>(w + i * 256 + lane * 4);
    uint2 o;
    o.x = pack2(v[i].x * rstd * ww.x, v[i].y * rstd * ww.y);
    o.y = pack2(v[i].z * rstd * ww.z, v[i].w * rstd * ww.w);
    *reinterpret_cast<uint2*>(out + i * 256 + lane * 4) = o;
  }
}

constexpr int CT_IN = 157 * 16, CT_BR = 512, CT_OUT = 256, CT_F1 = 88 * 16, CT_F2 = 44 * 16, CT_GLU = 64;
constexpr int CT_TOTAL = CT_IN + CT_BR + CT_OUT + CT_F1 + CT_F2 + CT_GLU;

__device__ void phase_convert_norm(const Params& p, int l, char* smem) {
  const int tid = opaque_tid();
  char* ws = p.ws;
  const int ntask = CT_TOTAL + T_TOK / 4;
  const float* xsrc = (l == 0) ? p.in[I_X] : p.out;
  for (int t = blockIdx.x; t < ntask; t += gridDim.x) {
    if (t < CT_TOTAL) {
      int c = t;
      if (c < CT_IN) {
        int nt = c >> 4, kt = c & 15;
        const float* src = p.in[I_W_IN] + (size_t)l * 1024 * IN_COLS;
        if (nt < 64) conv_tile(src, IN_COLS, IN_COLS, kt * 64, nt * 64, (bf16_t*)(ws + OFF_WTGATE), 1024, 0, smem, tid);
        else conv_tile(src + 4096, IN_COLS, IN_COLS - 4096, kt * 64, (nt - 64) * 64, (bf16_t*)(ws + OFF_WTIN), 1024, 0, smem, tid);
        continue;
      }
      c -= CT_IN;
      if (c < CT_BR) {
        int kb = c >> 7, r = c & 127, nt = r >> 3, kt = r & 7;
        const float* src = p.in[I_W_BRANCH] + ((size_t)l * 4 + kb) * 512 * 1024;
        conv_tile(src, 1024, 1024, kt * 64, nt * 64, (bf16_t*)(ws + OFF_WTBR) + (size_t)kb * 1024 * 512, 512, 0, smem, tid);
        continue;
      }
      c -= CT_BR;
      if (c < CT_OUT) {
        int nt = c >> 4, kt = c & 15;
        conv_tile(p.in[I_W_OUT] + (size_t)l * 1024 * 1024, 1024, 1024, kt * 64, nt * 64, (bf16_t*)(ws + OFF_WTOUT), 1024, 0, smem, tid);
        continue;
      }
      c -= CT_OUT;
      if (c < CT_F1) {
        int nt = c >> 4, kt = c & 15;
        conv_tile(p.in[I_W_FFN_IN] + (size_t)l * 1024 * 5632, 5632, 5632, kt * 64, nt * 64, (bf16_t*)(ws + OFF_WTF1), 1024, 1, smem, tid);
        continue;
      }
      c -= CT_F1;
      if (c < CT_F2) {
        int nt = c / 44, kt = c % 44;
        conv_tile(p.in[I_W_FFN_OUT] + (size_t)l * FFH * 1024, 1024, 1024, kt * 64, nt * 64, (bf16_t*)(ws + OFF_WTF2), FFH, 0, smem, tid);
        continue;
      }
      c -= CT_F2;
      {
        int nt = c >> 3, kt = c & 7;
        conv_tile(p.in[I_S5_WGLU] + (size_t)l * 512 * 512, 512, 512, kt * 64, nt * 64, (bf16_t*)(ws + OFF_WTGLU), 512, 0, smem, tid);
      }
    } else {
      int row = (t - CT_TOTAL) * 4 + (tid >> 6);
      rmsnorm_row_to_bf16(xsrc + (size_t)row * DM, p.in[I_NORM_MIX] + l * DM, (bf16_t*)(ws + OFF_U) + (size_t)row * DM, tid & 63);
    }
  }
}

__device__ void phase_norm_only(const Params& p, const float* xsrc, const float* w) {
  const int tid = opaque_tid();
  for (int t = blockIdx.x; t < T_TOK / 4; t += gridDim.x) {
    int row = t * 4 + (tid >> 6);
    rmsnorm_row_to_bf16(xsrc + (size_t)row * DM, w, (bf16_t*)(p.ws + OFF_U) + (size_t)row * DM, tid & 63);
  }
}

__device__ void phase_inproj(const Params& p, char* smem) {
  const bf16_t* U = (const bf16_t*)(p.ws + OFF_U);
  const bf16_t* Wt = (const bf16_t*)(p.ws + OFF_WTIN);
  bf16_t* Z = (bf16_t*)(p.ws + OFF_Z);
  const int tid = opaque_tid();
  const int lane = tid & 63, wid = tid >> 6, wm = wid >> 1, wn = wid & 1;
  constexpr int NT = 47;
  for (int t = blockIdx.x; t < 128 * NT; t += gridDim.x) {
    int mt = t / NT, nt = t % NT;
    f32x4 acc[4][4];
    zero_acc<128>(acc);
    gemm_mainloop<128>(acc, U, 1024, mt * 128, Wt, 1024, nt * 128, NZ - 1, 1024, smem, tid);
#pragma unroll
    for (int mi = 0; mi < 4; ++mi)
#pragma unroll
      for (int ni = 0; ni < 4; ++ni) {
        int col = nt * 128 + wn * 64 + ni * 16 + (lane >> 4) * 4;
        int row = mt * 128 + wm * 64 + mi * 16 + (lane & 15);
        if (col < NZ) {
          uint2 o;
          o.x = pack2(acc[mi][ni][0], acc[mi][ni][1]);
          o.y = pack2(acc[mi][ni][2], acc[mi][ni][3]);
          *reinterpret_cast<uint2*>(Z + (size_t)row * ZS + col) = o;
        }
      }
  }
}

template <int J>
__device__ __forceinline__ void lora_mm(const float* sIn, const float* W, float (&a0)[16], float (&a1)[16], const int tid) {
#pragma unroll
  for (int i = 0; i < 16; ++i) { a0[i] = 0.f; a1[i] = 0.f; }
#pragma unroll 2
  for (int j = 0; j < J; ++j) {
    float w0 = W[j * 512 + tid], w1 = W[j * 512 + tid + 256];
    const float4* x4 = reinterpret_cast<const float4*>(sIn + j * 16);
#pragma unroll
    for (int q = 0; q < 4; ++q) {
      float4 x = x4[q];
      a0[q * 4 + 0] = fmaf(w0, x.x, a0[q * 4 + 0]); a1[q * 4 + 0] = fmaf(w1, x.x, a1[q * 4 + 0]);
      a0[q * 4 + 1] = fmaf(w0, x.y, a0[q * 4 + 1]); a1[q * 4 + 1] = fmaf(w1, x.y, a1[q * 4 + 1]);
      a0[q * 4 + 2] = fmaf(w0, x.z, a0[q * 4 + 2]); a1[q * 4 + 2] = fmaf(w1, x.z, a1[q * 4 + 2]);
      a0[q * 4 + 3] = fmaf(w0, x.w, a0[q * 4 + 3]); a1[q * 4 + 3] = fmaf(w1, x.w, a1[q * 4 + 3]);
    }
  }
}

__device__ __forceinline__ float rw_shift(const bf16_t* Z, int row, int s, int rc, float mu) {
  float cur = bf2f(Z[(size_t)row * ZS + ZRW + rc]);
  float prev = (s > 0) ? bf2f(Z[(size_t)(row - 1) * ZS + ZRW + rc]) : 0.f;
  return cur + (prev - cur) * mu;
}

__device__ void phase_rwprep(const Params& p, int l, char* smem) {
  const bf16_t* Z = (const bf16_t*)(p.ws + OFF_Z);
  bf16_t* LW = (bf16_t*)(p.ws + OFF_U);
  bf16_t* LA = LW + (size_t)T_TOK * 512;
  bf16_t* VF = (bf16_t*)(p.ws + OFF_VF);
  float* sXw = reinterpret_cast<float*>(smem);
  float* sXa = sXw + 64 * 16;
  float* sTmp = sXa + 64 * 16;
  float* sZv = sTmp + 32 * 16;
  const float* mu = p.in[I_RW_MU] + l * 1792;
  const int tid = opaque_tid();
  for (int t = blockIdx.x; t < T_TOK / 16; t += gridDim.x) {
    const int row0 = t * 16;
    for (int e = tid; e < 2048; e += 256) {
      int which = e >> 10, r = e & 1023, j = r >> 4, tok = r & 15;
      int row = row0 + tok, s = row & (SEQ - 1);
      int rc = 1536 + which * 64 + j;
      float z = rw_shift(Z, row, s, rc, mu[rc]);
      if (which == 0) sXw[j * 16 + tok] = tanhf(z); else sXa[j * 16 + tok] = z;
    }
    float zv0[16], zv1[16];
    {
      float m0 = mu[1024 + tid], m1 = mu[1024 + tid + 256];
#pragma unroll
      for (int tok = 0; tok < 16; ++tok) {
        int row = row0 + tok, s = row & (SEQ - 1);
        zv0[tok] = rw_shift(Z, row, s, 1024 + tid, m0);
        zv1[tok] = rw_shift(Z, row, s, 1024 + tid + 256, m1);
      }
    }
    if (l > 0) {
#pragma unroll
      for (int tok = 0; tok < 16; ++tok) { sZv[tid * 16 + tok] = zv0[tok]; sZv[(tid + 256) * 16 + tok] = zv1[tok]; }
    }
    __syncthreads();
    float a0[16], a1[16];
    lora_mm<64>(sXw, p.in[I_RW_W2] + (size_t)l * 64 * 512, a0, a1, tid);
#pragma unroll
    for (int tok = 0; tok < 16; ++tok) {
      LW[(size_t)(row0 + tok) * 512 + tid] = f2bf(a0[tok]);
      LW[(size_t)(row0 + tok) * 512 + tid + 256] = f2bf(a1[tok]);
    }
    lora_mm<64>(sXa, p.in[I_RW_A2] + (size_t)l * 64 * 512, a0, a1, tid);
#pragma unroll
    for (int tok = 0; tok < 16; ++tok) {
      LA[(size_t)(row0 + tok) * 512 + tid] = f2bf(a0[tok]);
      LA[(size_t)(row0 + tok) * 512 + tid + 256] = f2bf(a1[tok]);
    }
    if (l == 0) {
#pragma unroll
      for (int tok = 0; tok < 16; ++tok) {
        VF[(size_t)(row0 + tok) * 512 + tid] = f2bf(zv0[tok]);
        VF[(size_t)(row0 + tok) * 512 + tid + 256] = f2bf(zv1[tok]);
      }
    } else {
      const float* v1 = p.in[I_RW_V1] + (size_t)(l - 1) * 512 * 32;
      const float* v2 = p.in[I_RW_V2] + (size_t)(l - 1) * 32 * 512;
      const float* v0 = p.in[I_RW_V0] + (size_t)(l - 1) * 512;
      {
        int r = tid & 31, tg = tid >> 5;
        float t0 = 0.f, t1 = 0.f;
#pragma unroll 4
        for (int c = 0; c < 512; ++c) {
          float w = v1[c * 32 + r];
          float2 x = *reinterpret_cast<const float2*>(sZv + c * 16 + tg * 2);
          t0 = fmaf(w, x.x, t0); t1 = fmaf(w, x.y, t1);
        }
        sTmp[r * 16 + tg * 2] = t0; sTmp[r * 16 + tg * 2 + 1] = t1;
      }
      __syncthreads();
      lora_mm<32>(sTmp, v2, a0, a1, tid);
      float b0 = v0[tid], b1 = v0[tid + 256];
#pragma unroll
      for (int tok = 0; tok < 16; ++tok) {
        size_t i0 = (size_t)(row0 + tok) * 512 + tid;
        float vf0 = bf2f(VF[i0]), vf1 = bf2f(VF[i0 + 256]);
        VF[i0] = f2bf(zv0[tok] + (vf0 - zv0[tok]) * sigmoidf_(b0 + a0[tok]));
        VF[i0 + 256] = f2bf(zv1[tok] + (vf1 - zv1[tok]) * sigmoidf_(b1 + a1[tok]));
      }
    }
    __syncthreads();
  }
}

__device__ __forceinline__ float frcp(float x) { return __builtin_amdgcn_rcpf(x); }
__device__ __forceinline__ float fsigmoid(float x) { return frcp(1.f + __expf(-x)); }
__device__ __forceinline__ float fsilu(float x) { return x * frcp(1.f + __expf(-x)); }
__device__ __forceinline__ float fsoftplus(float x) { return x > 20.f ? x : __logf(1.f + __expf(x)); }
__device__ __forceinline__ float ftanh(float x) {
  float e = __expf(2.f * fminf(fmaxf(x, -15.f), 15.f));
  return (e - 1.f) * frcp(e + 1.f);
}
__device__ __forceinline__ float fgelu(float x) {
  float u = 0.7978845608028654f * (x + 0.044715f * x * x * x);
  return 0.5f * x * (1.f + ftanh(u));
}

__device__ void hg_scan(const Params& p, int l, int task, char* smem) {
  const int b = task >> 3, h = (task >> 1) & 3, vg = task & 1;
  float* sFg = reinterpret_cast<float*>(smem);
  float* sQs = sFg + 16 * 128;
  float* sO = sQs + 16 * 128;
  float* sVv = sO + 4 * 16 * 64;
  const int tid = opaque_tid(), w = tid >> 6, lane = tid & 63;
  bf16_t* Z = (bf16_t*)(p.ws + OFF_Z) + (size_t)b * SEQ * ZS;
  const int ks = tid & 127;
  float lb = 0.f;
  if (l > 0) {
    float x0 = p.in[I_HG_LB][h * 128 + ks], x1 = p.in[I_HG_LB][512 + h * 128 + ks];
    float m = fmaxf(x0, x1), e0 = expf(x0 - m), e1 = expf(x1 - m);
    lb = e1 / (e0 + e1);
  }
  float s[32];
#pragma unroll
  for (int j = 0; j < 32; ++j) s[j] = 0.f;
  const int vcol = ZHG + 1024 + h * 128 + vg * 64;
  const int qcol = ZHG + h * 128 + ks;
  bf16_t rq0, rq1, rq2, rq3, rq4, rq5, rq6, rq7, rf0, rf1, rf2, rf3, rf4, rf5, rf6, rf7, rv0, rv1, rv2, rv3;
#define HG_LOAD(T0)                                                                                \
  {                                                                                                \
    const bf16_t* zb = Z + (size_t)((T0) + (tid >> 7)) * ZS + qcol;                                \
    rq0 = zb[0]; rf0 = zb[512]; zb += 2 * ZS; rq1 = zb[0]; rf1 = zb[512]; zb += 2 * ZS;            \
    rq2 = zb[0]; rf2 = zb[512]; zb += 2 * ZS; rq3 = zb[0]; rf3 = zb[512]; zb += 2 * ZS;            \
    rq4 = zb[0]; rf4 = zb[512]; zb += 2 * ZS; rq5 = zb[0]; rf5 = zb[512]; zb += 2 * ZS;            \
    rq6 = zb[0]; rf6 = zb[512]; zb += 2 * ZS; rq7 = zb[0]; rf7 = zb[512];                          \
    const bf16_t* zv = Z + (size_t)((T0) + w) * ZS + vcol + lane;                                  \
    rv0 = zv[0]; rv1 = zv[4 * ZS]; rv2 = zv[8 * ZS]; rv3 = zv[12 * ZS];                            \
  }
#define HG_PUT1(I, RQ, RF)                                                                         \
  {                                                                                                \
    int t = (tid >> 7) + 2 * (I);                                                                  \
    sFg[t * 128 + ks] = fmaxf(lb + (1.f - lb) * fsigmoid(bf2f(RF)), 1e-30f);                       \
    sQs[t * 128 + ks] = fsilu(bf2f(RQ));                                                           \
  }
#define HG_PROCESS()                                                                               \
  {                                                                                                \
    HG_PUT1(0, rq0, rf0) HG_PUT1(1, rq1, rf1) HG_PUT1(2, rq2, rf2) HG_PUT1(3, rq3, rf3)            \
    HG_PUT1(4, rq4, rf4) HG_PUT1(5, rq5, rf5) HG_PUT1(6, rq6, rf6) HG_PUT1(7, rq7, rf7)            \
    sVv[(w)*64 + lane] = bf2f(rv0); sVv[(w + 4) * 64 + lane] = bf2f(rv1);                          \
    sVv[(w + 8) * 64 + lane] = bf2f(rv2); sVv[(w + 12) * 64 + lane] = bf2f(rv3);                   \
  }
  HG_LOAD(0);
  HG_PROCESS();
  __syncthreads();
  constexpr int NCH = SEQ / 16;
#pragma unroll 1
  for (int c = 0; c < NCH; ++c) {
    const int t0 = c * 16;
    const int tn = (c + 1 < NCH) ? t0 + 16 : t0;
    HG_LOAD(tn);
    __builtin_amdgcn_sched_barrier(0);
#pragma unroll 2
    for (int t = 0; t < 16; ++t) {
      const float v = sVv[t * 64 + lane];
      const float opv = (lane < 32) ? sFg[t * 128 + w * 32 + lane] : sQs[t * 128 + w * 32 + (lane - 32)];
      const int opi = __builtin_bit_cast(int, opv);
      float o = 0.f;
#pragma unroll
      for (int j = 0; j < 32; ++j) {
        const float fg = __builtin_bit_cast(float, __builtin_amdgcn_readlane(opi, j));
        const float qq = __builtin_bit_cast(float, __builtin_amdgcn_readlane(opi, 32 + j));
        const float kv = fmaf(-fg, v, v);
        s[j] = fmaf(s[j], fg, kv);
        o = fmaf(qq, s[j], o);
      }
      sO[(w * 16 + t) * 64 + lane] = o;
    }
    __builtin_amdgcn_sched_barrier(0);
    __syncthreads();
    {
      int t = tid >> 4, v4 = (tid & 15) * 4;
      float4 a = *reinterpret_cast<const float4*>(sO + (0 * 16 + t) * 64 + v4);
      float4 bq = *reinterpret_cast<const float4*>(sO + (1 * 16 + t) * 64 + v4);
      float4 cq = *reinterpret_cast<const float4*>(sO + (2 * 16 + t) * 64 + v4);
      float4 d = *reinterpret_cast<const float4*>(sO + (3 * 16 + t) * 64 + v4);
      uint2 o;
      o.x = pack2(a.x + bq.x + cq.x + d.x, a.y + bq.y + cq.y + d.y);
      o.y = pack2(a.z + bq.z + cq.z + d.z, a.w + bq.w + cq.w + d.w);
      *reinterpret_cast<uint2*>(Z + (size_t)(t0 + t) * ZS + vcol + v4) = o;
    }
    HG_PROCESS();
    __syncthreads();
  }
#undef HG_LOAD
#undef HG_PUT1
#undef HG_PROCESS
}

__device__ void mb_scan(const Params& p, int l, int task, char* smem) {
  const int b = task >> 3, hd = task & 7, g = hd >> 2;
  float* sB = reinterpret_cast<float*>(smem);
  float* sC = sB + 16 * 128;
  float* sX = sC + 16 * 128;
  float* sDt = sX + 16 * 64;
  float* sDA = sDt + 16;
  float* sO = sDA + 16;
  const int tid = opaque_tid(), w = tid >> 6, lane = tid & 63;
  bf16_t* Z = (bf16_t*)(p.ws + OFF_Z) + (size_t)b * SEQ * ZS;
  const float* cw = p.in[I_MB_CONVW] + (size_t)l * 4 * 1024;
  const float* cb = p.in[I_MB_CONVB] + (size_t)l * 1024;
  int ci0, ci1;
  {
    int ch = tid;
    ci0 = (ch < 64) ? hd * 64 + ch : (ch < 192 ? 512 + g * 128 + (ch - 64) : 768 + g * 128 + (ch - 192));
    ci1 = 768 + g * 128 + 64 + (tid & 63);
  }
  float* dstA = (tid < 64) ? (sX + tid) : (tid < 192 ? (sB + (tid - 64)) : (sC + (tid - 192)));
  const int strideA = (tid < 64) ? 64 : 128;
  const float w0a = cw[ci0], w1a = cw[1024 + ci0], w2a = cw[2048 + ci0], w3a = cw[3072 + ci0], ba = cb[ci0];
  const float w0b = cw[ci1], w1b = cw[1024 + ci1], w2b = cw[2048 + ci1], w3b = cw[3072 + ci1], bb = cb[ci1];
  const float Aneg = -expf(p.in[I_MB_ALOG][l * 8 + hd]);
  const float dtb = p.in[I_MB_DTB][l * 8 + hd];
  const float Dsk = p.in[I_MB_D][l * 8 + hd];
  float s[32];
#pragma unroll
  for (int j = 0; j < 32; ++j) s[j] = 0.f;
  float pa1 = 0.f, pa2 = 0.f, pa3 = 0.f, pb1 = 0.f, pb2 = 0.f, pb3 = 0.f;
  const int xcol = ZMB + 512;
  const int rt = tid >> 4, rp4 = (tid & 15) * 4;
  bf16_t xa0, xa1, xa2, xa3, xa4, xa5, xa6, xa7, xa8, xa9, xa10, xa11, xa12, xa13, xa14, xa15;
  bf16_t xb0, xb1, xb2, xb3, xb4, xb5, xb6, xb7, xb8, xb9, xb10, xb11, xb12, xb13, xb14, xb15;
  bf16_t rdt;
  uint2 gcur, gnext;
#define MB_LOAD(T0)                                                                                 \
  {                                                                                                 \
    const bf16_t* za = Z + (size_t)(T0) * ZS + xcol + ci0;                                          \
    xa0 = za[0]; xa1 = za[ZS]; xa2 = za[2 * ZS]; xa3 = za[3 * ZS]; xa4 = za[4 * ZS]; xa5 = za[5 * ZS];        \
    xa6 = za[6 * ZS]; xa7 = za[7 * ZS]; xa8 = za[8 * ZS]; xa9 = za[9 * ZS]; xa10 = za[10 * ZS];     \
    xa11 = za[11 * ZS]; xa12 = za[12 * ZS]; xa13 = za[13 * ZS]; xa14 = za[14 * ZS]; xa15 = za[15 * ZS];       \
    if (tid < 64) {                                                                                 \
      const bf16_t* zb = Z + (size_t)(T0) * ZS + xcol + ci1;                                        \
      xb0 = zb[0]; xb1 = zb[ZS]; xb2 = zb[2 * ZS]; xb3 = zb[3 * ZS]; xb4 = zb[4 * ZS]; xb5 = zb[5 * ZS];      \
      xb6 = zb[6 * ZS]; xb7 = zb[7 * ZS]; xb8 = zb[8 * ZS]; xb9 = zb[9 * ZS]; xb10 = zb[10 * ZS];   \
      xb11 = zb[11 * ZS]; xb12 = zb[12 * ZS]; xb13 = zb[13 * ZS]; xb14 = zb[14 * ZS]; xb15 = zb[15 * ZS];     \
    }                                                                                               \
    rdt = Z[(size_t)((T0) + (tid & 15)) * ZS + ZMB + 1536 + hd];                                    \
    gnext = *reinterpret_cast<const uint2*>(Z + (size_t)((T0) + rt) * ZS + ZMB + hd * 64 + rp4);    \
  }
#define MB_CONV_A(T, XR)                                                                            \
  {                                                                                                 \
    float xv = bf2f(XR);                                                                            \
    dstA[(T)*strideA] = fsilu(ba + w0a * pa3 + w1a * pa2 + w2a * pa1 + w3a * xv);                   \
    pa3 = pa2; pa2 = pa1; pa1 = xv;                                                                 \
  }
#define MB_CONV_B(T, XR)                                                                            \
  {                                                                                                 \
    float xv = bf2f(XR);                                                                            \
    sC[(T)*128 + 64 + tid] = fsilu(bb + w0b * pb3 + w1b * pb2 + w2b * pb1 + w3b * xv);              \
    pb3 = pb2; pb2 = pb1; pb1 = xv;                                                                 \
  }
#define MB_PROCESS()                                                                                \
  {                                                                                                 \
    MB_CONV_A(0, xa0) MB_CONV_A(1, xa1) MB_CONV_A(2, xa2) MB_CONV_A(3, xa3) MB_CONV_A(4, xa4)       \
    MB_CONV_A(5, xa5) MB_CONV_A(6, xa6) MB_CONV_A(7, xa7) MB_CONV_A(8, xa8) MB_CONV_A(9, xa9)       \
    MB_CONV_A(10, xa10) MB_CONV_A(11, xa11) MB_CONV_A(12, xa12) MB_CONV_A(13, xa13)                 \
    MB_CONV_A(14, xa14) MB_CONV_A(15, xa15)                                                         \
    if (tid < 64) {                                                                                 \
      MB_CONV_B(0, xb0) MB_CONV_B(1, xb1) MB_CONV_B(2, xb2) MB_CONV_B(3, xb3) MB_CONV_B(4, xb4)     \
      MB_CONV_B(5, xb5) MB_CONV_B(6, xb6) MB_CONV_B(7, xb7) MB_CONV_B(8, xb8) MB_CONV_B(9, xb9)     \
      MB_CONV_B(10, xb10) MB_CONV_B(11, xb11) MB_CONV_B(12, xb12) MB_CONV_B(13, xb13)               \
      MB_CONV_B(14, xb14) MB_CONV_B(15, xb15)                                                       \
    }                                                                                               \
    if (tid < 16) {                                                                                 \
      float dt = fsoftplus(bf2f(rdt) + dtb);                                                        \
      sDt[tid] = dt;                                                                                \
      sDA[tid] = __expf(Aneg * dt);                                                                 \
    }                                                                                               \
    gcur = gnext;                                                                                   \
  }
  MB_LOAD(0);
  MB_PROCESS();
  __syncthreads();
  constexpr int NCH = SEQ / 16;
#pragma unroll 1
  for (int c = 0; c < NCH; ++c) {
    const int t0 = c * 16;
    const bool more = (c + 1 < NCH);
    const int tn = more ? t0 + 16 : t0;
    MB_LOAD(tn);
    __builtin_amdgcn_sched_barrier(0);
#pragma unroll 2
    for (int t = 0; t < 16; ++t) {
      const float dA = sDA[t];
      const float xdt = sX[t * 64 + lane] * sDt[t];
      const float opv = (lane < 32) ? sB[t * 128 + w * 32 + lane] : sC[t * 128 + w * 32 + (lane - 32)];
      const int opi = __builtin_bit_cast(int, opv);
      float y = 0.f;
#pragma unroll
      for (int j = 0; j < 32; ++j) {
        const float bn = __builtin_bit_cast(float, __builtin_amdgcn_readlane(opi, j));
        const float cn = __builtin_bit_cast(float, __builtin_amdgcn_readlane(opi, 32 + j));
        s[j] = fmaf(s[j], dA, bn * xdt);
        y = fmaf(cn, s[j], y);
      }
      sO[(w * 16 + t) * 64 + lane] = y;
    }
    __builtin_amdgcn_sched_barrier(0);
    __syncthreads();
    {
      float4 a = *reinterpret_cast<const float4*>(sO + (0 * 16 + rt) * 64 + rp4);
      float4 bq = *reinterpret_cast<const float4*>(sO + (1 * 16 + rt) * 64 + rp4);
      float4 cq = *reinterpret_cast<const float4*>(sO + (2 * 16 + rt) * 64 + rp4);
      float4 d = *reinterpret_cast<const float4*>(sO + (3 * 16 + rt) * 64 + rp4);
      float4 xs = *reinterpret_cast<const float4*>(sX + rt * 64 + rp4);
      bf16_t* gp = Z + (size_t)(t0 + rt) * ZS + ZMB + hd * 64 + rp4;
      float g0 = bf2f((bf16_t)(gcur.x & 0xffff)), g1 = bf2f((bf16_t)(gcur.x >> 16));
      float g2 = bf2f((bf16_t)(gcur.y & 0xffff)), g3 = bf2f((bf16_t)(gcur.y >> 16));
      float y0 = a.x + bq.x + cq.x + d.x + Dsk * xs.x;
      float y1 = a.y + bq.y + cq.y + d.y + Dsk * xs.y;
      float y2 = a.z + bq.z + cq.z + d.z + Dsk * xs.z;
      float y3 = a.w + bq.w + cq.w + d.w + Dsk * xs.w;
      uint2 o;
      o.x = pack2(y0 * fsilu(g0), y1 * fsilu(g1));
      o.y = pack2(y2 * fsilu(g2), y3 * fsilu(g3));
      *reinterpret_cast<uint2*>(gp) = o;
    }
    __syncthreads();
    if (more) MB_PROCESS();
    __syncthreads();
  }
#undef MB_LOAD
#undef MB_CONV_A
#undef MB_CONV_B
#undef MB_PROCESS
}

__device__ void s5_scan(const Params& p, int l, int task, char* smem) {
  const int tid = opaque_tid(), w = tid >> 6, lane = tid & 63;
  const int b = task >> 3, g = (task & 7) * 4 + w;
  float* base = reinterpret_cast<float*>(smem) + w * 3264;
  float* sU = base;
  float* sH = sU + 128;
  float* sC = sH + 8 * 65 * 2;
  bf16_t* Z = (bf16_t*)(p.ws + OFF_Z) + (size_t)b * SEQ * ZS + ZS5 + g * 16;
  const int n = lane;
  float lr, li, bbr[16], bbi[16];
  {
    float dt = expf(p.in[I_S5_LOGDT][l * 32 + g]);
    float are = p.in[I_S5_ARE][(l * 32 + g) * 64 + n], aim = p.in[I_S5_AIM][(l * 32 + g) * 64 + n];
    float mag = expf(dt * are);
    lr = mag * cosf(dt * aim); li = mag * sinf(dt * aim);
    float den = are * are + aim * aim;
    float cr = ((lr - 1.f) * are + li * aim) / den;
    float ci = (li * are - (lr - 1.f) * aim) / den;
    const float* bre = p.in[I_S5_BRE] + ((size_t)(l * 32 + g) * 64 + n) * 16;
    const float* bim = p.in[I_S5_BIM] + ((size_t)(l * 32 + g) * 64 + n) * 16;
#pragma unroll
    for (int c = 0; c < 16; ++c) {
      float br = bre[c], bi = bim[c];
      bbr[c] = cr * br - ci * bi;
      bbi[c] = cr * bi + ci * br;
    }
    const float* cre = p.in[I_S5_CRE] + (size_t)(l * 32 + g) * 16 * 64;
    const float* cim = p.in[I_S5_CIM] + (size_t)(l * 32 + g) * 16 * 64;
#pragma unroll
    for (int cp = 0; cp < 8; ++cp) {
      float4 v;
      v.x = cre[(2 * cp) * 64 + n]; v.y = cre[(2 * cp + 1) * 64 + n];
      v.z = cim[(2 * cp) * 64 + n]; v.w = cim[(2 * cp + 1) * 64 + n];
      *reinterpret_cast<float4*>(sC + (n * 8 + cp) * 4) = v;
    }
  }
  const int ot = lane >> 3, ocp = lane & 7;
  const float d0 = p.in[I_S5_D][l * 512 + g * 16 + 2 * ocp], d1 = p.in[I_S5_D][l * 512 + g * 16 + 2 * ocp + 1];
  float hr = 0.f, hi = 0.f;
  unsigned unext = *reinterpret_cast<const unsigned*>(Z + (size_t)ot * ZS + 2 * ocp);
  constexpr int NCH = SEQ / 8;
#pragma unroll 1
  for (int c = 0; c < NCH; ++c) {
    const int t0 = c * 8;
    const unsigned uraw = unext;
    const float u0 = bf2f((bf16_t)(uraw & 0xffff)), u1 = bf2f((bf16_t)(uraw >> 16));
    *reinterpret_cast<float2*>(sU + ot * 16 + 2 * ocp) = float2{u0, u1};
    {
      const int tn = (c + 1 < NCH) ? t0 + 8 : t0;
      unext = *reinterpret_cast<const unsigned*>(Z + (size_t)(tn + ot) * ZS + 2 * ocp);
    }
    __builtin_amdgcn_sched_barrier(0);
    __syncthreads();
#pragma unroll 2
    for (int t = 0; t < 8; ++t) {
      const float4* u4 = reinterpret_cast<const float4*>(sU + t * 16);
      float bur = 0.f, bui = 0.f;
#pragma unroll
      for (int q = 0; q < 4; ++q) {
        float4 u = u4[q];
        bur = fmaf(bbr[q * 4 + 0], u.x, bur); bui = fmaf(bbi[q * 4 + 0], u.x, bui);
        bur = fmaf(bbr[q * 4 + 1], u.y, bur); bui = fmaf(bbi[q * 4 + 1], u.y, bui);
        bur = fmaf(bbr[q * 4 + 2], u.z, bur); bui = fmaf(bbi[q * 4 + 2], u.z, bui);
        bur = fmaf(bbr[q * 4 + 3], u.w, bur); bui = fmaf(bbi[q * 4 + 3], u.w, bui);
      }
      float nr = lr * hr - li * hi + bur;
      float ni = lr * hi + li * hr + bui;
      hr = nr; hi = ni;
      *reinterpret_cast<float2*>(sH + (t * 65 + n) * 2) = float2{hr, hi};
    }
    __syncthreads();
    {
      float y0 = 0.f, y1 = 0.f, y2 = 0.f, y3 = 0.f;
#pragma unroll 8
      for (int nn = 0; nn < 64; nn += 2) {
        float2 hh = *reinterpret_cast<const float2*>(sH + (ot * 65 + nn) * 2);
        float4 cc = *reinterpret_cast<const float4*>(sC + (nn * 8 + ocp) * 4);
        float2 hh2 = *reinterpret_cast<const float2*>(sH + (ot * 65 + nn + 1) * 2);
        float4 cc2 = *reinterpret_cast<const float4*>(sC + ((nn + 1) * 8 + ocp) * 4);
        y0 = fmaf(cc.x, hh.x, y0); y0 = fmaf(-cc.z, hh.y, y0);
        y1 = fmaf(cc.y, hh.x, y1); y1 = fmaf(-cc.w, hh.y, y1);
        y2 = fmaf(cc2.x, hh2.x, y2); y2 = fmaf(-cc2.z, hh2.y, y2);
        y3 = fmaf(cc2.y, hh2.x, y3); y3 = fmaf(-cc2.w, hh2.y, y3);
      }
      y0 = fgelu(y0 + y2 + d0 * u0);
      y1 = fgelu(y1 + y3 + d1 * u1);
      *reinterpret_cast<unsigned*>(Z + (size_t)(t0 + ot) * ZS + 2 * ocp) = pack2(y0, y1);
    }
    __syncthreads();
  }
}

__device__ void rw_scan(const Params& p, int l, int task, char* smem) {
  const int b = task >> 3, h = task & 7;
  float* sR = reinterpret_cast<float*>(smem);
  float* sW = sR + 1024;
  float* sK = sW + 1024;
  float* sA = sK + 1024;
  float* sBb = sA + 1024;
  float* sV = sBb + 1024;
  float* sY = sV + 1024;
  float* sBonus = sY + 1024;
  const int tid = opaque_tid(), w = tid >> 6, lane = tid & 63;
  const size_t tokbase = (size_t)b * SEQ;
  bf16_t* Z = (bf16_t*)(p.ws + OFF_Z) + tokbase * ZS;
  const bf16_t* LW = (const bf16_t*)(p.ws + OFF_U) + tokbase * 512;
  const bf16_t* LA = LW + (size_t)T_TOK * 512;
  const bf16_t* VF = (const bf16_t*)(p.ws + OFF_VF) + tokbase * 512;
  const int st = tid >> 4, c4 = (tid & 15) * 4, ch = h * 64 + c4;
  float mur[4], muk[4], w0[4], a0[4], kk_[4], ka_[4], rk_[4], lnw[4], lnb[4];
#pragma unroll
  for (int e = 0; e < 4; ++e) {
    mur[e] = p.in[I_RW_MU][l * 1792 + ch + e];
    muk[e] = p.in[I_RW_MU][l * 1792 + 512 + ch + e];
    w0[e] = p.in[I_RW_W0][l * 512 + ch + e];
    a0[e] = p.in[I_RW_A0][l * 512 + ch + e];
    kk_[e] = p.in[I_RW_KK][l * 512 + ch + e];
    ka_[e] = p.in[I_RW_KA][l * 512 + ch + e];
    rk_[e] = p.in[I_RW_RK][l * 512 + ch + e];
    lnw[e] = p.in[I_RW_LNW][l * 512 + ch + e];
    lnb[e] = p.in[I_RW_LNB][l * 512 + ch + e];
  }
  const int rg = lane >> 3, kq = lane & 7, vrow = w * 16 + rg * 2;
  float S0[8], S1[8];
#pragma unroll
  for (int j = 0; j < 8; ++j) { S0[j] = 0.f; S1[j] = 0.f; }
  uint2 rc, kc, rp, kp, lwv, lav, vfv;
#define RW_LOAD(T0)                                                                                 \
  {                                                                                                 \
    const int s_ = (T0) + st;                                                                       \
    const bf16_t* zr = Z + (size_t)s_ * ZS + ZRW + ch;                                              \
    rc = *reinterpret_cast<const uint2*>(zr);                                                       \
    kc = *reinterpret_cast<const uint2*>(zr + 512);                                                 \
    rp = uint2{0u, 0u}; kp = uint2{0u, 0u};                                                         \
    if (s_ > 0) { rp = *reinterpret_cast<const uint2*>(zr - ZS); kp = *reinterpret_cast<const uint2*>(zr - ZS + 512); } \
    lwv = *reinterpret_cast<const uint2*>(LW + (size_t)s_ * 512 + ch);                              \
    lav = *reinterpret_cast<const uint2*>(LA + (size_t)s_ * 512 + ch);                              \
    vfv = *reinterpret_cast<const uint2*>(VF + (size_t)s_ * 512 + ch);                              \
  }
#define RW_PROCESS()                                                                                \
  {                                                                                                 \
    float r4[4], k4[4], kkv[4], av[4], wv[4], vv[4];                                                \
    float n2 = 0.f;                                                                                 \
    _Pragma("unroll") for (int e = 0; e < 4; ++e) {                                                 \
      unsigned rcw = (e < 2) ? rc.x : rc.y, kcw = (e < 2) ? kc.x : kc.y, rpw = (e < 2) ? rp.x : rp.y, kpw = (e < 2) ? kp.x : kp.y; \
      unsigned lww = (e < 2) ? lwv.x : lwv.y, law = (e < 2) ? lav.x : lav.y, vfw = (e < 2) ? vfv.x : vfv.y; \
      int sh = (e & 1) * 16;                                                                        \
      float rcur = bf2f((bf16_t)((rcw >> sh) & 0xffff)), rprev = bf2f((bf16_t)((rpw >> sh) & 0xffff)); \
      float kcur = bf2f((bf16_t)((kcw >> sh) & 0xffff)), kprev = bf2f((bf16_t)((kpw >> sh) & 0xffff)); \
      float lwf = bf2f((bf16_t)((lww >> sh) & 0xffff)), laf = bf2f((bf16_t)((law >> sh) & 0xffff)); \
      vv[e] = bf2f((bf16_t)((vfw >> sh) & 0xffff));                                                 \
      r4[e] = rcur + (rprev - rcur) * mur[e];                                                       \
      k4[e] = kcur + (kprev - kcur) * muk[e];                                                       \
      float wlog = -fsoftplus(-(w0[e] + lwf)) - 0.5f;                                               \
      wv[e] = __expf(-__expf(wlog));                                                                \
      av[e] = fsigmoid(a0[e] + laf);                                                                \
      kkv[e] = k4[e] * kk_[e];                                                                      \
      n2 += kkv[e] * kkv[e];                                                                        \
    }                                                                                               \
    n2 = sum16(n2);                                                                                 \
    float inv = 1.f / fmaxf(sqrtf(n2), 1e-12f);                                                     \
    float bon = 0.f;                                                                                \
    float kt4[4], ap4[4], bp4[4];                                                                   \
    _Pragma("unroll") for (int e = 0; e < 4; ++e) {                                                 \
      float kkn = kkv[e] * inv;                                                                     \
      kt4[e] = k4[e] * (1.f + (av[e] - 1.f) * ka_[e]);                                              \
      ap4[e] = -kkn;                                                                                \
      bp4[e] = kkn * av[e];                                                                         \
      bon += r4[e] * kt4[e] * rk_[e];                                                               \
    }                                                                                               \
    bon = sum16(bon);                                                                               \
    *reinterpret_cast<float4*>(sR + st * 64 + c4) = float4{r4[0], r4[1], r4[2], r4[3]};             \
    *reinterpret_cast<float4*>(sW + st * 64 + c4) = float4{wv[0], wv[1], wv[2], wv[3]};             \
    *reinterpret_cast<float4*>(sK + st * 64 + c4) = float4{kt4[0], kt4[1], kt4[2], kt4[3]};         \
    *reinterpret_cast<float4*>(sA + st * 64 + c4) = float4{ap4[0], ap4[1], ap4[2], ap4[3]};         \
    *reinterpret_cast<float4*>(sBb + st * 64 + c4) = float4{bp4[0], bp4[1], bp4[2], bp4[3]};        \
    *reinterpret_cast<float4*>(sV + st * 64 + c4) = float4{vv[0], vv[1], vv[2], vv[3]};             \
    if ((tid & 15) == 0) sBonus[st] = bon;                                                          \
  }
  RW_LOAD(0);
  RW_PROCESS();
  __syncthreads();
  constexpr int NCH = SEQ / 16;
#pragma unroll 1
  for (int c = 0; c < NCH; ++c) {
    const int t0 = c * 16;
    const int tn = (c + 1 < NCH) ? t0 + 16 : t0;
    RW_LOAD(tn);
    __builtin_amdgcn_sched_barrier(0);
#pragma unroll 2
    for (int t = 0; t < 16; ++t) {
      const float4* a4p = reinterpret_cast<const float4*>(sA + t * 64 + kq * 8);
      const float4* w4p = reinterpret_cast<const float4*>(sW + t * 64 + kq * 8);
      const float4* b4p = reinterpret_cast<const float4*>(sBb + t * 64 + kq * 8);
      const float4* k4p = reinterpret_cast<const float4*>(sK + t * 64 + kq * 8);
      const float4* r4p = reinterpret_cast<const float4*>(sR + t * 64 + kq * 8);
      const float2 vv = *reinterpret_cast<const float2*>(sV + t * 64 + vrow);
      float sa0 = 0.f, sa1 = 0.f;
#pragma unroll
      for (int q = 0; q < 2; ++q) {
        float4 a = a4p[q];
        sa0 = fmaf(S0[q * 4 + 0], a.x, sa0); sa1 = fmaf(S1[q * 4 + 0], a.x, sa1);
        sa0 = fmaf(S0[q * 4 + 1], a.y, sa0); sa1 = fmaf(S1[q * 4 + 1], a.y, sa1);
        sa0 = fmaf(S0[q * 4 + 2], a.z, sa0); sa1 = fmaf(S1[q * 4 + 2], a.z, sa1);
        sa0 = fmaf(S0[q * 4 + 3], a.w, sa0); sa1 = fmaf(S1[q * 4 + 3], a.w, sa1);
      }
      sa0 = oct_sum(sa0); sa1 = oct_sum(sa1);
      float y0 = 0.f, y1 = 0.f;
#pragma unroll
      for (int q = 0; q < 2; ++q) {
        float4 ww = w4p[q], bb = b4p[q], kk = k4p[q], rr = r4p[q];
        S0[q * 4 + 0] = fmaf(S0[q * 4 + 0], ww.x, fmaf(sa0, bb.x, vv.x * kk.x)); y0 = fmaf(S0[q * 4 + 0], rr.x, y0);
        S1[q * 4 + 0] = fmaf(S1[q * 4 + 0], ww.x, fmaf(sa1, bb.x, vv.y * kk.x)); y1 = fmaf(S1[q * 4 + 0], rr.x, y1);
        S0[q * 4 + 1] = fmaf(S0[q * 4 + 1], ww.y, fmaf(sa0, bb.y, vv.x * kk.y)); y0 = fmaf(S0[q * 4 + 1], rr.y, y0);
        S1[q * 4 + 1] = fmaf(S1[q * 4 + 1], ww.y, fmaf(sa1, bb.y, vv.y * kk.y)); y1 = fmaf(S1[q * 4 + 1], rr.y, y1);
        S0[q * 4 + 2] = fmaf(S0[q * 4 + 2], ww.z, fmaf(sa0, bb.z, vv.x * kk.z)); y0 = fmaf(S0[q * 4 + 2], rr.z, y0);
        S1[q * 4 + 2] = fmaf(S1[q * 4 + 2], ww.z, fmaf(sa1, bb.z, vv.y * kk.z)); y1 = fmaf(S1[q * 4 + 2], rr.z, y1);
        S0[q * 4 + 3] = fmaf(S0[q * 4 + 3], ww.w, fmaf(sa0, bb.w, vv.x * kk.w)); y0 = fmaf(S0[q * 4 + 3], rr.w, y0);
        S1[q * 4 + 3] = fmaf(S1[q * 4 + 3], ww.w, fmaf(sa1, bb.w, vv.y * kk.w)); y1 = fmaf(S1[q * 4 + 3], rr.w, y1);
      }
      y0 = oct_sum(y0); y1 = oct_sum(y1);
      if (kq == 0) *reinterpret_cast<float2*>(sY + t * 64 + vrow) = float2{y0, y1};
    }
    __builtin_amdgcn_sched_barrier(0);
    __syncthreads();
    {
      float4 y4 = *reinterpret_cast<const float4*>(sY + st * 64 + c4);
      float4 v4 = *reinterpret_cast<const float4*>(sV + st * 64 + c4);
      float bon = sBonus[st];
      float mean = sum16(y4.x + y4.y + y4.z + y4.w) * (1.f / 64.f);
      float dx = y4.x - mean, dy = y4.y - mean, dz = y4.z - mean, dw = y4.w - mean;
      float var = sum16(dx * dx + dy * dy + dz * dz + dw * dw) * (1.f / 64.f);
      float rs = rsqrtf(var + 64e-5f);
      float o0 = dx * rs * lnw[0] + lnb[0] + bon * v4.x;
      float o1 = dy * rs * lnw[1] + lnb[1] + bon * v4.y;
      float o2 = dz * rs * lnw[2] + lnb[2] + bon * v4.z;
      float o3 = dw * rs * lnw[3] + lnb[3] + bon * v4.w;
      uint2 o;
      o.x = pack2(o0, o1); o.y = pack2(o2, o3);
      *reinterpret_cast<uint2*>(Z + (size_t)(t0 + st) * ZS + ZRW + 1024 + ch) = o;
    }
    RW_PROCESS();
    __syncthreads();
  }
#undef RW_LOAD
#undef RW_PROCESS
}

__device__ void phase_scans(const Params& p, int l, char* smem, int scan_mask = 15) {
  for (int t = blockIdx.x; t < 256; t += gridDim.x) {
    int type = t & 3, idx = t >> 2;
    if (!((scan_mask >> type) & 1)) continue;
#ifndef SCM
#define SCM 15
#endif
    if (type == 0) { if (SCM & 1) rw_scan(p, l, idx, smem); }
    else if (type == 1) { if (SCM & 2) hg_scan(p, l, idx, smem); }
    else if (type == 2) { if (SCM & 4) mb_scan(p, l, idx, smem); }
    else { if (SCM & 8) s5_scan(p, l, idx, smem); }
    __syncthreads();
  }
}

__device__ __forceinline__ void unpack8(const uint4& v, float (&f)[8]) {
  f[0] = bf2f((bf16_t)(v.x & 0xffff)); f[1] = bf2f((bf16_t)(v.x >> 16));
  f[2] = bf2f((bf16_t)(v.y & 0xffff)); f[3] = bf2f((bf16_t)(v.y >> 16));
  f[4] = bf2f((bf16_t)(v.z & 0xffff)); f[5] = bf2f((bf16_t)(v.z >> 16));
  f[6] = bf2f((bf16_t)(v.w & 0xffff)); f[7] = bf2f((bf16_t)(v.w >> 16));
}

__device__ void phase_post(const Params& p, int l, char* smem) {
  bf16_t* Z = (bf16_t*)(p.ws + OFF_Z);
  const int tid = opaque_tid(), lane = tid & 63, wid = tid >> 6;
  constexpr int N_ROWT = T_TOK / 4, N_RWT = T_TOK / 16, N_GLU = 128 * 4, N_NORM = T_TOK / 4;
  const float* xsrc = (l == 0) ? p.in[I_X] : p.out;
  for (int t = blockIdx.x; t < N_ROWT + N_RWT + N_GLU + N_NORM; t += gridDim.x) {
    if (t < N_ROWT) {
      const int row = t * 4 + wid;
      {
        bf16_t* op = Z + (size_t)row * ZS + ZHG + 1024 + lane * 8;
        uint4 ov = *reinterpret_cast<const uint4*>(op);
        uint4 gv = *reinterpret_cast<const uint4*>(op + 512);
        float o[8], g[8];
        unpack8(ov, o); unpack8(gv, g);
        float ss = 0.f;
#pragma unroll
        for (int e = 0; e < 8; ++e) ss += o[e] * o[e];
        ss = sum16(ss);
        float rstd = rsqrtf(ss * (1.f / 128.f) + 1e-6f);
        const float* nw = p.in[I_HG_NW] + l * 512 + lane * 8;
        float r[8];
#pragma unroll
        for (int e = 0; e < 8; ++e) r[e] = o[e] * rstd * nw[e] * siluf_(g[e]);
        *reinterpret_cast<uint4*>(op) = uint4{pack2(r[0], r[1]), pack2(r[2], r[3]), pack2(r[4], r[5]), pack2(r[6], r[7])};
      }
      {
        bf16_t* op = Z + (size_t)row * ZS + ZMB + lane * 8;
        uint4 ov = *reinterpret_cast<const uint4*>(op);
        float o[8];
        unpack8(ov, o);
        float ss = 0.f;
#pragma unroll
        for (int e = 0; e < 8; ++e) ss += o[e] * o[e];
        ss = sum64(ss);
        float rstd = rsqrtf(ss * (1.f / 512.f) + 1e-6f);
        const float* nw = p.in[I_MB_NW] + l * 512 + lane * 8;
        float r[8];
#pragma unroll
        for (int e = 0; e < 8; ++e) r[e] = o[e] * rstd * nw[e];
        *reinterpret_cast<uint4*>(op) = uint4{pack2(r[0], r[1]), pack2(r[2], r[3]), pack2(r[4], r[5]), pack2(r[6], r[7])};
      }
    } else if (t < N_ROWT + N_RWT) {
      const int row0 = (t - N_ROWT) * 16;
      float* sXg = reinterpret_cast<float*>(smem);
      const float* mu = p.in[I_RW_MU] + l * 1792 + 1664;
      for (int e = tid; e < 2048; e += 256) {
        int j = e >> 4, tok = e & 15;
        int row = row0 + tok, s = row & (SEQ - 1);
        sXg[j * 16 + tok] = sigmoidf_(rw_shift(Z, row, s, 1664 + j, mu[j]));
      }
      __syncthreads();
      float a0[16], a1[16];
      lora_mm<128>(sXg, p.in[I_RW_G2] + (size_t)l * 128 * 512, a0, a1, tid);
#pragma unroll
      for (int tok = 0; tok < 16; ++tok) {
        bf16_t* yp = Z + (size_t)(row0 + tok) * ZS + ZRW + 1024 + tid;
        yp[0] = f2bf(bf2f(yp[0]) * a0[tok]);
        yp[256] = f2bf(bf2f(yp[256]) * a1[tok]);
      }
      __syncthreads();
    } else if (t < N_ROWT + N_RWT + N_GLU) {
      const int tt = t - N_ROWT - N_RWT, mt = tt >> 2, nt = tt & 3;
      const int wm = wid >> 1, wn = wid & 1;
      f32x4 acc[4][4];
      zero_acc<128>(acc);
      gemm_mainloop<128>(acc, Z + ZS5, ZS, mt * 128, (const bf16_t*)(p.ws + OFF_WTGLU), 512, nt * 128, 511, 512, smem, tid);
      const float* bg = p.in[I_S5_BGLU] + l * 512;
#pragma unroll
      for (int mi = 0; mi < 4; ++mi)
#pragma unroll
        for (int ni = 0; ni < 4; ++ni) {
          int col = nt * 128 + wn * 64 + ni * 16 + (lane >> 4) * 4;
          int row = mt * 128 + wm * 64 + mi * 16 + (lane & 15);
          float4 b4 = *reinterpret_cast<const float4*>(bg + col);
          uint2 yv = *reinterpret_cast<const uint2*>(Z + (size_t)row * ZS + ZS5 + col);
          float y0 = bf2f((bf16_t)(yv.x & 0xffff)), y1 = bf2f((bf16_t)(yv.x >> 16));
          float y2 = bf2f((bf16_t)(yv.y & 0xffff)), y3 = bf2f((bf16_t)(yv.y >> 16));
          uint2 o;
          o.x = pack2(y0 * sigmoidf_(acc[mi][ni][0] + b4.x), y1 * sigmoidf_(acc[mi][ni][1] + b4.y));
          o.y = pack2(y2 * sigmoidf_(acc[mi][ni][2] + b4.z), y3 * sigmoidf_(acc[mi][ni][3] + b4.w));
          *reinterpret_cast<uint2*>(Z + (size_t)row * ZS + ZMB + 1024 + col) = o;
        }
    } else {
      const int row = (t - N_ROWT - N_RWT - N_GLU) * 4 + wid;
      rmsnorm_row_to_bf16(xsrc + (size_t)row * DM, p.in[I_NORM_MIX] + l * DM, (bf16_t*)(p.ws + OFF_U) + (size_t)row * DM, tid & 63);
    }
  }
}

__device__ void phase_merge(const Params& p, char* smem) {
  bf16_t* Z = (bf16_t*)(p.ws + OFF_Z);
  const bf16_t* U = (const bf16_t*)(p.ws + OFF_U);
  const bf16_t* Wg = (const bf16_t*)(p.ws + OFF_WTGATE);
  const bf16_t* Wb = (const bf16_t*)(p.ws + OFF_WTBR);
  const int tid = opaque_tid();
  const int lane = tid & 63, wid = tid >> 6, wm = wid >> 1, wn = wid & 1;
  for (int t = blockIdx.x; t < 128 * 16; t += gridDim.x) {
    const int mt = t >> 4, nt = t & 15;
    f32x4 accm[4][2];
    zero_acc<64>(accm);
    for (int kb = 0; kb < 4; ++kb) {
      f32x4 g[4][2], pr[4][2];
      zero_acc<64>(g);
      zero_acc<64>(pr);
      gemm_mainloop<64>(g, U, 1024, mt * 128, Wg + (size_t)kb * 1024 * 1024, 1024, nt * 64, 1023, 1024, smem, tid);
      const int ycol = (kb == 0) ? (ZHG + 1024) : (kb == 1) ? (ZRW + 1024) : (kb == 2) ? (ZMB + 1024) : ZMB;
      gemm_mainloop<64>(pr, Z + ycol, ZS, mt * 128, Wb + (size_t)kb * 1024 * 512, 512, nt * 64, 1023, 512, smem, tid);
#pragma unroll
      for (int mi = 0; mi < 4; ++mi)
#pragma unroll
        for (int ni = 0; ni < 2; ++ni)
#pragma unroll
          for (int j = 0; j < 4; ++j) accm[mi][ni][j] = fmaf(sigmoidf_(g[mi][ni][j]), pr[mi][ni][j], accm[mi][ni][j]);
    }
#pragma unroll
    for (int mi = 0; mi < 4; ++mi)
#pragma unroll
      for (int ni = 0; ni < 2; ++ni) {
        int col = nt * 64 + wn * 32 + ni * 16 + (lane >> 4) * 4;
        int row = mt * 128 + wm * 64 + mi * 16 + (lane & 15);
        uint2 o;
        o.x = pack2(accm[mi][ni][0], accm[mi][ni][1]);
        o.y = pack2(accm[mi][ni][2], accm[mi][ni][3]);
        *reinterpret_cast<uint2*>(Z + (size_t)row * ZS + col) = o;
      }
  }
}

__device__ void phase_resid_gemm(const Params& p, const bf16_t* A, int lda, const bf16_t* Wt, int K, const float* xold, char* smem) {
  const int tid = opaque_tid();
  const int lane = tid & 63, wid = tid >> 6, wm = wid >> 1, wn = wid & 1;
  for (int t = blockIdx.x; t < 128 * 8; t += gridDim.x) {
    const int mt = t >> 3, nt = t & 7;
    f32x4 acc[4][4];
    zero_acc<128>(acc);
    gemm_mainloop<128>(acc, A, lda, mt * 128, Wt, K, nt * 128, 1023, K, smem, tid);
#pragma unroll
    for (int mi = 0; mi < 4; ++mi)
#pragma unroll
      for (int ni = 0; ni < 4; ++ni) {
        int col = nt * 128 + wn * 64 + ni * 16 + (lane >> 4) * 4;
        int row = mt * 128 + wm * 64 + mi * 16 + (lane & 15);
        size_t o = (size_t)row * DM + col;
        float4 xo = *reinterpret_cast<const float4*>(xold + o);
        float4 r = float4{xo.x + acc[mi][ni][0], xo.y + acc[mi][ni][1], xo.z + acc[mi][ni][2], xo.w + acc[mi][ni][3]};
        *reinterpret_cast<float4*>(p.out + o) = r;
      }
  }
}

__device__ void phase_ffn_in(const Params& p, char* smem) {
  const bf16_t* U = (const bf16_t*)(p.ws + OFF_U);
  const bf16_t* Wt = (const bf16_t*)(p.ws + OFF_WTF1);
  bf16_t* H = (bf16_t*)(p.ws + OFF_Z);
  const int tid = opaque_tid();
  const int lane = tid & 63, wid = tid >> 6, wm = wid >> 1, wn = wid & 1;
  for (int t = blockIdx.x; t < 128 * 44; t += gridDim.x) {
    const int mt = t / 44, nt = t % 44;
    f32x4 acc[4][4];
    zero_acc<128>(acc);
    gemm_mainloop<128>(acc, U, 1024, mt * 128, Wt, 1024, nt * 128, 5631, 1024, smem, tid);
#pragma unroll
    for (int mi = 0; mi < 4; ++mi)
#pragma unroll
      for (int q = 0; q < 2; ++q) {
        int hcol = ((nt * 128 + wn * 64 + q * 32) >> 1) + (lane >> 4) * 4;
        int row = mt * 128 + wm * 64 + mi * 16 + (lane & 15);
        uint2 o;
        o.x = pack2(siluf_(acc[mi][2 * q][0]) * acc[mi][2 * q + 1][0], siluf_(acc[mi][2 * q][1]) * acc[mi][2 * q + 1][1]);
        o.y = pack2(siluf_(acc[mi][2 * q][2]) * acc[mi][2 * q + 1][2], siluf_(acc[mi][2 * q][3]) * acc[mi][2 * q + 1][3]);
        *reinterpret_cast<uint2*>(H + (size_t)row * FFH + hcol) = o;
      }
  }
}

__device__ void phase_final(const Params& p) {
  const int tid = opaque_tid();
  const int lane = tid & 63;
  const float* w = p.in[I_NORM_FINAL];
  for (int t = blockIdx.x; t < T_TOK / 4; t += gridDim.x) {
    int row = t * 4 + (tid >> 6);
    float* x = p.out + (size_t)row * DM;
    float4 v[4];
    float ss = 0.f;
#pragma unroll
    for (int i = 0; i < 4; ++i) {
      v[i] = *reinterpret_cast<const float4*>(x + i * 256 + lane * 4);
      ss += v[i].x * v[i].x + v[i].y * v[i].y + v[i].z * v[i].z + v[i].w * v[i].w;
    }
    ss = sum64(ss);
    float rstd = rsqrtf(ss * (1.f / 1024.f) + 1e-6f);
#pragma unroll
    for (int i = 0; i < 4; ++i) {
      float4 ww = *reinterpret_cast<const float4*>(w + i * 256 + lane * 4);
      float4 o = float4{v[i].x * rstd * ww.x, v[i].y * rstd * ww.y, v[i].z * rstd * ww.z, v[i].w * rstd * ww.w};
      *reinterpret_cast<float4*>(x + i * 256 + lane * 4) = o;
    }
  }
}

template <int SUB>
__device__ __forceinline__ void run_phase(const Params& p, int l, char* smem) {
  if (SUB == 0) phase_convert_norm(p, l, smem);
  else if (SUB == 1) phase_inproj(p, smem);
  else if (SUB == 2) phase_rwprep(p, l, smem);
  else if (SUB == 3) phase_scans(p, l, smem);
  else if (SUB == 4) phase_post(p, l, smem);
  else if (SUB == 5) phase_merge(p, smem);
  else if (SUB == 6) phase_resid_gemm(p, (const bf16_t*)(p.ws + OFF_Z), ZS, (const bf16_t*)(p.ws + OFF_WTOUT), 1024,
                                      (l == 0) ? p.in[I_X] : p.out, smem);
  else if (SUB == 7) phase_norm_only(p, p.out, p.in[I_NORM_FFN] + l * DM);
  else if (SUB == 8) phase_ffn_in(p, smem);
  else if (SUB == 9) phase_resid_gemm(p, (const bf16_t*)(p.ws + OFF_Z), FFH, (const bf16_t*)(p.ws + OFF_WTF2), FFH, p.out, smem);
  else phase_final(p);
}

#ifndef PHM
#define PHM 0xFFFF
#endif
__device__ __forceinline__ void grid_bar(unsigned* ctr, unsigned& target) {
  asm volatile("s_waitcnt vmcnt(0)" ::: "memory");
  __syncthreads();
  if (threadIdx.x == 0) {
    target += gridDim.x;
    __builtin_amdgcn_fence(__ATOMIC_RELEASE, "agent");
    __hip_atomic_fetch_add(ctr, 1u, __ATOMIC_RELAXED, __HIP_MEMORY_SCOPE_AGENT);
    while (__hip_atomic_load(ctr, __ATOMIC_RELAXED, __HIP_MEMORY_SCOPE_AGENT) < target) __builtin_amdgcn_s_sleep(32);
    __builtin_amdgcn_fence(__ATOMIC_ACQUIRE, "agent");
    asm volatile("s_waitcnt vmcnt(0)" ::: "memory");
  }
  __syncthreads();
}

#if COOP
__global__ void __launch_bounds__(256, 2) fwd_kernel(Params p, int ph0, int ph1, int scan_mask) {
  __shared__ __attribute__((aligned(16))) char smem[65536];
  cg::grid_group grid = cg::this_grid();
  unsigned* bar_ctr = reinterpret_cast<unsigned*>(p.ws + OFF_BAR);
  unsigned bar_target = 0;
  for (int ph = ph0; ph < ph1; ++ph) {
    if (ph == NPHASES - 1) {
      phase_final(p);
    } else {
      const int l = ph / NPH_LAYER, sub = ph % NPH_LAYER;
      switch (sub) {
        case 0: if (PHM & (1<<0)) run_phase<0>(p, l, smem); break;
        case 1: if (PHM & (1<<1)) run_phase<1>(p, l, smem); break;
        case 2: if (PHM & (1<<2)) run_phase<2>(p, l, smem); break;
        case 3: if (PHM & (1<<3)) phase_scans(p, l, smem, scan_mask); break;
        case 4: if (PHM & (1<<4)) run_phase<4>(p, l, smem); break;
        case 5: if (PHM & (1<<5)) run_phase<5>(p, l, smem); break;
        case 6: if (PHM & (1<<6)) run_phase<6>(p, l, smem); break;
        case 7: if (PHM & (1<<7)) run_phase<7>(p, l, smem); break;
        case 8: if (PHM & (1<<8)) run_phase<8>(p, l, smem); break;
        case 9: if (PHM & (1<<9)) run_phase<9>(p, l, smem); break;
      }
    }
    if (ph + 1 < ph1) {
      if (ph == ph0) grid.sync();
      else grid_bar(bar_ctr, bar_target);
    }
  }
}
#else
template <int SUB>
__global__ void __launch_bounds__(256, 2) k_phase(Params p, int l) {
  __shared__ __attribute__((aligned(16))) char smem[65536];
  run_phase<SUB>(p, l, smem);
}
#endif

extern "C" void kernel_launch(void* const* d_in, const int* in_sizes, int n_in, void* d_out, int out_size, void* d_ws,
                              size_t ws_size, hipStream_t stream) {
  if (n_in < 41 || ws_size < WS_NEED) {
    fprintf(stderr, "kernel_launch: bad args n_in=%d ws=%zu need=%zu\n", n_in, ws_size, (size_t)WS_NEED);
    return;
  }
  Params p{};
  for (int i = 0; i < 41; ++i) p.in[i] = (const float*)d_in[i];
  p.out = (float*)d_out;
  p.ws = (char*)d_ws;
#if COOP
  static int grid_blocks = 0;
  if (!grid_blocks) {
    int dev = 0, cus = 0, per_cu = 0;
    hipGetDevice(&dev);
    hipDeviceGetAttribute(&cus, hipDeviceAttributeMultiprocessorCount, dev);
    hipOccupancyMaxActiveBlocksPerMultiprocessor(&per_cu, fwd_kernel, 256, 0);
    if (per_cu > 2) per_cu = 2;
    grid_blocks = cus * per_cu;
  }
#ifdef HYBRID
  for (int ph = 0; ph < NPHASES; ++ph) {
    if (ph % 10 == 3 && ph < 20) {
      const int groups[4] = SCAN_GROUPS;
      for (int gi = 0; gi < 4; ++gi) if (groups[gi]) fwd_kernel<<<grid_blocks, 256, 0, stream>>>(p, ph, ph + 1, groups[gi]);
    } else {
      fwd_kernel<<<grid_blocks, 256, 0, stream>>>(p, ph, ph + 1, 15);
    }
  }
#else
  hipMemsetAsync((char*)d_ws + OFF_BAR, 0, 256, stream);
  int ph0 = 0, ph1 = NPHASES, smask = 15;
  void* args[] = {&p, &ph0, &ph1, &smask};
  hipError_t e = hipLaunchCooperativeKernel((void*)fwd_kernel, dim3(grid_blocks), dim3(256), args, 0, stream);
  if (e != hipSuccess) fprintf(stderr, "cooperative launch failed: %s (grid %d)\n", hipGetErrorString(e), grid_blocks);
#endif
#else
  const dim3 g(512), b(256);
  for (int l = 0; l < 2; ++l) {
    k_phase<0><<<g, b, 0, stream>>>(p, l);
    k_phase<1><<<g, b, 0, stream>>>(p, l);
    k_phase<2><<<g, b, 0, stream>>>(p, l);
    k_phase<3><<<g, b, 0, stream>>>(p, l);
    k_phase<4><<<g, b, 0, stream>>>(p, l);
    k_phase<5><<<g, b, 0, stream>>>(p, l);
    k_phase<6><<<g, b, 0, stream>>>(p, l);
    k_phase<7><<<g, b, 0, stream>>>(p, l);
    k_phase<8><<<g, b, 0, stream>>>(p, l);
    k_phase<9><<<g, b, 0, stream>>>(p, l);
  }
  k_phase<10><<<g, b, 0, stream>>>(p, 0);
#endif
}
```

```cpp
#include <hip/hip_runtime.h>
#include <hip/hip_cooperative_groups.h>
#include <cstdio>
#include <cstdint>
namespace cg = cooperative_groups;

#ifndef COOP
#define COOP 1
#endif

typedef unsigned short bf16_t;
typedef __attribute__((ext_vector_type(8))) short bf16x8;
typedef __attribute__((ext_vector_type(4))) float f32x4;
typedef __attribute__((ext_vector_type(4))) unsigned u32x4;

constexpr int T_TOK = 16384, SEQ = 2048, DM = 1024;
constexpr int IN_COLS = 9992, NZ = 5896, ZS = 5904;
constexpr int ZHG = 0, ZRW = 2048, ZS5 = 3840, ZMB = 4352;
constexpr int FFH = 2816;
constexpr int NPH_LAYER = 10, NPHASES = 21;

constexpr size_t OFF_WTIN   = 0;
constexpr size_t OFF_WTGATE = OFF_WTIN + (size_t)5896 * 1024 * 2;
constexpr size_t OFF_WTBR   = OFF_WTGATE + (size_t)4096 * 1024 * 2;
constexpr size_t OFF_WTOUT  = OFF_WTBR + (size_t)4 * 1024 * 512 * 2;
constexpr size_t OFF_WTF1   = OFF_WTOUT + (size_t)1024 * 1024 * 2;
constexpr size_t OFF_WTF2   = OFF_WTF1 + (size_t)5632 * 1024 * 2;
constexpr size_t OFF_WTGLU  = OFF_WTF2 + (size_t)1024 * 2816 * 2;
constexpr size_t OFF_U      = OFF_WTGLU + (size_t)512 * 512 * 2;
constexpr size_t OFF_Z      = OFF_U + (size_t)T_TOK * 1024 * 2;
constexpr size_t OFF_VF     = OFF_Z + (size_t)T_TOK * ZS * 2;
constexpr size_t OFF_BAR    = OFF_VF + (size_t)T_TOK * 512 * 2;
constexpr size_t WS_NEED    = OFF_BAR + 256;

struct Params {
  const float* in[41];
  float* out;
  char* ws;
};

enum { I_X = 0, I_NORM_MIX, I_W_IN, I_W_BRANCH, I_W_OUT, I_NORM_FFN, I_W_FFN_IN, I_W_FFN_OUT, I_NORM_FINAL,
       I_HG_LB, I_HG_NW, I_RW_MU, I_RW_W0, I_RW_W2, I_RW_A0, I_RW_A2, I_RW_G2, I_RW_KK, I_RW_KA, I_RW_RK,
       I_RW_LNW, I_RW_LNB, I_RW_V0, I_RW_V1, I_RW_V2, I_S5_ARE, I_S5_AIM, I_S5_BRE, I_S5_BIM, I_S5_CRE,
       I_S5_CIM, I_S5_D, I_S5_LOGDT, I_S5_WGLU, I_S5_BGLU, I_MB_CONVW, I_MB_CONVB, I_MB_DTB, I_MB_ALOG,
       I_MB_D, I_MB_NW };

__device__ __forceinline__ float bf2f(bf16_t v) { return __uint_as_float(((unsigned)v) << 16); }
typedef __attribute__((ext_vector_type(2))) __bf16 bf16x2_t;
__device__ __forceinline__ unsigned pack2(float a, float b) {
  bf16x2_t v;
  v[0] = (__bf16)a;
  v[1] = (__bf16)b;
  return __builtin_bit_cast(unsigned, v);
}
__device__ __forceinline__ bf16_t f2bf(float f) { return (bf16_t)(pack2(f, 0.f) & 0xffffu); }
__device__ __forceinline__ float sigmoidf_(float x) { return 1.f / (1.f + __expf(-x)); }
__device__ __forceinline__ float siluf_(float x) { return x / (1.f + __expf(-x)); }
__device__ __forceinline__ float softplusf_(float x) { return x > 20.f ? x : log1pf(__expf(x)); }
__device__ __forceinline__ float gelu_tanh(float x) {
  float u = 0.7978845608028654f * (x + 0.044715f * x * x * x);
  return 0.5f * x * (1.f + tanhf(u));
}
__device__ __forceinline__ float quad_sum(float x) {
  x += __builtin_bit_cast(float, __builtin_amdgcn_update_dpp(0, __builtin_bit_cast(int, x), 0xB1, 0xF, 0xF, true));
  x += __builtin_bit_cast(float, __builtin_amdgcn_update_dpp(0, __builtin_bit_cast(int, x), 0x4E, 0xF, 0xF, true));
  return x;
}
__device__ __forceinline__ float oct_sum(float x) {
  x = quad_sum(x);
  x += __builtin_bit_cast(float, __builtin_amdgcn_update_dpp(0, __builtin_bit_cast(int, x), 0x141, 0xF, 0xF, true));
  return x;
}
__device__ __forceinline__ float sum16(float x) {
  x += __shfl_xor(x, 1); x += __shfl_xor(x, 2); x += __shfl_xor(x, 4); x += __shfl_xor(x, 8);
  return x;
}
__device__ __forceinline__ float sum64(float x) {
  x = sum16(x); x += __shfl_xor(x, 16); x += __shfl_xor(x, 32);
  return x;
}

__device__ __forceinline__ int opaque_tid() {
  int t = threadIdx.x;
  asm volatile("" : "+v"(t));
  return t;
}

template <int BN>
__device__ __forceinline__ void gemm_mainloop(f32x4 (&acc)[4][BN / 32], const bf16_t* A, int lda, int m0,
                                              const bf16_t* Bt, int ldb, int n0, int nmax, int K, char* smem, const int tid) {
  const int lane = tid & 63, wid = tid >> 6, wm = wid >> 1, wn = wid & 1;
  const int q = tid & 7, r0 = tid >> 3;
  unsigned offA[4], offB[BN / 32];
#pragma unroll
  for (int i = 0; i < 4; ++i) offA[i] = ((unsigned)(m0 + r0 + 32 * i) * (unsigned)lda + (unsigned)q * 8u) * 2u;
#pragma unroll
  for (int i = 0; i < BN / 32; ++i) {
    int row = n0 + r0 + 32 * i;
    row = row < nmax ? row : nmax;
    offB[i] = ((unsigned)row * (unsigned)ldb + (unsigned)q * 8u) * 2u;
  }
  const unsigned sto = (unsigned)r0 * 128u + (unsigned)((q ^ ((r0 >> 1) & 7)) << 4);
  unsigned aoff[4], boff[BN / 32];
#pragma unroll
  for (int mi = 0; mi < 4; ++mi) {
    int row = wm * 64 + mi * 16 + (lane & 15);
    aoff[mi] = (unsigned)row * 128u + (unsigned)(((lane >> 4) ^ ((row >> 1) & 7)) << 4);
  }
#pragma unroll
  for (int ni = 0; ni < BN / 32; ++ni) {
    int row = wn * (BN / 2) + ni * 16 + (lane & 15);
    boff[ni] = (unsigned)row * 128u + (unsigned)(((lane >> 4) ^ ((row >> 1) & 7)) << 4);
  }
  const char* Ab = reinterpret_cast<const char*>(A);
  const char* Bb = reinterpret_cast<const char*>(Bt);
  const int nk = K >> 6;
  constexpr bool WIDE = (BN == 128);
  u32x4 Ra0, Ra1, Ra2, Ra3, Rb0, Rb1, Rb2, Rb3;
  u32x4 Qa0, Qa1, Qa2, Qa3, Qb0, Qb1, Qb2, Qb3;
#define GLOAD(P, TILE)                                                         \
  {                                                                            \
    const char* Ak_ = Ab + (size_t)(TILE) * 128;                               \
    const char* Bk_ = Bb + (size_t)(TILE) * 128;                               \
    P##a0 = *reinterpret_cast<const u32x4*>(Ak_ + offA[0]);                    \
    P##a1 = *reinterpret_cast<const u32x4*>(Ak_ + offA[1]);                    \
    P##a2 = *reinterpret_cast<const u32x4*>(Ak_ + offA[2]);                    \
    P##a3 = *reinterpret_cast<const u32x4*>(Ak_ + offA[3]);                    \
    P##b0 = *reinterpret_cast<const u32x4*>(Bk_ + offB[0]);                    \
    P##b1 = *reinterpret_cast<const u32x4*>(Bk_ + offB[1]);                    \
    if (WIDE) {                                                                \
      P##b2 = *reinterpret_cast<const u32x4*>(Bk_ + offB[BN / 32 - 2]);        \
      P##b3 = *reinterpret_cast<const u32x4*>(Bk_ + offB[BN / 32 - 1]);        \
    }                                                                          \
  }
#define SSTORE(P, BUF)                                                         \
  {                                                                            \
    char* ad_ = smem + (BUF) * 16384 + sto;                                    \
    char* bd_ = smem + 32768 + (BUF) * (BN * 128) + sto;                       \
    *reinterpret_cast<u32x4*>(ad_) = P##a0;                                    \
    *reinterpret_cast<u32x4*>(ad_ + 4096) = P##a1;                             \
    *reinterpret_cast<u32x4*>(ad_ + 8192) = P##a2;                             \
    *reinterpret_cast<u32x4*>(ad_ + 12288) = P##a3;                            \
    *reinterpret_cast<u32x4*>(bd_) = P##b0;                                    \
    *reinterpret_cast<u32x4*>(bd_ + 4096) = P##b1;                             \
    if (WIDE) {                                                                \
      *reinterpret_cast<u32x4*>(bd_ + 8192) = P##b2;                           \
      *reinterpret_cast<u32x4*>(bd_ + 12288) = P##b3;                          \
    }                                                                          \
  }
#define COMPUTE(BUF)                                                           \
  {                                                                            \
    const char* a_s = smem + (BUF) * 16384;                                    \
    const char* b_s = smem + 32768 + (BUF) * (BN * 128);                       \
    _Pragma("unroll") for (int ks = 0; ks < 2; ++ks) {                         \
      bf16x8 af[4], bfr[BN / 32];                                              \
      _Pragma("unroll") for (int mi = 0; mi < 4; ++mi)                         \
          af[mi] = *reinterpret_cast<const bf16x8*>(a_s + (aoff[mi] ^ (ks * 64)));       \
      _Pragma("unroll") for (int ni = 0; ni < BN / 32; ++ni)                   \
          bfr[ni] = *reinterpret_cast<const bf16x8*>(b_s + (boff[ni] ^ (ks * 64)));      \
      _Pragma("unroll") for (int mi = 0; mi < 4; ++mi)                         \
        _Pragma("unroll") for (int ni = 0; ni < BN / 32; ++ni)                 \
          acc[mi][ni] = __builtin_amdgcn_mfma_f32_16x16x32_bf16(bfr[ni], af[mi], acc[mi][ni], 0, 0, 0); \
    }                                                                          \
  }
  if constexpr (WIDE) {
    GLOAD(R, 0);
    SSTORE(R, 0);
    GLOAD(R, 1);
    if (nk > 2) GLOAD(Q, 2);
    __syncthreads();
#pragma unroll 1
    for (int kt = 0; kt < nk; kt += 2) {
      __builtin_amdgcn_sched_barrier(0);
      COMPUTE(0);
      __builtin_amdgcn_sched_barrier(0);
      SSTORE(R, 1);
      if (kt + 3 < nk) GLOAD(R, kt + 3);
      __syncthreads();
      __builtin_amdgcn_sched_barrier(0);
      COMPUTE(1);
      __builtin_amdgcn_sched_barrier(0);
      if (kt + 2 < nk) SSTORE(Q, 0);
      if (kt + 4 < nk) GLOAD(Q, kt + 4);
      __syncthreads();
    }
  } else {
    GLOAD(R, 0);
    SSTORE(R, 0);
    __syncthreads();
#pragma unroll 1
    for (int kt = 0; kt < nk; ++kt) {
      const int buf = kt & 1;
      const bool more = (kt + 1 < nk);
      if (more) GLOAD(R, kt + 1);
      __builtin_amdgcn_sched_barrier(0);
      COMPUTE(buf);
      __builtin_amdgcn_sched_barrier(0);
      if (more) SSTORE(R, buf ^ 1);
      __syncthreads();
    }
  }
#undef GLOAD
#undef SSTORE
#undef COMPUTE
}

template <int BN>
__device__ __forceinline__ void zero_acc(f32x4 (&acc)[4][BN / 32]) {
#pragma unroll
  for (int mi = 0; mi < 4; ++mi)
#pragma unroll
    for (int ni = 0; ni < BN / 32; ++ni) acc[mi][ni] = f32x4{0.f, 0.f, 0.f, 0.f};
}

__device__ __forceinline__ void conv_tile(const float* src, int ld, int nlimit, int k0, int n0, bf16_t* dst, int Kd, int mode,
                                          char* smem, const int tid) {
  float* sT = reinterpret_cast<float*>(smem);
#pragma unroll
  for (int i = 0; i < 16; ++i) {
    int kk = i * 4 + (tid >> 6), nn = tid & 63;
    float v = (n0 + nn < nlimit) ? src[(size_t)(k0 + kk) * ld + n0 + nn] : 0.f;
    sT[kk * 65 + nn] = v;
  }
  __syncthreads();
  {
    int nn = tid >> 2, kq = tid & 3;
    int n = n0 + nn;
    if (n < nlimit) {
      int drow = n;
      if (mode == 1) {
        if (n < FFH) drow = (n >> 4) * 32 + (n & 15);
        else { int j = n - FFH; drow = (j >> 4) * 32 + 16 + (j & 15); }
      }
      unsigned pk[8];
#pragma unroll
      for (int j = 0; j < 8; ++j) pk[j] = pack2(sT[(kq * 16 + 2 * j) * 65 + nn], sT[(kq * 16 + 2 * j + 1) * 65 + nn]);
      uint4* d = reinterpret_cast<uint4*>(dst + (size_t)drow * Kd + k0 + kq * 16);
      d[0] = uint4{pk[0], pk[1], pk[2], pk[3]};
      d[1] = uint4{pk[4], pk[5], pk[6], pk[7]};
    }
  }
  __syncthreads();
}

__device__ __forceinline__ void rmsnorm_row_to_bf16(const float* x, const float* w, bf16_t* out, const int lane) {
  float4 v[4];
  float ss = 0.f;
#pragma unroll
  for (int i = 0; i < 4; ++i) {
    v[i] = *reinterpret_cast<const float4*>(x + i * 256 + lane * 4);
    ss += v[i].x * v[i].x + v[i].y * v[i].y + v[i].z * v[i].z + v[i].w * v[i].w;
  }
  ss = sum64(ss);
  float rstd = rsqrtf(ss * (1.f / 1024.f) + 1e-6f);
#pragma unroll
  for (int i = 0; i < 4; ++i) {
    float4 ww = *reinterpret_cast<const float4*>(w + i * 256 + lane * 4);
    uint2 o;
    o.x = pack2(v[i].x * rstd * ww.x, v[i].y * rstd * ww.y);
    o.y = pack2(v[i].z * rstd * ww.z, v[i].w * rstd * ww.w);
    *reinterpret_cast<uint2*>(out + i * 256 + lane * 4) = o;
  }
}

constexpr int CT_IN = 157 * 16, CT_BR = 512, CT_OUT = 256, CT_F1 = 88 * 16, CT_F2 = 44 * 16, CT_GLU = 64;
constexpr int CT_TOTAL = CT_IN + CT_BR + CT_OUT + CT_F1 + CT_F2 + CT_GLU;

__device__ void phase_convert_norm(const Params& p, int l, char* smem) {
  const int tid = opaque_tid();
  char* ws = p.ws;
  const int ntask = CT_TOTAL + T_TOK / 4;
  const float* xsrc = (l == 0) ? p.in[I_X] : p.out;
  for (int t = blockIdx.x; t < ntask; t += gridDim.x) {
    if (t < CT_TOTAL) {
      int c = t;
      if (c < CT_IN) {
        int nt = c >> 4, kt = c & 15;
        const float* src = p.in[I_W_IN] + (size_t)l * 1024 * IN_COLS;
        if (nt < 64) conv_tile(src, IN_COLS, IN_COLS, kt * 64, nt * 64, (bf16_t*)(ws + OFF_WTGATE), 1024, 0, smem, tid);
        else conv_tile(src + 4096, IN_COLS, IN_COLS - 4096, kt * 64, (nt - 64) * 64, (bf16_t*)(ws + OFF_WTIN), 1024, 0, smem, tid);
        continue;
      }
      c -= CT_IN;
      if (c < CT_BR) {
        int kb = c >> 7, r = c & 127, nt = r >> 3, kt = r & 7;
        const float* src = p.in[I_W_BRANCH] + ((size_t)l * 4 + kb) * 512 * 1024;
        conv_tile(src, 1024, 1024, kt * 64, nt * 64, (bf16_t*)(ws + OFF_WTBR) + (size_t)kb * 1024 * 512, 512, 0, smem, tid);
        continue;
      }
      c -= CT_BR;
      if (c < CT_OUT) {
        int nt = c >> 4, kt = c & 15;
        conv_tile(p.in[I_W_OUT] + (size_t)l * 1024 * 1024, 1024, 1024, kt * 64, nt * 64, (bf16_t*)(ws + OFF_WTOUT), 1024, 0, smem, tid);
        continue;
      }
      c -= CT_OUT;
      if (c < CT_F1) {
        int nt = c >> 4, kt = c & 15;
        conv_tile(p.in[I_W_FFN_IN] + (size_t)l * 1024 * 5632, 5632, 5632, kt * 64, nt * 64, (bf16_t*)(ws + OFF_WTF1), 1024, 1, smem, tid);
        continue;
      }
      c -= CT_F1;
      if (c < CT_F2) {
        int nt = c / 44, kt = c % 44;
        conv_tile(p.in[I_W_FFN_OUT] + (size_t)l * FFH * 1024, 1024, 1024, kt * 64, nt * 64, (bf16_t*)(ws + OFF_WTF2), FFH, 0, smem, tid);
        continue;
      }
      c -= CT_F2;
      {
        int nt = c >> 3, kt = c & 7;
        conv_tile(p.in[I_S5_WGLU] + (size_t)l * 512 * 512, 512, 512, kt * 64, nt * 64, (bf16_t*)(ws + OFF_WTGLU), 512, 0, smem, tid);
      }
    } else {
      int row = (t - CT_TOTAL) * 4 + (tid >> 6);
      rmsnorm_row_to_bf16(xsrc + (size_t)row * DM, p.in[I_NORM_MIX] + l * DM, (bf16_t*)(ws + OFF_U) + (size_t)row * DM, tid & 63);
    }
  }
}

__device__ void phase_norm_only(const Params& p, const float* xsrc, const float* w) {
  const int tid = opaque_tid();
  for (int t = blockIdx.x; t < T_TOK / 4; t += gridDim.x) {
    int row = t * 4 + (tid >> 6);
    rmsnorm_row_to_bf16(xsrc + (size_t)row * DM, w, (bf16_t*)(p.ws + OFF_U) + (size_t)row * DM, tid & 63);
  }
}

__device__ __forceinline__ bool tile_map(int t, int NT, int& mt, int& nt) {
  const int x = t & 7, r = t >> 3;
  const int cnt = (NT + 7) >> 3;
  const int ni = r % cnt;
  mt = r / cnt;
  nt = x + 8 * ni;
  return nt < NT;
}
__device__ __forceinline__ int tile_count(int MT, int NT) { return 8 * MT * ((NT + 7) >> 3); }

__device__ void phase_inproj(const Params& p, char* smem) {
  const bf16_t* U = (const bf16_t*)(p.ws + OFF_U);
  const bf16_t* Wt = (const bf16_t*)(p.ws + OFF_WTIN);
  bf16_t* Z = (bf16_t*)(p.ws + OFF_Z);
  const int tid = opaque_tid();
  const int lane = tid & 63, wid = tid >> 6, wm = wid >> 1, wn = wid & 1;
  constexpr int NT = 47;
  for (int t = blockIdx.x; t < tile_count(128, NT); t += gridDim.x) {
    int mt, nt;
    if (!tile_map(t, NT, mt, nt)) continue;
    f32x4 acc[4][4];
    zero_acc<128>(acc);
    gemm_mainloop<128>(acc, U, 1024, mt * 128, Wt, 1024, nt * 128, NZ - 1, 1024, smem, tid);
#pragma unroll
    for (int mi = 0; mi < 4; ++mi)
#pragma unroll
      for (int ni = 0; ni < 4; ++ni) {
        int col = nt * 128 + wn * 64 + ni * 16 + (lane >> 4) * 4;
        int row = mt * 128 + wm * 64 + mi * 16 + (lane & 15);
        if (col < NZ) {
          uint2 o;
          o.x = pack2(acc[mi][ni][0], acc[mi][ni][1]);
          o.y = pack2(acc[mi][ni][2], acc[mi][ni][3]);
          *reinterpret_cast<uint2*>(Z + (size_t)row * ZS + col) = o;
        }
      }
  }
}

template <int J>
__device__ __forceinline__ void lora_mm(const float* sIn, const float* W, float (&a0)[16], float (&a1)[16], const int tid) {
#pragma unroll
  for (int i = 0; i < 16; ++i) { a0[i] = 0.f; a1[i] = 0.f; }
#pragma unroll 8
  for (int j = 0; j < J; ++j) {
    float w0 = W[j * 512 + tid], w1 = W[j * 512 + tid + 256];
    const float4* x4 = reinterpret_cast<const float4*>(sIn + j * 16);
#pragma unroll
    for (int q = 0; q < 4; ++q) {
      float4 x = x4[q];
      a0[q * 4 + 0] = fmaf(w0, x.x, a0[q * 4 + 0]); a1[q * 4 + 0] = fmaf(w1, x.x, a1[q * 4 + 0]);
      a0[q * 4 + 1] = fmaf(w0, x.y, a0[q * 4 + 1]); a1[q * 4 + 1] = fmaf(w1, x.y, a1[q * 4 + 1]);
      a0[q * 4 + 2] = fmaf(w0, x.z, a0[q * 4 + 2]); a1[q * 4 + 2] = fmaf(w1, x.z, a1[q * 4 + 2]);
      a0[q * 4 + 3] = fmaf(w0, x.w, a0[q * 4 + 3]); a1[q * 4 + 3] = fmaf(w1, x.w, a1[q * 4 + 3]);
    }
  }
}

__device__ __forceinline__ float rw_shift(const bf16_t* Z, int row, int s, int rc, float mu) {
  float cur = bf2f(Z[(size_t)row * ZS + ZRW + rc]);
  float prev = (s > 0) ? bf2f(Z[(size_t)(row - 1) * ZS + ZRW + rc]) : 0.f;
  return cur + (prev - cur) * mu;
}

__device__ void phase_rwprep(const Params& p, int l, char* smem) {
  const bf16_t* Z = (const bf16_t*)(p.ws + OFF_Z);
  bf16_t* LW = (bf16_t*)(p.ws + OFF_U);
  bf16_t* LA = LW + (size_t)T_TOK * 512;
  bf16_t* VF = (bf16_t*)(p.ws + OFF_VF);
  float* sXw = reinterpret_cast<float*>(smem);
  float* sXa = sXw + 64 * 16;
  float* sTmp = sXa + 64 * 16;
  float* sZv = sTmp + 32 * 16;
  const float* mu = p.in[I_RW_MU] + l * 1792;
  const int tid = opaque_tid();
  for (int t = blockIdx.x; t < T_TOK / 16; t += gridDim.x) {
    const int row0 = t * 16;
    for (int e = tid; e < 2048; e += 256) {
      int which = e >> 10, r = e & 1023, j = r >> 4, tok = r & 15;
      int row = row0 + tok, s = row & (SEQ - 1);
      int rc = 1536 + which * 64 + j;
      float z = rw_shift(Z, row, s, rc, mu[rc]);
      if (which == 0) sXw[j * 16 + tok] = tanhf(z); else sXa[j * 16 + tok] = z;
    }
    float zv0[16], zv1[16];
    {
      float m0 = mu[1024 + tid], m1 = mu[1024 + tid + 256];
#pragma unroll
      for (int tok = 0; tok < 16; ++tok) {
        int row = row0 + tok, s = row & (SEQ - 1);
        zv0[tok] = rw_shift(Z, row, s, 1024 + tid, m0);
        zv1[tok] = rw_shift(Z, row, s, 1024 + tid + 256, m1);
      }
    }
    if (l > 0) {
#pragma unroll
      for (int tok = 0; tok < 16; ++tok) { sZv[tid * 16 + tok] = zv0[tok]; sZv[(tid + 256) * 16 + tok] = zv1[tok]; }
    }
    __syncthreads();
    float a0[16], a1[16];
    lora_mm<64>(sXw, p.in[I_RW_W2] + (size_t)l * 64 * 512, a0, a1, tid);
#pragma unroll
    for (int tok = 0; tok < 16; ++tok) {
      LW[(size_t)(row0 + tok) * 512 + tid] = f2bf(a0[tok]);
      LW[(size_t)(row0 + tok) * 512 + tid + 256] = f2bf(a1[tok]);
    }
    lora_mm<64>(sXa, p.in[I_RW_A2] + (size_t)l * 64 * 512, a0, a1, tid);
#pragma unroll
    for (int tok = 0; tok < 16; ++tok) {
      LA[(size_t)(row0 + tok) * 512 + tid] = f2bf(a0[tok]);
      LA[(size_t)(row0 + tok) * 512 + tid + 256] = f2bf(a1[tok]);
    }
    if (l == 0) {
#pragma unroll
      for (int tok = 0; tok < 16; ++tok) {
        VF[(size_t)(row0 + tok) * 512 + tid] = f2bf(zv0[tok]);
        VF[(size_t)(row0 + tok) * 512 + tid + 256] = f2bf(zv1[tok]);
      }
    } else {
      const float* v1 = p.in[I_RW_V1] + (size_t)(l - 1) * 512 * 32;
      const float* v2 = p.in[I_RW_V2] + (size_t)(l - 1) * 32 * 512;
      const float* v0 = p.in[I_RW_V0] + (size_t)(l - 1) * 512;
      {
        int r = tid & 31, tg = tid >> 5;
        float t0 = 0.f, t1 = 0.f;
#pragma unroll 16
        for (int c = 0; c < 512; ++c) {
          float w = v1[c * 32 + r];
          float2 x = *reinterpret_cast<const float2*>(sZv + c * 16 + tg * 2);
          t0 = fmaf(w, x.x, t0); t1 = fmaf(w, x.y, t1);
        }
        sTmp[r * 16 + tg * 2] = t0; sTmp[r * 16 + tg * 2 + 1] = t1;
      }
      __syncthreads();
      lora_mm<32>(sTmp, v2, a0, a1, tid);
      float b0 = v0[tid], b1 = v0[tid + 256];
#pragma unroll
      for (int tok = 0; tok < 16; ++tok) {
        size_t i0 = (size_t)(row0 + tok) * 512 + tid;
        float vf0 = bf2f(VF[i0]), vf1 = bf2f(VF[i0 + 256]);
        VF[i0] = f2bf(zv0[tok] + (vf0 - zv0[tok]) * sigmoidf_(b0 + a0[tok]));
        VF[i0 + 256] = f2bf(zv1[tok] + (vf1 - zv1[tok]) * sigmoidf_(b1 + a1[tok]));
      }
    }
    __syncthreads();
  }
}

__device__ __forceinline__ float frcp(float x) { return __builtin_amdgcn_rcpf(x); }
__device__ __forceinline__ float fsigmoid(float x) { return frcp(1.f + __expf(-x)); }
__device__ __forceinline__ float fsilu(float x) { return x * frcp(1.f + __expf(-x)); }
__device__ __forceinline__ float fsoftplus(float x) { return x > 20.f ? x : __logf(1.f + __expf(x)); }
__device__ __forceinline__ float ftanh(float x) {
  float e = __expf(2.f * fminf(fmaxf(x, -15.f), 15.f));
  return (e - 1.f) * frcp(e + 1.f);
}
__device__ __forceinline__ float fgelu(float x) {
  float u = 0.7978845608028654f * (x + 0.044715f * x * x * x);
  return 0.5f * x * (1.f + ftanh(u));
}

__device__ void hg_scan(const Params& p, int l, int task, char* smem) {
  const int b = task >> 3, h = (task >> 1) & 3, vg = task & 1;
  float* sFg = reinterpret_cast<float*>(smem);
  float* sQs = sFg + 16 * 128;
  float* sO = sQs + 16 * 128;
  float* sVv = sO + 4 * 16 * 64;
  const int tid = opaque_tid(), w = tid >> 6, lane = tid & 63;
  bf16_t* Z = (bf16_t*)(p.ws + OFF_Z) + (size_t)b * SEQ * ZS;
  const int ks = tid & 127;
  float lb = 0.f;
  if (l > 0) {
    float x0 = p.in[I_HG_LB][h * 128 + ks], x1 = p.in[I_HG_LB][512 + h * 128 + ks];
    float m = fmaxf(x0, x1), e0 = expf(x0 - m), e1 = expf(x1 - m);
    lb = e1 / (e0 + e1);
  }
  float s[32];
#pragma unroll
  for (int j = 0; j < 32; ++j) s[j] = 0.f;
  const int vcol = ZHG + 1024 + h * 128 + vg * 64;
  const int qcol = ZHG + h * 128 + ks;
  bf16_t rq0, rq1, rq2, rq3, rq4, rq5, rq6, rq7, rf0, rf1, rf2, rf3, rf4, rf5, rf6, rf7, rv0, rv1, rv2, rv3;
#define HG_LOAD(T0)                                                                                \
  {                                                                                                \
    const bf16_t* zb = Z + (size_t)((T0) + (tid >> 7)) * ZS + qcol;                                \
    rq0 = zb[0]; rf0 = zb[512]; zb += 2 * ZS; rq1 = zb[0]; rf1 = zb[512]; zb += 2 * ZS;            \
    rq2 = zb[0]; rf2 = zb[512]; zb += 2 * ZS; rq3 = zb[0]; rf3 = zb[512]; zb += 2 * ZS;            \
    rq4 = zb[0]; rf4 = zb[512]; zb += 2 * ZS; rq5 = zb[0]; rf5 = zb[512]; zb += 2 * ZS;            \
    rq6 = zb[0]; rf6 = zb[512]; zb += 2 * ZS; rq7 = zb[0]; rf7 = zb[512];                          \
    const bf16_t* zv = Z + (size_t)((T0) + w) * ZS + vcol + lane;                                  \
    rv0 = zv[0]; rv1 = zv[4 * ZS]; rv2 = zv[8 * ZS]; rv3 = zv[12 * ZS];                            \
  }
#define HG_PUT1(I, RQ, RF)                                                                         \
  {                                                                                                \
    int t = (tid >> 7) + 2 * (I);                                                                  \
    sFg[t * 128 + ks] = fmaxf(lb + (1.f - lb) * fsigmoid(bf2f(RF)), 1e-30f);                       \
    sQs[t * 128 + ks] = fsilu(bf2f(RQ));                                                           \
  }
#define HG_PROCESS()                                                                               \
  {                                                                                                \
    HG_PUT1(0, rq0, rf0) HG_PUT1(1, rq1, rf1) HG_PUT1(2, rq2, rf2) HG_PUT1(3, rq3, rf3)            \
    HG_PUT1(4, rq4, rf4) HG_PUT1(5, rq5, rf5) HG_PUT1(6, rq6, rf6) HG_PUT1(7, rq7, rf7)            \
    sVv[(w)*64 + lane] = bf2f(rv0); sVv[(w + 4) * 64 + lane] = bf2f(rv1);                          \
    sVv[(w + 8) * 64 + lane] = bf2f(rv2); sVv[(w + 12) * 64 + lane] = bf2f(rv3);                   \
  }
  HG_LOAD(0);
  HG_PROCESS();
  __syncthreads();
  constexpr int NCH = SEQ / 16;
#pragma unroll 1
  for (int c = 0; c < NCH; ++c) {
    const int t0 = c * 16;
    const int tn = (c + 1 < NCH) ? t0 + 16 : t0;
    HG_LOAD(tn);
    __builtin_amdgcn_sched_barrier(0);
#pragma unroll 2
    for (int t = 0; t < 16; ++t) {
      const float v = sVv[t * 64 + lane];
      const float opv = (lane < 32) ? sFg[t * 128 + w * 32 + lane] : sQs[t * 128 + w * 32 + (lane - 32)];
      const int opi = __builtin_bit_cast(int, opv);
      float o = 0.f;
#pragma unroll
      for (int j = 0; j < 32; ++j) {
        const float fg = __builtin_bit_cast(float, __builtin_amdgcn_readlane(opi, j));
        const float qq = __builtin_bit_cast(float, __builtin_amdgcn_readlane(opi, 32 + j));
        const float kv = fmaf(-fg, v, v);
        s[j] = fmaf(s[j], fg, kv);
        o = fmaf(qq, s[j], o);
      }
      sO[(w * 16 + t) * 64 + lane] = o;
    }
    __builtin_amdgcn_sched_barrier(0);
    __syncthreads();
    {
      int t = tid >> 4, v4 = (tid & 15) * 4;
      float4 a = *reinterpret_cast<const float4*>(sO + (0 * 16 + t) * 64 + v4);
      float4 bq = *reinterpret_cast<const float4*>(sO + (1 * 16 + t) * 64 + v4);
      float4 cq = *reinterpret_cast<const float4*>(sO + (2 * 16 + t) * 64 + v4);
      float4 d = *reinterpret_cast<const float4*>(sO + (3 * 16 + t) * 64 + v4);
      uint2 o;
      o.x = pack2(a.x + bq.x + cq.x + d.x, a.y + bq.y + cq.y + d.y);
      o.y = pack2(a.z + bq.z + cq.z + d.z, a.w + bq.w + cq.w + d.w);
      *reinterpret_cast<uint2*>(Z + (size_t)(t0 + t) * ZS + vcol + v4) = o;
    }
    HG_PROCESS();
    __syncthreads();
  }
#undef HG_LOAD
#undef HG_PUT1
#undef HG_PROCESS
}

__device__ void mb_scan(const Params& p, int l, int task, char* smem) {
  const int b = task >> 3, hd = task & 7, g = hd >> 2;
  float* sB = reinterpret_cast<float*>(smem);
  float* sC = sB + 16 * 128;
  float* sX = sC + 16 * 128;
  float* sDt = sX + 16 * 64;
  float* sDA = sDt + 16;
  float* sO = sDA + 16;
  const int tid = opaque_tid(), w = tid >> 6, lane = tid & 63;
  bf16_t* Z = (bf16_t*)(p.ws + OFF_Z) + (size_t)b * SEQ * ZS;
  const float* cw = p.in[I_MB_CONVW] + (size_t)l * 4 * 1024;
  const float* cb = p.in[I_MB_CONVB] + (size_t)l * 1024;
  int ci0, ci1;
  {
    int ch = tid;
    ci0 = (ch < 64) ? hd * 64 + ch : (ch < 192 ? 512 + g * 128 + (ch - 64) : 768 + g * 128 + (ch - 192));
    ci1 = 768 + g * 128 + 64 + (tid & 63);
  }
  float* dstA = (tid < 64) ? (sX + tid) : (tid < 192 ? (sB + (tid - 64)) : (sC + (tid - 192)));
  const int strideA = (tid < 64) ? 64 : 128;
  const float w0a = cw[ci0], w1a = cw[1024 + ci0], w2a = cw[2048 + ci0], w3a = cw[3072 + ci0], ba = cb[ci0];
  const float w0b = cw[ci1], w1b = cw[1024 + ci1], w2b = cw[2048 + ci1], w3b = cw[3072 + ci1], bb = cb[ci1];
  const float Aneg = -expf(p.in[I_MB_ALOG][l * 8 + hd]);
  const float dtb = p.in[I_MB_DTB][l * 8 + hd];
  const float Dsk = p.in[I_MB_D][l * 8 + hd];
  float s[32];
#pragma unroll
  for (int j = 0; j < 32; ++j) s[j] = 0.f;
  float pa1 = 0.f, pa2 = 0.f, pa3 = 0.f, pb1 = 0.f, pb2 = 0.f, pb3 = 0.f;
  const int xcol = ZMB + 512;
  const int rt = tid >> 4, rp4 = (tid & 15) * 4;
  bf16_t xa0, xa1, xa2, xa3, xa4, xa5, xa6, xa7, xa8, xa9, xa10, xa11, xa12, xa13, xa14, xa15;
  bf16_t xb0, xb1, xb2, xb3, xb4, xb5, xb6, xb7, xb8, xb9, xb10, xb11, xb12, xb13, xb14, xb15;
  bf16_t rdt;
  uint2 gcur, gnext;
#define MB_LOAD(T0)                                                                                 \
  {                                                                                                 \
    const bf16_t* za = Z + (size_t)(T0) * ZS + xcol + ci0;                                          \
    xa0 = za[0]; xa1 = za[ZS]; xa2 = za[2 * ZS]; xa3 = za[3 * ZS]; xa4 = za[4 * ZS]; xa5 = za[5 * ZS];        \
    xa6 = za[6 * ZS]; xa7 = za[7 * ZS]; xa8 = za[8 * ZS]; xa9 = za[9 * ZS]; xa10 = za[10 * ZS];     \
    xa11 = za[11 * ZS]; xa12 = za[12 * ZS]; xa13 = za[13 * ZS]; xa14 = za[14 * ZS]; xa15 = za[15 * ZS];       \
    if (tid < 64) {                                                                                 \
      const bf16_t* zb = Z + (size_t)(T0) * ZS + xcol + ci1;                                        \
      xb0 = zb[0]; xb1 = zb[ZS]; xb2 = zb[2 * ZS]; xb3 = zb[3 * ZS]; xb4 = zb[4 * ZS]; xb5 = zb[5 * ZS];      \
      xb6 = zb[6 * ZS]; xb7 = zb[7 * ZS]; xb8 = zb[8 * ZS]; xb9 = zb[9 * ZS]; xb10 = zb[10 * ZS];   \
      xb11 = zb[11 * ZS]; xb12 = zb[12 * ZS]; xb13 = zb[13 * ZS]; xb14 = zb[14 * ZS]; xb15 = zb[15 * ZS];     \
    }                                                                                               \
    rdt = Z[(size_t)((T0) + (tid & 15)) * ZS + ZMB + 1536 + hd];                                    \
    gnext = *reinterpret_cast<const uint2*>(Z + (size_t)((T0) + rt) * ZS + ZMB + hd * 64 + rp4);    \
  }
#define MB_CONV_A(T, XR)                                                                            \
  {                                                                                                 \
    float xv = bf2f(XR);                                                                            \
    dstA[(T)*strideA] = fsilu(ba + w0a * pa3 + w1a * pa2 + w2a * pa1 + w3a * xv);                   \
    pa3 = pa2; pa2 = pa1; pa1 = xv;                                                                 \
  }
#define MB_CONV_B(T, XR)                                                                            \
  {                                                                                                 \
    float xv = bf2f(XR);                                                                            \
    sC[(T)*128 + 64 + tid] = fsilu(bb + w0b * pb3 + w1b * pb2 + w2b * pb1 + w3b * xv);              \
    pb3 = pb2; pb2 = pb1; pb1 = xv;                                                                 \
  }
#define MB_PROCESS()                                                                                \
  {                                                                                                 \
    MB_CONV_A(0, xa0) MB_CONV_A(1, xa1) MB_CONV_A(2, xa2) MB_CONV_A(3, xa3) MB_CONV_A(4, xa4)       \
    MB_CONV_A(5, xa5) MB_CONV_A(6, xa6) MB_CONV_A(7, xa7) MB_CONV_A(8, xa8) MB_CONV_A(9, xa9)       \
    MB_CONV_A(10, xa10) MB_CONV_A(11, xa11) MB_CONV_A(12, xa12) MB_CONV_A(13, xa13)                 \
    MB_CONV_A(14, xa14) MB_CONV_A(15, xa15)                                                         \
    if (tid < 64) {                                                                                 \
      MB_CONV_B(0, xb0) MB_CONV_B(1, xb1) MB_CONV_B(2, xb2) MB_CONV_B(3, xb3) MB_CONV_B(4, xb4)     \
      MB_CONV_B(5, xb5) MB_CONV_B(6, xb6) MB_CONV_B(7, xb7) MB_CONV_B(8, xb8) MB_CONV_B(9, xb9)     \
      MB_CONV_B(10, xb10) MB_CONV_B(11, xb11) MB_CONV_B(12, xb12) MB_CONV_B(13, xb13)               \
      MB_CONV_B(14, xb14) MB_CONV_B(15, xb15)                                                       \
    }                                                                                               \
    if (tid < 16) {                                                                                 \
      float dt = fsoftplus(bf2f(rdt) + dtb);                                                        \
      sDt[tid] = dt;                                                                                \
      sDA[tid] = __expf(Aneg * dt);                                                                 \
    }                                                                                               \
    gcur = gnext;                                                                                   \
  }
  MB_LOAD(0);
  MB_PROCESS();
  __syncthreads();
  constexpr int NCH = SEQ / 16;
#pragma unroll 1
  for (int c = 0; c < NCH; ++c) {
    const int t0 = c * 16;
    const bool more = (c + 1 < NCH);
    const int tn = more ? t0 + 16 : t0;
    MB_LOAD(tn);
    __builtin_amdgcn_sched_barrier(0);
#pragma unroll 2
    for (int t = 0; t < 16; ++t) {
      const float dA = sDA[t];
      const float xdt = sX[t * 64 + lane] * sDt[t];
      const float opv = (lane < 32) ? sB[t * 128 + w * 32 + lane] : sC[t * 128 + w * 32 + (lane - 32)];
      const int opi = __builtin_bit_cast(int, opv);
      float y = 0.f;
#pragma unroll
      for (int j = 0; j < 32; ++j) {
        const float bn = __builtin_bit_cast(float, __builtin_amdgcn_readlane(opi, j));
        const float cn = __builtin_bit_cast(float, __builtin_amdgcn_readlane(opi, 32 + j));
        s[j] = fmaf(s[j], dA, bn * xdt);
        y = fmaf(cn, s[j], y);
      }
      sO[(w * 16 + t) * 64 + lane] = y;
    }
    __builtin_amdgcn_sched_barrier(0);
    __syncthreads();
    {
      float4 a = *reinterpret_cast<const float4*>(sO + (0 * 16 + rt) * 64 + rp4);
      float4 bq = *reinterpret_cast<const float4*>(sO + (1 * 16 + rt) * 64 + rp4);
      float4 cq = *reinterpret_cast<const float4*>(sO + (2 * 16 + rt) * 64 + rp4);
      float4 d = *reinterpret_cast<const float4*>(sO + (3 * 16 + rt) * 64 + rp4);
      float4 xs = *reinterpret_cast<const float4*>(sX + rt * 64 + rp4);
      bf16_t* gp = Z + (size_t)(t0 + rt) * ZS + ZMB + hd * 64 + rp4;
      float g0 = bf2f((bf16_t)(gcur.x & 0xffff)), g1 = bf2f((bf16_t)(gcur.x >> 16));
      float g2 = bf2f((bf16_t)(gcur.y & 0xffff)), g3 = bf2f((bf16_t)(gcur.y >> 16));
      float y0 = a.x + bq.x + cq.x + d.x + Dsk * xs.x;
      float y1 = a.y + bq.y + cq.y + d.y + Dsk * xs.y;
      float y2 = a.z + bq.z + cq.z + d.z + Dsk * xs.z;
      float y3 = a.w + bq.w + cq.w + d.w + Dsk * xs.w;
      uint2 o;
      o.x = pack2(y0 * fsilu(g0), y1 * fsilu(g1));
      o.y = pack2(y2 * fsilu(g2), y3 * fsilu(g3));
      *reinterpret_cast<uint2*>(gp) = o;
    }
    __syncthreads();
    if (more) MB_PROCESS();
    __syncthreads();
  }
#undef MB_LOAD
#undef MB_CONV_A
#undef MB_CONV_B
#undef MB_PROCESS
}

__device__ void s5_scan(const Params& p, int l, int task, char* smem) {
  const int tid = opaque_tid(), w = tid >> 6, lane = tid & 63;
  const int b = task >> 3, g = (task & 7) * 4 + w;
  char* base = smem + w * 6144;
  float* sU = reinterpret_cast<float*>(base);
  char* sHb = base + 1024;
  bf16_t* Z = (bf16_t*)(p.ws + OFF_Z) + (size_t)b * SEQ * ZS + ZS5 + g * 16;
  const int n = lane;
  float lr, li, bbr[16], bbi[16];
  bf16x8 Bf0, Bf1, Bf2, Bf3;
  {
    float dt = expf(p.in[I_S5_LOGDT][l * 32 + g]);
    float are = p.in[I_S5_ARE][(l * 32 + g) * 64 + n], aim = p.in[I_S5_AIM][(l * 32 + g) * 64 + n];
    float mag = expf(dt * are);
    lr = mag * cosf(dt * aim); li = mag * sinf(dt * aim);
    float den = are * are + aim * aim;
    float cr = ((lr - 1.f) * are + li * aim) / den;
    float ci = (li * are - (lr - 1.f) * aim) / den;
    const float* bre = p.in[I_S5_BRE] + ((size_t)(l * 32 + g) * 64 + n) * 16;
    const float* bim = p.in[I_S5_BIM] + ((size_t)(l * 32 + g) * 64 + n) * 16;
#pragma unroll
    for (int c = 0; c < 16; ++c) {
      float br = bre[c], bi = bim[c];
      bbr[c] = cr * br - ci * bi;
      bbi[c] = cr * bi + ci * br;
    }
    const float* cre = p.in[I_S5_CRE] + (size_t)(l * 32 + g) * 16 * 64 + (lane & 15) * 64;
    const float* cim = p.in[I_S5_CIM] + (size_t)(l * 32 + g) * 16 * 64 + (lane & 15) * 64;
#pragma unroll
    for (int j = 0; j < 8; ++j) {
      const int kb = 8 * (lane >> 4) + j;
      const int n0 = kb >> 1;
      const bool im = (j & 1);
      Bf0[j] = (short)f2bf(im ? -cim[n0] : cre[n0]);
      Bf1[j] = (short)f2bf(im ? -cim[n0 + 16] : cre[n0 + 16]);
      Bf2[j] = (short)f2bf(im ? -cim[n0 + 32] : cre[n0 + 32]);
      Bf3[j] = (short)f2bf(im ? -cim[n0 + 48] : cre[n0 + 48]);
    }
  }
  const float dsk = p.in[I_S5_D][l * 512 + g * 16 + (lane & 15)];
  const int pt = lane >> 2, pc4 = (lane & 3) * 4;
  float hr = 0.f, hi = 0.f;
  uint2 unext = *reinterpret_cast<const uint2*>(Z + (size_t)pt * ZS + pc4);
  constexpr int NCH = SEQ / 16;
#pragma unroll 1
  for (int c = 0; c < NCH; ++c) {
    const int t0 = c * 16;
    {
      const uint2 ur = unext;
      *reinterpret_cast<float4*>(sU + pt * 16 + pc4) =
          float4{bf2f((bf16_t)(ur.x & 0xffff)), bf2f((bf16_t)(ur.x >> 16)), bf2f((bf16_t)(ur.y & 0xffff)), bf2f((bf16_t)(ur.y >> 16))};
      const int tn = (c + 1 < NCH) ? t0 + 16 : t0;
      unext = *reinterpret_cast<const uint2*>(Z + (size_t)(tn + pt) * ZS + pc4);
    }
    __builtin_amdgcn_sched_barrier(0);
    __syncthreads();
#pragma unroll 2
    for (int t = 0; t < 16; ++t) {
      const float4* u4 = reinterpret_cast<const float4*>(sU + t * 16);
      float bur = 0.f, bui = 0.f;
#pragma unroll
      for (int q = 0; q < 4; ++q) {
        float4 u = u4[q];
        bur = fmaf(bbr[q * 4 + 0], u.x, bur); bui = fmaf(bbi[q * 4 + 0], u.x, bui);
        bur = fmaf(bbr[q * 4 + 1], u.y, bur); bui = fmaf(bbi[q * 4 + 1], u.y, bui);
        bur = fmaf(bbr[q * 4 + 2], u.z, bur); bui = fmaf(bbi[q * 4 + 2], u.z, bui);
        bur = fmaf(bbr[q * 4 + 3], u.w, bur); bui = fmaf(bbi[q * 4 + 3], u.w, bui);
      }
      float nr = lr * hr - li * hi + bur;
      float ni = lr * hi + li * hr + bui;
      hr = nr; hi = ni;
      *reinterpret_cast<unsigned*>(sHb + t * 272 + n * 4) = pack2(hr, hi);
    }
    __syncthreads();
    {
      f32x4 acc = f32x4{0.f, 0.f, 0.f, 0.f};
      const char* ap = sHb + (lane & 15) * 272 + (lane >> 4) * 16;
      acc = __builtin_amdgcn_mfma_f32_16x16x32_bf16(*reinterpret_cast<const bf16x8*>(ap), Bf0, acc, 0, 0, 0);
      acc = __builtin_amdgcn_mfma_f32_16x16x32_bf16(*reinterpret_cast<const bf16x8*>(ap + 64), Bf1, acc, 0, 0, 0);
      acc = __builtin_amdgcn_mfma_f32_16x16x32_bf16(*reinterpret_cast<const bf16x8*>(ap + 128), Bf2, acc, 0, 0, 0);
      acc = __builtin_amdgcn_mfma_f32_16x16x32_bf16(*reinterpret_cast<const bf16x8*>(ap + 192), Bf3, acc, 0, 0, 0);
      const int cc = lane & 15, tb = (lane >> 4) * 4;
#pragma unroll
      for (int jj = 0; jj < 4; ++jj) {
        float y = acc[jj] + dsk * sU[(tb + jj) * 16 + cc];
        Z[(size_t)(t0 + tb + jj) * ZS + cc] = f2bf(fgelu(y));
      }
    }
    __syncthreads();
  }
}

__device__ void rw_scan(const Params& p, int l, int task, char* smem) {
  const int b = task >> 3, h = task & 7;
  float* sR = reinterpret_cast<float*>(smem);
  float* sW = sR + 1024;
  float* sK = sW + 1024;
  float* sA = sK + 1024;
  float* sBb = sA + 1024;
  float* sV = sBb + 1024;
  float* sY = sV + 1024;
  float* sBonus = sY + 1024;
  const int tid = opaque_tid(), w = tid >> 6, lane = tid & 63;
  const size_t tokbase = (size_t)b * SEQ;
  bf16_t* Z = (bf16_t*)(p.ws + OFF_Z) + tokbase * ZS;
  const bf16_t* LW = (const bf16_t*)(p.ws + OFF_U) + tokbase * 512;
  const bf16_t* LA = LW + (size_t)T_TOK * 512;
  const bf16_t* VF = (const bf16_t*)(p.ws + OFF_VF) + tokbase * 512;
  const int st = tid >> 4, c4 = (tid & 15) * 4, ch = h * 64 + c4;
  float mur[4], muk[4], w0[4], a0[4], kk_[4], ka_[4], rk_[4], lnw[4], lnb[4];
#pragma unroll
  for (int e = 0; e < 4; ++e) {
    mur[e] = p.in[I_RW_MU][l * 1792 + ch + e];
    muk[e] = p.in[I_RW_MU][l * 1792 + 512 + ch + e];
    w0[e] = p.in[I_RW_W0][l * 512 + ch + e];
    a0[e] = p.in[I_RW_A0][l * 512 + ch + e];
    kk_[e] = p.in[I_RW_KK][l * 512 + ch + e];
    ka_[e] = p.in[I_RW_KA][l * 512 + ch + e];
    rk_[e] = p.in[I_RW_RK][l * 512 + ch + e];
    lnw[e] = p.in[I_RW_LNW][l * 512 + ch + e];
    lnb[e] = p.in[I_RW_LNB][l * 512 + ch + e];
  }
  const int rg = lane >> 3, kq = lane & 7, vrow = w * 16 + rg * 2;
  float S0[8], S1[8];
#pragma unroll
  for (int j = 0; j < 8; ++j) { S0[j] = 0.f; S1[j] = 0.f; }
  uint2 rc, kc, rp, kp, lwv, lav, vfv;
#define RW_LOAD(T0)                                                                                 \
  {                                                                                                 \
    const int s_ = (T0) + st;                                                                       \
    const bf16_t* zr = Z + (size_t)s_ * ZS + ZRW + ch;                                              \
    rc = *reinterpret_cast<const uint2*>(zr);                                                       \
    kc = *reinterpret_cast<const uint2*>(zr + 512);                                                 \
    rp = uint2{0u, 0u}; kp = uint2{0u, 0u};                                                         \
    if (s_ > 0) { rp = *reinterpret_cast<const uint2*>(zr - ZS); kp = *reinterpret_cast<const uint2*>(zr - ZS + 512); } \
    lwv = *reinterpret_cast<const uint2*>(LW + (size_t)s_ * 512 + ch);                              \
    lav = *reinterpret_cast<const uint2*>(LA + (size_t)s_ * 512 + ch);                              \
    vfv = *reinterpret_cast<const uint2*>(VF + (size_t)s_ * 512 + ch);                              \
  }
#define RW_PROCESS()                                                                                \
  {                                                                                                 \
    float r4[4], k4[4], kkv[4], av[4], wv[4], vv[4];                                                \
    float n2 = 0.f;                                                                                 \
    _Pragma("unroll") for (int e = 0; e < 4; ++e) {                                                 \
      unsigned rcw = (e < 2) ? rc.x : rc.y, kcw = (e < 2) ? kc.x : kc.y, rpw = (e < 2) ? rp.x : rp.y, kpw = (e < 2) ? kp.x : kp.y; \
      unsigned lww = (e < 2) ? lwv.x : lwv.y, law = (e < 2) ? lav.x : lav.y, vfw = (e < 2) ? vfv.x : vfv.y; \
      int sh = (e & 1) * 16;                                                                        \
      float rcur = bf2f((bf16_t)((rcw >> sh) & 0xffff)), rprev = bf2f((bf16_t)((rpw >> sh) & 0xffff)); \
      float kcur = bf2f((bf16_t)((kcw >> sh) & 0xffff)), kprev = bf2f((bf16_t)((kpw >> sh) & 0xffff)); \
      float lwf = bf2f((bf16_t)((lww >> sh) & 0xffff)), laf = bf2f((bf16_t)((law >> sh) & 0xffff)); \
      vv[e] = bf2f((bf16_t)((vfw >> sh) & 0xffff));                                                 \
      r4[e] = rcur + (rprev - rcur) * mur[e];                                                       \
      k4[e] = kcur + (kprev - kcur) * muk[e];                                                       \
      float wlog = -fsoftplus(-(w0[e] + lwf)) - 0.5f;                                               \
      wv[e] = __expf(-__expf(wlog));                                                                \
      av[e] = fsigmoid(a0[e] + laf);                                                                \
      kkv[e] = k4[e] * kk_[e];                                                                      \
      n2 += kkv[e] * kkv[e];                                                                        \
    }                                                                                               \
    n2 = sum16(n2);                                                                                 \
    float inv = 1.f / fmaxf(sqrtf(n2), 1e-12f);                                                     \
    float bon = 0.f;                                                                                \
    float kt4[4], ap4[4], bp4[4];                                                                   \
    _Pragma("unroll") for (int e = 0; e < 4; ++e) {                                                 \
      float kkn = kkv[e] * inv;                                                                     \
      kt4[e] = k4[e] * (1.f + (av[e] - 1.f) * ka_[e]);                                              \
      ap4[e] = -kkn;                                                                                \
      bp4[e] = kkn * av[e];                                                                         \
      bon += r4[e] * kt4[e] * rk_[e];                                                               \
    }                                                                                               \
    bon = sum16(bon);                                                                               \
    *reinterpret_cast<float4*>(sR + st * 64 + c4) = float4{r4[0], r4[1], r4[2], r4[3]};             \
    *reinterpret_cast<float4*>(sW + st * 64 + c4) = float4{wv[0], wv[1], wv[2], wv[3]};             \
    *reinterpret_cast<float4*>(sK + st * 64 + c4) = float4{kt4[0], kt4[1], kt4[2], kt4[3]};         \
    *reinterpret_cast<float4*>(sA + st * 64 + c4) = float4{ap4[0], ap4[1], ap4[2], ap4[3]};         \
    *reinterpret_cast<float4*>(sBb + st * 64 + c4) = float4{bp4[0], bp4[1], bp4[2], bp4[3]};        \
    *reinterpret_cast<float4*>(sV + st * 64 + c4) = float4{vv[0], vv[1], vv[2], vv[3]};             \
    if ((tid & 15) == 0) sBonus[st] = bon;                                                          \
  }
  RW_LOAD(0);
  RW_PROCESS();
  __syncthreads();
  constexpr int NCH = SEQ / 16;
#pragma unroll 1
  for (int c = 0; c < NCH; ++c) {
    const int t0 = c * 16;
    const int tn = (c + 1 < NCH) ? t0 + 16 : t0;
    RW_LOAD(tn);
    __builtin_amdgcn_sched_barrier(0);
#pragma unroll 2
    for (int t = 0; t < 16; ++t) {
      const float4* a4p = reinterpret_cast<const float4*>(sA + t * 64 + kq * 8);
      const float4* w4p = reinterpret_cast<const float4*>(sW + t * 64 + kq * 8);
      const float4* b4p = reinterpret_cast<const float4*>(sBb + t * 64 + kq * 8);
      const float4* k4p = reinterpret_cast<const float4*>(sK + t * 64 + kq * 8);
      const float4* r4p = reinterpret_cast<const float4*>(sR + t * 64 + kq * 8);
      const float2 vv = *reinterpret_cast<const float2*>(sV + t * 64 + vrow);
      float sa0 = 0.f, sa1 = 0.f;
#pragma unroll
      for (int q = 0; q < 2; ++q) {
        float4 a = a4p[q];
        sa0 = fmaf(S0[q * 4 + 0], a.x, sa0); sa1 = fmaf(S1[q * 4 + 0], a.x, sa1);
        sa0 = fmaf(S0[q * 4 + 1], a.y, sa0); sa1 = fmaf(S1[q * 4 + 1], a.y, sa1);
        sa0 = fmaf(S0[q * 4 + 2], a.z, sa0); sa1 = fmaf(S1[q * 4 + 2], a.z, sa1);
        sa0 = fmaf(S0[q * 4 + 3], a.w, sa0); sa1 = fmaf(S1[q * 4 + 3], a.w, sa1);
      }
      sa0 = oct_sum(sa0); sa1 = oct_sum(sa1);
      float y0 = 0.f, y1 = 0.f;
#pragma unroll
      for (int q = 0; q < 2; ++q) {
        float4 ww = w4p[q], bb = b4p[q], kk = k4p[q], rr = r4p[q];
        S0[q * 4 + 0] = fmaf(S0[q * 4 + 0], ww.x, fmaf(sa0, bb.x, vv.x * kk.x)); y0 = fmaf(S0[q * 4 + 0], rr.x, y0);
        S1[q * 4 + 0] = fmaf(S1[q * 4 + 0], ww.x, fmaf(sa1, bb.x, vv.y * kk.x)); y1 = fmaf(S1[q * 4 + 0], rr.x, y1);
        S0[q * 4 + 1] = fmaf(S0[q * 4 + 1], ww.y, fmaf(sa0, bb.y, vv.x * kk.y)); y0 = fmaf(S0[q * 4 + 1], rr.y, y0);
        S1[q * 4 + 1] = fmaf(S1[q * 4 + 1], ww.y, fmaf(sa1, bb.y, vv.y * kk.y)); y1 = fmaf(S1[q * 4 + 1], rr.y, y1);
        S0[q * 4 + 2] = fmaf(S0[q * 4 + 2], ww.z, fmaf(sa0, bb.z, vv.x * kk.z)); y0 = fmaf(S0[q * 4 + 2], rr.z, y0);
        S1[q * 4 + 2] = fmaf(S1[q * 4 + 2], ww.z, fmaf(sa1, bb.z, vv.y * kk.z)); y1 = fmaf(S1[q * 4 + 2], rr.z, y1);
        S0[q * 4 + 3] = fmaf(S0[q * 4 + 3], ww.w, fmaf(sa0, bb.w, vv.x * kk.w)); y0 = fmaf(S0[q * 4 + 3], rr.w, y0);
        S1[q * 4 + 3] = fmaf(S1[q * 4 + 3], ww.w, fmaf(sa1, bb.w, vv.y * kk.w)); y1 = fmaf(S1[q * 4 + 3], rr.w, y1);
      }
      y0 = oct_sum(y0); y1 = oct_sum(y1);
      if (kq == 0) *reinterpret_cast<float2*>(sY + t * 64 + vrow) = float2{y0, y1};
    }
    __builtin_amdgcn_sched_barrier(0);
    __syncthreads();
    {
      float4 y4 = *reinterpret_cast<const float4*>(sY + st * 64 + c4);
      float4 v4 = *reinterpret_cast<const float4*>(sV + st * 64 + c4);
      float bon = sBonus[st];
      float mean = sum16(y4.x + y4.y + y4.z + y4.w) * (1.f / 64.f);
      float dx = y4.x - mean, dy = y4.y - mean, dz = y4.z - mean, dw = y4.w - mean;
      float var = sum16(dx * dx + dy * dy + dz * dz + dw * dw) * (1.f / 64.f);
      float rs = rsqrtf(var + 64e-5f);
      float o0 = dx * rs * lnw[0] + lnb[0] + bon * v4.x;
      float o1 = dy * rs * lnw[1] + lnb[1] + bon * v4.y;
      float o2 = dz * rs * lnw[2] + lnb[2] + bon * v4.z;
      float o3 = dw * rs * lnw[3] + lnb[3] + bon * v4.w;
      uint2 o;
      o.x = pack2(o0, o1); o.y = pack2(o2, o3);
      *reinterpret_cast<uint2*>(Z + (size_t)(t0 + st) * ZS + ZRW + 1024 + ch) = o;
    }
    RW_PROCESS();
    __syncthreads();
  }
#undef RW_LOAD
#undef RW_PROCESS
}

__device__ void phase_scans(const Params& p, int l, char* smem, int scan_mask = 15) {
  for (int t = blockIdx.x; t < 256; t += gridDim.x) {
    int type = t & 3, idx = t >> 2;
    if (!((scan_mask >> type) & 1)) continue;
#ifndef SCM
#define SCM 15
#endif
    if (type == 0) { if (SCM & 1) rw_scan(p, l, idx, smem); }
    else if (type == 1) { if (SCM & 2) hg_scan(p, l, idx, smem); }
    else if (type == 2) { if (SCM & 4) mb_scan(p, l, idx, smem); }
    else { if (SCM & 8) s5_scan(p, l, idx, smem); }
    __syncthreads();
  }
}

__device__ __forceinline__ void unpack8(const uint4& v, float (&f)[8]) {
  f[0] = bf2f((bf16_t)(v.x & 0xffff)); f[1] = bf2f((bf16_t)(v.x >> 16));
  f[2] = bf2f((bf16_t)(v.y & 0xffff)); f[3] = bf2f((bf16_t)(v.y >> 16));
  f[4] = bf2f((bf16_t)(v.z & 0xffff)); f[5] = bf2f((bf16_t)(v.z >> 16));
  f[6] = bf2f((bf16_t)(v.w & 0xffff)); f[7] = bf2f((bf16_t)(v.w >> 16));
}

__device__ void phase_post(const Params& p, int l, char* smem) {
  bf16_t* Z = (bf16_t*)(p.ws + OFF_Z);
  const int tid = opaque_tid(), lane = tid & 63, wid = tid >> 6;
  constexpr int N_ROWT = T_TOK / 4, N_RWT = T_TOK / 16, N_GLU = 128 * 4, N_NORM = T_TOK / 4;
  const float* xsrc = (l == 0) ? p.in[I_X] : p.out;
  for (int t = blockIdx.x; t < N_ROWT + N_RWT + N_GLU + N_NORM; t += gridDim.x) {
    if (t < N_ROWT) {
      const int row = t * 4 + wid;
      {
        bf16_t* op = Z + (size_t)row * ZS + ZHG + 1024 + lane * 8;
        uint4 ov = *reinterpret_cast<const uint4*>(op);
        uint4 gv = *reinterpret_cast<const uint4*>(op + 512);
        float o[8], g[8];
        unpack8(ov, o); unpack8(gv, g);
        float ss = 0.f;
#pragma unroll
        for (int e = 0; e < 8; ++e) ss += o[e] * o[e];
        ss = sum16(ss);
        float rstd = rsqrtf(ss * (1.f / 128.f) + 1e-6f);
        const float* nw = p.in[I_HG_NW] + l * 512 + lane * 8;
        float r[8];
#pragma unroll
        for (int e = 0; e < 8; ++e) r[e] = o[e] * rstd * nw[e] * siluf_(g[e]);
        *reinterpret_cast<uint4*>(op) = uint4{pack2(r[0], r[1]), pack2(r[2], r[3]), pack2(r[4], r[5]), pack2(r[6], r[7])};
      }
      {
        bf16_t* op = Z + (size_t)row * ZS + ZMB + lane * 8;
        uint4 ov = *reinterpret_cast<const uint4*>(op);
        float o[8];
        unpack8(ov, o);
        float ss = 0.f;
#pragma unroll
        for (int e = 0; e < 8; ++e) ss += o[e] * o[e];
        ss = sum64(ss);
        float rstd = rsqrtf(ss * (1.f / 512.f) + 1e-6f);
        const float* nw = p.in[I_MB_NW] + l * 512 + lane * 8;
        float r[8];
#pragma unroll
        for (int e = 0; e < 8; ++e) r[e] = o[e] * rstd * nw[e];
        *reinterpret_cast<uint4*>(op) = uint4{pack2(r[0], r[1]), pack2(r[2], r[3]), pack2(r[4], r[5]), pack2(r[6], r[7])};
      }
    } else if (t < N_ROWT + N_RWT) {
      const int row0 = (t - N_ROWT) * 16;
      float* sXg = reinterpret_cast<float*>(smem);
      const float* mu = p.in[I_RW_MU] + l * 1792 + 1664;
      for (int e = tid; e < 2048; e += 256) {
        int j = e >> 4, tok = e & 15;
        int row = row0 + tok, s = row & (SEQ - 1);
        sXg[j * 16 + tok] = sigmoidf_(rw_shift(Z, row, s, 1664 + j, mu[j]));
      }
      __syncthreads();
      float a0[16], a1[16];
      lora_mm<128>(sXg, p.in[I_RW_G2] + (size_t)l * 128 * 512, a0, a1, tid);
#pragma unroll
      for (int tok = 0; tok < 16; ++tok) {
        bf16_t* yp = Z + (size_t)(row0 + tok) * ZS + ZRW + 1024 + tid;
        yp[0] = f2bf(bf2f(yp[0]) * a0[tok]);
        yp[256] = f2bf(bf2f(yp[256]) * a1[tok]);
      }
      __syncthreads();
    } else if (t < N_ROWT + N_RWT + N_GLU) {
      const int tt = t - N_ROWT - N_RWT, mt = tt >> 2, nt = tt & 3;
      const int wm = wid >> 1, wn = wid & 1;
      f32x4 acc[4][4];
      zero_acc<128>(acc);
      gemm_mainloop<128>(acc, Z + ZS5, ZS, mt * 128, (const bf16_t*)(p.ws + OFF_WTGLU), 512, nt * 128, 511, 512, smem, tid);
      const float* bg = p.in[I_S5_BGLU] + l * 512;
#pragma unroll
      for (int mi = 0; mi < 4; ++mi)
#pragma unroll
        for (int ni = 0; ni < 4; ++ni) {
          int col = nt * 128 + wn * 64 + ni * 16 + (lane >> 4) * 4;
          int row = mt * 128 + wm * 64 + mi * 16 + (lane & 15);
          float4 b4 = *reinterpret_cast<const float4*>(bg + col);
          uint2 yv = *reinterpret_cast<const uint2*>(Z + (size_t)row * ZS + ZS5 + col);
          float y0 = bf2f((bf16_t)(yv.x & 0xffff)), y1 = bf2f((bf16_t)(yv.x >> 16));
          float y2 = bf2f((bf16_t)(yv.y & 0xffff)), y3 = bf2f((bf16_t)(yv.y >> 16));
          uint2 o;
          o.x = pack2(y0 * sigmoidf_(acc[mi][ni][0] + b4.x), y1 * sigmoidf_(acc[mi][ni][1] + b4.y));
          o.y = pack2(y2 * sigmoidf_(acc[mi][ni][2] + b4.z), y3 * sigmoidf_(acc[mi][ni][3] + b4.w));
          *reinterpret_cast<uint2*>(Z + (size_t)row * ZS + ZMB + 1024 + col) = o;
        }
    } else {
      const int row = (t - N_ROWT - N_RWT - N_GLU) * 4 + wid;
      rmsnorm_row_to_bf16(xsrc + (size_t)row * DM, p.in[I_NORM_MIX] + l * DM, (bf16_t*)(p.ws + OFF_U) + (size_t)row * DM, tid & 63);
    }
  }
}

__device__ void phase_merge(const Params& p, char* smem) {
  bf16_t* Z = (bf16_t*)(p.ws + OFF_Z);
  const bf16_t* U = (const bf16_t*)(p.ws + OFF_U);
  const bf16_t* Wg = (const bf16_t*)(p.ws + OFF_WTGATE);
  const bf16_t* Wb = (const bf16_t*)(p.ws + OFF_WTBR);
  const int tid = opaque_tid();
  const int lane = tid & 63, wid = tid >> 6, wm = wid >> 1, wn = wid & 1;
  for (int t = blockIdx.x; t < tile_count(128, 16); t += gridDim.x) {
    int mt, nt;
    if (!tile_map(t, 16, mt, nt)) continue;
    f32x4 accm[4][2];
    zero_acc<64>(accm);
    for (int kb = 0; kb < 4; ++kb) {
      f32x4 g[4][2], pr[4][2];
      zero_acc<64>(g);
      zero_acc<64>(pr);
      gemm_mainloop<64>(g, U, 1024, mt * 128, Wg + (size_t)kb * 1024 * 1024, 1024, nt * 64, 1023, 1024, smem, tid);
      const int ycol = (kb == 0) ? (ZHG + 1024) : (kb == 1) ? (ZRW + 1024) : (kb == 2) ? (ZMB + 1024) : ZMB;
      gemm_mainloop<64>(pr, Z + ycol, ZS, mt * 128, Wb + (size_t)kb * 1024 * 512, 512, nt * 64, 1023, 512, smem, tid);
#pragma unroll
      for (int mi = 0; mi < 4; ++mi)
#pragma unroll
        for (int ni = 0; ni < 2; ++ni)
#pragma unroll
          for (int j = 0; j < 4; ++j) accm[mi][ni][j] = fmaf(sigmoidf_(g[mi][ni][j]), pr[mi][ni][j], accm[mi][ni][j]);
    }
#pragma unroll
    for (int mi = 0; mi < 4; ++mi)
#pragma unroll
      for (int ni = 0; ni < 2; ++ni) {
        int col = nt * 64 + wn * 32 + ni * 16 + (lane >> 4) * 4;
        int row = mt * 128 + wm * 64 + mi * 16 + (lane & 15);
        uint2 o;
        o.x = pack2(accm[mi][ni][0], accm[mi][ni][1]);
        o.y = pack2(accm[mi][ni][2], accm[mi][ni][3]);
        *reinterpret_cast<uint2*>(Z + (size_t)row * ZS + col) = o;
      }
  }
}

__device__ void phase_resid_gemm(const Params& p, const bf16_t* A, int lda, const bf16_t* Wt, int K, const float* xold, char* smem) {
  const int tid = opaque_tid();
  const int lane = tid & 63, wid = tid >> 6, wm = wid >> 1, wn = wid & 1;
  for (int t = blockIdx.x; t < tile_count(128, 8); t += gridDim.x) {
    int mt, nt;
    if (!tile_map(t, 8, mt, nt)) continue;
    f32x4 acc[4][4];
    zero_acc<128>(acc);
    gemm_mainloop<128>(acc, A, lda, mt * 128, Wt, K, nt * 128, 1023, K, smem, tid);
#pragma unroll
    for (int mi = 0; mi < 4; ++mi)
#pragma unroll
      for (int ni = 0; ni < 4; ++ni) {
        int col = nt * 128 + wn * 64 + ni * 16 + (lane >> 4) * 4;
        int row = mt * 128 + wm * 64 + mi * 16 + (lane & 15);
        size_t o = (size_t)row * DM + col;
        float4 xo = *reinterpret_cast<const float4*>(xold + o);
        float4 r = float4{xo.x + acc[mi][ni][0], xo.y + acc[mi][ni][1], xo.z + acc[mi][ni][2], xo.w + acc[mi][ni][3]};
        *reinterpret_cast<float4*>(p.out + o) = r;
      }
  }
}

__device__ void phase_ffn_in(const Params& p, char* smem) {
  const bf16_t* U = (const bf16_t*)(p.ws + OFF_U);
  const bf16_t* Wt = (const bf16_t*)(p.ws + OFF_WTF1);
  bf16_t* H = (bf16_t*)(p.ws + OFF_Z);
  const int tid = opaque_tid();
  const int lane = tid & 63, wid = tid >> 6, wm = wid >> 1, wn = wid & 1;
  for (int t = blockIdx.x; t < tile_count(128, 44); t += gridDim.x) {
    int mt, nt;
    if (!tile_map(t, 44, mt, nt)) continue;
    f32x4 acc[4][4];
    zero_acc<128>(acc);
    gemm_mainloop<128>(acc, U, 1024, mt * 128, Wt, 1024, nt * 128, 5631, 1024, smem, tid);
#pragma unroll
    for (int mi = 0; mi < 4; ++mi)
#pragma unroll
      for (int q = 0; q < 2; ++q) {
        int hcol = ((nt * 128 + wn * 64 + q * 32) >> 1) + (lane >> 4) * 4;
        int row = mt * 128 + wm * 64 + mi * 16 + (lane & 15);
        uint2 o;
        o.x = pack2(siluf_(acc[mi][2 * q][0]) * acc[mi][2 * q + 1][0], siluf_(acc[mi][2 * q][1]) * acc[mi][2 * q + 1][1]);
        o.y = pack2(siluf_(acc[mi][2 * q][2]) * acc[mi][2 * q + 1][2], siluf_(acc[mi][2 * q][3]) * acc[mi][2 * q + 1][3]);
        *reinterpret_cast<uint2*>(H + (size_t)row * FFH + hcol) = o;
      }
  }
}

__device__ void phase_final(const Params& p) {
  const int tid = opaque_tid();
  const int lane = tid & 63;
  const float* w = p.in[I_NORM_FINAL];
  for (int t = blockIdx.x; t < T_TOK / 4; t += gridDim.x) {
    int row = t * 4 + (tid >> 6);
    float* x = p.out + (size_t)row * DM;
    float4 v[4];
    float ss = 0.f;
#pragma unroll
    for (int i = 0; i < 4; ++i) {
      v[i] = *reinterpret_cast<const float4*>(x + i * 256 + lane * 4);
      ss += v[i].x * v[i].x + v[i].y * v[i].y + v[i].z * v[i].z + v[i].w * v[i].w;
    }
    ss = sum64(ss);
    float rstd = rsqrtf(ss * (1.f / 1024.f) + 1e-6f);
#pragma unroll
    for (int i = 0; i < 4; ++i) {
      float4 ww = *reinterpret_cast<const float4*>(w + i * 256 + lane * 4);
      float4 o = float4{v[i].x * rstd * ww.x, v[i].y * rstd * ww.y, v[i].z * rstd * ww.z, v[i].w * rstd * ww.w};
      *reinterpret_cast<float4*>(x + i * 256 + lane * 4) = o;
    }
  }
}

template <int SUB>
__device__ __forceinline__ void run_phase(const Params& p, int l, char* smem) {
  if (SUB == 0) phase_convert_norm(p, l, smem);
  else if (SUB == 1) phase_inproj(p, smem);
  else if (SUB == 2) phase_rwprep(p, l, smem);
  else if (SUB == 3) phase_scans(p, l, smem);
  else if (SUB == 4) phase_post(p, l, smem);
  else if (SUB == 5) phase_merge(p, smem);
  else if (SUB == 6) phase_resid_gemm(p, (const bf16_t*)(p.ws + OFF_Z), ZS, (const bf16_t*)(p.ws + OFF_WTOUT), 1024,
                                      (l == 0) ? p.in[I_X] : p.out, smem);
  else if (SUB == 7) phase_norm_only(p, p.out, p.in[I_NORM_FFN] + l * DM);
  else if (SUB == 8) phase_ffn_in(p, smem);
  else if (SUB == 9) phase_resid_gemm(p, (const bf16_t*)(p.ws + OFF_Z), FFH, (const bf16_t*)(p.ws + OFF_WTF2), FFH, p.out, smem);
  else phase_final(p);
}

#ifndef PHM
#define PHM 0xFFFF
#endif
__device__ __forceinline__ void grid_bar(unsigned* ctr, unsigned& target) {
  asm volatile("s_waitcnt vmcnt(0)" ::: "memory");
  __syncthreads();
  if (threadIdx.x == 0) {
    target += gridDim.x;
    __builtin_amdgcn_fence(__ATOMIC_RELEASE, "agent");
    __hip_atomic_fetch_add(ctr, 1u, __ATOMIC_RELAXED, __HIP_MEMORY_SCOPE_AGENT);
    while (__hip_atomic_load(ctr, __ATOMIC_RELAXED, __HIP_MEMORY_SCOPE_AGENT) < target) __builtin_amdgcn_s_sleep(32);
    __builtin_amdgcn_fence(__ATOMIC_ACQUIRE, "agent");
    asm volatile("s_waitcnt vmcnt(0)" ::: "memory");
  }
  __syncthreads();
}

#if COOP
__global__ void __launch_bounds__(256, 2) fwd_kernel(Params p, int ph0, int ph1, int scan_mask) {
  __shared__ __attribute__((aligned(16))) char smem[65536];
  cg::grid_group grid = cg::this_grid();
  unsigned* bar_ctr = reinterpret_cast<unsigned*>(p.ws + OFF_BAR);
  unsigned bar_target = 0;
  for (int ph = ph0; ph < ph1; ++ph) {
    if (ph == NPHASES - 1) {
      phase_final(p);
    } else {
      const int l = ph / NPH_LAYER, sub = ph % NPH_LAYER;
      switch (sub) {
        case 0: if (PHM & (1<<0)) run_phase<0>(p, l, smem); break;
        case 1: if (PHM & (1<<1)) run_phase<1>(p, l, smem); break;
        case 2: if (PHM & (1<<2)) run_phase<2>(p, l, smem); break;
        case 3: if (PHM & (1<<3)) phase_scans(p, l, smem, scan_mask); break;
        case 4: if (PHM & (1<<4)) run_phase<4>(p, l, smem); break;
        case 5: if (PHM & (1<<5)) run_phase<5>(p, l, smem); break;
        case 6: if (PHM & (1<<6)) run_phase<6>(p, l, smem); break;
        case 7: if (PHM & (1<<7)) run_phase<7>(p, l, smem); break;
        case 8: if (PHM & (1<<8)) run_phase<8>(p, l, smem); break;
        case 9: if (PHM & (1<<9)) run_phase<9>(p, l, smem); break;
      }
    }
    if (ph + 1 < ph1) {
      if (ph == ph0) grid.sync();
      else grid_bar(bar_ctr, bar_target);
    }
  }
}
#else
template <int SUB>
__global__ void __launch_bounds__(256, 2) k_phase(Params p, int l) {
  __shared__ __attribute__((aligned(16))) char smem[65536];
  run_phase<SUB>(p, l, smem);
}
#endif

extern "C" void kernel_launch(void* const* d_in, const int* in_sizes, int n_in, void* d_out, int out_size, void* d_ws,
                              size_t ws_size, hipStream_t stream) {
  if (n_in < 41 || ws_size < WS_NEED) {
    fprintf(stderr, "kernel_launch: bad args n_in=%d ws=%zu need=%zu\n", n_in, ws_size, (size_t)WS_NEED);
    return;
  }
  Params p{};
  for (int i = 0; i < 41; ++i) p.in[i] = (const float*)d_in[i];
  p.out = (float*)d_out;
  p.ws = (char*)d_ws;
#if COOP
  static int grid_blocks = 0;
  if (!grid_blocks) {
    int dev = 0, cus = 0, per_cu = 0;
    hipGetDevice(&dev);
    hipDeviceGetAttribute(&cus, hipDeviceAttributeMultiprocessorCount, dev);
    hipOccupancyMaxActiveBlocksPerMultiprocessor(&per_cu, fwd_kernel, 256, 0);
    if (per_cu > 2) per_cu = 2;
    grid_blocks = cus * per_cu;
  }
#ifdef HYBRID
  for (int ph = 0; ph < NPHASES; ++ph) {
    if (ph % 10 == 3 && ph < 20) {
      const int groups[4] = SCAN_GROUPS;
      for (int gi = 0; gi < 4; ++gi) if (groups[gi]) fwd_kernel<<<grid_blocks, 256, 0, stream>>>(p, ph, ph + 1, groups[gi]);
    } else {
      fwd_kernel<<<grid_blocks, 256, 0, stream>>>(p, ph, ph + 1, 15);
    }
  }
#else
  hipMemsetAsync((char*)d_ws + OFF_BAR, 0, 256, stream);
  int ph0 = 0, ph1 = NPHASES, smask = 15;
  void* args[] = {&p, &ph0, &ph1, &smask};
  hipError_t e = hipLaunchCooperativeKernel((void*)fwd_kernel, dim3(grid_blocks), dim3(256), args, 0, stream);
  if (e != hipSuccess) fprintf(stderr, "cooperative launch failed: %s (grid %d)\n", hipGetErrorString(e), grid_blocks);
#endif
#else
  const dim3 g(512), b(256);
  for (int l = 0; l < 2; ++l) {
    k_phase<0><<<g, b, 0, stream>>>(p, l);
    k_phase<1><<<g, b, 0, stream>>>(p, l);
    k_phase<2><<<g, b, 0, stream>>>(p, l);
    k_phase<3><<<g, b, 0, stream>>>(p, l);
    k_phase<4><<<g, b, 0, stream>>>(p, l);
    k_phase<5><<<g, b, 0, stream>>>(p, l);
    k_phase<6><<<g, b, 0, stream>>>(p, l);
    k_phase<7><<<g, b, 0, stream>>>(p, l);
    k_phase<8><<<g, b, 0, stream>>>(p, l);
    k_phase<9><<<g, b, 0, stream>>>(p, l);
  }
  k_phase<10><<<g, b, 0, stream>>>(p, 0);
#endif
}
```

```cpp
#include <hip/hip_runtime.h>
#include <hip/hip_cooperative_groups.h>
#include <cstdio>
#include <cstdint>
namespace cg = cooperative_groups;

#ifndef COOP
#define COOP 1
#endif

typedef unsigned short bf16_t;
typedef __attribute__((ext_vector_type(8))) short bf16x8;
typedef __attribute__((ext_vector_type(4))) float f32x4;
typedef __attribute__((ext_vector_type(4))) unsigned u32x4;

constexpr int T_TOK = 16384, SEQ = 2048, DM = 1024;
constexpr int IN_COLS = 9992, NZ = 5896, ZS = 5904;
constexpr int ZHG = 0, ZRW = 2048, ZS5 = 3840, ZMB = 4352;
constexpr int FFH = 2816;
constexpr int NPH_LAYER = 10, NPHASES = 21;

constexpr size_t OFF_WTIN   = 0;
constexpr size_t OFF_WTGATE = OFF_WTIN + (size_t)5896 * 1024 * 2;
constexpr size_t OFF_WTBR   = OFF_WTGATE + (size_t)4096 * 1024 * 2;
constexpr size_t OFF_WTOUT  = OFF_WTBR + (size_t)4 * 1024 * 512 * 2;
constexpr size_t OFF_WTF1   = OFF_WTOUT + (size_t)1024 * 1024 * 2;
constexpr size_t OFF_WTF2   = OFF_WTF1 + (size_t)5632 * 1024 * 2;
constexpr size_t OFF_WTGLU  = OFF_WTF2 + (size_t)1024 * 2816 * 2;
constexpr size_t OFF_U      = OFF_WTGLU + (size_t)512 * 512 * 2;
constexpr size_t OFF_Z      = OFF_U + (size_t)T_TOK * 1024 * 2;
constexpr size_t OFF_VF     = OFF_Z + (size_t)T_TOK * ZS * 2;
constexpr size_t OFF_BAR    = OFF_VF + (size_t)T_TOK * 512 * 2;
constexpr size_t WS_NEED    = OFF_BAR + 256;

struct Params {
  const float* in[41];
  float* out;
  char* ws;
};

enum { I_X = 0, I_NORM_MIX, I_W_IN, I_W_BRANCH, I_W_OUT, I_NORM_FFN, I_W_FFN_IN, I_W_FFN_OUT, I_NORM_FINAL,
       I_HG_LB, I_HG_NW, I_RW_MU, I_RW_W0, I_RW_W2, I_RW_A0, I_RW_A2, I_RW_G2, I_RW_KK, I_RW_KA, I_RW_RK,
       I_RW_LNW, I_RW_LNB, I_RW_V0, I_RW_V1, I_RW_V2, I_S5_ARE, I_S5_AIM, I_S5_BRE, I_S5_BIM, I_S5_CRE,
       I_S5_CIM, I_S5_D, I_S5_LOGDT, I_S5_WGLU, I_S5_BGLU, I_MB_CONVW, I_MB_CONVB, I_MB_DTB, I_MB_ALOG,
       I_MB_D, I_MB_NW };

__device__ __forceinline__ float bf2f(bf16_t v) { return __uint_as_float(((unsigned)v) << 16); }
typedef __attribute__((ext_vector_type(2))) __bf16 bf16x2_t;
__device__ __forceinline__ unsigned pack2(float a, float b) {
  bf16x2_t v;
  v[0] = (__bf16)a;
  v[1] = (__bf16)b;
  return __builtin_bit_cast(unsigned, v);
}
__device__ __forceinline__ bf16_t f2bf(float f) { return (bf16_t)(pack2(f, 0.f) & 0xffffu); }
__device__ __forceinline__ float sigmoidf_(float x) { return 1.f / (1.f + __expf(-x)); }
__device__ __forceinline__ float siluf_(float x) { return x / (1.f + __expf(-x)); }
__device__ __forceinline__ float softplusf_(float x) { return x > 20.f ? x : log1pf(__expf(x)); }
__device__ __forceinline__ float gelu_tanh(float x) {
  float u = 0.7978845608028654f * (x + 0.044715f * x * x * x);
  return 0.5f * x * (1.f + tanhf(u));
}
__device__ __forceinline__ float quad_sum(float x) {
  x += __builtin_bit_cast(float, __builtin_amdgcn_update_dpp(0, __builtin_bit_cast(int, x), 0xB1, 0xF, 0xF, true));
  x += __builtin_bit_cast(float, __builtin_amdgcn_update_dpp(0, __builtin_bit_cast(int, x), 0x4E, 0xF, 0xF, true));
  return x;
}
__device__ __forceinline__ float oct_sum(float x) {
  x = quad_sum(x);
  x += __builtin_bit_cast(float, __builtin_amdgcn_update_dpp(0, __builtin_bit_cast(int, x), 0x141, 0xF, 0xF, true));
  return x;
}
__device__ __forceinline__ float sum16(float x) {
  x += __shfl_xor(x, 1); x += __shfl_xor(x, 2); x += __shfl_xor(x, 4); x += __shfl_xor(x, 8);
  return x;
}
__device__ __forceinline__ float sum64(float x) {
  x = sum16(x); x += __shfl_xor(x, 16); x += __shfl_xor(x, 32);
  return x;
}

__device__ __forceinline__ int opaque_tid() {
  int t = threadIdx.x;
  asm volatile("" : "+v"(t));
  return t;
}

template <int BN>
__device__ __forceinline__ void gemm_mainloop(f32x4 (&acc)[4][BN / 32], const bf16_t* A, int lda, int m0,
                                              const bf16_t* Bt, int ldb, int n0, int nmax, int K, char* smem, const int tid) {
  const int lane = tid & 63, wid = tid >> 6, wm = wid >> 1, wn = wid & 1;
  const int q = tid & 7, r0 = tid >> 3;
  unsigned offA[4], offB[BN / 32];
#pragma unroll
  for (int i = 0; i < 4; ++i) offA[i] = ((unsigned)(m0 + r0 + 32 * i) * (unsigned)lda + (unsigned)q * 8u) * 2u;
#pragma unroll
  for (int i = 0; i < BN / 32; ++i) {
    int row = n0 + r0 + 32 * i;
    row = row < nmax ? row : nmax;
    offB[i] = ((unsigned)row * (unsigned)ldb + (unsigned)q * 8u) * 2u;
  }
  const unsigned sto = (unsigned)r0 * 128u + (unsigned)((q ^ ((r0 >> 1) & 7)) << 4);
  unsigned aoff[4], boff[BN / 32];
#pragma unroll
  for (int mi = 0; mi < 4; ++mi) {
    int row = wm * 64 + mi * 16 + (lane & 15);
    aoff[mi] = (unsigned)row * 128u + (unsigned)(((lane >> 4) ^ ((row >> 1) & 7)) << 4);
  }
#pragma unroll
  for (int ni = 0; ni < BN / 32; ++ni) {
    int row = wn * (BN / 2) + ni * 16 + (lane & 15);
    boff[ni] = (unsigned)row * 128u + (unsigned)(((lane >> 4) ^ ((row >> 1) & 7)) << 4);
  }
  const char* Ab = reinterpret_cast<const char*>(A);
  const char* Bb = reinterpret_cast<const char*>(Bt);
  const int nk = K >> 6;
  constexpr bool WIDE = (BN == 128);
  u32x4 Ra0, Ra1, Ra2, Ra3, Rb0, Rb1, Rb2, Rb3;
  u32x4 Qa0, Qa1, Qa2, Qa3, Qb0, Qb1, Qb2, Qb3;
#define GLOAD(P, TILE)                                                         \
  {                                                                            \
    const char* Ak_ = Ab + (size_t)(TILE) * 128;                               \
    const char* Bk_ = Bb + (size_t)(TILE) * 128;                               \
    P##a0 = *reinterpret_cast<const u32x4*>(Ak_ + offA[0]);                    \
    P##a1 = *reinterpret_cast<const u32x4*>(Ak_ + offA[1]);                    \
    P##a2 = *reinterpret_cast<const u32x4*>(Ak_ + offA[2]);                    \
    P##a3 = *reinterpret_cast<const u32x4*>(Ak_ + offA[3]);                    \
    P##b0 = *reinterpret_cast<const u32x4*>(Bk_ + offB[0]);                    \
    P##b1 = *reinterpret_cast<const u32x4*>(Bk_ + offB[1]);                    \
    if (WIDE) {                                                                \
      P##b2 = *reinterpret_cast<const u32x4*>(Bk_ + offB[BN / 32 - 2]);        \
      P##b3 = *reinterpret_cast<const u32x4*>(Bk_ + offB[BN / 32 - 1]);        \
    }                                                                          \
  }
#define SSTORE(P, BUF)                                                         \
  {                                                                            \
    char* ad_ = smem + (BUF) * 16384 + sto;                                    \
    char* bd_ = smem + 32768 + (BUF) * (BN * 128) + sto;                       \
    *reinterpret_cast<u32x4*>(ad_) = P##a0;                                    \
    *reinterpret_cast<u32x4*>(ad_ + 4096) = P##a1;                             \
    *reinterpret_cast<u32x4*>(ad_ + 8192) = P##a2;                             \
    *reinterpret_cast<u32x4*>(ad_ + 12288) = P##a3;                            \
    *reinterpret_cast<u32x4*>(bd_) = P##b0;                                    \
    *reinterpret_cast<u32x4*>(bd_ + 4096) = P##b1;                             \
    if (WIDE) {                                                                \
      *reinterpret_cast<u32x4*>(bd_ + 8192) = P##b2;                           \
      *reinterpret_cast<u32x4*>(bd_ + 12288) = P##b3;                          \
    }                                                                          \
  }
#define COMPUTE(BUF)                                                           \
  {                                                                            \
    const char* a_s = smem + (BUF) * 16384;                                    \
    const char* b_s = smem + 32768 + (BUF) * (BN * 128);                       \
    _Pragma("unroll") for (int ks = 0; ks < 2; ++ks) {                         \
      bf16x8 af[4], bfr[BN / 32];                                              \
      _Pragma("unroll") for (int mi = 0; mi < 4; ++mi)                         \
          af[mi] = *reinterpret_cast<const bf16x8*>(a_s + (aoff[mi] ^ (ks * 64)));       \
      _Pragma("unroll") for (int ni = 0; ni < BN / 32; ++ni)                   \
          bfr[ni] = *reinterpret_cast<const bf16x8*>(b_s + (boff[ni] ^ (ks * 64)));      \
      _Pragma("unroll") for (int mi = 0; mi < 4; ++mi)                         \
        _Pragma("unroll") for (int ni = 0; ni < BN / 32; ++ni)                 \
          acc[mi][ni] = __builtin_amdgcn_mfma_f32_16x16x32_bf16(bfr[ni], af[mi], acc[mi][ni], 0, 0, 0); \
    }                                                                          \
  }
  if constexpr (WIDE) {
    GLOAD(R, 0);
    SSTORE(R, 0);
    GLOAD(R, 1);
    if (nk > 2) GLOAD(Q, 2);
    __syncthreads();
#pragma unroll 1
    for (int kt = 0; kt < nk; kt += 2) {
      __builtin_amdgcn_sched_barrier(0);
      COMPUTE(0);
      __builtin_amdgcn_sched_barrier(0);
      SSTORE(R, 1);
      if (kt + 3 < nk) GLOAD(R, kt + 3);
      __syncthreads();
      __builtin_amdgcn_sched_barrier(0);
      COMPUTE(1);
      __builtin_amdgcn_sched_barrier(0);
      if (kt + 2 < nk) SSTORE(Q, 0);
      if (kt + 4 < nk) GLOAD(Q, kt + 4);
      __syncthreads();
    }
  } else {
    GLOAD(R, 0);
    SSTORE(R, 0);
    __syncthreads();
#pragma unroll 1
    for (int kt = 0; kt < nk; ++kt) {
      const int buf = kt & 1;
      const bool more = (kt + 1 < nk);
      if (more) GLOAD(R, kt + 1);
      __builtin_amdgcn_sched_barrier(0);
      COMPUTE(buf);
      __builtin_amdgcn_sched_barrier(0);
      if (more) SSTORE(R, buf ^ 1);
      __syncthreads();
    }
  }
#undef GLOAD
#undef SSTORE
#undef COMPUTE
}

template <int BN>
__device__ __forceinline__ void zero_acc(f32x4 (&acc)[4][BN / 32]) {
#pragma unroll
  for (int mi = 0; mi < 4; ++mi)
#pragma unroll
    for (int ni = 0; ni < BN / 32; ++ni) acc[mi][ni] = f32x4{0.f, 0.f, 0.f, 0.f};
}

__device__ __forceinline__ void gemm_mainloop_big(f32x4 (&acc)[8][4], const bf16_t* A, int lda, int m0, const bf16_t* Bt,
                                                  int ldb, int n0, int nmax, int K, char* smem, const int tid) {
  const int lane = tid & 63, wid = tid >> 6, wm = wid >> 1, wn = wid & 1;
  const int q = tid & 3, r0 = tid >> 2;
  unsigned offA[4], offB[2];
#pragma unroll
  for (int i = 0; i < 4; ++i) offA[i] = ((unsigned)(m0 + r0 + 64 * i) * (unsigned)lda + (unsigned)q * 8u) * 2u;
#pragma unroll
  for (int i = 0; i < 2; ++i) {
    int row = n0 + r0 + 64 * i;
    row = row < nmax ? row : nmax;
    offB[i] = ((unsigned)row * (unsigned)ldb + (unsigned)q * 8u) * 2u;
  }
  const unsigned sto = (unsigned)r0 * 64u + (unsigned)((q ^ ((r0 >> 2) & 3)) << 4);
  unsigned aoff[8], boff[4];
#pragma unroll
  for (int mi = 0; mi < 8; ++mi) {
    int row = wm * 128 + mi * 16 + (lane & 15);
    aoff[mi] = (unsigned)row * 64u + (unsigned)(((lane >> 4) ^ ((row >> 2) & 3)) << 4);
  }
#pragma unroll
  for (int ni = 0; ni < 4; ++ni) {
    int row = wn * 64 + ni * 16 + (lane & 15);
    boff[ni] = (unsigned)row * 64u + (unsigned)(((lane >> 4) ^ ((row >> 2) & 3)) << 4);
  }
  const char* Ab = reinterpret_cast<const char*>(A);
  const char* Bb = reinterpret_cast<const char*>(Bt);
  const int nk = K >> 5;
  u32x4 Ra0, Ra1, Ra2, Ra3, Rb0, Rb1;
#define BG_LOAD(TILE)                                                  \
  {                                                                    \
    const char* Ak_ = Ab + (size_t)(TILE) * 64;                        \
    const char* Bk_ = Bb + (size_t)(TILE) * 64;                        \
    Ra0 = *reinterpret_cast<const u32x4*>(Ak_ + offA[0]);              \
    Ra1 = *reinterpret_cast<const u32x4*>(Ak_ + offA[1]);              \
    Ra2 = *reinterpret_cast<const u32x4*>(Ak_ + offA[2]);              \
    Ra3 = *reinterpret_cast<const u32x4*>(Ak_ + offA[3]);              \
    Rb0 = *reinterpret_cast<const u32x4*>(Bk_ + offB[0]);              \
    Rb1 = *reinterpret_cast<const u32x4*>(Bk_ + offB[1]);              \
  }
#define BG_STORE(BUF)                                                  \
  {                                                                    \
    char* ad_ = smem + (BUF) * 16384 + sto;                            \
    char* bd_ = smem + 32768 + (BUF) * 8192 + sto;                     \
    *reinterpret_cast<u32x4*>(ad_) = Ra0;                              \
    *reinterpret_cast<u32x4*>(ad_ + 4096) = Ra1;                       \
    *reinterpret_cast<u32x4*>(ad_ + 8192) = Ra2;                       \
    *reinterpret_cast<u32x4*>(ad_ + 12288) = Ra3;                      \
    *reinterpret_cast<u32x4*>(bd_) = Rb0;                              \
    *reinterpret_cast<u32x4*>(bd_ + 4096) = Rb1;                       \
  }
  BG_LOAD(0);
  BG_STORE(0);
  __syncthreads();
#pragma unroll 1
  for (int kt = 0; kt < nk; ++kt) {
    const int buf = kt & 1;
    const bool more = (kt + 1 < nk);
    if (more) BG_LOAD(kt + 1);
    __builtin_amdgcn_sched_barrier(0);
    {
      const char* a_s = smem + buf * 16384;
      const char* b_s = smem + 32768 + buf * 8192;
      bf16x8 bfr[4];
#pragma unroll
      for (int ni = 0; ni < 4; ++ni) bfr[ni] = *reinterpret_cast<const bf16x8*>(b_s + boff[ni]);
#pragma unroll
      for (int mi = 0; mi < 8; ++mi) {
        bf16x8 af = *reinterpret_cast<const bf16x8*>(a_s + aoff[mi]);
#pragma unroll
        for (int ni = 0; ni < 4; ++ni)
          acc[mi][ni] = __builtin_amdgcn_mfma_f32_16x16x32_bf16(bfr[ni], af, acc[mi][ni], 0, 0, 0);
      }
    }
    __builtin_amdgcn_sched_barrier(0);
    if (more) BG_STORE(buf ^ 1);
    __syncthreads();
  }
#undef BG_LOAD
#undef BG_STORE
}

__device__ __forceinline__ void zero_acc_big(f32x4 (&acc)[8][4]) {
#pragma unroll
  for (int mi = 0; mi < 8; ++mi)
#pragma unroll
    for (int ni = 0; ni < 4; ++ni) acc[mi][ni] = f32x4{0.f, 0.f, 0.f, 0.f};
}

__device__ __forceinline__ void conv_tile(const float* src, int ld, int nlimit, int k0, int n0, bf16_t* dst, int Kd, int mode,
                                          char* smem, const int tid) {
  float* sT = reinterpret_cast<float*>(smem);
#pragma unroll
  for (int i = 0; i < 16; ++i) {
    int kk = i * 4 + (tid >> 6), nn = tid & 63;
    float v = (n0 + nn < nlimit) ? src[(size_t)(k0 + kk) * ld + n0 + nn] : 0.f;
    sT[kk * 65 + nn] = v;
  }
  __syncthreads();
  {
    int nn = tid >> 2, kq = tid & 3;
    int n = n0 + nn;
    if (n < nlimit) {
      int drow = n;
      if (mode == 1) {
        if (n < FFH) drow = (n >> 4) * 32 + (n & 15);
        else { int j = n - FFH; drow = (j >> 4) * 32 + 16 + (j & 15); }
      }
      unsigned pk[8];
#pragma unroll
      for (int j = 0; j < 8; ++j) pk[j] = pack2(sT[(kq * 16 + 2 * j) * 65 + nn], sT[(kq * 16 + 2 * j + 1) * 65 + nn]);
      uint4* d = reinterpret_cast<uint4*>(dst + (size_t)drow * Kd + k0 + kq * 16);
      d[0] = uint4{pk[0], pk[1], pk[2], pk[3]};
      d[1] = uint4{pk[4], pk[5], pk[6], pk[7]};
    }
  }
  __syncthreads();
}

__device__ __forceinline__ void rmsnorm_row_to_bf16(const float* x, const float* w, bf16_t* out, const int lane) {
  float4 v[4];
  float ss = 0.f;
#pragma unroll
  for (int i = 0; i < 4; ++i) {
    v[i] = *reinterpret_cast<const float4*>(x + i * 256 + lane * 4);
    ss += v[i].x * v[i].x + v[i].y * v[i].y + v[i].z * v[i].z + v[i].w * v[i].w;
  }
  ss = sum64(ss);
  float rstd = rsqrtf(ss * (1.f / 1024.f) + 1e-6f);
#pragma unroll
  for (int i = 0; i < 4; ++i) {
    float4 ww = *reinterpret_cast<const float4*>(w + i * 256 + lane * 4);
    uint2 o;
    o.x = pack2(v[i].x * rstd * ww.x, v[i].y * rstd * ww.y);
    o.y = pack2(v[i].z * rstd * ww.z, v[i].w * rstd * ww.w);
    *reinterpret_cast<uint2*>(out + i * 256 + lane * 4) = o;
  }
}

constexpr int CT_IN = 157 * 16, CT_BR = 512, CT_OUT = 256, CT_F1 = 88 * 16, CT_F2 = 44 * 16, CT_GLU = 64;
constexpr int CT_TOTAL = CT_IN + CT_BR + CT_OUT + CT_F1 + CT_F2 + CT_GLU;

__device__ void phase_convert_norm(const Params& p, int l, char* smem) {
  const int tid = opaque_tid();
  char* ws = p.ws;
  const int ntask = CT_TOTAL + T_TOK / 4;
  const float* xsrc = (l == 0) ? p.in[I_X] : p.out;
  for (int t = blockIdx.x; t < ntask; t += gridDim.x) {
    if (t < CT_TOTAL) {
      int c = t;
      if (c < CT_IN) {
        int nt = c >> 4, kt = c & 15;
        const float* src = p.in[I_W_IN] + (size_t)l * 1024 * IN_COLS;
        if (nt < 64) conv_tile(src, IN_COLS, IN_COLS, kt * 64, nt * 64, (bf16_t*)(ws + OFF_WTGATE), 1024, 0, smem, tid);
        else conv_tile(src + 4096, IN_COLS, IN_COLS - 4096, kt * 64, (nt - 64) * 64, (bf16_t*)(ws + OFF_WTIN), 1024, 0, smem, tid);
        continue;
      }
      c -= CT_IN;
      if (c < CT_BR) {
        int kb = c >> 7, r = c & 127, nt = r >> 3, kt = r & 7;
        const float* src = p.in[I_W_BRANCH] + ((size_t)l * 4 + kb) * 512 * 1024;
        conv_tile(src, 1024, 1024, kt * 64, nt * 64, (bf16_t*)(ws + OFF_WTBR) + (size_t)kb * 1024 * 512, 512, 0, smem, tid);
        continue;
      }
      c -= CT_BR;
      if (c < CT_OUT) {
        int nt = c >> 4, kt = c & 15;
        conv_tile(p.in[I_W_OUT] + (size_t)l * 1024 * 1024, 1024, 1024, kt * 64, nt * 64, (bf16_t*)(ws + OFF_WTOUT), 1024, 0, smem, tid);
        continue;
      }
      c -= CT_OUT;
      if (c < CT_F1) {
        int nt = c >> 4, kt = c & 15;
        conv_tile(p.in[I_W_FFN_IN] + (size_t)l * 1024 * 5632, 5632, 5632, kt * 64, nt * 64, (bf16_t*)(ws + OFF_WTF1), 1024, 1, smem, tid);
        continue;
      }
      c -= CT_F1;
      if (c < CT_F2) {
        int nt = c / 44, kt = c % 44;
        conv_tile(p.in[I_W_FFN_OUT] + (size_t)l * FFH * 1024, 1024, 1024, kt * 64, nt * 64, (bf16_t*)(ws + OFF_WTF2), FFH, 0, smem, tid);
        continue;
      }
      c -= CT_F2;
      {
        int nt = c >> 3, kt = c & 7;
        conv_tile(p.in[I_S5_WGLU] + (size_t)l * 512 * 512, 512, 512, kt * 64, nt * 64, (bf16_t*)(ws + OFF_WTGLU), 512, 0, smem, tid);
      }
    } else {
      int row = (t - CT_TOTAL) * 4 + (tid >> 6);
      rmsnorm_row_to_bf16(xsrc + (size_t)row * DM, p.in[I_NORM_MIX] + l * DM, (bf16_t*)(ws + OFF_U) + (size_t)row * DM, tid & 63);
    }
  }
}

__device__ void phase_norm_only(const Params& p, const float* xsrc, const float* w) {
  const int tid = opaque_tid();
  for (int t = blockIdx.x; t < T_TOK / 4; t += gridDim.x) {
    int row = t * 4 + (tid >> 6);
    rmsnorm_row_to_bf16(xsrc + (size_t)row * DM, w, (bf16_t*)(p.ws + OFF_U) + (size_t)row * DM, tid & 63);
  }
}

__device__ __forceinline__ bool tile_map(int t, int NT, int& mt, int& nt) {
  const int x = t & 7, r = t >> 3;
  const int cnt = (NT + 7) >> 3;
  const int ni = r % cnt;
  mt = r / cnt;
  nt = x + 8 * ni;
  return nt < NT;
}
__device__ __forceinline__ int tile_count(int MT, int NT) { return 8 * MT * ((NT + 7) >> 3); }

__device__ void phase_inproj(const Params& p, char* smem) {
  const bf16_t* U = (const bf16_t*)(p.ws + OFF_U);
  const bf16_t* Wt = (const bf16_t*)(p.ws + OFF_WTIN);
  bf16_t* Z = (bf16_t*)(p.ws + OFF_Z);
  const int tid = opaque_tid();
  const int lane = tid & 63, wid = tid >> 6, wm = wid >> 1, wn = wid & 1;
  constexpr int NT = 47;
  for (int t = blockIdx.x; t < tile_count(64, NT); t += gridDim.x) {
    int mt, nt;
    if (!tile_map(t, NT, mt, nt)) continue;
    f32x4 acc[8][4];
    zero_acc_big(acc);
    gemm_mainloop_big(acc, U, 1024, mt * 256, Wt, 1024, nt * 128, NZ - 1, 1024, smem, tid);
#pragma unroll
    for (int mi = 0; mi < 8; ++mi)
#pragma unroll
      for (int ni = 0; ni < 4; ++ni) {
        int col = nt * 128 + wn * 64 + ni * 16 + (lane >> 4) * 4;
        int row = mt * 256 + wm * 128 + mi * 16 + (lane & 15);
        if (col < NZ) {
          uint2 o;
          o.x = pack2(acc[mi][ni][0], acc[mi][ni][1]);
          o.y = pack2(acc[mi][ni][2], acc[mi][ni][3]);
          *reinterpret_cast<uint2*>(Z + (size_t)row * ZS + col) = o;
        }
      }
  }
}

template <int J>
__device__ __forceinline__ void lora_mm(const float* sIn, const float* W, float (&a0)[16], float (&a1)[16], const int tid) {
#pragma unroll
  for (int i = 0; i < 16; ++i) { a0[i] = 0.f; a1[i] = 0.f; }
#pragma unroll 8
  for (int j = 0; j < J; ++j) {
    float w0 = W[j * 512 + tid], w1 = W[j * 512 + tid + 256];
    const float4* x4 = reinterpret_cast<const float4*>(sIn + j * 16);
#pragma unroll
    for (int q = 0; q < 4; ++q) {
      float4 x = x4[q];
      a0[q * 4 + 0] = fmaf(w0, x.x, a0[q * 4 + 0]); a1[q * 4 + 0] = fmaf(w1, x.x, a1[q * 4 + 0]);
      a0[q * 4 + 1] = fmaf(w0, x.y, a0[q * 4 + 1]); a1[q * 4 + 1] = fmaf(w1, x.y, a1[q * 4 + 1]);
      a0[q * 4 + 2] = fmaf(w0, x.z, a0[q * 4 + 2]); a1[q * 4 + 2] = fmaf(w1, x.z, a1[q * 4 + 2]);
      a0[q * 4 + 3] = fmaf(w0, x.w, a0[q * 4 + 3]); a1[q * 4 + 3] = fmaf(w1, x.w, a1[q * 4 + 3]);
    }
  }
}

__device__ __forceinline__ float rw_shift(const bf16_t* Z, int row, int s, int rc, float mu) {
  float cur = bf2f(Z[(size_t)row * ZS + ZRW + rc]);
  float prev = (s > 0) ? bf2f(Z[(size_t)(row - 1) * ZS + ZRW + rc]) : 0.f;
  return cur + (prev - cur) * mu;
}

__device__ void phase_rwprep(const Params& p, int l, char* smem) {
  const bf16_t* Z = (const bf16_t*)(p.ws + OFF_Z);
  bf16_t* LW = (bf16_t*)(p.ws + OFF_U);
  bf16_t* LA = LW + (size_t)T_TOK * 512;
  bf16_t* VF = (bf16_t*)(p.ws + OFF_VF);
  float* sXw = reinterpret_cast<float*>(smem);
  float* sXa = sXw + 64 * 16;
  float* sTmp = sXa + 64 * 16;
  float* sZv = sTmp + 32 * 16;
  const float* mu = p.in[I_RW_MU] + l * 1792;
  const int tid = opaque_tid();
  for (int t = blockIdx.x; t < T_TOK / 16; t += gridDim.x) {
    const int row0 = t * 16;
    for (int e = tid; e < 2048; e += 256) {
      int which = e >> 10, r = e & 1023, j = r >> 4, tok = r & 15;
      int row = row0 + tok, s = row & (SEQ - 1);
      int rc = 1536 + which * 64 + j;
      float z = rw_shift(Z, row, s, rc, mu[rc]);
      if (which == 0) sXw[j * 16 + tok] = tanhf(z); else sXa[j * 16 + tok] = z;
    }
    float zv0[16], zv1[16];
    {
      float m0 = mu[1024 + tid], m1 = mu[1024 + tid + 256];
#pragma unroll
      for (int tok = 0; tok < 16; ++tok) {
        int row = row0 + tok, s = row & (SEQ - 1);
        zv0[tok] = rw_shift(Z, row, s, 1024 + tid, m0);
        zv1[tok] = rw_shift(Z, row, s, 1024 + tid + 256, m1);
      }
    }
    if (l > 0) {
#pragma unroll
      for (int tok = 0; tok < 16; ++tok) { sZv[tid * 16 + tok] = zv0[tok]; sZv[(tid + 256) * 16 + tok] = zv1[tok]; }
    }
    __syncthreads();
    float a0[16], a1[16];
    lora_mm<64>(sXw, p.in[I_RW_W2] + (size_t)l * 64 * 512, a0, a1, tid);
#pragma unroll
    for (int tok = 0; tok < 16; ++tok) {
      LW[(size_t)(row0 + tok) * 512 + tid] = f2bf(a0[tok]);
      LW[(size_t)(row0 + tok) * 512 + tid + 256] = f2bf(a1[tok]);
    }
    lora_mm<64>(sXa, p.in[I_RW_A2] + (size_t)l * 64 * 512, a0, a1, tid);
#pragma unroll
    for (int tok = 0; tok < 16; ++tok) {
      LA[(size_t)(row0 + tok) * 512 + tid] = f2bf(a0[tok]);
      LA[(size_t)(row0 + tok) * 512 + tid + 256] = f2bf(a1[tok]);
    }
    if (l == 0) {
#pragma unroll
      for (int tok = 0; tok < 16; ++tok) {
        VF[(size_t)(row0 + tok) * 512 + tid] = f2bf(zv0[tok]);
        VF[(size_t)(row0 + tok) * 512 + tid + 256] = f2bf(zv1[tok]);
      }
    } else {
      const float* v1 = p.in[I_RW_V1] + (size_t)(l - 1) * 512 * 32;
      const float* v2 = p.in[I_RW_V2] + (size_t)(l - 1) * 32 * 512;
      const float* v0 = p.in[I_RW_V0] + (size_t)(l - 1) * 512;
      {
        int r = tid & 31, tg = tid >> 5;
        float t0 = 0.f, t1 = 0.f;
#pragma unroll 16
        for (int c = 0; c < 512; ++c) {
          float w = v1[c * 32 + r];
          float2 x = *reinterpret_cast<const float2*>(sZv + c * 16 + tg * 2);
          t0 = fmaf(w, x.x, t0); t1 = fmaf(w, x.y, t1);
        }
        sTmp[r * 16 + tg * 2] = t0; sTmp[r * 16 + tg * 2 + 1] = t1;
      }
      __syncthreads();
      lora_mm<32>(sTmp, v2, a0, a1, tid);
      float b0 = v0[tid], b1 = v0[tid + 256];
#pragma unroll
      for (int tok = 0; tok < 16; ++tok) {
        size_t i0 = (size_t)(row0 + tok) * 512 + tid;
        float vf0 = bf2f(VF[i0]), vf1 = bf2f(VF[i0 + 256]);
        VF[i0] = f2bf(zv0[tok] + (vf0 - zv0[tok]) * sigmoidf_(b0 + a0[tok]));
        VF[i0 + 256] = f2bf(zv1[tok] + (vf1 - zv1[tok]) * sigmoidf_(b1 + a1[tok]));
      }
    }
    __syncthreads();
  }
}

__device__ __forceinline__ float frcp(float x) { return __builtin_amdgcn_rcpf(x); }
__device__ __forceinline__ float fsigmoid(float x) { return frcp(1.f + __expf(-x)); }
__device__ __forceinline__ float fsilu(float x) { return x * frcp(1.f + __expf(-x)); }
__device__ __forceinline__ float fsoftplus(float x) { return x > 20.f ? x : __logf(1.f + __expf(x)); }
__device__ __forceinline__ float ftanh(float x) {
  float e = __expf(2.f * fminf(fmaxf(x, -15.f), 15.f));
  return (e - 1.f) * frcp(e + 1.f);
}
__device__ __forceinline__ float fgelu(float x) {
  float u = 0.7978845608028654f * (x + 0.044715f * x * x * x);
  return 0.5f * x * (1.f + ftanh(u));
}

__device__ void hg_scan(const Params& p, int l, int task, char* smem) {
  const int b = task >> 3, h = (task >> 1) & 3, vg = task & 1;
  float* sFg = reinterpret_cast<float*>(smem);
  float* sQs = sFg + 16 * 128;
  float* sO = sQs + 16 * 128;
  float* sVv = sO + 4 * 16 * 64;
  const int tid = opaque_tid(), w = tid >> 6, lane = tid & 63;
  bf16_t* Z = (bf16_t*)(p.ws + OFF_Z) + (size_t)b * SEQ * ZS;
  const int ks = tid & 127;
  float lb = 0.f;
  if (l > 0) {
    float x0 = p.in[I_HG_LB][h * 128 + ks], x1 = p.in[I_HG_LB][512 + h * 128 + ks];
    float m = fmaxf(x0, x1), e0 = expf(x0 - m), e1 = expf(x1 - m);
    lb = e1 / (e0 + e1);
  }
  float s[32];
#pragma unroll
  for (int j = 0; j < 32; ++j) s[j] = 0.f;
  const int vcol = ZHG + 1024 + h * 128 + vg * 64;
  const int qcol = ZHG + h * 128 + ks;
  bf16_t rq0, rq1, rq2, rq3, rq4, rq5, rq6, rq7, rf0, rf1, rf2, rf3, rf4, rf5, rf6, rf7, rv0, rv1, rv2, rv3;
#define HG_LOAD(T0)                                                                                \
  {                                                                                                \
    const bf16_t* zb = Z + (size_t)((T0) + (tid >> 7)) * ZS + qcol;                                \
    rq0 = zb[0]; rf0 = zb[512]; zb += 2 * ZS; rq1 = zb[0]; rf1 = zb[512]; zb += 2 * ZS;            \
    rq2 = zb[0]; rf2 = zb[512]; zb += 2 * ZS; rq3 = zb[0]; rf3 = zb[512]; zb += 2 * ZS;            \
    rq4 = zb[0]; rf4 = zb[512]; zb += 2 * ZS; rq5 = zb[0]; rf5 = zb[512]; zb += 2 * ZS;            \
    rq6 = zb[0]; rf6 = zb[512]; zb += 2 * ZS; rq7 = zb[0]; rf7 = zb[512];                          \
    const bf16_t* zv = Z + (size_t)((T0) + w) * ZS + vcol + lane;                                  \
    rv0 = zv[0]; rv1 = zv[4 * ZS]; rv2 = zv[8 * ZS]; rv3 = zv[12 * ZS];                            \
  }
#define HG_PUT1(I, RQ, RF)                                                                         \
  {                                                                                                \
    int t = (tid >> 7) + 2 * (I);                                                                  \
    sFg[t * 128 + ks] = fmaxf(lb + (1.f - lb) * fsigmoid(bf2f(RF)), 1e-30f);                       \
    sQs[t * 128 + ks] = fsilu(bf2f(RQ));                                                           \
  }
#define HG_PROCESS()                                                                               \
  {                                                                                                \
    HG_PUT1(0, rq0, rf0) HG_PUT1(1, rq1, rf1) HG_PUT1(2, rq2, rf2) HG_PUT1(3, rq3, rf3)            \
    HG_PUT1(4, rq4, rf4) HG_PUT1(5, rq5, rf5) HG_PUT1(6, rq6, rf6) HG_PUT1(7, rq7, rf7)            \
    sVv[(w)*64 + lane] = bf2f(rv0); sVv[(w + 4) * 64 + lane] = bf2f(rv1);                          \
    sVv[(w + 8) * 64 + lane] = bf2f(rv2); sVv[(w + 12) * 64 + lane] = bf2f(rv3);                   \
  }
  HG_LOAD(0);
  HG_PROCESS();
  __syncthreads();
  constexpr int NCH = SEQ / 16;
#pragma unroll 1
  for (int c = 0; c < NCH; ++c) {
    const int t0 = c * 16;
    const int tn = (c + 1 < NCH) ? t0 + 16 : t0;
    HG_LOAD(tn);
    __builtin_amdgcn_sched_barrier(0);
#pragma unroll 2
    for (int t = 0; t < 16; ++t) {
      const float v = sVv[t * 64 + lane];
      const float opv = (lane < 32) ? sFg[t * 128 + w * 32 + lane] : sQs[t * 128 + w * 32 + (lane - 32)];
      const int opi = __builtin_bit_cast(int, opv);
      float o = 0.f;
#pragma unroll
      for (int j = 0; j < 32; ++j) {
        const float fg = __builtin_bit_cast(float, __builtin_amdgcn_readlane(opi, j));
        const float qq = __builtin_bit_cast(float, __builtin_amdgcn_readlane(opi, 32 + j));
        const float kv = fmaf(-fg, v, v);
        s[j] = fmaf(s[j], fg, kv);
        o = fmaf(qq, s[j], o);
      }
      sO[(w * 16 + t) * 64 + lane] = o;
    }
    __builtin_amdgcn_sched_barrier(0);
    __syncthreads();
    {
      int t = tid >> 4, v4 = (tid & 15) * 4;
      float4 a = *reinterpret_cast<const float4*>(sO + (0 * 16 + t) * 64 + v4);
      float4 bq = *reinterpret_cast<const float4*>(sO + (1 * 16 + t) * 64 + v4);
      float4 cq = *reinterpret_cast<const float4*>(sO + (2 * 16 + t) * 64 + v4);
      float4 d = *reinterpret_cast<const float4*>(sO + (3 * 16 + t) * 64 + v4);
      uint2 o;
      o.x = pack2(a.x + bq.x + cq.x + d.x, a.y + bq.y + cq.y + d.y);
      o.y = pack2(a.z + bq.z + cq.z + d.z, a.w + bq.w + cq.w + d.w);
      *reinterpret_cast<uint2*>(Z + (size_t)(t0 + t) * ZS + vcol + v4) = o;
    }
    HG_PROCESS();
    __syncthreads();
  }
#undef HG_LOAD
#undef HG_PUT1
#undef HG_PROCESS
}

__device__ void mb_scan(const Params& p, int l, int task, char* smem) {
  const int b = task >> 3, hd = task & 7, g = hd >> 2;
  float* sB = reinterpret_cast<float*>(smem);
  float* sC = sB + 16 * 128;
  float* sX = sC + 16 * 128;
  float* sDt = sX + 16 * 64;
  float* sDA = sDt + 16;
  float* sO = sDA + 16;
  const int tid = opaque_tid(), w = tid >> 6, lane = tid & 63;
  bf16_t* Z = (bf16_t*)(p.ws + OFF_Z) + (size_t)b * SEQ * ZS;
  const float* cw = p.in[I_MB_CONVW] + (size_t)l * 4 * 1024;
  const float* cb = p.in[I_MB_CONVB] + (size_t)l * 1024;
  int ci0, ci1;
  {
    int ch = tid;
    ci0 = (ch < 64) ? hd * 64 + ch : (ch < 192 ? 512 + g * 128 + (ch - 64) : 768 + g * 128 + (ch - 192));
    ci1 = 768 + g * 128 + 64 + (tid & 63);
  }
  float* dstA = (tid < 64) ? (sX + tid) : (tid < 192 ? (sB + (tid - 64)) : (sC + (tid - 192)));
  const int strideA = (tid < 64) ? 64 : 128;
  const float w0a = cw[ci0], w1a = cw[1024 + ci0], w2a = cw[2048 + ci0], w3a = cw[3072 + ci0], ba = cb[ci0];
  const float w0b = cw[ci1], w1b = cw[1024 + ci1], w2b = cw[2048 + ci1], w3b = cw[3072 + ci1], bb = cb[ci1];
  const float Aneg = -expf(p.in[I_MB_ALOG][l * 8 + hd]);
  const float dtb = p.in[I_MB_DTB][l * 8 + hd];
  const float Dsk = p.in[I_MB_D][l * 8 + hd];
  float s[32];
#pragma unroll
  for (int j = 0; j < 32; ++j) s[j] = 0.f;
  float pa1 = 0.f, pa2 = 0.f, pa3 = 0.f, pb1 = 0.f, pb2 = 0.f, pb3 = 0.f;
  const int xcol = ZMB + 512;
  const int rt = tid >> 4, rp4 = (tid & 15) * 4;
  bf16_t xa0, xa1, xa2, xa3, xa4, xa5, xa6, xa7, xa8, xa9, xa10, xa11, xa12, xa13, xa14, xa15;
  bf16_t xb0, xb1, xb2, xb3, xb4, xb5, xb6, xb7, xb8, xb9, xb10, xb11, xb12, xb13, xb14, xb15;
  bf16_t rdt;
  uint2 gcur, gnext;
#define MB_LOAD(T0)                                                                                 \
  {                                                                                                 \
    const bf16_t* za = Z + (size_t)(T0) * ZS + xcol + ci0;                                          \
    xa0 = za[0]; xa1 = za[ZS]; xa2 = za[2 * ZS]; xa3 = za[3 * ZS]; xa4 = za[4 * ZS]; xa5 = za[5 * ZS];        \
    xa6 = za[6 * ZS]; xa7 = za[7 * ZS]; xa8 = za[8 * ZS]; xa9 = za[9 * ZS]; xa10 = za[10 * ZS];     \
    xa11 = za[11 * ZS]; xa12 = za[12 * ZS]; xa13 = za[13 * ZS]; xa14 = za[14 * ZS]; xa15 = za[15 * ZS];       \
    if (tid < 64) {                                                                                 \
      const bf16_t* zb = Z + (size_t)(T0) * ZS + xcol + ci1;                                        \
      xb0 = zb[0]; xb1 = zb[ZS]; xb2 = zb[2 * ZS]; xb3 = zb[3 * ZS]; xb4 = zb[4 * ZS]; xb5 = zb[5 * ZS];      \
      xb6 = zb[6 * ZS]; xb7 = zb[7 * ZS]; xb8 = zb[8 * ZS]; xb9 = zb[9 * ZS]; xb10 = zb[10 * ZS];   \
      xb11 = zb[11 * ZS]; xb12 = zb[12 * ZS]; xb13 = zb[13 * ZS]; xb14 = zb[14 * ZS]; xb15 = zb[15 * ZS];     \
    }                                                                                               \
    rdt = Z[(size_t)((T0) + (tid & 15)) * ZS + ZMB + 1536 + hd];                                    \
    gnext = *reinterpret_cast<const uint2*>(Z + (size_t)((T0) + rt) * ZS + ZMB + hd * 64 + rp4);    \
  }
#define MB_CONV_A(T, XR)                                                                            \
  {                                                                                                 \
    float xv = bf2f(XR);                                                                            \
    dstA[(T)*strideA] = fsilu(ba + w0a * pa3 + w1a * pa2 + w2a * pa1 + w3a * xv);                   \
    pa3 = pa2; pa2 = pa1; pa1 = xv;                                                                 \
  }
#define MB_CONV_B(T, XR)                                                                            \
  {                                                                                                 \
    float xv = bf2f(XR);                                                                            \
    sC[(T)*128 + 64 + tid] = fsilu(bb + w0b * pb3 + w1b * pb2 + w2b * pb1 + w3b * xv);              \
    pb3 = pb2; pb2 = pb1; pb1 = xv;                                                                 \
  }
#define MB_PROCESS()                                                                                \
  {                                                                                                 \
    MB_CONV_A(0, xa0) MB_CONV_A(1, xa1) MB_CONV_A(2, xa2) MB_CONV_A(3, xa3) MB_CONV_A(4, xa4)       \
    MB_CONV_A(5, xa5) MB_CONV_A(6, xa6) MB_CONV_A(7, xa7) MB_CONV_A(8, xa8) MB_CONV_A(9, xa9)       \
    MB_CONV_A(10, xa10) MB_CONV_A(11, xa11) MB_CONV_A(12, xa12) MB_CONV_A(13, xa13)                 \
    MB_CONV_A(14, xa14) MB_CONV_A(15, xa15)                                                         \
    if (tid < 64) {                                                                                 \
      MB_CONV_B(0, xb0) MB_CONV_B(1, xb1) MB_CONV_B(2, xb2) MB_CONV_B(3, xb3) MB_CONV_B(4, xb4)     \
      MB_CONV_B(5, xb5) MB_CONV_B(6, xb6) MB_CONV_B(7, xb7) MB_CONV_B(8, xb8) MB_CONV_B(9, xb9)     \
      MB_CONV_B(10, xb10) MB_CONV_B(11, xb11) MB_CONV_B(12, xb12) MB_CONV_B(13, xb13)               \
      MB_CONV_B(14, xb14) MB_CONV_B(15, xb15)                                                       \
    }                                                                                               \
    if (tid < 16) {                                                                                 \
      float dt = fsoftplus(bf2f(rdt) + dtb);                                                        \
      sDt[tid] = dt;                                                                                \
      sDA[tid] = __expf(Aneg * dt);                                                                 \
    }                                                                                               \
    gcur = gnext;                                                                                   \
  }
  MB_LOAD(0);
  MB_PROCESS();
  __syncthreads();
  constexpr int NCH = SEQ / 16;
#pragma unroll 1
  for (int c = 0; c < NCH; ++c) {
    const int t0 = c * 16;
    const bool more = (c + 1 < NCH);
    const int tn = more ? t0 + 16 : t0;
    MB_LOAD(tn);
    __builtin_amdgcn_sched_barrier(0);
#pragma unroll 2
    for (int t = 0; t < 16; ++t) {
      const float dA = sDA[t];
      const float xdt = sX[t * 64 + lane] * sDt[t];
      const float opv = (lane < 32) ? sB[t * 128 + w * 32 + lane] : sC[t * 128 + w * 32 + (lane - 32)];
      const int opi = __builtin_bit_cast(int, opv);
      float y = 0.f;
#pragma unroll
      for (int j = 0; j < 32; ++j) {
        const float bn = __builtin_bit_cast(float, __builtin_amdgcn_readlane(opi, j));
        const float cn = __builtin_bit_cast(float, __builtin_amdgcn_readlane(opi, 32 + j));
        s[j] = fmaf(s[j], dA, bn * xdt);
        y = fmaf(cn, s[j], y);
      }
      sO[(w * 16 + t) * 64 + lane] = y;
    }
    __builtin_amdgcn_sched_barrier(0);
    __syncthreads();
    {
      float4 a = *reinterpret_cast<const float4*>(sO + (0 * 16 + rt) * 64 + rp4);
      float4 bq = *reinterpret_cast<const float4*>(sO + (1 * 16 + rt) * 64 + rp4);
      float4 cq = *reinterpret_cast<const float4*>(sO + (2 * 16 + rt) * 64 + rp4);
      float4 d = *reinterpret_cast<const float4*>(sO + (3 * 16 + rt) * 64 + rp4);
      float4 xs = *reinterpret_cast<const float4*>(sX + rt * 64 + rp4);
      bf16_t* gp = Z + (size_t)(t0 + rt) * ZS + ZMB + hd * 64 + rp4;
      float g0 = bf2f((bf16_t)(gcur.x & 0xffff)), g1 = bf2f((bf16_t)(gcur.x >> 16));
      float g2 = bf2f((bf16_t)(gcur.y & 0xffff)), g3 = bf2f((bf16_t)(gcur.y >> 16));
      float y0 = a.x + bq.x + cq.x + d.x + Dsk * xs.x;
      float y1 = a.y + bq.y + cq.y + d.y + Dsk * xs.y;
      float y2 = a.z + bq.z + cq.z + d.z + Dsk * xs.z;
      float y3 = a.w + bq.w + cq.w + d.w + Dsk * xs.w;
      uint2 o;
      o.x = pack2(y0 * fsilu(g0), y1 * fsilu(g1));
      o.y = pack2(y2 * fsilu(g2), y3 * fsilu(g3));
      *reinterpret_cast<uint2*>(gp) = o;
    }
    __syncthreads();
    if (more) MB_PROCESS();
    __syncthreads();
  }
#undef MB_LOAD
#undef MB_CONV_A
#undef MB_CONV_B
#undef MB_PROCESS
}

__device__ void s5_scan(const Params& p, int l, int task, char* smem) {
  const int tid = opaque_tid(), w = tid >> 6, lane = tid & 63;
  const int b = task >> 3, g = (task & 7) * 4 + w;
  char* base = smem + w * 6144;
  float* sU = reinterpret_cast<float*>(base);
  char* sHb = base + 1024;
  bf16_t* Z = (bf16_t*)(p.ws + OFF_Z) + (size_t)b * SEQ * ZS + ZS5 + g * 16;
  const int n = lane;
  float lr, li, bbr[16], bbi[16];
  bf16x8 Bf0, Bf1, Bf2, Bf3;
  {
    float dt = expf(p.in[I_S5_LOGDT][l * 32 + g]);
    float are = p.in[I_S5_ARE][(l * 32 + g) * 64 + n], aim = p.in[I_S5_AIM][(l * 32 + g) * 64 + n];
    float mag = expf(dt * are);
    lr = mag * cosf(dt * aim); li = mag * sinf(dt * aim);
    float den = are * are + aim * aim;
    float cr = ((lr - 1.f) * are + li * aim) / den;
    float ci = (li * are - (lr - 1.f) * aim) / den;
    const float* bre = p.in[I_S5_BRE] + ((size_t)(l * 32 + g) * 64 + n) * 16;
    const float* bim = p.in[I_S5_BIM] + ((size_t)(l * 32 + g) * 64 + n) * 16;
#pragma unroll
    for (int c = 0; c < 16; ++c) {
      float br = bre[c], bi = bim[c];
      bbr[c] = cr * br - ci * bi;
      bbi[c] = cr * bi + ci * br;
    }
    const float* cre = p.in[I_S5_CRE] + (size_t)(l * 32 + g) * 16 * 64 + (lane & 15) * 64;
    const float* cim = p.in[I_S5_CIM] + (size_t)(l * 32 + g) * 16 * 64 + (lane & 15) * 64;
#pragma unroll
    for (int j = 0; j < 8; ++j) {
      const int kb = 8 * (lane >> 4) + j;
      const int n0 = kb >> 1;
      const bool im = (j & 1);
      Bf0[j] = (short)f2bf(im ? -cim[n0] : cre[n0]);
      Bf1[j] = (short)f2bf(im ? -cim[n0 + 16] : cre[n0 + 16]);
      Bf2[j] = (short)f2bf(im ? -cim[n0 + 32] : cre[n0 + 32]);
      Bf3[j] = (short)f2bf(im ? -cim[n0 + 48] : cre[n0 + 48]);
    }
  }
  const float dsk = p.in[I_S5_D][l * 512 + g * 16 + (lane & 15)];
  const int pt = lane >> 2, pc4 = (lane & 3) * 4;
  float hr = 0.f, hi = 0.f;
  uint2 unext = *reinterpret_cast<const uint2*>(Z + (size_t)pt * ZS + pc4);
  constexpr int NCH = SEQ / 16;
#pragma unroll 1
  for (int c = 0; c < NCH; ++c) {
    const int t0 = c * 16;
    {
      const uint2 ur = unext;
      *reinterpret_cast<float4*>(sU + pt * 16 + pc4) =
          float4{bf2f((bf16_t)(ur.x & 0xffff)), bf2f((bf16_t)(ur.x >> 16)), bf2f((bf16_t)(ur.y & 0xffff)), bf2f((bf16_t)(ur.y >> 16))};
      const int tn = (c + 1 < NCH) ? t0 + 16 : t0;
      unext = *reinterpret_cast<const uint2*>(Z + (size_t)(tn + pt) * ZS + pc4);
    }
    __builtin_amdgcn_sched_barrier(0);
    __syncthreads();
#pragma unroll 2
    for (int t = 0; t < 16; ++t) {
      const float4* u4 = reinterpret_cast<const float4*>(sU + t * 16);
      float bur = 0.f, bui = 0.f;
#pragma unroll
      for (int q = 0; q < 4; ++q) {
        float4 u = u4[q];
        bur = fmaf(bbr[q * 4 + 0], u.x, bur); bui = fmaf(bbi[q * 4 + 0], u.x, bui);
        bur = fmaf(bbr[q * 4 + 1], u.y, bur); bui = fmaf(bbi[q * 4 + 1], u.y, bui);
        bur = fmaf(bbr[q * 4 + 2], u.z, bur); bui = fmaf(bbi[q * 4 + 2], u.z, bui);
        bur = fmaf(bbr[q * 4 + 3], u.w, bur); bui = fmaf(bbi[q * 4 + 3], u.w, bui);
      }
      float nr = lr * hr - li * hi + bur;
      float ni = lr * hi + li * hr + bui;
      hr = nr; hi = ni;
      *reinterpret_cast<unsigned*>(sHb + t * 272 + n * 4) = pack2(hr, hi);
    }
    __syncthreads();
    {
      f32x4 acc = f32x4{0.f, 0.f, 0.f, 0.f};
      const char* ap = sHb + (lane & 15) * 272 + (lane >> 4) * 16;
      acc = __builtin_amdgcn_mfma_f32_16x16x32_bf16(*reinterpret_cast<const bf16x8*>(ap), Bf0, acc, 0, 0, 0);
      acc = __builtin_amdgcn_mfma_f32_16x16x32_bf16(*reinterpret_cast<const bf16x8*>(ap + 64), Bf1, acc, 0, 0, 0);
      acc = __builtin_amdgcn_mfma_f32_16x16x32_bf16(*reinterpret_cast<const bf16x8*>(ap + 128), Bf2, acc, 0, 0, 0);
      acc = __builtin_amdgcn_mfma_f32_16x16x32_bf16(*reinterpret_cast<const bf16x8*>(ap + 192), Bf3, acc, 0, 0, 0);
      const int cc = lane & 15, tb = (lane >> 4) * 4;
#pragma unroll
      for (int jj = 0; jj < 4; ++jj) {
        float y = acc[jj] + dsk * sU[(tb + jj) * 16 + cc];
        Z[(size_t)(t0 + tb + jj) * ZS + cc] = f2bf(fgelu(y));
      }
    }
    __syncthreads();
  }
}

__device__ void rw_scan(const Params& p, int l, int task, char* smem) {
  const int b = task >> 3, h = task & 7;
  float* sR = reinterpret_cast<float*>(smem);
  float* sW = sR + 1024;
  float* sK = sW + 1024;
  float* sA = sK + 1024;
  float* sBb = sA + 1024;
  float* sV = sBb + 1024;
  float* sY = sV + 1024;
  float* sBonus = sY + 1024;
  const int tid = opaque_tid(), w = tid >> 6, lane = tid & 63;
  const size_t tokbase = (size_t)b * SEQ;
  bf16_t* Z = (bf16_t*)(p.ws + OFF_Z) + tokbase * ZS;
  const bf16_t* LW = (const bf16_t*)(p.ws + OFF_U) + tokbase * 512;
  const bf16_t* LA = LW + (size_t)T_TOK * 512;
  const bf16_t* VF = (const bf16_t*)(p.ws + OFF_VF) + tokbase * 512;
  const int st = tid >> 4, c4 = (tid & 15) * 4, ch = h * 64 + c4;
  float mur[4], muk[4], w0[4], a0[4], kk_[4], ka_[4], rk_[4], lnw[4], lnb[4];
#pragma unroll
  for (int e = 0; e < 4; ++e) {
    mur[e] = p.in[I_RW_MU][l * 1792 + ch + e];
    muk[e] = p.in[I_RW_MU][l * 1792 + 512 + ch + e];
    w0[e] = p.in[I_RW_W0][l * 512 + ch + e];
    a0[e] = p.in[I_RW_A0][l * 512 + ch + e];
    kk_[e] = p.in[I_RW_KK][l * 512 + ch + e];
    ka_[e] = p.in[I_RW_KA][l * 512 + ch + e];
    rk_[e] = p.in[I_RW_RK][l * 512 + ch + e];
    lnw[e] = p.in[I_RW_LNW][l * 512 + ch + e];
    lnb[e] = p.in[I_RW_LNB][l * 512 + ch + e];
  }
  const int rg = lane >> 3, kq = lane & 7, vrow = w * 16 + rg * 2;
  float S0[8], S1[8];
#pragma unroll
  for (int j = 0; j < 8; ++j) { S0[j] = 0.f; S1[j] = 0.f; }
  uint2 rc, kc, rp, kp, lwv, lav, vfv;
#define RW_LOAD(T0)                                                                                 \
  {                                                                                                 \
    const int s_ = (T0) + st;                                                                       \
    const bf16_t* zr = Z + (size_t)s_ * ZS + ZRW + ch;                                              \
    rc = *reinterpret_cast<const uint2*>(zr);                                                       \
    kc = *reinterpret_cast<const uint2*>(zr + 512);                                                 \
    rp = uint2{0u, 0u}; kp = uint2{0u, 0u};                                                         \
    if (s_ > 0) { rp = *reinterpret_cast<const uint2*>(zr - ZS); kp = *reinterpret_cast<const uint2*>(zr - ZS + 512); } \
    lwv = *reinterpret_cast<const uint2*>(LW + (size_t)s_ * 512 + ch);                              \
    lav = *reinterpret_cast<const uint2*>(LA + (size_t)s_ * 512 + ch);                              \
    vfv = *reinterpret_cast<const uint2*>(VF + (size_t)s_ * 512 + ch);                              \
  }
#define RW_PROCESS()                                                                                \
  {                                                                                                 \
    float r4[4], k4[4], kkv[4], av[4], wv[4], vv[4];                                                \
    float n2 = 0.f;                                                                                 \
    _Pragma("unroll") for (int e = 0; e < 4; ++e) {                                                 \
      unsigned rcw = (e < 2) ? rc.x : rc.y, kcw = (e < 2) ? kc.x : kc.y, rpw = (e < 2) ? rp.x : rp.y, kpw = (e < 2) ? kp.x : kp.y; \
      unsigned lww = (e < 2) ? lwv.x : lwv.y, law = (e < 2) ? lav.x : lav.y, vfw = (e < 2) ? vfv.x : vfv.y; \
      int sh = (e & 1) * 16;                                                                        \
      float rcur = bf2f((bf16_t)((rcw >> sh) & 0xffff)), rprev = bf2f((bf16_t)((rpw >> sh) & 0xffff)); \
      float kcur = bf2f((bf16_t)((kcw >> sh) & 0xffff)), kprev = bf2f((bf16_t)((kpw >> sh) & 0xffff)); \
      float lwf = bf2f((bf16_t)((lww >> sh) & 0xffff)), laf = bf2f((bf16_t)((law >> sh) & 0xffff)); \
      vv[e] = bf2f((bf16_t)((vfw >> sh) & 0xffff));                                                 \
      r4[e] = rcur + (rprev - rcur) * mur[e];                                                       \
      k4[e] = kcur + (kprev - kcur) * muk[e];                                                       \
      float wlog = -fsoftplus(-(w0[e] + lwf)) - 0.5f;                                               \
      wv[e] = __expf(-__expf(wlog));                                                                \
      av[e] = fsigmoid(a0[e] + laf);                                                                \
      kkv[e] = k4[e] * kk_[e];                                                                      \
      n2 += kkv[e] * kkv[e];                                                                        \
    }                                                                                               \
    n2 = sum16(n2);                                                                                 \
    float inv = 1.f / fmaxf(sqrtf(n2), 1e-12f);                                                     \
    float bon = 0.f;                                                                                \
    float kt4[4], ap4[4], bp4[4];                                                                   \
    _Pragma("unroll") for (int e = 0; e < 4; ++e) {                                                 \
      float kkn = kkv[e] * inv;                                                                     \
      kt4[e] = k4[e] * (1.f + (av[e] - 1.f) * ka_[e]);                                              \
      ap4[e] = -kkn;                                                                                \
      bp4[e] = kkn * av[e];                                                                         \
      bon += r4[e] * kt4[e] * rk_[e];                                                               \
    }                                                                                               \
    bon = sum16(bon);                                                                               \
    *reinterpret_cast<float4*>(sR + st * 64 + c4) = float4{r4[0], r4[1], r4[2], r4[3]};             \
    *reinterpret_cast<float4*>(sW + st * 64 + c4) = float4{wv[0], wv[1], wv[2], wv[3]};             \
    *reinterpret_cast<float4*>(sK + st * 64 + c4) = float4{kt4[0], kt4[1], kt4[2], kt4[3]};         \
    *reinterpret_cast<float4*>(sA + st * 64 + c4) = float4{ap4[0], ap4[1], ap4[2], ap4[3]};         \
    *reinterpret_cast<float4*>(sBb + st * 64 + c4) = float4{bp4[0], bp4[1], bp4[2], bp4[3]};        \
    *reinterpret_cast<float4*>(sV + st * 64 + c4) = float4{vv[0], vv[1], vv[2], vv[3]};             \
    if ((tid & 15) == 0) sBonus[st] = bon;                                                          \
  }
  RW_LOAD(0);
  RW_PROCESS();
  __syncthreads();
  constexpr int NCH = SEQ / 16;
#pragma unroll 1
  for (int c = 0; c < NCH; ++c) {
    const int t0 = c * 16;
    const int tn = (c + 1 < NCH) ? t0 + 16 : t0;
    RW_LOAD(tn);
    __builtin_amdgcn_sched_barrier(0);
#pragma unroll 2
    for (int t = 0; t < 16; ++t) {
      const float4* a4p = reinterpret_cast<const float4*>(sA + t * 64 + kq * 8);
      const float4* w4p = reinterpret_cast<const float4*>(sW + t * 64 + kq * 8);
      const float4* b4p = reinterpret_cast<const float4*>(sBb + t * 64 + kq * 8);
      const float4* k4p = reinterpret_cast<const float4*>(sK + t * 64 + kq * 8);
      const float4* r4p = reinterpret_cast<const float4*>(sR + t * 64 + kq * 8);
      const float2 vv = *reinterpret_cast<const float2*>(sV + t * 64 + vrow);
      float sa0 = 0.f, sa1 = 0.f;
#pragma unroll
      for (int q = 0; q < 2; ++q) {
        float4 a = a4p[q];
        sa0 = fmaf(S0[q * 4 + 0], a.x, sa0); sa1 = fmaf(S1[q * 4 + 0], a.x, sa1);
        sa0 = fmaf(S0[q * 4 + 1], a.y, sa0); sa1 = fmaf(S1[q * 4 + 1], a.y, sa1);
        sa0 = fmaf(S0[q * 4 + 2], a.z, sa0); sa1 = fmaf(S1[q * 4 + 2], a.z, sa1);
        sa0 = fmaf(S0[q * 4 + 3], a.w, sa0); sa1 = fmaf(S1[q * 4 + 3], a.w, sa1);
      }
      sa0 = oct_sum(sa0); sa1 = oct_sum(sa1);
      float y0 = 0.f, y1 = 0.f;
#pragma unroll
      for (int q = 0; q < 2; ++q) {
        float4 ww = w4p[q], bb = b4p[q], kk = k4p[q], rr = r4p[q];
        S0[q * 4 + 0] = fmaf(S0[q * 4 + 0], ww.x, fmaf(sa0, bb.x, vv.x * kk.x)); y0 = fmaf(S0[q * 4 + 0], rr.x, y0);
        S1[q * 4 + 0] = fmaf(S1[q * 4 + 0], ww.x, fmaf(sa1, bb.x, vv.y * kk.x)); y1 = fmaf(S1[q * 4 + 0], rr.x, y1);
        S0[q * 4 + 1] = fmaf(S0[q * 4 + 1], ww.y, fmaf(sa0, bb.y, vv.x * kk.y)); y0 = fmaf(S0[q * 4 + 1], rr.y, y0);
        S1[q * 4 + 1] = fmaf(S1[q * 4 + 1], ww.y, fmaf(sa1, bb.y, vv.y * kk.y)); y1 = fmaf(S1[q * 4 + 1], rr.y, y1);
        S0[q * 4 + 2] = fmaf(S0[q * 4 + 2], ww.z, fmaf(sa0, bb.z, vv.x * kk.z)); y0 = fmaf(S0[q * 4 + 2], rr.z, y0);
        S1[q * 4 + 2] = fmaf(S1[q * 4 + 2], ww.z, fmaf(sa1, bb.z, vv.y * kk.z)); y1 = fmaf(S1[q * 4 + 2], rr.z, y1);
        S0[q * 4 + 3] = fmaf(S0[q * 4 + 3], ww.w, fmaf(sa0, bb.w, vv.x * kk.w)); y0 = fmaf(S0[q * 4 + 3], rr.w, y0);
        S1[q * 4 + 3] = fmaf(S1[q * 4 + 3], ww.w, fmaf(sa1, bb.w, vv.y * kk.w)); y1 = fmaf(S1[q * 4 + 3], rr.w, y1);
      }
      y0 = oct_sum(y0); y1 = oct_sum(y1);
      if (kq == 0) *reinterpret_cast<float2*>(sY + t * 64 + vrow) = float2{y0, y1};
    }
    __builtin_amdgcn_sched_barrier(0);
    __syncthreads();
    {
      float4 y4 = *reinterpret_cast<const float4*>(sY + st * 64 + c4);
      float4 v4 = *reinterpret_cast<const float4*>(sV + st * 64 + c4);
      float bon = sBonus[st];
      float mean = sum16(y4.x + y4.y + y4.z + y4.w) * (1.f / 64.f);
      float dx = y4.x - mean, dy = y4.y - mean, dz = y4.z - mean, dw = y4.w - mean;
      float var = sum16(dx * dx + dy * dy + dz * dz + dw * dw) * (1.f / 64.f);
      float rs = rsqrtf(var + 64e-5f);
      float o0 = dx * rs * lnw[0] + lnb[0] + bon * v4.x;
      float o1 = dy * rs * lnw[1] + lnb[1] + bon * v4.y;
      float o2 = dz * rs * lnw[2] + lnb[2] + bon * v4.z;
      float o3 = dw * rs * lnw[3] + lnb[3] + bon * v4.w;
      uint2 o;
      o.x = pack2(o0, o1); o.y = pack2(o2, o3);
      *reinterpret_cast<uint2*>(Z + (size_t)(t0 + st) * ZS + ZRW + 1024 + ch) = o;
    }
    RW_PROCESS();
    __syncthreads();
  }
#undef RW_LOAD
#undef RW_PROCESS
}

__device__ void phase_scans(const Params& p, int l, char* smem, int scan_mask = 15) {
  for (int t = blockIdx.x; t < 256; t += gridDim.x) {
    int type = t & 3, idx = t >> 2;
    if (!((scan_mask >> type) & 1)) continue;
#ifndef SCM
#define SCM 15
#endif
    if (type == 0) { if (SCM & 1) rw_scan(p, l, idx, smem); }
    else if (type == 1) { if (SCM & 2) hg_scan(p, l, idx, smem); }
    else if (type == 2) { if (SCM & 4) mb_scan(p, l, idx, smem); }
    else { if (SCM & 8) s5_scan(p, l, idx, smem); }
    __syncthreads();
  }
}

__device__ __forceinline__ void unpack8(const uint4& v, float (&f)[8]) {
  f[0] = bf2f((bf16_t)(v.x & 0xffff)); f[1] = bf2f((bf16_t)(v.x >> 16));
  f[2] = bf2f((bf16_t)(v.y & 0xffff)); f[3] = bf2f((bf16_t)(v.y >> 16));
  f[4] = bf2f((bf16_t)(v.z & 0xffff)); f[5] = bf2f((bf16_t)(v.z >> 16));
  f[6] = bf2f((bf16_t)(v.w & 0xffff)); f[7] = bf2f((bf16_t)(v.w >> 16));
}

__device__ void phase_post(const Params& p, int l, char* smem) {
  bf16_t* Z = (bf16_t*)(p.ws + OFF_Z);
  const int tid = opaque_tid(), lane = tid & 63, wid = tid >> 6;
  constexpr int N_ROWT = T_TOK / 4, N_RWT = T_TOK / 16, N_GLU = 128 * 4, N_NORM = T_TOK / 4;
  const float* xsrc = (l == 0) ? p.in[I_X] : p.out;
  for (int t = blockIdx.x; t < N_ROWT + N_RWT + N_GLU + N_NORM; t += gridDim.x) {
    if (t < N_ROWT) {
      const int row = t * 4 + wid;
      {
        bf16_t* op = Z + (size_t)row * ZS + ZHG + 1024 + lane * 8;
        uint4 ov = *reinterpret_cast<const uint4*>(op);
        uint4 gv = *reinterpret_cast<const uint4*>(op + 512);
        float o[8], g[8];
        unpack8(ov, o); unpack8(gv, g);
        float ss = 0.f;
#pragma unroll
        for (int e = 0; e < 8; ++e) ss += o[e] * o[e];
        ss = sum16(ss);
        float rstd = rsqrtf(ss * (1.f / 128.f) + 1e-6f);
        const float* nw = p.in[I_HG_NW] + l * 512 + lane * 8;
        float r[8];
#pragma unroll
        for (int e = 0; e < 8; ++e) r[e] = o[e] * rstd * nw[e] * siluf_(g[e]);
        *reinterpret_cast<uint4*>(op) = uint4{pack2(r[0], r[1]), pack2(r[2], r[3]), pack2(r[4], r[5]), pack2(r[6], r[7])};
      }
      {
        bf16_t* op = Z + (size_t)row * ZS + ZMB + lane * 8;
        uint4 ov = *reinterpret_cast<const uint4*>(op);
        float o[8];
        unpack8(ov, o);
        float ss = 0.f;
#pragma unroll
        for (int e = 0; e < 8; ++e) ss += o[e] * o[e];
        ss = sum64(ss);
        float rstd = rsqrtf(ss * (1.f / 512.f) + 1e-6f);
        const float* nw = p.in[I_MB_NW] + l * 512 + lane * 8;
        float r[8];
#pragma unroll
        for (int e = 0; e < 8; ++e) r[e] = o[e] * rstd * nw[e];
        *reinterpret_cast<uint4*>(op) = uint4{pack2(r[0], r[1]), pack2(r[2], r[3]), pack2(r[4], r[5]), pack2(r[6], r[7])};
      }
    } else if (t < N_ROWT + N_RWT) {
      const int row0 = (t - N_ROWT) * 16;
      float* sXg = reinterpret_cast<float*>(smem);
      const float* mu = p.in[I_RW_MU] + l * 1792 + 1664;
      for (int e = tid; e < 2048; e += 256) {
        int j = e >> 4, tok = e & 15;
        int row = row0 + tok, s = row & (SEQ - 1);
        sXg[j * 16 + tok] = sigmoidf_(rw_shift(Z, row, s, 1664 + j, mu[j]));
      }
      __syncthreads();
      float a0[16], a1[16];
      lora_mm<128>(sXg, p.in[I_RW_G2] + (size_t)l * 128 * 512, a0, a1, tid);
#pragma unroll
      for (int tok = 0; tok < 16; ++tok) {
        bf16_t* yp = Z + (size_t)(row0 + tok) * ZS + ZRW + 1024 + tid;
        yp[0] = f2bf(bf2f(yp[0]) * a0[tok]);
        yp[256] = f2bf(bf2f(yp[256]) * a1[tok]);
      }
      __syncthreads();
    } else if (t < N_ROWT + N_RWT + N_GLU) {
      const int tt = t - N_ROWT - N_RWT, mt = tt >> 2, nt = tt & 3;
      const int wm = wid >> 1, wn = wid & 1;
      f32x4 acc[4][4];
      zero_acc<128>(acc);
      gemm_mainloop<128>(acc, Z + ZS5, ZS, mt * 128, (const bf16_t*)(p.ws + OFF_WTGLU), 512, nt * 128, 511, 512, smem, tid);
      const float* bg = p.in[I_S5_BGLU] + l * 512;
#pragma unroll
      for (int mi = 0; mi < 4; ++mi)
#pragma unroll
        for (int ni = 0; ni < 4; ++ni) {
          int col = nt * 128 + wn * 64 + ni * 16 + (lane >> 4) * 4;
          int row = mt * 128 + wm * 64 + mi * 16 + (lane & 15);
          float4 b4 = *reinterpret_cast<const float4*>(bg + col);
          uint2 yv = *reinterpret_cast<const uint2*>(Z + (size_t)row * ZS + ZS5 + col);
          float y0 = bf2f((bf16_t)(yv.x & 0xffff)), y1 = bf2f((bf16_t)(yv.x >> 16));
          float y2 = bf2f((bf16_t)(yv.y & 0xffff)), y3 = bf2f((bf16_t)(yv.y >> 16));
          uint2 o;
          o.x = pack2(y0 * sigmoidf_(acc[mi][ni][0] + b4.x), y1 * sigmoidf_(acc[mi][ni][1] + b4.y));
          o.y = pack2(y2 * sigmoidf_(acc[mi][ni][2] + b4.z), y3 * sigmoidf_(acc[mi][ni][3] + b4.w));
          *reinterpret_cast<uint2*>(Z + (size_t)row * ZS + ZMB + 1024 + col) = o;
        }
    } else {
      const int row = (t - N_ROWT - N_RWT - N_GLU) * 4 + wid;
      rmsnorm_row_to_bf16(xsrc + (size_t)row * DM, p.in[I_NORM_MIX] + l * DM, (bf16_t*)(p.ws + OFF_U) + (size_t)row * DM, tid & 63);
    }
  }
}

__device__ void phase_merge(const Params& p, char* smem) {
  bf16_t* Z = (bf16_t*)(p.ws + OFF_Z);
  const bf16_t* U = (const bf16_t*)(p.ws + OFF_U);
  const bf16_t* Wg = (const bf16_t*)(p.ws + OFF_WTGATE);
  const bf16_t* Wb = (const bf16_t*)(p.ws + OFF_WTBR);
  const int tid = opaque_tid();
  const int lane = tid & 63, wid = tid >> 6, wm = wid >> 1, wn = wid & 1;
  for (int t = blockIdx.x; t < tile_count(128, 16); t += gridDim.x) {
    int mt, nt;
    if (!tile_map(t, 16, mt, nt)) continue;
    f32x4 accm[4][2];
    zero_acc<64>(accm);
    for (int kb = 0; kb < 4; ++kb) {
      f32x4 g[4][2], pr[4][2];
      zero_acc<64>(g);
      zero_acc<64>(pr);
      gemm_mainloop<64>(g, U, 1024, mt * 128, Wg + (size_t)kb * 1024 * 1024, 1024, nt * 64, 1023, 1024, smem, tid);
      const int ycol = (kb == 0) ? (ZHG + 1024) : (kb == 1) ? (ZRW + 1024) : (kb == 2) ? (ZMB + 1024) : ZMB;
      gemm_mainloop<64>(pr, Z + ycol, ZS, mt * 128, Wb + (size_t)kb * 1024 * 512, 512, nt * 64, 1023, 512, smem, tid);
#pragma unroll
      for (int mi = 0; mi < 4; ++mi)
#pragma unroll
        for (int ni = 0; ni < 2; ++ni)
#pragma unroll
          for (int j = 0; j < 4; ++j) accm[mi][ni][j] = fmaf(sigmoidf_(g[mi][ni][j]), pr[mi][ni][j], accm[mi][ni][j]);
    }
#pragma unroll
    for (int mi = 0; mi < 4; ++mi)
#pragma unroll
      for (int ni = 0; ni < 2; ++ni) {
        int col = nt * 64 + wn * 32 + ni * 16 + (lane >> 4) * 4;
        int row = mt * 128 + wm * 64 + mi * 16 + (lane & 15);
        uint2 o;
        o.x = pack2(accm[mi][ni][0], accm[mi][ni][1]);
        o.y = pack2(accm[mi][ni][2], accm[mi][ni][3]);
        *reinterpret_cast<uint2*>(Z + (size_t)row * ZS + col) = o;
      }
  }
}

__device__ void phase_resid_gemm(const Params& p, const bf16_t* A, int lda, const bf16_t* Wt, int K, const float* xold, char* smem) {
  const int tid = opaque_tid();
  const int lane = tid & 63, wid = tid >> 6, wm = wid >> 1, wn = wid & 1;
  for (int t = blockIdx.x; t < tile_count(64, 8); t += gridDim.x) {
    int mt, nt;
    if (!tile_map(t, 8, mt, nt)) continue;
    f32x4 acc[8][4];
    zero_acc_big(acc);
    gemm_mainloop_big(acc, A, lda, mt * 256, Wt, K, nt * 128, 1023, K, smem, tid);
#pragma unroll
    for (int mi = 0; mi < 8; ++mi)
#pragma unroll
      for (int ni = 0; ni < 4; ++ni) {
        int col = nt * 128 + wn * 64 + ni * 16 + (lane >> 4) * 4;
        int row = mt * 256 + wm * 128 + mi * 16 + (lane & 15);
        size_t o = (size_t)row * DM + col;
        float4 xo = *reinterpret_cast<const float4*>(xold + o);
        float4 r = float4{xo.x + acc[mi][ni][0], xo.y + acc[mi][ni][1], xo.z + acc[mi][ni][2], xo.w + acc[mi][ni][3]};
        *reinterpret_cast<float4*>(p.out + o) = r;
      }
  }
}

__device__ void phase_ffn_in(const Params& p, char* smem) {
  const bf16_t* U = (const bf16_t*)(p.ws + OFF_U);
  const bf16_t* Wt = (const bf16_t*)(p.ws + OFF_WTF1);
  bf16_t* H = (bf16_t*)(p.ws + OFF_Z);
  const int tid = opaque_tid();
  const int lane = tid & 63, wid = tid >> 6, wm = wid >> 1, wn = wid & 1;
  for (int t = blockIdx.x; t < tile_count(64, 44); t += gridDim.x) {
    int mt, nt;
    if (!tile_map(t, 44, mt, nt)) continue;
    f32x4 acc[8][4];
    zero_acc_big(acc);
    gemm_mainloop_big(acc, U, 1024, mt * 256, Wt, 1024, nt * 128, 5631, 1024, smem, tid);
#pragma unroll
    for (int mi = 0; mi < 8; ++mi)
#pragma unroll
      for (int q = 0; q < 2; ++q) {
        int hcol = ((nt * 128 + wn * 64 + q * 32) >> 1) + (lane >> 4) * 4;
        int row = mt * 256 + wm * 128 + mi * 16 + (lane & 15);
        uint2 o;
        o.x = pack2(fsilu(acc[mi][2 * q][0]) * acc[mi][2 * q + 1][0], fsilu(acc[mi][2 * q][1]) * acc[mi][2 * q + 1][1]);
        o.y = pack2(fsilu(acc[mi][2 * q][2]) * acc[mi][2 * q + 1][2], fsilu(acc[mi][2 * q][3]) * acc[mi][2 * q + 1][3]);
        *reinterpret_cast<uint2*>(H + (size_t)row * FFH + hcol) = o;
      }
  }
}

__device__ void phase_final(const Params& p) {
  const int tid = opaque_tid();
  const int lane = tid & 63;
  const float* w = p.in[I_NORM_FINAL];
  for (int t = blockIdx.x; t < T_TOK / 4; t += gridDim.x) {
    int row = t * 4 + (tid >> 6);
    float* x = p.out + (size_t)row * DM;
    float4 v[4];
    float ss = 0.f;
#pragma unroll
    for (int i = 0; i < 4; ++i) {
      v[i] = *reinterpret_cast<const float4*>(x + i * 256 + lane * 4);
      ss += v[i].x * v[i].x + v[i].y * v[i].y + v[i].z * v[i].z + v[i].w * v[i].w;
    }
    ss = sum64(ss);
    float rstd = rsqrtf(ss * (1.f / 1024.f) + 1e-6f);
#pragma unroll
    for (int i = 0; i < 4; ++i) {
      float4 ww = *reinterpret_cast<const float4*>(w + i * 256 + lane * 4);
      float4 o = float4{v[i].x * rstd * ww.x, v[i].y * rstd * ww.y, v[i].z * rstd * ww.z, v[i].w * rstd * ww.w};
      *reinterpret_cast<float4*>(x + i * 256 + lane * 4) = o;
    }
  }
}

template <int SUB>
__device__ __forceinline__ void run_phase(const Params& p, int l, char* smem) {
  if (SUB == 0) phase_convert_norm(p, l, smem);
  else if (SUB == 1) phase_inproj(p, smem);
  else if (SUB == 2) phase_rwprep(p, l, smem);
  else if (SUB == 3) phase_scans(p, l, smem);
  else if (SUB == 4) phase_post(p, l, smem);
  else if (SUB == 5) phase_merge(p, smem);
  else if (SUB == 6) phase_resid_gemm(p, (const bf16_t*)(p.ws + OFF_Z), ZS, (const bf16_t*)(p.ws + OFF_WTOUT), 1024,
                                      (l == 0) ? p.in[I_X] : p.out, smem);
  else if (SUB == 7) phase_norm_only(p, p.out, p.in[I_NORM_FFN] + l * DM);
  else if (SUB == 8) phase_ffn_in(p, smem);
  else if (SUB == 9) phase_resid_gemm(p, (const bf16_t*)(p.ws + OFF_Z), FFH, (const bf16_t*)(p.ws + OFF_WTF2), FFH, p.out, smem);
  else phase_final(p);
}

#ifndef PHM
#define PHM 0xFFFF
#endif
__device__ __forceinline__ void grid_bar(unsigned* ctr, unsigned& target) {
  asm volatile("s_waitcnt vmcnt(0)" ::: "memory");
  __syncthreads();
  if (threadIdx.x == 0) {
    target += gridDim.x;
    __builtin_amdgcn_fence(__ATOMIC_RELEASE, "agent");
    __hip_atomic_fetch_add(ctr, 1u, __ATOMIC_RELAXED, __HIP_MEMORY_SCOPE_AGENT);
    while (__hip_atomic_load(ctr, __ATOMIC_RELAXED, __HIP_MEMORY_SCOPE_AGENT) < target) __builtin_amdgcn_s_sleep(32);
    __builtin_amdgcn_fence(__ATOMIC_ACQUIRE, "agent");
    asm volatile("s_waitcnt vmcnt(0)" ::: "memory");
  }
  __syncthreads();
}

#if COOP
__global__ void __launch_bounds__(256, 2) fwd_kernel(Params p, int ph0, int ph1, int scan_mask) {
  __shared__ __attribute__((aligned(16))) char smem[65536];
  cg::grid_group grid = cg::this_grid();
  unsigned* bar_ctr = reinterpret_cast<unsigned*>(p.ws + OFF_BAR);
  unsigned bar_target = 0;
  for (int ph = ph0; ph < ph1; ++ph) {
    if (ph == NPHASES - 1) {
      phase_final(p);
    } else {
      const int l = ph / NPH_LAYER, sub = ph % NPH_LAYER;
      switch (sub) {
        case 0: if (PHM & (1<<0)) run_phase<0>(p, l, smem); break;
        case 1: if (PHM & (1<<1)) run_phase<1>(p, l, smem); break;
        case 2: if (PHM & (1<<2)) run_phase<2>(p, l, smem); break;
        case 3: if (PHM & (1<<3)) phase_scans(p, l, smem, scan_mask); break;
        case 4: if (PHM & (1<<4)) run_phase<4>(p, l, smem); break;
        case 5: if (PHM & (1<<5)) run_phase<5>(p, l, smem); break;
        case 6: if (PHM & (1<<6)) run_phase<6>(p, l, smem); break;
        case 7: if (PHM & (1<<7)) run_phase<7>(p, l, smem); break;
        case 8: if (PHM & (1<<8)) run_phase<8>(p, l, smem); break;
        case 9: if (PHM & (1<<9)) run_phase<9>(p, l, smem); break;
      }
    }
    if (ph + 1 < ph1) {
      if (ph == ph0) grid.sync();
      else grid_bar(bar_ctr, bar_target);
    }
  }
}
#else
template <int SUB>
__global__ void __launch_bounds__(256, 2) k_phase(Params p, int l) {
  __shared__ __attribute__((aligned(16))) char smem[65536];
  run_phase<SUB>(p, l, smem);
}
#endif

extern "C" void kernel_launch(void* const* d_in, const int* in_sizes, int n_in, void* d_out, int out_size, void* d_ws,
                              size_t ws_size, hipStream_t stream) {
  if (n_in < 41 || ws_size < WS_NEED) {
    fprintf(stderr, "kernel_launch: bad args n_in=%d ws=%zu need=%zu\n", n_in, ws_size, (size_t)WS_NEED);
    return;
  }
  Params p{};
  for (int i = 0; i < 41; ++i) p.in[i] = (const float*)d_in[i];
  p.out = (float*)d_out;
  p.ws = (char*)d_ws;
#if COOP
  static int grid_blocks = 0;
  if (!grid_blocks) {
    int dev = 0, cus = 0, per_cu = 0;
    hipGetDevice(&dev);
    hipDeviceGetAttribute(&cus, hipDeviceAttributeMultiprocessorCount, dev);
    hipOccupancyMaxActiveBlocksPerMultiprocessor(&per_cu, fwd_kernel, 256, 0);
    if (per_cu > 2) per_cu = 2;
    grid_blocks = cus * per_cu;
  }
#ifdef HYBRID
  for (int ph = 0; ph < NPHASES; ++ph) {
    if (ph % 10 == 3 && ph < 20) {
      const int groups[4] = SCAN_GROUPS;
      for (int gi = 0; gi < 4; ++gi) if (groups[gi]) fwd_kernel<<<grid_blocks, 256, 0, stream>>>(p, ph, ph + 1, groups[gi]);
    } else {
      fwd_kernel<<<grid_blocks, 256, 0, stream>>>(p, ph, ph + 1, 15);
    }
  }
#else
  hipMemsetAsync((char*)d_ws + OFF_BAR, 0, 256, stream);
  int ph0 = 0, ph1 = NPHASES, smask = 15;
  void* args[] = {&p, &ph0, &ph1, &smask};
  hipError_t e = hipLaunchCooperativeKernel((void*)fwd_kernel, dim3(grid_blocks), dim3(256), args, 0, stream);
  if (e != hipSuccess) fprintf(stderr, "cooperative launch failed: %s (grid %d)\n", hipGetErrorString(e), grid_blocks);
#endif
#else
  const dim3 g(512), b(256);
  for (int l = 0; l < 2; ++l) {
    k_phase<0><<<g, b, 0, stream>>>(p, l);
    k_phase<1><<<g, b, 0, stream>>>(p, l);
    k_phase<2><<<g, b, 0, stream>>>(p, l);
    k_phase<3><<<g, b, 0, stream>>>(p, l);
    k_phase<4><<<g, b, 0, stream>>>(p, l);
    k_phase<5><<<g, b, 0, stream>>>(p, l);
    k_phase<6><<<g, b, 0, stream>>>(p, l);
    k_phase<7><<<g, b, 0, stream>>>(p, l);
    k_phase<8><<<g, b, 0, stream>>>(p, l);
    k_phase<9><<<g, b, 0, stream>>>(p, l);
  }
  k_phase<10><<<g, b, 0, stream>>>(p, 0);
#endif
}
```

```cpp
#include <hip/hip_runtime.h>
#include <hip/hip_cooperative_groups.h>
#include <cstdio>
#include <cstdint>
namespace cg = cooperative_groups;

#ifndef COOP
#define COOP 1
#endif

typedef unsigned short bf16_t;
typedef __attribute__((ext_vector_type(8))) short bf16x8;
typedef __attribute__((ext_vector_type(4))) float f32x4;
typedef __attribute__((ext_vector_type(4))) unsigned u32x4;

constexpr int T_TOK = 16384, SEQ = 2048, DM = 1024;
constexpr int IN_COLS = 9992, NZ = 5896, ZS = 5904;
constexpr int ZHG = 0, ZRW = 2048, ZS5 = 3840, ZMB = 4352;
constexpr int FFH = 2816;
constexpr int NPH_LAYER = 10, NPHASES = 21;

constexpr size_t OFF_WTIN   = 0;
constexpr size_t OFF_WTGATE = OFF_WTIN + (size_t)5896 * 1024 * 2;
constexpr size_t OFF_WTBR   = OFF_WTGATE + (size_t)4096 * 1024 * 2;
constexpr size_t OFF_WTOUT  = OFF_WTBR + (size_t)4 * 1024 * 512 * 2;
constexpr size_t OFF_WTF1   = OFF_WTOUT + (size_t)1024 * 1024 * 2;
constexpr size_t OFF_WTF2   = OFF_WTF1 + (size_t)5632 * 1024 * 2;
constexpr size_t OFF_WTGLU  = OFF_WTF2 + (size_t)1024 * 2816 * 2;
constexpr size_t OFF_U      = OFF_WTGLU + (size_t)512 * 512 * 2;
constexpr size_t OFF_Z      = OFF_U + (size_t)T_TOK * 1024 * 2;
constexpr size_t OFF_VF     = OFF_Z + (size_t)T_TOK * ZS * 2;
constexpr size_t OFF_BAR    = OFF_VF + (size_t)T_TOK * 512 * 2;
constexpr size_t OFF_WTGATE_B = OFF_BAR + 256;
constexpr size_t OFF_WB_B     = OFF_WTGATE_B + (size_t)4096 * 1024 * 2;
constexpr size_t WS_NEED      = OFF_WB_B + (OFF_U - OFF_WTBR);
constexpr size_t DELTA_GATE   = OFF_WTGATE_B - OFF_WTGATE;
constexpr size_t DELTA_WB     = OFF_WB_B - OFF_WTBR;
#define WOFF_GATE(l) (OFF_WTGATE + (size_t)(l) * DELTA_GATE)
#define WOFF(off, l) ((off) + (size_t)(l) * DELTA_WB)

struct Params {
  const float* in[41];
  float* out;
  char* ws;
};

enum { I_X = 0, I_NORM_MIX, I_W_IN, I_W_BRANCH, I_W_OUT, I_NORM_FFN, I_W_FFN_IN, I_W_FFN_OUT, I_NORM_FINAL,
       I_HG_LB, I_HG_NW, I_RW_MU, I_RW_W0, I_RW_W2, I_RW_A0, I_RW_A2, I_RW_G2, I_RW_KK, I_RW_KA, I_RW_RK,
       I_RW_LNW, I_RW_LNB, I_RW_V0, I_RW_V1, I_RW_V2, I_S5_ARE, I_S5_AIM, I_S5_BRE, I_S5_BIM, I_S5_CRE,
       I_S5_CIM, I_S5_D, I_S5_LOGDT, I_S5_WGLU, I_S5_BGLU, I_MB_CONVW, I_MB_CONVB, I_MB_DTB, I_MB_ALOG,
       I_MB_D, I_MB_NW };

__device__ __forceinline__ float bf2f(bf16_t v) { return __uint_as_float(((unsigned)v) << 16); }
typedef __attribute__((ext_vector_type(2))) __bf16 bf16x2_t;
__device__ __forceinline__ unsigned pack2(float a, float b) {
  bf16x2_t v;
  v[0] = (__bf16)a;
  v[1] = (__bf16)b;
  return __builtin_bit_cast(unsigned, v);
}
__device__ __forceinline__ bf16_t f2bf(float f) { return (bf16_t)(pack2(f, 0.f) & 0xffffu); }
__device__ __forceinline__ float sigmoidf_(float x) { return 1.f / (1.f + __expf(-x)); }
__device__ __forceinline__ float siluf_(float x) { return x / (1.f + __expf(-x)); }
__device__ __forceinline__ float softplusf_(float x) { return x > 20.f ? x : log1pf(__expf(x)); }
__device__ __forceinline__ float gelu_tanh(float x) {
  float u = 0.7978845608028654f * (x + 0.044715f * x * x * x);
  return 0.5f * x * (1.f + tanhf(u));
}
__device__ __forceinline__ float quad_sum(float x) {
  x += __builtin_bit_cast(float, __builtin_amdgcn_update_dpp(0, __builtin_bit_cast(int, x), 0xB1, 0xF, 0xF, true));
  x += __builtin_bit_cast(float, __builtin_amdgcn_update_dpp(0, __builtin_bit_cast(int, x), 0x4E, 0xF, 0xF, true));
  return x;
}
__device__ __forceinline__ float oct_sum(float x) {
  x = quad_sum(x);
  x += __builtin_bit_cast(float, __builtin_amdgcn_update_dpp(0, __builtin_bit_cast(int, x), 0x141, 0xF, 0xF, true));
  return x;
}
__device__ __forceinline__ float sum16(float x) {
  x += __shfl_xor(x, 1); x += __shfl_xor(x, 2); x += __shfl_xor(x, 4); x += __shfl_xor(x, 8);
  return x;
}
__device__ __forceinline__ float sum64(float x) {
  x = sum16(x); x += __shfl_xor(x, 16); x += __shfl_xor(x, 32);
  return x;
}

__device__ __forceinline__ int opaque_tid() {
  int t = threadIdx.x;
  asm volatile("" : "+v"(t));
  return t;
}

template <int BN>
__device__ __forceinline__ void gemm_mainloop(f32x4 (&acc)[4][BN / 32], const bf16_t* A, int lda, int m0,
                                              const bf16_t* Bt, int ldb, int n0, int nmax, int K, char* smem, const int tid) {
  const int lane = tid & 63, wid = tid >> 6, wm = wid >> 1, wn = wid & 1;
  const int q = tid & 7, r0 = tid >> 3;
  unsigned offA[4], offB[BN / 32];
#pragma unroll
  for (int i = 0; i < 4; ++i) offA[i] = ((unsigned)(m0 + r0 + 32 * i) * (unsigned)lda + (unsigned)q * 8u) * 2u;
#pragma unroll
  for (int i = 0; i < BN / 32; ++i) {
    int row = n0 + r0 + 32 * i;
    row = row < nmax ? row : nmax;
    offB[i] = ((unsigned)row * (unsigned)ldb + (unsigned)q * 8u) * 2u;
  }
  const unsigned sto = (unsigned)r0 * 128u + (unsigned)((q ^ ((r0 >> 1) & 7)) << 4);
  unsigned aoff[4], boff[BN / 32];
#pragma unroll
  for (int mi = 0; mi < 4; ++mi) {
    int row = wm * 64 + mi * 16 + (lane & 15);
    aoff[mi] = (unsigned)row * 128u + (unsigned)(((lane >> 4) ^ ((row >> 1) & 7)) << 4);
  }
#pragma unroll
  for (int ni = 0; ni < BN / 32; ++ni) {
    int row = wn * (BN / 2) + ni * 16 + (lane & 15);
    boff[ni] = (unsigned)row * 128u + (unsigned)(((lane >> 4) ^ ((row >> 1) & 7)) << 4);
  }
  const char* Ab = reinterpret_cast<const char*>(A);
  const char* Bb = reinterpret_cast<const char*>(Bt);
  const int nk = K >> 6;
  constexpr bool WIDE = (BN == 128);
  u32x4 Ra0, Ra1, Ra2, Ra3, Rb0, Rb1, Rb2, Rb3;
  u32x4 Qa0, Qa1, Qa2, Qa3, Qb0, Qb1, Qb2, Qb3;
#define GLOAD(P, TILE)                                                         \
  {                                                                            \
    const char* Ak_ = Ab + (size_t)(TILE) * 128;                               \
    const char* Bk_ = Bb + (size_t)(TILE) * 128;                               \
    P##a0 = *reinterpret_cast<const u32x4*>(Ak_ + offA[0]);                    \
    P##a1 = *reinterpret_cast<const u32x4*>(Ak_ + offA[1]);                    \
    P##a2 = *reinterpret_cast<const u32x4*>(Ak_ + offA[2]);                    \
    P##a3 = *reinterpret_cast<const u32x4*>(Ak_ + offA[3]);                    \
    P##b0 = *reinterpret_cast<const u32x4*>(Bk_ + offB[0]);                    \
    P##b1 = *reinterpret_cast<const u32x4*>(Bk_ + offB[1]);                    \
    if (WIDE) {                                                                \
      P##b2 = *reinterpret_cast<const u32x4*>(Bk_ + offB[BN / 32 - 2]);        \
      P##b3 = *reinterpret_cast<const u32x4*>(Bk_ + offB[BN / 32 - 1]);        \
    }                                                                          \
  }
#define SSTORE(P, BUF)                                                         \
  {                                                                            \
    char* ad_ = smem + (BUF) * 16384 + sto;                                    \
    char* bd_ = smem + 32768 + (BUF) * (BN * 128) + sto;                       \
    *reinterpret_cast<u32x4*>(ad_) = P##a0;                                    \
    *reinterpret_cast<u32x4*>(ad_ + 4096) = P##a1;                             \
    *reinterpret_cast<u32x4*>(ad_ + 8192) = P##a2;                             \
    *reinterpret_cast<u32x4*>(ad_ + 12288) = P##a3;                            \
    *reinterpret_cast<u32x4*>(bd_) = P##b0;                                    \
    *reinterpret_cast<u32x4*>(bd_ + 4096) = P##b1;                             \
    if (WIDE) {                                                                \
      *reinterpret_cast<u32x4*>(bd_ + 8192) = P##b2;                           \
      *reinterpret_cast<u32x4*>(bd_ + 12288) = P##b3;                          \
    }                                                                          \
  }
#define COMPUTE(BUF)                                                           \
  {                                                                            \
    const char* a_s = smem + (BUF) * 16384;                                    \
    const char* b_s = smem + 32768 + (BUF) * (BN * 128);                       \
    _Pragma("unroll") for (int ks = 0; ks < 2; ++ks) {                         \
      bf16x8 af[4], bfr[BN / 32];                                              \
      _Pragma("unroll") for (int mi = 0; mi < 4; ++mi)                         \
          af[mi] = *reinterpret_cast<const bf16x8*>(a_s + (aoff[mi] ^ (ks * 64)));       \
      _Pragma("unroll") for (int ni = 0; ni < BN / 32; ++ni)                   \
          bfr[ni] = *reinterpret_cast<const bf16x8*>(b_s + (boff[ni] ^ (ks * 64)));      \
      _Pragma("unroll") for (int mi = 0; mi < 4; ++mi)                         \
        _Pragma("unroll") for (int ni = 0; ni < BN / 32; ++ni)                 \
          acc[mi][ni] = __builtin_amdgcn_mfma_f32_16x16x32_bf16(bfr[ni], af[mi], acc[mi][ni], 0, 0, 0); \
    }                                                                          \
  }
  if constexpr (WIDE) {
    GLOAD(R, 0);
    SSTORE(R, 0);
    GLOAD(R, 1);
    if (nk > 2) GLOAD(Q, 2);
    __syncthreads();
#pragma unroll 1
    for (int kt = 0; kt < nk; kt += 2) {
      __builtin_amdgcn_sched_barrier(0);
      COMPUTE(0);
      __builtin_amdgcn_sched_barrier(0);
      SSTORE(R, 1);
      if (kt + 3 < nk) GLOAD(R, kt + 3);
      __syncthreads();
      __builtin_amdgcn_sched_barrier(0);
      COMPUTE(1);
      __builtin_amdgcn_sched_barrier(0);
      if (kt + 2 < nk) SSTORE(Q, 0);
      if (kt + 4 < nk) GLOAD(Q, kt + 4);
      __syncthreads();
    }
  } else {
    GLOAD(R, 0);
    SSTORE(R, 0);
    __syncthreads();
#pragma unroll 1
    for (int kt = 0; kt < nk; ++kt) {
      const int buf = kt & 1;
      const bool more = (kt + 1 < nk);
      if (more) GLOAD(R, kt + 1);
      __builtin_amdgcn_sched_barrier(0);
      COMPUTE(buf);
      __builtin_amdgcn_sched_barrier(0);
      if (more) SSTORE(R, buf ^ 1);
      __syncthreads();
    }
  }
#undef GLOAD
#undef SSTORE
#undef COMPUTE
}

template <int BN>
__device__ __forceinline__ void zero_acc(f32x4 (&acc)[4][BN / 32]) {
#pragma unroll
  for (int mi = 0; mi < 4; ++mi)
#pragma unroll
    for (int ni = 0; ni < BN / 32; ++ni) acc[mi][ni] = f32x4{0.f, 0.f, 0.f, 0.f};
}

__device__ __forceinline__ void gemm_mainloop_big(f32x4 (&acc)[8][4], const bf16_t* A, int lda, int m0, const bf16_t* Bt,
                                                  int ldb, int n0, int nmax, int K, char* smem, const int tid) {
  const int lane = tid & 63, wid = tid >> 6, wm = wid >> 1, wn = wid & 1;
  const int q = tid & 3, r0 = tid >> 2;
  unsigned offA[4], offB[2];
#pragma unroll
  for (int i = 0; i < 4; ++i) offA[i] = ((unsigned)(m0 + r0 + 64 * i) * (unsigned)lda + (unsigned)q * 8u) * 2u;
#pragma unroll
  for (int i = 0; i < 2; ++i) {
    int row = n0 + r0 + 64 * i;
    row = row < nmax ? row : nmax;
    offB[i] = ((unsigned)row * (unsigned)ldb + (unsigned)q * 8u) * 2u;
  }
  const unsigned sto = (unsigned)r0 * 64u + (unsigned)((q ^ ((r0 >> 2) & 3)) << 4);
  unsigned aoff[8], boff[4];
#pragma unroll
  for (int mi = 0; mi < 8; ++mi) {
    int row = wm * 128 + mi * 16 + (lane & 15);
    aoff[mi] = (unsigned)row * 64u + (unsigned)(((lane >> 4) ^ ((row >> 2) & 3)) << 4);
  }
#pragma unroll
  for (int ni = 0; ni < 4; ++ni) {
    int row = wn * 64 + ni * 16 + (lane & 15);
    boff[ni] = (unsigned)row * 64u + (unsigned)(((lane >> 4) ^ ((row >> 2) & 3)) << 4);
  }
  const char* Ab = reinterpret_cast<const char*>(A);
  const char* Bb = reinterpret_cast<const char*>(Bt);
  const int nk = K >> 5;
  u32x4 Ra0, Ra1, Ra2, Ra3, Rb0, Rb1;
#define BG_LOAD(TILE)                                                  \
  {                                                                    \
    const char* Ak_ = Ab + (size_t)(TILE) * 64;                        \
    const char* Bk_ = Bb + (size_t)(TILE) * 64;                        \
    Ra0 = *reinterpret_cast<const u32x4*>(Ak_ + offA[0]);              \
    Ra1 = *reinterpret_cast<const u32x4*>(Ak_ + offA[1]);              \
    Ra2 = *reinterpret_cast<const u32x4*>(Ak_ + offA[2]);              \
    Ra3 = *reinterpret_cast<const u32x4*>(Ak_ + offA[3]);              \
    Rb0 = *reinterpret_cast<const u32x4*>(Bk_ + offB[0]);              \
    Rb1 = *reinterpret_cast<const u32x4*>(Bk_ + offB[1]);              \
  }
#define BG_STORE(BUF)                                                  \
  {                                                                    \
    char* ad_ = smem + (BUF) * 16384 + sto;                            \
    char* bd_ = smem + 32768 + (BUF) * 8192 + sto;                     \
    *reinterpret_cast<u32x4*>(ad_) = Ra0;                              \
    *reinterpret_cast<u32x4*>(ad_ + 4096) = Ra1;                       \
    *reinterpret_cast<u32x4*>(ad_ + 8192) = Ra2;                       \
    *reinterpret_cast<u32x4*>(ad_ + 12288) = Ra3;                      \
    *reinterpret_cast<u32x4*>(bd_) = Rb0;                              \
    *reinterpret_cast<u32x4*>(bd_ + 4096) = Rb1;                       \
  }
  BG_LOAD(0);
  BG_STORE(0);
  __syncthreads();
#pragma unroll 1
  for (int kt = 0; kt < nk; ++kt) {
    const int buf = kt & 1;
    const bool more = (kt + 1 < nk);
    if (more) BG_LOAD(kt + 1);
    __builtin_amdgcn_sched_barrier(0);
    {
      const char* a_s = smem + buf * 16384;
      const char* b_s = smem + 32768 + buf * 8192;
      bf16x8 bfr[4];
#pragma unroll
      for (int ni = 0; ni < 4; ++ni) bfr[ni] = *reinterpret_cast<const bf16x8*>(b_s + boff[ni]);
#pragma unroll
      for (int mi = 0; mi < 8; ++mi) {
        bf16x8 af = *reinterpret_cast<const bf16x8*>(a_s + aoff[mi]);
#pragma unroll
        for (int ni = 0; ni < 4; ++ni)
          acc[mi][ni] = __builtin_amdgcn_mfma_f32_16x16x32_bf16(bfr[ni], af, acc[mi][ni], 0, 0, 0);
      }
    }
    __builtin_amdgcn_sched_barrier(0);
    if (more) BG_STORE(buf ^ 1);
    __syncthreads();
  }
#undef BG_LOAD
#undef BG_STORE
}

__device__ __forceinline__ void zero_acc_big(f32x4 (&acc)[8][4]) {
#pragma unroll
  for (int mi = 0; mi < 8; ++mi)
#pragma unroll
    for (int ni = 0; ni < 4; ++ni) acc[mi][ni] = f32x4{0.f, 0.f, 0.f, 0.f};
}

__device__ __forceinline__ void conv_tile(const float* src, int ld, int nlimit, int k0, int n0, bf16_t* dst, int Kd, int mode,
                                          char* smem, const int tid) {
  float* sT = reinterpret_cast<float*>(smem);
#pragma unroll
  for (int i = 0; i < 16; ++i) {
    int kk = i * 4 + (tid >> 6), nn = tid & 63;
    float v = (n0 + nn < nlimit) ? src[(size_t)(k0 + kk) * ld + n0 + nn] : 0.f;
    sT[kk * 65 + nn] = v;
  }
  __syncthreads();
  {
    int nn = tid >> 2, kq = tid & 3;
    int n = n0 + nn;
    if (n < nlimit) {
      int drow = n;
      if (mode == 1) {
        if (n < FFH) drow = (n >> 4) * 32 + (n & 15);
        else { int j = n - FFH; drow = (j >> 4) * 32 + 16 + (j & 15); }
      }
      unsigned pk[8];
#pragma unroll
      for (int j = 0; j < 8; ++j) pk[j] = pack2(sT[(kq * 16 + 2 * j) * 65 + nn], sT[(kq * 16 + 2 * j + 1) * 65 + nn]);
      uint4* d = reinterpret_cast<uint4*>(dst + (size_t)drow * Kd + k0 + kq * 16);
      d[0] = uint4{pk[0], pk[1], pk[2], pk[3]};
      d[1] = uint4{pk[4], pk[5], pk[6], pk[7]};
    }
  }
  __syncthreads();
}

__device__ __forceinline__ void rmsnorm_row_to_bf16(const float* x, const float* w, bf16_t* out, const int lane) {
  float4 v[4];
  float ss = 0.f;
#pragma unroll
  for (int i = 0; i < 4; ++i) {
    v[i] = *reinterpret_cast<const float4*>(x + i * 256 + lane * 4);
    ss += v[i].x * v[i].x + v[i].y * v[i].y + v[i].z * v[i].z + v[i].w * v[i].w;
  }
  ss = sum64(ss);
  float rstd = rsqrtf(ss * (1.f / 1024.f) + 1e-6f);
#pragma unroll
  for (int i = 0; i < 4; ++i) {
    float4 ww = *reinterpret_cast<const float4*>(w + i * 256 + lane * 4);
    uint2 o;
    o.x = pack2(v[i].x * rstd * ww.x, v[i].y * rstd * ww.y);
    o.y = pack2(v[i].z * rstd * ww.z, v[i].w * rstd * ww.w);
    *reinterpret_cast<uint2*>(out + i * 256 + lane * 4) = o;
  }
}

constexpr int CT_IN = 157 * 16, CT_BR = 512, CT_OUT = 256, CT_F1 = 88 * 16, CT_F2 = 44 * 16, CT_GLU = 64;
constexpr int CT_TOTAL = CT_IN + CT_BR + CT_OUT + CT_F1 + CT_F2 + CT_GLU;

__device__ __forceinline__ void convert_one(const Params& p, int l, int c, char* smem, const int tid) {
  char* ws = p.ws;
  if (c < CT_IN) {
    int nt = c >> 4, kt = c & 15;
    const float* src = p.in[I_W_IN] + (size_t)l * 1024 * IN_COLS;
    if (nt < 64) conv_tile(src, IN_COLS, IN_COLS, kt * 64, nt * 64, (bf16_t*)(ws + WOFF_GATE(l)), 1024, 0, smem, tid);
    else conv_tile(src + 4096, IN_COLS, IN_COLS - 4096, kt * 64, (nt - 64) * 64, (bf16_t*)(ws + OFF_WTIN), 1024, 0, smem, tid);
    return;
  }
  c -= CT_IN;
  if (c < CT_BR) {
    int kb = c >> 7, r = c & 127, nt = r >> 3, kt = r & 7;
    const float* src = p.in[I_W_BRANCH] + ((size_t)l * 4 + kb) * 512 * 1024;
    conv_tile(src, 1024, 1024, kt * 64, nt * 64, (bf16_t*)(ws + WOFF(OFF_WTBR, l)) + (size_t)kb * 1024 * 512, 512, 0, smem, tid);
    return;
  }
  c -= CT_BR;
  if (c < CT_OUT) {
    int nt = c >> 4, kt = c & 15;
    conv_tile(p.in[I_W_OUT] + (size_t)l * 1024 * 1024, 1024, 1024, kt * 64, nt * 64, (bf16_t*)(ws + WOFF(OFF_WTOUT, l)), 1024, 0, smem, tid);
    return;
  }
  c -= CT_OUT;
  if (c < CT_F1) {
    int nt = c >> 4, kt = c & 15;
    conv_tile(p.in[I_W_FFN_IN] + (size_t)l * 1024 * 5632, 5632, 5632, kt * 64, nt * 64, (bf16_t*)(ws + WOFF(OFF_WTF1, l)), 1024, 1, smem, tid);
    return;
  }
  c -= CT_F1;
  if (c < CT_F2) {
    int nt = c / 44, kt = c % 44;
    conv_tile(p.in[I_W_FFN_OUT] + (size_t)l * FFH * 1024, 1024, 1024, kt * 64, nt * 64, (bf16_t*)(ws + WOFF(OFF_WTF2, l)), FFH, 0, smem, tid);
    return;
  }
  c -= CT_F2;
  {
    int nt = c >> 3, kt = c & 7;
    conv_tile(p.in[I_S5_WGLU] + (size_t)l * 512 * 512, 512, 512, kt * 64, nt * 64, (bf16_t*)(ws + WOFF(OFF_WTGLU, l)), 512, 0, smem, tid);
  }
}

__device__ void phase_convert_norm(const Params& p, int l, char* smem) {
  const int tid = opaque_tid();
  const int nconv = (l == 0) ? CT_TOTAL : 0;
  const int ntask = nconv + T_TOK / 4;
  const float* xsrc = (l == 0) ? p.in[I_X] : p.out;
  for (int t = blockIdx.x; t < ntask; t += gridDim.x) {
    if (t < nconv) {
      convert_one(p, l, t, smem, tid);
    } else {
      int row = (t - nconv) * 4 + (tid >> 6);
      rmsnorm_row_to_bf16(xsrc + (size_t)row * DM, p.in[I_NORM_MIX] + l * DM, (bf16_t*)(p.ws + OFF_U) + (size_t)row * DM, tid & 63);
    }
  }
}

__device__ void phase_norm_only(const Params& p, const float* xsrc, const float* w) {
  const int tid = opaque_tid();
  for (int t = blockIdx.x; t < T_TOK / 4; t += gridDim.x) {
    int row = t * 4 + (tid >> 6);
    rmsnorm_row_to_bf16(xsrc + (size_t)row * DM, w, (bf16_t*)(p.ws + OFF_U) + (size_t)row * DM, tid & 63);
  }
}

__device__ __forceinline__ bool tile_map(int t, int NT, int& mt, int& nt) {
  const int x = t & 7, r = t >> 3;
  const int cnt = (NT + 7) >> 3;
  const int ni = r % cnt;
  mt = r / cnt;
  nt = x + 8 * ni;
  return nt < NT;
}
__device__ __forceinline__ int tile_count(int MT, int NT) { return 8 * MT * ((NT + 7) >> 3); }

__device__ void phase_inproj(const Params& p, char* smem) {
  const bf16_t* U = (const bf16_t*)(p.ws + OFF_U);
  const bf16_t* Wt = (const bf16_t*)(p.ws + OFF_WTIN);
  bf16_t* Z = (bf16_t*)(p.ws + OFF_Z);
  const int tid = opaque_tid();
  const int lane = tid & 63, wid = tid >> 6, wm = wid >> 1, wn = wid & 1;
  constexpr int NT = 47;
  for (int t = blockIdx.x; t < tile_count(64, NT); t += gridDim.x) {
    int mt, nt;
    if (!tile_map(t, NT, mt, nt)) continue;
    f32x4 acc[8][4];
    zero_acc_big(acc);
    gemm_mainloop_big(acc, U, 1024, mt * 256, Wt, 1024, nt * 128, NZ - 1, 1024, smem, tid);
#pragma unroll
    for (int mi = 0; mi < 8; ++mi)
#pragma unroll
      for (int ni = 0; ni < 4; ++ni) {
        int col = nt * 128 + wn * 64 + ni * 16 + (lane >> 4) * 4;
        int row = mt * 256 + wm * 128 + mi * 16 + (lane & 15);
        if (col < NZ) {
          uint2 o;
          o.x = pack2(acc[mi][ni][0], acc[mi][ni][1]);
          o.y = pack2(acc[mi][ni][2], acc[mi][ni][3]);
          *reinterpret_cast<uint2*>(Z + (size_t)row * ZS + col) = o;
        }
      }
  }
}

template <int J>
__device__ __forceinline__ void lora_mm(const float* sIn, const float* W, float (&a0)[16], float (&a1)[16], const int tid) {
#pragma unroll
  for (int i = 0; i < 16; ++i) { a0[i] = 0.f; a1[i] = 0.f; }
#pragma unroll 8
  for (int j = 0; j < J; ++j) {
    float w0 = W[j * 512 + tid], w1 = W[j * 512 + tid + 256];
    const float4* x4 = reinterpret_cast<const float4*>(sIn + j * 16);
#pragma unroll
    for (int q = 0; q < 4; ++q) {
      float4 x = x4[q];
      a0[q * 4 + 0] = fmaf(w0, x.x, a0[q * 4 + 0]); a1[q * 4 + 0] = fmaf(w1, x.x, a1[q * 4 + 0]);
      a0[q * 4 + 1] = fmaf(w0, x.y, a0[q * 4 + 1]); a1[q * 4 + 1] = fmaf(w1, x.y, a1[q * 4 + 1]);
      a0[q * 4 + 2] = fmaf(w0, x.z, a0[q * 4 + 2]); a1[q * 4 + 2] = fmaf(w1, x.z, a1[q * 4 + 2]);
      a0[q * 4 + 3] = fmaf(w0, x.w, a0[q * 4 + 3]); a1[q * 4 + 3] = fmaf(w1, x.w, a1[q * 4 + 3]);
    }
  }
}

__device__ __forceinline__ float rw_shift(const bf16_t* Z, int row, int s, int rc, float mu) {
  float cur = bf2f(Z[(size_t)row * ZS + ZRW + rc]);
  float prev = (s > 0) ? bf2f(Z[(size_t)(row - 1) * ZS + ZRW + rc]) : 0.f;
  return cur + (prev - cur) * mu;
}

__device__ void phase_rwprep(const Params& p, int l, char* smem) {
  const bf16_t* Z = (const bf16_t*)(p.ws + OFF_Z);
  bf16_t* LW = (bf16_t*)(p.ws + OFF_U);
  bf16_t* LA = LW + (size_t)T_TOK * 512;
  bf16_t* VF = (bf16_t*)(p.ws + OFF_VF);
  float* sXw = reinterpret_cast<float*>(smem);
  float* sXa = sXw + 64 * 16;
  float* sTmp = sXa + 64 * 16;
  float* sZv = sTmp + 32 * 16;
  const float* mu = p.in[I_RW_MU] + l * 1792;
  const int tid = opaque_tid();
  for (int t = blockIdx.x; t < T_TOK / 16; t += gridDim.x) {
    const int row0 = t * 16;
    for (int e = tid; e < 2048; e += 256) {
      int which = e >> 10, r = e & 1023, j = r >> 4, tok = r & 15;
      int row = row0 + tok, s = row & (SEQ - 1);
      int rc = 1536 + which * 64 + j;
      float z = rw_shift(Z, row, s, rc, mu[rc]);
      if (which == 0) sXw[j * 16 + tok] = tanhf(z); else sXa[j * 16 + tok] = z;
    }
    float zv0[16], zv1[16];
    {
      float m0 = mu[1024 + tid], m1 = mu[1024 + tid + 256];
#pragma unroll
      for (int tok = 0; tok < 16; ++tok) {
        int row = row0 + tok, s = row & (SEQ - 1);
        zv0[tok] = rw_shift(Z, row, s, 1024 + tid, m0);
        zv1[tok] = rw_shift(Z, row, s, 1024 + tid + 256, m1);
      }
    }
    if (l > 0) {
#pragma unroll
      for (int tok = 0; tok < 16; ++tok) { sZv[tid * 16 + tok] = zv0[tok]; sZv[(tid + 256) * 16 + tok] = zv1[tok]; }
    }
    __syncthreads();
    float a0[16], a1[16];
    lora_mm<64>(sXw, p.in[I_RW_W2] + (size_t)l * 64 * 512, a0, a1, tid);
#pragma unroll
    for (int tok = 0; tok < 16; ++tok) {
      LW[(size_t)(row0 + tok) * 512 + tid] = f2bf(a0[tok]);
      LW[(size_t)(row0 + tok) * 512 + tid + 256] = f2bf(a1[tok]);
    }
    lora_mm<64>(sXa, p.in[I_RW_A2] + (size_t)l * 64 * 512, a0, a1, tid);
#pragma unroll
    for (int tok = 0; tok < 16; ++tok) {
      LA[(size_t)(row0 + tok) * 512 + tid] = f2bf(a0[tok]);
      LA[(size_t)(row0 + tok) * 512 + tid + 256] = f2bf(a1[tok]);
    }
    if (l == 0) {
#pragma unroll
      for (int tok = 0; tok < 16; ++tok) {
        VF[(size_t)(row0 + tok) * 512 + tid] = f2bf(zv0[tok]);
        VF[(size_t)(row0 + tok) * 512 + tid + 256] = f2bf(zv1[tok]);
      }
    } else {
      const float* v1 = p.in[I_RW_V1] + (size_t)(l - 1) * 512 * 32;
      const float* v2 = p.in[I_RW_V2] + (size_t)(l - 1) * 32 * 512;
      const float* v0 = p.in[I_RW_V0] + (size_t)(l - 1) * 512;
      {
        int r = tid & 31, tg = tid >> 5;
        float t0 = 0.f, t1 = 0.f;
#pragma unroll 16
        for (int c = 0; c < 512; ++c) {
          float w = v1[c * 32 + r];
          float2 x = *reinterpret_cast<const float2*>(sZv + c * 16 + tg * 2);
          t0 = fmaf(w, x.x, t0); t1 = fmaf(w, x.y, t1);
        }
        sTmp[r * 16 + tg * 2] = t0; sTmp[r * 16 + tg * 2 + 1] = t1;
      }
      __syncthreads();
      lora_mm<32>(sTmp, v2, a0, a1, tid);
      float b0 = v0[tid], b1 = v0[tid + 256];
#pragma unroll
      for (int tok = 0; tok < 16; ++tok) {
        size_t i0 = (size_t)(row0 + tok) * 512 + tid;
        float vf0 = bf2f(VF[i0]), vf1 = bf2f(VF[i0 + 256]);
        VF[i0] = f2bf(zv0[tok] + (vf0 - zv0[tok]) * sigmoidf_(b0 + a0[tok]));
        VF[i0 + 256] = f2bf(zv1[tok] + (vf1 - zv1[tok]) * sigmoidf_(b1 + a1[tok]));
      }
    }
    __syncthreads();
  }
}

__device__ __forceinline__ float frcp(float x) { return __builtin_amdgcn_rcpf(x); }
__device__ __forceinline__ float fsigmoid(float x) { return frcp(1.f + __expf(-x)); }
__device__ __forceinline__ float fsilu(float x) { return x * frcp(1.f + __expf(-x)); }
__device__ __forceinline__ float fsoftplus(float x) { return x > 20.f ? x : __logf(1.f + __expf(x)); }
__device__ __forceinline__ float ftanh(float x) {
  float e = __expf(2.f * fminf(fmaxf(x, -15.f), 15.f));
  return (e - 1.f) * frcp(e + 1.f);
}
__device__ __forceinline__ float fgelu(float x) {
  float u = 0.7978845608028654f * (x + 0.044715f * x * x * x);
  return 0.5f * x * (1.f + ftanh(u));
}

__device__ void hg_scan(const Params& p, int l, int task, char* smem) {
  const int b = task >> 3, h = (task >> 1) & 3, vg = task & 1;
  float* sFg = reinterpret_cast<float*>(smem);
  float* sQs = sFg + 16 * 128;
  float* sO = sQs + 16 * 128;
  float* sVv = sO + 4 * 16 * 64;
  const int tid = opaque_tid(), w = tid >> 6, lane = tid & 63;
  bf16_t* Z = (bf16_t*)(p.ws + OFF_Z) + (size_t)b * SEQ * ZS;
  const int ks = tid & 127;
  float lb = 0.f;
  if (l > 0) {
    float x0 = p.in[I_HG_LB][h * 128 + ks], x1 = p.in[I_HG_LB][512 + h * 128 + ks];
    float m = fmaxf(x0, x1), e0 = expf(x0 - m), e1 = expf(x1 - m);
    lb = e1 / (e0 + e1);
  }
  float s[32];
#pragma unroll
  for (int j = 0; j < 32; ++j) s[j] = 0.f;
  const int vcol = ZHG + 1024 + h * 128 + vg * 64;
  const int qcol = ZHG + h * 128 + ks;
  bf16_t rq0, rq1, rq2, rq3, rq4, rq5, rq6, rq7, rf0, rf1, rf2, rf3, rf4, rf5, rf6, rf7, rv0, rv1, rv2, rv3;
#define HG_LOAD(T0)                                                                                \
  {                                                                                                \
    const bf16_t* zb = Z + (size_t)((T0) + (tid >> 7)) * ZS + qcol;                                \
    rq0 = zb[0]; rf0 = zb[512]; zb += 2 * ZS; rq1 = zb[0]; rf1 = zb[512]; zb += 2 * ZS;            \
    rq2 = zb[0]; rf2 = zb[512]; zb += 2 * ZS; rq3 = zb[0]; rf3 = zb[512]; zb += 2 * ZS;            \
    rq4 = zb[0]; rf4 = zb[512]; zb += 2 * ZS; rq5 = zb[0]; rf5 = zb[512]; zb += 2 * ZS;            \
    rq6 = zb[0]; rf6 = zb[512]; zb += 2 * ZS; rq7 = zb[0]; rf7 = zb[512];                          \
    const bf16_t* zv = Z + (size_t)((T0) + w) * ZS + vcol + lane;                                  \
    rv0 = zv[0]; rv1 = zv[4 * ZS]; rv2 = zv[8 * ZS]; rv3 = zv[12 * ZS];                            \
  }
#define HG_PUT1(I, RQ, RF)                                                                         \
  {                                                                                                \
    int t = (tid >> 7) + 2 * (I);                                                                  \
    sFg[t * 128 + ks] = fmaxf(lb + (1.f - lb) * fsigmoid(bf2f(RF)), 1e-30f);                       \
    sQs[t * 128 + ks] = fsilu(bf2f(RQ));                                                           \
  }
#define HG_PROCESS()                                                                               \
  {                                                                                                \
    HG_PUT1(0, rq0, rf0) HG_PUT1(1, rq1, rf1) HG_PUT1(2, rq2, rf2) HG_PUT1(3, rq3, rf3)            \
    HG_PUT1(4, rq4, rf4) HG_PUT1(5, rq5, rf5) HG_PUT1(6, rq6, rf6) HG_PUT1(7, rq7, rf7)            \
    sVv[(w)*64 + lane] = bf2f(rv0); sVv[(w + 4) * 64 + lane] = bf2f(rv1);                          \
    sVv[(w + 8) * 64 + lane] = bf2f(rv2); sVv[(w + 12) * 64 + lane] = bf2f(rv3);                   \
  }
  HG_LOAD(0);
  HG_PROCESS();
  __syncthreads();
  constexpr int NCH = SEQ / 16;
#pragma unroll 1
  for (int c = 0; c < NCH; ++c) {
    const int t0 = c * 16;
    const int tn = (c + 1 < NCH) ? t0 + 16 : t0;
    HG_LOAD(tn);
    __builtin_amdgcn_sched_barrier(0);
#pragma unroll 2
    for (int t = 0; t < 16; ++t) {
      const float v = sVv[t * 64 + lane];
      const float opv = (lane < 32) ? sFg[t * 128 + w * 32 + lane] : sQs[t * 128 + w * 32 + (lane - 32)];
      const int opi = __builtin_bit_cast(int, opv);
      float o = 0.f;
#pragma unroll
      for (int j = 0; j < 32; ++j) {
        const float fg = __builtin_bit_cast(float, __builtin_amdgcn_readlane(opi, j));
        const float qq = __builtin_bit_cast(float, __builtin_amdgcn_readlane(opi, 32 + j));
        const float kv = fmaf(-fg, v, v);
        s[j] = fmaf(s[j], fg, kv);
        o = fmaf(qq, s[j], o);
      }
      sO[(w * 16 + t) * 64 + lane] = o;
    }
    __builtin_amdgcn_sched_barrier(0);
    __syncthreads();
    {
      int t = tid >> 4, v4 = (tid & 15) * 4;
      float4 a = *reinterpret_cast<const float4*>(sO + (0 * 16 + t) * 64 + v4);
      float4 bq = *reinterpret_cast<const float4*>(sO + (1 * 16 + t) * 64 + v4);
      float4 cq = *reinterpret_cast<const float4*>(sO + (2 * 16 + t) * 64 + v4);
      float4 d = *reinterpret_cast<const float4*>(sO + (3 * 16 + t) * 64 + v4);
      uint2 o;
      o.x = pack2(a.x + bq.x + cq.x + d.x, a.y + bq.y + cq.y + d.y);
      o.y = pack2(a.z + bq.z + cq.z + d.z, a.w + bq.w + cq.w + d.w);
      *reinterpret_cast<uint2*>(Z + (size_t)(t0 + t) * ZS + vcol + v4) = o;
    }
    HG_PROCESS();
    __syncthreads();
  }
#undef HG_LOAD
#undef HG_PUT1
#undef HG_PROCESS
}

__device__ void mb_scan(const Params& p, int l, int task, char* smem) {
  const int b = task >> 3, hd = task & 7, g = hd >> 2;
  float* sB = reinterpret_cast<float*>(smem);
  float* sC = sB + 16 * 128;
  float* sX = sC + 16 * 128;
  float* sDt = sX + 16 * 64;
  float* sDA = sDt + 16;
  float* sO = sDA + 16;
  const int tid = opaque_tid(), w = tid >> 6, lane = tid & 63;
  bf16_t* Z = (bf16_t*)(p.ws + OFF_Z) + (size_t)b * SEQ * ZS;
  const float* cw = p.in[I_MB_CONVW] + (size_t)l * 4 * 1024;
  const float* cb = p.in[I_MB_CONVB] + (size_t)l * 1024;
  int ci0, ci1;
  {
    int ch = tid;
    ci0 = (ch < 64) ? hd * 64 + ch : (ch < 192 ? 512 + g * 128 + (ch - 64) : 768 + g * 128 + (ch - 192));
    ci1 = 768 + g * 128 + 64 + (tid & 63);
  }
  float* dstA = (tid < 64) ? (sX + tid) : (tid < 192 ? (sB + (tid - 64)) : (sC + (tid - 192)));
  const int strideA = (tid < 64) ? 64 : 128;
  const float w0a = cw[ci0], w1a = cw[1024 + ci0], w2a = cw[2048 + ci0], w3a = cw[3072 + ci0], ba = cb[ci0];
  const float w0b = cw[ci1], w1b = cw[1024 + ci1], w2b = cw[2048 + ci1], w3b = cw[3072 + ci1], bb = cb[ci1];
  const float Aneg = -expf(p.in[I_MB_ALOG][l * 8 + hd]);
  const float dtb = p.in[I_MB_DTB][l * 8 + hd];
  const float Dsk = p.in[I_MB_D][l * 8 + hd];
  float s[32];
#pragma unroll
  for (int j = 0; j < 32; ++j) s[j] = 0.f;
  float pa1 = 0.f, pa2 = 0.f, pa3 = 0.f, pb1 = 0.f, pb2 = 0.f, pb3 = 0.f;
  const int xcol = ZMB + 512;
  const int rt = tid >> 4, rp4 = (tid & 15) * 4;
  bf16_t xa0, xa1, xa2, xa3, xa4, xa5, xa6, xa7, xa8, xa9, xa10, xa11, xa12, xa13, xa14, xa15;
  bf16_t xb0, xb1, xb2, xb3, xb4, xb5, xb6, xb7, xb8, xb9, xb10, xb11, xb12, xb13, xb14, xb15;
  bf16_t rdt;
  uint2 gcur, gnext;
#define MB_LOAD(T0)                                                                                 \
  {                                                                                                 \
    const bf16_t* za = Z + (size_t)(T0) * ZS + xcol + ci0;                                          \
    xa0 = za[0]; xa1 = za[ZS]; xa2 = za[2 * ZS]; xa3 = za[3 * ZS]; xa4 = za[4 * ZS]; xa5 = za[5 * ZS];        \
    xa6 = za[6 * ZS]; xa7 = za[7 * ZS]; xa8 = za[8 * ZS]; xa9 = za[9 * ZS]; xa10 = za[10 * ZS];     \
    xa11 = za[11 * ZS]; xa12 = za[12 * ZS]; xa13 = za[13 * ZS]; xa14 = za[14 * ZS]; xa15 = za[15 * ZS];       \
    if (tid < 64) {                                                                                 \
      const bf16_t* zb = Z + (size_t)(T0) * ZS + xcol + ci1;                                        \
      xb0 = zb[0]; xb1 = zb[ZS]; xb2 = zb[2 * ZS]; xb3 = zb[3 * ZS]; xb4 = zb[4 * ZS]; xb5 = zb[5 * ZS];      \
      xb6 = zb[6 * ZS]; xb7 = zb[7 * ZS]; xb8 = zb[8 * ZS]; xb9 = zb[9 * ZS]; xb10 = zb[10 * ZS];   \
      xb11 = zb[11 * ZS]; xb12 = zb[12 * ZS]; xb13 = zb[13 * ZS]; xb14 = zb[14 * ZS]; xb15 = zb[15 * ZS];     \
    }                                                                                               \
    rdt = Z[(size_t)((T0) + (tid & 15)) * ZS + ZMB + 1536 + hd];                                    \
    gnext = *reinterpret_cast<const uint2*>(Z + (size_t)((T0) + rt) * ZS + ZMB + hd * 64 + rp4);    \
  }
#define MB_CONV_A(T, XR)                                                                            \
  {                                                                                                 \
    float xv = bf2f(XR);                                                                            \
    dstA[(T)*strideA] = fsilu(ba + w0a * pa3 + w1a * pa2 + w2a * pa1 + w3a * xv);                   \
    pa3 = pa2; pa2 = pa1; pa1 = xv;                                                                 \
  }
#define MB_CONV_B(T, XR)                                                                            \
  {                                                                                                 \
    float xv = bf2f(XR);                                                                            \
    sC[(T)*128 + 64 + tid] = fsilu(bb + w0b * pb3 + w1b * pb2 + w2b * pb1 + w3b * xv);              \
    pb3 = pb2; pb2 = pb1; pb1 = xv;                                                                 \
  }
#define MB_PROCESS()                                                                                \
  {                                                                                                 \
    MB_CONV_A(0, xa0) MB_CONV_A(1, xa1) MB_CONV_A(2, xa2) MB_CONV_A(3, xa3) MB_CONV_A(4, xa4)       \
    MB_CONV_A(5, xa5) MB_CONV_A(6, xa6) MB_CONV_A(7, xa7) MB_CONV_A(8, xa8) MB_CONV_A(9, xa9)       \
    MB_CONV_A(10, xa10) MB_CONV_A(11, xa11) MB_CONV_A(12, xa12) MB_CONV_A(13, xa13)                 \
    MB_CONV_A(14, xa14) MB_CONV_A(15, xa15)                                                         \
    if (tid < 64) {                                                                                 \
      MB_CONV_B(0, xb0) MB_CONV_B(1, xb1) MB_CONV_B(2, xb2) MB_CONV_B(3, xb3) MB_CONV_B(4, xb4)     \
      MB_CONV_B(5, xb5) MB_CONV_B(6, xb6) MB_CONV_B(7, xb7) MB_CONV_B(8, xb8) MB_CONV_B(9, xb9)     \
      MB_CONV_B(10, xb10) MB_CONV_B(11, xb11) MB_CONV_B(12, xb12) MB_CONV_B(13, xb13)               \
      MB_CONV_B(14, xb14) MB_CONV_B(15, xb15)                                                       \
    }                                                                                               \
    if (tid < 16) {                                                                                 \
      float dt = fsoftplus(bf2f(rdt) + dtb);                                                        \
      sDt[tid] = dt;                                                                                \
      sDA[tid] = __expf(Aneg * dt);                                                                 \
    }                                                                                               \
    gcur = gnext;                                                                                   \
  }
  MB_LOAD(0);
  MB_PROCESS();
  __syncthreads();
  constexpr int NCH = SEQ / 16;
#pragma unroll 1
  for (int c = 0; c < NCH; ++c) {
    const int t0 = c * 16;
    const bool more = (c + 1 < NCH);
    const int tn = more ? t0 + 16 : t0;
    MB_LOAD(tn);
    __builtin_amdgcn_sched_barrier(0);
#pragma unroll 2
    for (int t = 0; t < 16; ++t) {
      const float dA = sDA[t];
      const float xdt = sX[t * 64 + lane] * sDt[t];
      const float opv = (lane < 32) ? sB[t * 128 + w * 32 + lane] : sC[t * 128 + w * 32 + (lane - 32)];
      const int opi = __builtin_bit_cast(int, opv);
      float y = 0.f;
#pragma unroll
      for (int j = 0; j < 32; ++j) {
        const float bn = __builtin_bit_cast(float, __builtin_amdgcn_readlane(opi, j));
        const float cn = __builtin_bit_cast(float, __builtin_amdgcn_readlane(opi, 32 + j));
        s[j] = fmaf(s[j], dA, bn * xdt);
        y = fmaf(cn, s[j], y);
      }
      sO[(w * 16 + t) * 64 + lane] = y;
    }
    __builtin_amdgcn_sched_barrier(0);
    __syncthreads();
    {
      float4 a = *reinterpret_cast<const float4*>(sO + (0 * 16 + rt) * 64 + rp4);
      float4 bq = *reinterpret_cast<const float4*>(sO + (1 * 16 + rt) * 64 + rp4);
      float4 cq = *reinterpret_cast<const float4*>(sO + (2 * 16 + rt) * 64 + rp4);
      float4 d = *reinterpret_cast<const float4*>(sO + (3 * 16 + rt) * 64 + rp4);
      float4 xs = *reinterpret_cast<const float4*>(sX + rt * 64 + rp4);
      bf16_t* gp = Z + (size_t)(t0 + rt) * ZS + ZMB + hd * 64 + rp4;
      float g0 = bf2f((bf16_t)(gcur.x & 0xffff)), g1 = bf2f((bf16_t)(gcur.x >> 16));
      float g2 = bf2f((bf16_t)(gcur.y & 0xffff)), g3 = bf2f((bf16_t)(gcur.y >> 16));
      float y0 = a.x + bq.x + cq.x + d.x + Dsk * xs.x;
      float y1 = a.y + bq.y + cq.y + d.y + Dsk * xs.y;
      float y2 = a.z + bq.z + cq.z + d.z + Dsk * xs.z;
      float y3 = a.w + bq.w + cq.w + d.w + Dsk * xs.w;
      uint2 o;
      o.x = pack2(y0 * fsilu(g0), y1 * fsilu(g1));
      o.y = pack2(y2 * fsilu(g2), y3 * fsilu(g3));
      *reinterpret_cast<uint2*>(gp) = o;
    }
    __syncthreads();
    if (more) MB_PROCESS();
    __syncthreads();
  }
#undef MB_LOAD
#undef MB_CONV_A
#undef MB_CONV_B
#undef MB_PROCESS
}

__device__ void s5_scan(const Params& p, int l, int task, char* smem) {
  const int tid = opaque_tid(), w = tid >> 6, lane = tid & 63;
  const int b = task >> 3, g = (task & 7) * 4 + w;
  char* base = smem + w * 6144;
  float* sU = reinterpret_cast<float*>(base);
  char* sHb = base + 1024;
  bf16_t* Z = (bf16_t*)(p.ws + OFF_Z) + (size_t)b * SEQ * ZS + ZS5 + g * 16;
  const int n = lane;
  float lr, li, bbr[16], bbi[16];
  bf16x8 Bf0, Bf1, Bf2, Bf3;
  {
    float dt = expf(p.in[I_S5_LOGDT][l * 32 + g]);
    float are = p.in[I_S5_ARE][(l * 32 + g) * 64 + n], aim = p.in[I_S5_AIM][(l * 32 + g) * 64 + n];
    float mag = expf(dt * are);
    lr = mag * cosf(dt * aim); li = mag * sinf(dt * aim);
    float den = are * are + aim * aim;
    float cr = ((lr - 1.f) * are + li * aim) / den;
    float ci = (li * are - (lr - 1.f) * aim) / den;
    const float* bre = p.in[I_S5_BRE] + ((size_t)(l * 32 + g) * 64 + n) * 16;
    const float* bim = p.in[I_S5_BIM] + ((size_t)(l * 32 + g) * 64 + n) * 16;
#pragma unroll
    for (int c = 0; c < 16; ++c) {
      float br = bre[c], bi = bim[c];
      bbr[c] = cr * br - ci * bi;
      bbi[c] = cr * bi + ci * br;
    }
    const float* cre = p.in[I_S5_CRE] + (size_t)(l * 32 + g) * 16 * 64 + (lane & 15) * 64;
    const float* cim = p.in[I_S5_CIM] + (size_t)(l * 32 + g) * 16 * 64 + (lane & 15) * 64;
#pragma unroll
    for (int j = 0; j < 8; ++j) {
      const int kb = 8 * (lane >> 4) + j;
      const int n0 = kb >> 1;
      const bool im = (j & 1);
      Bf0[j] = (short)f2bf(im ? -cim[n0] : cre[n0]);
      Bf1[j] = (short)f2bf(im ? -cim[n0 + 16] : cre[n0 + 16]);
      Bf2[j] = (short)f2bf(im ? -cim[n0 + 32] : cre[n0 + 32]);
      Bf3[j] = (short)f2bf(im ? -cim[n0 + 48] : cre[n0 + 48]);
    }
  }
  const float dsk = p.in[I_S5_D][l * 512 + g * 16 + (lane & 15)];
  const int pt = lane >> 2, pc4 = (lane & 3) * 4;
  float hr = 0.f, hi = 0.f;
  uint2 unext = *reinterpret_cast<const uint2*>(Z + (size_t)pt * ZS + pc4);
  constexpr int NCH = SEQ / 16;
#pragma unroll 1
  for (int c = 0; c < NCH; ++c) {
    const int t0 = c * 16;
    {
      const uint2 ur = unext;
      *reinterpret_cast<float4*>(sU + pt * 16 + pc4) =
          float4{bf2f((bf16_t)(ur.x & 0xffff)), bf2f((bf16_t)(ur.x >> 16)), bf2f((bf16_t)(ur.y & 0xffff)), bf2f((bf16_t)(ur.y >> 16))};
      const int tn = (c + 1 < NCH) ? t0 + 16 : t0;
      unext = *reinterpret_cast<const uint2*>(Z + (size_t)(tn + pt) * ZS + pc4);
    }
    __builtin_amdgcn_sched_barrier(0);
    __syncthreads();
#pragma unroll 2
    for (int t = 0; t < 16; ++t) {
      const float4* u4 = reinterpret_cast<const float4*>(sU + t * 16);
      float bur = 0.f, bui = 0.f;
#pragma unroll
      for (int q = 0; q < 4; ++q) {
        float4 u = u4[q];
        bur = fmaf(bbr[q * 4 + 0], u.x, bur); bui = fmaf(bbi[q * 4 + 0], u.x, bui);
        bur = fmaf(bbr[q * 4 + 1], u.y, bur); bui = fmaf(bbi[q * 4 + 1], u.y, bui);
        bur = fmaf(bbr[q * 4 + 2], u.z, bur); bui = fmaf(bbi[q * 4 + 2], u.z, bui);
        bur = fmaf(bbr[q * 4 + 3], u.w, bur); bui = fmaf(bbi[q * 4 + 3], u.w, bui);
      }
      float nr = lr * hr - li * hi + bur;
      float ni = lr * hi + li * hr + bui;
      hr = nr; hi = ni;
      *reinterpret_cast<unsigned*>(sHb + t * 272 + n * 4) = pack2(hr, hi);
    }
    __syncthreads();
    {
      f32x4 acc = f32x4{0.f, 0.f, 0.f, 0.f};
      const char* ap = sHb + (lane & 15) * 272 + (lane >> 4) * 16;
      acc = __builtin_amdgcn_mfma_f32_16x16x32_bf16(*reinterpret_cast<const bf16x8*>(ap), Bf0, acc, 0, 0, 0);
      acc = __builtin_amdgcn_mfma_f32_16x16x32_bf16(*reinterpret_cast<const bf16x8*>(ap + 64), Bf1, acc, 0, 0, 0);
      acc = __builtin_amdgcn_mfma_f32_16x16x32_bf16(*reinterpret_cast<const bf16x8*>(ap + 128), Bf2, acc, 0, 0, 0);
      acc = __builtin_amdgcn_mfma_f32_16x16x32_bf16(*reinterpret_cast<const bf16x8*>(ap + 192), Bf3, acc, 0, 0, 0);
      const int cc = lane & 15, tb = (lane >> 4) * 4;
#pragma unroll
      for (int jj = 0; jj < 4; ++jj) {
        float y = acc[jj] + dsk * sU[(tb + jj) * 16 + cc];
        Z[(size_t)(t0 + tb + jj) * ZS + cc] = f2bf(fgelu(y));
      }
    }
    __syncthreads();
  }
}

__device__ void rw_scan(const Params& p, int l, int task, char* smem) {
  const int b = task >> 3, h = task & 7;
  float* sR = reinterpret_cast<float*>(smem);
  float* sW = sR + 1024;
  float* sK = sW + 1024;
  float* sA = sK + 1024;
  float* sBb = sA + 1024;
  float* sV = sBb + 1024;
  float* sY = sV + 1024;
  float* sBonus = sY + 1024;
  const int tid = opaque_tid(), w = tid >> 6, lane = tid & 63;
  const size_t tokbase = (size_t)b * SEQ;
  bf16_t* Z = (bf16_t*)(p.ws + OFF_Z) + tokbase * ZS;
  const bf16_t* LW = (const bf16_t*)(p.ws + OFF_U) + tokbase * 512;
  const bf16_t* LA = LW + (size_t)T_TOK * 512;
  const bf16_t* VF = (const bf16_t*)(p.ws + OFF_VF) + tokbase * 512;
  const int st = tid >> 4, c4 = (tid & 15) * 4, ch = h * 64 + c4;
  float mur[4], muk[4], w0[4], a0[4], kk_[4], ka_[4], rk_[4], lnw[4], lnb[4];
#pragma unroll
  for (int e = 0; e < 4; ++e) {
    mur[e] = p.in[I_RW_MU][l * 1792 + ch + e];
    muk[e] = p.in[I_RW_MU][l * 1792 + 512 + ch + e];
    w0[e] = p.in[I_RW_W0][l * 512 + ch + e];
    a0[e] = p.in[I_RW_A0][l * 512 + ch + e];
    kk_[e] = p.in[I_RW_KK][l * 512 + ch + e];
    ka_[e] = p.in[I_RW_KA][l * 512 + ch + e];
    rk_[e] = p.in[I_RW_RK][l * 512 + ch + e];
    lnw[e] = p.in[I_RW_LNW][l * 512 + ch + e];
    lnb[e] = p.in[I_RW_LNB][l * 512 + ch + e];
  }
  const int rg = lane >> 3, kq = lane & 7, vrow = w * 16 + rg * 2;
  float S0[8], S1[8];
#pragma unroll
  for (int j = 0; j < 8; ++j) { S0[j] = 0.f; S1[j] = 0.f; }
  uint2 rc, kc, rp, kp, lwv, lav, vfv;
#define RW_LOAD(T0)                                                                                 \
  {                                                                                                 \
    const int s_ = (T0) + st;                                                                       \
    const bf16_t* zr = Z + (size_t)s_ * ZS + ZRW + ch;                                              \
    rc = *reinterpret_cast<const uint2*>(zr);                                                       \
    kc = *reinterpret_cast<const uint2*>(zr + 512);                                                 \
    rp = uint2{0u, 0u}; kp = uint2{0u, 0u};                                                         \
    if (s_ > 0) { rp = *reinterpret_cast<const uint2*>(zr - ZS); kp = *reinterpret_cast<const uint2*>(zr - ZS + 512); } \
    lwv = *reinterpret_cast<const uint2*>(LW + (size_t)s_ * 512 + ch);                              \
    lav = *reinterpret_cast<const uint2*>(LA + (size_t)s_ * 512 + ch);                              \
    vfv = *reinterpret_cast<const uint2*>(VF + (size_t)s_ * 512 + ch);                              \
  }
#define RW_PROCESS()                                                                                \
  {                                                                                                 \
    float r4[4], k4[4], kkv[4], av[4], wv[4], vv[4];                                                \
    float n2 = 0.f;                                                                                 \
    _Pragma("unroll") for (int e = 0; e < 4; ++e) {                                                 \
      unsigned rcw = (e < 2) ? rc.x : rc.y, kcw = (e < 2) ? kc.x : kc.y, rpw = (e < 2) ? rp.x : rp.y, kpw = (e < 2) ? kp.x : kp.y; \
      unsigned lww = (e < 2) ? lwv.x : lwv.y, law = (e < 2) ? lav.x : lav.y, vfw = (e < 2) ? vfv.x : vfv.y; \
      int sh = (e & 1) * 16;                                                                        \
      float rcur = bf2f((bf16_t)((rcw >> sh) & 0xffff)), rprev = bf2f((bf16_t)((rpw >> sh) & 0xffff)); \
      float kcur = bf2f((bf16_t)((kcw >> sh) & 0xffff)), kprev = bf2f((bf16_t)((kpw >> sh) & 0xffff)); \
      float lwf = bf2f((bf16_t)((lww >> sh) & 0xffff)), laf = bf2f((bf16_t)((law >> sh) & 0xffff)); \
      vv[e] = bf2f((bf16_t)((vfw >> sh) & 0xffff));                                                 \
      r4[e] = rcur + (rprev - rcur) * mur[e];                                                       \
      k4[e] = kcur + (kprev - kcur) * muk[e];                                                       \
      float wlog = -fsoftplus(-(w0[e] + lwf)) - 0.5f;                                               \
      wv[e] = __expf(-__expf(wlog));                                                                \
      av[e] = fsigmoid(a0[e] + laf);                                                                \
      kkv[e] = k4[e] * kk_[e];                                                                      \
      n2 += kkv[e] * kkv[e];                                                                        \
    }                                                                                               \
    n2 = sum16(n2);                                                                                 \
    float inv = 1.f / fmaxf(sqrtf(n2), 1e-12f);                                                     \
    float bon = 0.f;                                                                                \
    float kt4[4], ap4[4], bp4[4];                                                                   \
    _Pragma("unroll") for (int e = 0; e < 4; ++e) {                                                 \
      float kkn = kkv[e] * inv;                                                                     \
      kt4[e] = k4[e] * (1.f + (av[e] - 1.f) * ka_[e]);                                              \
      ap4[e] = -kkn;                                                                                \
      bp4[e] = kkn * av[e];                                                                         \
      bon += r4[e] * kt4[e] * rk_[e];                                                               \
    }                                                                                               \
    bon = sum16(bon);                                                                               \
    *reinterpret_cast<float4*>(sR + st * 64 + c4) = float4{r4[0], r4[1], r4[2], r4[3]};             \
    *reinterpret_cast<float4*>(sW + st * 64 + c4) = float4{wv[0], wv[1], wv[2], wv[3]};             \
    *reinterpret_cast<float4*>(sK + st * 64 + c4) = float4{kt4[0], kt4[1], kt4[2], kt4[3]};         \
    *reinterpret_cast<float4*>(sA + st * 64 + c4) = float4{ap4[0], ap4[1], ap4[2], ap4[3]};         \
    *reinterpret_cast<float4*>(sBb + st * 64 + c4) = float4{bp4[0], bp4[1], bp4[2], bp4[3]};        \
    *reinterpret_cast<float4*>(sV + st * 64 + c4) = float4{vv[0], vv[1], vv[2], vv[3]};             \
    if ((tid & 15) == 0) sBonus[st] = bon;                                                          \
  }
  RW_LOAD(0);
  RW_PROCESS();
  __syncthreads();
  constexpr int NCH = SEQ / 16;
#pragma unroll 1
  for (int c = 0; c < NCH; ++c) {
    const int t0 = c * 16;
    const int tn = (c + 1 < NCH) ? t0 + 16 : t0;
    RW_LOAD(tn);
    __builtin_amdgcn_sched_barrier(0);
#pragma unroll 2
    for (int t = 0; t < 16; ++t) {
      const float4* a4p = reinterpret_cast<const float4*>(sA + t * 64 + kq * 8);
      const float4* w4p = reinterpret_cast<const float4*>(sW + t * 64 + kq * 8);
      const float4* b4p = reinterpret_cast<const float4*>(sBb + t * 64 + kq * 8);
      const float4* k4p = reinterpret_cast<const float4*>(sK + t * 64 + kq * 8);
      const float4* r4p = reinterpret_cast<const float4*>(sR + t * 64 + kq * 8);
      const float2 vv = *reinterpret_cast<const float2*>(sV + t * 64 + vrow);
      float sa0 = 0.f, sa1 = 0.f;
#pragma unroll
      for (int q = 0; q < 2; ++q) {
        float4 a = a4p[q];
        sa0 = fmaf(S0[q * 4 + 0], a.x, sa0); sa1 = fmaf(S1[q * 4 + 0], a.x, sa1);
        sa0 = fmaf(S0[q * 4 + 1], a.y, sa0); sa1 = fmaf(S1[q * 4 + 1], a.y, sa1);
        sa0 = fmaf(S0[q * 4 + 2], a.z, sa0); sa1 = fmaf(S1[q * 4 + 2], a.z, sa1);
        sa0 = fmaf(S0[q * 4 + 3], a.w, sa0); sa1 = fmaf(S1[q * 4 + 3], a.w, sa1);
      }
      sa0 = oct_sum(sa0); sa1 = oct_sum(sa1);
      float y0 = 0.f, y1 = 0.f;
#pragma unroll
      for (int q = 0; q < 2; ++q) {
        float4 ww = w4p[q], bb = b4p[q], kk = k4p[q], rr = r4p[q];
        S0[q * 4 + 0] = fmaf(S0[q * 4 + 0], ww.x, fmaf(sa0, bb.x, vv.x * kk.x)); y0 = fmaf(S0[q * 4 + 0], rr.x, y0);
        S1[q * 4 + 0] = fmaf(S1[q * 4 + 0], ww.x, fmaf(sa1, bb.x, vv.y * kk.x)); y1 = fmaf(S1[q * 4 + 0], rr.x, y1);
        S0[q * 4 + 1] = fmaf(S0[q * 4 + 1], ww.y, fmaf(sa0, bb.y, vv.x * kk.y)); y0 = fmaf(S0[q * 4 + 1], rr.y, y0);
        S1[q * 4 + 1] = fmaf(S1[q * 4 + 1], ww.y, fmaf(sa1, bb.y, vv.y * kk.y)); y1 = fmaf(S1[q * 4 + 1], rr.y, y1);
        S0[q * 4 + 2] = fmaf(S0[q * 4 + 2], ww.z, fmaf(sa0, bb.z, vv.x * kk.z)); y0 = fmaf(S0[q * 4 + 2], rr.z, y0);
        S1[q * 4 + 2] = fmaf(S1[q * 4 + 2], ww.z, fmaf(sa1, bb.z, vv.y * kk.z)); y1 = fmaf(S1[q * 4 + 2], rr.z, y1);
        S0[q * 4 + 3] = fmaf(S0[q * 4 + 3], ww.w, fmaf(sa0, bb.w, vv.x * kk.w)); y0 = fmaf(S0[q * 4 + 3], rr.w, y0);
        S1[q * 4 + 3] = fmaf(S1[q * 4 + 3], ww.w, fmaf(sa1, bb.w, vv.y * kk.w)); y1 = fmaf(S1[q * 4 + 3], rr.w, y1);
      }
      y0 = oct_sum(y0); y1 = oct_sum(y1);
      if (kq == 0) *reinterpret_cast<float2*>(sY + t * 64 + vrow) = float2{y0, y1};
    }
    __builtin_amdgcn_sched_barrier(0);
    __syncthreads();
    {
      float4 y4 = *reinterpret_cast<const float4*>(sY + st * 64 + c4);
      float4 v4 = *reinterpret_cast<const float4*>(sV + st * 64 + c4);
      float bon = sBonus[st];
      float mean = sum16(y4.x + y4.y + y4.z + y4.w) * (1.f / 64.f);
      float dx = y4.x - mean, dy = y4.y - mean, dz = y4.z - mean, dw = y4.w - mean;
      float var = sum16(dx * dx + dy * dy + dz * dz + dw * dw) * (1.f / 64.f);
      float rs = rsqrtf(var + 64e-5f);
      float o0 = dx * rs * lnw[0] + lnb[0] + bon * v4.x;
      float o1 = dy * rs * lnw[1] + lnb[1] + bon * v4.y;
      float o2 = dz * rs * lnw[2] + lnb[2] + bon * v4.z;
      float o3 = dw * rs * lnw[3] + lnb[3] + bon * v4.w;
      uint2 o;
      o.x = pack2(o0, o1); o.y = pack2(o2, o3);
      *reinterpret_cast<uint2*>(Z + (size_t)(t0 + st) * ZS + ZRW + 1024 + ch) = o;
    }
    RW_PROCESS();
    __syncthreads();
  }
#undef RW_LOAD
#undef RW_PROCESS
}

__device__ void phase_scans(const Params& p, int l, char* smem, int scan_mask = 15) {
  for (int t = blockIdx.x; t < 256; t += gridDim.x) {
    int type = t & 3, idx = t >> 2;
    if (!((scan_mask >> type) & 1)) continue;
#ifndef SCM
#define SCM 15
#endif
    if (type == 0) { if (SCM & 1) rw_scan(p, l, idx, smem); }
    else if (type == 1) { if (SCM & 2) hg_scan(p, l, idx, smem); }
    else if (type == 2) { if (SCM & 4) mb_scan(p, l, idx, smem); }
    else { if (SCM & 8) s5_scan(p, l, idx, smem); }
    __syncthreads();
  }
  if (l + 1 < 2) {
    const int tid = opaque_tid();
    const int nb = (gridDim.x > 256) ? (int)gridDim.x - 256 : (int)gridDim.x;
    const int b0 = (gridDim.x > 256) ? (int)blockIdx.x - 256 : (int)blockIdx.x;
    if (b0 >= 0)
      for (int c = b0; c < CT_TOTAL; c += nb) convert_one(p, l + 1, c, smem, tid);
  }
}

__device__ __forceinline__ void unpack8(const uint4& v, float (&f)[8]) {
  f[0] = bf2f((bf16_t)(v.x & 0xffff)); f[1] = bf2f((bf16_t)(v.x >> 16));
  f[2] = bf2f((bf16_t)(v.y & 0xffff)); f[3] = bf2f((bf16_t)(v.y >> 16));
  f[4] = bf2f((bf16_t)(v.z & 0xffff)); f[5] = bf2f((bf16_t)(v.z >> 16));
  f[6] = bf2f((bf16_t)(v.w & 0xffff)); f[7] = bf2f((bf16_t)(v.w >> 16));
}

__device__ void phase_post(const Params& p, int l, char* smem) {
  bf16_t* Z = (bf16_t*)(p.ws + OFF_Z);
  const int tid = opaque_tid(), lane = tid & 63, wid = tid >> 6;
  constexpr int N_ROWT = T_TOK / 4, N_RWT = T_TOK / 16, N_GLU = 128 * 4, N_NORM = T_TOK / 4;
  const float* xsrc = (l == 0) ? p.in[I_X] : p.out;
  for (int t = blockIdx.x; t < N_ROWT + N_RWT + N_GLU + N_NORM; t += gridDim.x) {
    if (t < N_ROWT) {
      const int row = t * 4 + wid;
      {
        bf16_t* op = Z + (size_t)row * ZS + ZHG + 1024 + lane * 8;
        uint4 ov = *reinterpret_cast<const uint4*>(op);
        uint4 gv = *reinterpret_cast<const uint4*>(op + 512);
        float o[8], g[8];
        unpack8(ov, o); unpack8(gv, g);
        float ss = 0.f;
#pragma unroll
        for (int e = 0; e < 8; ++e) ss += o[e] * o[e];
        ss = sum16(ss);
        float rstd = rsqrtf(ss * (1.f / 128.f) + 1e-6f);
        const float* nw = p.in[I_HG_NW] + l * 512 + lane * 8;
        float r[8];
#pragma unroll
        for (int e = 0; e < 8; ++e) r[e] = o[e] * rstd * nw[e] * siluf_(g[e]);
        *reinterpret_cast<uint4*>(op) = uint4{pack2(r[0], r[1]), pack2(r[2], r[3]), pack2(r[4], r[5]), pack2(r[6], r[7])};
      }
      {
        bf16_t* op = Z + (size_t)row * ZS + ZMB + lane * 8;
        uint4 ov = *reinterpret_cast<const uint4*>(op);
        float o[8];
        unpack8(ov, o);
        float ss = 0.f;
#pragma unroll
        for (int e = 0; e < 8; ++e) ss += o[e] * o[e];
        ss = sum64(ss);
        float rstd = rsqrtf(ss * (1.f / 512.f) + 1e-6f);
        const float* nw = p.in[I_MB_NW] + l * 512 + lane * 8;
        float r[8];
#pragma unroll
        for (int e = 0; e < 8; ++e) r[e] = o[e] * rstd * nw[e];
        *reinterpret_cast<uint4*>(op) = uint4{pack2(r[0], r[1]), pack2(r[2], r[3]), pack2(r[4], r[5]), pack2(r[6], r[7])};
      }
    } else if (t < N_ROWT + N_RWT) {
      const int row0 = (t - N_ROWT) * 16;
      float* sXg = reinterpret_cast<float*>(smem);
      const float* mu = p.in[I_RW_MU] + l * 1792 + 1664;
      for (int e = tid; e < 2048; e += 256) {
        int j = e >> 4, tok = e & 15;
        int row = row0 + tok, s = row & (SEQ - 1);
        sXg[j * 16 + tok] = sigmoidf_(rw_shift(Z, row, s, 1664 + j, mu[j]));
      }
      __syncthreads();
      float a0[16], a1[16];
      lora_mm<128>(sXg, p.in[I_RW_G2] + (size_t)l * 128 * 512, a0, a1, tid);
#pragma unroll
      for (int tok = 0; tok < 16; ++tok) {
        bf16_t* yp = Z + (size_t)(row0 + tok) * ZS + ZRW + 1024 + tid;
        yp[0] = f2bf(bf2f(yp[0]) * a0[tok]);
        yp[256] = f2bf(bf2f(yp[256]) * a1[tok]);
      }
      __syncthreads();
    } else if (t < N_ROWT + N_RWT + N_GLU) {
      const int tt = t - N_ROWT - N_RWT, mt = tt >> 2, nt = tt & 3;
      const int wm = wid >> 1, wn = wid & 1;
      f32x4 acc[4][4];
      zero_acc<128>(acc);
      gemm_mainloop<128>(acc, Z + ZS5, ZS, mt * 128, (const bf16_t*)(p.ws + WOFF(OFF_WTGLU, l)), 512, nt * 128, 511, 512, smem, tid);
      const float* bg = p.in[I_S5_BGLU] + l * 512;
#pragma unroll
      for (int mi = 0; mi < 4; ++mi)
#pragma unroll
        for (int ni = 0; ni < 4; ++ni) {
          int col = nt * 128 + wn * 64 + ni * 16 + (lane >> 4) * 4;
          int row = mt * 128 + wm * 64 + mi * 16 + (lane & 15);
          float4 b4 = *reinterpret_cast<const float4*>(bg + col);
          uint2 yv = *reinterpret_cast<const uint2*>(Z + (size_t)row * ZS + ZS5 + col);
          float y0 = bf2f((bf16_t)(yv.x & 0xffff)), y1 = bf2f((bf16_t)(yv.x >> 16));
          float y2 = bf2f((bf16_t)(yv.y & 0xffff)), y3 = bf2f((bf16_t)(yv.y >> 16));
          uint2 o;
          o.x = pack2(y0 * sigmoidf_(acc[mi][ni][0] + b4.x), y1 * sigmoidf_(acc[mi][ni][1] + b4.y));
          o.y = pack2(y2 * sigmoidf_(acc[mi][ni][2] + b4.z), y3 * sigmoidf_(acc[mi][ni][3] + b4.w));
          *reinterpret_cast<uint2*>(Z + (size_t)row * ZS + ZMB + 1024 + col) = o;
        }
    } else {
      const int row = (t - N_ROWT - N_RWT - N_GLU) * 4 + wid;
      rmsnorm_row_to_bf16(xsrc + (size_t)row * DM, p.in[I_NORM_MIX] + l * DM, (bf16_t*)(p.ws + OFF_U) + (size_t)row * DM, tid & 63);
    }
  }
}

__device__ void phase_merge(const Params& p, int l, char* smem) {
  bf16_t* Z = (bf16_t*)(p.ws + OFF_Z);
  const bf16_t* U = (const bf16_t*)(p.ws + OFF_U);
  const bf16_t* Wg = (const bf16_t*)(p.ws + WOFF_GATE(l));
  const bf16_t* Wb = (const bf16_t*)(p.ws + WOFF(OFF_WTBR, l));
  const int tid = opaque_tid();
  const int lane = tid & 63, wid = tid >> 6, wm = wid >> 1, wn = wid & 1;
  for (int t = blockIdx.x; t < tile_count(128, 16); t += gridDim.x) {
    int mt, nt;
    if (!tile_map(t, 16, mt, nt)) continue;
    f32x4 accm[4][2];
    zero_acc<64>(accm);
    for (int kb = 0; kb < 4; ++kb) {
      f32x4 g[4][2], pr[4][2];
      zero_acc<64>(g);
      zero_acc<64>(pr);
      gemm_mainloop<64>(g, U, 1024, mt * 128, Wg + (size_t)kb * 1024 * 1024, 1024, nt * 64, 1023, 1024, smem, tid);
      const int ycol = (kb == 0) ? (ZHG + 1024) : (kb == 1) ? (ZRW + 1024) : (kb == 2) ? (ZMB + 1024) : ZMB;
      gemm_mainloop<64>(pr, Z + ycol, ZS, mt * 128, Wb + (size_t)kb * 1024 * 512, 512, nt * 64, 1023, 512, smem, tid);
#pragma unroll
      for (int mi = 0; mi < 4; ++mi)
#pragma unroll
        for (int ni = 0; ni < 2; ++ni)
#pragma unroll
          for (int j = 0; j < 4; ++j) accm[mi][ni][j] = fmaf(sigmoidf_(g[mi][ni][j]), pr[mi][ni][j], accm[mi][ni][j]);
    }
#pragma unroll
    for (int mi = 0; mi < 4; ++mi)
#pragma unroll
      for (int ni = 0; ni < 2; ++ni) {
        int col = nt * 64 + wn * 32 + ni * 16 + (lane >> 4) * 4;
        int row = mt * 128 + wm * 64 + mi * 16 + (lane & 15);
        uint2 o;
        o.x = pack2(accm[mi][ni][0], accm[mi][ni][1]);
        o.y = pack2(accm[mi][ni][2], accm[mi][ni][3]);
        *reinterpret_cast<uint2*>(Z + (size_t)row * ZS + col) = o;
      }
  }
}

__device__ void phase_resid_gemm(const Params& p, const bf16_t* A, int lda, const bf16_t* Wt, int K, const float* xold, char* smem) {
  const int tid = opaque_tid();
  const int lane = tid & 63, wid = tid >> 6, wm = wid >> 1, wn = wid & 1;
  for (int t = blockIdx.x; t < tile_count(64, 8); t += gridDim.x) {
    int mt, nt;
    if (!tile_map(t, 8, mt, nt)) continue;
    f32x4 acc[8][4];
    zero_acc_big(acc);
    gemm_mainloop_big(acc, A, lda, mt * 256, Wt, K, nt * 128, 1023, K, smem, tid);
#pragma unroll
    for (int mi = 0; mi < 8; ++mi)
#pragma unroll
      for (int ni = 0; ni < 4; ++ni) {
        int col = nt * 128 + wn * 64 + ni * 16 + (lane >> 4) * 4;
        int row = mt * 256 + wm * 128 + mi * 16 + (lane & 15);
        size_t o = (size_t)row * DM + col;
        float4 xo = *reinterpret_cast<const float4*>(xold + o);
        float4 r = float4{xo.x + acc[mi][ni][0], xo.y + acc[mi][ni][1], xo.z + acc[mi][ni][2], xo.w + acc[mi][ni][3]};
        *reinterpret_cast<float4*>(p.out + o) = r;
      }
  }
}

__device__ void phase_ffn_in(const Params& p, int l, char* smem) {
  const bf16_t* U = (const bf16_t*)(p.ws + OFF_U);
  const bf16_t* Wt = (const bf16_t*)(p.ws + WOFF(OFF_WTF1, l));
  bf16_t* H = (bf16_t*)(p.ws + OFF_Z);
  const int tid = opaque_tid();
  const int lane = tid & 63, wid = tid >> 6, wm = wid >> 1, wn = wid & 1;
  for (int t = blockIdx.x; t < tile_count(64, 44); t += gridDim.x) {
    int mt, nt;
    if (!tile_map(t, 44, mt, nt)) continue;
    f32x4 acc[8][4];
    zero_acc_big(acc);
    gemm_mainloop_big(acc, U, 1024, mt * 256, Wt, 1024, nt * 128, 5631, 1024, smem, tid);
#pragma unroll
    for (int mi = 0; mi < 8; ++mi)
#pragma unroll
      for (int q = 0; q < 2; ++q) {
        int hcol = ((nt * 128 + wn * 64 + q * 32) >> 1) + (lane >> 4) * 4;
        int row = mt * 256 + wm * 128 + mi * 16 + (lane & 15);
        uint2 o;
        o.x = pack2(fsilu(acc[mi][2 * q][0]) * acc[mi][2 * q + 1][0], fsilu(acc[mi][2 * q][1]) * acc[mi][2 * q + 1][1]);
        o.y = pack2(fsilu(acc[mi][2 * q][2]) * acc[mi][2 * q + 1][2], fsilu(acc[mi][2 * q][3]) * acc[mi][2 * q + 1][3]);
        *reinterpret_cast<uint2*>(H + (size_t)row * FFH + hcol) = o;
      }
  }
}

__device__ void phase_final(const Params& p) {
  const int tid = opaque_tid();
  const int lane = tid & 63;
  const float* w = p.in[I_NORM_FINAL];
  for (int t = blockIdx.x; t < T_TOK / 4; t += gridDim.x) {
    int row = t * 4 + (tid >> 6);
    float* x = p.out + (size_t)row * DM;
    float4 v[4];
    float ss = 0.f;
#pragma unroll
    for (int i = 0; i < 4; ++i) {
      v[i] = *reinterpret_cast<const float4*>(x + i * 256 + lane * 4);
      ss += v[i].x * v[i].x + v[i].y * v[i].y + v[i].z * v[i].z + v[i].w * v[i].w;
    }
    ss = sum64(ss);
    float rstd = rsqrtf(ss * (1.f / 1024.f) + 1e-6f);
#pragma unroll
    for (int i = 0; i < 4; ++i) {
      float4 ww = *reinterpret_cast<const float4*>(w + i * 256 + lane * 4);
      float4 o = float4{v[i].x * rstd * ww.x, v[i].y * rstd * ww.y, v[i].z * rstd * ww.z, v[i].w * rstd * ww.w};
      *reinterpret_cast<float4*>(x + i * 256 + lane * 4) = o;
    }
  }
}

template <int SUB>
__device__ __forceinline__ void run_phase(const Params& p, int l, char* smem) {
  if (SUB == 0) phase_convert_norm(p, l, smem);
  else if (SUB == 1) phase_inproj(p, smem);
  else if (SUB == 2) phase_rwprep(p, l, smem);
  else if (SUB == 3) phase_scans(p, l, smem);
  else if (SUB == 4) phase_post(p, l, smem);
  else if (SUB == 5) phase_merge(p, l, smem);
  else if (SUB == 6) phase_resid_gemm(p, (const bf16_t*)(p.ws + OFF_Z), ZS, (const bf16_t*)(p.ws + WOFF(OFF_WTOUT, l)), 1024,
                                      (l == 0) ? p.in[I_X] : p.out, smem);
  else if (SUB == 7) phase_norm_only(p, p.out, p.in[I_NORM_FFN] + l * DM);
  else if (SUB == 8) phase_ffn_in(p, l, smem);
  else if (SUB == 9) phase_resid_gemm(p, (const bf16_t*)(p.ws + OFF_Z), FFH, (const bf16_t*)(p.ws + WOFF(OFF_WTF2, l)), FFH, p.out, smem);
  else phase_final(p);
}

#ifndef PHM
#define PHM 0xFFFF
#endif
__device__ __forceinline__ void grid_bar(unsigned* ctr, unsigned& target) {
  asm volatile("s_waitcnt vmcnt(0)" ::: "memory");
  __syncthreads();
  if (threadIdx.x == 0) {
    target += gridDim.x;
    __builtin_amdgcn_fence(__ATOMIC_RELEASE, "agent");
    __hip_atomic_fetch_add(ctr, 1u, __ATOMIC_RELAXED, __HIP_MEMORY_SCOPE_AGENT);
    while (__hip_atomic_load(ctr, __ATOMIC_RELAXED, __HIP_MEMORY_SCOPE_AGENT) < target) __builtin_amdgcn_s_sleep(32);
    __builtin_amdgcn_fence(__ATOMIC_ACQUIRE, "agent");
    asm volatile("s_waitcnt vmcnt(0)" ::: "memory");
  }
  __syncthreads();
}

#if COOP
__global__ void __launch_bounds__(256, 2) fwd_kernel(Params p, int ph0, int ph1, int scan_mask) {
  __shared__ __attribute__((aligned(16))) char smem[65536];
  cg::grid_group grid = cg::this_grid();
  unsigned* bar_ctr = reinterpret_cast<unsigned*>(p.ws + OFF_BAR);
  unsigned bar_target = 0;
  for (int ph = ph0; ph < ph1; ++ph) {
    if (ph == NPHASES - 1) {
      phase_final(p);
    } else {
      const int l = ph / NPH_LAYER, sub = ph % NPH_LAYER;
      switch (sub) {
        case 0: if (PHM & (1<<0)) run_phase<0>(p, l, smem); break;
        case 1: if (PHM & (1<<1)) run_phase<1>(p, l, smem); break;
        case 2: if (PHM & (1<<2)) run_phase<2>(p, l, smem); break;
        case 3: if (PHM & (1<<3)) phase_scans(p, l, smem, scan_mask); break;
        case 4: if (PHM & (1<<4)) run_phase<4>(p, l, smem); break;
        case 5: if (PHM & (1<<5)) run_phase<5>(p, l, smem); break;
        case 6: if (PHM & (1<<6)) run_phase<6>(p, l, smem); break;
        case 7: if (PHM & (1<<7)) run_phase<7>(p, l, smem); break;
        case 8: if (PHM & (1<<8)) run_phase<8>(p, l, smem); break;
        case 9: if (PHM & (1<<9)) run_phase<9>(p, l, smem); break;
      }
    }
    if (ph + 1 < ph1) {
      if (ph == ph0) grid.sync();
      else grid_bar(bar_ctr, bar_target);
    }
  }
}
#else
template <int SUB>
__global__ void __launch_bounds__(256, 2) k_phase(Params p, int l) {
  __shared__ __attribute__((aligned(16))) char smem[65536];
  run_phase<SUB>(p, l, smem);
}
#endif

extern "C" void kernel_launch(void* const* d_in, const int* in_sizes, int n_in, void* d_out, int out_size, void* d_ws,
                              size_t ws_size, hipStream_t stream) {
  if (n_in < 41 || ws_size < WS_NEED) {
    fprintf(stderr, "kernel_launch: bad args n_in=%d ws=%zu need=%zu\n", n_in, ws_size, (size_t)WS_NEED);
    return;
  }
  Params p{};
  for (int i = 0; i < 41; ++i) p.in[i] = (const float*)d_in[i];
  p.out = (float*)d_out;
  p.ws = (char*)d_ws;
#if COOP
  static int grid_blocks = 0;
  if (!grid_blocks) {
    int dev = 0, cus = 0, per_cu = 0;
    hipGetDevice(&dev);
    hipDeviceGetAttribute(&cus, hipDeviceAttributeMultiprocessorCount, dev);
    hipOccupancyMaxActiveBlocksPerMultiprocessor(&per_cu, fwd_kernel, 256, 0);
    if (per_cu > 2) per_cu = 2;
    grid_blocks = cus * per_cu;
  }
#ifdef HYBRID
  for (int ph = 0; ph < NPHASES; ++ph) {
    if (ph % 10 == 3 && ph < 20) {
      const int groups[4] = SCAN_GROUPS;
      for (int gi = 0; gi < 4; ++gi) if (groups[gi]) fwd_kernel<<<grid_blocks, 256, 0, stream>>>(p, ph, ph + 1, groups[gi]);
    } else {
      fwd_kernel<<<grid_blocks, 256, 0, stream>>>(p, ph, ph + 1, 15);
    }
  }
#else
  hipMemsetAsync((char*)d_ws + OFF_BAR, 0, 256, stream);
  int ph0 = 0, ph1 = NPHASES, smask = 15;
  void* args[] = {&p, &ph0, &ph1, &smask};
  hipError_t e = hipLaunchCooperativeKernel((void*)fwd_kernel, dim3(grid_blocks), dim3(256), args, 0, stream);
  if (e != hipSuccess) fprintf(stderr, "cooperative launch failed: %s (grid %d)\n", hipGetErrorString(e), grid_blocks);
#endif
#else
  const dim3 g(512), b(256);
  for (int l = 0; l < 2; ++l) {
    k_phase<0><<<g, b, 0, stream>>>(p, l);
    k_phase<1><<<g, b, 0, stream>>>(p, l);
    k_phase<2><<<g, b, 0, stream>>>(p, l);
    k_phase<3><<<g, b, 0, stream>>>(p, l);
    k_phase<4><<<g, b, 0, stream>>>(p, l);
    k_phase<5><<<g, b, 0, stream>>>(p, l);
    k_phase<6><<<g, b, 0, stream>>>(p, l);
    k_phase<7><<<g, b, 0, stream>>>(p, l);
    k_phase<8><<<g, b, 0, stream>>>(p, l);
    k_phase<9><<<g, b, 0, stream>>>(p, l);
  }
  k_phase<10><<<g, b, 0, stream>>>(p, 0);
#endif
}
```

```cpp
#include <hip/hip_runtime.h>
#include <hip/hip_cooperative_groups.h>
#include <cstdio>
#include <cstdint>
namespace cg = cooperative_groups;

#ifndef COOP
#define COOP 1
#endif

typedef unsigned short bf16_t;
typedef __attribute__((ext_vector_type(8))) short bf16x8;
typedef __attribute__((ext_vector_type(4))) float f32x4;
typedef __attribute__((ext_vector_type(4))) unsigned u32x4;

constexpr int T_TOK = 16384, SEQ = 2048, DM = 1024;
constexpr int IN_COLS = 9992, NZ = 5896, ZS = 5904;
constexpr int ZHG = 0, ZRW = 2048, ZS5 = 3840, ZMB = 4352;
constexpr int FFH = 2816;
constexpr int NPH_LAYER = 10, NPHASES = 21;

constexpr size_t OFF_WTIN   = 0;
constexpr size_t OFF_WTGATE = OFF_WTIN + (size_t)5896 * 1024 * 2;
constexpr size_t OFF_WTBR   = OFF_WTGATE + (size_t)4096 * 1024 * 2;
constexpr size_t OFF_WTOUT  = OFF_WTBR + (size_t)4 * 1024 * 512 * 2;
constexpr size_t OFF_WTF1   = OFF_WTOUT + (size_t)1024 * 1024 * 2;
constexpr size_t OFF_WTF2   = OFF_WTF1 + (size_t)5632 * 1024 * 2;
constexpr size_t OFF_WTGLU  = OFF_WTF2 + (size_t)1024 * 2816 * 2;
constexpr size_t OFF_U      = OFF_WTGLU + (size_t)512 * 512 * 2;
constexpr size_t OFF_Z      = OFF_U + (size_t)T_TOK * 1024 * 2;
constexpr size_t OFF_VF     = OFF_Z + (size_t)T_TOK * ZS * 2;
constexpr size_t OFF_BAR    = OFF_VF + (size_t)T_TOK * 512 * 2;
constexpr size_t OFF_WTGATE_B = OFF_BAR + 16384;
constexpr size_t OFF_WB_B     = OFF_WTGATE_B + (size_t)4096 * 1024 * 2;
constexpr size_t WS_NEED      = OFF_WB_B + (OFF_U - OFF_WTBR);
constexpr size_t DELTA_GATE   = OFF_WTGATE_B - OFF_WTGATE;
constexpr size_t DELTA_WB     = OFF_WB_B - OFF_WTBR;
#define WOFF_GATE(l) (OFF_WTGATE + (size_t)(l) * DELTA_GATE)
#define WOFF(off, l) ((off) + (size_t)(l) * DELTA_WB)

struct Params {
  const float* in[41];
  float* out;
  char* ws;
};

enum { I_X = 0, I_NORM_MIX, I_W_IN, I_W_BRANCH, I_W_OUT, I_NORM_FFN, I_W_FFN_IN, I_W_FFN_OUT, I_NORM_FINAL,
       I_HG_LB, I_HG_NW, I_RW_MU, I_RW_W0, I_RW_W2, I_RW_A0, I_RW_A2, I_RW_G2, I_RW_KK, I_RW_KA, I_RW_RK,
       I_RW_LNW, I_RW_LNB, I_RW_V0, I_RW_V1, I_RW_V2, I_S5_ARE, I_S5_AIM, I_S5_BRE, I_S5_BIM, I_S5_CRE,
       I_S5_CIM, I_S5_D, I_S5_LOGDT, I_S5_WGLU, I_S5_BGLU, I_MB_CONVW, I_MB_CONVB, I_MB_DTB, I_MB_ALOG,
       I_MB_D, I_MB_NW };

__device__ __forceinline__ float bf2f(bf16_t v) { return __uint_as_float(((unsigned)v) << 16); }
typedef __attribute__((ext_vector_type(2))) __bf16 bf16x2_t;
__device__ __forceinline__ unsigned pack2(float a, float b) {
  bf16x2_t v;
  v[0] = (__bf16)a;
  v[1] = (__bf16)b;
  return __builtin_bit_cast(unsigned, v);
}
__device__ __forceinline__ bf16_t f2bf(float f) { return (bf16_t)(pack2(f, 0.f) & 0xffffu); }
__device__ __forceinline__ float sigmoidf_(float x) { return 1.f / (1.f + __expf(-x)); }
__device__ __forceinline__ float siluf_(float x) { return x / (1.f + __expf(-x)); }
__device__ __forceinline__ float softplusf_(float x) { return x > 20.f ? x : log1pf(__expf(x)); }
__device__ __forceinline__ float gelu_tanh(float x) {
  float u = 0.7978845608028654f * (x + 0.044715f * x * x * x);
  return 0.5f * x * (1.f + tanhf(u));
}
__device__ __forceinline__ float quad_sum(float x) {
  x += __builtin_bit_cast(float, __builtin_amdgcn_update_dpp(0, __builtin_bit_cast(int, x), 0xB1, 0xF, 0xF, true));
  x += __builtin_bit_cast(float, __builtin_amdgcn_update_dpp(0, __builtin_bit_cast(int, x), 0x4E, 0xF, 0xF, true));
  return x;
}
__device__ __forceinline__ float oct_sum(float x) {
  x = quad_sum(x);
  x += __builtin_bit_cast(float, __builtin_amdgcn_update_dpp(0, __builtin_bit_cast(int, x), 0x141, 0xF, 0xF, true));
  return x;
}
__device__ __forceinline__ float sum16(float x) {
  x += __shfl_xor(x, 1); x += __shfl_xor(x, 2); x += __shfl_xor(x, 4); x += __shfl_xor(x, 8);
  return x;
}
__device__ __forceinline__ float sum64(float x) {
  x = sum16(x); x += __shfl_xor(x, 16); x += __shfl_xor(x, 32);
  return x;
}

__device__ __forceinline__ int opaque_tid() {
  int t = threadIdx.x;
  asm volatile("" : "+v"(t));
  return t;
}

template <int BN>
__device__ __forceinline__ void gemm_mainloop(f32x4 (&acc)[4][BN / 32], const bf16_t* A, int lda, int m0,
                                              const bf16_t* Bt, int ldb, int n0, int nmax, int K, char* smem, const int tid) {
  const int lane = tid & 63, wid = tid >> 6, wm = wid >> 1, wn = wid & 1;
  const int q = tid & 7, r0 = tid >> 3;
  unsigned offA[4], offB[BN / 32];
#pragma unroll
  for (int i = 0; i < 4; ++i) offA[i] = ((unsigned)(m0 + r0 + 32 * i) * (unsigned)lda + (unsigned)q * 8u) * 2u;
#pragma unroll
  for (int i = 0; i < BN / 32; ++i) {
    int row = n0 + r0 + 32 * i;
    row = row < nmax ? row : nmax;
    offB[i] = ((unsigned)row * (unsigned)ldb + (unsigned)q * 8u) * 2u;
  }
  const unsigned sto = (unsigned)r0 * 128u + (unsigned)((q ^ ((r0 >> 1) & 7)) << 4);
  unsigned aoff[4], boff[BN / 32];
#pragma unroll
  for (int mi = 0; mi < 4; ++mi) {
    int row = wm * 64 + mi * 16 + (lane & 15);
    aoff[mi] = (unsigned)row * 128u + (unsigned)(((lane >> 4) ^ ((row >> 1) & 7)) << 4);
  }
#pragma unroll
  for (int ni = 0; ni < BN / 32; ++ni) {
    int row = wn * (BN / 2) + ni * 16 + (lane & 15);
    boff[ni] = (unsigned)row * 128u + (unsigned)(((lane >> 4) ^ ((row >> 1) & 7)) << 4);
  }
  const char* Ab = reinterpret_cast<const char*>(A);
  const char* Bb = reinterpret_cast<const char*>(Bt);
  const int nk = K >> 6;
  constexpr bool WIDE = (BN == 128);
  u32x4 Ra0, Ra1, Ra2, Ra3, Rb0, Rb1, Rb2, Rb3;
  u32x4 Qa0, Qa1, Qa2, Qa3, Qb0, Qb1, Qb2, Qb3;
#define GLOAD(P, TILE)                                                         \
  {                                                                            \
    const char* Ak_ = Ab + (size_t)(TILE) * 128;                               \
    const char* Bk_ = Bb + (size_t)(TILE) * 128;                               \
    P##a0 = *reinterpret_cast<const u32x4*>(Ak_ + offA[0]);                    \
    P##a1 = *reinterpret_cast<const u32x4*>(Ak_ + offA[1]);                    \
    P##a2 = *reinterpret_cast<const u32x4*>(Ak_ + offA[2]);                    \
    P##a3 = *reinterpret_cast<const u32x4*>(Ak_ + offA[3]);                    \
    P##b0 = *reinterpret_cast<const u32x4*>(Bk_ + offB[0]);                    \
    P##b1 = *reinterpret_cast<const u32x4*>(Bk_ + offB[1]);                    \
    if (WIDE) {                                                                \
      P##b2 = *reinterpret_cast<const u32x4*>(Bk_ + offB[BN / 32 - 2]);        \
      P##b3 = *reinterpret_cast<const u32x4*>(Bk_ + offB[BN / 32 - 1]);        \
    }                                                                          \
  }
#define SSTORE(P, BUF)                                                         \
  {                                                                            \
    char* ad_ = smem + (BUF) * 16384 + sto;                                    \
    char* bd_ = smem + 32768 + (BUF) * (BN * 128) + sto;                       \
    *reinterpret_cast<u32x4*>(ad_) = P##a0;                                    \
    *reinterpret_cast<u32x4*>(ad_ + 4096) = P##a1;                             \
    *reinterpret_cast<u32x4*>(ad_ + 8192) = P##a2;                             \
    *reinterpret_cast<u32x4*>(ad_ + 12288) = P##a3;                            \
    *reinterpret_cast<u32x4*>(bd_) = P##b0;                                    \
    *reinterpret_cast<u32x4*>(bd_ + 4096) = P##b1;                             \
    if (WIDE) {                                                                \
      *reinterpret_cast<u32x4*>(bd_ + 8192) = P##b2;                           \
      *reinterpret_cast<u32x4*>(bd_ + 12288) = P##b3;                          \
    }                                                                          \
  }
#define COMPUTE(BUF)                                                           \
  {                                                                            \
    const char* a_s = smem + (BUF) * 16384;                                    \
    const char* b_s = smem + 32768 + (BUF) * (BN * 128);                       \
    _Pragma("unroll") for (int ks = 0; ks < 2; ++ks) {                         \
      bf16x8 af[4], bfr[BN / 32];                                              \
      _Pragma("unroll") for (int mi = 0; mi < 4; ++mi)                         \
          af[mi] = *reinterpret_cast<const bf16x8*>(a_s + (aoff[mi] ^ (ks * 64)));       \
      _Pragma("unroll") for (int ni = 0; ni < BN / 32; ++ni)                   \
          bfr[ni] = *reinterpret_cast<const bf16x8*>(b_s + (boff[ni] ^ (ks * 64)));      \
      _Pragma("unroll") for (int mi = 0; mi < 4; ++mi)                         \
        _Pragma("unroll") for (int ni = 0; ni < BN / 32; ++ni)                 \
          acc[mi][ni] = __builtin_amdgcn_mfma_f32_16x16x32_bf16(bfr[ni], af[mi], acc[mi][ni], 0, 0, 0); \
    }                                                                          \
  }
  if constexpr (WIDE) {
    GLOAD(R, 0);
    SSTORE(R, 0);
    GLOAD(R, 1);
    if (nk > 2) GLOAD(Q, 2);
    __syncthreads();
#pragma unroll 1
    for (int kt = 0; kt < nk; kt += 2) {
      __builtin_amdgcn_sched_barrier(0);
      COMPUTE(0);
      __builtin_amdgcn_sched_barrier(0);
      SSTORE(R, 1);
      if (kt + 3 < nk) GLOAD(R, kt + 3);
      __syncthreads();
      __builtin_amdgcn_sched_barrier(0);
      COMPUTE(1);
      __builtin_amdgcn_sched_barrier(0);
      if (kt + 2 < nk) SSTORE(Q, 0);
      if (kt + 4 < nk) GLOAD(Q, kt + 4);
      __syncthreads();
    }
  } else {
    GLOAD(R, 0);
    SSTORE(R, 0);
    __syncthreads();
#pragma unroll 1
    for (int kt = 0; kt < nk; ++kt) {
      const int buf = kt & 1;
      const bool more = (kt + 1 < nk);
      if (more) GLOAD(R, kt + 1);
      __builtin_amdgcn_sched_barrier(0);
      COMPUTE(buf);
      __builtin_amdgcn_sched_barrier(0);
      if (more) SSTORE(R, buf ^ 1);
      __syncthreads();
    }
  }
#undef GLOAD
#undef SSTORE
#undef COMPUTE
}

template <int BN>
__device__ __forceinline__ void zero_acc(f32x4 (&acc)[4][BN / 32]) {
#pragma unroll
  for (int mi = 0; mi < 4; ++mi)
#pragma unroll
    for (int ni = 0; ni < BN / 32; ++ni) acc[mi][ni] = f32x4{0.f, 0.f, 0.f, 0.f};
}

__device__ __forceinline__ void gemm_mainloop_big(f32x4 (&acc)[8][4], const bf16_t* A, int lda, int m0, const bf16_t* Bt,
                                                  int ldb, int n0, int nmax, int K, char* smem, const int tid) {
  const int lane = tid & 63, wid = tid >> 6, wm = wid >> 1, wn = wid & 1;
  const int q = tid & 3, r0 = tid >> 2;
  unsigned offA[4], offB[2];
#pragma unroll
  for (int i = 0; i < 4; ++i) offA[i] = ((unsigned)(m0 + r0 + 64 * i) * (unsigned)lda + (unsigned)q * 8u) * 2u;
#pragma unroll
  for (int i = 0; i < 2; ++i) {
    int row = n0 + r0 + 64 * i;
    row = row < nmax ? row : nmax;
    offB[i] = ((unsigned)row * (unsigned)ldb + (unsigned)q * 8u) * 2u;
  }
  const unsigned sto = (unsigned)r0 * 64u + (unsigned)((q ^ ((r0 >> 2) & 3)) << 4);
  unsigned aoff[8], boff[4];
#pragma unroll
  for (int mi = 0; mi < 8; ++mi) {
    int row = wm * 128 + mi * 16 + (lane & 15);
    aoff[mi] = (unsigned)row * 64u + (unsigned)(((lane >> 4) ^ ((row >> 2) & 3)) << 4);
  }
#pragma unroll
  for (int ni = 0; ni < 4; ++ni) {
    int row = wn * 64 + ni * 16 + (lane & 15);
    boff[ni] = (unsigned)row * 64u + (unsigned)(((lane >> 4) ^ ((row >> 2) & 3)) << 4);
  }
  const char* Ab = reinterpret_cast<const char*>(A);
  const char* Bb = reinterpret_cast<const char*>(Bt);
  const int nk = K >> 5;
  u32x4 Ra0, Ra1, Ra2, Ra3, Rb0, Rb1;
#define BG_LOAD(TILE)                                                  \
  {                                                                    \
    const char* Ak_ = Ab + (size_t)(TILE) * 64;                        \
    const char* Bk_ = Bb + (size_t)(TILE) * 64;                        \
    Ra0 = *reinterpret_cast<const u32x4*>(Ak_ + offA[0]);              \
    Ra1 = *reinterpret_cast<const u32x4*>(Ak_ + offA[1]);              \
    Ra2 = *reinterpret_cast<const u32x4*>(Ak_ + offA[2]);              \
    Ra3 = *reinterpret_cast<const u32x4*>(Ak_ + offA[3]);              \
    Rb0 = *reinterpret_cast<const u32x4*>(Bk_ + offB[0]);              \
    Rb1 = *reinterpret_cast<const u32x4*>(Bk_ + offB[1]);              \
  }
#define BG_STORE(BUF)                                                  \
  {                                                                    \
    char* ad_ = smem + (BUF) * 16384 + sto;                            \
    char* bd_ = smem + 32768 + (BUF) * 8192 + sto;                     \
    *reinterpret_cast<u32x4*>(ad_) = Ra0;                              \
    *reinterpret_cast<u32x4*>(ad_ + 4096) = Ra1;                       \
    *reinterpret_cast<u32x4*>(ad_ + 8192) = Ra2;                       \
    *reinterpret_cast<u32x4*>(ad_ + 12288) = Ra3;                      \
    *reinterpret_cast<u32x4*>(bd_) = Rb0;                              \
    *reinterpret_cast<u32x4*>(bd_ + 4096) = Rb1;                       \
  }
  BG_LOAD(0);
  BG_STORE(0);
  __syncthreads();
#pragma unroll 1
  for (int kt = 0; kt < nk; ++kt) {
    const int buf = kt & 1;
    const bool more = (kt + 1 < nk);
    if (more) BG_LOAD(kt + 1);
    __builtin_amdgcn_sched_barrier(0);
    {
      const char* a_s = smem + buf * 16384;
      const char* b_s = smem + 32768 + buf * 8192;
      bf16x8 bfr[4], af[8];
#pragma unroll
      for (int ni = 0; ni < 4; ++ni) bfr[ni] = *reinterpret_cast<const bf16x8*>(b_s + boff[ni]);
#pragma unroll
      for (int mi = 0; mi < 8; ++mi) af[mi] = *reinterpret_cast<const bf16x8*>(a_s + aoff[mi]);
      __builtin_amdgcn_sched_barrier(0);
#pragma unroll
      for (int mi = 0; mi < 8; ++mi)
#pragma unroll
        for (int ni = 0; ni < 4; ++ni)
          acc[mi][ni] = __builtin_amdgcn_mfma_f32_16x16x32_bf16(bfr[ni], af[mi], acc[mi][ni], 0, 0, 0);
    }
    __builtin_amdgcn_sched_barrier(0);
    if (more) BG_STORE(buf ^ 1);
    __syncthreads();
  }
#undef BG_LOAD
#undef BG_STORE
}

__device__ __forceinline__ void zero_acc_big(f32x4 (&acc)[8][4]) {
#pragma unroll
  for (int mi = 0; mi < 8; ++mi)
#pragma unroll
    for (int ni = 0; ni < 4; ++ni) acc[mi][ni] = f32x4{0.f, 0.f, 0.f, 0.f};
}

__device__ __forceinline__ void conv_tile(const float* src, int ld, int nlimit, int k0, int n0, bf16_t* dst, int Kd, int mode,
                                          char* smem, const int tid) {
  float* sT = reinterpret_cast<float*>(smem);
#pragma unroll
  for (int i = 0; i < 16; ++i) {
    int kk = i * 4 + (tid >> 6), nn = tid & 63;
    float v = (n0 + nn < nlimit) ? src[(size_t)(k0 + kk) * ld + n0 + nn] : 0.f;
    sT[kk * 65 + nn] = v;
  }
  __syncthreads();
  {
    int nn = tid >> 2, kq = tid & 3;
    int n = n0 + nn;
    if (n < nlimit) {
      int drow = n;
      if (mode == 1) {
        if (n < FFH) drow = (n >> 4) * 32 + (n & 15);
        else { int j = n - FFH; drow = (j >> 4) * 32 + 16 + (j & 15); }
      }
      unsigned pk[8];
#pragma unroll
      for (int j = 0; j < 8; ++j) pk[j] = pack2(sT[(kq * 16 + 2 * j) * 65 + nn], sT[(kq * 16 + 2 * j + 1) * 65 + nn]);
      uint4* d = reinterpret_cast<uint4*>(dst + (size_t)drow * Kd + k0 + kq * 16);
      d[0] = uint4{pk[0], pk[1], pk[2], pk[3]};
      d[1] = uint4{pk[4], pk[5], pk[6], pk[7]};
    }
  }
  __syncthreads();
}

__device__ __forceinline__ void rmsnorm_row_to_bf16(const float* x, const float* w, bf16_t* out, const int lane) {
  float4 v[4];
  float ss = 0.f;
#pragma unroll
  for (int i = 0; i < 4; ++i) {
    v[i] = *reinterpret_cast<const float4*>(x + i * 256 + lane * 4);
    ss += v[i].x * v[i].x + v[i].y * v[i].y + v[i].z * v[i].z + v[i].w * v[i].w;
  }
  ss = sum64(ss);
  float rstd = rsqrtf(ss * (1.f / 1024.f) + 1e-6f);
#pragma unroll
  for (int i = 0; i < 4; ++i) {
    float4 ww = *reinterpret_cast<const float4*>(w + i * 256 + lane * 4);
    uint2 o;
    o.x = pack2(v[i].x * rstd * ww.x, v[i].y * rstd * ww.y);
    o.y = pack2(v[i].z * rstd * ww.z, v[i].w * rstd * ww.w);
    *reinterpret_cast<uint2*>(out + i * 256 + lane * 4) = o;
  }
}

constexpr int CT_IN = 157 * 16, CT_BR = 512, CT_OUT = 256, CT_F1 = 88 * 16, CT_F2 = 44 * 16, CT_GLU = 64;
constexpr int CT_TOTAL = CT_IN + CT_BR + CT_OUT + CT_F1 + CT_F2 + CT_GLU;

__device__ __forceinline__ void convert_one(const Params& p, int l, int c, char* smem, const int tid) {
  char* ws = p.ws;
  if (c < CT_IN) {
    int nt = c >> 4, kt = c & 15;
    const float* src = p.in[I_W_IN] + (size_t)l * 1024 * IN_COLS;
    if (nt < 64) conv_tile(src, IN_COLS, IN_COLS, kt * 64, nt * 64, (bf16_t*)(ws + WOFF_GATE(l)), 1024, 0, smem, tid);
    else conv_tile(src + 4096, IN_COLS, IN_COLS - 4096, kt * 64, (nt - 64) * 64, (bf16_t*)(ws + OFF_WTIN), 1024, 0, smem, tid);
    return;
  }
  c -= CT_IN;
  if (c < CT_BR) {
    int kb = c >> 7, r = c & 127, nt = r >> 3, kt = r & 7;
    const float* src = p.in[I_W_BRANCH] + ((size_t)l * 4 + kb) * 512 * 1024;
    conv_tile(src, 1024, 1024, kt * 64, nt * 64, (bf16_t*)(ws + WOFF(OFF_WTBR, l)) + (size_t)kb * 1024 * 512, 512, 0, smem, tid);
    return;
  }
  c -= CT_BR;
  if (c < CT_OUT) {
    int nt = c >> 4, kt = c & 15;
    conv_tile(p.in[I_W_OUT] + (size_t)l * 1024 * 1024, 1024, 1024, kt * 64, nt * 64, (bf16_t*)(ws + WOFF(OFF_WTOUT, l)), 1024, 0, smem, tid);
    return;
  }
  c -= CT_OUT;
  if (c < CT_F1) {
    int nt = c >> 4, kt = c & 15;
    conv_tile(p.in[I_W_FFN_IN] + (size_t)l * 1024 * 5632, 5632, 5632, kt * 64, nt * 64, (bf16_t*)(ws + WOFF(OFF_WTF1, l)), 1024, 1, smem, tid);
    return;
  }
  c -= CT_F1;
  if (c < CT_F2) {
    int nt = c / 44, kt = c % 44;
    conv_tile(p.in[I_W_FFN_OUT] + (size_t)l * FFH * 1024, 1024, 1024, kt * 64, nt * 64, (bf16_t*)(ws + WOFF(OFF_WTF2, l)), FFH, 0, smem, tid);
    return;
  }
  c -= CT_F2;
  {
    int nt = c >> 3, kt = c & 7;
    conv_tile(p.in[I_S5_WGLU] + (size_t)l * 512 * 512, 512, 512, kt * 64, nt * 64, (bf16_t*)(ws + WOFF(OFF_WTGLU, l)), 512, 0, smem, tid);
  }
}

__device__ void phase_convert_norm(const Params& p, int l, char* smem) {
  const int tid = opaque_tid();
  const int nconv = (l == 0) ? CT_TOTAL : 0;
  const int ntask = nconv + T_TOK / 4;
  const float* xsrc = (l == 0) ? p.in[I_X] : p.out;
  for (int t = blockIdx.x; t < ntask; t += gridDim.x) {
    if (t < nconv) {
      convert_one(p, l, t, smem, tid);
    } else {
      int row = (t - nconv) * 4 + (tid >> 6);
      rmsnorm_row_to_bf16(xsrc + (size_t)row * DM, p.in[I_NORM_MIX] + l * DM, (bf16_t*)(p.ws + OFF_U) + (size_t)row * DM, tid & 63);
    }
  }
}

__device__ void phase_norm_only(const Params& p, const float* xsrc, const float* w) {
  const int tid = opaque_tid();
  for (int t = blockIdx.x; t < T_TOK / 4; t += gridDim.x) {
    int row = t * 4 + (tid >> 6);
    rmsnorm_row_to_bf16(xsrc + (size_t)row * DM, w, (bf16_t*)(p.ws + OFF_U) + (size_t)row * DM, tid & 63);
  }
}

__device__ __forceinline__ bool tile_map(int t, int NT, int& mt, int& nt) {
  const int x = t & 7, r = t >> 3;
  const int cnt = (NT + 7) >> 3;
  const int ni = r % cnt;
  mt = r / cnt;
  nt = x + 8 * ni;
  return nt < NT;
}
__device__ __forceinline__ int tile_count(int MT, int NT) { return 8 * MT * ((NT + 7) >> 3); }

__device__ void phase_inproj(const Params& p, char* smem) {
  const bf16_t* U = (const bf16_t*)(p.ws + OFF_U);
  const bf16_t* Wt = (const bf16_t*)(p.ws + OFF_WTIN);
  bf16_t* Z = (bf16_t*)(p.ws + OFF_Z);
  const int tid = opaque_tid();
  const int lane = tid & 63, wid = tid >> 6, wm = wid >> 1, wn = wid & 1;
  constexpr int NT = 47;
  for (int t = blockIdx.x; t < tile_count(64, NT); t += gridDim.x) {
    int mt, nt;
    if (!tile_map(t, NT, mt, nt)) continue;
    f32x4 acc[8][4];
    zero_acc_big(acc);
    gemm_mainloop_big(acc, U, 1024, mt * 256, Wt, 1024, nt * 128, NZ - 1, 1024, smem, tid);
#pragma unroll
    for (int mi = 0; mi < 8; ++mi)
#pragma unroll
      for (int ni = 0; ni < 4; ++ni) {
        int col = nt * 128 + wn * 64 + ni * 16 + (lane >> 4) * 4;
        int row = mt * 256 + wm * 128 + mi * 16 + (lane & 15);
        if (col < NZ) {
          uint2 o;
          o.x = pack2(acc[mi][ni][0], acc[mi][ni][1]);
          o.y = pack2(acc[mi][ni][2], acc[mi][ni][3]);
          *reinterpret_cast<uint2*>(Z + (size_t)row * ZS + col) = o;
        }
      }
  }
}

template <int J>
__device__ __forceinline__ void lora_mm(const float* sIn, const float* W, float (&a0)[16], float (&a1)[16], const int tid) {
#pragma unroll
  for (int i = 0; i < 16; ++i) { a0[i] = 0.f; a1[i] = 0.f; }
#pragma unroll 8
  for (int j = 0; j < J; ++j) {
    float w0 = W[j * 512 + tid], w1 = W[j * 512 + tid + 256];
    const float4* x4 = reinterpret_cast<const float4*>(sIn + j * 16);
#pragma unroll
    for (int q = 0; q < 4; ++q) {
      float4 x = x4[q];
      a0[q * 4 + 0] = fmaf(w0, x.x, a0[q * 4 + 0]); a1[q * 4 + 0] = fmaf(w1, x.x, a1[q * 4 + 0]);
      a0[q * 4 + 1] = fmaf(w0, x.y, a0[q * 4 + 1]); a1[q * 4 + 1] = fmaf(w1, x.y, a1[q * 4 + 1]);
      a0[q * 4 + 2] = fmaf(w0, x.z, a0[q * 4 + 2]); a1[q * 4 + 2] = fmaf(w1, x.z, a1[q * 4 + 2]);
      a0[q * 4 + 3] = fmaf(w0, x.w, a0[q * 4 + 3]); a1[q * 4 + 3] = fmaf(w1, x.w, a1[q * 4 + 3]);
    }
  }
}

__device__ __forceinline__ float rw_shift(const bf16_t* Z, int row, int s, int rc, float mu) {
  float cur = bf2f(Z[(size_t)row * ZS + ZRW + rc]);
  float prev = (s > 0) ? bf2f(Z[(size_t)(row - 1) * ZS + ZRW + rc]) : 0.f;
  return cur + (prev - cur) * mu;
}

__device__ void phase_rwprep(const Params& p, int l, char* smem) {
  const bf16_t* Z = (const bf16_t*)(p.ws + OFF_Z);
  bf16_t* LW = (bf16_t*)(p.ws + OFF_U);
  bf16_t* LA = LW + (size_t)T_TOK * 512;
  bf16_t* VF = (bf16_t*)(p.ws + OFF_VF);
  float* sXw = reinterpret_cast<float*>(smem);
  float* sXa = sXw + 64 * 16;
  float* sTmp = sXa + 64 * 16;
  float* sZv = sTmp + 32 * 16;
  const float* mu = p.in[I_RW_MU] + l * 1792;
  const int tid = opaque_tid();
  for (int t = blockIdx.x; t < T_TOK / 16; t += gridDim.x) {
    const int row0 = t * 16;
    for (int e = tid; e < 2048; e += 256) {
      int which = e >> 10, r = e & 1023, j = r >> 4, tok = r & 15;
      int row = row0 + tok, s = row & (SEQ - 1);
      int rc = 1536 + which * 64 + j;
      float z = rw_shift(Z, row, s, rc, mu[rc]);
      if (which == 0) sXw[j * 16 + tok] = tanhf(z); else sXa[j * 16 + tok] = z;
    }
    float zv0[16], zv1[16];
    {
      float m0 = mu[1024 + tid], m1 = mu[1024 + tid + 256];
#pragma unroll
      for (int tok = 0; tok < 16; ++tok) {
        int row = row0 + tok, s = row & (SEQ - 1);
        zv0[tok] = rw_shift(Z, row, s, 1024 + tid, m0);
        zv1[tok] = rw_shift(Z, row, s, 1024 + tid + 256, m1);
      }
    }
    if (l > 0) {
#pragma unroll
      for (int tok = 0; tok < 16; ++tok) { sZv[tid * 16 + tok] = zv0[tok]; sZv[(tid + 256) * 16 + tok] = zv1[tok]; }
    }
    __syncthreads();
    float a0[16], a1[16];
    lora_mm<64>(sXw, p.in[I_RW_W2] + (size_t)l * 64 * 512, a0, a1, tid);
#pragma unroll
    for (int tok = 0; tok < 16; ++tok) {
      LW[(size_t)(row0 + tok) * 512 + tid] = f2bf(a0[tok]);
      LW[(size_t)(row0 + tok) * 512 + tid + 256] = f2bf(a1[tok]);
    }
    lora_mm<64>(sXa, p.in[I_RW_A2] + (size_t)l * 64 * 512, a0, a1, tid);
#pragma unroll
    for (int tok = 0; tok < 16; ++tok) {
      LA[(size_t)(row0 + tok) * 512 + tid] = f2bf(a0[tok]);
      LA[(size_t)(row0 + tok) * 512 + tid + 256] = f2bf(a1[tok]);
    }
    if (l == 0) {
#pragma unroll
      for (int tok = 0; tok < 16; ++tok) {
        VF[(size_t)(row0 + tok) * 512 + tid] = f2bf(zv0[tok]);
        VF[(size_t)(row0 + tok) * 512 + tid + 256] = f2bf(zv1[tok]);
      }
    } else {
      const float* v1 = p.in[I_RW_V1] + (size_t)(l - 1) * 512 * 32;
      const float* v2 = p.in[I_RW_V2] + (size_t)(l - 1) * 32 * 512;
      const float* v0 = p.in[I_RW_V0] + (size_t)(l - 1) * 512;
      {
        int r = tid & 31, tg = tid >> 5;
        float t0 = 0.f, t1 = 0.f;
#pragma unroll 16
        for (int c = 0; c < 512; ++c) {
          float w = v1[c * 32 + r];
          float2 x = *reinterpret_cast<const float2*>(sZv + c * 16 + tg * 2);
          t0 = fmaf(w, x.x, t0); t1 = fmaf(w, x.y, t1);
        }
        sTmp[r * 16 + tg * 2] = t0; sTmp[r * 16 + tg * 2 + 1] = t1;
      }
      __syncthreads();
      lora_mm<32>(sTmp, v2, a0, a1, tid);
      float b0 = v0[tid], b1 = v0[tid + 256];
#pragma unroll
      for (int tok = 0; tok < 16; ++tok) {
        size_t i0 = (size_t)(row0 + tok) * 512 + tid;
        float vf0 = bf2f(VF[i0]), vf1 = bf2f(VF[i0 + 256]);
        VF[i0] = f2bf(zv0[tok] + (vf0 - zv0[tok]) * sigmoidf_(b0 + a0[tok]));
        VF[i0 + 256] = f2bf(zv1[tok] + (vf1 - zv1[tok]) * sigmoidf_(b1 + a1[tok]));
      }
    }
    __syncthreads();
  }
}

__device__ __forceinline__ float frcp(float x) { return __builtin_amdgcn_rcpf(x); }
__device__ __forceinline__ float fsigmoid(float x) { return frcp(1.f + __expf(-x)); }
__device__ __forceinline__ float fsilu(float x) { return x * frcp(1.f + __expf(-x)); }
__device__ __forceinline__ float fsoftplus(float x) { return x > 20.f ? x : __logf(1.f + __expf(x)); }
__device__ __forceinline__ float ftanh(float x) {
  float e = __expf(2.f * fminf(fmaxf(x, -15.f), 15.f));
  return (e - 1.f) * frcp(e + 1.f);
}
__device__ __forceinline__ float fgelu(float x) {
  float u = 0.7978845608028654f * (x + 0.044715f * x * x * x);
  return 0.5f * x * (1.f + ftanh(u));
}

__device__ void hg_scan(const Params& p, int l, int task, char* smem) {
  const int b = task >> 3, h = (task >> 1) & 3, vg = task & 1;
  float* sFg = reinterpret_cast<float*>(smem);
  float* sQs = sFg + 16 * 128;
  float* sO = sQs + 16 * 128;
  float* sVv = sO + 4 * 16 * 64;
  const int tid = opaque_tid(), w = tid >> 6, lane = tid & 63;
  bf16_t* Z = (bf16_t*)(p.ws + OFF_Z) + (size_t)b * SEQ * ZS;
  const int ks = tid & 127;
  float lb = 0.f;
  if (l > 0) {
    float x0 = p.in[I_HG_LB][h * 128 + ks], x1 = p.in[I_HG_LB][512 + h * 128 + ks];
    float m = fmaxf(x0, x1), e0 = expf(x0 - m), e1 = expf(x1 - m);
    lb = e1 / (e0 + e1);
  }
  float s[32];
#pragma unroll
  for (int j = 0; j < 32; ++j) s[j] = 0.f;
  const int vcol = ZHG + 1024 + h * 128 + vg * 64;
  const int qcol = ZHG + h * 128 + ks;
  bf16_t rq0, rq1, rq2, rq3, rq4, rq5, rq6, rq7, rf0, rf1, rf2, rf3, rf4, rf5, rf6, rf7, rv0, rv1, rv2, rv3;
#define HG_LOAD(T0)                                                                                \
  {                                                                                                \
    const bf16_t* zb = Z + (size_t)((T0) + (tid >> 7)) * ZS + qcol;                                \
    rq0 = zb[0]; rf0 = zb[512]; zb += 2 * ZS; rq1 = zb[0]; rf1 = zb[512]; zb += 2 * ZS;            \
    rq2 = zb[0]; rf2 = zb[512]; zb += 2 * ZS; rq3 = zb[0]; rf3 = zb[512]; zb += 2 * ZS;            \
    rq4 = zb[0]; rf4 = zb[512]; zb += 2 * ZS; rq5 = zb[0]; rf5 = zb[512]; zb += 2 * ZS;            \
    rq6 = zb[0]; rf6 = zb[512]; zb += 2 * ZS; rq7 = zb[0]; rf7 = zb[512];                          \
    const bf16_t* zv = Z + (size_t)((T0) + w) * ZS + vcol + lane;                                  \
    rv0 = zv[0]; rv1 = zv[4 * ZS]; rv2 = zv[8 * ZS]; rv3 = zv[12 * ZS];                            \
  }
#define HG_PUT1(I, RQ, RF)                                                                         \
  {                                                                                                \
    int t = (tid >> 7) + 2 * (I);                                                                  \
    sFg[t * 128 + ks] = fmaxf(lb + (1.f - lb) * fsigmoid(bf2f(RF)), 1e-30f);                       \
    sQs[t * 128 + ks] = fsilu(bf2f(RQ));                                                           \
  }
#define HG_PROCESS()                                                                               \
  {                                                                                                \
    HG_PUT1(0, rq0, rf0) HG_PUT1(1, rq1, rf1) HG_PUT1(2, rq2, rf2) HG_PUT1(3, rq3, rf3)            \
    HG_PUT1(4, rq4, rf4) HG_PUT1(5, rq5, rf5) HG_PUT1(6, rq6, rf6) HG_PUT1(7, rq7, rf7)            \
    sVv[(w)*64 + lane] = bf2f(rv0); sVv[(w + 4) * 64 + lane] = bf2f(rv1);                          \
    sVv[(w + 8) * 64 + lane] = bf2f(rv2); sVv[(w + 12) * 64 + lane] = bf2f(rv3);                   \
  }
  HG_LOAD(0);
  HG_PROCESS();
  __syncthreads();
  constexpr int NCH = SEQ / 16;
#pragma unroll 1
  for (int c = 0; c < NCH; ++c) {
    const int t0 = c * 16;
    const int tn = (c + 1 < NCH) ? t0 + 16 : t0;
    HG_LOAD(tn);
    __builtin_amdgcn_sched_barrier(0);
#pragma unroll 2
    for (int t = 0; t < 16; ++t) {
      const float v = sVv[t * 64 + lane];
      const float opv = (lane < 32) ? sFg[t * 128 + w * 32 + lane] : sQs[t * 128 + w * 32 + (lane - 32)];
      const int opi = __builtin_bit_cast(int, opv);
      float o = 0.f;
#pragma unroll
      for (int j = 0; j < 32; ++j) {
        const float fg = __builtin_bit_cast(float, __builtin_amdgcn_readlane(opi, j));
        const float qq = __builtin_bit_cast(float, __builtin_amdgcn_readlane(opi, 32 + j));
        const float kv = fmaf(-fg, v, v);
        s[j] = fmaf(s[j], fg, kv);
        o = fmaf(qq, s[j], o);
      }
      sO[(w * 16 + t) * 64 + lane] = o;
    }
    __builtin_amdgcn_sched_barrier(0);
    __syncthreads();
    {
      int t = tid >> 4, v4 = (tid & 15) * 4;
      float4 a = *reinterpret_cast<const float4*>(sO + (0 * 16 + t) * 64 + v4);
      float4 bq = *reinterpret_cast<const float4*>(sO + (1 * 16 + t) * 64 + v4);
      float4 cq = *reinterpret_cast<const float4*>(sO + (2 * 16 + t) * 64 + v4);
      float4 d = *reinterpret_cast<const float4*>(sO + (3 * 16 + t) * 64 + v4);
      uint2 o;
      o.x = pack2(a.x + bq.x + cq.x + d.x, a.y + bq.y + cq.y + d.y);
      o.y = pack2(a.z + bq.z + cq.z + d.z, a.w + bq.w + cq.w + d.w);
      *reinterpret_cast<uint2*>(Z + (size_t)(t0 + t) * ZS + vcol + v4) = o;
    }
    HG_PROCESS();
    __syncthreads();
  }
#undef HG_LOAD
#undef HG_PUT1
#undef HG_PROCESS
}

__device__ void mb_scan(const Params& p, int l, int task, char* smem) {
  const int b = task >> 3, hd = task & 7, g = hd >> 2;
  float* sB = reinterpret_cast<float*>(smem);
  float* sC = sB + 16 * 128;
  float* sX = sC + 16 * 128;
  float* sDt = sX + 16 * 64;
  float* sDA = sDt + 16;
  float* sO = sDA + 16;
  const int tid = opaque_tid(), w = tid >> 6, lane = tid & 63;
  bf16_t* Z = (bf16_t*)(p.ws + OFF_Z) + (size_t)b * SEQ * ZS;
  const float* cw = p.in[I_MB_CONVW] + (size_t)l * 4 * 1024;
  const float* cb = p.in[I_MB_CONVB] + (size_t)l * 1024;
  int ci0, ci1;
  {
    int ch = tid;
    ci0 = (ch < 64) ? hd * 64 + ch : (ch < 192 ? 512 + g * 128 + (ch - 64) : 768 + g * 128 + (ch - 192));
    ci1 = 768 + g * 128 + 64 + (tid & 63);
  }
  float* dstA = (tid < 64) ? (sX + tid) : (tid < 192 ? (sB + (tid - 64)) : (sC + (tid - 192)));
  const int strideA = (tid < 64) ? 64 : 128;
  const float w0a = cw[ci0], w1a = cw[1024 + ci0], w2a = cw[2048 + ci0], w3a = cw[3072 + ci0], ba = cb[ci0];
  const float w0b = cw[ci1], w1b = cw[1024 + ci1], w2b = cw[2048 + ci1], w3b = cw[3072 + ci1], bb = cb[ci1];
  const float Aneg = -expf(p.in[I_MB_ALOG][l * 8 + hd]);
  const float dtb = p.in[I_MB_DTB][l * 8 + hd];
  const float Dsk = p.in[I_MB_D][l * 8 + hd];
  float s[32];
#pragma unroll
  for (int j = 0; j < 32; ++j) s[j] = 0.f;
  float pa1 = 0.f, pa2 = 0.f, pa3 = 0.f, pb1 = 0.f, pb2 = 0.f, pb3 = 0.f;
  const int xcol = ZMB + 512;
  const int rt = tid >> 4, rp4 = (tid & 15) * 4;
  bf16_t xa0, xa1, xa2, xa3, xa4, xa5, xa6, xa7, xa8, xa9, xa10, xa11, xa12, xa13, xa14, xa15;
  bf16_t xb0, xb1, xb2, xb3, xb4, xb5, xb6, xb7, xb8, xb9, xb10, xb11, xb12, xb13, xb14, xb15;
  bf16_t rdt;
  uint2 gcur, gnext;
#define MB_LOAD(T0)                                                                                 \
  {                                                                                                 \
    const bf16_t* za = Z + (size_t)(T0) * ZS + xcol + ci0;                                          \
    xa0 = za[0]; xa1 = za[ZS]; xa2 = za[2 * ZS]; xa3 = za[3 * ZS]; xa4 = za[4 * ZS]; xa5 = za[5 * ZS];        \
    xa6 = za[6 * ZS]; xa7 = za[7 * ZS]; xa8 = za[8 * ZS]; xa9 = za[9 * ZS]; xa10 = za[10 * ZS];     \
    xa11 = za[11 * ZS]; xa12 = za[12 * ZS]; xa13 = za[13 * ZS]; xa14 = za[14 * ZS]; xa15 = za[15 * ZS];       \
    if (tid < 64) {                                                                                 \
      const bf16_t* zb = Z + (size_t)(T0) * ZS + xcol + ci1;                                        \
      xb0 = zb[0]; xb1 = zb[ZS]; xb2 = zb[2 * ZS]; xb3 = zb[3 * ZS]; xb4 = zb[4 * ZS]; xb5 = zb[5 * ZS];      \
      xb6 = zb[6 * ZS]; xb7 = zb[7 * ZS]; xb8 = zb[8 * ZS]; xb9 = zb[9 * ZS]; xb10 = zb[10 * ZS];   \
      xb11 = zb[11 * ZS]; xb12 = zb[12 * ZS]; xb13 = zb[13 * ZS]; xb14 = zb[14 * ZS]; xb15 = zb[15 * ZS];     \
    }                                                                                               \
    rdt = Z[(size_t)((T0) + (tid & 15)) * ZS + ZMB + 1536 + hd];                                    \
    gnext = *reinterpret_cast<const uint2*>(Z + (size_t)((T0) + rt) * ZS + ZMB + hd * 64 + rp4);    \
  }
#define MB_CONV_A(T, XR)                                                                            \
  {                                                                                                 \
    float xv = bf2f(XR);                                                                            \
    dstA[(T)*strideA] = fsilu(ba + w0a * pa3 + w1a * pa2 + w2a * pa1 + w3a * xv);                   \
    pa3 = pa2; pa2 = pa1; pa1 = xv;                                                                 \
  }
#define MB_CONV_B(T, XR)                                                                            \
  {                                                                                                 \
    float xv = bf2f(XR);                                                                            \
    sC[(T)*128 + 64 + tid] = fsilu(bb + w0b * pb3 + w1b * pb2 + w2b * pb1 + w3b * xv);              \
    pb3 = pb2; pb2 = pb1; pb1 = xv;                                                                 \
  }
#define MB_PROCESS()                                                                                \
  {                                                                                                 \
    MB_CONV_A(0, xa0) MB_CONV_A(1, xa1) MB_CONV_A(2, xa2) MB_CONV_A(3, xa3) MB_CONV_A(4, xa4)       \
    MB_CONV_A(5, xa5) MB_CONV_A(6, xa6) MB_CONV_A(7, xa7) MB_CONV_A(8, xa8) MB_CONV_A(9, xa9)       \
    MB_CONV_A(10, xa10) MB_CONV_A(11, xa11) MB_CONV_A(12, xa12) MB_CONV_A(13, xa13)                 \
    MB_CONV_A(14, xa14) MB_CONV_A(15, xa15)                                                         \
    if (tid < 64) {                                                                                 \
      MB_CONV_B(0, xb0) MB_CONV_B(1, xb1) MB_CONV_B(2, xb2) MB_CONV_B(3, xb3) MB_CONV_B(4, xb4)     \
      MB_CONV_B(5, xb5) MB_CONV_B(6, xb6) MB_CONV_B(7, xb7) MB_CONV_B(8, xb8) MB_CONV_B(9, xb9)     \
      MB_CONV_B(10, xb10) MB_CONV_B(11, xb11) MB_CONV_B(12, xb12) MB_CONV_B(13, xb13)               \
      MB_CONV_B(14, xb14) MB_CONV_B(15, xb15)                                                       \
    }                                                                                               \
    if (tid < 16) {                                                                                 \
      float dt = fsoftplus(bf2f(rdt) + dtb);                                                        \
      sDt[tid] = dt;                                                                                \
      sDA[tid] = __expf(Aneg * dt);                                                                 \
    }                                                                                               \
    gcur = gnext;                                                                                   \
  }
  MB_LOAD(0);
  MB_PROCESS();
  __syncthreads();
  constexpr int NCH = SEQ / 16;
#pragma unroll 1
  for (int c = 0; c < NCH; ++c) {
    const int t0 = c * 16;
    const bool more = (c + 1 < NCH);
    const int tn = more ? t0 + 16 : t0;
    MB_LOAD(tn);
    __builtin_amdgcn_sched_barrier(0);
#pragma unroll 2
    for (int t = 0; t < 16; ++t) {
      const float dA = sDA[t];
      const float xdt = sX[t * 64 + lane] * sDt[t];
      const float opv = (lane < 32) ? sB[t * 128 + w * 32 + lane] : sC[t * 128 + w * 32 + (lane - 32)];
      const int opi = __builtin_bit_cast(int, opv);
      float y = 0.f;
#pragma unroll
      for (int j = 0; j < 32; ++j) {
        const float bn = __builtin_bit_cast(float, __builtin_amdgcn_readlane(opi, j));
        const float cn = __builtin_bit_cast(float, __builtin_amdgcn_readlane(opi, 32 + j));
        s[j] = fmaf(s[j], dA, bn * xdt);
        y = fmaf(cn, s[j], y);
      }
      sO[(w * 16 + t) * 64 + lane] = y;
    }
    __builtin_amdgcn_sched_barrier(0);
    __syncthreads();
    {
      float4 a = *reinterpret_cast<const float4*>(sO + (0 * 16 + rt) * 64 + rp4);
      float4 bq = *reinterpret_cast<const float4*>(sO + (1 * 16 + rt) * 64 + rp4);
      float4 cq = *reinterpret_cast<const float4*>(sO + (2 * 16 + rt) * 64 + rp4);
      float4 d = *reinterpret_cast<const float4*>(sO + (3 * 16 + rt) * 64 + rp4);
      float4 xs = *reinterpret_cast<const float4*>(sX + rt * 64 + rp4);
      bf16_t* gp = Z + (size_t)(t0 + rt) * ZS + ZMB + hd * 64 + rp4;
      float g0 = bf2f((bf16_t)(gcur.x & 0xffff)), g1 = bf2f((bf16_t)(gcur.x >> 16));
      float g2 = bf2f((bf16_t)(gcur.y & 0xffff)), g3 = bf2f((bf16_t)(gcur.y >> 16));
      float y0 = a.x + bq.x + cq.x + d.x + Dsk * xs.x;
      float y1 = a.y + bq.y + cq.y + d.y + Dsk * xs.y;
      float y2 = a.z + bq.z + cq.z + d.z + Dsk * xs.z;
      float y3 = a.w + bq.w + cq.w + d.w + Dsk * xs.w;
      uint2 o;
      o.x = pack2(y0 * fsilu(g0), y1 * fsilu(g1));
      o.y = pack2(y2 * fsilu(g2), y3 * fsilu(g3));
      *reinterpret_cast<uint2*>(gp) = o;
    }
    __syncthreads();
    if (more) MB_PROCESS();
    __syncthreads();
  }
#undef MB_LOAD
#undef MB_CONV_A
#undef MB_CONV_B
#undef MB_PROCESS
}

__device__ void s5_scan(const Params& p, int l, int task, char* smem) {
  const int tid = opaque_tid(), w = tid >> 6, lane = tid & 63;
  const int b = task >> 3, g = (task & 7) * 4 + w;
  char* base = smem + w * 6144;
  float* sU = reinterpret_cast<float*>(base);
  char* sHb = base + 1024;
  bf16_t* Z = (bf16_t*)(p.ws + OFF_Z) + (size_t)b * SEQ * ZS + ZS5 + g * 16;
  const int n = lane;
  float lr, li, bbr[16], bbi[16];
  bf16x8 Bf0, Bf1, Bf2, Bf3;
  {
    float dt = expf(p.in[I_S5_LOGDT][l * 32 + g]);
    float are = p.in[I_S5_ARE][(l * 32 + g) * 64 + n], aim = p.in[I_S5_AIM][(l * 32 + g) * 64 + n];
    float mag = expf(dt * are);
    lr = mag * cosf(dt * aim); li = mag * sinf(dt * aim);
    float den = are * are + aim * aim;
    float cr = ((lr - 1.f) * are + li * aim) / den;
    float ci = (li * are - (lr - 1.f) * aim) / den;
    const float* bre = p.in[I_S5_BRE] + ((size_t)(l * 32 + g) * 64 + n) * 16;
    const float* bim = p.in[I_S5_BIM] + ((size_t)(l * 32 + g) * 64 + n) * 16;
#pragma unroll
    for (int c = 0; c < 16; ++c) {
      float br = bre[c], bi = bim[c];
      bbr[c] = cr * br - ci * bi;
      bbi[c] = cr * bi + ci * br;
    }
    const float* cre = p.in[I_S5_CRE] + (size_t)(l * 32 + g) * 16 * 64 + (lane & 15) * 64;
    const float* cim = p.in[I_S5_CIM] + (size_t)(l * 32 + g) * 16 * 64 + (lane & 15) * 64;
#pragma unroll
    for (int j = 0; j < 8; ++j) {
      const int kb = 8 * (lane >> 4) + j;
      const int n0 = kb >> 1;
      const bool im = (j & 1);
      Bf0[j] = (short)f2bf(im ? -cim[n0] : cre[n0]);
      Bf1[j] = (short)f2bf(im ? -cim[n0 + 16] : cre[n0 + 16]);
      Bf2[j] = (short)f2bf(im ? -cim[n0 + 32] : cre[n0 + 32]);
      Bf3[j] = (short)f2bf(im ? -cim[n0 + 48] : cre[n0 + 48]);
    }
  }
  const float dsk = p.in[I_S5_D][l * 512 + g * 16 + (lane & 15)];
  const int pt = lane >> 2, pc4 = (lane & 3) * 4;
  float hr = 0.f, hi = 0.f;
  uint2 unext = *reinterpret_cast<const uint2*>(Z + (size_t)pt * ZS + pc4);
  constexpr int NCH = SEQ / 16;
#pragma unroll 1
  for (int c = 0; c < NCH; ++c) {
    const int t0 = c * 16;
    {
      const uint2 ur = unext;
      *reinterpret_cast<float4*>(sU + pt * 16 + pc4) =
          float4{bf2f((bf16_t)(ur.x & 0xffff)), bf2f((bf16_t)(ur.x >> 16)), bf2f((bf16_t)(ur.y & 0xffff)), bf2f((bf16_t)(ur.y >> 16))};
      const int tn = (c + 1 < NCH) ? t0 + 16 : t0;
      unext = *reinterpret_cast<const uint2*>(Z + (size_t)(tn + pt) * ZS + pc4);
    }
    __builtin_amdgcn_sched_barrier(0);
    __syncthreads();
#pragma unroll 2
    for (int t = 0; t < 16; ++t) {
      const float4* u4 = reinterpret_cast<const float4*>(sU + t * 16);
      float bur = 0.f, bui = 0.f;
#pragma unroll
      for (int q = 0; q < 4; ++q) {
        float4 u = u4[q];
        bur = fmaf(bbr[q * 4 + 0], u.x, bur); bui = fmaf(bbi[q * 4 + 0], u.x, bui);
        bur = fmaf(bbr[q * 4 + 1], u.y, bur); bui = fmaf(bbi[q * 4 + 1], u.y, bui);
        bur = fmaf(bbr[q * 4 + 2], u.z, bur); bui = fmaf(bbi[q * 4 + 2], u.z, bui);
        bur = fmaf(bbr[q * 4 + 3], u.w, bur); bui = fmaf(bbi[q * 4 + 3], u.w, bui);
      }
      float nr = lr * hr - li * hi + bur;
      float ni = lr * hi + li * hr + bui;
      hr = nr; hi = ni;
      *reinterpret_cast<unsigned*>(sHb + t * 272 + n * 4) = pack2(hr, hi);
    }
    __syncthreads();
    {
      f32x4 acc = f32x4{0.f, 0.f, 0.f, 0.f};
      const char* ap = sHb + (lane & 15) * 272 + (lane >> 4) * 16;
      acc = __builtin_amdgcn_mfma_f32_16x16x32_bf16(*reinterpret_cast<const bf16x8*>(ap), Bf0, acc, 0, 0, 0);
      acc = __builtin_amdgcn_mfma_f32_16x16x32_bf16(*reinterpret_cast<const bf16x8*>(ap + 64), Bf1, acc, 0, 0, 0);
      acc = __builtin_amdgcn_mfma_f32_16x16x32_bf16(*reinterpret_cast<const bf16x8*>(ap + 128), Bf2, acc, 0, 0, 0);
      acc = __builtin_amdgcn_mfma_f32_16x16x32_bf16(*reinterpret_cast<const bf16x8*>(ap + 192), Bf3, acc, 0, 0, 0);
      const int cc = lane & 15, tb = (lane >> 4) * 4;
#pragma unroll
      for (int jj = 0; jj < 4; ++jj) {
        float y = acc[jj] + dsk * sU[(tb + jj) * 16 + cc];
        Z[(size_t)(t0 + tb + jj) * ZS + cc] = f2bf(fgelu(y));
      }
    }
    __syncthreads();
  }
}

__device__ void rw_scan(const Params& p, int l, int task, char* smem) {
  const int b = task >> 3, h = task & 7;
  float* sR = reinterpret_cast<float*>(smem);
  float* sW = sR + 1024;
  float* sK = sW + 1024;
  float* sA = sK + 1024;
  float* sBb = sA + 1024;
  float* sV = sBb + 1024;
  float* sY = sV + 1024;
  float* sBonus = sY + 1024;
  const int tid = opaque_tid(), w = tid >> 6, lane = tid & 63;
  const size_t tokbase = (size_t)b * SEQ;
  bf16_t* Z = (bf16_t*)(p.ws + OFF_Z) + tokbase * ZS;
  const bf16_t* LW = (const bf16_t*)(p.ws + OFF_U) + tokbase * 512;
  const bf16_t* LA = LW + (size_t)T_TOK * 512;
  const bf16_t* VF = (const bf16_t*)(p.ws + OFF_VF) + tokbase * 512;
  const int st = tid >> 4, c4 = (tid & 15) * 4, ch = h * 64 + c4;
  float mur[4], muk[4], w0[4], a0[4], kk_[4], ka_[4], rk_[4], lnw[4], lnb[4];
#pragma unroll
  for (int e = 0; e < 4; ++e) {
    mur[e] = p.in[I_RW_MU][l * 1792 + ch + e];
    muk[e] = p.in[I_RW_MU][l * 1792 + 512 + ch + e];
    w0[e] = p.in[I_RW_W0][l * 512 + ch + e];
    a0[e] = p.in[I_RW_A0][l * 512 + ch + e];
    kk_[e] = p.in[I_RW_KK][l * 512 + ch + e];
    ka_[e] = p.in[I_RW_KA][l * 512 + ch + e];
    rk_[e] = p.in[I_RW_RK][l * 512 + ch + e];
    lnw[e] = p.in[I_RW_LNW][l * 512 + ch + e];
    lnb[e] = p.in[I_RW_LNB][l * 512 + ch + e];
  }
  const int rg = lane >> 3, kq = lane & 7, vrow = w * 16 + rg * 2;
  float S0[8], S1[8];
#pragma unroll
  for (int j = 0; j < 8; ++j) { S0[j] = 0.f; S1[j] = 0.f; }
  uint2 rc, kc, rp, kp, lwv, lav, vfv;
#define RW_LOAD(T0)                                                                                 \
  {                                                                                                 \
    const int s_ = (T0) + st;                                                                       \
    const bf16_t* zr = Z + (size_t)s_ * ZS + ZRW + ch;                                              \
    rc = *reinterpret_cast<const uint2*>(zr);                                                       \
    kc = *reinterpret_cast<const uint2*>(zr + 512);                                                 \
    rp = uint2{0u, 0u}; kp = uint2{0u, 0u};                                                         \
    if (s_ > 0) { rp = *reinterpret_cast<const uint2*>(zr - ZS); kp = *reinterpret_cast<const uint2*>(zr - ZS + 512); } \
    lwv = *reinterpret_cast<const uint2*>(LW + (size_t)s_ * 512 + ch);                              \
    lav = *reinterpret_cast<const uint2*>(LA + (size_t)s_ * 512 + ch);                              \
    vfv = *reinterpret_cast<const uint2*>(VF + (size_t)s_ * 512 + ch);                              \
  }
#define RW_PROCESS()                                                                                \
  {                                                                                                 \
    float r4[4], k4[4], kkv[4], av[4], wv[4], vv[4];                                                \
    float n2 = 0.f;                                                                                 \
    _Pragma("unroll") for (int e = 0; e < 4; ++e) {                                                 \
      unsigned rcw = (e < 2) ? rc.x : rc.y, kcw = (e < 2) ? kc.x : kc.y, rpw = (e < 2) ? rp.x : rp.y, kpw = (e < 2) ? kp.x : kp.y; \
      unsigned lww = (e < 2) ? lwv.x : lwv.y, law = (e < 2) ? lav.x : lav.y, vfw = (e < 2) ? vfv.x : vfv.y; \
      int sh = (e & 1) * 16;                                                                        \
      float rcur = bf2f((bf16_t)((rcw >> sh) & 0xffff)), rprev = bf2f((bf16_t)((rpw >> sh) & 0xffff)); \
      float kcur = bf2f((bf16_t)((kcw >> sh) & 0xffff)), kprev = bf2f((bf16_t)((kpw >> sh) & 0xffff)); \
      float lwf = bf2f((bf16_t)((lww >> sh) & 0xffff)), laf = bf2f((bf16_t)((law >> sh) & 0xffff)); \
      vv[e] = bf2f((bf16_t)((vfw >> sh) & 0xffff));                                                 \
      r4[e] = rcur + (rprev - rcur) * mur[e];                                                       \
      k4[e] = kcur + (kprev - kcur) * muk[e];                                                       \
      float wlog = -fsoftplus(-(w0[e] + lwf)) - 0.5f;                                               \
      wv[e] = __expf(-__expf(wlog));                                                                \
      av[e] = fsigmoid(a0[e] + laf);                                                                \
      kkv[e] = k4[e] * kk_[e];                                                                      \
      n2 += kkv[e] * kkv[e];                                                                        \
    }                                                                                               \
    n2 = sum16(n2);                                                                                 \
    float inv = 1.f / fmaxf(sqrtf(n2), 1e-12f);                                                     \
    float bon = 0.f;                                                                                \
    float kt4[4], ap4[4], bp4[4];                                                                   \
    _Pragma("unroll") for (int e = 0; e < 4; ++e) {                                                 \
      float kkn = kkv[e] * inv;                                                                     \
      kt4[e] = k4[e] * (1.f + (av[e] - 1.f) * ka_[e]);                                              \
      ap4[e] = -kkn;                                                                                \
      bp4[e] = kkn * av[e];                                                                         \
      bon += r4[e] * kt4[e] * rk_[e];                                                               \
    }                                                                                               \
    bon = sum16(bon);                                                                               \
    *reinterpret_cast<float4*>(sR + st * 64 + c4) = float4{r4[0], r4[1], r4[2], r4[3]};             \
    *reinterpret_cast<float4*>(sW + st * 64 + c4) = float4{wv[0], wv[1], wv[2], wv[3]};             \
    *reinterpret_cast<float4*>(sK + st * 64 + c4) = float4{kt4[0], kt4[1], kt4[2], kt4[3]};         \
    *reinterpret_cast<float4*>(sA + st * 64 + c4) = float4{ap4[0], ap4[1], ap4[2], ap4[3]};         \
    *reinterpret_cast<float4*>(sBb + st * 64 + c4) = float4{bp4[0], bp4[1], bp4[2], bp4[3]};        \
    *reinterpret_cast<float4*>(sV + st * 64 + c4) = float4{vv[0], vv[1], vv[2], vv[3]};             \
    if ((tid & 15) == 0) sBonus[st] = bon;                                                          \
  }
  RW_LOAD(0);
  RW_PROCESS();
  __syncthreads();
  constexpr int NCH = SEQ / 16;
#pragma unroll 1
  for (int c = 0; c < NCH; ++c) {
    const int t0 = c * 16;
    const int tn = (c + 1 < NCH) ? t0 + 16 : t0;
    RW_LOAD(tn);
    __builtin_amdgcn_sched_barrier(0);
#pragma unroll 2
    for (int t = 0; t < 16; ++t) {
      const float4* a4p = reinterpret_cast<const float4*>(sA + t * 64 + kq * 8);
      const float4* w4p = reinterpret_cast<const float4*>(sW + t * 64 + kq * 8);
      const float4* b4p = reinterpret_cast<const float4*>(sBb + t * 64 + kq * 8);
      const float4* k4p = reinterpret_cast<const float4*>(sK + t * 64 + kq * 8);
      const float4* r4p = reinterpret_cast<const float4*>(sR + t * 64 + kq * 8);
      const float2 vv = *reinterpret_cast<const float2*>(sV + t * 64 + vrow);
      float sa0 = 0.f, sa1 = 0.f;
#pragma unroll
      for (int q = 0; q < 2; ++q) {
        float4 a = a4p[q];
        sa0 = fmaf(S0[q * 4 + 0], a.x, sa0); sa1 = fmaf(S1[q * 4 + 0], a.x, sa1);
        sa0 = fmaf(S0[q * 4 + 1], a.y, sa0); sa1 = fmaf(S1[q * 4 + 1], a.y, sa1);
        sa0 = fmaf(S0[q * 4 + 2], a.z, sa0); sa1 = fmaf(S1[q * 4 + 2], a.z, sa1);
        sa0 = fmaf(S0[q * 4 + 3], a.w, sa0); sa1 = fmaf(S1[q * 4 + 3], a.w, sa1);
      }
      sa0 = oct_sum(sa0); sa1 = oct_sum(sa1);
      float y0 = 0.f, y1 = 0.f;
#pragma unroll
      for (int q = 0; q < 2; ++q) {
        float4 ww = w4p[q], bb = b4p[q], kk = k4p[q], rr = r4p[q];
        S0[q * 4 + 0] = fmaf(S0[q * 4 + 0], ww.x, fmaf(sa0, bb.x, vv.x * kk.x)); y0 = fmaf(S0[q * 4 + 0], rr.x, y0);
        S1[q * 4 + 0] = fmaf(S1[q * 4 + 0], ww.x, fmaf(sa1, bb.x, vv.y * kk.x)); y1 = fmaf(S1[q * 4 + 0], rr.x, y1);
        S0[q * 4 + 1] = fmaf(S0[q * 4 + 1], ww.y, fmaf(sa0, bb.y, vv.x * kk.y)); y0 = fmaf(S0[q * 4 + 1], rr.y, y0);
        S1[q * 4 + 1] = fmaf(S1[q * 4 + 1], ww.y, fmaf(sa1, bb.y, vv.y * kk.y)); y1 = fmaf(S1[q * 4 + 1], rr.y, y1);
        S0[q * 4 + 2] = fmaf(S0[q * 4 + 2], ww.z, fmaf(sa0, bb.z, vv.x * kk.z)); y0 = fmaf(S0[q * 4 + 2], rr.z, y0);
        S1[q * 4 + 2] = fmaf(S1[q * 4 + 2], ww.z, fmaf(sa1, bb.z, vv.y * kk.z)); y1 = fmaf(S1[q * 4 + 2], rr.z, y1);
        S0[q * 4 + 3] = fmaf(S0[q * 4 + 3], ww.w, fmaf(sa0, bb.w, vv.x * kk.w)); y0 = fmaf(S0[q * 4 + 3], rr.w, y0);
        S1[q * 4 + 3] = fmaf(S1[q * 4 + 3], ww.w, fmaf(sa1, bb.w, vv.y * kk.w)); y1 = fmaf(S1[q * 4 + 3], rr.w, y1);
      }
      y0 = oct_sum(y0); y1 = oct_sum(y1);
      if (kq == 0) *reinterpret_cast<float2*>(sY + t * 64 + vrow) = float2{y0, y1};
    }
    __builtin_amdgcn_sched_barrier(0);
    __syncthreads();
    {
      float4 y4 = *reinterpret_cast<const float4*>(sY + st * 64 + c4);
      float4 v4 = *reinterpret_cast<const float4*>(sV + st * 64 + c4);
      float bon = sBonus[st];
      float mean = sum16(y4.x + y4.y + y4.z + y4.w) * (1.f / 64.f);
      float dx = y4.x - mean, dy = y4.y - mean, dz = y4.z - mean, dw = y4.w - mean;
      float var = sum16(dx * dx + dy * dy + dz * dz + dw * dw) * (1.f / 64.f);
      float rs = rsqrtf(var + 64e-5f);
      float o0 = dx * rs * lnw[0] + lnb[0] + bon * v4.x;
      float o1 = dy * rs * lnw[1] + lnb[1] + bon * v4.y;
      float o2 = dz * rs * lnw[2] + lnb[2] + bon * v4.z;
      float o3 = dw * rs * lnw[3] + lnb[3] + bon * v4.w;
      uint2 o;
      o.x = pack2(o0, o1); o.y = pack2(o2, o3);
      *reinterpret_cast<uint2*>(Z + (size_t)(t0 + st) * ZS + ZRW + 1024 + ch) = o;
    }
    RW_PROCESS();
    __syncthreads();
  }
#undef RW_LOAD
#undef RW_PROCESS
}

__device__ void phase_scans(const Params& p, int l, char* smem, int scan_mask = 15) {
  for (int t = blockIdx.x; t < 256; t += gridDim.x) {
    int type = t & 3, idx = t >> 2;
    if (!((scan_mask >> type) & 1)) continue;
#ifndef SCM
#define SCM 15
#endif
    if (type == 0) { if (SCM & 1) rw_scan(p, l, idx, smem); }
    else if (type == 1) { if (SCM & 2) hg_scan(p, l, idx, smem); }
    else if (type == 2) { if (SCM & 4) mb_scan(p, l, idx, smem); }
    else { if (SCM & 8) s5_scan(p, l, idx, smem); }
    __syncthreads();
  }
  if (l + 1 < 2) {
    const int tid = opaque_tid();
    const int nb = (gridDim.x > 256) ? (int)gridDim.x - 256 : (int)gridDim.x;
    const int b0 = (gridDim.x > 256) ? (int)blockIdx.x - 256 : (int)blockIdx.x;
    if (b0 >= 0)
      for (int c = b0; c < CT_TOTAL; c += nb) convert_one(p, l + 1, c, smem, tid);
  }
}

__device__ __forceinline__ void unpack8(const uint4& v, float (&f)[8]) {
  f[0] = bf2f((bf16_t)(v.x & 0xffff)); f[1] = bf2f((bf16_t)(v.x >> 16));
  f[2] = bf2f((bf16_t)(v.y & 0xffff)); f[3] = bf2f((bf16_t)(v.y >> 16));
  f[4] = bf2f((bf16_t)(v.z & 0xffff)); f[5] = bf2f((bf16_t)(v.z >> 16));
  f[6] = bf2f((bf16_t)(v.w & 0xffff)); f[7] = bf2f((bf16_t)(v.w >> 16));
}

__device__ void phase_post(const Params& p, int l, char* smem) {
  bf16_t* Z = (bf16_t*)(p.ws + OFF_Z);
  const int tid = opaque_tid(), lane = tid & 63, wid = tid >> 6;
  constexpr int N_ROWT = T_TOK / 4, N_RWT = T_TOK / 16, N_GLU = 128 * 4, N_NORM = T_TOK / 4;
  const float* xsrc = (l == 0) ? p.in[I_X] : p.out;
  for (int t = blockIdx.x; t < N_ROWT + N_RWT + N_GLU + N_NORM; t += gridDim.x) {
    if (t < N_ROWT) {
      const int row = t * 4 + wid;
      {
        bf16_t* op = Z + (size_t)row * ZS + ZHG + 1024 + lane * 8;
        uint4 ov = *reinterpret_cast<const uint4*>(op);
        uint4 gv = *reinterpret_cast<const uint4*>(op + 512);
        float o[8], g[8];
        unpack8(ov, o); unpack8(gv, g);
        float ss = 0.f;
#pragma unroll
        for (int e = 0; e < 8; ++e) ss += o[e] * o[e];
        ss = sum16(ss);
        float rstd = rsqrtf(ss * (1.f / 128.f) + 1e-6f);
        const float* nw = p.in[I_HG_NW] + l * 512 + lane * 8;
        float r[8];
#pragma unroll
        for (int e = 0; e < 8; ++e) r[e] = o[e] * rstd * nw[e] * siluf_(g[e]);
        *reinterpret_cast<uint4*>(op) = uint4{pack2(r[0], r[1]), pack2(r[2], r[3]), pack2(r[4], r[5]), pack2(r[6], r[7])};
      }
      {
        bf16_t* op = Z + (size_t)row * ZS + ZMB + lane * 8;
        uint4 ov = *reinterpret_cast<const uint4*>(op);
        float o[8];
        unpack8(ov, o);
        float ss = 0.f;
#pragma unroll
        for (int e = 0; e < 8; ++e) ss += o[e] * o[e];
        ss = sum64(ss);
        float rstd = rsqrtf(ss * (1.f / 512.f) + 1e-6f);
        const float* nw = p.in[I_MB_NW] + l * 512 + lane * 8;
        float r[8];
#pragma unroll
        for (int e = 0; e < 8; ++e) r[e] = o[e] * rstd * nw[e];
        *reinterpret_cast<uint4*>(op) = uint4{pack2(r[0], r[1]), pack2(r[2], r[3]), pack2(r[4], r[5]), pack2(r[6], r[7])};
      }
    } else if (t < N_ROWT + N_RWT) {
      const int row0 = (t - N_ROWT) * 16;
      float* sXg = reinterpret_cast<float*>(smem);
      const float* mu = p.in[I_RW_MU] + l * 1792 + 1664;
      for (int e = tid; e < 2048; e += 256) {
        int j = e >> 4, tok = e & 15;
        int row = row0 + tok, s = row & (SEQ - 1);
        sXg[j * 16 + tok] = sigmoidf_(rw_shift(Z, row, s, 1664 + j, mu[j]));
      }
      __syncthreads();
      float a0[16], a1[16];
      lora_mm<128>(sXg, p.in[I_RW_G2] + (size_t)l * 128 * 512, a0, a1, tid);
#pragma unroll
      for (int tok = 0; tok < 16; ++tok) {
        bf16_t* yp = Z + (size_t)(row0 + tok) * ZS + ZRW + 1024 + tid;
        yp[0] = f2bf(bf2f(yp[0]) * a0[tok]);
        yp[256] = f2bf(bf2f(yp[256]) * a1[tok]);
      }
      __syncthreads();
    } else if (t < N_ROWT + N_RWT + N_GLU) {
      const int tt = t - N_ROWT - N_RWT, mt = tt >> 2, nt = tt & 3;
      const int wm = wid >> 1, wn = wid & 1;
      f32x4 acc[4][4];
      zero_acc<128>(acc);
      gemm_mainloop<128>(acc, Z + ZS5, ZS, mt * 128, (const bf16_t*)(p.ws + WOFF(OFF_WTGLU, l)), 512, nt * 128, 511, 512, smem, tid);
      const float* bg = p.in[I_S5_BGLU] + l * 512;
#pragma unroll
      for (int mi = 0; mi < 4; ++mi)
#pragma unroll
        for (int ni = 0; ni < 4; ++ni) {
          int col = nt * 128 + wn * 64 + ni * 16 + (lane >> 4) * 4;
          int row = mt * 128 + wm * 64 + mi * 16 + (lane & 15);
          float4 b4 = *reinterpret_cast<const float4*>(bg + col);
          uint2 yv = *reinterpret_cast<const uint2*>(Z + (size_t)row * ZS + ZS5 + col);
          float y0 = bf2f((bf16_t)(yv.x & 0xffff)), y1 = bf2f((bf16_t)(yv.x >> 16));
          float y2 = bf2f((bf16_t)(yv.y & 0xffff)), y3 = bf2f((bf16_t)(yv.y >> 16));
          uint2 o;
          o.x = pack2(y0 * sigmoidf_(acc[mi][ni][0] + b4.x), y1 * sigmoidf_(acc[mi][ni][1] + b4.y));
          o.y = pack2(y2 * sigmoidf_(acc[mi][ni][2] + b4.z), y3 * sigmoidf_(acc[mi][ni][3] + b4.w));
          *reinterpret_cast<uint2*>(Z + (size_t)row * ZS + ZMB + 1024 + col) = o;
        }
    } else {
      const int row = (t - N_ROWT - N_RWT - N_GLU) * 4 + wid;
      rmsnorm_row_to_bf16(xsrc + (size_t)row * DM, p.in[I_NORM_MIX] + l * DM, (bf16_t*)(p.ws + OFF_U) + (size_t)row * DM, tid & 63);
    }
  }
}

__device__ void phase_merge(const Params& p, int l, char* smem) {
  bf16_t* Z = (bf16_t*)(p.ws + OFF_Z);
  const bf16_t* U = (const bf16_t*)(p.ws + OFF_U);
  const bf16_t* Wg = (const bf16_t*)(p.ws + WOFF_GATE(l));
  const bf16_t* Wb = (const bf16_t*)(p.ws + WOFF(OFF_WTBR, l));
  const int tid = opaque_tid();
  const int lane = tid & 63, wid = tid >> 6, wm = wid >> 1, wn = wid & 1;
  for (int t = blockIdx.x; t < tile_count(128, 16); t += gridDim.x) {
    int mt, nt;
    if (!tile_map(t, 16, mt, nt)) continue;
    f32x4 accm[4][2];
    zero_acc<64>(accm);
    for (int kb = 0; kb < 4; ++kb) {
      f32x4 g[4][2], pr[4][2];
      zero_acc<64>(g);
      zero_acc<64>(pr);
      gemm_mainloop<64>(g, U, 1024, mt * 128, Wg + (size_t)kb * 1024 * 1024, 1024, nt * 64, 1023, 1024, smem, tid);
      const int ycol = (kb == 0) ? (ZHG + 1024) : (kb == 1) ? (ZRW + 1024) : (kb == 2) ? (ZMB + 1024) : ZMB;
      gemm_mainloop<64>(pr, Z + ycol, ZS, mt * 128, Wb + (size_t)kb * 1024 * 512, 512, nt * 64, 1023, 512, smem, tid);
#pragma unroll
      for (int mi = 0; mi < 4; ++mi)
#pragma unroll
        for (int ni = 0; ni < 2; ++ni)
#pragma unroll
          for (int j = 0; j < 4; ++j) accm[mi][ni][j] = fmaf(sigmoidf_(g[mi][ni][j]), pr[mi][ni][j], accm[mi][ni][j]);
    }
#pragma unroll
    for (int mi = 0; mi < 4; ++mi)
#pragma unroll
      for (int ni = 0; ni < 2; ++ni) {
        int col = nt * 64 + wn * 32 + ni * 16 + (lane >> 4) * 4;
        int row = mt * 128 + wm * 64 + mi * 16 + (lane & 15);
        uint2 o;
        o.x = pack2(accm[mi][ni][0], accm[mi][ni][1]);
        o.y = pack2(accm[mi][ni][2], accm[mi][ni][3]);
        *reinterpret_cast<uint2*>(Z + (size_t)row * ZS + col) = o;
      }
  }
}

__device__ void phase_resid_gemm(const Params& p, const bf16_t* A, int lda, const bf16_t* Wt, int K, const float* xold, char* smem) {
  const int tid = opaque_tid();
  const int lane = tid & 63, wid = tid >> 6, wm = wid >> 1, wn = wid & 1;
  for (int t = blockIdx.x; t < tile_count(64, 8); t += gridDim.x) {
    int mt, nt;
    if (!tile_map(t, 8, mt, nt)) continue;
    f32x4 acc[8][4];
    zero_acc_big(acc);
    gemm_mainloop_big(acc, A, lda, mt * 256, Wt, K, nt * 128, 1023, K, smem, tid);
#pragma unroll
    for (int mi = 0; mi < 8; ++mi)
#pragma unroll
      for (int ni = 0; ni < 4; ++ni) {
        int col = nt * 128 + wn * 64 + ni * 16 + (lane >> 4) * 4;
        int row = mt * 256 + wm * 128 + mi * 16 + (lane & 15);
        size_t o = (size_t)row * DM + col;
        float4 xo = *reinterpret_cast<const float4*>(xold + o);
        float4 r = float4{xo.x + acc[mi][ni][0], xo.y + acc[mi][ni][1], xo.z + acc[mi][ni][2], xo.w + acc[mi][ni][3]};
        *reinterpret_cast<float4*>(p.out + o) = r;
      }
  }
}

__device__ void phase_ffn_in(const Params& p, int l, char* smem) {
  const bf16_t* U = (const bf16_t*)(p.ws + OFF_U);
  const bf16_t* Wt = (const bf16_t*)(p.ws + WOFF(OFF_WTF1, l));
  bf16_t* H = (bf16_t*)(p.ws + OFF_Z);
  const int tid = opaque_tid();
  const int lane = tid & 63, wid = tid >> 6, wm = wid >> 1, wn = wid & 1;
  for (int t = blockIdx.x; t < tile_count(64, 44); t += gridDim.x) {
    int mt, nt;
    if (!tile_map(t, 44, mt, nt)) continue;
    f32x4 acc[8][4];
    zero_acc_big(acc);
    gemm_mainloop_big(acc, U, 1024, mt * 256, Wt, 1024, nt * 128, 5631, 1024, smem, tid);
#pragma unroll
    for (int mi = 0; mi < 8; ++mi)
#pragma unroll
      for (int q = 0; q < 2; ++q) {
        int hcol = ((nt * 128 + wn * 64 + q * 32) >> 1) + (lane >> 4) * 4;
        int row = mt * 256 + wm * 128 + mi * 16 + (lane & 15);
        uint2 o;
        o.x = pack2(fsilu(acc[mi][2 * q][0]) * acc[mi][2 * q + 1][0], fsilu(acc[mi][2 * q][1]) * acc[mi][2 * q + 1][1]);
        o.y = pack2(fsilu(acc[mi][2 * q][2]) * acc[mi][2 * q + 1][2], fsilu(acc[mi][2 * q][3]) * acc[mi][2 * q + 1][3]);
        *reinterpret_cast<uint2*>(H + (size_t)row * FFH + hcol) = o;
      }
  }
}

__device__ void phase_final(const Params& p) {
  const int tid = opaque_tid();
  const int lane = tid & 63;
  const float* w = p.in[I_NORM_FINAL];
  for (int t = blockIdx.x; t < T_TOK / 4; t += gridDim.x) {
    int row = t * 4 + (tid >> 6);
    float* x = p.out + (size_t)row * DM;
    float4 v[4];
    float ss = 0.f;
#pragma unroll
    for (int i = 0; i < 4; ++i) {
      v[i] = *reinterpret_cast<const float4*>(x + i * 256 + lane * 4);
      ss += v[i].x * v[i].x + v[i].y * v[i].y + v[i].z * v[i].z + v[i].w * v[i].w;
    }
    ss = sum64(ss);
    float rstd = rsqrtf(ss * (1.f / 1024.f) + 1e-6f);
#pragma unroll
    for (int i = 0; i < 4; ++i) {
      float4 ww = *reinterpret_cast<const float4*>(w + i * 256 + lane * 4);
      float4 o = float4{v[i].x * rstd * ww.x, v[i].y * rstd * ww.y, v[i].z * rstd * ww.z, v[i].w * rstd * ww.w};
      *reinterpret_cast<float4*>(x + i * 256 + lane * 4) = o;
    }
  }
}

template <int SUB>
__device__ __forceinline__ void run_phase(const Params& p, int l, char* smem) {
  if (SUB == 0) phase_convert_norm(p, l, smem);
  else if (SUB == 1) phase_inproj(p, smem);
  else if (SUB == 2) phase_rwprep(p, l, smem);
  else if (SUB == 3) phase_scans(p, l, smem);
  else if (SUB == 4) phase_post(p, l, smem);
  else if (SUB == 5) phase_merge(p, l, smem);
  else if (SUB == 6) phase_resid_gemm(p, (const bf16_t*)(p.ws + OFF_Z), ZS, (const bf16_t*)(p.ws + WOFF(OFF_WTOUT, l)), 1024,
                                      (l == 0) ? p.in[I_X] : p.out, smem);
  else if (SUB == 7) phase_norm_only(p, p.out, p.in[I_NORM_FFN] + l * DM);
  else if (SUB == 8) phase_ffn_in(p, l, smem);
  else if (SUB == 9) phase_resid_gemm(p, (const bf16_t*)(p.ws + OFF_Z), FFH, (const bf16_t*)(p.ws + WOFF(OFF_WTF2, l)), FFH, p.out, smem);
  else phase_final(p);
}

#ifndef PHM
#define PHM 0xFFFF
#endif
#define XB_TMO      128
#define XB_XCNT(j)  (256  + 64 * (j))
#define XB_XSUB(j)  (1280 + 64 * (j))
#define XB_XGEN(j)  (2304 + 64 * (j))
#define XB_TOP      3328
#define XB_TOPGEN   3392
#define XCD_BAR_WORDS 3456
#define XB_SPIN_CAP (1u << 18)
#define LAS __attribute__((address_space(3)))

__device__ __forceinline__ unsigned xb_ld(unsigned* p)              { return __hip_atomic_load(p, __ATOMIC_RELAXED, __HIP_MEMORY_SCOPE_AGENT); }
__device__ __forceinline__ unsigned xb_add(unsigned* p, unsigned v) { return __hip_atomic_fetch_add(p, v, __ATOMIC_RELAXED, __HIP_MEMORY_SCOPE_AGENT); }
__device__ __forceinline__ unsigned xb_xcc_id() { return (unsigned)__builtin_amdgcn_s_getreg((3 << 11) | 20) & 0xFu; }
#define XB_SPIN(cond, bar) do { unsigned _sp = 0; while (cond) { __builtin_amdgcn_s_sleep(1); \
    if ((++_sp & 255u) == 0u) { if (xb_ld(&(bar)[XB_TMO])) break; if (_sp > XB_SPIN_CAP) { atomicAdd(&(bar)[XB_TMO], 1u); break; } } } } while (0)

struct XcdBarrier {
    unsigned* bar; unsigned x;
    volatile LAS unsigned* st;
};

__device__ __forceinline__ XcdBarrier xcd_barrier_post(unsigned* bar, volatile LAS unsigned* st) {
    XcdBarrier b; b.bar = bar; b.x = xb_xcc_id(); b.st = st;
    if (threadIdx.x == 0) (void)xb_add(&bar[XB_XCNT(b.x)], 1u);
    return b;
}
__device__ __forceinline__ void xcd_barrier_complete(unsigned* bar, unsigned x, unsigned& nloc, unsigned& nx) {
    const unsigned G = gridDim.x * gridDim.y * gridDim.z;
    unsigned sum, cnt, mine, sp = 0u;
    for (;;) {
        sum = 0u; cnt = 0u; mine = 0u;
#pragma unroll
        for (unsigned j = 0; j < 16; ++j) { const unsigned c = xb_ld(&bar[XB_XCNT(j)]); sum += c; cnt += (c > 0u) ? 1u : 0u; mine = (j == x) ? c : mine; }
        if (sum == G) break;
        __builtin_amdgcn_s_sleep(1);
        if ((++sp & 255u) == 0u) { if (xb_ld(&bar[XB_TMO])) break; if (sp > XB_SPIN_CAP) { atomicAdd(&bar[XB_TMO], 1u); break; } }
    }
    nloc = mine > 0u ? mine : 1u; nx = cnt > 0u ? cnt : 1u;
}

__device__ __forceinline__ void xcd_barrier(const XcdBarrier& b) {
    asm volatile("s_waitcnt vmcnt(0)" ::: "memory");
    __syncthreads();
    if (threadIdx.x == 0) {
        unsigned* bar = b.bar;
        __builtin_amdgcn_s_waitcnt(0);
        unsigned nloc = b.st[0], nx = b.st[1];
        if (nloc == 0u) { xcd_barrier_complete(bar, b.x, nloc, nx); b.st[0] = nloc; b.st[1] = nx; }
        const unsigned old = xb_add(&bar[XB_XSUB(b.x)], 1u);
        const unsigned gen = old / nloc;
        if (old + 1u == (gen + 1u) * nloc) {
            __builtin_amdgcn_fence(__ATOMIC_RELEASE, "agent");
            asm volatile("s_waitcnt vmcnt(0)" ::: "memory");
            const unsigned og = xb_add(&bar[XB_TOP], 1u);
            const unsigned tg = og / nx;
            if (og + 1u == (tg + 1u) * nx) xb_add(&bar[XB_TOPGEN], 1u);
            else XB_SPIN(xb_ld(&bar[XB_TOPGEN]) == tg, bar);
            __builtin_amdgcn_fence(__ATOMIC_ACQUIRE, "agent");
            xb_add(&bar[XB_XGEN(b.x)], 1u);
            asm volatile("s_waitcnt vmcnt(0)" ::: "memory");
        } else {
            XB_SPIN(xb_ld(&bar[XB_XGEN(b.x)]) == gen, bar);
            __builtin_amdgcn_fence(__ATOMIC_ACQUIRE, "agent");
            asm volatile("s_waitcnt vmcnt(0)" ::: "memory");
        }
    }
    __syncthreads();
}


constexpr int LDS_MAIN = 73728;
constexpr int LDS_BYTES = LDS_MAIN + 16;

#if COOP
__global__ void __launch_bounds__(256, 2) fwd_kernel(Params p, int ph0, int ph1, int scan_mask) {
  extern __shared__ __attribute__((aligned(16))) char smem[];
  cg::grid_group grid = cg::this_grid();
  volatile LAS unsigned* xb_st = (volatile LAS unsigned*)(smem + LDS_MAIN);
  if (threadIdx.x == 0) { xb_st[0] = 0u; xb_st[1] = 0u; xb_st[2] = 0u; xb_st[3] = 0u; }
  __syncthreads();
  XcdBarrier xbar = xcd_barrier_post(reinterpret_cast<unsigned*>(p.ws + OFF_BAR), xb_st);
  for (int ph = ph0; ph < ph1; ++ph) {
    if (ph == NPHASES - 1) {
      phase_final(p);
    } else {
      const int l = ph / NPH_LAYER, sub = ph % NPH_LAYER;
      switch (sub) {
        case 0: if (PHM & (1<<0)) run_phase<0>(p, l, smem); break;
        case 1: if (PHM & (1<<1)) run_phase<1>(p, l, smem); break;
        case 2: if (PHM & (1<<2)) run_phase<2>(p, l, smem); break;
        case 3: if (PHM & (1<<3)) phase_scans(p, l, smem, scan_mask); break;
        case 4: if (PHM & (1<<4)) run_phase<4>(p, l, smem); break;
        case 5: if (PHM & (1<<5)) run_phase<5>(p, l, smem); break;
        case 6: if (PHM & (1<<6)) run_phase<6>(p, l, smem); break;
        case 7: if (PHM & (1<<7)) run_phase<7>(p, l, smem); break;
        case 8: if (PHM & (1<<8)) run_phase<8>(p, l, smem); break;
        case 9: if (PHM & (1<<9)) run_phase<9>(p, l, smem); break;
      }
    }
    if (ph + 1 < ph1) {
      if (ph == ph0) grid.sync();
      else xcd_barrier(xbar);
    }
  }
}
#else
template <int SUB>
__global__ void __launch_bounds__(256, 2) k_phase(Params p, int l) {
  __shared__ __attribute__((aligned(16))) char smem[65536];
  run_phase<SUB>(p, l, smem);
}
#endif

extern "C" void kernel_launch(void* const* d_in, const int* in_sizes, int n_in, void* d_out, int out_size, void* d_ws,
                              size_t ws_size, hipStream_t stream) {
  if (n_in < 41 || ws_size < WS_NEED) {
    fprintf(stderr, "kernel_launch: bad args n_in=%d ws=%zu need=%zu\n", n_in, ws_size, (size_t)WS_NEED);
    return;
  }
  Params p{};
  for (int i = 0; i < 41; ++i) p.in[i] = (const float*)d_in[i];
  p.out = (float*)d_out;
  p.ws = (char*)d_ws;
#if COOP
  static int grid_blocks = 0;
  if (!grid_blocks) {
    int dev = 0, cus = 0, per_cu = 0;
    hipGetDevice(&dev);
    hipDeviceGetAttribute(&cus, hipDeviceAttributeMultiprocessorCount, dev);
    hipFuncSetAttribute((const void*)fwd_kernel, hipFuncAttributeMaxDynamicSharedMemorySize, LDS_BYTES);
    hipOccupancyMaxActiveBlocksPerMultiprocessor(&per_cu, fwd_kernel, 256, LDS_BYTES);
    if (per_cu > 2) per_cu = 2;
    grid_blocks = cus * per_cu;
  }
#ifdef HYBRID
  for (int ph = 0; ph < NPHASES; ++ph) {
    if (ph % 10 == 3 && ph < 20) {
      const int groups[4] = SCAN_GROUPS;
      for (int gi = 0; gi < 4; ++gi) if (groups[gi]) fwd_kernel<<<grid_blocks, 256, LDS_BYTES, stream>>>(p, ph, ph + 1, groups[gi]);
    } else {
      fwd_kernel<<<grid_blocks, 256, LDS_BYTES, stream>>>(p, ph, ph + 1, 15);
    }
  }
#else
  hipMemsetAsync((char*)d_ws + OFF_BAR, 0, XCD_BAR_WORDS * 4, stream);
  int ph0 = 0, ph1 = NPHASES, smask = 15;
  void* args[] = {&p, &ph0, &ph1, &smask};
  hipError_t e = hipLaunchCooperativeKernel((void*)fwd_kernel, dim3(grid_blocks), dim3(256), args, LDS_BYTES, stream);
  if (e != hipSuccess) fprintf(stderr, "cooperative launch failed: %s (grid %d)\n", hipGetErrorString(e), grid_blocks);
#endif
#else
  const dim3 g(512), b(256);
  for (int l = 0; l < 2; ++l) {
    k_phase<0><<<g, b, 0, stream>>>(p, l);
    k_phase<1><<<g, b, 0, stream>>>(p, l);
    k_phase<2><<<g, b, 0, stream>>>(p, l);
    k_phase<3><<<g, b, 0, stream>>>(p, l);
    k_phase<4><<<g, b, 0, stream>>>(p, l);
    k_phase<5><<<g, b, 0, stream>>>(p, l);
    k_phase<6><<<g, b, 0, stream>>>(p, l);
    k_phase<7><<<g, b, 0, stream>>>(p, l);
    k_phase<8><<<g, b, 0, stream>>>(p, l);
    k_phase<9><<<g, b, 0, stream>>>(p, l);
  }
  k_phase<10><<<g, b, 0, stream>>>(p, 0);
#endif
}
```

```cpp
#include <hip/hip_runtime.h>
#include <hip/hip_cooperative_groups.h>
#include <cstdio>
#include <cstdint>
namespace cg = cooperative_groups;

#ifndef COOP
#define COOP 1
#endif

#define LAS __attribute__((address_space(3)))
typedef unsigned short bf16_t;
typedef __attribute__((ext_vector_type(8))) short bf16x8;
typedef __attribute__((ext_vector_type(4))) float f32x4;
typedef __attribute__((ext_vector_type(4))) unsigned u32x4;

constexpr int T_TOK = 16384, SEQ = 2048, DM = 1024;
constexpr int IN_COLS = 9992, NZ = 5896, ZS = 5904;
constexpr int ZHG = 0, ZRW = 2048, ZS5 = 3840, ZMB = 4352;
constexpr int FFH = 2816;
constexpr int NPH_LAYER = 10, NPHASES = 21;

constexpr size_t OFF_WTIN   = 0;
constexpr size_t OFF_WTGATE = OFF_WTIN + (size_t)5896 * 1024 * 2;
constexpr size_t OFF_WTBR   = OFF_WTGATE + (size_t)4096 * 1024 * 2;
constexpr size_t OFF_WTOUT  = OFF_WTBR + (size_t)4 * 1024 * 512 * 2;
constexpr size_t OFF_WTF1   = OFF_WTOUT + (size_t)1024 * 1024 * 2;
constexpr size_t OFF_WTF2   = OFF_WTF1 + (size_t)5632 * 1024 * 2;
constexpr size_t OFF_WTGLU  = OFF_WTF2 + (size_t)1024 * 2816 * 2;
constexpr size_t OFF_U      = OFF_WTGLU + (size_t)512 * 512 * 2;
constexpr size_t OFF_Z      = OFF_U + (size_t)T_TOK * 1024 * 2;
constexpr size_t OFF_VF     = OFF_Z + (size_t)T_TOK * ZS * 2;
constexpr size_t OFF_BAR    = OFF_VF + (size_t)T_TOK * 512 * 2;
constexpr size_t OFF_WTGATE_B = OFF_BAR + 16384;
constexpr size_t OFF_WB_B     = OFF_WTGATE_B + (size_t)4096 * 1024 * 2;
constexpr size_t OFF_LORA     = OFF_WB_B + (OFF_U - OFF_WTBR);
constexpr size_t LORA_STRIDE  = 524288;
constexpr size_t LO_G2 = 0, LO_W2 = 131072, LO_A2 = 196608, LO_V1 = 262144, LO_V2 = 294912;
constexpr size_t WS_NEED      = OFF_LORA + 2 * LORA_STRIDE;
constexpr size_t DELTA_GATE   = OFF_WTGATE_B - OFF_WTGATE;
constexpr size_t DELTA_WB     = OFF_WB_B - OFF_WTBR;
#define WOFF_GATE(l) (OFF_WTGATE + (size_t)(l) * DELTA_GATE)
#define WOFF(off, l) ((off) + (size_t)(l) * DELTA_WB)

struct Params {
  const float* in[41];
  float* out;
  char* ws;
};

enum { I_X = 0, I_NORM_MIX, I_W_IN, I_W_BRANCH, I_W_OUT, I_NORM_FFN, I_W_FFN_IN, I_W_FFN_OUT, I_NORM_FINAL,
       I_HG_LB, I_HG_NW, I_RW_MU, I_RW_W0, I_RW_W2, I_RW_A0, I_RW_A2, I_RW_G2, I_RW_KK, I_RW_KA, I_RW_RK,
       I_RW_LNW, I_RW_LNB, I_RW_V0, I_RW_V1, I_RW_V2, I_S5_ARE, I_S5_AIM, I_S5_BRE, I_S5_BIM, I_S5_CRE,
       I_S5_CIM, I_S5_D, I_S5_LOGDT, I_S5_WGLU, I_S5_BGLU, I_MB_CONVW, I_MB_CONVB, I_MB_DTB, I_MB_ALOG,
       I_MB_D, I_MB_NW };

__device__ __forceinline__ float bf2f(bf16_t v) { return __uint_as_float(((unsigned)v) << 16); }
typedef __attribute__((ext_vector_type(2))) __bf16 bf16x2_t;
__device__ __forceinline__ unsigned pack2(float a, float b) {
  bf16x2_t v;
  v[0] = (__bf16)a;
  v[1] = (__bf16)b;
  return __builtin_bit_cast(unsigned, v);
}
__device__ __forceinline__ bf16_t f2bf(float f) { return (bf16_t)(pack2(f, 0.f) & 0xffffu); }
__device__ __forceinline__ float sigmoidf_(float x) { return 1.f / (1.f + __expf(-x)); }
__device__ __forceinline__ float siluf_(float x) { return x / (1.f + __expf(-x)); }
__device__ __forceinline__ float softplusf_(float x) { return x > 20.f ? x : log1pf(__expf(x)); }
__device__ __forceinline__ float gelu_tanh(float x) {
  float u = 0.7978845608028654f * (x + 0.044715f * x * x * x);
  return 0.5f * x * (1.f + tanhf(u));
}
__device__ __forceinline__ float frcp(float x) { return __builtin_amdgcn_rcpf(x); }
__device__ __forceinline__ float fsigmoid(float x) { return frcp(1.f + __expf(-x)); }
__device__ __forceinline__ float fsilu(float x) { return x * frcp(1.f + __expf(-x)); }
__device__ __forceinline__ float fsoftplus(float x) { return x > 20.f ? x : __logf(1.f + __expf(x)); }
__device__ __forceinline__ float ftanh(float x) {
  float e = __expf(2.f * fminf(fmaxf(x, -15.f), 15.f));
  return (e - 1.f) * frcp(e + 1.f);
}
__device__ __forceinline__ float fgelu(float x) {
  float u = 0.7978845608028654f * (x + 0.044715f * x * x * x);
  return 0.5f * x * (1.f + ftanh(u));
}

__device__ __forceinline__ float quad_sum(float x) {
  x += __builtin_bit_cast(float, __builtin_amdgcn_update_dpp(0, __builtin_bit_cast(int, x), 0xB1, 0xF, 0xF, true));
  x += __builtin_bit_cast(float, __builtin_amdgcn_update_dpp(0, __builtin_bit_cast(int, x), 0x4E, 0xF, 0xF, true));
  return x;
}
__device__ __forceinline__ float oct_sum(float x) {
  x = quad_sum(x);
  x += __builtin_bit_cast(float, __builtin_amdgcn_update_dpp(0, __builtin_bit_cast(int, x), 0x141, 0xF, 0xF, true));
  return x;
}
__device__ __forceinline__ float sum16(float x) {
  x += __shfl_xor(x, 1); x += __shfl_xor(x, 2); x += __shfl_xor(x, 4); x += __shfl_xor(x, 8);
  return x;
}
__device__ __forceinline__ float sum64(float x) {
  x = sum16(x); x += __shfl_xor(x, 16); x += __shfl_xor(x, 32);
  return x;
}

__device__ __forceinline__ int opaque_tid() {
  int t = threadIdx.x;
  asm volatile("" : "+v"(t));
  return t;
}

template <int BN>
__device__ __forceinline__ void gemm_mainloop(f32x4 (&acc)[4][BN / 32], const bf16_t* A, int lda, int m0,
                                              const bf16_t* Bt, int ldb, int n0, int nmax, int K, char* smem, const int tid) {
  const int lane = tid & 63, wid = tid >> 6, wm = wid >> 1, wn = wid & 1;
  const int q = tid & 7, r0 = tid >> 3;
  unsigned offA[4], offB[BN / 32];
#pragma unroll
  for (int i = 0; i < 4; ++i) offA[i] = ((unsigned)(m0 + r0 + 32 * i) * (unsigned)lda + (unsigned)q * 8u) * 2u;
#pragma unroll
  for (int i = 0; i < BN / 32; ++i) {
    int row = n0 + r0 + 32 * i;
    row = row < nmax ? row : nmax;
    offB[i] = ((unsigned)row * (unsigned)ldb + (unsigned)q * 8u) * 2u;
  }
  const unsigned sto = (unsigned)r0 * 128u + (unsigned)((q ^ ((r0 >> 1) & 7)) << 4);
  unsigned aoff[4], boff[BN / 32];
#pragma unroll
  for (int mi = 0; mi < 4; ++mi) {
    int row = wm * 64 + mi * 16 + (lane & 15);
    aoff[mi] = (unsigned)row * 128u + (unsigned)(((lane >> 4) ^ ((row >> 1) & 7)) << 4);
  }
#pragma unroll
  for (int ni = 0; ni < BN / 32; ++ni) {
    int row = wn * (BN / 2) + ni * 16 + (lane & 15);
    boff[ni] = (unsigned)row * 128u + (unsigned)(((lane >> 4) ^ ((row >> 1) & 7)) << 4);
  }
  const char* Ab = reinterpret_cast<const char*>(A);
  const char* Bb = reinterpret_cast<const char*>(Bt);
  const int nk = K >> 6;
  constexpr bool WIDE = (BN == 128);
  u32x4 Ra0, Ra1, Ra2, Ra3, Rb0, Rb1, Rb2, Rb3;
  u32x4 Qa0, Qa1, Qa2, Qa3, Qb0, Qb1, Qb2, Qb3;
#define GLOAD(P, TILE)                                                         \
  {                                                                            \
    const char* Ak_ = Ab + (size_t)(TILE) * 128;                               \
    const char* Bk_ = Bb + (size_t)(TILE) * 128;                               \
    P##a0 = *reinterpret_cast<const u32x4*>(Ak_ + offA[0]);                    \
    P##a1 = *reinterpret_cast<const u32x4*>(Ak_ + offA[1]);                    \
    P##a2 = *reinterpret_cast<const u32x4*>(Ak_ + offA[2]);                    \
    P##a3 = *reinterpret_cast<const u32x4*>(Ak_ + offA[3]);                    \
    P##b0 = *reinterpret_cast<const u32x4*>(Bk_ + offB[0]);                    \
    P##b1 = *reinterpret_cast<const u32x4*>(Bk_ + offB[1]);                    \
    if (WIDE) {                                                                \
      P##b2 = *reinterpret_cast<const u32x4*>(Bk_ + offB[BN / 32 - 2]);        \
      P##b3 = *reinterpret_cast<const u32x4*>(Bk_ + offB[BN / 32 - 1]);        \
    }                                                                          \
  }
#define SSTORE(P, BUF)                                                         \
  {                                                                            \
    char* ad_ = smem + (BUF) * 16384 + sto;                                    \
    char* bd_ = smem + 32768 + (BUF) * (BN * 128) + sto;                       \
    *reinterpret_cast<u32x4*>(ad_) = P##a0;                                    \
    *reinterpret_cast<u32x4*>(ad_ + 4096) = P##a1;                             \
    *reinterpret_cast<u32x4*>(ad_ + 8192) = P##a2;                             \
    *reinterpret_cast<u32x4*>(ad_ + 12288) = P##a3;                            \
    *reinterpret_cast<u32x4*>(bd_) = P##b0;                                    \
    *reinterpret_cast<u32x4*>(bd_ + 4096) = P##b1;                             \
    if (WIDE) {                                                                \
      *reinterpret_cast<u32x4*>(bd_ + 8192) = P##b2;                           \
      *reinterpret_cast<u32x4*>(bd_ + 12288) = P##b3;                          \
    }                                                                          \
  }
#define COMPUTE(BUF)                                                           \
  {                                                                            \
    const char* a_s = smem + (BUF) * 16384;                                    \
    const char* b_s = smem + 32768 + (BUF) * (BN * 128);                       \
    _Pragma("unroll") for (int ks = 0; ks < 2; ++ks) {                         \
      bf16x8 af[4], bfr[BN / 32];                                              \
      _Pragma("unroll") for (int mi = 0; mi < 4; ++mi)                         \
          af[mi] = *reinterpret_cast<const bf16x8*>(a_s + (aoff[mi] ^ (ks * 64)));       \
      _Pragma("unroll") for (int ni = 0; ni < BN / 32; ++ni)                   \
          bfr[ni] = *reinterpret_cast<const bf16x8*>(b_s + (boff[ni] ^ (ks * 64)));      \
      _Pragma("unroll") for (int mi = 0; mi < 4; ++mi)                         \
        _Pragma("unroll") for (int ni = 0; ni < BN / 32; ++ni)                 \
          acc[mi][ni] = __builtin_amdgcn_mfma_f32_16x16x32_bf16(bfr[ni], af[mi], acc[mi][ni], 0, 0, 0); \
    }                                                                          \
  }
  if constexpr (WIDE && false) {
    GLOAD(R, 0);
    SSTORE(R, 0);
    GLOAD(R, 1);
    if (nk > 2) GLOAD(Q, 2);
    __syncthreads();
#pragma unroll 1
    for (int kt = 0; kt < nk; kt += 2) {
      __builtin_amdgcn_sched_barrier(0);
      COMPUTE(0);
      __builtin_amdgcn_sched_barrier(0);
      SSTORE(R, 1);
      if (kt + 3 < nk) GLOAD(R, kt + 3);
      __syncthreads();
      __builtin_amdgcn_sched_barrier(0);
      COMPUTE(1);
      __builtin_amdgcn_sched_barrier(0);
      if (kt + 2 < nk) SSTORE(Q, 0);
      if (kt + 4 < nk) GLOAD(Q, kt + 4);
      __syncthreads();
    }
  } else {
    GLOAD(R, 0);
    SSTORE(R, 0);
    __syncthreads();
#pragma unroll 1
    for (int kt = 0; kt < nk; ++kt) {
      const int buf = kt & 1;
      const bool more = (kt + 1 < nk);
      if (more) GLOAD(R, kt + 1);
      __builtin_amdgcn_sched_barrier(0);
      COMPUTE(buf);
      __builtin_amdgcn_sched_barrier(0);
      if (more) SSTORE(R, buf ^ 1);
      __syncthreads();
    }
  }
#undef GLOAD
#undef SSTORE
#undef COMPUTE
}

template <int BN>
__device__ __forceinline__ void zero_acc(f32x4 (&acc)[4][BN / 32]) {
#pragma unroll
  for (int mi = 0; mi < 4; ++mi)
#pragma unroll
    for (int ni = 0; ni < BN / 32; ++ni) acc[mi][ni] = f32x4{0.f, 0.f, 0.f, 0.f};
}

#define RAW_BARRIER() do { asm volatile("s_waitcnt lgkmcnt(0)" ::: "memory"); __builtin_amdgcn_s_barrier(); } while (0)
__device__ __forceinline__ void gemm_mainloop_big(f32x4 (&acc)[8][4], const bf16_t* A, int lda, int m0, const bf16_t* Bt,
                                                  int ldb, int n0, int nmax, int K, char* smem, const int tid) {
  const int lane = tid & 63, wid = tid >> 6, wm = wid >> 1, wn = wid & 1;
  unsigned gA[4], gB[2];
#pragma unroll
  for (int i = 0; i < 4; ++i) {
    const int row = (wid * 4 + i) * 16 + (lane >> 2);
    const int q = (lane & 3) ^ ((row >> 2) & 3);
    gA[i] = ((unsigned)(m0 + row) * (unsigned)lda + (unsigned)q * 8u) * 2u;
  }
#pragma unroll
  for (int i = 0; i < 2; ++i) {
    const int row = (wid * 2 + i) * 16 + (lane >> 2);
    const int q = (lane & 3) ^ ((row >> 2) & 3);
    int grow = n0 + row;
    grow = grow < nmax ? grow : nmax;
    gB[i] = ((unsigned)grow * (unsigned)ldb + (unsigned)q * 8u) * 2u;
  }
  unsigned aoff[8], boff[4];
#pragma unroll
  for (int mi = 0; mi < 8; ++mi) {
    int row = wm * 128 + mi * 16 + (lane & 15);
    aoff[mi] = (unsigned)row * 64u + (unsigned)(((lane >> 4) ^ ((row >> 2) & 3)) << 4);
  }
#pragma unroll
  for (int ni = 0; ni < 4; ++ni) {
    int row = wn * 64 + ni * 16 + (lane & 15);
    boff[ni] = 16384u + (unsigned)row * 64u + (unsigned)(((lane >> 4) ^ ((row >> 2) & 3)) << 4);
  }
  const char* Ab = reinterpret_cast<const char*>(A);
  const char* Bb = reinterpret_cast<const char*>(Bt);
  const int nk = K >> 5;
  char* ldsA = smem + wid * 4096;
  char* ldsB = smem + 16384 + wid * 2048;
#define BG_GLDS(TILE, ST)                                                                                           \
  {                                                                                                                 \
    const char* Ak_ = Ab + (size_t)(TILE) * 64;                                                                     \
    const char* Bk_ = Bb + (size_t)(TILE) * 64;                                                                     \
    char* la_ = ldsA + (ST) * 24576;                                                                                \
    char* lb_ = ldsB + (ST) * 24576;                                                                                \
    __builtin_amdgcn_global_load_lds((const unsigned*)(Ak_ + gA[0]), (LAS unsigned*)(la_), 16, 0, 0);              \
    __builtin_amdgcn_global_load_lds((const unsigned*)(Ak_ + gA[1]), (LAS unsigned*)(la_ + 1024), 16, 0, 0);       \
    __builtin_amdgcn_global_load_lds((const unsigned*)(Ak_ + gA[2]), (LAS unsigned*)(la_ + 2048), 16, 0, 0);       \
    __builtin_amdgcn_global_load_lds((const unsigned*)(Ak_ + gA[3]), (LAS unsigned*)(la_ + 3072), 16, 0, 0);       \
    __builtin_amdgcn_global_load_lds((const unsigned*)(Bk_ + gB[0]), (LAS unsigned*)(lb_), 16, 0, 0);              \
    __builtin_amdgcn_global_load_lds((const unsigned*)(Bk_ + gB[1]), (LAS unsigned*)(lb_ + 1024), 16, 0, 0);       \
  }
#define BG_COMPUTE(ST)                                                                                              \
  {                                                                                                                 \
    const char* s_ = smem + (ST) * 24576;                                                                           \
    bf16x8 bfr[4], af[8];                                                                                           \
    _Pragma("unroll") for (int ni = 0; ni < 4; ++ni) bfr[ni] = *reinterpret_cast<const bf16x8*>(s_ + boff[ni]);     \
    _Pragma("unroll") for (int mi = 0; mi < 8; ++mi) af[mi] = *reinterpret_cast<const bf16x8*>(s_ + aoff[mi]);      \
    __builtin_amdgcn_sched_barrier(0);                                                                              \
    _Pragma("unroll") for (int mi = 0; mi < 8; ++mi)                                                                \
      _Pragma("unroll") for (int ni = 0; ni < 4; ++ni)                                                              \
        acc[mi][ni] = __builtin_amdgcn_mfma_f32_16x16x32_bf16(bfr[ni], af[mi], acc[mi][ni], 0, 0, 0);               \
  }
  asm volatile("s_waitcnt vmcnt(0)" ::: "memory");
  BG_GLDS(0, 0);
  BG_GLDS(1, 1);
  int st = 0;
#pragma unroll 1
  for (int kt = 0; kt < nk - 1; ++kt) {
    asm volatile("s_waitcnt vmcnt(6)" ::: "memory");
    RAW_BARRIER();
    if (kt + 2 < nk) {
      const int st2 = (st >= 1) ? st - 1 : 2;
      BG_GLDS(kt + 2, st2);
    }
    __builtin_amdgcn_sched_barrier(0);
    BG_COMPUTE(st);
    __builtin_amdgcn_sched_barrier(0);
    st = (st == 2) ? 0 : st + 1;
  }
  asm volatile("s_waitcnt vmcnt(0)" ::: "memory");
  RAW_BARRIER();
  BG_COMPUTE(st);
  RAW_BARRIER();
#undef BG_GLDS
#undef BG_COMPUTE
}

__device__ __forceinline__ void zero_acc_big(f32x4 (&acc)[8][4]) {
#pragma unroll
  for (int mi = 0; mi < 8; ++mi)
#pragma unroll
    for (int ni = 0; ni < 4; ++ni) acc[mi][ni] = f32x4{0.f, 0.f, 0.f, 0.f};
}

__device__ __forceinline__ void conv_tile(const float* src, int ld, int nlimit, int k0, int n0, bf16_t* dst, int Kd, int mode,
                                          char* smem, const int tid) {
  float* sT = reinterpret_cast<float*>(smem);
#pragma unroll
  for (int i = 0; i < 16; ++i) {
    int kk = i * 4 + (tid >> 6), nn = tid & 63;
    float v = (n0 + nn < nlimit) ? src[(size_t)(k0 + kk) * ld + n0 + nn] : 0.f;
    sT[kk * 65 + nn] = v;
  }
  __syncthreads();
  {
    int nn = tid >> 2, kq = tid & 3;
    int n = n0 + nn;
    if (n < nlimit) {
      int drow = n;
      if (mode == 1) {
        if (n < FFH) drow = (n >> 4) * 32 + (n & 15);
        else { int j = n - FFH; drow = (j >> 4) * 32 + 16 + (j & 15); }
      }
      unsigned pk[8];
#pragma unroll
      for (int j = 0; j < 8; ++j) pk[j] = pack2(sT[(kq * 16 + 2 * j) * 65 + nn], sT[(kq * 16 + 2 * j + 1) * 65 + nn]);
      uint4* d = reinterpret_cast<uint4*>(dst + (size_t)drow * Kd + k0 + kq * 16);
      d[0] = uint4{pk[0], pk[1], pk[2], pk[3]};
      d[1] = uint4{pk[4], pk[5], pk[6], pk[7]};
    }
  }
  __syncthreads();
}

__device__ __forceinline__ void rmsnorm_row_to_bf16(const float* x, const float* w, bf16_t* out, const int lane) {
  float4 v[4];
  float ss = 0.f;
#pragma unroll
  for (int i = 0; i < 4; ++i) {
    v[i] = *reinterpret_cast<const float4*>(x + i * 256 + lane * 4);
    ss += v[i].x * v[i].x + v[i].y * v[i].y + v[i].z * v[i].z + v[i].w * v[i].w;
  }
  ss = sum64(ss);
  float rstd = rsqrtf(ss * (1.f / 1024.f) + 1e-6f);
#pragma unroll
  for (int i = 0; i < 4; ++i) {
    float4 ww = *reinterpret_cast<const float4*>(w + i * 256 + lane * 4);
    uint2 o;
    o.x = pack2(v[i].x * rstd * ww.x, v[i].y * rstd * ww.y);
    o.y = pack2(v[i].z * rstd * ww.z, v[i].w * rstd * ww.w);
    *reinterpret_cast<uint2*>(out + i * 256 + lane * 4) = o;
  }
}

constexpr int CT_IN = 157 * 16, CT_BR = 512, CT_OUT = 256, CT_F1 = 88 * 16, CT_F2 = 44 * 16, CT_GLU = 64;
constexpr int CT_TOTAL = CT_IN + CT_BR + CT_OUT + CT_F1 + CT_F2 + CT_GLU;

__device__ __forceinline__ void convert_one(const Params& p, int l, int c, char* smem, const int tid) {
  char* ws = p.ws;
  if (c < CT_IN) {
    int nt = c >> 4, kt = c & 15;
    const float* src = p.in[I_W_IN] + (size_t)l * 1024 * IN_COLS;
    if (nt < 64) conv_tile(src, IN_COLS, IN_COLS, kt * 64, nt * 64, (bf16_t*)(ws + WOFF_GATE(l)), 1024, 0, smem, tid);
    else conv_tile(src + 4096, IN_COLS, IN_COLS - 4096, kt * 64, (nt - 64) * 64, (bf16_t*)(ws + OFF_WTIN), 1024, 0, smem, tid);
    return;
  }
  c -= CT_IN;
  if (c < CT_BR) {
    int kb = c >> 7, r = c & 127, nt = r >> 3, kt = r & 7;
    const float* src = p.in[I_W_BRANCH] + ((size_t)l * 4 + kb) * 512 * 1024;
    conv_tile(src, 1024, 1024, kt * 64, nt * 64, (bf16_t*)(ws + WOFF(OFF_WTBR, l)) + (size_t)kb * 1024 * 512, 512, 0, smem, tid);
    return;
  }
  c -= CT_BR;
  if (c < CT_OUT) {
    int nt = c >> 4, kt = c & 15;
    conv_tile(p.in[I_W_OUT] + (size_t)l * 1024 * 1024, 1024, 1024, kt * 64, nt * 64, (bf16_t*)(ws + WOFF(OFF_WTOUT, l)), 1024, 0, smem, tid);
    return;
  }
  c -= CT_OUT;
  if (c < CT_F1) {
    int nt = c >> 4, kt = c & 15;
    conv_tile(p.in[I_W_FFN_IN] + (size_t)l * 1024 * 5632, 5632, 5632, kt * 64, nt * 64, (bf16_t*)(ws + WOFF(OFF_WTF1, l)), 1024, 1, smem, tid);
    return;
  }
  c -= CT_F1;
  if (c < CT_F2) {
    int nt = c / 44, kt = c % 44;
    conv_tile(p.in[I_W_FFN_OUT] + (size_t)l * FFH * 1024, 1024, 1024, kt * 64, nt * 64, (bf16_t*)(ws + WOFF(OFF_WTF2, l)), FFH, 0, smem, tid);
    return;
  }
  c -= CT_F2;
  {
    int nt = c >> 3, kt = c & 7;
    conv_tile(p.in[I_S5_WGLU] + (size_t)l * 512 * 512, 512, 512, kt * 64, nt * 64, (bf16_t*)(ws + WOFF(OFF_WTGLU, l)), 512, 0, smem, tid);
  }
}

constexpr int CT_LORA = 41;
__device__ __forceinline__ void convert_lora(const Params& p, int l, int c, char* smem, const int tid) {
  char* lo = p.ws + OFF_LORA + (size_t)l * LORA_STRIDE;
  if (c < 16) { int nt = c >> 1, kt = c & 1;
    conv_tile(p.in[I_RW_G2] + (size_t)l * 128 * 512, 512, 512, kt * 64, nt * 64, (bf16_t*)(lo + LO_G2), 128, 0, smem, tid); return; }
  c -= 16;
  if (c < 8) { conv_tile(p.in[I_RW_W2] + (size_t)l * 64 * 512, 512, 512, 0, c * 64, (bf16_t*)(lo + LO_W2), 64, 0, smem, tid); return; }
  c -= 8;
  if (c < 8) { conv_tile(p.in[I_RW_A2] + (size_t)l * 64 * 512, 512, 512, 0, c * 64, (bf16_t*)(lo + LO_A2), 64, 0, smem, tid); return; }
  c -= 8;
  if (l == 0) return;
  if (c < 8) { conv_tile(p.in[I_RW_V1] + (size_t)(l - 1) * 512 * 32, 32, 32, c * 64, 0, (bf16_t*)(lo + LO_V1), 512, 0, smem, tid); return; }
  {
    const float* src = p.in[I_RW_V2] + (size_t)(l - 1) * 32 * 512;
    bf16_t* dst = (bf16_t*)(lo + LO_V2);
    for (int e = tid; e < 32 * 512; e += 256) { int ch = e >> 5, r = e & 31; dst[e] = f2bf(src[r * 512 + ch]); }
  }
}

template <int J>
__device__ __forceinline__ void lora_mfma(const char* sIn, int rowb, const bf16_t* Wt, f32x4 (&acc)[8], const int tid) {
  const int lane = tid & 63, w = tid >> 6;
#pragma unroll
  for (int i = 0; i < 8; ++i) acc[i] = f32x4{0.f, 0.f, 0.f, 0.f};
#pragma unroll
  for (int ks = 0; ks < J / 32; ++ks) {
    const bf16x8 a = *reinterpret_cast<const bf16x8*>(sIn + (lane & 15) * rowb + (ks * 32 + 8 * (lane >> 4)) * 2);
#pragma unroll
    for (int i = 0; i < 8; ++i) {
      const bf16x8 b = *reinterpret_cast<const bf16x8*>(Wt + (size_t)((w * 8 + i) * 16 + (lane & 15)) * J + ks * 32 + 8 * (lane >> 4));
      acc[i] = __builtin_amdgcn_mfma_f32_16x16x32_bf16(a, b, acc[i], 0, 0, 0);
    }
  }
}

__device__ void phase_convert_norm(const Params& p, int l, char* smem) {
  const int tid = opaque_tid();
  const int nconv = (l == 0) ? CT_TOTAL + 2 * CT_LORA : 0;
  const int ntask = nconv + T_TOK / 4;
  const float* xsrc = (l == 0) ? p.in[I_X] : p.out;
  for (int t = blockIdx.x; t < ntask; t += gridDim.x) {
    if (t < nconv) {
      if (t < CT_TOTAL) convert_one(p, l, t, smem, tid);
      else { int c = t - CT_TOTAL; convert_lora(p, c / CT_LORA, c % CT_LORA, smem, tid); __syncthreads(); }
    } else {
      int row = (t - nconv) * 4 + (tid >> 6);
      rmsnorm_row_to_bf16(xsrc + (size_t)row * DM, p.in[I_NORM_MIX] + l * DM, (bf16_t*)(p.ws + OFF_U) + (size_t)row * DM, tid & 63);
    }
  }
}

__device__ void phase_norm_only(const Params& p, const float* xsrc, const float* w) {
  const int tid = opaque_tid();
  for (int t = blockIdx.x; t < T_TOK / 4; t += gridDim.x) {
    int row = t * 4 + (tid >> 6);
    rmsnorm_row_to_bf16(xsrc + (size_t)row * DM, w, (bf16_t*)(p.ws + OFF_U) + (size_t)row * DM, tid & 63);
  }
}

__device__ __forceinline__ bool tile_map(int t, int NT, int& mt, int& nt) {
  const int x = t & 7, r = t >> 3;
  const int cnt = (NT + 7) >> 3;
  const int ni = r % cnt;
  mt = r / cnt;
  nt = x + 8 * ni;
  return nt < NT;
}
__device__ __forceinline__ int tile_count(int MT, int NT) { return 8 * MT * ((NT + 7) >> 3); }

__device__ void phase_inproj(const Params& p, char* smem) {
  const bf16_t* U = (const bf16_t*)(p.ws + OFF_U);
  const bf16_t* Wt = (const bf16_t*)(p.ws + OFF_WTIN);
  bf16_t* Z = (bf16_t*)(p.ws + OFF_Z);
  const int tid = opaque_tid();
  const int lane = tid & 63, wid = tid >> 6, wm = wid >> 1, wn = wid & 1;
  constexpr int NT = 47;
  for (int t = blockIdx.x; t < tile_count(64, NT); t += gridDim.x) {
    int mt, nt;
    if (!tile_map(t, NT, mt, nt)) continue;
    f32x4 acc[8][4];
    zero_acc_big(acc);
    gemm_mainloop_big(acc, U, 1024, mt * 256, Wt, 1024, nt * 128, NZ - 1, 1024, smem, tid);
#pragma unroll
    for (int mi = 0; mi < 8; ++mi)
#pragma unroll
      for (int ni = 0; ni < 4; ++ni) {
        int col = nt * 128 + wn * 64 + ni * 16 + (lane >> 4) * 4;
        int row = mt * 256 + wm * 128 + mi * 16 + (lane & 15);
        if (col < NZ) {
          uint2 o;
          o.x = pack2(acc[mi][ni][0], acc[mi][ni][1]);
          o.y = pack2(acc[mi][ni][2], acc[mi][ni][3]);
          *reinterpret_cast<uint2*>(Z + (size_t)row * ZS + col) = o;
        }
      }
  }
}

template <int J>
__device__ __forceinline__ void lora_mm(const float* sIn, const float* W, float (&a0)[16], float (&a1)[16], const int tid) {
#pragma unroll
  for (int i = 0; i < 16; ++i) { a0[i] = 0.f; a1[i] = 0.f; }
#pragma unroll 8
  for (int j = 0; j < J; ++j) {
    float w0 = W[j * 512 + tid], w1 = W[j * 512 + tid + 256];
    const float4* x4 = reinterpret_cast<const float4*>(sIn + j * 16);
#pragma unroll
    for (int q = 0; q < 4; ++q) {
      float4 x = x4[q];
      a0[q * 4 + 0] = fmaf(w0, x.x, a0[q * 4 + 0]); a1[q * 4 + 0] = fmaf(w1, x.x, a1[q * 4 + 0]);
      a0[q * 4 + 1] = fmaf(w0, x.y, a0[q * 4 + 1]); a1[q * 4 + 1] = fmaf(w1, x.y, a1[q * 4 + 1]);
      a0[q * 4 + 2] = fmaf(w0, x.z, a0[q * 4 + 2]); a1[q * 4 + 2] = fmaf(w1, x.z, a1[q * 4 + 2]);
      a0[q * 4 + 3] = fmaf(w0, x.w, a0[q * 4 + 3]); a1[q * 4 + 3] = fmaf(w1, x.w, a1[q * 4 + 3]);
    }
  }
}

__device__ __forceinline__ float rw_shift(const bf16_t* Z, int row, int s, int rc, float mu) {
  float cur = bf2f(Z[(size_t)row * ZS + ZRW + rc]);
  float prev = (s > 0) ? bf2f(Z[(size_t)(row - 1) * ZS + ZRW + rc]) : 0.f;
  return cur + (prev - cur) * mu;
}

__device__ void phase_rwprep(const Params& p, int l, char* smem) {
  const bf16_t* Z = (const bf16_t*)(p.ws + OFF_Z);
  bf16_t* LW = (bf16_t*)(p.ws + OFF_U);
  bf16_t* LA = LW + (size_t)T_TOK * 512;
  bf16_t* VF = (bf16_t*)(p.ws + OFF_VF);
  const char* lo = p.ws + OFF_LORA + (size_t)l * LORA_STRIDE;
  char* sXw = smem;
  char* sXa = smem + 2304;
  char* sZv = smem + 4608;
  float* sTmpF = reinterpret_cast<float*>(smem + 4608 + 16640);
  char* sTmp = smem + 4608 + 16640 + 4096;
  const float* mu = p.in[I_RW_MU] + l * 1792;
  const int tid = opaque_tid(), lane = tid & 63, w = tid >> 6;
  for (int t = blockIdx.x; t < T_TOK / 16; t += gridDim.x) {
    const int row0 = t * 16;
    for (int e = tid; e < 2048; e += 256) {
      int which = e >> 10, r = e & 1023, tok = r >> 6, j = r & 63;
      int row = row0 + tok, sq = row & (SEQ - 1);
      int rc = 1536 + which * 64 + j;
      float z = rw_shift(Z, row, sq, rc, mu[rc]);
      if (which == 0) *reinterpret_cast<bf16_t*>(sXw + tok * 144 + j * 2) = f2bf(ftanh(z));
      else *reinterpret_cast<bf16_t*>(sXa + tok * 144 + j * 2) = f2bf(z);
    }
    {
      float m0 = mu[1024 + tid], m1 = mu[1024 + tid + 256];
#pragma unroll 4
      for (int tok = 0; tok < 16; ++tok) {
        int row = row0 + tok, sq = row & (SEQ - 1);
        bf16_t z0 = f2bf(rw_shift(Z, row, sq, 1024 + tid, m0));
        bf16_t z1 = f2bf(rw_shift(Z, row, sq, 1024 + tid + 256, m1));
        *reinterpret_cast<bf16_t*>(sZv + tok * 1040 + tid * 2) = z0;
        *reinterpret_cast<bf16_t*>(sZv + tok * 1040 + (tid + 256) * 2) = z1;
        if (l == 0) {
          VF[(size_t)row * 512 + tid] = z0;
          VF[(size_t)row * 512 + tid + 256] = z1;
        }
      }
    }
    __syncthreads();
    f32x4 acc[8];
    lora_mfma<64>(sXw, 144, (const bf16_t*)(lo + LO_W2), acc, tid);
#pragma unroll
    for (int i = 0; i < 8; ++i)
#pragma unroll
      for (int jj = 0; jj < 4; ++jj)
        LW[(size_t)(row0 + (lane >> 4) * 4 + jj) * 512 + (w * 8 + i) * 16 + (lane & 15)] = f2bf(acc[i][jj]);
    lora_mfma<64>(sXa, 144, (const bf16_t*)(lo + LO_A2), acc, tid);
#pragma unroll
    for (int i = 0; i < 8; ++i)
#pragma unroll
      for (int jj = 0; jj < 4; ++jj)
        LA[(size_t)(row0 + (lane >> 4) * 4 + jj) * 512 + (w * 8 + i) * 16 + (lane & 15)] = f2bf(acc[i][jj]);
    if (l > 0) {
      {
        const bf16_t* v1t = (const bf16_t*)(lo + LO_V1);
        const int ntile = w & 1, kh = w >> 1;
        f32x4 tacc = f32x4{0.f, 0.f, 0.f, 0.f};
#pragma unroll
        for (int ks = 0; ks < 8; ++ks) {
          const int k0 = (kh * 8 + ks) * 32 + 8 * (lane >> 4);
          const bf16x8 a = *reinterpret_cast<const bf16x8*>(sZv + (lane & 15) * 1040 + k0 * 2);
          const bf16x8 b = *reinterpret_cast<const bf16x8*>(v1t + (size_t)(ntile * 16 + (lane & 15)) * 512 + k0);
          tacc = __builtin_amdgcn_mfma_f32_16x16x32_bf16(a, b, tacc, 0, 0, 0);
        }
#pragma unroll
        for (int jj = 0; jj < 4; ++jj)
          sTmpF[(kh * 16 + (lane >> 4) * 4 + jj) * 32 + ntile * 16 + (lane & 15)] = tacc[jj];
      }
      __syncthreads();
      for (int e = tid; e < 512; e += 256) {
        int tok = e >> 5, r = e & 31;
        *reinterpret_cast<bf16_t*>(sTmp + tok * 80 + r * 2) = f2bf(sTmpF[tok * 32 + r] + sTmpF[(16 + tok) * 32 + r]);
      }
      __syncthreads();
      lora_mfma<32>(sTmp, 80, (const bf16_t*)(lo + LO_V2), acc, tid);
      const float* v0 = p.in[I_RW_V0] + (size_t)(l - 1) * 512;
#pragma unroll
      for (int i = 0; i < 8; ++i) {
        const int ch = (w * 8 + i) * 16 + (lane & 15);
        const float b0 = v0[ch];
#pragma unroll
        for (int jj = 0; jj < 4; ++jj) {
          const int tok = (lane >> 4) * 4 + jj;
          const float zv = bf2f(*reinterpret_cast<const bf16_t*>(sZv + tok * 1040 + ch * 2));
          const size_t idx = (size_t)(row0 + tok) * 512 + ch;
          const float vf = bf2f(VF[idx]);
          VF[idx] = f2bf(zv + (vf - zv) * fsigmoid(b0 + acc[i][jj]));
        }
      }
    }
    __syncthreads();
  }
}

__device__ void hg_scan(const Params& p, int l, int task, char* smem) {
  const int b = task >> 3, h = (task >> 1) & 3, vg = task & 1;
  float* sFg = reinterpret_cast<float*>(smem);
  float* sQs = sFg + 16 * 128;
  float* sO = sQs + 16 * 128;
  float* sVv = sO + 4 * 16 * 64;
  const int tid = opaque_tid(), w = tid >> 6, lane = tid & 63;
  bf16_t* Z = (bf16_t*)(p.ws + OFF_Z) + (size_t)b * SEQ * ZS;
  const int ks = tid & 127;
  float lb = 0.f;
  if (l > 0) {
    float x0 = p.in[I_HG_LB][h * 128 + ks], x1 = p.in[I_HG_LB][512 + h * 128 + ks];
    float m = fmaxf(x0, x1), e0 = expf(x0 - m), e1 = expf(x1 - m);
    lb = e1 / (e0 + e1);
  }
  float s[32];
#pragma unroll
  for (int j = 0; j < 32; ++j) s[j] = 0.f;
  const int vcol = ZHG + 1024 + h * 128 + vg * 64;
  const int qcol = ZHG + h * 128 + ks;
  bf16_t rq0, rq1, rq2, rq3, rq4, rq5, rq6, rq7, rf0, rf1, rf2, rf3, rf4, rf5, rf6, rf7, rv0, rv1, rv2, rv3;
#define HG_LOAD(T0)                                                                                \
  {                                                                                                \
    const bf16_t* zb = Z + (size_t)((T0) + (tid >> 7)) * ZS + qcol;                                \
    rq0 = zb[0]; rf0 = zb[512]; zb += 2 * ZS; rq1 = zb[0]; rf1 = zb[512]; zb += 2 * ZS;            \
    rq2 = zb[0]; rf2 = zb[512]; zb += 2 * ZS; rq3 = zb[0]; rf3 = zb[512]; zb += 2 * ZS;            \
    rq4 = zb[0]; rf4 = zb[512]; zb += 2 * ZS; rq5 = zb[0]; rf5 = zb[512]; zb += 2 * ZS;            \
    rq6 = zb[0]; rf6 = zb[512]; zb += 2 * ZS; rq7 = zb[0]; rf7 = zb[512];                          \
    const bf16_t* zv = Z + (size_t)((T0) + w) * ZS + vcol + lane;                                  \
    rv0 = zv[0]; rv1 = zv[4 * ZS]; rv2 = zv[8 * ZS]; rv3 = zv[12 * ZS];                            \
  }
#define HG_PUT1(I, RQ, RF)                                                                         \
  {                                                                                                \
    int t = (tid >> 7) + 2 * (I);                                                                  \
    sFg[t * 128 + ks] = fmaxf(lb + (1.f - lb) * fsigmoid(bf2f(RF)), 1e-30f);                       \
    sQs[t * 128 + ks] = fsilu(bf2f(RQ));                                                           \
  }
#define HG_PROCESS()                                                                               \
  {                                                                                                \
    HG_PUT1(0, rq0, rf0) HG_PUT1(1, rq1, rf1) HG_PUT1(2, rq2, rf2) HG_PUT1(3, rq3, rf3)            \
    HG_PUT1(4, rq4, rf4) HG_PUT1(5, rq5, rf5) HG_PUT1(6, rq6, rf6) HG_PUT1(7, rq7, rf7)            \
    sVv[(w)*64 + lane] = bf2f(rv0); sVv[(w + 4) * 64 + lane] = bf2f(rv1);                          \
    sVv[(w + 8) * 64 + lane] = bf2f(rv2); sVv[(w + 12) * 64 + lane] = bf2f(rv3);                   \
  }
  HG_LOAD(0);
  HG_PROCESS();
  __syncthreads();
  constexpr int NCH = SEQ / 16;
#pragma unroll 1
  for (int c = 0; c < NCH; ++c) {
    const int t0 = c * 16;
    const int tn = (c + 1 < NCH) ? t0 + 16 : t0;
    HG_LOAD(tn);
    __builtin_amdgcn_sched_barrier(0);
#pragma unroll 2
    for (int t = 0; t < 16; ++t) {
      const float v = sVv[t * 64 + lane];
      const float opv = (lane < 32) ? sFg[t * 128 + w * 32 + lane] : sQs[t * 128 + w * 32 + (lane - 32)];
      const int opi = __builtin_bit_cast(int, opv);
      float o = 0.f;
#pragma unroll
      for (int j = 0; j < 32; ++j) {
        const float fg = __builtin_bit_cast(float, __builtin_amdgcn_readlane(opi, j));
        const float qq = __builtin_bit_cast(float, __builtin_amdgcn_readlane(opi, 32 + j));
        const float kv = fmaf(-fg, v, v);
        s[j] = fmaf(s[j], fg, kv);
        o = fmaf(qq, s[j], o);
      }
      sO[(w * 16 + t) * 64 + lane] = o;
    }
    __builtin_amdgcn_sched_barrier(0);
    __syncthreads();
    {
      int t = tid >> 4, v4 = (tid & 15) * 4;
      float4 a = *reinterpret_cast<const float4*>(sO + (0 * 16 + t) * 64 + v4);
      float4 bq = *reinterpret_cast<const float4*>(sO + (1 * 16 + t) * 64 + v4);
      float4 cq = *reinterpret_cast<const float4*>(sO + (2 * 16 + t) * 64 + v4);
      float4 d = *reinterpret_cast<const float4*>(sO + (3 * 16 + t) * 64 + v4);
      uint2 o;
      o.x = pack2(a.x + bq.x + cq.x + d.x, a.y + bq.y + cq.y + d.y);
      o.y = pack2(a.z + bq.z + cq.z + d.z, a.w + bq.w + cq.w + d.w);
      *reinterpret_cast<uint2*>(Z + (size_t)(t0 + t) * ZS + vcol + v4) = o;
    }
    HG_PROCESS();
    __syncthreads();
  }
#undef HG_LOAD
#undef HG_PUT1
#undef HG_PROCESS
}

__device__ void mb_scan(const Params& p, int l, int task, char* smem) {
  const int b = task >> 3, hd = task & 7, g = hd >> 2;
  float* sB = reinterpret_cast<float*>(smem);
  float* sC = sB + 16 * 128;
  float* sX = sC + 16 * 128;
  float* sDt = sX + 16 * 64;
  float* sDA = sDt + 16;
  float* sO = sDA + 16;
  const int tid = opaque_tid(), w = tid >> 6, lane = tid & 63;
  bf16_t* Z = (bf16_t*)(p.ws + OFF_Z) + (size_t)b * SEQ * ZS;
  const float* cw = p.in[I_MB_CONVW] + (size_t)l * 4 * 1024;
  const float* cb = p.in[I_MB_CONVB] + (size_t)l * 1024;
  int ci0, ci1;
  {
    int ch = tid;
    ci0 = (ch < 64) ? hd * 64 + ch : (ch < 192 ? 512 + g * 128 + (ch - 64) : 768 + g * 128 + (ch - 192));
    ci1 = 768 + g * 128 + 64 + (tid & 63);
  }
  float* dstA = (tid < 64) ? (sX + tid) : (tid < 192 ? (sB + (tid - 64)) : (sC + (tid - 192)));
  const int strideA = (tid < 64) ? 64 : 128;
  const float w0a = cw[ci0], w1a = cw[1024 + ci0], w2a = cw[2048 + ci0], w3a = cw[3072 + ci0], ba = cb[ci0];
  const float w0b = cw[ci1], w1b = cw[1024 + ci1], w2b = cw[2048 + ci1], w3b = cw[3072 + ci1], bb = cb[ci1];
  const float Aneg = -expf(p.in[I_MB_ALOG][l * 8 + hd]);
  const float dtb = p.in[I_MB_DTB][l * 8 + hd];
  const float Dsk = p.in[I_MB_D][l * 8 + hd];
  float s[32];
#pragma unroll
  for (int j = 0; j < 32; ++j) s[j] = 0.f;
  float pa1 = 0.f, pa2 = 0.f, pa3 = 0.f, pb1 = 0.f, pb2 = 0.f, pb3 = 0.f;
  const int xcol = ZMB + 512;
  const int rt = tid >> 4, rp4 = (tid & 15) * 4;
  bf16_t xa0, xa1, xa2, xa3, xa4, xa5, xa6, xa7, xa8, xa9, xa10, xa11, xa12, xa13, xa14, xa15;
  bf16_t xb0, xb1, xb2, xb3, xb4, xb5, xb6, xb7, xb8, xb9, xb10, xb11, xb12, xb13, xb14, xb15;
  bf16_t rdt;
  uint2 gcur, gnext;
#define MB_LOAD(T0)                                                                                 \
  {                                                                                                 \
    const bf16_t* za = Z + (size_t)(T0) * ZS + xcol + ci0;                                          \
    xa0 = za[0]; xa1 = za[ZS]; xa2 = za[2 * ZS]; xa3 = za[3 * ZS]; xa4 = za[4 * ZS]; xa5 = za[5 * ZS];        \
    xa6 = za[6 * ZS]; xa7 = za[7 * ZS]; xa8 = za[8 * ZS]; xa9 = za[9 * ZS]; xa10 = za[10 * ZS];     \
    xa11 = za[11 * ZS]; xa12 = za[12 * ZS]; xa13 = za[13 * ZS]; xa14 = za[14 * ZS]; xa15 = za[15 * ZS];       \
    if (tid < 64) {                                                                                 \
      const bf16_t* zb = Z + (size_t)(T0) * ZS + xcol + ci1;                                        \
      xb0 = zb[0]; xb1 = zb[ZS]; xb2 = zb[2 * ZS]; xb3 = zb[3 * ZS]; xb4 = zb[4 * ZS]; xb5 = zb[5 * ZS];      \
      xb6 = zb[6 * ZS]; xb7 = zb[7 * ZS]; xb8 = zb[8 * ZS]; xb9 = zb[9 * ZS]; xb10 = zb[10 * ZS];   \
      xb11 = zb[11 * ZS]; xb12 = zb[12 * ZS]; xb13 = zb[13 * ZS]; xb14 = zb[14 * ZS]; xb15 = zb[15 * ZS];     \
    }                                                                                               \
    rdt = Z[(size_t)((T0) + (tid & 15)) * ZS + ZMB + 1536 + hd];                                    \
    gnext = *reinterpret_cast<const uint2*>(Z + (size_t)((T0) + rt) * ZS + ZMB + hd * 64 + rp4);    \
  }
#define MB_CONV_A(T, XR)                                                                            \
  {                                                                                                 \
    float xv = bf2f(XR);                                                                            \
    dstA[(T)*strideA] = fsilu(ba + w0a * pa3 + w1a * pa2 + w2a * pa1 + w3a * xv);                   \
    pa3 = pa2; pa2 = pa1; pa1 = xv;                                                                 \
  }
#define MB_CONV_B(T, XR)                                                                            \
  {                                                                                                 \
    float xv = bf2f(XR);                                                                            \
    sC[(T)*128 + 64 + tid] = fsilu(bb + w0b * pb3 + w1b * pb2 + w2b * pb1 + w3b * xv);              \
    pb3 = pb2; pb2 = pb1; pb1 = xv;                                                                 \
  }
#define MB_PROCESS()                                                                                \
  {                                                                                                 \
    MB_CONV_A(0, xa0) MB_CONV_A(1, xa1) MB_CONV_A(2, xa2) MB_CONV_A(3, xa3) MB_CONV_A(4, xa4)       \
    MB_CONV_A(5, xa5) MB_CONV_A(6, xa6) MB_CONV_A(7, xa7) MB_CONV_A(8, xa8) MB_CONV_A(9, xa9)       \
    MB_CONV_A(10, xa10) MB_CONV_A(11, xa11) MB_CONV_A(12, xa12) MB_CONV_A(13, xa13)                 \
    MB_CONV_A(14, xa14) MB_CONV_A(15, xa15)                                                         \
    if (tid < 64) {                                                                                 \
      MB_CONV_B(0, xb0) MB_CONV_B(1, xb1) MB_CONV_B(2, xb2) MB_CONV_B(3, xb3) MB_CONV_B(4, xb4)     \
      MB_CONV_B(5, xb5) MB_CONV_B(6, xb6) MB_CONV_B(7, xb7) MB_CONV_B(8, xb8) MB_CONV_B(9, xb9)     \
      MB_CONV_B(10, xb10) MB_CONV_B(11, xb11) MB_CONV_B(12, xb12) MB_CONV_B(13, xb13)               \
      MB_CONV_B(14, xb14) MB_CONV_B(15, xb15)                                                       \
    }                                                                                               \
    if (tid < 16) {                                                                                 \
      float dt = fsoftplus(bf2f(rdt) + dtb);                                                        \
      sDt[tid] = dt;                                                                                \
      sDA[tid] = __expf(Aneg * dt);                                                                 \
    }                                                                                               \
    gcur = gnext;                                                                                   \
  }
  MB_LOAD(0);
  MB_PROCESS();
  __syncthreads();
  constexpr int NCH = SEQ / 16;
#pragma unroll 1
  for (int c = 0; c < NCH; ++c) {
    const int t0 = c * 16;
    const bool more = (c + 1 < NCH);
    const int tn = more ? t0 + 16 : t0;
    MB_LOAD(tn);
    __builtin_amdgcn_sched_barrier(0);
#pragma unroll 2
    for (int t = 0; t < 16; ++t) {
      const float dA = sDA[t];
      const float xdt = sX[t * 64 + lane] * sDt[t];
      const float opv = (lane < 32) ? sB[t * 128 + w * 32 + lane] : sC[t * 128 + w * 32 + (lane - 32)];
      const int opi = __builtin_bit_cast(int, opv);
      float y = 0.f;
#pragma unroll
      for (int j = 0; j < 32; ++j) {
        const float bn = __builtin_bit_cast(float, __builtin_amdgcn_readlane(opi, j));
        const float cn = __builtin_bit_cast(float, __builtin_amdgcn_readlane(opi, 32 + j));
        s[j] = fmaf(s[j], dA, bn * xdt);
        y = fmaf(cn, s[j], y);
      }
      sO[(w * 16 + t) * 64 + lane] = y;
    }
    __builtin_amdgcn_sched_barrier(0);
    __syncthreads();
    {
      float4 a = *reinterpret_cast<const float4*>(sO + (0 * 16 + rt) * 64 + rp4);
      float4 bq = *reinterpret_cast<const float4*>(sO + (1 * 16 + rt) * 64 + rp4);
      float4 cq = *reinterpret_cast<const float4*>(sO + (2 * 16 + rt) * 64 + rp4);
      float4 d = *reinterpret_cast<const float4*>(sO + (3 * 16 + rt) * 64 + rp4);
      float4 xs = *reinterpret_cast<const float4*>(sX + rt * 64 + rp4);
      bf16_t* gp = Z + (size_t)(t0 + rt) * ZS + ZMB + hd * 64 + rp4;
      float g0 = bf2f((bf16_t)(gcur.x & 0xffff)), g1 = bf2f((bf16_t)(gcur.x >> 16));
      float g2 = bf2f((bf16_t)(gcur.y & 0xffff)), g3 = bf2f((bf16_t)(gcur.y >> 16));
      float y0 = a.x + bq.x + cq.x + d.x + Dsk * xs.x;
      float y1 = a.y + bq.y + cq.y + d.y + Dsk * xs.y;
      float y2 = a.z + bq.z + cq.z + d.z + Dsk * xs.z;
      float y3 = a.w + bq.w + cq.w + d.w + Dsk * xs.w;
      uint2 o;
      o.x = pack2(y0 * fsilu(g0), y1 * fsilu(g1));
      o.y = pack2(y2 * fsilu(g2), y3 * fsilu(g3));
      *reinterpret_cast<uint2*>(gp) = o;
    }
    __syncthreads();
    if (more) MB_PROCESS();
    __syncthreads();
  }
#undef MB_LOAD
#undef MB_CONV_A
#undef MB_CONV_B
#undef MB_PROCESS
}

__device__ void s5_scan(const Params& p, int l, int task, char* smem) {
  const int tid = opaque_tid(), w = tid >> 6, lane = tid & 63;
  const int b = task >> 3, g = (task & 7) * 4 + w;
  char* base = smem + w * 6144;
  float* sU = reinterpret_cast<float*>(base);
  char* sHb = base + 1024;
  bf16_t* Z = (bf16_t*)(p.ws + OFF_Z) + (size_t)b * SEQ * ZS + ZS5 + g * 16;
  const int n = lane;
  float lr, li, bbr[16], bbi[16];
  bf16x8 Bf0, Bf1, Bf2, Bf3;
  {
    float dt = expf(p.in[I_S5_LOGDT][l * 32 + g]);
    float are = p.in[I_S5_ARE][(l * 32 + g) * 64 + n], aim = p.in[I_S5_AIM][(l * 32 + g) * 64 + n];
    float mag = expf(dt * are);
    lr = mag * cosf(dt * aim); li = mag * sinf(dt * aim);
    float den = are * are + aim * aim;
    float cr = ((lr - 1.f) * are + li * aim) / den;
    float ci = (li * are - (lr - 1.f) * aim) / den;
    const float* bre = p.in[I_S5_BRE] + ((size_t)(l * 32 + g) * 64 + n) * 16;
    const float* bim = p.in[I_S5_BIM] + ((size_t)(l * 32 + g) * 64 + n) * 16;
#pragma unroll
    for (int c = 0; c < 16; ++c) {
      float br = bre[c], bi = bim[c];
      bbr[c] = cr * br - ci * bi;
      bbi[c] = cr * bi + ci * br;
    }
    const float* cre = p.in[I_S5_CRE] + (size_t)(l * 32 + g) * 16 * 64 + (lane & 15) * 64;
    const float* cim = p.in[I_S5_CIM] + (size_t)(l * 32 + g) * 16 * 64 + (lane & 15) * 64;
#pragma unroll
    for (int j = 0; j < 8; ++j) {
      const int kb = 8 * (lane >> 4) + j;
      const int n0 = kb >> 1;
      const bool im = (j & 1);
      Bf0[j] = (short)f2bf(im ? -cim[n0] : cre[n0]);
      Bf1[j] = (short)f2bf(im ? -cim[n0 + 16] : cre[n0 + 16]);
      Bf2[j] = (short)f2bf(im ? -cim[n0 + 32] : cre[n0 + 32]);
      Bf3[j] = (short)f2bf(im ? -cim[n0 + 48] : cre[n0 + 48]);
    }
  }
  const float dsk = p.in[I_S5_D][l * 512 + g * 16 + (lane & 15)];
  const int pt = lane >> 2, pc4 = (lane & 3) * 4;
  float hr = 0.f, hi = 0.f;
  uint2 unext = *reinterpret_cast<const uint2*>(Z + (size_t)pt * ZS + pc4);
  constexpr int NCH = SEQ / 16;
#pragma unroll 1
  for (int c = 0; c < NCH; ++c) {
    const int t0 = c * 16;
    {
      const uint2 ur = unext;
      *reinterpret_cast<float4*>(sU + pt * 16 + pc4) =
          float4{bf2f((bf16_t)(ur.x & 0xffff)), bf2f((bf16_t)(ur.x >> 16)), bf2f((bf16_t)(ur.y & 0xffff)), bf2f((bf16_t)(ur.y >> 16))};
      const int tn = (c + 1 < NCH) ? t0 + 16 : t0;
      unext = *reinterpret_cast<const uint2*>(Z + (size_t)(tn + pt) * ZS + pc4);
    }
    __builtin_amdgcn_sched_barrier(0);
    __syncthreads();
#pragma unroll 2
    for (int t = 0; t < 16; ++t) {
      const float4* u4 = reinterpret_cast<const float4*>(sU + t * 16);
      float bur = 0.f, bui = 0.f;
#pragma unroll
      for (int q = 0; q < 4; ++q) {
        float4 u = u4[q];
        bur = fmaf(bbr[q * 4 + 0], u.x, bur); bui = fmaf(bbi[q * 4 + 0], u.x, bui);
        bur = fmaf(bbr[q * 4 + 1], u.y, bur); bui = fmaf(bbi[q * 4 + 1], u.y, bui);
        bur = fmaf(bbr[q * 4 + 2], u.z, bur); bui = fmaf(bbi[q * 4 + 2], u.z, bui);
        bur = fmaf(bbr[q * 4 + 3], u.w, bur); bui = fmaf(bbi[q * 4 + 3], u.w, bui);
      }
      float nr = lr * hr - li * hi + bur;
      float ni = lr * hi + li * hr + bui;
      hr = nr; hi = ni;
      *reinterpret_cast<unsigned*>(sHb + t * 272 + n * 4) = pack2(hr, hi);
    }
    __syncthreads();
    {
      f32x4 acc = f32x4{0.f, 0.f, 0.f, 0.f};
      const char* ap = sHb + (lane & 15) * 272 + (lane >> 4) * 16;
      acc = __builtin_amdgcn_mfma_f32_16x16x32_bf16(*reinterpret_cast<const bf16x8*>(ap), Bf0, acc, 0, 0, 0);
      acc = __builtin_amdgcn_mfma_f32_16x16x32_bf16(*reinterpret_cast<const bf16x8*>(ap + 64), Bf1, acc, 0, 0, 0);
      acc = __builtin_amdgcn_mfma_f32_16x16x32_bf16(*reinterpret_cast<const bf16x8*>(ap + 128), Bf2, acc, 0, 0, 0);
      acc = __builtin_amdgcn_mfma_f32_16x16x32_bf16(*reinterpret_cast<const bf16x8*>(ap + 192), Bf3, acc, 0, 0, 0);
      const int cc = lane & 15, tb = (lane >> 4) * 4;
#pragma unroll
      for (int jj = 0; jj < 4; ++jj) {
        float y = acc[jj] + dsk * sU[(tb + jj) * 16 + cc];
        Z[(size_t)(t0 + tb + jj) * ZS + cc] = f2bf(fgelu(y));
      }
    }
    __syncthreads();
  }
}

__device__ void rw_scan(const Params& p, int l, int task, char* smem) {
  const int b = task >> 3, h = task & 7;
  float* sR = reinterpret_cast<float*>(smem);
  float* sW = sR + 1024;
  float* sK = sW + 1024;
  float* sA = sK + 1024;
  float* sBb = sA + 1024;
  float* sV = sBb + 1024;
  float* sY = sV + 1024;
  float* sBonus = sY + 1024;
  const int tid = opaque_tid(), w = tid >> 6, lane = tid & 63;
  const size_t tokbase = (size_t)b * SEQ;
  bf16_t* Z = (bf16_t*)(p.ws + OFF_Z) + tokbase * ZS;
  const bf16_t* LW = (const bf16_t*)(p.ws + OFF_U) + tokbase * 512;
  const bf16_t* LA = LW + (size_t)T_TOK * 512;
  const bf16_t* VF = (const bf16_t*)(p.ws + OFF_VF) + tokbase * 512;
  const int st = tid >> 4, c4 = (tid & 15) * 4, ch = h * 64 + c4;
  float mur[4], muk[4], w0[4], a0[4], kk_[4], ka_[4], rk_[4], lnw[4], lnb[4];
#pragma unroll
  for (int e = 0; e < 4; ++e) {
    mur[e] = p.in[I_RW_MU][l * 1792 + ch + e];
    muk[e] = p.in[I_RW_MU][l * 1792 + 512 + ch + e];
    w0[e] = p.in[I_RW_W0][l * 512 + ch + e];
    a0[e] = p.in[I_RW_A0][l * 512 + ch + e];
    kk_[e] = p.in[I_RW_KK][l * 512 + ch + e];
    ka_[e] = p.in[I_RW_KA][l * 512 + ch + e];
    rk_[e] = p.in[I_RW_RK][l * 512 + ch + e];
    lnw[e] = p.in[I_RW_LNW][l * 512 + ch + e];
    lnb[e] = p.in[I_RW_LNB][l * 512 + ch + e];
  }
  const int rg = lane >> 3, kq = lane & 7, vrow = w * 16 + rg * 2;
  float S0[8], S1[8];
#pragma unroll
  for (int j = 0; j < 8; ++j) { S0[j] = 0.f; S1[j] = 0.f; }
  uint2 rc, kc, rp, kp, lwv, lav, vfv;
#define RW_LOAD(T0)                                                                                 \
  {                                                                                                 \
    const int s_ = (T0) + st;                                                                       \
    const bf16_t* zr = Z + (size_t)s_ * ZS + ZRW + ch;                                              \
    rc = *reinterpret_cast<const uint2*>(zr);                                                       \
    kc = *reinterpret_cast<const uint2*>(zr + 512);                                                 \
    rp = uint2{0u, 0u}; kp = uint2{0u, 0u};                                                         \
    if (s_ > 0) { rp = *reinterpret_cast<const uint2*>(zr - ZS); kp = *reinterpret_cast<const uint2*>(zr - ZS + 512); } \
    lwv = *reinterpret_cast<const uint2*>(LW + (size_t)s_ * 512 + ch);                              \
    lav = *reinterpret_cast<const uint2*>(LA + (size_t)s_ * 512 + ch);                              \
    vfv = *reinterpret_cast<const uint2*>(VF + (size_t)s_ * 512 + ch);                              \
  }
#define RW_PROCESS()                                                                                \
  {                                                                                                 \
    float r4[4], k4[4], kkv[4], av[4], wv[4], vv[4];                                                \
    float n2 = 0.f;                                                                                 \
    _Pragma("unroll") for (int e = 0; e < 4; ++e) {                                                 \
      unsigned rcw = (e < 2) ? rc.x : rc.y, kcw = (e < 2) ? kc.x : kc.y, rpw = (e < 2) ? rp.x : rp.y, kpw = (e < 2) ? kp.x : kp.y; \
      unsigned lww = (e < 2) ? lwv.x : lwv.y, law = (e < 2) ? lav.x : lav.y, vfw = (e < 2) ? vfv.x : vfv.y; \
      int sh = (e & 1) * 16;                                                                        \
      float rcur = bf2f((bf16_t)((rcw >> sh) & 0xffff)), rprev = bf2f((bf16_t)((rpw >> sh) & 0xffff)); \
      float kcur = bf2f((bf16_t)((kcw >> sh) & 0xffff)), kprev = bf2f((bf16_t)((kpw >> sh) & 0xffff)); \
      float lwf = bf2f((bf16_t)((lww >> sh) & 0xffff)), laf = bf2f((bf16_t)((law >> sh) & 0xffff)); \
      vv[e] = bf2f((bf16_t)((vfw >> sh) & 0xffff));                                                 \
      r4[e] = rcur + (rprev - rcur) * mur[e];                                                       \
      k4[e] = kcur + (kprev - kcur) * muk[e];                                                       \
      float wlog = -fsoftplus(-(w0[e] + lwf)) - 0.5f;                                               \
      wv[e] = __expf(-__expf(wlog));                                                                \
      av[e] = fsigmoid(a0[e] + laf);                                                                \
      kkv[e] = k4[e] * kk_[e];                                                                      \
      n2 += kkv[e] * kkv[e];                                                                        \
    }                                                                                               \
    n2 = sum16(n2);                                                                                 \
    float inv = 1.f / fmaxf(sqrtf(n2), 1e-12f);                                                     \
    float bon = 0.f;                                                                                \
    float kt4[4], ap4[4], bp4[4];                                                                   \
    _Pragma("unroll") for (int e = 0; e < 4; ++e) {                                                 \
      float kkn = kkv[e] * inv;                                                                     \
      kt4[e] = k4[e] * (1.f + (av[e] - 1.f) * ka_[e]);                                              \
      ap4[e] = -kkn;                                                                                \
      bp4[e] = kkn * av[e];                                                                         \
      bon += r4[e] * kt4[e] * rk_[e];                                                               \
    }                                                                                               \
    bon = sum16(bon);                                                                               \
    *reinterpret_cast<float4*>(sR + st * 64 + c4) = float4{r4[0], r4[1], r4[2], r4[3]};             \
    *reinterpret_cast<float4*>(sW + st * 64 + c4) = float4{wv[0], wv[1], wv[2], wv[3]};             \
    *reinterpret_cast<float4*>(sK + st * 64 + c4) = float4{kt4[0], kt4[1], kt4[2], kt4[3]};         \
    *reinterpret_cast<float4*>(sA + st * 64 + c4) = float4{ap4[0], ap4[1], ap4[2], ap4[3]};         \
    *reinterpret_cast<float4*>(sBb + st * 64 + c4) = float4{bp4[0], bp4[1], bp4[2], bp4[3]};        \
    *reinterpret_cast<float4*>(sV + st * 64 + c4) = float4{vv[0], vv[1], vv[2], vv[3]};             \
    if ((tid & 15) == 0) sBonus[st] = bon;                                                          \
  }
  RW_LOAD(0);
  RW_PROCESS();
  __syncthreads();
  constexpr int NCH = SEQ / 16;
#pragma unroll 1
  for (int c = 0; c < NCH; ++c) {
    const int t0 = c * 16;
    const int tn = (c + 1 < NCH) ? t0 + 16 : t0;
    RW_LOAD(tn);
    __builtin_amdgcn_sched_barrier(0);
#pragma unroll 2
    for (int t = 0; t < 16; ++t) {
      const float4* a4p = reinterpret_cast<const float4*>(sA + t * 64 + kq * 8);
      const float4* w4p = reinterpret_cast<const float4*>(sW + t * 64 + kq * 8);
      const float4* b4p = reinterpret_cast<const float4*>(sBb + t * 64 + kq * 8);
      const float4* k4p = reinterpret_cast<const float4*>(sK + t * 64 + kq * 8);
      const float4* r4p = reinterpret_cast<const float4*>(sR + t * 64 + kq * 8);
      const float2 vv = *reinterpret_cast<const float2*>(sV + t * 64 + vrow);
      float sa0 = 0.f, sa1 = 0.f;
#pragma unroll
      for (int q = 0; q < 2; ++q) {
        float4 a = a4p[q];
        sa0 = fmaf(S0[q * 4 + 0], a.x, sa0); sa1 = fmaf(S1[q * 4 + 0], a.x, sa1);
        sa0 = fmaf(S0[q * 4 + 1], a.y, sa0); sa1 = fmaf(S1[q * 4 + 1], a.y, sa1);
        sa0 = fmaf(S0[q * 4 + 2], a.z, sa0); sa1 = fmaf(S1[q * 4 + 2], a.z, sa1);
        sa0 = fmaf(S0[q * 4 + 3], a.w, sa0); sa1 = fmaf(S1[q * 4 + 3], a.w, sa1);
      }
      sa0 = oct_sum(sa0); sa1 = oct_sum(sa1);
      float y0 = 0.f, y1 = 0.f;
#pragma unroll
      for (int q = 0; q < 2; ++q) {
        float4 ww = w4p[q], bb = b4p[q], kk = k4p[q], rr = r4p[q];
        S0[q * 4 + 0] = fmaf(S0[q * 4 + 0], ww.x, fmaf(sa0, bb.x, vv.x * kk.x)); y0 = fmaf(S0[q * 4 + 0], rr.x, y0);
        S1[q * 4 + 0] = fmaf(S1[q * 4 + 0], ww.x, fmaf(sa1, bb.x, vv.y * kk.x)); y1 = fmaf(S1[q * 4 + 0], rr.x, y1);
        S0[q * 4 + 1] = fmaf(S0[q * 4 + 1], ww.y, fmaf(sa0, bb.y, vv.x * kk.y)); y0 = fmaf(S0[q * 4 + 1], rr.y, y0);
        S1[q * 4 + 1] = fmaf(S1[q * 4 + 1], ww.y, fmaf(sa1, bb.y, vv.y * kk.y)); y1 = fmaf(S1[q * 4 + 1], rr.y, y1);
        S0[q * 4 + 2] = fmaf(S0[q * 4 + 2], ww.z, fmaf(sa0, bb.z, vv.x * kk.z)); y0 = fmaf(S0[q * 4 + 2], rr.z, y0);
        S1[q * 4 + 2] = fmaf(S1[q * 4 + 2], ww.z, fmaf(sa1, bb.z, vv.y * kk.z)); y1 = fmaf(S1[q * 4 + 2], rr.z, y1);
        S0[q * 4 + 3] = fmaf(S0[q * 4 + 3], ww.w, fmaf(sa0, bb.w, vv.x * kk.w)); y0 = fmaf(S0[q * 4 + 3], rr.w, y0);
        S1[q * 4 + 3] = fmaf(S1[q * 4 + 3], ww.w, fmaf(sa1, bb.w, vv.y * kk.w)); y1 = fmaf(S1[q * 4 + 3], rr.w, y1);
      }
      y0 = oct_sum(y0); y1 = oct_sum(y1);
      if (kq == 0) *reinterpret_cast<float2*>(sY + t * 64 + vrow) = float2{y0, y1};
    }
    __builtin_amdgcn_sched_barrier(0);
    __syncthreads();
    {
      float4 y4 = *reinterpret_cast<const float4*>(sY + st * 64 + c4);
      float4 v4 = *reinterpret_cast<const float4*>(sV + st * 64 + c4);
      float bon = sBonus[st];
      float mean = sum16(y4.x + y4.y + y4.z + y4.w) * (1.f / 64.f);
      float dx = y4.x - mean, dy = y4.y - mean, dz = y4.z - mean, dw = y4.w - mean;
      float var = sum16(dx * dx + dy * dy + dz * dz + dw * dw) * (1.f / 64.f);
      float rs = rsqrtf(var + 64e-5f);
      float o0 = dx * rs * lnw[0] + lnb[0] + bon * v4.x;
      float o1 = dy * rs * lnw[1] + lnb[1] + bon * v4.y;
      float o2 = dz * rs * lnw[2] + lnb[2] + bon * v4.z;
      float o3 = dw * rs * lnw[3] + lnb[3] + bon * v4.w;
      uint2 o;
      o.x = pack2(o0, o1); o.y = pack2(o2, o3);
      *reinterpret_cast<uint2*>(Z + (size_t)(t0 + st) * ZS + ZRW + 1024 + ch) = o;
    }
    RW_PROCESS();
    __syncthreads();
  }
#undef RW_LOAD
#undef RW_PROCESS
}

__device__ void phase_scans(const Params& p, int l, char* smem, int scan_mask = 15) {
  for (int t = blockIdx.x; t < 256; t += gridDim.x) {
    int type = t & 3, idx = t >> 2;
    if (!((scan_mask >> type) & 1)) continue;
#ifndef SCM
#define SCM 15
#endif
    if (type == 0) { if (SCM & 1) rw_scan(p, l, idx, smem); }
    else if (type == 1) { if (SCM & 2) hg_scan(p, l, idx, smem); }
    else if (type == 2) { if (SCM & 4) mb_scan(p, l, idx, smem); }
    else { if (SCM & 8) s5_scan(p, l, idx, smem); }
    __syncthreads();
  }
  if (l + 1 < 2) {
    const int tid = opaque_tid();
    const int nb = (gridDim.x > 256) ? (int)gridDim.x - 256 : (int)gridDim.x;
    const int b0 = (gridDim.x > 256) ? (int)blockIdx.x - 256 : (int)blockIdx.x;
    if (b0 >= 0)
      for (int c = b0; c < CT_TOTAL; c += nb) convert_one(p, l + 1, c, smem, tid);
  }
}

__device__ __forceinline__ void unpack8(const uint4& v, float (&f)[8]) {
  f[0] = bf2f((bf16_t)(v.x & 0xffff)); f[1] = bf2f((bf16_t)(v.x >> 16));
  f[2] = bf2f((bf16_t)(v.y & 0xffff)); f[3] = bf2f((bf16_t)(v.y >> 16));
  f[4] = bf2f((bf16_t)(v.z & 0xffff)); f[5] = bf2f((bf16_t)(v.z >> 16));
  f[6] = bf2f((bf16_t)(v.w & 0xffff)); f[7] = bf2f((bf16_t)(v.w >> 16));
}

__device__ void phase_post(const Params& p, int l, char* smem) {
  bf16_t* Z = (bf16_t*)(p.ws + OFF_Z);
  const int tid = opaque_tid(), lane = tid & 63, wid = tid >> 6;
  constexpr int N_ROWT = T_TOK / 4, N_RWT = T_TOK / 16, N_GLU = 128 * 4, N_NORM = T_TOK / 4;
  const float* xsrc = (l == 0) ? p.in[I_X] : p.out;
  for (int t = blockIdx.x; t < N_ROWT + N_RWT + N_GLU + N_NORM; t += gridDim.x) {
    if (t < N_ROWT) {
      const int row = t * 4 + wid;
      {
        bf16_t* op = Z + (size_t)row * ZS + ZHG + 1024 + lane * 8;
        uint4 ov = *reinterpret_cast<const uint4*>(op);
        uint4 gv = *reinterpret_cast<const uint4*>(op + 512);
        float o[8], g[8];
        unpack8(ov, o); unpack8(gv, g);
        float ss = 0.f;
#pragma unroll
        for (int e = 0; e < 8; ++e) ss += o[e] * o[e];
        ss = sum16(ss);
        float rstd = rsqrtf(ss * (1.f / 128.f) + 1e-6f);
        const float* nw = p.in[I_HG_NW] + l * 512 + lane * 8;
        float r[8];
#pragma unroll
        for (int e = 0; e < 8; ++e) r[e] = o[e] * rstd * nw[e] * siluf_(g[e]);
        *reinterpret_cast<uint4*>(op) = uint4{pack2(r[0], r[1]), pack2(r[2], r[3]), pack2(r[4], r[5]), pack2(r[6], r[7])};
      }
      {
        bf16_t* op = Z + (size_t)row * ZS + ZMB + lane * 8;
        uint4 ov = *reinterpret_cast<const uint4*>(op);
        float o[8];
        unpack8(ov, o);
        float ss = 0.f;
#pragma unroll
        for (int e = 0; e < 8; ++e) ss += o[e] * o[e];
        ss = sum64(ss);
        float rstd = rsqrtf(ss * (1.f / 512.f) + 1e-6f);
        const float* nw = p.in[I_MB_NW] + l * 512 + lane * 8;
        float r[8];
#pragma unroll
        for (int e = 0; e < 8; ++e) r[e] = o[e] * rstd * nw[e];
        *reinterpret_cast<uint4*>(op) = uint4{pack2(r[0], r[1]), pack2(r[2], r[3]), pack2(r[4], r[5]), pack2(r[6], r[7])};
      }
    } else if (t < N_ROWT + N_RWT) {
      const int row0 = (t - N_ROWT) * 16;
      char* sXg = smem;
      const float* mu = p.in[I_RW_MU] + l * 1792 + 1664;
      for (int e = tid; e < 2048; e += 256) {
        int tok = e >> 7, j = e & 127;
        int row = row0 + tok, sq = row & (SEQ - 1);
        *reinterpret_cast<bf16_t*>(sXg + tok * 272 + j * 2) = f2bf(fsigmoid(rw_shift(Z, row, sq, 1664 + j, mu[j])));
      }
      __syncthreads();
      f32x4 acc[8];
      lora_mfma<128>(sXg, 272, (const bf16_t*)(p.ws + OFF_LORA + (size_t)l * LORA_STRIDE + LO_G2), acc, tid);
#pragma unroll
      for (int i = 0; i < 8; ++i)
#pragma unroll
        for (int jj = 0; jj < 4; ++jj) {
          bf16_t* yp = Z + (size_t)(row0 + (lane >> 4) * 4 + jj) * ZS + ZRW + 1024 + (wid * 8 + i) * 16 + (lane & 15);
          *yp = f2bf(bf2f(*yp) * acc[i][jj]);
        }
      __syncthreads();
    } else if (t < N_ROWT + N_RWT + N_GLU) {
      const int tt = t - N_ROWT - N_RWT, mt = tt >> 2, nt = tt & 3;
      const int wm = wid >> 1, wn = wid & 1;
      f32x4 acc[4][4];
      zero_acc<128>(acc);
      gemm_mainloop<128>(acc, Z + ZS5, ZS, mt * 128, (const bf16_t*)(p.ws + WOFF(OFF_WTGLU, l)), 512, nt * 128, 511, 512, smem, tid);
      const float* bg = p.in[I_S5_BGLU] + l * 512;
#pragma unroll
      for (int mi = 0; mi < 4; ++mi)
#pragma unroll
        for (int ni = 0; ni < 4; ++ni) {
          int col = nt * 128 + wn * 64 + ni * 16 + (lane >> 4) * 4;
          int row = mt * 128 + wm * 64 + mi * 16 + (lane & 15);
          float4 b4 = *reinterpret_cast<const float4*>(bg + col);
          uint2 yv = *reinterpret_cast<const uint2*>(Z + (size_t)row * ZS + ZS5 + col);
          float y0 = bf2f((bf16_t)(yv.x & 0xffff)), y1 = bf2f((bf16_t)(yv.x >> 16));
          float y2 = bf2f((bf16_t)(yv.y & 0xffff)), y3 = bf2f((bf16_t)(yv.y >> 16));
          uint2 o;
          o.x = pack2(y0 * sigmoidf_(acc[mi][ni][0] + b4.x), y1 * sigmoidf_(acc[mi][ni][1] + b4.y));
          o.y = pack2(y2 * sigmoidf_(acc[mi][ni][2] + b4.z), y3 * sigmoidf_(acc[mi][ni][3] + b4.w));
          *reinterpret_cast<uint2*>(Z + (size_t)row * ZS + ZMB + 1024 + col) = o;
        }
    } else {
      const int row = (t - N_ROWT - N_RWT - N_GLU) * 4 + wid;
      rmsnorm_row_to_bf16(xsrc + (size_t)row * DM, p.in[I_NORM_MIX] + l * DM, (bf16_t*)(p.ws + OFF_U) + (size_t)row * DM, tid & 63);
    }
  }
}

__device__ void phase_merge(const Params& p, int l, char* smem) {
  bf16_t* Z = (bf16_t*)(p.ws + OFF_Z);
  const bf16_t* U = (const bf16_t*)(p.ws + OFF_U);
  const bf16_t* Wg = (const bf16_t*)(p.ws + WOFF_GATE(l));
  const bf16_t* Wb = (const bf16_t*)(p.ws + WOFF(OFF_WTBR, l));
  const int tid = opaque_tid();
  const int lane = tid & 63, wid = tid >> 6, wm = wid >> 1, wn = wid & 1;
  for (int t = blockIdx.x; t < tile_count(128, 16); t += gridDim.x) {
    int mt, nt;
    if (!tile_map(t, 16, mt, nt)) continue;
    f32x4 accm[4][2];
    zero_acc<64>(accm);
    for (int kb = 0; kb < 4; ++kb) {
      f32x4 g[4][2], pr[4][2];
      zero_acc<64>(g);
      zero_acc<64>(pr);
      gemm_mainloop<64>(g, U, 1024, mt * 128, Wg + (size_t)kb * 1024 * 1024, 1024, nt * 64, 1023, 1024, smem, tid);
      const int ycol = (kb == 0) ? (ZHG + 1024) : (kb == 1) ? (ZRW + 1024) : (kb == 2) ? (ZMB + 1024) : ZMB;
      gemm_mainloop<64>(pr, Z + ycol, ZS, mt * 128, Wb + (size_t)kb * 1024 * 512, 512, nt * 64, 1023, 512, smem, tid);
#pragma unroll
      for (int mi = 0; mi < 4; ++mi)
#pragma unroll
        for (int ni = 0; ni < 2; ++ni)
#pragma unroll
          for (int j = 0; j < 4; ++j) accm[mi][ni][j] = fmaf(sigmoidf_(g[mi][ni][j]), pr[mi][ni][j], accm[mi][ni][j]);
    }
#pragma unroll
    for (int mi = 0; mi < 4; ++mi)
#pragma unroll
      for (int ni = 0; ni < 2; ++ni) {
        int col = nt * 64 + wn * 32 + ni * 16 + (lane >> 4) * 4;
        int row = mt * 128 + wm * 64 + mi * 16 + (lane & 15);
        uint2 o;
        o.x = pack2(accm[mi][ni][0], accm[mi][ni][1]);
        o.y = pack2(accm[mi][ni][2], accm[mi][ni][3]);
        *reinterpret_cast<uint2*>(Z + (size_t)row * ZS + col) = o;
      }
  }
}

__device__ void phase_resid_gemm(const Params& p, const bf16_t* A, int lda, const bf16_t* Wt, int K, const float* xold, char* smem) {
  const int tid = opaque_tid();
  const int lane = tid & 63, wid = tid >> 6, wm = wid >> 1, wn = wid & 1;
  for (int t = blockIdx.x; t < tile_count(64, 8); t += gridDim.x) {
    int mt, nt;
    if (!tile_map(t, 8, mt, nt)) continue;
    f32x4 acc[8][4];
    zero_acc_big(acc);
    gemm_mainloop_big(acc, A, lda, mt * 256, Wt, K, nt * 128, 1023, K, smem, tid);
#pragma unroll
    for (int mi = 0; mi < 8; ++mi)
#pragma unroll
      for (int ni = 0; ni < 4; ++ni) {
        int col = nt * 128 + wn * 64 + ni * 16 + (lane >> 4) * 4;
        int row = mt * 256 + wm * 128 + mi * 16 + (lane & 15);
        size_t o = (size_t)row * DM + col;
        float4 xo = *reinterpret_cast<const float4*>(xold + o);
        float4 r = float4{xo.x + acc[mi][ni][0], xo.y + acc[mi][ni][1], xo.z + acc[mi][ni][2], xo.w + acc[mi][ni][3]};
        *reinterpret_cast<float4*>(p.out + o) = r;
      }
  }
}

__device__ void phase_ffn_in(const Params& p, int l, char* smem) {
  const bf16_t* U = (const bf16_t*)(p.ws + OFF_U);
  const bf16_t* Wt = (const bf16_t*)(p.ws + WOFF(OFF_WTF1, l));
  bf16_t* H = (bf16_t*)(p.ws + OFF_Z);
  const int tid = opaque_tid();
  const int lane = tid & 63, wid = tid >> 6, wm = wid >> 1, wn = wid & 1;
  for (int t = blockIdx.x; t < tile_count(64, 44); t += gridDim.x) {
    int mt, nt;
    if (!tile_map(t, 44, mt, nt)) continue;
    f32x4 acc[8][4];
    zero_acc_big(acc);
    gemm_mainloop_big(acc, U, 1024, mt * 256, Wt, 1024, nt * 128, 5631, 1024, smem, tid);
#pragma unroll
    for (int mi = 0; mi < 8; ++mi)
#pragma unroll
      for (int q = 0; q < 2; ++q) {
        int hcol = ((nt * 128 + wn * 64 + q * 32) >> 1) + (lane >> 4) * 4;
        int row = mt * 256 + wm * 128 + mi * 16 + (lane & 15);
        uint2 o;
        o.x = pack2(fsilu(acc[mi][2 * q][0]) * acc[mi][2 * q + 1][0], fsilu(acc[mi][2 * q][1]) * acc[mi][2 * q + 1][1]);
        o.y = pack2(fsilu(acc[mi][2 * q][2]) * acc[mi][2 * q + 1][2], fsilu(acc[mi][2 * q][3]) * acc[mi][2 * q + 1][3]);
        *reinterpret_cast<uint2*>(H + (size_t)row * FFH + hcol) = o;
      }
  }
}

__device__ void phase_final(const Params& p) {
  const int tid = opaque_tid();
  const int lane = tid & 63;
  const float* w = p.in[I_NORM_FINAL];
  for (int t = blockIdx.x; t < T_TOK / 4; t += gridDim.x) {
    int row = t * 4 + (tid >> 6);
    float* x = p.out + (size_t)row * DM;
    float4 v[4];
    float ss = 0.f;
#pragma unroll
    for (int i = 0; i < 4; ++i) {
      v[i] = *reinterpret_cast<const float4*>(x + i * 256 + lane * 4);
      ss += v[i].x * v[i].x + v[i].y * v[i].y + v[i].z * v[i].z + v[i].w * v[i].w;
    }
    ss = sum64(ss);
    float rstd = rsqrtf(ss * (1.f / 1024.f) + 1e-6f);
#pragma unroll
    for (int i = 0; i < 4; ++i) {
      float4 ww = *reinterpret_cast<const float4*>(w + i * 256 + lane * 4);
      float4 o = float4{v[i].x * rstd * ww.x, v[i].y * rstd * ww.y, v[i].z * rstd * ww.z, v[i].w * rstd * ww.w};
      *reinterpret_cast<float4*>(x + i * 256 + lane * 4) = o;
    }
  }
}

template <int SUB>
__device__ __forceinline__ void run_phase(const Params& p, int l, char* smem) {
  if (SUB == 0) phase_convert_norm(p, l, smem);
  else if (SUB == 1) phase_inproj(p, smem);
  else if (SUB == 2) phase_rwprep(p, l, smem);
  else if (SUB == 3) phase_scans(p, l, smem);
  else if (SUB == 4) phase_post(p, l, smem);
  else if (SUB == 5) phase_merge(p, l, smem);
  else if (SUB == 6) phase_resid_gemm(p, (const bf16_t*)(p.ws + OFF_Z), ZS, (const bf16_t*)(p.ws + WOFF(OFF_WTOUT, l)), 1024,
                                      (l == 0) ? p.in[I_X] : p.out, smem);
  else if (SUB == 7) phase_norm_only(p, p.out, p.in[I_NORM_FFN] + l * DM);
  else if (SUB == 8) phase_ffn_in(p, l, smem);
  else if (SUB == 9) phase_resid_gemm(p, (const bf16_t*)(p.ws + OFF_Z), FFH, (const bf16_t*)(p.ws + WOFF(OFF_WTF2, l)), FFH, p.out, smem);
  else phase_final(p);
}

#ifndef PHM
#define PHM 0xFFFF
#endif
#define XB_TMO      128
#define XB_XCNT(j)  (256  + 64 * (j))
#define XB_XSUB(j)  (1280 + 64 * (j))
#define XB_XGEN(j)  (2304 + 64 * (j))
#define XB_TOP      3328
#define XB_TOPGEN   3392
#define XCD_BAR_WORDS 3456
#define XB_SPIN_CAP (1u << 18)
#define LAS __attribute__((address_space(3)))

__device__ __forceinline__ unsigned xb_ld(unsigned* p)              { return __hip_atomic_load(p, __ATOMIC_RELAXED, __HIP_MEMORY_SCOPE_AGENT); }
__device__ __forceinline__ unsigned xb_add(unsigned* p, unsigned v) { return __hip_atomic_fetch_add(p, v, __ATOMIC_RELAXED, __HIP_MEMORY_SCOPE_AGENT); }
__device__ __forceinline__ unsigned xb_xcc_id() { return (unsigned)__builtin_amdgcn_s_getreg((3 << 11) | 20) & 0xFu; }
#define XB_SPIN(cond, bar) do { unsigned _sp = 0; while (cond) { __builtin_amdgcn_s_sleep(1); \
    if ((++_sp & 255u) == 0u) { if (xb_ld(&(bar)[XB_TMO])) break; if (_sp > XB_SPIN_CAP) { atomicAdd(&(bar)[XB_TMO], 1u); break; } } } } while (0)

struct XcdBarrier {
    unsigned* bar; unsigned x;
    volatile LAS unsigned* st;
};

__device__ __forceinline__ XcdBarrier xcd_barrier_post(unsigned* bar, volatile LAS unsigned* st) {
    XcdBarrier b; b.bar = bar; b.x = xb_xcc_id(); b.st = st;
    if (threadIdx.x == 0) (void)xb_add(&bar[XB_XCNT(b.x)], 1u);
    return b;
}
__device__ __forceinline__ void xcd_barrier_complete(unsigned* bar, unsigned x, unsigned& nloc, unsigned& nx) {
    const unsigned G = gridDim.x * gridDim.y * gridDim.z;
    unsigned sum, cnt, mine, sp = 0u;
    for (;;) {
        sum = 0u; cnt = 0u; mine = 0u;
#pragma unroll
        for (unsigned j = 0; j < 16; ++j) { const unsigned c = xb_ld(&bar[XB_XCNT(j)]); sum += c; cnt += (c > 0u) ? 1u : 0u; mine = (j == x) ? c : mine; }
        if (sum == G) break;
        __builtin_amdgcn_s_sleep(1);
        if ((++sp & 255u) == 0u) { if (xb_ld(&bar[XB_TMO])) break; if (sp > XB_SPIN_CAP) { atomicAdd(&bar[XB_TMO], 1u); break; } }
    }
    nloc = mine > 0u ? mine : 1u; nx = cnt > 0u ? cnt : 1u;
}

__device__ __forceinline__ void xcd_barrier(const XcdBarrier& b) {
    asm volatile("s_waitcnt vmcnt(0)" ::: "memory");
    __syncthreads();
    if (threadIdx.x == 0) {
        unsigned* bar = b.bar;
        __builtin_amdgcn_s_waitcnt(0);
        unsigned nloc = b.st[0], nx = b.st[1];
        if (nloc == 0u) { xcd_barrier_complete(bar, b.x, nloc, nx); b.st[0] = nloc; b.st[1] = nx; }
        const unsigned old = xb_add(&bar[XB_XSUB(b.x)], 1u);
        const unsigned gen = old / nloc;
        if (old + 1u == (gen + 1u) * nloc) {
            __builtin_amdgcn_fence(__ATOMIC_RELEASE, "agent");
            asm volatile("s_waitcnt vmcnt(0)" ::: "memory");
            const unsigned og = xb_add(&bar[XB_TOP], 1u);
            const unsigned tg = og / nx;
            if (og + 1u == (tg + 1u) * nx) xb_add(&bar[XB_TOPGEN], 1u);
            else XB_SPIN(xb_ld(&bar[XB_TOPGEN]) == tg, bar);
            __builtin_amdgcn_fence(__ATOMIC_ACQUIRE, "agent");
            xb_add(&bar[XB_XGEN(b.x)], 1u);
            asm volatile("s_waitcnt vmcnt(0)" ::: "memory");
        } else {
            XB_SPIN(xb_ld(&bar[XB_XGEN(b.x)]) == gen, bar);
            __builtin_amdgcn_fence(__ATOMIC_ACQUIRE, "agent");
            asm volatile("s_waitcnt vmcnt(0)" ::: "memory");
        }
    }
    __syncthreads();
}


constexpr int LDS_MAIN = 73728;
constexpr int LDS_BYTES = LDS_MAIN + 16;

#if COOP
__global__ void __launch_bounds__(256, 2) fwd_kernel(Params p, int ph0, int ph1, int scan_mask) {
  extern __shared__ __attribute__((aligned(16))) char smem[];
  cg::grid_group grid = cg::this_grid();
  volatile LAS unsigned* xb_st = (volatile LAS unsigned*)(smem + LDS_MAIN);
  if (threadIdx.x == 0) { xb_st[0] = 0u; xb_st[1] = 0u; xb_st[2] = 0u; xb_st[3] = 0u; }
  __syncthreads();
  XcdBarrier xbar = xcd_barrier_post(reinterpret_cast<unsigned*>(p.ws + OFF_BAR), xb_st);
  for (int ph = ph0; ph < ph1; ++ph) {
    if (ph == NPHASES - 1) {
      phase_final(p);
    } else {
      const int l = ph / NPH_LAYER, sub = ph % NPH_LAYER;
      switch (sub) {
        case 0: if (PHM & (1<<0)) run_phase<0>(p, l, smem); break;
        case 1: if (PHM & (1<<1)) run_phase<1>(p, l, smem); break;
        case 2: if (PHM & (1<<2)) run_phase<2>(p, l, smem); break;
        case 3: if (PHM & (1<<3)) phase_scans(p, l, smem, scan_mask); break;
        case 4: if (PHM & (1<<4)) run_phase<4>(p, l, smem); break;
        case 5: if (PHM & (1<<5)) run_phase<5>(p, l, smem); break;
        case 6: if (PHM & (1<<6)) run_phase<6>(p, l, smem); break;
        case 7: if (PHM & (1<<7)) run_phase<7>(p, l, smem); break;
        case 8: if (PHM & (1<<8)) run_phase<8>(p, l, smem); break;
        case 9: if (PHM & (1<<9)) run_phase<9>(p, l, smem); break;
      }
    }
    if (ph + 1 < ph1) {
      if (ph1 > 1000) grid.sync();
      else xcd_barrier(xbar);
    }
  }
}
#else
template <int SUB>
__global__ void __launch_bounds__(256, 2) k_phase(Params p, int l) {
  __shared__ __attribute__((aligned(16))) char smem[65536];
  run_phase<SUB>(p, l, smem);
}
#endif

extern "C" void kernel_launch(void* const* d_in, const int* in_sizes, int n_in, void* d_out, int out_size, void* d_ws,
                              size_t ws_size, hipStream_t stream) {
  if (n_in < 41 || ws_size < WS_NEED) {
    fprintf(stderr, "kernel_launch: bad args n_in=%d ws=%zu need=%zu\n", n_in, ws_size, (size_t)WS_NEED);
    return;
  }
  Params p{};
  for (int i = 0; i < 41; ++i) p.in[i] = (const float*)d_in[i];
  p.out = (float*)d_out;
  p.ws = (char*)d_ws;
#if COOP
  static int grid_blocks = 0;
  if (!grid_blocks) {
    int dev = 0, cus = 0, per_cu = 0;
    hipGetDevice(&dev);
    hipDeviceGetAttribute(&cus, hipDeviceAttributeMultiprocessorCount, dev);
    hipFuncSetAttribute((const void*)fwd_kernel, hipFuncAttributeMaxDynamicSharedMemorySize, LDS_BYTES);
    hipOccupancyMaxActiveBlocksPerMultiprocessor(&per_cu, fwd_kernel, 256, LDS_BYTES);
    if (per_cu > 2) per_cu = 2;
    grid_blocks = cus * per_cu;
  }
#ifdef HYBRID
  for (int ph = 0; ph < NPHASES; ++ph) {
    if (ph % 10 == 3 && ph < 20) {
      const int groups[4] = SCAN_GROUPS;
      for (int gi = 0; gi < 4; ++gi) if (groups[gi]) fwd_kernel<<<grid_blocks, 256, LDS_BYTES, stream>>>(p, ph, ph + 1, groups[gi]);
    } else {
      fwd_kernel<<<grid_blocks, 256, LDS_BYTES, stream>>>(p, ph, ph + 1, 15);
    }
  }
#else
  hipMemsetAsync((char*)d_ws + OFF_BAR, 0, XCD_BAR_WORDS * 4, stream);
  int ph0 = 0, ph1 = NPHASES, smask = 15;
  void* args[] = {&p, &ph0, &ph1, &smask};
  hipError_t e = hipLaunchCooperativeKernel((void*)fwd_kernel, dim3(grid_blocks), dim3(256), args, LDS_BYTES, stream);
  if (e != hipSuccess) fprintf(stderr, "cooperative launch failed: %s (grid %d)\n", hipGetErrorString(e), grid_blocks);
#endif
#else
  const dim3 g(512), b(256);
  for (int l = 0; l < 2; ++l) {
    k_phase<0><<<g, b, 0, stream>>>(p, l);
    k_phase<1><<<g, b, 0, stream>>>(p, l);
    k_phase<2><<<g, b, 0, stream>>>(p, l);
    k_phase<3><<<g, b, 0, stream>>>(p, l);
    k_phase<4><<<g, b, 0, stream>>>(p, l);
    k_phase<5><<<g, b, 0, stream>>>(p, l);
    k_phase<6><<<g, b, 0, stream>>>(p, l);
    k_phase<7><<<g, b, 0, stream>>>(p, l);
    k_phase<8><<<g, b, 0, stream>>>(p, l);
    k_phase<9><<<g, b, 0, stream>>>(p, l);
  }
  k_phase<10><<<g, b, 0, stream>>>(p, 0);
#endif
}
```

```cpp
#include <hip/hip_runtime.h>
#include <hip/hip_cooperative_groups.h>
#include <cstdio>
#include <cstdint>
namespace cg = cooperative_groups;

#ifndef COOP
#define COOP 1
#endif

#define LAS __attribute__((address_space(3)))
typedef unsigned short bf16_t;
typedef __attribute__((ext_vector_type(8))) short bf16x8;
typedef __attribute__((ext_vector_type(4))) float f32x4;
typedef __attribute__((ext_vector_type(4))) unsigned u32x4;

constexpr int T_TOK = 16384, SEQ = 2048, DM = 1024;
constexpr int IN_COLS = 9992, NZ = 5896, ZS = 5904;
constexpr int ZHG = 0, ZRW = 2048, ZS5 = 3840, ZMB = 4352;
constexpr int FFH = 2816;
constexpr int NPH_LAYER = 10, NPHASES = 21;

constexpr size_t OFF_WTIN   = 0;
constexpr size_t OFF_WTGATE = OFF_WTIN + (size_t)5896 * 1024 * 2;
constexpr size_t OFF_WTBR   = OFF_WTGATE + (size_t)4096 * 1024 * 2;
constexpr size_t OFF_WTOUT  = OFF_WTBR + (size_t)4 * 1024 * 512 * 2;
constexpr size_t OFF_WTF1   = OFF_WTOUT + (size_t)1024 * 1024 * 2;
constexpr size_t OFF_WTF2   = OFF_WTF1 + (size_t)5632 * 1024 * 2;
constexpr size_t OFF_WTGLU  = OFF_WTF2 + (size_t)1024 * 2816 * 2;
constexpr size_t OFF_U      = OFF_WTGLU + (size_t)512 * 512 * 2;
constexpr size_t OFF_Z      = OFF_U + (size_t)T_TOK * 1024 * 2;
constexpr size_t OFF_VF     = OFF_Z + (size_t)T_TOK * ZS * 2;
constexpr size_t OFF_BAR    = OFF_VF + (size_t)T_TOK * 512 * 2;
constexpr size_t OFF_WTGATE_B = OFF_BAR + 16384;
constexpr size_t OFF_WB_B     = OFF_WTGATE_B + (size_t)4096 * 1024 * 2;
constexpr size_t OFF_LORA     = OFF_WB_B + (OFF_U - OFF_WTBR);
constexpr size_t LORA_STRIDE  = 524288;
constexpr size_t LO_G2 = 0, LO_W2 = 131072, LO_A2 = 196608, LO_V1 = 262144, LO_V2 = 294912;
constexpr size_t WS_NEED      = OFF_LORA + 2 * LORA_STRIDE;
constexpr size_t DELTA_GATE   = OFF_WTGATE_B - OFF_WTGATE;
constexpr size_t DELTA_WB     = OFF_WB_B - OFF_WTBR;
#define WOFF_GATE(l) (OFF_WTGATE + (size_t)(l) * DELTA_GATE)
#define WOFF(off, l) ((off) + (size_t)(l) * DELTA_WB)

struct Params {
  const float* in[41];
  float* out;
  char* ws;
};

enum { I_X = 0, I_NORM_MIX, I_W_IN, I_W_BRANCH, I_W_OUT, I_NORM_FFN, I_W_FFN_IN, I_W_FFN_OUT, I_NORM_FINAL,
       I_HG_LB, I_HG_NW, I_RW_MU, I_RW_W0, I_RW_W2, I_RW_A0, I_RW_A2, I_RW_G2, I_RW_KK, I_RW_KA, I_RW_RK,
       I_RW_LNW, I_RW_LNB, I_RW_V0, I_RW_V1, I_RW_V2, I_S5_ARE, I_S5_AIM, I_S5_BRE, I_S5_BIM, I_S5_CRE,
       I_S5_CIM, I_S5_D, I_S5_LOGDT, I_S5_WGLU, I_S5_BGLU, I_MB_CONVW, I_MB_CONVB, I_MB_DTB, I_MB_ALOG,
       I_MB_D, I_MB_NW };

__device__ __forceinline__ float bf2f(bf16_t v) { return __uint_as_float(((unsigned)v) << 16); }
typedef __attribute__((ext_vector_type(2))) __bf16 bf16x2_t;
__device__ __forceinline__ unsigned pack2(float a, float b) {
  bf16x2_t v;
  v[0] = (__bf16)a;
  v[1] = (__bf16)b;
  return __builtin_bit_cast(unsigned, v);
}
__device__ __forceinline__ bf16_t f2bf(float f) { return (bf16_t)(pack2(f, 0.f) & 0xffffu); }
__device__ __forceinline__ float sigmoidf_(float x) { return 1.f / (1.f + __expf(-x)); }
__device__ __forceinline__ float siluf_(float x) { return x / (1.f + __expf(-x)); }
__device__ __forceinline__ float softplusf_(float x) { return x > 20.f ? x : log1pf(__expf(x)); }
__device__ __forceinline__ float gelu_tanh(float x) {
  float u = 0.7978845608028654f * (x + 0.044715f * x * x * x);
  return 0.5f * x * (1.f + tanhf(u));
}
__device__ __forceinline__ float frcp(float x) { return __builtin_amdgcn_rcpf(x); }
__device__ __forceinline__ float fsigmoid(float x) { return frcp(1.f + __expf(-x)); }
__device__ __forceinline__ float fsilu(float x) { return x * frcp(1.f + __expf(-x)); }
__device__ __forceinline__ float fsoftplus(float x) { return x > 20.f ? x : __logf(1.f + __expf(x)); }
__device__ __forceinline__ float ftanh(float x) {
  float e = __expf(2.f * fminf(fmaxf(x, -15.f), 15.f));
  return (e - 1.f) * frcp(e + 1.f);
}
__device__ __forceinline__ float fgelu(float x) {
  float u = 0.7978845608028654f * (x + 0.044715f * x * x * x);
  return 0.5f * x * (1.f + ftanh(u));
}

__device__ __forceinline__ float quad_sum(float x) {
  x += __builtin_bit_cast(float, __builtin_amdgcn_update_dpp(0, __builtin_bit_cast(int, x), 0xB1, 0xF, 0xF, true));
  x += __builtin_bit_cast(float, __builtin_amdgcn_update_dpp(0, __builtin_bit_cast(int, x), 0x4E, 0xF, 0xF, true));
  return x;
}
__device__ __forceinline__ float oct_sum(float x) {
  x = quad_sum(x);
  x += __builtin_bit_cast(float, __builtin_amdgcn_update_dpp(0, __builtin_bit_cast(int, x), 0x141, 0xF, 0xF, true));
  return x;
}
__device__ __forceinline__ float sum16(float x) {
  x += __shfl_xor(x, 1); x += __shfl_xor(x, 2); x += __shfl_xor(x, 4); x += __shfl_xor(x, 8);
  return x;
}
__device__ __forceinline__ float sum64(float x) {
  x = sum16(x); x += __shfl_xor(x, 16); x += __shfl_xor(x, 32);
  return x;
}

__device__ __forceinline__ int opaque_tid() {
  int t = threadIdx.x;
  asm volatile("" : "+v"(t));
  return t;
}

template <int BN>
__device__ __forceinline__ void gemm_mainloop(f32x4 (&acc)[4][BN / 32], const bf16_t* A, int lda, int m0,
                                              const bf16_t* Bt, int ldb, int n0, int nmax, int K, char* smem, const int tid) {
  const int lane = tid & 63, wid = tid >> 6, wm = wid >> 1, wn = wid & 1;
  const int q = tid & 7, r0 = tid >> 3;
  unsigned offA[4], offB[BN / 32];
#pragma unroll
  for (int i = 0; i < 4; ++i) offA[i] = ((unsigned)(m0 + r0 + 32 * i) * (unsigned)lda + (unsigned)q * 8u) * 2u;
#pragma unroll
  for (int i = 0; i < BN / 32; ++i) {
    int row = n0 + r0 + 32 * i;
    row = row < nmax ? row : nmax;
    offB[i] = ((unsigned)row * (unsigned)ldb + (unsigned)q * 8u) * 2u;
  }
  const unsigned sto = (unsigned)r0 * 128u + (unsigned)((q ^ ((r0 >> 1) & 7)) << 4);
  unsigned aoff[4], boff[BN / 32];
#pragma unroll
  for (int mi = 0; mi < 4; ++mi) {
    int row = wm * 64 + mi * 16 + (lane & 15);
    aoff[mi] = (unsigned)row * 128u + (unsigned)(((lane >> 4) ^ ((row >> 1) & 7)) << 4);
  }
#pragma unroll
  for (int ni = 0; ni < BN / 32; ++ni) {
    int row = wn * (BN / 2) + ni * 16 + (lane & 15);
    boff[ni] = (unsigned)row * 128u + (unsigned)(((lane >> 4) ^ ((row >> 1) & 7)) << 4);
  }
  const char* Ab = reinterpret_cast<const char*>(A);
  const char* Bb = reinterpret_cast<const char*>(Bt);
  const int nk = K >> 6;
  constexpr bool WIDE = (BN == 128);
  u32x4 Ra0, Ra1, Ra2, Ra3, Rb0, Rb1, Rb2, Rb3;
  u32x4 Qa0, Qa1, Qa2, Qa3, Qb0, Qb1, Qb2, Qb3;
#define GLOAD(P, TILE)                                                         \
  {                                                                            \
    const char* Ak_ = Ab + (size_t)(TILE) * 128;                               \
    const char* Bk_ = Bb + (size_t)(TILE) * 128;                               \
    P##a0 = *reinterpret_cast<const u32x4*>(Ak_ + offA[0]);                    \
    P##a1 = *reinterpret_cast<const u32x4*>(Ak_ + offA[1]);                    \
    P##a2 = *reinterpret_cast<const u32x4*>(Ak_ + offA[2]);                    \
    P##a3 = *reinterpret_cast<const u32x4*>(Ak_ + offA[3]);                    \
    P##b0 = *reinterpret_cast<const u32x4*>(Bk_ + offB[0]);                    \
    P##b1 = *reinterpret_cast<const u32x4*>(Bk_ + offB[1]);                    \
    if (WIDE) {                                                                \
      P##b2 = *reinterpret_cast<const u32x4*>(Bk_ + offB[BN / 32 - 2]);        \
      P##b3 = *reinterpret_cast<const u32x4*>(Bk_ + offB[BN / 32 - 1]);        \
    }                                                                          \
  }
#define SSTORE(P, BUF)                                                         \
  {                                                                            \
    char* ad_ = smem + (BUF) * 16384 + sto;                                    \
    char* bd_ = smem + 32768 + (BUF) * (BN * 128) + sto;                       \
    *reinterpret_cast<u32x4*>(ad_) = P##a0;                                    \
    *reinterpret_cast<u32x4*>(ad_ + 4096) = P##a1;                             \
    *reinterpret_cast<u32x4*>(ad_ + 8192) = P##a2;                             \
    *reinterpret_cast<u32x4*>(ad_ + 12288) = P##a3;                            \
    *reinterpret_cast<u32x4*>(bd_) = P##b0;                                    \
    *reinterpret_cast<u32x4*>(bd_ + 4096) = P##b1;                             \
    if (WIDE) {                                                                \
      *reinterpret_cast<u32x4*>(bd_ + 8192) = P##b2;                           \
      *reinterpret_cast<u32x4*>(bd_ + 12288) = P##b3;                          \
    }                                                                          \
  }
#define COMPUTE(BUF)                                                           \
  {                                                                            \
    const char* a_s = smem + (BUF) * 16384;                                    \
    const char* b_s = smem + 32768 + (BUF) * (BN * 128);                       \
    _Pragma("unroll") for (int ks = 0; ks < 2; ++ks) {                         \
      bf16x8 af[4], bfr[BN / 32];                                              \
      _Pragma("unroll") for (int mi = 0; mi < 4; ++mi)                         \
          af[mi] = *reinterpret_cast<const bf16x8*>(a_s + (aoff[mi] ^ (ks * 64)));       \
      _Pragma("unroll") for (int ni = 0; ni < BN / 32; ++ni)                   \
          bfr[ni] = *reinterpret_cast<const bf16x8*>(b_s + (boff[ni] ^ (ks * 64)));      \
      _Pragma("unroll") for (int mi = 0; mi < 4; ++mi)                         \
        _Pragma("unroll") for (int ni = 0; ni < BN / 32; ++ni)                 \
          acc[mi][ni] = __builtin_amdgcn_mfma_f32_16x16x32_bf16(bfr[ni], af[mi], acc[mi][ni], 0, 0, 0); \
    }                                                                          \
  }
  if constexpr (WIDE && false) {
    GLOAD(R, 0);
    SSTORE(R, 0);
    GLOAD(R, 1);
    if (nk > 2) GLOAD(Q, 2);
    __syncthreads();
#pragma unroll 1
    for (int kt = 0; kt < nk; kt += 2) {
      __builtin_amdgcn_sched_barrier(0);
      COMPUTE(0);
      __builtin_amdgcn_sched_barrier(0);
      SSTORE(R, 1);
      if (kt + 3 < nk) GLOAD(R, kt + 3);
      __syncthreads();
      __builtin_amdgcn_sched_barrier(0);
      COMPUTE(1);
      __builtin_amdgcn_sched_barrier(0);
      if (kt + 2 < nk) SSTORE(Q, 0);
      if (kt + 4 < nk) GLOAD(Q, kt + 4);
      __syncthreads();
    }
  } else {
    GLOAD(R, 0);
    SSTORE(R, 0);
    __syncthreads();
#pragma unroll 1
    for (int kt = 0; kt < nk; ++kt) {
      const int buf = kt & 1;
      const bool more = (kt + 1 < nk);
      if (more) GLOAD(R, kt + 1);
      __builtin_amdgcn_sched_barrier(0);
      COMPUTE(buf);
      __builtin_amdgcn_sched_barrier(0);
      if (more) SSTORE(R, buf ^ 1);
      __syncthreads();
    }
  }
#undef GLOAD
#undef SSTORE
#undef COMPUTE
}

template <int BN>
__device__ __forceinline__ void zero_acc(f32x4 (&acc)[4][BN / 32]) {
#pragma unroll
  for (int mi = 0; mi < 4; ++mi)
#pragma unroll
    for (int ni = 0; ni < BN / 32; ++ni) acc[mi][ni] = f32x4{0.f, 0.f, 0.f, 0.f};
}

#define RAW_BARRIER() do { asm volatile("s_waitcnt lgkmcnt(0)" ::: "memory"); __builtin_amdgcn_s_barrier(); } while (0)
template <int MROWS>
__device__ __forceinline__ void gemm_mainloop_glds(f32x4 (&acc)[MROWS / 32][4], const bf16_t* A, int lda, int m0, const bf16_t* Bt,
                                                   int ldb, int n0, int nmax, int K, char* smem, const int tid) {
  constexpr int NA = MROWS / 64;
  constexpr int NMI = MROWS / 32;
  constexpr int STAGE = (MROWS + 128) * 64;
  constexpr int BOFF = MROWS * 64;
  const int lane = tid & 63, wid = tid >> 6, wm = wid >> 1, wn = wid & 1;
  unsigned gA[NA], gB[2];
#pragma unroll
  for (int i = 0; i < NA; ++i) {
    const int row = (wid * NA + i) * 16 + (lane >> 2);
    const int q = (lane & 3) ^ ((row >> 2) & 3);
    gA[i] = ((unsigned)(m0 + row) * (unsigned)lda + (unsigned)q * 8u) * 2u;
  }
#pragma unroll
  for (int i = 0; i < 2; ++i) {
    const int row = (wid * 2 + i) * 16 + (lane >> 2);
    const int q = (lane & 3) ^ ((row >> 2) & 3);
    int grow = n0 + row;
    grow = grow < nmax ? grow : nmax;
    gB[i] = ((unsigned)grow * (unsigned)ldb + (unsigned)q * 8u) * 2u;
  }
  unsigned aoff[NMI], boff[4];
#pragma unroll
  for (int mi = 0; mi < NMI; ++mi) {
    int row = wm * (MROWS / 2) + mi * 16 + (lane & 15);
    aoff[mi] = (unsigned)row * 64u + (unsigned)(((lane >> 4) ^ ((row >> 2) & 3)) << 4);
  }
#pragma unroll
  for (int ni = 0; ni < 4; ++ni) {
    int row = wn * 64 + ni * 16 + (lane & 15);
    boff[ni] = (unsigned)BOFF + (unsigned)row * 64u + (unsigned)(((lane >> 4) ^ ((row >> 2) & 3)) << 4);
  }
  const char* Ab = reinterpret_cast<const char*>(A);
  const char* Bb = reinterpret_cast<const char*>(Bt);
  const int nk = K >> 5;
  char* ldsA = smem + wid * (NA * 1024);
  char* ldsB = smem + BOFF + wid * 2048;
#define BG_GLDS(TILE, ST)                                                                                           \
  {                                                                                                                 \
    const char* Ak_ = Ab + (size_t)(TILE) * 64;                                                                     \
    const char* Bk_ = Bb + (size_t)(TILE) * 64;                                                                     \
    char* la_ = ldsA + (ST) * STAGE;                                                                                \
    char* lb_ = ldsB + (ST) * STAGE;                                                                                \
    _Pragma("unroll") for (int i_ = 0; i_ < NA; ++i_)                                                               \
      __builtin_amdgcn_global_load_lds((const unsigned*)(Ak_ + gA[i_]), (LAS unsigned*)(la_ + i_ * 1024), 16, 0, 0); \
    __builtin_amdgcn_global_load_lds((const unsigned*)(Bk_ + gB[0]), (LAS unsigned*)(lb_), 16, 0, 0);              \
    __builtin_amdgcn_global_load_lds((const unsigned*)(Bk_ + gB[1]), (LAS unsigned*)(lb_ + 1024), 16, 0, 0);       \
  }
#define BG_COMPUTE(ST)                                                                                              \
  {                                                                                                                 \
    const char* s_ = smem + (ST) * STAGE;                                                                           \
    bf16x8 bfr[4], af[NMI];                                                                                         \
    _Pragma("unroll") for (int ni = 0; ni < 4; ++ni) bfr[ni] = *reinterpret_cast<const bf16x8*>(s_ + boff[ni]);     \
    _Pragma("unroll") for (int mi = 0; mi < NMI; ++mi) af[mi] = *reinterpret_cast<const bf16x8*>(s_ + aoff[mi]);    \
    __builtin_amdgcn_sched_barrier(0);                                                                              \
    _Pragma("unroll") for (int mi = 0; mi < NMI; ++mi)                                                              \
      _Pragma("unroll") for (int ni = 0; ni < 4; ++ni)                                                              \
        acc[mi][ni] = __builtin_amdgcn_mfma_f32_16x16x32_bf16(bfr[ni], af[mi], acc[mi][ni], 0, 0, 0);               \
  }
  asm volatile("s_waitcnt vmcnt(0)" ::: "memory");
  BG_GLDS(0, 0);
  BG_GLDS(1, 1);
  int st = 0;
#pragma unroll 1
  for (int kt = 0; kt < nk - 1; ++kt) {
    if constexpr (NA == 4) asm volatile("s_waitcnt vmcnt(6)" ::: "memory");
    else asm volatile("s_waitcnt vmcnt(4)" ::: "memory");
    RAW_BARRIER();
    if (kt + 2 < nk) {
      const int st2 = (st >= 1) ? st - 1 : 2;
      BG_GLDS(kt + 2, st2);
    }
    __builtin_amdgcn_sched_barrier(0);
    BG_COMPUTE(st);
    __builtin_amdgcn_sched_barrier(0);
    st = (st == 2) ? 0 : st + 1;
  }
  asm volatile("s_waitcnt vmcnt(0)" ::: "memory");
  RAW_BARRIER();
  BG_COMPUTE(st);
  RAW_BARRIER();
#undef BG_GLDS
#undef BG_COMPUTE
}
__device__ __forceinline__ void gemm_mainloop_big(f32x4 (&acc)[8][4], const bf16_t* A, int lda, int m0, const bf16_t* Bt,
                                                  int ldb, int n0, int nmax, int K, char* smem, const int tid) {
  gemm_mainloop_glds<256>(acc, A, lda, m0, Bt, ldb, n0, nmax, K, smem, tid);
}

__device__ __forceinline__ void zero_acc_big(f32x4 (&acc)[8][4]) {
#pragma unroll
  for (int mi = 0; mi < 8; ++mi)
#pragma unroll
    for (int ni = 0; ni < 4; ++ni) acc[mi][ni] = f32x4{0.f, 0.f, 0.f, 0.f};
}

__device__ __forceinline__ void conv_tile(const float* src, int ld, int nlimit, int k0, int n0, bf16_t* dst, int Kd, int mode,
                                          char* smem, const int tid) {
  float* sT = reinterpret_cast<float*>(smem);
#pragma unroll
  for (int i = 0; i < 16; ++i) {
    int kk = i * 4 + (tid >> 6), nn = tid & 63;
    float v = (n0 + nn < nlimit) ? src[(size_t)(k0 + kk) * ld + n0 + nn] : 0.f;
    sT[kk * 65 + nn] = v;
  }
  __syncthreads();
  {
    int nn = tid >> 2, kq = tid & 3;
    int n = n0 + nn;
    if (n < nlimit) {
      int drow = n;
      if (mode == 1) {
        if (n < FFH) drow = (n >> 4) * 32 + (n & 15);
        else { int j = n - FFH; drow = (j >> 4) * 32 + 16 + (j & 15); }
      }
      unsigned pk[8];
#pragma unroll
      for (int j = 0; j < 8; ++j) pk[j] = pack2(sT[(kq * 16 + 2 * j) * 65 + nn], sT[(kq * 16 + 2 * j + 1) * 65 + nn]);
      uint4* d = reinterpret_cast<uint4*>(dst + (size_t)drow * Kd + k0 + kq * 16);
      d[0] = uint4{pk[0], pk[1], pk[2], pk[3]};
      d[1] = uint4{pk[4], pk[5], pk[6], pk[7]};
    }
  }
  __syncthreads();
}

__device__ __forceinline__ void rmsnorm_row_to_bf16(const float* x, const float* w, bf16_t* out, const int lane) {
  float4 v[4];
  float ss = 0.f;
#pragma unroll
  for (int i = 0; i < 4; ++i) {
    v[i] = *reinterpret_cast<const float4*>(x + i * 256 + lane * 4);
    ss += v[i].x * v[i].x + v[i].y * v[i].y + v[i].z * v[i].z + v[i].w * v[i].w;
  }
  ss = sum64(ss);
  float rstd = rsqrtf(ss * (1.f / 1024.f) + 1e-6f);
#pragma unroll
  for (int i = 0; i < 4; ++i) {
    float4 ww = *reinterpret_cast<const float4*>(w + i * 256 + lane * 4);
    uint2 o;
    o.x = pack2(v[i].x * rstd * ww.x, v[i].y * rstd * ww.y);
    o.y = pack2(v[i].z * rstd * ww.z, v[i].w * rstd * ww.w);
    *reinterpret_cast<uint2*>(out + i * 256 + lane * 4) = o;
  }
}

constexpr int CT_IN = 157 * 16, CT_BR = 512, CT_OUT = 256, CT_F1 = 88 * 16, CT_F2 = 44 * 16, CT_GLU = 64;
constexpr int CT_TOTAL = CT_IN + CT_BR + CT_OUT + CT_F1 + CT_F2 + CT_GLU;

__device__ __forceinline__ void convert_one(const Params& p, int l, int c, char* smem, const int tid) {
  char* ws = p.ws;
  if (c < CT_IN) {
    int nt = c >> 4, kt = c & 15;
    const float* src = p.in[I_W_IN] + (size_t)l * 1024 * IN_COLS;
    if (nt < 64) conv_tile(src, IN_COLS, IN_COLS, kt * 64, nt * 64, (bf16_t*)(ws + WOFF_GATE(l)), 1024, 0, smem, tid);
    else conv_tile(src + 4096, IN_COLS, IN_COLS - 4096, kt * 64, (nt - 64) * 64, (bf16_t*)(ws + OFF_WTIN), 1024, 0, smem, tid);
    return;
  }
  c -= CT_IN;
  if (c < CT_BR) {
    int kb = c >> 7, r = c & 127, nt = r >> 3, kt = r & 7;
    const float* src = p.in[I_W_BRANCH] + ((size_t)l * 4 + kb) * 512 * 1024;
    conv_tile(src, 1024, 1024, kt * 64, nt * 64, (bf16_t*)(ws + WOFF(OFF_WTBR, l)) + (size_t)kb * 1024 * 512, 512, 0, smem, tid);
    return;
  }
  c -= CT_BR;
  if (c < CT_OUT) {
    int nt = c >> 4, kt = c & 15;
    conv_tile(p.in[I_W_OUT] + (size_t)l * 1024 * 1024, 1024, 1024, kt * 64, nt * 64, (bf16_t*)(ws + WOFF(OFF_WTOUT, l)), 1024, 0, smem, tid);
    return;
  }
  c -= CT_OUT;
  if (c < CT_F1) {
    int nt = c >> 4, kt = c & 15;
    conv_tile(p.in[I_W_FFN_IN] + (size_t)l * 1024 * 5632, 5632, 5632, kt * 64, nt * 64, (bf16_t*)(ws + WOFF(OFF_WTF1, l)), 1024, 1, smem, tid);
    return;
  }
  c -= CT_F1;
  if (c < CT_F2) {
    int nt = c / 44, kt = c % 44;
    conv_tile(p.in[I_W_FFN_OUT] + (size_t)l * FFH * 1024, 1024, 1024, kt * 64, nt * 64, (bf16_t*)(ws + WOFF(OFF_WTF2, l)), FFH, 0, smem, tid);
    return;
  }
  c -= CT_F2;
  {
    int nt = c >> 3, kt = c & 7;
    conv_tile(p.in[I_S5_WGLU] + (size_t)l * 512 * 512, 512, 512, kt * 64, nt * 64, (bf16_t*)(ws + WOFF(OFF_WTGLU, l)), 512, 0, smem, tid);
  }
}

constexpr int CT_LORA = 41;
__device__ __forceinline__ void convert_lora(const Params& p, int l, int c, char* smem, const int tid) {
  char* lo = p.ws + OFF_LORA + (size_t)l * LORA_STRIDE;
  if (c < 16) { int nt = c >> 1, kt = c & 1;
    conv_tile(p.in[I_RW_G2] + (size_t)l * 128 * 512, 512, 512, kt * 64, nt * 64, (bf16_t*)(lo + LO_G2), 128, 0, smem, tid); return; }
  c -= 16;
  if (c < 8) { conv_tile(p.in[I_RW_W2] + (size_t)l * 64 * 512, 512, 512, 0, c * 64, (bf16_t*)(lo + LO_W2), 64, 0, smem, tid); return; }
  c -= 8;
  if (c < 8) { conv_tile(p.in[I_RW_A2] + (size_t)l * 64 * 512, 512, 512, 0, c * 64, (bf16_t*)(lo + LO_A2), 64, 0, smem, tid); return; }
  c -= 8;
  if (l == 0) return;
  if (c < 8) { conv_tile(p.in[I_RW_V1] + (size_t)(l - 1) * 512 * 32, 32, 32, c * 64, 0, (bf16_t*)(lo + LO_V1), 512, 0, smem, tid); return; }
  {
    const float* src = p.in[I_RW_V2] + (size_t)(l - 1) * 32 * 512;
    bf16_t* dst = (bf16_t*)(lo + LO_V2);
    for (int e = tid; e < 32 * 512; e += 256) { int ch = e >> 5, r = e & 31; dst[e] = f2bf(src[r * 512 + ch]); }
  }
}

template <int J>
__device__ __forceinline__ void lora_mfma(const char* sIn, int rowb, const bf16_t* Wt, f32x4 (&acc)[8], const int tid) {
  const int lane = tid & 63, w = tid >> 6;
#pragma unroll
  for (int i = 0; i < 8; ++i) acc[i] = f32x4{0.f, 0.f, 0.f, 0.f};
#pragma unroll
  for (int ks = 0; ks < J / 32; ++ks) {
    const bf16x8 a = *reinterpret_cast<const bf16x8*>(sIn + (lane & 15) * rowb + (ks * 32 + 8 * (lane >> 4)) * 2);
#pragma unroll
    for (int i = 0; i < 8; ++i) {
      const bf16x8 b = *reinterpret_cast<const bf16x8*>(Wt + (size_t)((w * 8 + i) * 16 + (lane & 15)) * J + ks * 32 + 8 * (lane >> 4));
      acc[i] = __builtin_amdgcn_mfma_f32_16x16x32_bf16(a, b, acc[i], 0, 0, 0);
    }
  }
}

__device__ void phase_convert_norm(const Params& p, int l, char* smem) {
  const int tid = opaque_tid();
  const int nconv = (l == 0) ? CT_TOTAL + 2 * CT_LORA : 0;
  const int ntask = nconv + T_TOK / 4;
  const float* xsrc = (l == 0) ? p.in[I_X] : p.out;
  for (int t = blockIdx.x; t < ntask; t += gridDim.x) {
    if (t < nconv) {
      if (t < CT_TOTAL) convert_one(p, l, t, smem, tid);
      else { int c = t - CT_TOTAL; convert_lora(p, c / CT_LORA, c % CT_LORA, smem, tid); __syncthreads(); }
    } else {
      int row = (t - nconv) * 4 + (tid >> 6);
      rmsnorm_row_to_bf16(xsrc + (size_t)row * DM, p.in[I_NORM_MIX] + l * DM, (bf16_t*)(p.ws + OFF_U) + (size_t)row * DM, tid & 63);
    }
  }
}

__device__ void phase_norm_only(const Params& p, const float* xsrc, const float* w) {
  const int tid = opaque_tid();
  for (int t = blockIdx.x; t < T_TOK / 4; t += gridDim.x) {
    int row = t * 4 + (tid >> 6);
    rmsnorm_row_to_bf16(xsrc + (size_t)row * DM, w, (bf16_t*)(p.ws + OFF_U) + (size_t)row * DM, tid & 63);
  }
}

__device__ __forceinline__ bool tile_map(int t, int NT, int& mt, int& nt) {
  const int x = t & 7, r = t >> 3;
  const int cnt = (NT + 7) >> 3;
  const int ni = r % cnt;
  mt = r / cnt;
  nt = x + 8 * ni;
  return nt < NT;
}
__device__ __forceinline__ int tile_count(int MT, int NT) { return 8 * MT * ((NT + 7) >> 3); }

__device__ void phase_inproj(const Params& p, char* smem) {
  const bf16_t* U = (const bf16_t*)(p.ws + OFF_U);
  const bf16_t* Wt = (const bf16_t*)(p.ws + OFF_WTIN);
  bf16_t* Z = (bf16_t*)(p.ws + OFF_Z);
  const int tid = opaque_tid();
  const int lane = tid & 63, wid = tid >> 6, wm = wid >> 1, wn = wid & 1;
  constexpr int NT = 47;
  for (int t = blockIdx.x; t < tile_count(64, NT); t += gridDim.x) {
    int mt, nt;
    if (!tile_map(t, NT, mt, nt)) continue;
    f32x4 acc[8][4];
    zero_acc_big(acc);
    gemm_mainloop_big(acc, U, 1024, mt * 256, Wt, 1024, nt * 128, NZ - 1, 1024, smem, tid);
#pragma unroll
    for (int mi = 0; mi < 8; ++mi)
#pragma unroll
      for (int ni = 0; ni < 4; ++ni) {
        int col = nt * 128 + wn * 64 + ni * 16 + (lane >> 4) * 4;
        int row = mt * 256 + wm * 128 + mi * 16 + (lane & 15);
        if (col < NZ) {
          uint2 o;
          o.x = pack2(acc[mi][ni][0], acc[mi][ni][1]);
          o.y = pack2(acc[mi][ni][2], acc[mi][ni][3]);
          *reinterpret_cast<uint2*>(Z + (size_t)row * ZS + col) = o;
        }
      }
  }
}

template <int J>
__device__ __forceinline__ void lora_mm(const float* sIn, const float* W, float (&a0)[16], float (&a1)[16], const int tid) {
#pragma unroll
  for (int i = 0; i < 16; ++i) { a0[i] = 0.f; a1[i] = 0.f; }
#pragma unroll 8
  for (int j = 0; j < J; ++j) {
    float w0 = W[j * 512 + tid], w1 = W[j * 512 + tid + 256];
    const float4* x4 = reinterpret_cast<const float4*>(sIn + j * 16);
#pragma unroll
    for (int q = 0; q < 4; ++q) {
      float4 x = x4[q];
      a0[q * 4 + 0] = fmaf(w0, x.x, a0[q * 4 + 0]); a1[q * 4 + 0] = fmaf(w1, x.x, a1[q * 4 + 0]);
      a0[q * 4 + 1] = fmaf(w0, x.y, a0[q * 4 + 1]); a1[q * 4 + 1] = fmaf(w1, x.y, a1[q * 4 + 1]);
      a0[q * 4 + 2] = fmaf(w0, x.z, a0[q * 4 + 2]); a1[q * 4 + 2] = fmaf(w1, x.z, a1[q * 4 + 2]);
      a0[q * 4 + 3] = fmaf(w0, x.w, a0[q * 4 + 3]); a1[q * 4 + 3] = fmaf(w1, x.w, a1[q * 4 + 3]);
    }
  }
}

__device__ __forceinline__ float rw_shift(const bf16_t* Z, int row, int s, int rc, float mu) {
  float cur = bf2f(Z[(size_t)row * ZS + ZRW + rc]);
  float prev = (s > 0) ? bf2f(Z[(size_t)(row - 1) * ZS + ZRW + rc]) : 0.f;
  return cur + (prev - cur) * mu;
}

__device__ void phase_rwprep(const Params& p, int l, char* smem) {
  const bf16_t* Z = (const bf16_t*)(p.ws + OFF_Z);
  bf16_t* LW = (bf16_t*)(p.ws + OFF_U);
  bf16_t* LA = LW + (size_t)T_TOK * 512;
  bf16_t* VF = (bf16_t*)(p.ws + OFF_VF);
  const char* lo = p.ws + OFF_LORA + (size_t)l * LORA_STRIDE;
  char* sXw = smem;
  char* sXa = smem + 2304;
  char* sZv = smem + 4608;
  float* sTmpF = reinterpret_cast<float*>(smem + 4608 + 16640);
  char* sTmp = smem + 4608 + 16640 + 4096;
  const float* mu = p.in[I_RW_MU] + l * 1792;
  const int tid = opaque_tid(), lane = tid & 63, w = tid >> 6;
  for (int t = blockIdx.x; t < T_TOK / 16; t += gridDim.x) {
    const int row0 = t * 16;
    for (int e = tid; e < 2048; e += 256) {
      int which = e >> 10, r = e & 1023, tok = r >> 6, j = r & 63;
      int row = row0 + tok, sq = row & (SEQ - 1);
      int rc = 1536 + which * 64 + j;
      float z = rw_shift(Z, row, sq, rc, mu[rc]);
      if (which == 0) *reinterpret_cast<bf16_t*>(sXw + tok * 144 + j * 2) = f2bf(ftanh(z));
      else *reinterpret_cast<bf16_t*>(sXa + tok * 144 + j * 2) = f2bf(z);
    }
    {
      float m0 = mu[1024 + tid], m1 = mu[1024 + tid + 256];
#pragma unroll 4
      for (int tok = 0; tok < 16; ++tok) {
        int row = row0 + tok, sq = row & (SEQ - 1);
        bf16_t z0 = f2bf(rw_shift(Z, row, sq, 1024 + tid, m0));
        bf16_t z1 = f2bf(rw_shift(Z, row, sq, 1024 + tid + 256, m1));
        *reinterpret_cast<bf16_t*>(sZv + tok * 1040 + tid * 2) = z0;
        *reinterpret_cast<bf16_t*>(sZv + tok * 1040 + (tid + 256) * 2) = z1;
        if (l == 0) {
          VF[(size_t)row * 512 + tid] = z0;
          VF[(size_t)row * 512 + tid + 256] = z1;
        }
      }
    }
    __syncthreads();
    f32x4 acc[8];
    lora_mfma<64>(sXw, 144, (const bf16_t*)(lo + LO_W2), acc, tid);
#pragma unroll
    for (int i = 0; i < 8; ++i)
#pragma unroll
      for (int jj = 0; jj < 4; ++jj)
        LW[(size_t)(row0 + (lane >> 4) * 4 + jj) * 512 + (w * 8 + i) * 16 + (lane & 15)] = f2bf(acc[i][jj]);
    lora_mfma<64>(sXa, 144, (const bf16_t*)(lo + LO_A2), acc, tid);
#pragma unroll
    for (int i = 0; i < 8; ++i)
#pragma unroll
      for (int jj = 0; jj < 4; ++jj)
        LA[(size_t)(row0 + (lane >> 4) * 4 + jj) * 512 + (w * 8 + i) * 16 + (lane & 15)] = f2bf(acc[i][jj]);
    if (l > 0) {
      {
        const bf16_t* v1t = (const bf16_t*)(lo + LO_V1);
        const int ntile = w & 1, kh = w >> 1;
        f32x4 tacc = f32x4{0.f, 0.f, 0.f, 0.f};
#pragma unroll
        for (int ks = 0; ks < 8; ++ks) {
          const int k0 = (kh * 8 + ks) * 32 + 8 * (lane >> 4);
          const bf16x8 a = *reinterpret_cast<const bf16x8*>(sZv + (lane & 15) * 1040 + k0 * 2);
          const bf16x8 b = *reinterpret_cast<const bf16x8*>(v1t + (size_t)(ntile * 16 + (lane & 15)) * 512 + k0);
          tacc = __builtin_amdgcn_mfma_f32_16x16x32_bf16(a, b, tacc, 0, 0, 0);
        }
#pragma unroll
        for (int jj = 0; jj < 4; ++jj)
          sTmpF[(kh * 16 + (lane >> 4) * 4 + jj) * 32 + ntile * 16 + (lane & 15)] = tacc[jj];
      }
      __syncthreads();
      for (int e = tid; e < 512; e += 256) {
        int tok = e >> 5, r = e & 31;
        *reinterpret_cast<bf16_t*>(sTmp + tok * 80 + r * 2) = f2bf(sTmpF[tok * 32 + r] + sTmpF[(16 + tok) * 32 + r]);
      }
      __syncthreads();
      lora_mfma<32>(sTmp, 80, (const bf16_t*)(lo + LO_V2), acc, tid);
      const float* v0 = p.in[I_RW_V0] + (size_t)(l - 1) * 512;
#pragma unroll
      for (int i = 0; i < 8; ++i) {
        const int ch = (w * 8 + i) * 16 + (lane & 15);
        const float b0 = v0[ch];
#pragma unroll
        for (int jj = 0; jj < 4; ++jj) {
          const int tok = (lane >> 4) * 4 + jj;
          const float zv = bf2f(*reinterpret_cast<const bf16_t*>(sZv + tok * 1040 + ch * 2));
          const size_t idx = (size_t)(row0 + tok) * 512 + ch;
          const float vf = bf2f(VF[idx]);
          VF[idx] = f2bf(zv + (vf - zv) * fsigmoid(b0 + acc[i][jj]));
        }
      }
    }
    __syncthreads();
  }
}

__device__ void hg_scan(const Params& p, int l, int task, char* smem) {
  const int b = task >> 3, h = (task >> 1) & 3, vg = task & 1;
  float* sFg = reinterpret_cast<float*>(smem);
  float* sQs = sFg + 16 * 128;
  float* sO = sQs + 16 * 128;
  float* sVv = sO + 4 * 16 * 64;
  const int tid = opaque_tid(), w = tid >> 6, lane = tid & 63;
  bf16_t* Z = (bf16_t*)(p.ws + OFF_Z) + (size_t)b * SEQ * ZS;
  const int ks = tid & 127;
  float lb = 0.f;
  if (l > 0) {
    float x0 = p.in[I_HG_LB][h * 128 + ks], x1 = p.in[I_HG_LB][512 + h * 128 + ks];
    float m = fmaxf(x0, x1), e0 = expf(x0 - m), e1 = expf(x1 - m);
    lb = e1 / (e0 + e1);
  }
  float s[32];
#pragma unroll
  for (int j = 0; j < 32; ++j) s[j] = 0.f;
  const int vcol = ZHG + 1024 + h * 128 + vg * 64;
  const int qcol = ZHG + h * 128 + ks;
  bf16_t rq0, rq1, rq2, rq3, rq4, rq5, rq6, rq7, rf0, rf1, rf2, rf3, rf4, rf5, rf6, rf7, rv0, rv1, rv2, rv3;
#define HG_LOAD(T0)                                                                                \
  {                                                                                                \
    const bf16_t* zb = Z + (size_t)((T0) + (tid >> 7)) * ZS + qcol;                                \
    rq0 = zb[0]; rf0 = zb[512]; zb += 2 * ZS; rq1 = zb[0]; rf1 = zb[512]; zb += 2 * ZS;            \
    rq2 = zb[0]; rf2 = zb[512]; zb += 2 * ZS; rq3 = zb[0]; rf3 = zb[512]; zb += 2 * ZS;            \
    rq4 = zb[0]; rf4 = zb[512]; zb += 2 * ZS; rq5 = zb[0]; rf5 = zb[512]; zb += 2 * ZS;            \
    rq6 = zb[0]; rf6 = zb[512]; zb += 2 * ZS; rq7 = zb[0]; rf7 = zb[512];                          \
    const bf16_t* zv = Z + (size_t)((T0) + w) * ZS + vcol + lane;                                  \
    rv0 = zv[0]; rv1 = zv[4 * ZS]; rv2 = zv[8 * ZS]; rv3 = zv[12 * ZS];                            \
  }
#define HG_PUT1(I, RQ, RF)                                                                         \
  {                                                                                                \
    int t = (tid >> 7) + 2 * (I);                                                                  \
    sFg[t * 128 + ks] = fmaxf(lb + (1.f - lb) * fsigmoid(bf2f(RF)), 1e-30f);                       \
    sQs[t * 128 + ks] = fsilu(bf2f(RQ));                                                           \
  }
#define HG_PROCESS()                                                                               \
  {                                                                                                \
    HG_PUT1(0, rq0, rf0) HG_PUT1(1, rq1, rf1) HG_PUT1(2, rq2, rf2) HG_PUT1(3, rq3, rf3)            \
    HG_PUT1(4, rq4, rf4) HG_PUT1(5, rq5, rf5) HG_PUT1(6, rq6, rf6) HG_PUT1(7, rq7, rf7)            \
    sVv[(w)*64 + lane] = bf2f(rv0); sVv[(w + 4) * 64 + lane] = bf2f(rv1);                          \
    sVv[(w + 8) * 64 + lane] = bf2f(rv2); sVv[(w + 12) * 64 + lane] = bf2f(rv3);                   \
  }
  HG_LOAD(0);
  HG_PROCESS();
  __syncthreads();
  constexpr int NCH = SEQ / 16;
#pragma unroll 1
  for (int c = 0; c < NCH; ++c) {
    const int t0 = c * 16;
    const int tn = (c + 1 < NCH) ? t0 + 16 : t0;
    HG_LOAD(tn);
    __builtin_amdgcn_sched_barrier(0);
#pragma unroll 2
    for (int t = 0; t < 16; ++t) {
      const float v = sVv[t * 64 + lane];
      const float opv = (lane < 32) ? sFg[t * 128 + w * 32 + lane] : sQs[t * 128 + w * 32 + (lane - 32)];
      const int opi = __builtin_bit_cast(int, opv);
      float o = 0.f;
#pragma unroll
      for (int j = 0; j < 32; ++j) {
        const float fg = __builtin_bit_cast(float, __builtin_amdgcn_readlane(opi, j));
        const float qq = __builtin_bit_cast(float, __builtin_amdgcn_readlane(opi, 32 + j));
        const float kv = fmaf(-fg, v, v);
        s[j] = fmaf(s[j], fg, kv);
        o = fmaf(qq, s[j], o);
      }
      sO[(w * 16 + t) * 64 + lane] = o;
    }
    __builtin_amdgcn_sched_barrier(0);
    __syncthreads();
    {
      int t = tid >> 4, v4 = (tid & 15) * 4;
      float4 a = *reinterpret_cast<const float4*>(sO + (0 * 16 + t) * 64 + v4);
      float4 bq = *reinterpret_cast<const float4*>(sO + (1 * 16 + t) * 64 + v4);
      float4 cq = *reinterpret_cast<const float4*>(sO + (2 * 16 + t) * 64 + v4);
      float4 d = *reinterpret_cast<const float4*>(sO + (3 * 16 + t) * 64 + v4);
      uint2 o;
      o.x = pack2(a.x + bq.x + cq.x + d.x, a.y + bq.y + cq.y + d.y);
      o.y = pack2(a.z + bq.z + cq.z + d.z, a.w + bq.w + cq.w + d.w);
      *reinterpret_cast<uint2*>(Z + (size_t)(t0 + t) * ZS + vcol + v4) = o;
    }
    HG_PROCESS();
    __syncthreads();
  }
#undef HG_LOAD
#undef HG_PUT1
#undef HG_PROCESS
}

__device__ void mb_scan(const Params& p, int l, int task, char* smem) {
  const int b = task >> 3, hd = task & 7, g = hd >> 2;
  float* sB = reinterpret_cast<float*>(smem);
  float* sC = sB + 16 * 128;
  float* sX = sC + 16 * 128;
  float* sDt = sX + 16 * 64;
  float* sDA = sDt + 16;
  float* sO = sDA + 16;
  const int tid = opaque_tid(), w = tid >> 6, lane = tid & 63;
  bf16_t* Z = (bf16_t*)(p.ws + OFF_Z) + (size_t)b * SEQ * ZS;
  const float* cw = p.in[I_MB_CONVW] + (size_t)l * 4 * 1024;
  const float* cb = p.in[I_MB_CONVB] + (size_t)l * 1024;
  int ci0, ci1;
  {
    int ch = tid;
    ci0 = (ch < 64) ? hd * 64 + ch : (ch < 192 ? 512 + g * 128 + (ch - 64) : 768 + g * 128 + (ch - 192));
    ci1 = 768 + g * 128 + 64 + (tid & 63);
  }
  float* dstA = (tid < 64) ? (sX + tid) : (tid < 192 ? (sB + (tid - 64)) : (sC + (tid - 192)));
  const int strideA = (tid < 64) ? 64 : 128;
  const float w0a = cw[ci0], w1a = cw[1024 + ci0], w2a = cw[2048 + ci0], w3a = cw[3072 + ci0], ba = cb[ci0];
  const float w0b = cw[ci1], w1b = cw[1024 + ci1], w2b = cw[2048 + ci1], w3b = cw[3072 + ci1], bb = cb[ci1];
  const float Aneg = -expf(p.in[I_MB_ALOG][l * 8 + hd]);
  const float dtb = p.in[I_MB_DTB][l * 8 + hd];
  const float Dsk = p.in[I_MB_D][l * 8 + hd];
  float s[32];
#pragma unroll
  for (int j = 0; j < 32; ++j) s[j] = 0.f;
  float pa1 = 0.f, pa2 = 0.f, pa3 = 0.f, pb1 = 0.f, pb2 = 0.f, pb3 = 0.f;
  const int xcol = ZMB + 512;
  const int rt = tid >> 4, rp4 = (tid & 15) * 4;
  bf16_t xa0, xa1, xa2, xa3, xa4, xa5, xa6, xa7, xa8, xa9, xa10, xa11, xa12, xa13, xa14, xa15;
  bf16_t xb0, xb1, xb2, xb3, xb4, xb5, xb6, xb7, xb8, xb9, xb10, xb11, xb12, xb13, xb14, xb15;
  bf16_t rdt;
  uint2 gcur, gnext;
#define MB_LOAD(T0)                                                                                 \
  {                                                                                                 \
    const bf16_t* za = Z + (size_t)(T0) * ZS + xcol + ci0;                                          \
    xa0 = za[0]; xa1 = za[ZS]; xa2 = za[2 * ZS]; xa3 = za[3 * ZS]; xa4 = za[4 * ZS]; xa5 = za[5 * ZS];        \
    xa6 = za[6 * ZS]; xa7 = za[7 * ZS]; xa8 = za[8 * ZS]; xa9 = za[9 * ZS]; xa10 = za[10 * ZS];     \
    xa11 = za[11 * ZS]; xa12 = za[12 * ZS]; xa13 = za[13 * ZS]; xa14 = za[14 * ZS]; xa15 = za[15 * ZS];       \
    if (tid < 64) {                                                                                 \
      const bf16_t* zb = Z + (size_t)(T0) * ZS + xcol + ci1;                                        \
      xb0 = zb[0]; xb1 = zb[ZS]; xb2 = zb[2 * ZS]; xb3 = zb[3 * ZS]; xb4 = zb[4 * ZS]; xb5 = zb[5 * ZS];      \
      xb6 = zb[6 * ZS]; xb7 = zb[7 * ZS]; xb8 = zb[8 * ZS]; xb9 = zb[9 * ZS]; xb10 = zb[10 * ZS];   \
      xb11 = zb[11 * ZS]; xb12 = zb[12 * ZS]; xb13 = zb[13 * ZS]; xb14 = zb[14 * ZS]; xb15 = zb[15 * ZS];     \
    }                                                                                               \
    rdt = Z[(size_t)((T0) + (tid & 15)) * ZS + ZMB + 1536 + hd];                                    \
    gnext = *reinterpret_cast<const uint2*>(Z + (size_t)((T0) + rt) * ZS + ZMB + hd * 64 + rp4);    \
  }
#define MB_CONV_A(T, XR)                                                                            \
  {                                                                                                 \
    float xv = bf2f(XR);                                                                            \
    dstA[(T)*strideA] = fsilu(ba + w0a * pa3 + w1a * pa2 + w2a * pa1 + w3a * xv);                   \
    pa3 = pa2; pa2 = pa1; pa1 = xv;                                                                 \
  }
#define MB_CONV_B(T, XR)                                                                            \
  {                                                                                                 \
    float xv = bf2f(XR);                                                                            \
    sC[(T)*128 + 64 + tid] = fsilu(bb + w0b * pb3 + w1b * pb2 + w2b * pb1 + w3b * xv);              \
    pb3 = pb2; pb2 = pb1; pb1 = xv;                                                                 \
  }
#define MB_PROCESS()                                                                                \
  {                                                                                                 \
    MB_CONV_A(0, xa0) MB_CONV_A(1, xa1) MB_CONV_A(2, xa2) MB_CONV_A(3, xa3) MB_CONV_A(4, xa4)       \
    MB_CONV_A(5, xa5) MB_CONV_A(6, xa6) MB_CONV_A(7, xa7) MB_CONV_A(8, xa8) MB_CONV_A(9, xa9)       \
    MB_CONV_A(10, xa10) MB_CONV_A(11, xa11) MB_CONV_A(12, xa12) MB_CONV_A(13, xa13)                 \
    MB_CONV_A(14, xa14) MB_CONV_A(15, xa15)                                                         \
    if (tid < 64) {                                                                                 \
      MB_CONV_B(0, xb0) MB_CONV_B(1, xb1) MB_CONV_B(2, xb2) MB_CONV_B(3, xb3) MB_CONV_B(4, xb4)     \
      MB_CONV_B(5, xb5) MB_CONV_B(6, xb6) MB_CONV_B(7, xb7) MB_CONV_B(8, xb8) MB_CONV_B(9, xb9)     \
      MB_CONV_B(10, xb10) MB_CONV_B(11, xb11) MB_CONV_B(12, xb12) MB_CONV_B(13, xb13)               \
      MB_CONV_B(14, xb14) MB_CONV_B(15, xb15)                                                       \
    }                                                                                               \
    if (tid < 16) {                                                                                 \
      float dt = fsoftplus(bf2f(rdt) + dtb);                                                        \
      sDt[tid] = dt;                                                                                \
      sDA[tid] = __expf(Aneg * dt);                                                                 \
    }                                                                                               \
    gcur = gnext;                                                                                   \
  }
  MB_LOAD(0);
  MB_PROCESS();
  __syncthreads();
  constexpr int NCH = SEQ / 16;
#pragma unroll 1
  for (int c = 0; c < NCH; ++c) {
    const int t0 = c * 16;
    const bool more = (c + 1 < NCH);
    const int tn = more ? t0 + 16 : t0;
    MB_LOAD(tn);
    __builtin_amdgcn_sched_barrier(0);
#pragma unroll 2
    for (int t = 0; t < 16; ++t) {
      const float dA = sDA[t];
      const float xdt = sX[t * 64 + lane] * sDt[t];
      const float opv = (lane < 32) ? sB[t * 128 + w * 32 + lane] : sC[t * 128 + w * 32 + (lane - 32)];
      const int opi = __builtin_bit_cast(int, opv);
      float y = 0.f;
#pragma unroll
      for (int j = 0; j < 32; ++j) {
        const float bn = __builtin_bit_cast(float, __builtin_amdgcn_readlane(opi, j));
        const float cn = __builtin_bit_cast(float, __builtin_amdgcn_readlane(opi, 32 + j));
        s[j] = fmaf(s[j], dA, bn * xdt);
        y = fmaf(cn, s[j], y);
      }
      sO[(w * 16 + t) * 64 + lane] = y;
    }
    __builtin_amdgcn_sched_barrier(0);
    __syncthreads();
    {
      float4 a = *reinterpret_cast<const float4*>(sO + (0 * 16 + rt) * 64 + rp4);
      float4 bq = *reinterpret_cast<const float4*>(sO + (1 * 16 + rt) * 64 + rp4);
      float4 cq = *reinterpret_cast<const float4*>(sO + (2 * 16 + rt) * 64 + rp4);
      float4 d = *reinterpret_cast<const float4*>(sO + (3 * 16 + rt) * 64 + rp4);
      float4 xs = *reinterpret_cast<const float4*>(sX + rt * 64 + rp4);
      bf16_t* gp = Z + (size_t)(t0 + rt) * ZS + ZMB + hd * 64 + rp4;
      float g0 = bf2f((bf16_t)(gcur.x & 0xffff)), g1 = bf2f((bf16_t)(gcur.x >> 16));
      float g2 = bf2f((bf16_t)(gcur.y & 0xffff)), g3 = bf2f((bf16_t)(gcur.y >> 16));
      float y0 = a.x + bq.x + cq.x + d.x + Dsk * xs.x;
      float y1 = a.y + bq.y + cq.y + d.y + Dsk * xs.y;
      float y2 = a.z + bq.z + cq.z + d.z + Dsk * xs.z;
      float y3 = a.w + bq.w + cq.w + d.w + Dsk * xs.w;
      uint2 o;
      o.x = pack2(y0 * fsilu(g0), y1 * fsilu(g1));
      o.y = pack2(y2 * fsilu(g2), y3 * fsilu(g3));
      *reinterpret_cast<uint2*>(gp) = o;
    }
    __syncthreads();
    if (more) MB_PROCESS();
    __syncthreads();
  }
#undef MB_LOAD
#undef MB_CONV_A
#undef MB_CONV_B
#undef MB_PROCESS
}

__device__ void s5_scan(const Params& p, int l, int task, char* smem) {
  const int tid = opaque_tid(), w = tid >> 6, lane = tid & 63;
  const int b = task >> 3, g = (task & 7) * 4 + w;
  char* base = smem + w * 6144;
  float* sU = reinterpret_cast<float*>(base);
  char* sHb = base + 1024;
  bf16_t* Z = (bf16_t*)(p.ws + OFF_Z) + (size_t)b * SEQ * ZS + ZS5 + g * 16;
  const int n = lane;
  float lr, li, bbr[16], bbi[16];
  bf16x8 Bf0, Bf1, Bf2, Bf3;
  {
    float dt = expf(p.in[I_S5_LOGDT][l * 32 + g]);
    float are = p.in[I_S5_ARE][(l * 32 + g) * 64 + n], aim = p.in[I_S5_AIM][(l * 32 + g) * 64 + n];
    float mag = expf(dt * are);
    lr = mag * cosf(dt * aim); li = mag * sinf(dt * aim);
    float den = are * are + aim * aim;
    float cr = ((lr - 1.f) * are + li * aim) / den;
    float ci = (li * are - (lr - 1.f) * aim) / den;
    const float* bre = p.in[I_S5_BRE] + ((size_t)(l * 32 + g) * 64 + n) * 16;
    const float* bim = p.in[I_S5_BIM] + ((size_t)(l * 32 + g) * 64 + n) * 16;
#pragma unroll
    for (int c = 0; c < 16; ++c) {
      float br = bre[c], bi = bim[c];
      bbr[c] = cr * br - ci * bi;
      bbi[c] = cr * bi + ci * br;
    }
    const float* cre = p.in[I_S5_CRE] + (size_t)(l * 32 + g) * 16 * 64 + (lane & 15) * 64;
    const float* cim = p.in[I_S5_CIM] + (size_t)(l * 32 + g) * 16 * 64 + (lane & 15) * 64;
#pragma unroll
    for (int j = 0; j < 8; ++j) {
      const int kb = 8 * (lane >> 4) + j;
      const int n0 = kb >> 1;
      const bool im = (j & 1);
      Bf0[j] = (short)f2bf(im ? -cim[n0] : cre[n0]);
      Bf1[j] = (short)f2bf(im ? -cim[n0 + 16] : cre[n0 + 16]);
      Bf2[j] = (short)f2bf(im ? -cim[n0 + 32] : cre[n0 + 32]);
      Bf3[j] = (short)f2bf(im ? -cim[n0 + 48] : cre[n0 + 48]);
    }
  }
  const float dsk = p.in[I_S5_D][l * 512 + g * 16 + (lane & 15)];
  const int pt = lane >> 2, pc4 = (lane & 3) * 4;
  float hr = 0.f, hi = 0.f;
  uint2 unext = *reinterpret_cast<const uint2*>(Z + (size_t)pt * ZS + pc4);
  constexpr int NCH = SEQ / 16;
#pragma unroll 1
  for (int c = 0; c < NCH; ++c) {
    const int t0 = c * 16;
    {
      const uint2 ur = unext;
      *reinterpret_cast<float4*>(sU + pt * 16 + pc4) =
          float4{bf2f((bf16_t)(ur.x & 0xffff)), bf2f((bf16_t)(ur.x >> 16)), bf2f((bf16_t)(ur.y & 0xffff)), bf2f((bf16_t)(ur.y >> 16))};
      const int tn = (c + 1 < NCH) ? t0 + 16 : t0;
      unext = *reinterpret_cast<const uint2*>(Z + (size_t)(tn + pt) * ZS + pc4);
    }
    __builtin_amdgcn_sched_barrier(0);
    __syncthreads();
#pragma unroll 2
    for (int t = 0; t < 16; ++t) {
      const float4* u4 = reinterpret_cast<const float4*>(sU + t * 16);
      float bur = 0.f, bui = 0.f;
#pragma unroll
      for (int q = 0; q < 4; ++q) {
        float4 u = u4[q];
        bur = fmaf(bbr[q * 4 + 0], u.x, bur); bui = fmaf(bbi[q * 4 + 0], u.x, bui);
        bur = fmaf(bbr[q * 4 + 1], u.y, bur); bui = fmaf(bbi[q * 4 + 1], u.y, bui);
        bur = fmaf(bbr[q * 4 + 2], u.z, bur); bui = fmaf(bbi[q * 4 + 2], u.z, bui);
        bur = fmaf(bbr[q * 4 + 3], u.w, bur); bui = fmaf(bbi[q * 4 + 3], u.w, bui);
      }
      float nr = lr * hr - li * hi + bur;
      float ni = lr * hi + li * hr + bui;
      hr = nr; hi = ni;
      *reinterpret_cast<unsigned*>(sHb + t * 272 + n * 4) = pack2(hr, hi);
    }
    __syncthreads();
    {
      f32x4 acc = f32x4{0.f, 0.f, 0.f, 0.f};
      const char* ap = sHb + (lane & 15) * 272 + (lane >> 4) * 16;
      acc = __builtin_amdgcn_mfma_f32_16x16x32_bf16(*reinterpret_cast<const bf16x8*>(ap), Bf0, acc, 0, 0, 0);
      acc = __builtin_amdgcn_mfma_f32_16x16x32_bf16(*reinterpret_cast<const bf16x8*>(ap + 64), Bf1, acc, 0, 0, 0);
      acc = __builtin_amdgcn_mfma_f32_16x16x32_bf16(*reinterpret_cast<const bf16x8*>(ap + 128), Bf2, acc, 0, 0, 0);
      acc = __builtin_amdgcn_mfma_f32_16x16x32_bf16(*reinterpret_cast<const bf16x8*>(ap + 192), Bf3, acc, 0, 0, 0);
      const int cc = lane & 15, tb = (lane >> 4) * 4;
#pragma unroll
      for (int jj = 0; jj < 4; ++jj) {
        float y = acc[jj] + dsk * sU[(tb + jj) * 16 + cc];
        Z[(size_t)(t0 + tb + jj) * ZS + cc] = f2bf(fgelu(y));
      }
    }
    __syncthreads();
  }
}

__device__ void rw_scan(const Params& p, int l, int task, char* smem) {
  const int b = task >> 3, h = task & 7;
  float* sR = reinterpret_cast<float*>(smem);
  float* sW = sR + 1024;
  float* sK = sW + 1024;
  float* sA = sK + 1024;
  float* sBb = sA + 1024;
  float* sV = sBb + 1024;
  float* sY = sV + 1024;
  float* sBonus = sY + 1024;
  const int tid = opaque_tid(), w = tid >> 6, lane = tid & 63;
  const size_t tokbase = (size_t)b * SEQ;
  bf16_t* Z = (bf16_t*)(p.ws + OFF_Z) + tokbase * ZS;
  const bf16_t* LW = (const bf16_t*)(p.ws + OFF_U) + tokbase * 512;
  const bf16_t* LA = LW + (size_t)T_TOK * 512;
  const bf16_t* VF = (const bf16_t*)(p.ws + OFF_VF) + tokbase * 512;
  const int st = tid >> 4, c4 = (tid & 15) * 4, ch = h * 64 + c4;
  float mur[4], muk[4], w0[4], a0[4], kk_[4], ka_[4], rk_[4], lnw[4], lnb[4];
#pragma unroll
  for (int e = 0; e < 4; ++e) {
    mur[e] = p.in[I_RW_MU][l * 1792 + ch + e];
    muk[e] = p.in[I_RW_MU][l * 1792 + 512 + ch + e];
    w0[e] = p.in[I_RW_W0][l * 512 + ch + e];
    a0[e] = p.in[I_RW_A0][l * 512 + ch + e];
    kk_[e] = p.in[I_RW_KK][l * 512 + ch + e];
    ka_[e] = p.in[I_RW_KA][l * 512 + ch + e];
    rk_[e] = p.in[I_RW_RK][l * 512 + ch + e];
    lnw[e] = p.in[I_RW_LNW][l * 512 + ch + e];
    lnb[e] = p.in[I_RW_LNB][l * 512 + ch + e];
  }
  const int rg = lane >> 3, kq = lane & 7, vrow = w * 16 + rg * 2;
  float S0[8], S1[8];
#pragma unroll
  for (int j = 0; j < 8; ++j) { S0[j] = 0.f; S1[j] = 0.f; }
  uint2 rc, kc, rp, kp, lwv, lav, vfv;
#define RW_LOAD(T0)                                                                                 \
  {                                                                                                 \
    const int s_ = (T0) + st;                                                                       \
    const bf16_t* zr = Z + (size_t)s_ * ZS + ZRW + ch;                                              \
    rc = *reinterpret_cast<const uint2*>(zr);                                                       \
    kc = *reinterpret_cast<const uint2*>(zr + 512);                                                 \
    rp = uint2{0u, 0u}; kp = uint2{0u, 0u};                                                         \
    if (s_ > 0) { rp = *reinterpret_cast<const uint2*>(zr - ZS); kp = *reinterpret_cast<const uint2*>(zr - ZS + 512); } \
    lwv = *reinterpret_cast<const uint2*>(LW + (size_t)s_ * 512 + ch);                              \
    lav = *reinterpret_cast<const uint2*>(LA + (size_t)s_ * 512 + ch);                              \
    vfv = *reinterpret_cast<const uint2*>(VF + (size_t)s_ * 512 + ch);                              \
  }
#define RW_PROCESS()                                                                                \
  {                                                                                                 \
    float r4[4], k4[4], kkv[4], av[4], wv[4], vv[4];                                                \
    float n2 = 0.f;                                                                                 \
    _Pragma("unroll") for (int e = 0; e < 4; ++e) {                                                 \
      unsigned rcw = (e < 2) ? rc.x : rc.y, kcw = (e < 2) ? kc.x : kc.y, rpw = (e < 2) ? rp.x : rp.y, kpw = (e < 2) ? kp.x : kp.y; \
      unsigned lww = (e < 2) ? lwv.x : lwv.y, law = (e < 2) ? lav.x : lav.y, vfw = (e < 2) ? vfv.x : vfv.y; \
      int sh = (e & 1) * 16;                                                                        \
      float rcur = bf2f((bf16_t)((rcw >> sh) & 0xffff)), rprev = bf2f((bf16_t)((rpw >> sh) & 0xffff)); \
      float kcur = bf2f((bf16_t)((kcw >> sh) & 0xffff)), kprev = bf2f((bf16_t)((kpw >> sh) & 0xffff)); \
      float lwf = bf2f((bf16_t)((lww >> sh) & 0xffff)), laf = bf2f((bf16_t)((law >> sh) & 0xffff)); \
      vv[e] = bf2f((bf16_t)((vfw >> sh) & 0xffff));                                                 \
      r4[e] = rcur + (rprev - rcur) * mur[e];                                                       \
      k4[e] = kcur + (kprev - kcur) * muk[e];                                                       \
      float wlog = -fsoftplus(-(w0[e] + lwf)) - 0.5f;                                               \
      wv[e] = __expf(-__expf(wlog));                                                                \
      av[e] = fsigmoid(a0[e] + laf);                                                                \
      kkv[e] = k4[e] * kk_[e];                                                                      \
      n2 += kkv[e] * kkv[e];                                                                        \
    }                                                                                               \
    n2 = sum16(n2);                                                                                 \
    float inv = 1.f / fmaxf(sqrtf(n2), 1e-12f);                                                     \
    float bon = 0.f;                                                                                \
    float kt4[4], ap4[4], bp4[4];                                                                   \
    _Pragma("unroll") for (int e = 0; e < 4; ++e) {                                                 \
      float kkn = kkv[e] * inv;                                                                     \
      kt4[e] = k4[e] * (1.f + (av[e] - 1.f) * ka_[e]);                                              \
      ap4[e] = -kkn;                                                                                \
      bp4[e] = kkn * av[e];                                                                         \
      bon += r4[e] * kt4[e] * rk_[e];                                                               \
    }                                                                                               \
    bon = sum16(bon);                                                                               \
    *reinterpret_cast<float4*>(sR + st * 64 + c4) = float4{r4[0], r4[1], r4[2], r4[3]};             \
    *reinterpret_cast<float4*>(sW + st * 64 + c4) = float4{wv[0], wv[1], wv[2], wv[3]};             \
    *reinterpret_cast<float4*>(sK + st * 64 + c4) = float4{kt4[0], kt4[1], kt4[2], kt4[3]};         \
    *reinterpret_cast<float4*>(sA + st * 64 + c4) = float4{ap4[0], ap4[1], ap4[2], ap4[3]};         \
    *reinterpret_cast<float4*>(sBb + st * 64 + c4) = float4{bp4[0], bp4[1], bp4[2], bp4[3]};        \
    *reinterpret_cast<float4*>(sV + st * 64 + c4) = float4{vv[0], vv[1], vv[2], vv[3]};             \
    if ((tid & 15) == 0) sBonus[st] = bon;                                                          \
  }
  RW_LOAD(0);
  RW_PROCESS();
  __syncthreads();
  constexpr int NCH = SEQ / 16;
#pragma unroll 1
  for (int c = 0; c < NCH; ++c) {
    const int t0 = c * 16;
    const int tn = (c + 1 < NCH) ? t0 + 16 : t0;
    RW_LOAD(tn);
    __builtin_amdgcn_sched_barrier(0);
#pragma unroll 2
    for (int t = 0; t < 16; ++t) {
      const float4* a4p = reinterpret_cast<const float4*>(sA + t * 64 + kq * 8);
      const float4* w4p = reinterpret_cast<const float4*>(sW + t * 64 + kq * 8);
      const float4* b4p = reinterpret_cast<const float4*>(sBb + t * 64 + kq * 8);
      const float4* k4p = reinterpret_cast<const float4*>(sK + t * 64 + kq * 8);
      const float4* r4p = reinterpret_cast<const float4*>(sR + t * 64 + kq * 8);
      const float2 vv = *reinterpret_cast<const float2*>(sV + t * 64 + vrow);
      float sa0 = 0.f, sa1 = 0.f;
#pragma unroll
      for (int q = 0; q < 2; ++q) {
        float4 a = a4p[q];
        sa0 = fmaf(S0[q * 4 + 0], a.x, sa0); sa1 = fmaf(S1[q * 4 + 0], a.x, sa1);
        sa0 = fmaf(S0[q * 4 + 1], a.y, sa0); sa1 = fmaf(S1[q * 4 + 1], a.y, sa1);
        sa0 = fmaf(S0[q * 4 + 2], a.z, sa0); sa1 = fmaf(S1[q * 4 + 2], a.z, sa1);
        sa0 = fmaf(S0[q * 4 + 3], a.w, sa0); sa1 = fmaf(S1[q * 4 + 3], a.w, sa1);
      }
      sa0 = oct_sum(sa0); sa1 = oct_sum(sa1);
      float y0 = 0.f, y1 = 0.f;
#pragma unroll
      for (int q = 0; q < 2; ++q) {
        float4 ww = w4p[q], bb = b4p[q], kk = k4p[q], rr = r4p[q];
        S0[q * 4 + 0] = fmaf(S0[q * 4 + 0], ww.x, fmaf(sa0, bb.x, vv.x * kk.x)); y0 = fmaf(S0[q * 4 + 0], rr.x, y0);
        S1[q * 4 + 0] = fmaf(S1[q * 4 + 0], ww.x, fmaf(sa1, bb.x, vv.y * kk.x)); y1 = fmaf(S1[q * 4 + 0], rr.x, y1);
        S0[q * 4 + 1] = fmaf(S0[q * 4 + 1], ww.y, fmaf(sa0, bb.y, vv.x * kk.y)); y0 = fmaf(S0[q * 4 + 1], rr.y, y0);
        S1[q * 4 + 1] = fmaf(S1[q * 4 + 1], ww.y, fmaf(sa1, bb.y, vv.y * kk.y)); y1 = fmaf(S1[q * 4 + 1], rr.y, y1);
        S0[q * 4 + 2] = fmaf(S0[q * 4 + 2], ww.z, fmaf(sa0, bb.z, vv.x * kk.z)); y0 = fmaf(S0[q * 4 + 2], rr.z, y0);
        S1[q * 4 + 2] = fmaf(S1[q * 4 + 2], ww.z, fmaf(sa1, bb.z, vv.y * kk.z)); y1 = fmaf(S1[q * 4 + 2], rr.z, y1);
        S0[q * 4 + 3] = fmaf(S0[q * 4 + 3], ww.w, fmaf(sa0, bb.w, vv.x * kk.w)); y0 = fmaf(S0[q * 4 + 3], rr.w, y0);
        S1[q * 4 + 3] = fmaf(S1[q * 4 + 3], ww.w, fmaf(sa1, bb.w, vv.y * kk.w)); y1 = fmaf(S1[q * 4 + 3], rr.w, y1);
      }
      y0 = oct_sum(y0); y1 = oct_sum(y1);
      if (kq == 0) *reinterpret_cast<float2*>(sY + t * 64 + vrow) = float2{y0, y1};
    }
    __builtin_amdgcn_sched_barrier(0);
    __syncthreads();
    {
      float4 y4 = *reinterpret_cast<const float4*>(sY + st * 64 + c4);
      float4 v4 = *reinterpret_cast<const float4*>(sV + st * 64 + c4);
      float bon = sBonus[st];
      float mean = sum16(y4.x + y4.y + y4.z + y4.w) * (1.f / 64.f);
      float dx = y4.x - mean, dy = y4.y - mean, dz = y4.z - mean, dw = y4.w - mean;
      float var = sum16(dx * dx + dy * dy + dz * dz + dw * dw) * (1.f / 64.f);
      float rs = rsqrtf(var + 64e-5f);
      float o0 = dx * rs * lnw[0] + lnb[0] + bon * v4.x;
      float o1 = dy * rs * lnw[1] + lnb[1] + bon * v4.y;
      float o2 = dz * rs * lnw[2] + lnb[2] + bon * v4.z;
      float o3 = dw * rs * lnw[3] + lnb[3] + bon * v4.w;
      uint2 o;
      o.x = pack2(o0, o1); o.y = pack2(o2, o3);
      *reinterpret_cast<uint2*>(Z + (size_t)(t0 + st) * ZS + ZRW + 1024 + ch) = o;
    }
    RW_PROCESS();
    __syncthreads();
  }
#undef RW_LOAD
#undef RW_PROCESS
}

__device__ void phase_scans(const Params& p, int l, char* smem, int scan_mask = 15) {
  for (int t = blockIdx.x; t < 256; t += gridDim.x) {
    int type = t & 3, idx = t >> 2;
    if (!((scan_mask >> type) & 1)) continue;
#ifndef SCM
#define SCM 15
#endif
    if (type == 0) { if (SCM & 1) rw_scan(p, l, idx, smem); }
    else if (type == 1) { if (SCM & 2) hg_scan(p, l, idx, smem); }
    else if (type == 2) { if (SCM & 4) mb_scan(p, l, idx, smem); }
    else { if (SCM & 8) s5_scan(p, l, idx, smem); }
    __syncthreads();
  }
  if (l + 1 < 2) {
    const int tid = opaque_tid();
    const int nb = (gridDim.x > 256) ? (int)gridDim.x - 256 : (int)gridDim.x;
    const int b0 = (gridDim.x > 256) ? (int)blockIdx.x - 256 : (int)blockIdx.x;
    if (b0 >= 0)
      for (int c = b0; c < CT_TOTAL; c += nb) convert_one(p, l + 1, c, smem, tid);
  }
}

__device__ __forceinline__ void unpack8(const uint4& v, float (&f)[8]) {
  f[0] = bf2f((bf16_t)(v.x & 0xffff)); f[1] = bf2f((bf16_t)(v.x >> 16));
  f[2] = bf2f((bf16_t)(v.y & 0xffff)); f[3] = bf2f((bf16_t)(v.y >> 16));
  f[4] = bf2f((bf16_t)(v.z & 0xffff)); f[5] = bf2f((bf16_t)(v.z >> 16));
  f[6] = bf2f((bf16_t)(v.w & 0xffff)); f[7] = bf2f((bf16_t)(v.w >> 16));
}

__device__ void phase_post(const Params& p, int l, char* smem) {
  bf16_t* Z = (bf16_t*)(p.ws + OFF_Z);
  const int tid = opaque_tid(), lane = tid & 63, wid = tid >> 6;
  constexpr int N_ROWT = T_TOK / 4, N_RWT = T_TOK / 16, N_GLU = 128 * 4, N_NORM = T_TOK / 4;
  const float* xsrc = (l == 0) ? p.in[I_X] : p.out;
  for (int t = blockIdx.x; t < N_ROWT + N_RWT + N_GLU + N_NORM; t += gridDim.x) {
    if (t < N_ROWT) {
      const int row = t * 4 + wid;
      {
        bf16_t* op = Z + (size_t)row * ZS + ZHG + 1024 + lane * 8;
        uint4 ov = *reinterpret_cast<const uint4*>(op);
        uint4 gv = *reinterpret_cast<const uint4*>(op + 512);
        float o[8], g[8];
        unpack8(ov, o); unpack8(gv, g);
        float ss = 0.f;
#pragma unroll
        for (int e = 0; e < 8; ++e) ss += o[e] * o[e];
        ss = sum16(ss);
        float rstd = rsqrtf(ss * (1.f / 128.f) + 1e-6f);
        const float* nw = p.in[I_HG_NW] + l * 512 + lane * 8;
        float r[8];
#pragma unroll
        for (int e = 0; e < 8; ++e) r[e] = o[e] * rstd * nw[e] * siluf_(g[e]);
        *reinterpret_cast<uint4*>(op) = uint4{pack2(r[0], r[1]), pack2(r[2], r[3]), pack2(r[4], r[5]), pack2(r[6], r[7])};
      }
      {
        bf16_t* op = Z + (size_t)row * ZS + ZMB + lane * 8;
        uint4 ov = *reinterpret_cast<const uint4*>(op);
        float o[8];
        unpack8(ov, o);
        float ss = 0.f;
#pragma unroll
        for (int e = 0; e < 8; ++e) ss += o[e] * o[e];
        ss = sum64(ss);
        float rstd = rsqrtf(ss * (1.f / 512.f) + 1e-6f);
        const float* nw = p.in[I_MB_NW] + l * 512 + lane * 8;
        float r[8];
#pragma unroll
        for (int e = 0; e < 8; ++e) r[e] = o[e] * rstd * nw[e];
        *reinterpret_cast<uint4*>(op) = uint4{pack2(r[0], r[1]), pack2(r[2], r[3]), pack2(r[4], r[5]), pack2(r[6], r[7])};
      }
    } else if (t < N_ROWT + N_RWT) {
      const int row0 = (t - N_ROWT) * 16;
      char* sXg = smem;
      const float* mu = p.in[I_RW_MU] + l * 1792 + 1664;
      for (int e = tid; e < 2048; e += 256) {
        int tok = e >> 7, j = e & 127;
        int row = row0 + tok, sq = row & (SEQ - 1);
        *reinterpret_cast<bf16_t*>(sXg + tok * 272 + j * 2) = f2bf(fsigmoid(rw_shift(Z, row, sq, 1664 + j, mu[j])));
      }
      __syncthreads();
      f32x4 acc[8];
      lora_mfma<128>(sXg, 272, (const bf16_t*)(p.ws + OFF_LORA + (size_t)l * LORA_STRIDE + LO_G2), acc, tid);
#pragma unroll
      for (int i = 0; i < 8; ++i)
#pragma unroll
        for (int jj = 0; jj < 4; ++jj) {
          bf16_t* yp = Z + (size_t)(row0 + (lane >> 4) * 4 + jj) * ZS + ZRW + 1024 + (wid * 8 + i) * 16 + (lane & 15);
          *yp = f2bf(bf2f(*yp) * acc[i][jj]);
        }
      __syncthreads();
    } else if (t < N_ROWT + N_RWT + N_GLU) {
      const int tt = t - N_ROWT - N_RWT, mt = tt >> 2, nt = tt & 3;
      const int wm = wid >> 1, wn = wid & 1;
      f32x4 acc[4][4];
      zero_acc<128>(acc);
      gemm_mainloop<128>(acc, Z + ZS5, ZS, mt * 128, (const bf16_t*)(p.ws + WOFF(OFF_WTGLU, l)), 512, nt * 128, 511, 512, smem, tid);
      const float* bg = p.in[I_S5_BGLU] + l * 512;
#pragma unroll
      for (int mi = 0; mi < 4; ++mi)
#pragma unroll
        for (int ni = 0; ni < 4; ++ni) {
          int col = nt * 128 + wn * 64 + ni * 16 + (lane >> 4) * 4;
          int row = mt * 128 + wm * 64 + mi * 16 + (lane & 15);
          float4 b4 = *reinterpret_cast<const float4*>(bg + col);
          uint2 yv = *reinterpret_cast<const uint2*>(Z + (size_t)row * ZS + ZS5 + col);
          float y0 = bf2f((bf16_t)(yv.x & 0xffff)), y1 = bf2f((bf16_t)(yv.x >> 16));
          float y2 = bf2f((bf16_t)(yv.y & 0xffff)), y3 = bf2f((bf16_t)(yv.y >> 16));
          uint2 o;
          o.x = pack2(y0 * sigmoidf_(acc[mi][ni][0] + b4.x), y1 * sigmoidf_(acc[mi][ni][1] + b4.y));
          o.y = pack2(y2 * sigmoidf_(acc[mi][ni][2] + b4.z), y3 * sigmoidf_(acc[mi][ni][3] + b4.w));
          *reinterpret_cast<uint2*>(Z + (size_t)row * ZS + ZMB + 1024 + col) = o;
        }
    } else {
      const int row = (t - N_ROWT - N_RWT - N_GLU) * 4 + wid;
      rmsnorm_row_to_bf16(xsrc + (size_t)row * DM, p.in[I_NORM_MIX] + l * DM, (bf16_t*)(p.ws + OFF_U) + (size_t)row * DM, tid & 63);
    }
  }
}

__device__ void phase_merge(const Params& p, int l, char* smem) {
  bf16_t* Z = (bf16_t*)(p.ws + OFF_Z);
  const bf16_t* U = (const bf16_t*)(p.ws + OFF_U);
  const bf16_t* Wg = (const bf16_t*)(p.ws + WOFF_GATE(l));
  const bf16_t* Wb = (const bf16_t*)(p.ws + WOFF(OFF_WTBR, l));
  const int tid = opaque_tid();
  const int lane = tid & 63, wid = tid >> 6, wm = wid >> 1, wn = wid & 1;
  for (int t = blockIdx.x; t < tile_count(128, 8); t += gridDim.x) {
    int mt, nt;
    if (!tile_map(t, 8, mt, nt)) continue;
    f32x4 accm[4][4];
    zero_acc<128>(accm);
    f32x4 a1[4][4];
    zero_acc<128>(a1);
    uint2 sg[4][4];
#pragma unroll
    for (int mi = 0; mi < 4; ++mi)
#pragma unroll
      for (int ni = 0; ni < 4; ++ni) sg[mi][ni] = uint2{0u, 0u};
#pragma unroll 1
    for (int sub = 0; sub < 8; ++sub) {
      const int kb = sub >> 1, which = sub & 1;
      const int ycol = (kb == 0) ? (ZHG + 1024) : (kb == 1) ? (ZRW + 1024) : (kb == 2) ? (ZMB + 1024) : ZMB;
      const bf16_t* Ap = which ? (const bf16_t*)(Z + ycol) : U;
      const int ldap = which ? ZS : 1024;
      const bf16_t* Bp = which ? (Wb + (size_t)kb * 1024 * 512) : (Wg + (size_t)kb * 1024 * 1024);
      const int Kp = which ? 512 : 1024;
      gemm_mainloop_glds<128>(a1, Ap, ldap, mt * 128, Bp, Kp, nt * 128, 1023, Kp, smem, tid);
      if (which == 0) {
#pragma unroll
        for (int mi = 0; mi < 4; ++mi)
#pragma unroll
          for (int ni = 0; ni < 4; ++ni) {
            sg[mi][ni].x = pack2(fsigmoid(a1[mi][ni][0]), fsigmoid(a1[mi][ni][1]));
            sg[mi][ni].y = pack2(fsigmoid(a1[mi][ni][2]), fsigmoid(a1[mi][ni][3]));
            a1[mi][ni] = f32x4{0.f, 0.f, 0.f, 0.f};
          }
      } else {
#pragma unroll
        for (int mi = 0; mi < 4; ++mi)
#pragma unroll
          for (int ni = 0; ni < 4; ++ni) {
            accm[mi][ni][0] = fmaf(bf2f((bf16_t)(sg[mi][ni].x & 0xffff)), a1[mi][ni][0], accm[mi][ni][0]);
            accm[mi][ni][1] = fmaf(bf2f((bf16_t)(sg[mi][ni].x >> 16)), a1[mi][ni][1], accm[mi][ni][1]);
            accm[mi][ni][2] = fmaf(bf2f((bf16_t)(sg[mi][ni].y & 0xffff)), a1[mi][ni][2], accm[mi][ni][2]);
            accm[mi][ni][3] = fmaf(bf2f((bf16_t)(sg[mi][ni].y >> 16)), a1[mi][ni][3], accm[mi][ni][3]);
            a1[mi][ni] = f32x4{0.f, 0.f, 0.f, 0.f};
          }
      }
    }
#pragma unroll
    for (int mi = 0; mi < 4; ++mi)
#pragma unroll
      for (int ni = 0; ni < 4; ++ni) {
        int col = nt * 128 + wn * 64 + ni * 16 + (lane >> 4) * 4;
        int row = mt * 128 + wm * 64 + mi * 16 + (lane & 15);
        uint2 o;
        o.x = pack2(accm[mi][ni][0], accm[mi][ni][1]);
        o.y = pack2(accm[mi][ni][2], accm[mi][ni][3]);
        *reinterpret_cast<uint2*>(Z + (size_t)row * ZS + col) = o;
      }
  }
}

__device__ void phase_resid_gemm(const Params& p, const bf16_t* A, int lda, const bf16_t* Wt, int K, const float* xold, char* smem) {
  const int tid = opaque_tid();
  const int lane = tid & 63, wid = tid >> 6, wm = wid >> 1, wn = wid & 1;
  for (int t = blockIdx.x; t < tile_count(64, 8); t += gridDim.x) {
    int mt, nt;
    if (!tile_map(t, 8, mt, nt)) continue;
    f32x4 acc[8][4];
    zero_acc_big(acc);
    gemm_mainloop_big(acc, A, lda, mt * 256, Wt, K, nt * 128, 1023, K, smem, tid);
#pragma unroll
    for (int mi = 0; mi < 8; ++mi)
#pragma unroll
      for (int ni = 0; ni < 4; ++ni) {
        int col = nt * 128 + wn * 64 + ni * 16 + (lane >> 4) * 4;
        int row = mt * 256 + wm * 128 + mi * 16 + (lane & 15);
        size_t o = (size_t)row * DM + col;
        float4 xo = *reinterpret_cast<const float4*>(xold + o);
        float4 r = float4{xo.x + acc[mi][ni][0], xo.y + acc[mi][ni][1], xo.z + acc[mi][ni][2], xo.w + acc[mi][ni][3]};
        *reinterpret_cast<float4*>(p.out + o) = r;
      }
  }
}

__device__ void phase_ffn_in(const Params& p, int l, char* smem) {
  const bf16_t* U = (const bf16_t*)(p.ws + OFF_U);
  const bf16_t* Wt = (const bf16_t*)(p.ws + WOFF(OFF_WTF1, l));
  bf16_t* H = (bf16_t*)(p.ws + OFF_Z);
  const int tid = opaque_tid();
  const int lane = tid & 63, wid = tid >> 6, wm = wid >> 1, wn = wid & 1;
  for (int t = blockIdx.x; t < tile_count(64, 44); t += gridDim.x) {
    int mt, nt;
    if (!tile_map(t, 44, mt, nt)) continue;
    f32x4 acc[8][4];
    zero_acc_big(acc);
    gemm_mainloop_big(acc, U, 1024, mt * 256, Wt, 1024, nt * 128, 5631, 1024, smem, tid);
#pragma unroll
    for (int mi = 0; mi < 8; ++mi)
#pragma unroll
      for (int q = 0; q < 2; ++q) {
        int hcol = ((nt * 128 + wn * 64 + q * 32) >> 1) + (lane >> 4) * 4;
        int row = mt * 256 + wm * 128 + mi * 16 + (lane & 15);
        uint2 o;
        o.x = pack2(fsilu(acc[mi][2 * q][0]) * acc[mi][2 * q + 1][0], fsilu(acc[mi][2 * q][1]) * acc[mi][2 * q + 1][1]);
        o.y = pack2(fsilu(acc[mi][2 * q][2]) * acc[mi][2 * q + 1][2], fsilu(acc[mi][2 * q][3]) * acc[mi][2 * q + 1][3]);
        *reinterpret_cast<uint2*>(H + (size_t)row * FFH + hcol) = o;
      }
  }
}

__device__ void phase_final(const Params& p) {
  const int tid = opaque_tid();
  const int lane = tid & 63;
  const float* w = p.in[I_NORM_FINAL];
  for (int t = blockIdx.x; t < T_TOK / 4; t += gridDim.x) {
    int row = t * 4 + (tid >> 6);
    float* x = p.out + (size_t)row * DM;
    float4 v[4];
    float ss = 0.f;
#pragma unroll
    for (int i = 0; i < 4; ++i) {
      v[i] = *reinterpret_cast<const float4*>(x + i * 256 + lane * 4);
      ss += v[i].x * v[i].x + v[i].y * v[i].y + v[i].z * v[i].z + v[i].w * v[i].w;
    }
    ss = sum64(ss);
    float rstd = rsqrtf(ss * (1.f / 1024.f) + 1e-6f);
#pragma unroll
    for (int i = 0; i < 4; ++i) {
      float4 ww = *reinterpret_cast<const float4*>(w + i * 256 + lane * 4);
      float4 o = float4{v[i].x * rstd * ww.x, v[i].y * rstd * ww.y, v[i].z * rstd * ww.z, v[i].w * rstd * ww.w};
      *reinterpret_cast<float4*>(x + i * 256 + lane * 4) = o;
    }
  }
}

template <int SUB>
__device__ __forceinline__ void run_phase(const Params& p, int l, char* smem) {
  if (SUB == 0) phase_convert_norm(p, l, smem);
  else if (SUB == 1) phase_inproj(p, smem);
  else if (SUB == 2) phase_rwprep(p, l, smem);
  else if (SUB == 3) phase_scans(p, l, smem);
  else if (SUB == 4) phase_post(p, l, smem);
  else if (SUB == 5) phase_merge(p, l, smem);
  else if (SUB == 6) phase_resid_gemm(p, (const bf16_t*)(p.ws + OFF_Z), ZS, (const bf16_t*)(p.ws + WOFF(OFF_WTOUT, l)), 1024,
                                      (l == 0) ? p.in[I_X] : p.out, smem);
  else if (SUB == 7) phase_norm_only(p, p.out, p.in[I_NORM_FFN] + l * DM);
  else if (SUB == 8) phase_ffn_in(p, l, smem);
  else if (SUB == 9) phase_resid_gemm(p, (const bf16_t*)(p.ws + OFF_Z), FFH, (const bf16_t*)(p.ws + WOFF(OFF_WTF2, l)), FFH, p.out, smem);
  else phase_final(p);
}

#ifndef PHM
#define PHM 0xFFFF
#endif
#define XB_TMO      128
#define XB_XCNT(j)  (256  + 64 * (j))
#define XB_XSUB(j)  (1280 + 64 * (j))
#define XB_XGEN(j)  (2304 + 64 * (j))
#define XB_TOP      3328
#define XB_TOPGEN   3392
#define XCD_BAR_WORDS 3456
#define XB_SPIN_CAP (1u << 18)
#define LAS __attribute__((address_space(3)))

__device__ __forceinline__ unsigned xb_ld(unsigned* p)              { return __hip_atomic_load(p, __ATOMIC_RELAXED, __HIP_MEMORY_SCOPE_AGENT); }
__device__ __forceinline__ unsigned xb_add(unsigned* p, unsigned v) { return __hip_atomic_fetch_add(p, v, __ATOMIC_RELAXED, __HIP_MEMORY_SCOPE_AGENT); }
__device__ __forceinline__ unsigned xb_xcc_id() { return (unsigned)__builtin_amdgcn_s_getreg((3 << 11) | 20) & 0xFu; }
#define XB_SPIN(cond, bar) do { unsigned _sp = 0; while (cond) { __builtin_amdgcn_s_sleep(1); \
    if ((++_sp & 255u) == 0u) { if (xb_ld(&(bar)[XB_TMO])) break; if (_sp > XB_SPIN_CAP) { atomicAdd(&(bar)[XB_TMO], 1u); break; } } } } while (0)

struct XcdBarrier {
    unsigned* bar; unsigned x;
    volatile LAS unsigned* st;
};

__device__ __forceinline__ XcdBarrier xcd_barrier_post(unsigned* bar, volatile LAS unsigned* st) {
    XcdBarrier b; b.bar = bar; b.x = xb_xcc_id(); b.st = st;
    if (threadIdx.x == 0) (void)xb_add(&bar[XB_XCNT(b.x)], 1u);
    return b;
}
__device__ __forceinline__ void xcd_barrier_complete(unsigned* bar, unsigned x, unsigned& nloc, unsigned& nx) {
    const unsigned G = gridDim.x * gridDim.y * gridDim.z;
    unsigned sum, cnt, mine, sp = 0u;
    for (;;) {
        sum = 0u; cnt = 0u; mine = 0u;
#pragma unroll
        for (unsigned j = 0; j < 16; ++j) { const unsigned c = xb_ld(&bar[XB_XCNT(j)]); sum += c; cnt += (c > 0u) ? 1u : 0u; mine = (j == x) ? c : mine; }
        if (sum == G) break;
        __builtin_amdgcn_s_sleep(1);
        if ((++sp & 255u) == 0u) { if (xb_ld(&bar[XB_TMO])) break; if (sp > XB_SPIN_CAP) { atomicAdd(&bar[XB_TMO], 1u); break; } }
    }
    nloc = mine > 0u ? mine : 1u; nx = cnt > 0u ? cnt : 1u;
}

__device__ __forceinline__ void xcd_barrier(const XcdBarrier& b) {
    asm volatile("s_waitcnt vmcnt(0)" ::: "memory");
    __syncthreads();
    if (threadIdx.x == 0) {
        unsigned* bar = b.bar;
        __builtin_amdgcn_s_waitcnt(0);
        unsigned nloc = b.st[0], nx = b.st[1];
        if (nloc == 0u) { xcd_barrier_complete(bar, b.x, nloc, nx); b.st[0] = nloc; b.st[1] = nx; }
        const unsigned old = xb_add(&bar[XB_XSUB(b.x)], 1u);
        const unsigned gen = old / nloc;
        if (old + 1u == (gen + 1u) * nloc) {
            __builtin_amdgcn_fence(__ATOMIC_RELEASE, "agent");
            asm volatile("s_waitcnt vmcnt(0)" ::: "memory");
            const unsigned og = xb_add(&bar[XB_TOP], 1u);
            const unsigned tg = og / nx;
            if (og + 1u == (tg + 1u) * nx) xb_add(&bar[XB_TOPGEN], 1u);
            else XB_SPIN(xb_ld(&bar[XB_TOPGEN]) == tg, bar);
            __builtin_amdgcn_fence(__ATOMIC_ACQUIRE, "agent");
            xb_add(&bar[XB_XGEN(b.x)], 1u);
            asm volatile("s_waitcnt vmcnt(0)" ::: "memory");
        } else {
            XB_SPIN(xb_ld(&bar[XB_XGEN(b.x)]) == gen, bar);
            __builtin_amdgcn_fence(__ATOMIC_ACQUIRE, "agent");
            asm volatile("s_waitcnt vmcnt(0)" ::: "memory");
        }
    }
    __syncthreads();
}


constexpr int LDS_MAIN = 73728;
constexpr int LDS_BYTES = LDS_MAIN + 16;

#if COOP
__global__ void __launch_bounds__(256, 2) fwd_kernel(Params p, int ph0, int ph1, int scan_mask) {
  extern __shared__ __attribute__((aligned(16))) char smem[];
  cg::grid_group grid = cg::this_grid();
  volatile LAS unsigned* xb_st = (volatile LAS unsigned*)(smem + LDS_MAIN);
  if (threadIdx.x == 0) { xb_st[0] = 0u; xb_st[1] = 0u; xb_st[2] = 0u; xb_st[3] = 0u; }
  __syncthreads();
  XcdBarrier xbar = xcd_barrier_post(reinterpret_cast<unsigned*>(p.ws + OFF_BAR), xb_st);
  for (int ph = ph0; ph < ph1; ++ph) {
    if (ph == NPHASES - 1) {
      phase_final(p);
    } else {
      const int l = ph / NPH_LAYER, sub = ph % NPH_LAYER;
      switch (sub) {
        case 0: if (PHM & (1<<0)) run_phase<0>(p, l, smem); break;
        case 1: if (PHM & (1<<1)) run_phase<1>(p, l, smem); break;
        case 2: if (PHM & (1<<2)) run_phase<2>(p, l, smem); break;
        case 3: if (PHM & (1<<3)) phase_scans(p, l, smem, scan_mask); break;
        case 4: if (PHM & (1<<4)) run_phase<4>(p, l, smem); break;
        case 5: if (PHM & (1<<5)) run_phase<5>(p, l, smem); break;
        case 6: if (PHM & (1<<6)) run_phase<6>(p, l, smem); break;
        case 7: if (PHM & (1<<7)) run_phase<7>(p, l, smem); break;
        case 8: if (PHM & (1<<8)) run_phase<8>(p, l, smem); break;
        case 9: if (PHM & (1<<9)) run_phase<9>(p, l, smem); break;
      }
    }
    if (ph + 1 < ph1) {
      if (ph1 > 1000) grid.sync();
      else xcd_barrier(xbar);
    }
  }
}
#else
template <int SUB>
__global__ void __launch_bounds__(256, 2) k_phase(Params p, int l) {
  __shared__ __attribute__((aligned(16))) char smem[65536];
  run_phase<SUB>(p, l, smem);
}
#endif

extern "C" void kernel_launch(void* const* d_in, const int* in_sizes, int n_in, void* d_out, int out_size, void* d_ws,
                              size_t ws_size, hipStream_t stream) {
  if (n_in < 41 || ws_size < WS_NEED) {
    fprintf(stderr, "kernel_launch: bad args n_in=%d ws=%zu need=%zu\n", n_in, ws_size, (size_t)WS_NEED);
    return;
  }
  Params p{};
  for (int i = 0; i < 41; ++i) p.in[i] = (const float*)d_in[i];
  p.out = (float*)d_out;
  p.ws = (char*)d_ws;
#if COOP
  static int grid_blocks = 0;
  if (!grid_blocks) {
    int dev = 0, cus = 0, per_cu = 0;
    hipGetDevice(&dev);
    hipDeviceGetAttribute(&cus, hipDeviceAttributeMultiprocessorCount, dev);
    hipFuncSetAttribute((const void*)fwd_kernel, hipFuncAttributeMaxDynamicSharedMemorySize, LDS_BYTES);
    hipOccupancyMaxActiveBlocksPerMultiprocessor(&per_cu, fwd_kernel, 256, LDS_BYTES);
    if (per_cu > 2) per_cu = 2;
    grid_blocks = cus * per_cu;
  }
#ifdef HYBRID
  for (int ph = 0; ph < NPHASES; ++ph) {
    if (ph % 10 == 3 && ph < 20) {
      const int groups[4] = SCAN_GROUPS;
      for (int gi = 0; gi < 4; ++gi) if (groups[gi]) fwd_kernel<<<grid_blocks, 256, LDS_BYTES, stream>>>(p, ph, ph + 1, groups[gi]);
    } else {
      fwd_kernel<<<grid_blocks, 256, LDS_BYTES, stream>>>(p, ph, ph + 1, 15);
    }
  }
#else
  hipMemsetAsync((char*)d_ws + OFF_BAR, 0, XCD_BAR_WORDS * 4, stream);
  int ph0 = 0, ph1 = NPHASES, smask = 15;
  void* args[] = {&p, &ph0, &ph1, &smask};
  hipError_t e = hipLaunchCooperativeKernel((void*)fwd_kernel, dim3(grid_blocks), dim3(256), args, LDS_BYTES, stream);
  if (e != hipSuccess) fprintf(stderr, "cooperative launch failed: %s (grid %d)\n", hipGetErrorString(e), grid_blocks);
#endif
#else
  const dim3 g(512), b(256);
  for (int l = 0; l < 2; ++l) {
    k_phase<0><<<g, b, 0, stream>>>(p, l);
    k_phase<1><<<g, b, 0, stream>>>(p, l);
    k_phase<2><<<g, b, 0, stream>>>(p, l);
    k_phase<3><<<g, b, 0, stream>>>(p, l);
    k_phase<4><<<g, b, 0, stream>>>(p, l);
    k_phase<5><<<g, b, 0, stream>>>(p, l);
    k_phase<6><<<g, b, 0, stream>>>(p, l);
    k_phase<7><<<g, b, 0, stream>>>(p, l);
    k_phase<8><<<g, b, 0, stream>>>(p, l);
    k_phase<9><<<g, b, 0, stream>>>(p, l);
  }
  k_phase<10><<<g, b, 0, stream>>>(p, 0);
#endif
}
```

```cpp
#include <hip/hip_runtime.h>
#include <hip/hip_cooperative_groups.h>
#include <cstdio>
#include <cstdint>
namespace cg = cooperative_groups;

#ifndef COOP
#define COOP 1
#endif

#define LAS __attribute__((address_space(3)))
typedef unsigned short bf16_t;
typedef __attribute__((ext_vector_type(8))) short bf16x8;
typedef __attribute__((ext_vector_type(4))) float f32x4;
typedef __attribute__((ext_vector_type(4))) unsigned u32x4;

constexpr int T_TOK = 16384, SEQ = 2048, DM = 1024;
constexpr int IN_COLS = 9992, NZ = 5896, ZS = 5904;
constexpr int ZHG = 0, ZRW = 2048, ZS5 = 3840, ZMB = 4352;
constexpr int FFH = 2816;
constexpr int NPH_LAYER = 10, NPHASES = 21;

constexpr size_t OFF_WTIN   = 0;
constexpr size_t OFF_WTGATE = OFF_WTIN + (size_t)5896 * 1024 * 2;
constexpr size_t OFF_WTBR   = OFF_WTGATE + (size_t)4096 * 1024 * 2;
constexpr size_t OFF_WTOUT  = OFF_WTBR + (size_t)4 * 1024 * 512 * 2;
constexpr size_t OFF_WTF1   = OFF_WTOUT + (size_t)1024 * 1024 * 2;
constexpr size_t OFF_WTF2   = OFF_WTF1 + (size_t)5632 * 1024 * 2;
constexpr size_t OFF_WTGLU  = OFF_WTF2 + (size_t)1024 * 2816 * 2;
constexpr size_t OFF_U      = OFF_WTGLU + (size_t)512 * 512 * 2;
constexpr size_t OFF_Z      = OFF_U + (size_t)T_TOK * 1024 * 2;
constexpr size_t OFF_VF     = OFF_Z + (size_t)T_TOK * ZS * 2;
constexpr size_t OFF_BAR    = OFF_VF + (size_t)T_TOK * 512 * 2;
constexpr size_t OFF_WTGATE_B = OFF_BAR + 16384;
constexpr size_t OFF_WB_B     = OFF_WTGATE_B + (size_t)4096 * 1024 * 2;
constexpr size_t OFF_LORA     = OFF_WB_B + (OFF_U - OFF_WTBR);
constexpr size_t LORA_STRIDE  = 524288;
constexpr size_t LO_G2 = 0, LO_W2 = 131072, LO_A2 = 196608, LO_V1 = 262144, LO_V2 = 294912;
constexpr size_t WS_NEED      = OFF_LORA + 2 * LORA_STRIDE;
constexpr size_t DELTA_GATE   = OFF_WTGATE_B - OFF_WTGATE;
constexpr size_t DELTA_WB     = OFF_WB_B - OFF_WTBR;
#define WOFF_GATE(l) (OFF_WTGATE + (size_t)(l) * DELTA_GATE)
#define WOFF(off, l) ((off) + (size_t)(l) * DELTA_WB)

struct Params {
  const float* in[41];
  float* out;
  char* ws;
};

enum { I_X = 0, I_NORM_MIX, I_W_IN, I_W_BRANCH, I_W_OUT, I_NORM_FFN, I_W_FFN_IN, I_W_FFN_OUT, I_NORM_FINAL,
       I_HG_LB, I_HG_NW, I_RW_MU, I_RW_W0, I_RW_W2, I_RW_A0, I_RW_A2, I_RW_G2, I_RW_KK, I_RW_KA, I_RW_RK,
       I_RW_LNW, I_RW_LNB, I_RW_V0, I_RW_V1, I_RW_V2, I_S5_ARE, I_S5_AIM, I_S5_BRE, I_S5_BIM, I_S5_CRE,
       I_S5_CIM, I_S5_D, I_S5_LOGDT, I_S5_WGLU, I_S5_BGLU, I_MB_CONVW, I_MB_CONVB, I_MB_DTB, I_MB_ALOG,
       I_MB_D, I_MB_NW };

__device__ __forceinline__ float bf2f(bf16_t v) { return __uint_as_float(((unsigned)v) << 16); }
typedef __attribute__((ext_vector_type(2))) __bf16 bf16x2_t;
__device__ __forceinline__ unsigned pack2(float a, float b) {
  bf16x2_t v;
  v[0] = (__bf16)a;
  v[1] = (__bf16)b;
  return __builtin_bit_cast(unsigned, v);
}
__device__ __forceinline__ bf16_t f2bf(float f) { return (bf16_t)(pack2(f, 0.f) & 0xffffu); }
__device__ __forceinline__ float sigmoidf_(float x) { return 1.f / (1.f + __expf(-x)); }
__device__ __forceinline__ float siluf_(float x) { return x / (1.f + __expf(-x)); }
__device__ __forceinline__ float softplusf_(float x) { return x > 20.f ? x : log1pf(__expf(x)); }
__device__ __forceinline__ float gelu_tanh(float x) {
  float u = 0.7978845608028654f * (x + 0.044715f * x * x * x);
  return 0.5f * x * (1.f + tanhf(u));
}
__device__ __forceinline__ float frcp(float x) { return __builtin_amdgcn_rcpf(x); }
__device__ __forceinline__ float fsigmoid(float x) { return frcp(1.f + __expf(-x)); }
__device__ __forceinline__ float fsilu(float x) { return x * frcp(1.f + __expf(-x)); }
__device__ __forceinline__ float fsoftplus(float x) { return x > 20.f ? x : __logf(1.f + __expf(x)); }
__device__ __forceinline__ float ftanh(float x) {
  float e = __expf(2.f * fminf(fmaxf(x, -15.f), 15.f));
  return (e - 1.f) * frcp(e + 1.f);
}
__device__ __forceinline__ float fgelu(float x) {
  float u = 0.7978845608028654f * (x + 0.044715f * x * x * x);
  return 0.5f * x * (1.f + ftanh(u));
}

__device__ __forceinline__ float quad_sum(float x) {
  x += __builtin_bit_cast(float, __builtin_amdgcn_update_dpp(0, __builtin_bit_cast(int, x), 0xB1, 0xF, 0xF, true));
  x += __builtin_bit_cast(float, __builtin_amdgcn_update_dpp(0, __builtin_bit_cast(int, x), 0x4E, 0xF, 0xF, true));
  return x;
}
__device__ __forceinline__ float oct_sum(float x) {
  x = quad_sum(x);
  x += __builtin_bit_cast(float, __builtin_amdgcn_update_dpp(0, __builtin_bit_cast(int, x), 0x141, 0xF, 0xF, true));
  return x;
}
__device__ __forceinline__ float sum16(float x) {
  x += __shfl_xor(x, 1); x += __shfl_xor(x, 2); x += __shfl_xor(x, 4); x += __shfl_xor(x, 8);
  return x;
}
__device__ __forceinline__ float sum64(float x) {
  x = sum16(x); x += __shfl_xor(x, 16); x += __shfl_xor(x, 32);
  return x;
}

__device__ __forceinline__ int opaque_tid() {
  int t = threadIdx.x;
  asm volatile("" : "+v"(t));
  return t;
}

template <int BN>
__device__ __forceinline__ void gemm_mainloop(f32x4 (&acc)[4][BN / 32], const bf16_t* A, int lda, int m0,
                                              const bf16_t* Bt, int ldb, int n0, int nmax, int K, char* smem, const int tid) {
  const int lane = tid & 63, wid = tid >> 6, wm = wid >> 1, wn = wid & 1;
  const int q = tid & 7, r0 = tid >> 3;
  unsigned offA[4], offB[BN / 32];
#pragma unroll
  for (int i = 0; i < 4; ++i) offA[i] = ((unsigned)(m0 + r0 + 32 * i) * (unsigned)lda + (unsigned)q * 8u) * 2u;
#pragma unroll
  for (int i = 0; i < BN / 32; ++i) {
    int row = n0 + r0 + 32 * i;
    row = row < nmax ? row : nmax;
    offB[i] = ((unsigned)row * (unsigned)ldb + (unsigned)q * 8u) * 2u;
  }
  const unsigned sto = (unsigned)r0 * 128u + (unsigned)((q ^ ((r0 >> 1) & 7)) << 4);
  unsigned aoff[4], boff[BN / 32];
#pragma unroll
  for (int mi = 0; mi < 4; ++mi) {
    int row = wm * 64 + mi * 16 + (lane & 15);
    aoff[mi] = (unsigned)row * 128u + (unsigned)(((lane >> 4) ^ ((row >> 1) & 7)) << 4);
  }
#pragma unroll
  for (int ni = 0; ni < BN / 32; ++ni) {
    int row = wn * (BN / 2) + ni * 16 + (lane & 15);
    boff[ni] = (unsigned)row * 128u + (unsigned)(((lane >> 4) ^ ((row >> 1) & 7)) << 4);
  }
  const char* Ab = reinterpret_cast<const char*>(A);
  const char* Bb = reinterpret_cast<const char*>(Bt);
  const int nk = K >> 6;
  constexpr bool WIDE = (BN == 128);
  u32x4 Ra0, Ra1, Ra2, Ra3, Rb0, Rb1, Rb2, Rb3;
  u32x4 Qa0, Qa1, Qa2, Qa3, Qb0, Qb1, Qb2, Qb3;
#define GLOAD(P, TILE)                                                         \
  {                                                                            \
    const char* Ak_ = Ab + (size_t)(TILE) * 128;                               \
    const char* Bk_ = Bb + (size_t)(TILE) * 128;                               \
    P##a0 = *reinterpret_cast<const u32x4*>(Ak_ + offA[0]);                    \
    P##a1 = *reinterpret_cast<const u32x4*>(Ak_ + offA[1]);                    \
    P##a2 = *reinterpret_cast<const u32x4*>(Ak_ + offA[2]);                    \
    P##a3 = *reinterpret_cast<const u32x4*>(Ak_ + offA[3]);                    \
    P##b0 = *reinterpret_cast<const u32x4*>(Bk_ + offB[0]);                    \
    P##b1 = *reinterpret_cast<const u32x4*>(Bk_ + offB[1]);                    \
    if (WIDE) {                                                                \
      P##b2 = *reinterpret_cast<const u32x4*>(Bk_ + offB[BN / 32 - 2]);        \
      P##b3 = *reinterpret_cast<const u32x4*>(Bk_ + offB[BN / 32 - 1]);        \
    }                                                                          \
  }
#define SSTORE(P, BUF)                                                         \
  {                                                                            \
    char* ad_ = smem + (BUF) * 16384 + sto;                                    \
    char* bd_ = smem + 32768 + (BUF) * (BN * 128) + sto;                       \
    *reinterpret_cast<u32x4*>(ad_) = P##a0;                                    \
    *reinterpret_cast<u32x4*>(ad_ + 4096) = P##a1;                             \
    *reinterpret_cast<u32x4*>(ad_ + 8192) = P##a2;                             \
    *reinterpret_cast<u32x4*>(ad_ + 12288) = P##a3;                            \
    *reinterpret_cast<u32x4*>(bd_) = P##b0;                                    \
    *reinterpret_cast<u32x4*>(bd_ + 4096) = P##b1;                             \
    if (WIDE) {                                                                \
      *reinterpret_cast<u32x4*>(bd_ + 8192) = P##b2;                           \
      *reinterpret_cast<u32x4*>(bd_ + 12288) = P##b3;                          \
    }                                                                          \
  }
#define COMPUTE(BUF)                                                           \
  {                                                                            \
    const char* a_s = smem + (BUF) * 16384;                                    \
    const char* b_s = smem + 32768 + (BUF) * (BN * 128);                       \
    _Pragma("unroll") for (int ks = 0; ks < 2; ++ks) {                         \
      bf16x8 af[4], bfr[BN / 32];                                              \
      _Pragma("unroll") for (int mi = 0; mi < 4; ++mi)                         \
          af[mi] = *reinterpret_cast<const bf16x8*>(a_s + (aoff[mi] ^ (ks * 64)));       \
      _Pragma("unroll") for (int ni = 0; ni < BN / 32; ++ni)                   \
          bfr[ni] = *reinterpret_cast<const bf16x8*>(b_s + (boff[ni] ^ (ks * 64)));      \
      _Pragma("unroll") for (int mi = 0; mi < 4; ++mi)                         \
        _Pragma("unroll") for (int ni = 0; ni < BN / 32; ++ni)                 \
          acc[mi][ni] = __builtin_amdgcn_mfma_f32_16x16x32_bf16(bfr[ni], af[mi], acc[mi][ni], 0, 0, 0); \
    }                                                                          \
  }
  if constexpr (WIDE && false) {
    GLOAD(R, 0);
    SSTORE(R, 0);
    GLOAD(R, 1);
    if (nk > 2) GLOAD(Q, 2);
    __syncthreads();
#pragma unroll 1
    for (int kt = 0; kt < nk; kt += 2) {
      __builtin_amdgcn_sched_barrier(0);
      COMPUTE(0);
      __builtin_amdgcn_sched_barrier(0);
      SSTORE(R, 1);
      if (kt + 3 < nk) GLOAD(R, kt + 3);
      __syncthreads();
      __builtin_amdgcn_sched_barrier(0);
      COMPUTE(1);
      __builtin_amdgcn_sched_barrier(0);
      if (kt + 2 < nk) SSTORE(Q, 0);
      if (kt + 4 < nk) GLOAD(Q, kt + 4);
      __syncthreads();
    }
  } else {
    GLOAD(R, 0);
    SSTORE(R, 0);
    __syncthreads();
#pragma unroll 1
    for (int kt = 0; kt < nk; ++kt) {
      const int buf = kt & 1;
      const bool more = (kt + 1 < nk);
      if (more) GLOAD(R, kt + 1);
      __builtin_amdgcn_sched_barrier(0);
      COMPUTE(buf);
      __builtin_amdgcn_sched_barrier(0);
      if (more) SSTORE(R, buf ^ 1);
      __syncthreads();
    }
  }
#undef GLOAD
#undef SSTORE
#undef COMPUTE
}

template <int BN>
__device__ __forceinline__ void zero_acc(f32x4 (&acc)[4][BN / 32]) {
#pragma unroll
  for (int mi = 0; mi < 4; ++mi)
#pragma unroll
    for (int ni = 0; ni < BN / 32; ++ni) acc[mi][ni] = f32x4{0.f, 0.f, 0.f, 0.f};
}

#define RAW_BARRIER() do { asm volatile("s_waitcnt lgkmcnt(0)" ::: "memory"); __builtin_amdgcn_s_barrier(); } while (0)
template <int MROWS>
__device__ __forceinline__ void gemm_mainloop_glds(f32x4 (&acc)[MROWS / 32][4], const bf16_t* A, int lda, int m0, const bf16_t* Bt,
                                                   int ldb, int n0, int nmax, int K, char* smem, const int tid) {
  constexpr int NA = MROWS / 64;
  constexpr int NMI = MROWS / 32;
  constexpr int STAGE = (MROWS + 128) * 64;
  constexpr int BOFF = MROWS * 64;
  const int lane = tid & 63, wid = tid >> 6, wm = wid >> 1, wn = wid & 1;
  unsigned gA[NA], gB[2];
#pragma unroll
  for (int i = 0; i < NA; ++i) {
    const int row = (wid * NA + i) * 16 + (lane >> 2);
    const int q = (lane & 3) ^ ((row >> 2) & 3);
    gA[i] = ((unsigned)(m0 + row) * (unsigned)lda + (unsigned)q * 8u) * 2u;
  }
#pragma unroll
  for (int i = 0; i < 2; ++i) {
    const int row = (wid * 2 + i) * 16 + (lane >> 2);
    const int q = (lane & 3) ^ ((row >> 2) & 3);
    int grow = n0 + row;
    grow = grow < nmax ? grow : nmax;
    gB[i] = ((unsigned)grow * (unsigned)ldb + (unsigned)q * 8u) * 2u;
  }
  unsigned aoff[NMI], boff[4];
#pragma unroll
  for (int mi = 0; mi < NMI; ++mi) {
    int row = wm * (MROWS / 2) + mi * 16 + (lane & 15);
    aoff[mi] = (unsigned)row * 64u + (unsigned)(((lane >> 4) ^ ((row >> 2) & 3)) << 4);
  }
#pragma unroll
  for (int ni = 0; ni < 4; ++ni) {
    int row = wn * 64 + ni * 16 + (lane & 15);
    boff[ni] = (unsigned)BOFF + (unsigned)row * 64u + (unsigned)(((lane >> 4) ^ ((row >> 2) & 3)) << 4);
  }
  const char* Ab = reinterpret_cast<const char*>(A);
  const char* Bb = reinterpret_cast<const char*>(Bt);
  const int nk = K >> 5;
  char* ldsA = smem + wid * (NA * 1024);
  char* ldsB = smem + BOFF + wid * 2048;
#define BG_GLDS(TILE, ST)                                                                                           \
  {                                                                                                                 \
    const char* Ak_ = Ab + (size_t)(TILE) * 64;                                                                     \
    const char* Bk_ = Bb + (size_t)(TILE) * 64;                                                                     \
    char* la_ = ldsA + (ST) * STAGE;                                                                                \
    char* lb_ = ldsB + (ST) * STAGE;                                                                                \
    _Pragma("unroll") for (int i_ = 0; i_ < NA; ++i_)                                                               \
      __builtin_amdgcn_global_load_lds((const unsigned*)(Ak_ + gA[i_]), (LAS unsigned*)(la_ + i_ * 1024), 16, 0, 0); \
    __builtin_amdgcn_global_load_lds((const unsigned*)(Bk_ + gB[0]), (LAS unsigned*)(lb_), 16, 0, 0);              \
    __builtin_amdgcn_global_load_lds((const unsigned*)(Bk_ + gB[1]), (LAS unsigned*)(lb_ + 1024), 16, 0, 0);       \
  }
#define BG_COMPUTE(ST)                                                                                              \
  {                                                                                                                 \
    const char* s_ = smem + (ST) * STAGE;                                                                           \
    bf16x8 bfr[4], af[NMI];                                                                                         \
    _Pragma("unroll") for (int ni = 0; ni < 4; ++ni) bfr[ni] = *reinterpret_cast<const bf16x8*>(s_ + boff[ni]);     \
    _Pragma("unroll") for (int mi = 0; mi < NMI; ++mi) af[mi] = *reinterpret_cast<const bf16x8*>(s_ + aoff[mi]);    \
    __builtin_amdgcn_sched_barrier(0);                                                                              \
    _Pragma("unroll") for (int mi = 0; mi < NMI; ++mi)                                                              \
      _Pragma("unroll") for (int ni = 0; ni < 4; ++ni)                                                              \
        acc[mi][ni] = __builtin_amdgcn_mfma_f32_16x16x32_bf16(bfr[ni], af[mi], acc[mi][ni], 0, 0, 0);               \
  }
  asm volatile("s_waitcnt vmcnt(0)" ::: "memory");
  BG_GLDS(0, 0);
  BG_GLDS(1, 1);
  int st = 0;
#pragma unroll 1
  for (int kt = 0; kt < nk - 1; ++kt) {
    if constexpr (NA == 4) asm volatile("s_waitcnt vmcnt(6)" ::: "memory");
    else asm volatile("s_waitcnt vmcnt(4)" ::: "memory");
    RAW_BARRIER();
    if (kt + 2 < nk) {
      const int st2 = (st >= 1) ? st - 1 : 2;
      BG_GLDS(kt + 2, st2);
    }
    __builtin_amdgcn_sched_barrier(0);
    BG_COMPUTE(st);
    __builtin_amdgcn_sched_barrier(0);
    st = (st == 2) ? 0 : st + 1;
  }
  asm volatile("s_waitcnt vmcnt(0)" ::: "memory");
  RAW_BARRIER();
  BG_COMPUTE(st);
  RAW_BARRIER();
#undef BG_GLDS
#undef BG_COMPUTE
}
__device__ __forceinline__ void gemm_mainloop_big(f32x4 (&acc)[8][4], const bf16_t* A, int lda, int m0, const bf16_t* Bt,
                                                  int ldb, int n0, int nmax, int K, char* smem, const int tid) {
  gemm_mainloop_glds<256>(acc, A, lda, m0, Bt, ldb, n0, nmax, K, smem, tid);
}

__device__ __forceinline__ void zero_acc_big(f32x4 (&acc)[8][4]) {
#pragma unroll
  for (int mi = 0; mi < 8; ++mi)
#pragma unroll
    for (int ni = 0; ni < 4; ++ni) acc[mi][ni] = f32x4{0.f, 0.f, 0.f, 0.f};
}

__device__ __forceinline__ void conv_tile(const float* src, int ld, int nlimit, int k0, int n0, bf16_t* dst, int Kd, int mode,
                                          char* smem, const int tid) {
  float* sT = reinterpret_cast<float*>(smem);
#pragma unroll
  for (int i = 0; i < 16; ++i) {
    int kk = i * 4 + (tid >> 6), nn = tid & 63;
    float v = (n0 + nn < nlimit) ? src[(size_t)(k0 + kk) * ld + n0 + nn] : 0.f;
    sT[kk * 65 + nn] = v;
  }
  __syncthreads();
  {
    int nn = tid >> 2, kq = tid & 3;
    int n = n0 + nn;
    if (n < nlimit) {
      int drow = n;
      if (mode == 1) {
        if (n < FFH) drow = (n >> 4) * 32 + (n & 15);
        else { int j = n - FFH; drow = (j >> 4) * 32 + 16 + (j & 15); }
      }
      unsigned pk[8];
#pragma unroll
      for (int j = 0; j < 8; ++j) pk[j] = pack2(sT[(kq * 16 + 2 * j) * 65 + nn], sT[(kq * 16 + 2 * j + 1) * 65 + nn]);
      uint4* d = reinterpret_cast<uint4*>(dst + (size_t)drow * Kd + k0 + kq * 16);
      d[0] = uint4{pk[0], pk[1], pk[2], pk[3]};
      d[1] = uint4{pk[4], pk[5], pk[6], pk[7]};
    }
  }
  __syncthreads();
}

__device__ __forceinline__ void rmsnorm_row_to_bf16(const float* x, const float* w, bf16_t* out, const int lane) {
  float4 v[4];
  float ss = 0.f;
#pragma unroll
  for (int i = 0; i < 4; ++i) {
    v[i] = *reinterpret_cast<const float4*>(x + i * 256 + lane * 4);
    ss += v[i].x * v[i].x + v[i].y * v[i].y + v[i].z * v[i].z + v[i].w * v[i].w;
  }
  ss = sum64(ss);
  float rstd = rsqrtf(ss * (1.f / 1024.f) + 1e-6f);
#pragma unroll
  for (int i = 0; i < 4; ++i) {
    float4 ww = *reinterpret_cast<const float4*>(w + i * 256 + lane * 4);
    uint2 o;
    o.x = pack2(v[i].x * rstd * ww.x, v[i].y * rstd * ww.y);
    o.y = pack2(v[i].z * rstd * ww.z, v[i].w * rstd * ww.w);
    *reinterpret_cast<uint2*>(out + i * 256 + lane * 4) = o;
  }
}

constexpr int CT_IN = 157 * 16, CT_BR = 512, CT_OUT = 256, CT_F1 = 88 * 16, CT_F2 = 44 * 16, CT_GLU = 64;
constexpr int CT_TOTAL = CT_IN + CT_BR + CT_OUT + CT_F1 + CT_F2 + CT_GLU;

__device__ __forceinline__ void convert_one(const Params& p, int l, int c, char* smem, const int tid) {
  char* ws = p.ws;
  if (c < CT_IN) {
    int nt = c >> 4, kt = c & 15;
    const float* src = p.in[I_W_IN] + (size_t)l * 1024 * IN_COLS;
    if (nt < 64) conv_tile(src, IN_COLS, IN_COLS, kt * 64, nt * 64, (bf16_t*)(ws + WOFF_GATE(l)), 1024, 0, smem, tid);
    else conv_tile(src + 4096, IN_COLS, IN_COLS - 4096, kt * 64, (nt - 64) * 64, (bf16_t*)(ws + OFF_WTIN), 1024, 0, smem, tid);
    return;
  }
  c -= CT_IN;
  if (c < CT_BR) {
    int kb = c >> 7, r = c & 127, nt = r >> 3, kt = r & 7;
    const float* src = p.in[I_W_BRANCH] + ((size_t)l * 4 + kb) * 512 * 1024;
    conv_tile(src, 1024, 1024, kt * 64, nt * 64, (bf16_t*)(ws + WOFF(OFF_WTBR, l)) + (size_t)kb * 1024 * 512, 512, 0, smem, tid);
    return;
  }
  c -= CT_BR;
  if (c < CT_OUT) {
    int nt = c >> 4, kt = c & 15;
    conv_tile(p.in[I_W_OUT] + (size_t)l * 1024 * 1024, 1024, 1024, kt * 64, nt * 64, (bf16_t*)(ws + WOFF(OFF_WTOUT, l)), 1024, 0, smem, tid);
    return;
  }
  c -= CT_OUT;
  if (c < CT_F1) {
    int nt = c >> 4, kt = c & 15;
    conv_tile(p.in[I_W_FFN_IN] + (size_t)l * 1024 * 5632, 5632, 5632, kt * 64, nt * 64, (bf16_t*)(ws + WOFF(OFF_WTF1, l)), 1024, 1, smem, tid);
    return;
  }
  c -= CT_F1;
  if (c < CT_F2) {
    int nt = c / 44, kt = c % 44;
    conv_tile(p.in[I_W_FFN_OUT] + (size_t)l * FFH * 1024, 1024, 1024, kt * 64, nt * 64, (bf16_t*)(ws + WOFF(OFF_WTF2, l)), FFH, 0, smem, tid);
    return;
  }
  c -= CT_F2;
  {
    int nt = c >> 3, kt = c & 7;
    conv_tile(p.in[I_S5_WGLU] + (size_t)l * 512 * 512, 512, 512, kt * 64, nt * 64, (bf16_t*)(ws + WOFF(OFF_WTGLU, l)), 512, 0, smem, tid);
  }
}

constexpr int CT_LORA = 41;
__device__ __forceinline__ void convert_lora(const Params& p, int l, int c, char* smem, const int tid) {
  char* lo = p.ws + OFF_LORA + (size_t)l * LORA_STRIDE;
  if (c < 16) { int nt = c >> 1, kt = c & 1;
    conv_tile(p.in[I_RW_G2] + (size_t)l * 128 * 512, 512, 512, kt * 64, nt * 64, (bf16_t*)(lo + LO_G2), 128, 0, smem, tid); return; }
  c -= 16;
  if (c < 8) { conv_tile(p.in[I_RW_W2] + (size_t)l * 64 * 512, 512, 512, 0, c * 64, (bf16_t*)(lo + LO_W2), 64, 0, smem, tid); return; }
  c -= 8;
  if (c < 8) { conv_tile(p.in[I_RW_A2] + (size_t)l * 64 * 512, 512, 512, 0, c * 64, (bf16_t*)(lo + LO_A2), 64, 0, smem, tid); return; }
  c -= 8;
  if (l == 0) return;
  if (c < 8) { conv_tile(p.in[I_RW_V1] + (size_t)(l - 1) * 512 * 32, 32, 32, c * 64, 0, (bf16_t*)(lo + LO_V1), 512, 0, smem, tid); return; }
  {
    const float* src = p.in[I_RW_V2] + (size_t)(l - 1) * 32 * 512;
    bf16_t* dst = (bf16_t*)(lo + LO_V2);
    for (int e = tid; e < 32 * 512; e += 256) { int ch = e >> 5, r = e & 31; dst[e] = f2bf(src[r * 512 + ch]); }
  }
}

template <int J>
__device__ __forceinline__ void lora_mfma(const char* sIn, int rowb, const bf16_t* Wt, f32x4 (&acc)[8], const int tid) {
  const int lane = tid & 63, w = tid >> 6;
#pragma unroll
  for (int i = 0; i < 8; ++i) acc[i] = f32x4{0.f, 0.f, 0.f, 0.f};
#pragma unroll
  for (int ks = 0; ks < J / 32; ++ks) {
    const bf16x8 a = *reinterpret_cast<const bf16x8*>(sIn + (lane & 15) * rowb + (ks * 32 + 8 * (lane >> 4)) * 2);
#pragma unroll
    for (int i = 0; i < 8; ++i) {
      const bf16x8 b = *reinterpret_cast<const bf16x8*>(Wt + (size_t)((w * 8 + i) * 16 + (lane & 15)) * J + ks * 32 + 8 * (lane >> 4));
      acc[i] = __builtin_amdgcn_mfma_f32_16x16x32_bf16(a, b, acc[i], 0, 0, 0);
    }
  }
}

__device__ void phase_convert_norm(const Params& p, int l, char* smem) {
  const int tid = opaque_tid();
  constexpr int CT_IN_ONLY = CT_IN - 1024;
  const int nconv = (l == 0) ? CT_IN_ONLY + 2 * CT_LORA : 0;
  const int ntask = nconv + T_TOK / 4;
  const float* xsrc = (l == 0) ? p.in[I_X] : p.out;
  for (int t = blockIdx.x; t < ntask; t += gridDim.x) {
    if (t < nconv) {
      if (t < CT_IN_ONLY) convert_one(p, l, t + 1024, smem, tid);
      else { int c = t - CT_IN_ONLY; convert_lora(p, c / CT_LORA, c % CT_LORA, smem, tid); __syncthreads(); }
    } else {
      int row = (t - nconv) * 4 + (tid >> 6);
      rmsnorm_row_to_bf16(xsrc + (size_t)row * DM, p.in[I_NORM_MIX] + l * DM, (bf16_t*)(p.ws + OFF_U) + (size_t)row * DM, tid & 63);
    }
  }
}

__device__ void phase_norm_only(const Params& p, const float* xsrc, const float* w) {
  const int tid = opaque_tid();
  for (int t = blockIdx.x; t < T_TOK / 4; t += gridDim.x) {
    int row = t * 4 + (tid >> 6);
    rmsnorm_row_to_bf16(xsrc + (size_t)row * DM, w, (bf16_t*)(p.ws + OFF_U) + (size_t)row * DM, tid & 63);
  }
}

__device__ __forceinline__ bool tile_map(int t, int NT, int& mt, int& nt) {
  const int x = t & 7, r = t >> 3;
  const int cnt = (NT + 7) >> 3;
  const int ni = r % cnt;
  mt = r / cnt;
  nt = x + 8 * ni;
  return nt < NT;
}
__device__ __forceinline__ int tile_count(int MT, int NT) { return 8 * MT * ((NT + 7) >> 3); }

__device__ void phase_inproj(const Params& p, char* smem) {
  const bf16_t* U = (const bf16_t*)(p.ws + OFF_U);
  const bf16_t* Wt = (const bf16_t*)(p.ws + OFF_WTIN);
  bf16_t* Z = (bf16_t*)(p.ws + OFF_Z);
  const int tid = opaque_tid();
  const int lane = tid & 63, wid = tid >> 6, wm = wid >> 1, wn = wid & 1;
  constexpr int NT = 47;
  for (int t = blockIdx.x; t < tile_count(64, NT); t += gridDim.x) {
    int mt, nt;
    if (!tile_map(t, NT, mt, nt)) continue;
    f32x4 acc[8][4];
    zero_acc_big(acc);
    gemm_mainloop_big(acc, U, 1024, mt * 256, Wt, 1024, nt * 128, NZ - 1, 1024, smem, tid);
#pragma unroll
    for (int mi = 0; mi < 8; ++mi)
#pragma unroll
      for (int ni = 0; ni < 4; ++ni) {
        int col = nt * 128 + wn * 64 + ni * 16 + (lane >> 4) * 4;
        int row = mt * 256 + wm * 128 + mi * 16 + (lane & 15);
        if (col < NZ) {
          uint2 o;
          o.x = pack2(acc[mi][ni][0], acc[mi][ni][1]);
          o.y = pack2(acc[mi][ni][2], acc[mi][ni][3]);
          *reinterpret_cast<uint2*>(Z + (size_t)row * ZS + col) = o;
        }
      }
  }
}

template <int J>
__device__ __forceinline__ void lora_mm(const float* sIn, const float* W, float (&a0)[16], float (&a1)[16], const int tid) {
#pragma unroll
  for (int i = 0; i < 16; ++i) { a0[i] = 0.f; a1[i] = 0.f; }
#pragma unroll 8
  for (int j = 0; j < J; ++j) {
    float w0 = W[j * 512 + tid], w1 = W[j * 512 + tid + 256];
    const float4* x4 = reinterpret_cast<const float4*>(sIn + j * 16);
#pragma unroll
    for (int q = 0; q < 4; ++q) {
      float4 x = x4[q];
      a0[q * 4 + 0] = fmaf(w0, x.x, a0[q * 4 + 0]); a1[q * 4 + 0] = fmaf(w1, x.x, a1[q * 4 + 0]);
      a0[q * 4 + 1] = fmaf(w0, x.y, a0[q * 4 + 1]); a1[q * 4 + 1] = fmaf(w1, x.y, a1[q * 4 + 1]);
      a0[q * 4 + 2] = fmaf(w0, x.z, a0[q * 4 + 2]); a1[q * 4 + 2] = fmaf(w1, x.z, a1[q * 4 + 2]);
      a0[q * 4 + 3] = fmaf(w0, x.w, a0[q * 4 + 3]); a1[q * 4 + 3] = fmaf(w1, x.w, a1[q * 4 + 3]);
    }
  }
}

__device__ __forceinline__ float rw_shift(const bf16_t* Z, int row, int s, int rc, float mu) {
  float cur = bf2f(Z[(size_t)row * ZS + ZRW + rc]);
  float prev = (s > 0) ? bf2f(Z[(size_t)(row - 1) * ZS + ZRW + rc]) : 0.f;
  return cur + (prev - cur) * mu;
}

__device__ void phase_rwprep(const Params& p, int l, char* smem) {
  const bf16_t* Z = (const bf16_t*)(p.ws + OFF_Z);
  bf16_t* LW = (bf16_t*)(p.ws + OFF_U);
  bf16_t* LA = LW + (size_t)T_TOK * 512;
  bf16_t* VF = (bf16_t*)(p.ws + OFF_VF);
  const char* lo = p.ws + OFF_LORA + (size_t)l * LORA_STRIDE;
  char* sXw = smem;
  char* sXa = smem + 2304;
  char* sZv = smem + 4608;
  float* sTmpF = reinterpret_cast<float*>(smem + 4608 + 16640);
  char* sTmp = smem + 4608 + 16640 + 4096;
  const float* mu = p.in[I_RW_MU] + l * 1792;
  const int tid = opaque_tid(), lane = tid & 63, w = tid >> 6;
  for (int t = blockIdx.x; t < T_TOK / 16; t += gridDim.x) {
    const int row0 = t * 16;
    for (int e = tid; e < 2048; e += 256) {
      int which = e >> 10, r = e & 1023, tok = r >> 6, j = r & 63;
      int row = row0 + tok, sq = row & (SEQ - 1);
      int rc = 1536 + which * 64 + j;
      float z = rw_shift(Z, row, sq, rc, mu[rc]);
      if (which == 0) *reinterpret_cast<bf16_t*>(sXw + tok * 144 + j * 2) = f2bf(ftanh(z));
      else *reinterpret_cast<bf16_t*>(sXa + tok * 144 + j * 2) = f2bf(z);
    }
    {
      float m0 = mu[1024 + tid], m1 = mu[1024 + tid + 256];
#pragma unroll 4
      for (int tok = 0; tok < 16; ++tok) {
        int row = row0 + tok, sq = row & (SEQ - 1);
        bf16_t z0 = f2bf(rw_shift(Z, row, sq, 1024 + tid, m0));
        bf16_t z1 = f2bf(rw_shift(Z, row, sq, 1024 + tid + 256, m1));
        *reinterpret_cast<bf16_t*>(sZv + tok * 1040 + tid * 2) = z0;
        *reinterpret_cast<bf16_t*>(sZv + tok * 1040 + (tid + 256) * 2) = z1;
        if (l == 0) {
          VF[(size_t)row * 512 + tid] = z0;
          VF[(size_t)row * 512 + tid + 256] = z1;
        }
      }
    }
    __syncthreads();
    f32x4 acc[8];
    lora_mfma<64>(sXw, 144, (const bf16_t*)(lo + LO_W2), acc, tid);
#pragma unroll
    for (int i = 0; i < 8; ++i)
#pragma unroll
      for (int jj = 0; jj < 4; ++jj)
        LW[(size_t)(row0 + (lane >> 4) * 4 + jj) * 512 + (w * 8 + i) * 16 + (lane & 15)] = f2bf(acc[i][jj]);
    lora_mfma<64>(sXa, 144, (const bf16_t*)(lo + LO_A2), acc, tid);
#pragma unroll
    for (int i = 0; i < 8; ++i)
#pragma unroll
      for (int jj = 0; jj < 4; ++jj)
        LA[(size_t)(row0 + (lane >> 4) * 4 + jj) * 512 + (w * 8 + i) * 16 + (lane & 15)] = f2bf(acc[i][jj]);
    if (l > 0) {
      {
        const bf16_t* v1t = (const bf16_t*)(lo + LO_V1);
        const int ntile = w & 1, kh = w >> 1;
        f32x4 tacc = f32x4{0.f, 0.f, 0.f, 0.f};
#pragma unroll
        for (int ks = 0; ks < 8; ++ks) {
          const int k0 = (kh * 8 + ks) * 32 + 8 * (lane >> 4);
          const bf16x8 a = *reinterpret_cast<const bf16x8*>(sZv + (lane & 15) * 1040 + k0 * 2);
          const bf16x8 b = *reinterpret_cast<const bf16x8*>(v1t + (size_t)(ntile * 16 + (lane & 15)) * 512 + k0);
          tacc = __builtin_amdgcn_mfma_f32_16x16x32_bf16(a, b, tacc, 0, 0, 0);
        }
#pragma unroll
        for (int jj = 0; jj < 4; ++jj)
          sTmpF[(kh * 16 + (lane >> 4) * 4 + jj) * 32 + ntile * 16 + (lane & 15)] = tacc[jj];
      }
      __syncthreads();
      for (int e = tid; e < 512; e += 256) {
        int tok = e >> 5, r = e & 31;
        *reinterpret_cast<bf16_t*>(sTmp + tok * 80 + r * 2) = f2bf(sTmpF[tok * 32 + r] + sTmpF[(16 + tok) * 32 + r]);
      }
      __syncthreads();
      lora_mfma<32>(sTmp, 80, (const bf16_t*)(lo + LO_V2), acc, tid);
      const float* v0 = p.in[I_RW_V0] + (size_t)(l - 1) * 512;
#pragma unroll
      for (int i = 0; i < 8; ++i) {
        const int ch = (w * 8 + i) * 16 + (lane & 15);
        const float b0 = v0[ch];
#pragma unroll
        for (int jj = 0; jj < 4; ++jj) {
          const int tok = (lane >> 4) * 4 + jj;
          const float zv = bf2f(*reinterpret_cast<const bf16_t*>(sZv + tok * 1040 + ch * 2));
          const size_t idx = (size_t)(row0 + tok) * 512 + ch;
          const float vf = bf2f(VF[idx]);
          VF[idx] = f2bf(zv + (vf - zv) * fsigmoid(b0 + acc[i][jj]));
        }
      }
    }
    __syncthreads();
  }
}

__device__ void hg_scan(const Params& p, int l, int task, char* smem) {
  const int b = task >> 3, h = (task >> 1) & 3, vg = task & 1;
  float* sFg = reinterpret_cast<float*>(smem);
  float* sQs = sFg + 16 * 128;
  float* sO = sQs + 16 * 128;
  float* sVv = sO + 4 * 16 * 64;
  const int tid = opaque_tid(), w = tid >> 6, lane = tid & 63;
  bf16_t* Z = (bf16_t*)(p.ws + OFF_Z) + (size_t)b * SEQ * ZS;
  const int ks = tid & 127;
  float lb = 0.f;
  if (l > 0) {
    float x0 = p.in[I_HG_LB][h * 128 + ks], x1 = p.in[I_HG_LB][512 + h * 128 + ks];
    float m = fmaxf(x0, x1), e0 = expf(x0 - m), e1 = expf(x1 - m);
    lb = e1 / (e0 + e1);
  }
  float s[32];
#pragma unroll
  for (int j = 0; j < 32; ++j) s[j] = 0.f;
  const int vcol = ZHG + 1024 + h * 128 + vg * 64;
  const int qcol = ZHG + h * 128 + ks;
  bf16_t rq0, rq1, rq2, rq3, rq4, rq5, rq6, rq7, rf0, rf1, rf2, rf3, rf4, rf5, rf6, rf7, rv0, rv1, rv2, rv3;
#define HG_LOAD(T0)                                                                                \
  {                                                                                                \
    const bf16_t* zb = Z + (size_t)((T0) + (tid >> 7)) * ZS + qcol;                                \
    rq0 = zb[0]; rf0 = zb[512]; zb += 2 * ZS; rq1 = zb[0]; rf1 = zb[512]; zb += 2 * ZS;            \
    rq2 = zb[0]; rf2 = zb[512]; zb += 2 * ZS; rq3 = zb[0]; rf3 = zb[512]; zb += 2 * ZS;            \
    rq4 = zb[0]; rf4 = zb[512]; zb += 2 * ZS; rq5 = zb[0]; rf5 = zb[512]; zb += 2 * ZS;            \
    rq6 = zb[0]; rf6 = zb[512]; zb += 2 * ZS; rq7 = zb[0]; rf7 = zb[512];                          \
    const bf16_t* zv = Z + (size_t)((T0) + w) * ZS + vcol + lane;                                  \
    rv0 = zv[0]; rv1 = zv[4 * ZS]; rv2 = zv[8 * ZS]; rv3 = zv[12 * ZS];                            \
  }
#define HG_PUT1(I, RQ, RF)                                                                         \
  {                                                                                                \
    int t = (tid >> 7) + 2 * (I);                                                                  \
    sFg[t * 128 + ks] = fmaxf(lb + (1.f - lb) * fsigmoid(bf2f(RF)), 1e-30f);                       \
    sQs[t * 128 + ks] = fsilu(bf2f(RQ));                                                           \
  }
#define HG_PROCESS()                                                                               \
  {                                                                                                \
    HG_PUT1(0, rq0, rf0) HG_PUT1(1, rq1, rf1) HG_PUT1(2, rq2, rf2) HG_PUT1(3, rq3, rf3)            \
    HG_PUT1(4, rq4, rf4) HG_PUT1(5, rq5, rf5) HG_PUT1(6, rq6, rf6) HG_PUT1(7, rq7, rf7)            \
    sVv[(w)*64 + lane] = bf2f(rv0); sVv[(w + 4) * 64 + lane] = bf2f(rv1);                          \
    sVv[(w + 8) * 64 + lane] = bf2f(rv2); sVv[(w + 12) * 64 + lane] = bf2f(rv3);                   \
  }
  HG_LOAD(0);
  HG_PROCESS();
  __syncthreads();
  constexpr int NCH = SEQ / 16;
#pragma unroll 1
  for (int c = 0; c < NCH; ++c) {
    const int t0 = c * 16;
    const int tn = (c + 1 < NCH) ? t0 + 16 : t0;
    HG_LOAD(tn);
    __builtin_amdgcn_sched_barrier(0);
#pragma unroll 2
    for (int t = 0; t < 16; ++t) {
      const float v = sVv[t * 64 + lane];
      const float opv = (lane < 32) ? sFg[t * 128 + w * 32 + lane] : sQs[t * 128 + w * 32 + (lane - 32)];
      const int opi = __builtin_bit_cast(int, opv);
      float o = 0.f;
#pragma unroll
      for (int j = 0; j < 32; ++j) {
        const float fg = __builtin_bit_cast(float, __builtin_amdgcn_readlane(opi, j));
        const float qq = __builtin_bit_cast(float, __builtin_amdgcn_readlane(opi, 32 + j));
        const float kv = fmaf(-fg, v, v);
        s[j] = fmaf(s[j], fg, kv);
        o = fmaf(qq, s[j], o);
      }
      sO[(w * 16 + t) * 64 + lane] = o;
    }
    __builtin_amdgcn_sched_barrier(0);
    __syncthreads();
    {
      int t = tid >> 4, v4 = (tid & 15) * 4;
      float4 a = *reinterpret_cast<const float4*>(sO + (0 * 16 + t) * 64 + v4);
      float4 bq = *reinterpret_cast<const float4*>(sO + (1 * 16 + t) * 64 + v4);
      float4 cq = *reinterpret_cast<const float4*>(sO + (2 * 16 + t) * 64 + v4);
      float4 d = *reinterpret_cast<const float4*>(sO + (3 * 16 + t) * 64 + v4);
      uint2 o;
      o.x = pack2(a.x + bq.x + cq.x + d.x, a.y + bq.y + cq.y + d.y);
      o.y = pack2(a.z + bq.z + cq.z + d.z, a.w + bq.w + cq.w + d.w);
      *reinterpret_cast<uint2*>(Z + (size_t)(t0 + t) * ZS + vcol + v4) = o;
    }
    HG_PROCESS();
    __syncthreads();
  }
#undef HG_LOAD
#undef HG_PUT1
#undef HG_PROCESS
}

__device__ void mb_scan(const Params& p, int l, int task, char* smem) {
  const int b = task >> 3, hd = task & 7, g = hd >> 2;
  float* sB = reinterpret_cast<float*>(smem);
  float* sC = sB + 16 * 128;
  float* sX = sC + 16 * 128;
  float* sDt = sX + 16 * 64;
  float* sDA = sDt + 16;
  float* sO = sDA + 16;
  const int tid = opaque_tid(), w = tid >> 6, lane = tid & 63;
  bf16_t* Z = (bf16_t*)(p.ws + OFF_Z) + (size_t)b * SEQ * ZS;
  const float* cw = p.in[I_MB_CONVW] + (size_t)l * 4 * 1024;
  const float* cb = p.in[I_MB_CONVB] + (size_t)l * 1024;
  int ci0, ci1;
  {
    int ch = tid;
    ci0 = (ch < 64) ? hd * 64 + ch : (ch < 192 ? 512 + g * 128 + (ch - 64) : 768 + g * 128 + (ch - 192));
    ci1 = 768 + g * 128 + 64 + (tid & 63);
  }
  float* dstA = (tid < 64) ? (sX + tid) : (tid < 192 ? (sB + (tid - 64)) : (sC + (tid - 192)));
  const int strideA = (tid < 64) ? 64 : 128;
  const float w0a = cw[ci0], w1a = cw[1024 + ci0], w2a = cw[2048 + ci0], w3a = cw[3072 + ci0], ba = cb[ci0];
  const float w0b = cw[ci1], w1b = cw[1024 + ci1], w2b = cw[2048 + ci1], w3b = cw[3072 + ci1], bb = cb[ci1];
  const float Aneg = -expf(p.in[I_MB_ALOG][l * 8 + hd]);
  const float dtb = p.in[I_MB_DTB][l * 8 + hd];
  const float Dsk = p.in[I_MB_D][l * 8 + hd];
  float s[32];
#pragma unroll
  for (int j = 0; j < 32; ++j) s[j] = 0.f;
  float pa1 = 0.f, pa2 = 0.f, pa3 = 0.f, pb1 = 0.f, pb2 = 0.f, pb3 = 0.f;
  const int xcol = ZMB + 512;
  const int rt = tid >> 4, rp4 = (tid & 15) * 4;
  bf16_t xa0, xa1, xa2, xa3, xa4, xa5, xa6, xa7, xa8, xa9, xa10, xa11, xa12, xa13, xa14, xa15;
  bf16_t xb0, xb1, xb2, xb3, xb4, xb5, xb6, xb7, xb8, xb9, xb10, xb11, xb12, xb13, xb14, xb15;
  bf16_t rdt;
  uint2 gcur, gnext;
#define MB_LOAD(T0)                                                                                 \
  {                                                                                                 \
    const bf16_t* za = Z + (size_t)(T0) * ZS + xcol + ci0;                                          \
    xa0 = za[0]; xa1 = za[ZS]; xa2 = za[2 * ZS]; xa3 = za[3 * ZS]; xa4 = za[4 * ZS]; xa5 = za[5 * ZS];        \
    xa6 = za[6 * ZS]; xa7 = za[7 * ZS]; xa8 = za[8 * ZS]; xa9 = za[9 * ZS]; xa10 = za[10 * ZS];     \
    xa11 = za[11 * ZS]; xa12 = za[12 * ZS]; xa13 = za[13 * ZS]; xa14 = za[14 * ZS]; xa15 = za[15 * ZS];       \
    if (tid < 64) {                                                                                 \
      const bf16_t* zb = Z + (size_t)(T0) * ZS + xcol + ci1;                                        \
      xb0 = zb[0]; xb1 = zb[ZS]; xb2 = zb[2 * ZS]; xb3 = zb[3 * ZS]; xb4 = zb[4 * ZS]; xb5 = zb[5 * ZS];      \
      xb6 = zb[6 * ZS]; xb7 = zb[7 * ZS]; xb8 = zb[8 * ZS]; xb9 = zb[9 * ZS]; xb10 = zb[10 * ZS];   \
      xb11 = zb[11 * ZS]; xb12 = zb[12 * ZS]; xb13 = zb[13 * ZS]; xb14 = zb[14 * ZS]; xb15 = zb[15 * ZS];     \
    }                                                                                               \
    rdt = Z[(size_t)((T0) + (tid & 15)) * ZS + ZMB + 1536 + hd];                                    \
    gnext = *reinterpret_cast<const uint2*>(Z + (size_t)((T0) + rt) * ZS + ZMB + hd * 64 + rp4);    \
  }
#define MB_CONV_A(T, XR)                                                                            \
  {                                                                                                 \
    float xv = bf2f(XR);                                                                            \
    dstA[(T)*strideA] = fsilu(ba + w0a * pa3 + w1a * pa2 + w2a * pa1 + w3a * xv);                   \
    pa3 = pa2; pa2 = pa1; pa1 = xv;                                                                 \
  }
#define MB_CONV_B(T, XR)                                                                            \
  {                                                                                                 \
    float xv = bf2f(XR);                                                                            \
    sC[(T)*128 + 64 + tid] = fsilu(bb + w0b * pb3 + w1b * pb2 + w2b * pb1 + w3b * xv);              \
    pb3 = pb2; pb2 = pb1; pb1 = xv;                                                                 \
  }
#define MB_PROCESS()                                                                                \
  {                                                                                                 \
    MB_CONV_A(0, xa0) MB_CONV_A(1, xa1) MB_CONV_A(2, xa2) MB_CONV_A(3, xa3) MB_CONV_A(4, xa4)       \
    MB_CONV_A(5, xa5) MB_CONV_A(6, xa6) MB_CONV_A(7, xa7) MB_CONV_A(8, xa8) MB_CONV_A(9, xa9)       \
    MB_CONV_A(10, xa10) MB_CONV_A(11, xa11) MB_CONV_A(12, xa12) MB_CONV_A(13, xa13)                 \
    MB_CONV_A(14, xa14) MB_CONV_A(15, xa15)                                                         \
    if (tid < 64) {                                                                                 \
      MB_CONV_B(0, xb0) MB_CONV_B(1, xb1) MB_CONV_B(2, xb2) MB_CONV_B(3, xb3) MB_CONV_B(4, xb4)     \
      MB_CONV_B(5, xb5) MB_CONV_B(6, xb6) MB_CONV_B(7, xb7) MB_CONV_B(8, xb8) MB_CONV_B(9, xb9)     \
      MB_CONV_B(10, xb10) MB_CONV_B(11, xb11) MB_CONV_B(12, xb12) MB_CONV_B(13, xb13)               \
      MB_CONV_B(14, xb14) MB_CONV_B(15, xb15)                                                       \
    }                                                                                               \
    if (tid < 16) {                                                                                 \
      float dt = fsoftplus(bf2f(rdt) + dtb);                                                        \
      sDt[tid] = dt;                                                                                \
      sDA[tid] = __expf(Aneg * dt);                                                                 \
    }                                                                                               \
    gcur = gnext;                                                                                   \
  }
  MB_LOAD(0);
  MB_PROCESS();
  __syncthreads();
  constexpr int NCH = SEQ / 16;
#pragma unroll 1
  for (int c = 0; c < NCH; ++c) {
    const int t0 = c * 16;
    const bool more = (c + 1 < NCH);
    const int tn = more ? t0 + 16 : t0;
    MB_LOAD(tn);
    __builtin_amdgcn_sched_barrier(0);
#pragma unroll 2
    for (int t = 0; t < 16; ++t) {
      const float dA = sDA[t];
      const float xdt = sX[t * 64 + lane] * sDt[t];
      const float opv = (lane < 32) ? sB[t * 128 + w * 32 + lane] : sC[t * 128 + w * 32 + (lane - 32)];
      const int opi = __builtin_bit_cast(int, opv);
      float y = 0.f;
#pragma unroll
      for (int j = 0; j < 32; ++j) {
        const float bn = __builtin_bit_cast(float, __builtin_amdgcn_readlane(opi, j));
        const float cn = __builtin_bit_cast(float, __builtin_amdgcn_readlane(opi, 32 + j));
        s[j] = fmaf(s[j], dA, bn * xdt);
        y = fmaf(cn, s[j], y);
      }
      sO[(w * 16 + t) * 64 + lane] = y;
    }
    __builtin_amdgcn_sched_barrier(0);
    __syncthreads();
    {
      float4 a = *reinterpret_cast<const float4*>(sO + (0 * 16 + rt) * 64 + rp4);
      float4 bq = *reinterpret_cast<const float4*>(sO + (1 * 16 + rt) * 64 + rp4);
      float4 cq = *reinterpret_cast<const float4*>(sO + (2 * 16 + rt) * 64 + rp4);
      float4 d = *reinterpret_cast<const float4*>(sO + (3 * 16 + rt) * 64 + rp4);
      float4 xs = *reinterpret_cast<const float4*>(sX + rt * 64 + rp4);
      bf16_t* gp = Z + (size_t)(t0 + rt) * ZS + ZMB + hd * 64 + rp4;
      float g0 = bf2f((bf16_t)(gcur.x & 0xffff)), g1 = bf2f((bf16_t)(gcur.x >> 16));
      float g2 = bf2f((bf16_t)(gcur.y & 0xffff)), g3 = bf2f((bf16_t)(gcur.y >> 16));
      float y0 = a.x + bq.x + cq.x + d.x + Dsk * xs.x;
      float y1 = a.y + bq.y + cq.y + d.y + Dsk * xs.y;
      float y2 = a.z + bq.z + cq.z + d.z + Dsk * xs.z;
      float y3 = a.w + bq.w + cq.w + d.w + Dsk * xs.w;
      uint2 o;
      o.x = pack2(y0 * fsilu(g0), y1 * fsilu(g1));
      o.y = pack2(y2 * fsilu(g2), y3 * fsilu(g3));
      *reinterpret_cast<uint2*>(gp) = o;
    }
    __syncthreads();
    if (more) MB_PROCESS();
    __syncthreads();
  }
#undef MB_LOAD
#undef MB_CONV_A
#undef MB_CONV_B
#undef MB_PROCESS
}

__device__ void s5_scan(const Params& p, int l, int task, char* smem) {
  const int tid = opaque_tid(), w = tid >> 6, lane = tid & 63;
  const int b = task >> 3, g = (task & 7) * 4 + w;
  char* base = smem + w * 6144;
  float* sU = reinterpret_cast<float*>(base);
  char* sHb = base + 1024;
  bf16_t* Z = (bf16_t*)(p.ws + OFF_Z) + (size_t)b * SEQ * ZS + ZS5 + g * 16;
  const int n = lane;
  float lr, li, bbr[16], bbi[16];
  bf16x8 Bf0, Bf1, Bf2, Bf3;
  {
    float dt = expf(p.in[I_S5_LOGDT][l * 32 + g]);
    float are = p.in[I_S5_ARE][(l * 32 + g) * 64 + n], aim = p.in[I_S5_AIM][(l * 32 + g) * 64 + n];
    float mag = expf(dt * are);
    lr = mag * cosf(dt * aim); li = mag * sinf(dt * aim);
    float den = are * are + aim * aim;
    float cr = ((lr - 1.f) * are + li * aim) / den;
    float ci = (li * are - (lr - 1.f) * aim) / den;
    const float* bre = p.in[I_S5_BRE] + ((size_t)(l * 32 + g) * 64 + n) * 16;
    const float* bim = p.in[I_S5_BIM] + ((size_t)(l * 32 + g) * 64 + n) * 16;
#pragma unroll
    for (int c = 0; c < 16; ++c) {
      float br = bre[c], bi = bim[c];
      bbr[c] = cr * br - ci * bi;
      bbi[c] = cr * bi + ci * br;
    }
    const float* cre = p.in[I_S5_CRE] + (size_t)(l * 32 + g) * 16 * 64 + (lane & 15) * 64;
    const float* cim = p.in[I_S5_CIM] + (size_t)(l * 32 + g) * 16 * 64 + (lane & 15) * 64;
#pragma unroll
    for (int j = 0; j < 8; ++j) {
      const int kb = 8 * (lane >> 4) + j;
      const int n0 = kb >> 1;
      const bool im = (j & 1);
      Bf0[j] = (short)f2bf(im ? -cim[n0] : cre[n0]);
      Bf1[j] = (short)f2bf(im ? -cim[n0 + 16] : cre[n0 + 16]);
      Bf2[j] = (short)f2bf(im ? -cim[n0 + 32] : cre[n0 + 32]);
      Bf3[j] = (short)f2bf(im ? -cim[n0 + 48] : cre[n0 + 48]);
    }
  }
  const float dsk = p.in[I_S5_D][l * 512 + g * 16 + (lane & 15)];
  const int pt = lane >> 2, pc4 = (lane & 3) * 4;
  float hr = 0.f, hi = 0.f;
  uint2 unext = *reinterpret_cast<const uint2*>(Z + (size_t)pt * ZS + pc4);
  constexpr int NCH = SEQ / 16;
#pragma unroll 1
  for (int c = 0; c < NCH; ++c) {
    const int t0 = c * 16;
    {
      const uint2 ur = unext;
      *reinterpret_cast<float4*>(sU + pt * 16 + pc4) =
          float4{bf2f((bf16_t)(ur.x & 0xffff)), bf2f((bf16_t)(ur.x >> 16)), bf2f((bf16_t)(ur.y & 0xffff)), bf2f((bf16_t)(ur.y >> 16))};
      const int tn = (c + 1 < NCH) ? t0 + 16 : t0;
      unext = *reinterpret_cast<const uint2*>(Z + (size_t)(tn + pt) * ZS + pc4);
    }
    __builtin_amdgcn_sched_barrier(0);
    __syncthreads();
#pragma unroll 2
    for (int t = 0; t < 16; ++t) {
      const float4* u4 = reinterpret_cast<const float4*>(sU + t * 16);
      float bur = 0.f, bui = 0.f;
#pragma unroll
      for (int q = 0; q < 4; ++q) {
        float4 u = u4[q];
        bur = fmaf(bbr[q * 4 + 0], u.x, bur); bui = fmaf(bbi[q * 4 + 0], u.x, bui);
        bur = fmaf(bbr[q * 4 + 1], u.y, bur); bui = fmaf(bbi[q * 4 + 1], u.y, bui);
        bur = fmaf(bbr[q * 4 + 2], u.z, bur); bui = fmaf(bbi[q * 4 + 2], u.z, bui);
        bur = fmaf(bbr[q * 4 + 3], u.w, bur); bui = fmaf(bbi[q * 4 + 3], u.w, bui);
      }
      float nr = lr * hr - li * hi + bur;
      float ni = lr * hi + li * hr + bui;
      hr = nr; hi = ni;
      *reinterpret_cast<unsigned*>(sHb + t * 272 + n * 4) = pack2(hr, hi);
    }
    __syncthreads();
    {
      f32x4 acc = f32x4{0.f, 0.f, 0.f, 0.f};
      const char* ap = sHb + (lane & 15) * 272 + (lane >> 4) * 16;
      acc = __builtin_amdgcn_mfma_f32_16x16x32_bf16(*reinterpret_cast<const bf16x8*>(ap), Bf0, acc, 0, 0, 0);
      acc = __builtin_amdgcn_mfma_f32_16x16x32_bf16(*reinterpret_cast<const bf16x8*>(ap + 64), Bf1, acc, 0, 0, 0);
      acc = __builtin_amdgcn_mfma_f32_16x16x32_bf16(*reinterpret_cast<const bf16x8*>(ap + 128), Bf2, acc, 0, 0, 0);
      acc = __builtin_amdgcn_mfma_f32_16x16x32_bf16(*reinterpret_cast<const bf16x8*>(ap + 192), Bf3, acc, 0, 0, 0);
      const int cc = lane & 15, tb = (lane >> 4) * 4;
#pragma unroll
      for (int jj = 0; jj < 4; ++jj) {
        float y = acc[jj] + dsk * sU[(tb + jj) * 16 + cc];
        Z[(size_t)(t0 + tb + jj) * ZS + cc] = f2bf(fgelu(y));
      }
    }
    __syncthreads();
  }
}

__device__ void rw_scan(const Params& p, int l, int task, char* smem) {
  const int b = task >> 3, h = task & 7;
  float* sR = reinterpret_cast<float*>(smem);
  float* sW = sR + 1024;
  float* sK = sW + 1024;
  float* sA = sK + 1024;
  float* sBb = sA + 1024;
  float* sV = sBb + 1024;
  float* sY = sV + 1024;
  float* sBonus = sY + 1024;
  const int tid = opaque_tid(), w = tid >> 6, lane = tid & 63;
  const size_t tokbase = (size_t)b * SEQ;
  bf16_t* Z = (bf16_t*)(p.ws + OFF_Z) + tokbase * ZS;
  const bf16_t* LW = (const bf16_t*)(p.ws + OFF_U) + tokbase * 512;
  const bf16_t* LA = LW + (size_t)T_TOK * 512;
  const bf16_t* VF = (const bf16_t*)(p.ws + OFF_VF) + tokbase * 512;
  const int st = tid >> 4, c4 = (tid & 15) * 4, ch = h * 64 + c4;
  float mur[4], muk[4], w0[4], a0[4], kk_[4], ka_[4], rk_[4], lnw[4], lnb[4];
#pragma unroll
  for (int e = 0; e < 4; ++e) {
    mur[e] = p.in[I_RW_MU][l * 1792 + ch + e];
    muk[e] = p.in[I_RW_MU][l * 1792 + 512 + ch + e];
    w0[e] = p.in[I_RW_W0][l * 512 + ch + e];
    a0[e] = p.in[I_RW_A0][l * 512 + ch + e];
    kk_[e] = p.in[I_RW_KK][l * 512 + ch + e];
    ka_[e] = p.in[I_RW_KA][l * 512 + ch + e];
    rk_[e] = p.in[I_RW_RK][l * 512 + ch + e];
    lnw[e] = p.in[I_RW_LNW][l * 512 + ch + e];
    lnb[e] = p.in[I_RW_LNB][l * 512 + ch + e];
  }
  const int rg = lane >> 3, kq = lane & 7, vrow = w * 16 + rg * 2;
  float S0[8], S1[8];
#pragma unroll
  for (int j = 0; j < 8; ++j) { S0[j] = 0.f; S1[j] = 0.f; }
  uint2 rc, kc, rp, kp, lwv, lav, vfv;
#define RW_LOAD(T0)                                                                                 \
  {                                                                                                 \
    const int s_ = (T0) + st;                                                                       \
    const bf16_t* zr = Z + (size_t)s_ * ZS + ZRW + ch;                                              \
    rc = *reinterpret_cast<const uint2*>(zr);                                                       \
    kc = *reinterpret_cast<const uint2*>(zr + 512);                                                 \
    rp = uint2{0u, 0u}; kp = uint2{0u, 0u};                                                         \
    if (s_ > 0) { rp = *reinterpret_cast<const uint2*>(zr - ZS); kp = *reinterpret_cast<const uint2*>(zr - ZS + 512); } \
    lwv = *reinterpret_cast<const uint2*>(LW + (size_t)s_ * 512 + ch);                              \
    lav = *reinterpret_cast<const uint2*>(LA + (size_t)s_ * 512 + ch);                              \
    vfv = *reinterpret_cast<const uint2*>(VF + (size_t)s_ * 512 + ch);                              \
  }
#define RW_PROCESS()                                                                                \
  {                                                                                                 \
    float r4[4], k4[4], kkv[4], av[4], wv[4], vv[4];                                                \
    float n2 = 0.f;                                                                                 \
    _Pragma("unroll") for (int e = 0; e < 4; ++e) {                                                 \
      unsigned rcw = (e < 2) ? rc.x : rc.y, kcw = (e < 2) ? kc.x : kc.y, rpw = (e < 2) ? rp.x : rp.y, kpw = (e < 2) ? kp.x : kp.y; \
      unsigned lww = (e < 2) ? lwv.x : lwv.y, law = (e < 2) ? lav.x : lav.y, vfw = (e < 2) ? vfv.x : vfv.y; \
      int sh = (e & 1) * 16;                                                                        \
      float rcur = bf2f((bf16_t)((rcw >> sh) & 0xffff)), rprev = bf2f((bf16_t)((rpw >> sh) & 0xffff)); \
      float kcur = bf2f((bf16_t)((kcw >> sh) & 0xffff)), kprev = bf2f((bf16_t)((kpw >> sh) & 0xffff)); \
      float lwf = bf2f((bf16_t)((lww >> sh) & 0xffff)), laf = bf2f((bf16_t)((law >> sh) & 0xffff)); \
      vv[e] = bf2f((bf16_t)((vfw >> sh) & 0xffff));                                                 \
      r4[e] = rcur + (rprev - rcur) * mur[e];                                                       \
      k4[e] = kcur + (kprev - kcur) * muk[e];                                                       \
      float wlog = -fsoftplus(-(w0[e] + lwf)) - 0.5f;                                               \
      wv[e] = __expf(-__expf(wlog));                                                                \
      av[e] = fsigmoid(a0[e] + laf);                                                                \
      kkv[e] = k4[e] * kk_[e];                                                                      \
      n2 += kkv[e] * kkv[e];                                                                        \
    }                                                                                               \
    n2 = sum16(n2);                                                                                 \
    float inv = 1.f / fmaxf(sqrtf(n2), 1e-12f);                                                     \
    float bon = 0.f;                                                                                \
    float kt4[4], ap4[4], bp4[4];                                                                   \
    _Pragma("unroll") for (int e = 0; e < 4; ++e) {                                                 \
      float kkn = kkv[e] * inv;                                                                     \
      kt4[e] = k4[e] * (1.f + (av[e] - 1.f) * ka_[e]);                                              \
      ap4[e] = -kkn;                                                                                \
      bp4[e] = kkn * av[e];                                                                         \
      bon += r4[e] * kt4[e] * rk_[e];                                                               \
    }                                                                                               \
    bon = sum16(bon);                                                                               \
    *reinterpret_cast<float4*>(sR + st * 64 + c4) = float4{r4[0], r4[1], r4[2], r4[3]};             \
    *reinterpret_cast<float4*>(sW + st * 64 + c4) = float4{wv[0], wv[1], wv[2], wv[3]};             \
    *reinterpret_cast<float4*>(sK + st * 64 + c4) = float4{kt4[0], kt4[1], kt4[2], kt4[3]};         \
    *reinterpret_cast<float4*>(sA + st * 64 + c4) = float4{ap4[0], ap4[1], ap4[2], ap4[3]};         \
    *reinterpret_cast<float4*>(sBb + st * 64 + c4) = float4{bp4[0], bp4[1], bp4[2], bp4[3]};        \
    *reinterpret_cast<float4*>(sV + st * 64 + c4) = float4{vv[0], vv[1], vv[2], vv[3]};             \
    if ((tid & 15) == 0) sBonus[st] = bon;                                                          \
  }
  RW_LOAD(0);
  RW_PROCESS();
  __syncthreads();
  constexpr int NCH = SEQ / 16;
#pragma unroll 1
  for (int c = 0; c < NCH; ++c) {
    const int t0 = c * 16;
    const int tn = (c + 1 < NCH) ? t0 + 16 : t0;
    RW_LOAD(tn);
    __builtin_amdgcn_sched_barrier(0);
#pragma unroll 2
    for (int t = 0; t < 16; ++t) {
      const float4* a4p = reinterpret_cast<const float4*>(sA + t * 64 + kq * 8);
      const float4* w4p = reinterpret_cast<const float4*>(sW + t * 64 + kq * 8);
      const float4* b4p = reinterpret_cast<const float4*>(sBb + t * 64 + kq * 8);
      const float4* k4p = reinterpret_cast<const float4*>(sK + t * 64 + kq * 8);
      const float4* r4p = reinterpret_cast<const float4*>(sR + t * 64 + kq * 8);
      const float2 vv = *reinterpret_cast<const float2*>(sV + t * 64 + vrow);
      float sa0 = 0.f, sa1 = 0.f;
#pragma unroll
      for (int q = 0; q < 2; ++q) {
        float4 a = a4p[q];
        sa0 = fmaf(S0[q * 4 + 0], a.x, sa0); sa1 = fmaf(S1[q * 4 + 0], a.x, sa1);
        sa0 = fmaf(S0[q * 4 + 1], a.y, sa0); sa1 = fmaf(S1[q * 4 + 1], a.y, sa1);
        sa0 = fmaf(S0[q * 4 + 2], a.z, sa0); sa1 = fmaf(S1[q * 4 + 2], a.z, sa1);
        sa0 = fmaf(S0[q * 4 + 3], a.w, sa0); sa1 = fmaf(S1[q * 4 + 3], a.w, sa1);
      }
      sa0 = oct_sum(sa0); sa1 = oct_sum(sa1);
      float y0 = 0.f, y1 = 0.f;
#pragma unroll
      for (int q = 0; q < 2; ++q) {
        float4 ww = w4p[q], bb = b4p[q], kk = k4p[q], rr = r4p[q];
        S0[q * 4 + 0] = fmaf(S0[q * 4 + 0], ww.x, fmaf(sa0, bb.x, vv.x * kk.x)); y0 = fmaf(S0[q * 4 + 0], rr.x, y0);
        S1[q * 4 + 0] = fmaf(S1[q * 4 + 0], ww.x, fmaf(sa1, bb.x, vv.y * kk.x)); y1 = fmaf(S1[q * 4 + 0], rr.x, y1);
        S0[q * 4 + 1] = fmaf(S0[q * 4 + 1], ww.y, fmaf(sa0, bb.y, vv.x * kk.y)); y0 = fmaf(S0[q * 4 + 1], rr.y, y0);
        S1[q * 4 + 1] = fmaf(S1[q * 4 + 1], ww.y, fmaf(sa1, bb.y, vv.y * kk.y)); y1 = fmaf(S1[q * 4 + 1], rr.y, y1);
        S0[q * 4 + 2] = fmaf(S0[q * 4 + 2], ww.z, fmaf(sa0, bb.z, vv.x * kk.z)); y0 = fmaf(S0[q * 4 + 2], rr.z, y0);
        S1[q * 4 + 2] = fmaf(S1[q * 4 + 2], ww.z, fmaf(sa1, bb.z, vv.y * kk.z)); y1 = fmaf(S1[q * 4 + 2], rr.z, y1);
        S0[q * 4 + 3] = fmaf(S0[q * 4 + 3], ww.w, fmaf(sa0, bb.w, vv.x * kk.w)); y0 = fmaf(S0[q * 4 + 3], rr.w, y0);
        S1[q * 4 + 3] = fmaf(S1[q * 4 + 3], ww.w, fmaf(sa1, bb.w, vv.y * kk.w)); y1 = fmaf(S1[q * 4 + 3], rr.w, y1);
      }
      y0 = oct_sum(y0); y1 = oct_sum(y1);
      if (kq == 0) *reinterpret_cast<float2*>(sY + t * 64 + vrow) = float2{y0, y1};
    }
    __builtin_amdgcn_sched_barrier(0);
    __syncthreads();
    {
      float4 y4 = *reinterpret_cast<const float4*>(sY + st * 64 + c4);
      float4 v4 = *reinterpret_cast<const float4*>(sV + st * 64 + c4);
      float bon = sBonus[st];
      float mean = sum16(y4.x + y4.y + y4.z + y4.w) * (1.f / 64.f);
      float dx = y4.x - mean, dy = y4.y - mean, dz = y4.z - mean, dw = y4.w - mean;
      float var = sum16(dx * dx + dy * dy + dz * dz + dw * dw) * (1.f / 64.f);
      float rs = rsqrtf(var + 64e-5f);
      float o0 = dx * rs * lnw[0] + lnb[0] + bon * v4.x;
      float o1 = dy * rs * lnw[1] + lnb[1] + bon * v4.y;
      float o2 = dz * rs * lnw[2] + lnb[2] + bon * v4.z;
      float o3 = dw * rs * lnw[3] + lnb[3] + bon * v4.w;
      uint2 o;
      o.x = pack2(o0, o1); o.y = pack2(o2, o3);
      *reinterpret_cast<uint2*>(Z + (size_t)(t0 + st) * ZS + ZRW + 1024 + ch) = o;
    }
    RW_PROCESS();
    __syncthreads();
  }
#undef RW_LOAD
#undef RW_PROCESS
}

__device__ void phase_scans(const Params& p, int l, char* smem, int scan_mask = 15) {
  for (int t = blockIdx.x; t < 256; t += gridDim.x) {
    int type = t & 3, idx = t >> 2;
    if (!((scan_mask >> type) & 1)) continue;
#ifndef SCM
#define SCM 15
#endif
    if (type == 0) { if (SCM & 1) rw_scan(p, l, idx, smem); }
    else if (type == 1) { if (SCM & 2) hg_scan(p, l, idx, smem); }
    else if (type == 2) { if (SCM & 4) mb_scan(p, l, idx, smem); }
    else { if (SCM & 8) s5_scan(p, l, idx, smem); }
    __syncthreads();
  }
  if (l == 0) {
    const int tid = opaque_tid();
    const int nb = (gridDim.x > 256) ? (int)gridDim.x - 256 : (int)gridDim.x;
    const int b0 = (gridDim.x > 256) ? (int)blockIdx.x - 256 : (int)blockIdx.x;
    constexpr int NREST = CT_TOTAL - (CT_IN - 1024);
    if (b0 >= 0)
      for (int c = b0; c < NREST + CT_TOTAL; c += nb) {
        if (c < NREST) convert_one(p, 0, (c < 1024) ? c : c + (CT_IN - 1024), smem, tid);
        else convert_one(p, 1, c - NREST, smem, tid);
      }
  }
}

__device__ __forceinline__ void unpack8(const uint4& v, float (&f)[8]) {
  f[0] = bf2f((bf16_t)(v.x & 0xffff)); f[1] = bf2f((bf16_t)(v.x >> 16));
  f[2] = bf2f((bf16_t)(v.y & 0xffff)); f[3] = bf2f((bf16_t)(v.y >> 16));
  f[4] = bf2f((bf16_t)(v.z & 0xffff)); f[5] = bf2f((bf16_t)(v.z >> 16));
  f[6] = bf2f((bf16_t)(v.w & 0xffff)); f[7] = bf2f((bf16_t)(v.w >> 16));
}

__device__ void phase_post(const Params& p, int l, char* smem) {
  bf16_t* Z = (bf16_t*)(p.ws + OFF_Z);
  const int tid = opaque_tid(), lane = tid & 63, wid = tid >> 6;
  constexpr int N_ROWT = T_TOK / 4, N_RWT = T_TOK / 16, N_GLU = 128 * 4, N_NORM = T_TOK / 4;
  const float* xsrc = (l == 0) ? p.in[I_X] : p.out;
  for (int t = blockIdx.x; t < N_ROWT + N_RWT + N_GLU + N_NORM; t += gridDim.x) {
    if (t < N_ROWT) {
      const int row = t * 4 + wid;
      {
        bf16_t* op = Z + (size_t)row * ZS + ZHG + 1024 + lane * 8;
        uint4 ov = *reinterpret_cast<const uint4*>(op);
        uint4 gv = *reinterpret_cast<const uint4*>(op + 512);
        float o[8], g[8];
        unpack8(ov, o); unpack8(gv, g);
        float ss = 0.f;
#pragma unroll
        for (int e = 0; e < 8; ++e) ss += o[e] * o[e];
        ss = sum16(ss);
        float rstd = rsqrtf(ss * (1.f / 128.f) + 1e-6f);
        const float* nw = p.in[I_HG_NW] + l * 512 + lane * 8;
        float r[8];
#pragma unroll
        for (int e = 0; e < 8; ++e) r[e] = o[e] * rstd * nw[e] * siluf_(g[e]);
        *reinterpret_cast<uint4*>(op) = uint4{pack2(r[0], r[1]), pack2(r[2], r[3]), pack2(r[4], r[5]), pack2(r[6], r[7])};
      }
      {
        bf16_t* op = Z + (size_t)row * ZS + ZMB + lane * 8;
        uint4 ov = *reinterpret_cast<const uint4*>(op);
        float o[8];
        unpack8(ov, o);
        float ss = 0.f;
#pragma unroll
        for (int e = 0; e < 8; ++e) ss += o[e] * o[e];
        ss = sum64(ss);
        float rstd = rsqrtf(ss * (1.f / 512.f) + 1e-6f);
        const float* nw = p.in[I_MB_NW] + l * 512 + lane * 8;
        float r[8];
#pragma unroll
        for (int e = 0; e < 8; ++e) r[e] = o[e] * rstd * nw[e];
        *reinterpret_cast<uint4*>(op) = uint4{pack2(r[0], r[1]), pack2(r[2], r[3]), pack2(r[4], r[5]), pack2(r[6], r[7])};
      }
    } else if (t < N_ROWT + N_RWT) {
      const int row0 = (t - N_ROWT) * 16;
      char* sXg = smem;
      const float* mu = p.in[I_RW_MU] + l * 1792 + 1664;
      for (int e = tid; e < 2048; e += 256) {
        int tok = e >> 7, j = e & 127;
        int row = row0 + tok, sq = row & (SEQ - 1);
        *reinterpret_cast<bf16_t*>(sXg + tok * 272 + j * 2) = f2bf(fsigmoid(rw_shift(Z, row, sq, 1664 + j, mu[j])));
      }
      __syncthreads();
      f32x4 acc[8];
      lora_mfma<128>(sXg, 272, (const bf16_t*)(p.ws + OFF_LORA + (size_t)l * LORA_STRIDE + LO_G2), acc, tid);
#pragma unroll
      for (int i = 0; i < 8; ++i)
#pragma unroll
        for (int jj = 0; jj < 4; ++jj) {
          bf16_t* yp = Z + (size_t)(row0 + (lane >> 4) * 4 + jj) * ZS + ZRW + 1024 + (wid * 8 + i) * 16 + (lane & 15);
          *yp = f2bf(bf2f(*yp) * acc[i][jj]);
        }
      __syncthreads();
    } else if (t < N_ROWT + N_RWT + N_GLU) {
      const int tt = t - N_ROWT - N_RWT, mt = tt >> 2, nt = tt & 3;
      const int wm = wid >> 1, wn = wid & 1;
      f32x4 acc[4][4];
      zero_acc<128>(acc);
      gemm_mainloop<128>(acc, Z + ZS5, ZS, mt * 128, (const bf16_t*)(p.ws + WOFF(OFF_WTGLU, l)), 512, nt * 128, 511, 512, smem, tid);
      const float* bg = p.in[I_S5_BGLU] + l * 512;
#pragma unroll
      for (int mi = 0; mi < 4; ++mi)
#pragma unroll
        for (int ni = 0; ni < 4; ++ni) {
          int col = nt * 128 + wn * 64 + ni * 16 + (lane >> 4) * 4;
          int row = mt * 128 + wm * 64 + mi * 16 + (lane & 15);
          float4 b4 = *reinterpret_cast<const float4*>(bg + col);
          uint2 yv = *reinterpret_cast<const uint2*>(Z + (size_t)row * ZS + ZS5 + col);
          float y0 = bf2f((bf16_t)(yv.x & 0xffff)), y1 = bf2f((bf16_t)(yv.x >> 16));
          float y2 = bf2f((bf16_t)(yv.y & 0xffff)), y3 = bf2f((bf16_t)(yv.y >> 16));
          uint2 o;
          o.x = pack2(y0 * sigmoidf_(acc[mi][ni][0] + b4.x), y1 * sigmoidf_(acc[mi][ni][1] + b4.y));
          o.y = pack2(y2 * sigmoidf_(acc[mi][ni][2] + b4.z), y3 * sigmoidf_(acc[mi][ni][3] + b4.w));
          *reinterpret_cast<uint2*>(Z + (size_t)row * ZS + ZMB + 1024 + col) = o;
        }
    } else {
      const int row = (t - N_ROWT - N_RWT - N_GLU) * 4 + wid;
      rmsnorm_row_to_bf16(xsrc + (size_t)row * DM, p.in[I_NORM_MIX] + l * DM, (bf16_t*)(p.ws + OFF_U) + (size_t)row * DM, tid & 63);
    }
  }
}

__device__ void phase_merge(const Params& p, int l, char* smem) {
  bf16_t* Z = (bf16_t*)(p.ws + OFF_Z);
  const bf16_t* U = (const bf16_t*)(p.ws + OFF_U);
  const bf16_t* Wg = (const bf16_t*)(p.ws + WOFF_GATE(l));
  const bf16_t* Wb = (const bf16_t*)(p.ws + WOFF(OFF_WTBR, l));
  const int tid = opaque_tid();
  const int lane = tid & 63, wid = tid >> 6, wm = wid >> 1, wn = wid & 1;
  for (int t = blockIdx.x; t < tile_count(128, 8); t += gridDim.x) {
    int mt, nt;
    if (!tile_map(t, 8, mt, nt)) continue;
    f32x4 accm[4][4];
    zero_acc<128>(accm);
    f32x4 a1[4][4];
    zero_acc<128>(a1);
    uint2 sg[4][4];
#pragma unroll
    for (int mi = 0; mi < 4; ++mi)
#pragma unroll
      for (int ni = 0; ni < 4; ++ni) sg[mi][ni] = uint2{0u, 0u};
#pragma unroll 1
    for (int sub = 0; sub < 8; ++sub) {
      const int kb = sub >> 1, which = sub & 1;
      const int ycol = (kb == 0) ? (ZHG + 1024) : (kb == 1) ? (ZRW + 1024) : (kb == 2) ? (ZMB + 1024) : ZMB;
      const bf16_t* Ap = which ? (const bf16_t*)(Z + ycol) : U;
      const int ldap = which ? ZS : 1024;
      const bf16_t* Bp = which ? (Wb + (size_t)kb * 1024 * 512) : (Wg + (size_t)kb * 1024 * 1024);
      const int Kp = which ? 512 : 1024;
      gemm_mainloop_glds<128>(a1, Ap, ldap, mt * 128, Bp, Kp, nt * 128, 1023, Kp, smem, tid);
      if (which == 0) {
#pragma unroll
        for (int mi = 0; mi < 4; ++mi)
#pragma unroll
          for (int ni = 0; ni < 4; ++ni) {
            sg[mi][ni].x = pack2(fsigmoid(a1[mi][ni][0]), fsigmoid(a1[mi][ni][1]));
            sg[mi][ni].y = pack2(fsigmoid(a1[mi][ni][2]), fsigmoid(a1[mi][ni][3]));
            a1[mi][ni] = f32x4{0.f, 0.f, 0.f, 0.f};
          }
      } else {
#pragma unroll
        for (int mi = 0; mi < 4; ++mi)
#pragma unroll
          for (int ni = 0; ni < 4; ++ni) {
            accm[mi][ni][0] = fmaf(bf2f((bf16_t)(sg[mi][ni].x & 0xffff)), a1[mi][ni][0], accm[mi][ni][0]);
            accm[mi][ni][1] = fmaf(bf2f((bf16_t)(sg[mi][ni].x >> 16)), a1[mi][ni][1], accm[mi][ni][1]);
            accm[mi][ni][2] = fmaf(bf2f((bf16_t)(sg[mi][ni].y & 0xffff)), a1[mi][ni][2], accm[mi][ni][2]);
            accm[mi][ni][3] = fmaf(bf2f((bf16_t)(sg[mi][ni].y >> 16)), a1[mi][ni][3], accm[mi][ni][3]);
            a1[mi][ni] = f32x4{0.f, 0.f, 0.f, 0.f};
          }
      }
    }
#pragma unroll
    for (int mi = 0; mi < 4; ++mi)
#pragma unroll
      for (int ni = 0; ni < 4; ++ni) {
        int col = nt * 128 + wn * 64 + ni * 16 + (lane >> 4) * 4;
        int row = mt * 128 + wm * 64 + mi * 16 + (lane & 15);
        uint2 o;
        o.x = pack2(accm[mi][ni][0], accm[mi][ni][1]);
        o.y = pack2(accm[mi][ni][2], accm[mi][ni][3]);
        *reinterpret_cast<uint2*>(Z + (size_t)row * ZS + col) = o;
      }
  }
}

__device__ void phase_resid_gemm(const Params& p, const bf16_t* A, int lda, const bf16_t* Wt, int K, const float* xold, char* smem) {
  const int tid = opaque_tid();
  const int lane = tid & 63, wid = tid >> 6, wm = wid >> 1, wn = wid & 1;
  for (int t = blockIdx.x; t < tile_count(64, 8); t += gridDim.x) {
    int mt, nt;
    if (!tile_map(t, 8, mt, nt)) continue;
    f32x4 acc[8][4];
    zero_acc_big(acc);
    gemm_mainloop_big(acc, A, lda, mt * 256, Wt, K, nt * 128, 1023, K, smem, tid);
#pragma unroll
    for (int mi = 0; mi < 8; ++mi)
#pragma unroll
      for (int ni = 0; ni < 4; ++ni) {
        int col = nt * 128 + wn * 64 + ni * 16 + (lane >> 4) * 4;
        int row = mt * 256 + wm * 128 + mi * 16 + (lane & 15);
        size_t o = (size_t)row * DM + col;
        float4 xo = *reinterpret_cast<const float4*>(xold + o);
        float4 r = float4{xo.x + acc[mi][ni][0], xo.y + acc[mi][ni][1], xo.z + acc[mi][ni][2], xo.w + acc[mi][ni][3]};
        *reinterpret_cast<float4*>(p.out + o) = r;
      }
  }
}

__device__ void phase_ffn_in(const Params& p, int l, char* smem) {
  const bf16_t* U = (const bf16_t*)(p.ws + OFF_U);
  const bf16_t* Wt = (const bf16_t*)(p.ws + WOFF(OFF_WTF1, l));
  bf16_t* H = (bf16_t*)(p.ws + OFF_Z);
  const int tid = opaque_tid();
  const int lane = tid & 63, wid = tid >> 6, wm = wid >> 1, wn = wid & 1;
  for (int t = blockIdx.x; t < tile_count(64, 44); t += gridDim.x) {
    int mt, nt;
    if (!tile_map(t, 44, mt, nt)) continue;
    f32x4 acc[8][4];
    zero_acc_big(acc);
    gemm_mainloop_big(acc, U, 1024, mt * 256, Wt, 1024, nt * 128, 5631, 1024, smem, tid);
#pragma unroll
    for (int mi = 0; mi < 8; ++mi)
#pragma unroll
      for (int q = 0; q < 2; ++q) {
        int hcol = ((nt * 128 + wn * 64 + q * 32) >> 1) + (lane >> 4) * 4;
        int row = mt * 256 + wm * 128 + mi * 16 + (lane & 15);
        uint2 o;
        o.x = pack2(fsilu(acc[mi][2 * q][0]) * acc[mi][2 * q + 1][0], fsilu(acc[mi][2 * q][1]) * acc[mi][2 * q + 1][1]);
        o.y = pack2(fsilu(acc[mi][2 * q][2]) * acc[mi][2 * q + 1][2], fsilu(acc[mi][2 * q][3]) * acc[mi][2 * q + 1][3]);
        *reinterpret_cast<uint2*>(H + (size_t)row * FFH + hcol) = o;
      }
  }
}

__device__ void phase_final(const Params& p) {
  const int tid = opaque_tid();
  const int lane = tid & 63;
  const float* w = p.in[I_NORM_FINAL];
  for (int t = blockIdx.x; t < T_TOK / 4; t += gridDim.x) {
    int row = t * 4 + (tid >> 6);
    float* x = p.out + (size_t)row * DM;
    float4 v[4];
    float ss = 0.f;
#pragma unroll
    for (int i = 0; i < 4; ++i) {
      v[i] = *reinterpret_cast<const float4*>(x + i * 256 + lane * 4);
      ss += v[i].x * v[i].x + v[i].y * v[i].y + v[i].z * v[i].z + v[i].w * v[i].w;
    }
    ss = sum64(ss);
    float rstd = rsqrtf(ss * (1.f / 1024.f) + 1e-6f);
#pragma unroll
    for (int i = 0; i < 4; ++i) {
      float4 ww = *reinterpret_cast<const float4*>(w + i * 256 + lane * 4);
      float4 o = float4{v[i].x * rstd * ww.x, v[i].y * rstd * ww.y, v[i].z * rstd * ww.z, v[i].w * rstd * ww.w};
      *reinterpret_cast<float4*>(x + i * 256 + lane * 4) = o;
    }
  }
}

template <int SUB>
__device__ __forceinline__ void run_phase(const Params& p, int l, char* smem) {
  if (SUB == 0) phase_convert_norm(p, l, smem);
  else if (SUB == 1) phase_inproj(p, smem);
  else if (SUB == 2) phase_rwprep(p, l, smem);
  else if (SUB == 3) phase_scans(p, l, smem);
  else if (SUB == 4) phase_post(p, l, smem);
  else if (SUB == 5) phase_merge(p, l, smem);
  else if (SUB == 6) phase_resid_gemm(p, (const bf16_t*)(p.ws + OFF_Z), ZS, (const bf16_t*)(p.ws + WOFF(OFF_WTOUT, l)), 1024,
                                      (l == 0) ? p.in[I_X] : p.out, smem);
  else if (SUB == 7) phase_norm_only(p, p.out, p.in[I_NORM_FFN] + l * DM);
  else if (SUB == 8) phase_ffn_in(p, l, smem);
  else if (SUB == 9) phase_resid_gemm(p, (const bf16_t*)(p.ws + OFF_Z), FFH, (const bf16_t*)(p.ws + WOFF(OFF_WTF2, l)), FFH, p.out, smem);
  else phase_final(p);
}

#ifndef PHM
#define PHM 0xFFFF
#endif
#define XB_TMO      128
#define XB_XCNT(j)  (256  + 64 * (j))
#define XB_XSUB(j)  (1280 + 64 * (j))
#define XB_XGEN(j)  (2304 + 64 * (j))
#define XB_TOP      3328
#define XB_TOPGEN   3392
#define XCD_BAR_WORDS 3456
#define XB_SPIN_CAP (1u << 18)
#define LAS __attribute__((address_space(3)))

__device__ __forceinline__ unsigned xb_ld(unsigned* p)              { return __hip_atomic_load(p, __ATOMIC_RELAXED, __HIP_MEMORY_SCOPE_AGENT); }
__device__ __forceinline__ unsigned xb_add(unsigned* p, unsigned v) { return __hip_atomic_fetch_add(p, v, __ATOMIC_RELAXED, __HIP_MEMORY_SCOPE_AGENT); }
__device__ __forceinline__ unsigned xb_xcc_id() { return (unsigned)__builtin_amdgcn_s_getreg((3 << 11) | 20) & 0xFu; }
#define XB_SPIN(cond, bar) do { unsigned _sp = 0; while (cond) { __builtin_amdgcn_s_sleep(1); \
    if ((++_sp & 255u) == 0u) { if (xb_ld(&(bar)[XB_TMO])) break; if (_sp > XB_SPIN_CAP) { atomicAdd(&(bar)[XB_TMO], 1u); break; } } } } while (0)

struct XcdBarrier {
    unsigned* bar; unsigned x;
    volatile LAS unsigned* st;
};

__device__ __forceinline__ XcdBarrier xcd_barrier_post(unsigned* bar, volatile LAS unsigned* st) {
    XcdBarrier b; b.bar = bar; b.x = xb_xcc_id(); b.st = st;
    if (threadIdx.x == 0) (void)xb_add(&bar[XB_XCNT(b.x)], 1u);
    return b;
}
__device__ __forceinline__ void xcd_barrier_complete(unsigned* bar, unsigned x, unsigned& nloc, unsigned& nx) {
    const unsigned G = gridDim.x * gridDim.y * gridDim.z;
    unsigned sum, cnt, mine, sp = 0u;
    for (;;) {
        sum = 0u; cnt = 0u; mine = 0u;
#pragma unroll
        for (unsigned j = 0; j < 16; ++j) { const unsigned c = xb_ld(&bar[XB_XCNT(j)]); sum += c; cnt += (c > 0u) ? 1u : 0u; mine = (j == x) ? c : mine; }
        if (sum == G) break;
        __builtin_amdgcn_s_sleep(1);
        if ((++sp & 255u) == 0u) { if (xb_ld(&bar[XB_TMO])) break; if (sp > XB_SPIN_CAP) { atomicAdd(&bar[XB_TMO], 1u); break; } }
    }
    nloc = mine > 0u ? mine : 1u; nx = cnt > 0u ? cnt : 1u;
}

__device__ __forceinline__ void xcd_barrier(const XcdBarrier& b) {
    asm volatile("s_waitcnt vmcnt(0)" ::: "memory");
    __syncthreads();
    if (threadIdx.x == 0) {
        unsigned* bar = b.bar;
        __builtin_amdgcn_s_waitcnt(0);
        unsigned nloc = b.st[0], nx = b.st[1];
        if (nloc == 0u) { xcd_barrier_complete(bar, b.x, nloc, nx); b.st[0] = nloc; b.st[1] = nx; }
        const unsigned old = xb_add(&bar[XB_XSUB(b.x)], 1u);
        const unsigned gen = old / nloc;
        if (old + 1u == (gen + 1u) * nloc) {
            __builtin_amdgcn_fence(__ATOMIC_RELEASE, "agent");
            asm volatile("s_waitcnt vmcnt(0)" ::: "memory");
            const unsigned og = xb_add(&bar[XB_TOP], 1u);
            const unsigned tg = og / nx;
            if (og + 1u == (tg + 1u) * nx) xb_add(&bar[XB_TOPGEN], 1u);
            else XB_SPIN(xb_ld(&bar[XB_TOPGEN]) == tg, bar);
            __builtin_amdgcn_fence(__ATOMIC_ACQUIRE, "agent");
            xb_add(&bar[XB_XGEN(b.x)], 1u);
            asm volatile("s_waitcnt vmcnt(0)" ::: "memory");
        } else {
            XB_SPIN(xb_ld(&bar[XB_XGEN(b.x)]) == gen, bar);
            __builtin_amdgcn_fence(__ATOMIC_ACQUIRE, "agent");
            asm volatile("s_waitcnt vmcnt(0)" ::: "memory");
        }
    }
    __syncthreads();
}


constexpr int LDS_MAIN = 73728;
constexpr int LDS_BYTES = LDS_MAIN + 16;

#if COOP
__global__ void __launch_bounds__(256, 2) fwd_kernel(Params p, int ph0, int ph1, int scan_mask) {
  extern __shared__ __attribute__((aligned(16))) char smem[];
  cg::grid_group grid = cg::this_grid();
  volatile LAS unsigned* xb_st = (volatile LAS unsigned*)(smem + LDS_MAIN);
  if (threadIdx.x == 0) { xb_st[0] = 0u; xb_st[1] = 0u; xb_st[2] = 0u; xb_st[3] = 0u; }
  __syncthreads();
  XcdBarrier xbar = xcd_barrier_post(reinterpret_cast<unsigned*>(p.ws + OFF_BAR), xb_st);
  for (int ph = ph0; ph < ph1; ++ph) {
    if (ph == NPHASES - 1) {
      phase_final(p);
    } else {
      const int l = ph / NPH_LAYER, sub = ph % NPH_LAYER;
      switch (sub) {
        case 0: if (PHM & (1<<0)) run_phase<0>(p, l, smem); break;
        case 1: if (PHM & (1<<1)) run_phase<1>(p, l, smem); break;
        case 2: if (PHM & (1<<2)) run_phase<2>(p, l, smem); break;
        case 3: if (PHM & (1<<3)) phase_scans(p, l, smem, scan_mask); break;
        case 4: if (PHM & (1<<4)) run_phase<4>(p, l, smem); break;
        case 5: if (PHM & (1<<5)) run_phase<5>(p, l, smem); break;
        case 6: if (PHM & (1<<6)) run_phase<6>(p, l, smem); break;
        case 7: if (PHM & (1<<7)) run_phase<7>(p, l, smem); break;
        case 8: if (PHM & (1<<8)) run_phase<8>(p, l, smem); break;
        case 9: if (PHM & (1<<9)) run_phase<9>(p, l, smem); break;
      }
    }
    if (ph + 1 < ph1) {
      if (ph1 > 1000) grid.sync();
      else xcd_barrier(xbar);
    }
  }
}
#else
template <int SUB>
__global__ void __launch_bounds__(256, 2) k_phase(Params p, int l) {
  __shared__ __attribute__((aligned(16))) char smem[65536];
  run_phase<SUB>(p, l, smem);
}
#endif

extern "C" void kernel_launch(void* const* d_in, const int* in_sizes, int n_in, void* d_out, int out_size, void* d_ws,
                              size_t ws_size, hipStream_t stream) {
  if (n_in < 41 || ws_size < WS_NEED) {
    fprintf(stderr, "kernel_launch: bad args n_in=%d ws=%zu need=%zu\n", n_in, ws_size, (size_t)WS_NEED);
    return;
  }
  Params p{};
  for (int i = 0; i < 41; ++i) p.in[i] = (const float*)d_in[i];
  p.out = (float*)d_out;
  p.ws = (char*)d_ws;
#if COOP
  static int grid_blocks = 0;
  if (!grid_blocks) {
    int dev = 0, cus = 0, per_cu = 0;
    hipGetDevice(&dev);
    hipDeviceGetAttribute(&cus, hipDeviceAttributeMultiprocessorCount, dev);
    hipFuncSetAttribute((const void*)fwd_kernel, hipFuncAttributeMaxDynamicSharedMemorySize, LDS_BYTES);
    hipOccupancyMaxActiveBlocksPerMultiprocessor(&per_cu, fwd_kernel, 256, LDS_BYTES);
    if (per_cu > 2) per_cu = 2;
    grid_blocks = cus * per_cu;
  }
#ifdef HYBRID
  for (int ph = 0; ph < NPHASES; ++ph) {
    if (ph % 10 == 3 && ph < 20) {
      const int groups[4] = SCAN_GROUPS;
      for (int gi = 0; gi < 4; ++gi) if (groups[gi]) fwd_kernel<<<grid_blocks, 256, LDS_BYTES, stream>>>(p, ph, ph + 1, groups[gi]);
    } else {
      fwd_kernel<<<grid_blocks, 256, LDS_BYTES, stream>>>(p, ph, ph + 1, 15);
    }
  }
#else
  hipMemsetAsync((char*)d_ws + OFF_BAR, 0, XCD_BAR_WORDS * 4, stream);
  int ph0 = 0, ph1 = NPHASES, smask = 15;
  void* args[] = {&p, &ph0, &ph1, &smask};
  hipError_t e = hipLaunchCooperativeKernel((void*)fwd_kernel, dim3(grid_blocks), dim3(256), args, LDS_BYTES, stream);
  if (e != hipSuccess) fprintf(stderr, "cooperative launch failed: %s (grid %d)\n", hipGetErrorString(e), grid_blocks);
#endif
#else
  const dim3 g(512), b(256);
  for (int l = 0; l < 2; ++l) {
    k_phase<0><<<g, b, 0, stream>>>(p, l);
    k_phase<1><<<g, b, 0, stream>>>(p, l);
    k_phase<2><<<g, b, 0, stream>>>(p, l);
    k_phase<3><<<g, b, 0, stream>>>(p, l);
    k_phase<4><<<g, b, 0, stream>>>(p, l);
    k_phase<5><<<g, b, 0, stream>>>(p, l);
    k_phase<6><<<g, b, 0, stream>>>(p, l);
    k_phase<7><<<g, b, 0, stream>>>(p, l);
    k_phase<8><<<g, b, 0, stream>>>(p, l);
    k_phase<9><<<g, b, 0, stream>>>(p, l);
  }
  k_phase<10><<<g, b, 0, stream>>>(p, 0);
#endif
}
```

```cpp
#include <hip/hip_runtime.h>
#include <hip/hip_cooperative_groups.h>
#include <cstdio>
#include <cstdint>
namespace cg = cooperative_groups;

#ifndef COOP
#define COOP 1
#endif

#define LAS __attribute__((address_space(3)))
typedef unsigned short bf16_t;
typedef __attribute__((ext_vector_type(8))) short bf16x8;
typedef __attribute__((ext_vector_type(4))) float f32x4;
typedef __attribute__((ext_vector_type(4))) unsigned u32x4;

constexpr int T_TOK = 16384, SEQ = 2048, DM = 1024;
constexpr int IN_COLS = 9992, NZ = 5896, ZS = 5904;
constexpr int ZHG = 0, ZRW = 2048, ZS5 = 3840, ZMB = 4352;
constexpr int FFH = 2816;
constexpr int NPH_LAYER = 10, NPHASES = 21;

constexpr size_t OFF_WTIN   = 0;
constexpr size_t OFF_WTGATE = OFF_WTIN + (size_t)5896 * 1024 * 2;
constexpr size_t OFF_WTBR   = OFF_WTGATE + (size_t)4096 * 1024 * 2;
constexpr size_t OFF_WTOUT  = OFF_WTBR + (size_t)4 * 1024 * 512 * 2;
constexpr size_t OFF_WTF1   = OFF_WTOUT + (size_t)1024 * 1024 * 2;
constexpr size_t OFF_WTF2   = OFF_WTF1 + (size_t)5632 * 1024 * 2;
constexpr size_t OFF_WTGLU  = OFF_WTF2 + (size_t)1024 * 2816 * 2;
constexpr size_t OFF_U      = OFF_WTGLU + (size_t)512 * 512 * 2;
constexpr size_t OFF_Z      = OFF_U + (size_t)T_TOK * 1024 * 2;
constexpr size_t OFF_VF     = OFF_Z + (size_t)T_TOK * ZS * 2;
constexpr size_t OFF_BAR    = OFF_VF + (size_t)T_TOK * 512 * 2;
constexpr size_t OFF_WTGATE_B = OFF_BAR + 16384;
constexpr size_t OFF_WB_B     = OFF_WTGATE_B + (size_t)4096 * 1024 * 2;
constexpr size_t OFF_LORA     = OFF_WB_B + (OFF_U - OFF_WTBR);
constexpr size_t LORA_STRIDE  = 524288;
constexpr size_t LO_G2 = 0, LO_W2 = 131072, LO_A2 = 196608, LO_V1 = 262144, LO_V2 = 294912;
constexpr size_t WS_NEED      = OFF_LORA + 2 * LORA_STRIDE;
constexpr size_t DELTA_GATE   = OFF_WTGATE_B - OFF_WTGATE;
constexpr size_t DELTA_WB     = OFF_WB_B - OFF_WTBR;
#define WOFF_GATE(l) (OFF_WTGATE + (size_t)(l) * DELTA_GATE)
#define WOFF(off, l) ((off) + (size_t)(l) * DELTA_WB)

struct Params {
  const float* in[41];
  float* out;
  char* ws;
};

enum { I_X = 0, I_NORM_MIX, I_W_IN, I_W_BRANCH, I_W_OUT, I_NORM_FFN, I_W_FFN_IN, I_W_FFN_OUT, I_NORM_FINAL,
       I_HG_LB, I_HG_NW, I_RW_MU, I_RW_W0, I_RW_W2, I_RW_A0, I_RW_A2, I_RW_G2, I_RW_KK, I_RW_KA, I_RW_RK,
       I_RW_LNW, I_RW_LNB, I_RW_V0, I_RW_V1, I_RW_V2, I_S5_ARE, I_S5_AIM, I_S5_BRE, I_S5_BIM, I_S5_CRE,
       I_S5_CIM, I_S5_D, I_S5_LOGDT, I_S5_WGLU, I_S5_BGLU, I_MB_CONVW, I_MB_CONVB, I_MB_DTB, I_MB_ALOG,
       I_MB_D, I_MB_NW };

__device__ __forceinline__ float bf2f(bf16_t v) { return __uint_as_float(((unsigned)v) << 16); }
typedef __attribute__((ext_vector_type(2))) __bf16 bf16x2_t;
__device__ __forceinline__ unsigned pack2(float a, float b) {
  bf16x2_t v;
  v[0] = (__bf16)a;
  v[1] = (__bf16)b;
  return __builtin_bit_cast(unsigned, v);
}
__device__ __forceinline__ bf16_t f2bf(float f) { return (bf16_t)(pack2(f, 0.f) & 0xffffu); }
__device__ __forceinline__ void store_pair_bf16(bf16_t* p_sub0, const int lane, uint2 a, uint2 b, const bool ok = true) {
  auto rx = __builtin_amdgcn_permlane16_swap(a.x, b.x, false, false);
  auto ry = __builtin_amdgcn_permlane16_swap(a.y, b.y, false, false);
  const int off = ((lane >> 4) & 1) * 16 + (lane >> 5) * 8;
  if (ok) *reinterpret_cast<uint4*>(p_sub0 + off) = uint4{(unsigned)rx[0], (unsigned)ry[0], (unsigned)rx[1], (unsigned)ry[1]};
}
__device__ __forceinline__ float sigmoidf_(float x) { return 1.f / (1.f + __expf(-x)); }
__device__ __forceinline__ float siluf_(float x) { return x / (1.f + __expf(-x)); }
__device__ __forceinline__ float softplusf_(float x) { return x > 20.f ? x : log1pf(__expf(x)); }
__device__ __forceinline__ float gelu_tanh(float x) {
  float u = 0.7978845608028654f * (x + 0.044715f * x * x * x);
  return 0.5f * x * (1.f + tanhf(u));
}
__device__ __forceinline__ float frcp(float x) { return __builtin_amdgcn_rcpf(x); }
__device__ __forceinline__ float fsigmoid(float x) { return frcp(1.f + __expf(-x)); }
__device__ __forceinline__ float fsilu(float x) { return x * frcp(1.f + __expf(-x)); }
__device__ __forceinline__ float fsoftplus(float x) { return x > 20.f ? x : __logf(1.f + __expf(x)); }
__device__ __forceinline__ float ftanh(float x) {
  float e = __expf(2.f * fminf(fmaxf(x, -15.f), 15.f));
  return (e - 1.f) * frcp(e + 1.f);
}
__device__ __forceinline__ float fgelu(float x) {
  float u = 0.7978845608028654f * (x + 0.044715f * x * x * x);
  return 0.5f * x * (1.f + ftanh(u));
}

__device__ __forceinline__ float quad_sum(float x) {
  x += __builtin_bit_cast(float, __builtin_amdgcn_update_dpp(0, __builtin_bit_cast(int, x), 0xB1, 0xF, 0xF, true));
  x += __builtin_bit_cast(float, __builtin_amdgcn_update_dpp(0, __builtin_bit_cast(int, x), 0x4E, 0xF, 0xF, true));
  return x;
}
__device__ __forceinline__ float oct_sum(float x) {
  x = quad_sum(x);
  x += __builtin_bit_cast(float, __builtin_amdgcn_update_dpp(0, __builtin_bit_cast(int, x), 0x141, 0xF, 0xF, true));
  return x;
}
__device__ __forceinline__ float sum16(float x) {
  x += __shfl_xor(x, 1); x += __shfl_xor(x, 2); x += __shfl_xor(x, 4); x += __shfl_xor(x, 8);
  return x;
}
__device__ __forceinline__ float sum64(float x) {
  x = sum16(x); x += __shfl_xor(x, 16); x += __shfl_xor(x, 32);
  return x;
}

__device__ __forceinline__ int opaque_tid() {
  int t = threadIdx.x;
  asm volatile("" : "+v"(t));
  return t;
}

template <int BN>
__device__ __forceinline__ void gemm_mainloop(f32x4 (&acc)[4][BN / 32], const bf16_t* A, int lda, int m0,
                                              const bf16_t* Bt, int ldb, int n0, int nmax, int K, char* smem, const int tid) {
  const int lane = tid & 63, wid = tid >> 6, wm = wid >> 1, wn = wid & 1;
  const int q = tid & 7, r0 = tid >> 3;
  unsigned offA[4], offB[BN / 32];
#pragma unroll
  for (int i = 0; i < 4; ++i) offA[i] = ((unsigned)(m0 + r0 + 32 * i) * (unsigned)lda + (unsigned)q * 8u) * 2u;
#pragma unroll
  for (int i = 0; i < BN / 32; ++i) {
    int row = n0 + r0 + 32 * i;
    row = row < nmax ? row : nmax;
    offB[i] = ((unsigned)row * (unsigned)ldb + (unsigned)q * 8u) * 2u;
  }
  const unsigned sto = (unsigned)r0 * 128u + (unsigned)((q ^ ((r0 >> 1) & 7)) << 4);
  unsigned aoff[4], boff[BN / 32];
#pragma unroll
  for (int mi = 0; mi < 4; ++mi) {
    int row = wm * 64 + mi * 16 + (lane & 15);
    aoff[mi] = (unsigned)row * 128u + (unsigned)(((lane >> 4) ^ ((row >> 1) & 7)) << 4);
  }
#pragma unroll
  for (int ni = 0; ni < BN / 32; ++ni) {
    int row = wn * (BN / 2) + ni * 16 + (lane & 15);
    boff[ni] = (unsigned)row * 128u + (unsigned)(((lane >> 4) ^ ((row >> 1) & 7)) << 4);
  }
  const char* Ab = reinterpret_cast<const char*>(A);
  const char* Bb = reinterpret_cast<const char*>(Bt);
  const int nk = K >> 6;
  constexpr bool WIDE = (BN == 128);
  u32x4 Ra0, Ra1, Ra2, Ra3, Rb0, Rb1, Rb2, Rb3;
  u32x4 Qa0, Qa1, Qa2, Qa3, Qb0, Qb1, Qb2, Qb3;
#define GLOAD(P, TILE)                                                         \
  {                                                                            \
    const char* Ak_ = Ab + (size_t)(TILE) * 128;                               \
    const char* Bk_ = Bb + (size_t)(TILE) * 128;                               \
    P##a0 = *reinterpret_cast<const u32x4*>(Ak_ + offA[0]);                    \
    P##a1 = *reinterpret_cast<const u32x4*>(Ak_ + offA[1]);                    \
    P##a2 = *reinterpret_cast<const u32x4*>(Ak_ + offA[2]);                    \
    P##a3 = *reinterpret_cast<const u32x4*>(Ak_ + offA[3]);                    \
    P##b0 = *reinterpret_cast<const u32x4*>(Bk_ + offB[0]);                    \
    P##b1 = *reinterpret_cast<const u32x4*>(Bk_ + offB[1]);                    \
    if (WIDE) {                                                                \
      P##b2 = *reinterpret_cast<const u32x4*>(Bk_ + offB[BN / 32 - 2]);        \
      P##b3 = *reinterpret_cast<const u32x4*>(Bk_ + offB[BN / 32 - 1]);        \
    }                                                                          \
  }
#define SSTORE(P, BUF)                                                         \
  {                                                                            \
    char* ad_ = smem + (BUF) * 16384 + sto;                                    \
    char* bd_ = smem + 32768 + (BUF) * (BN * 128) + sto;                       \
    *reinterpret_cast<u32x4*>(ad_) = P##a0;                                    \
    *reinterpret_cast<u32x4*>(ad_ + 4096) = P##a1;                             \
    *reinterpret_cast<u32x4*>(ad_ + 8192) = P##a2;                             \
    *reinterpret_cast<u32x4*>(ad_ + 12288) = P##a3;                            \
    *reinterpret_cast<u32x4*>(bd_) = P##b0;                                    \
    *reinterpret_cast<u32x4*>(bd_ + 4096) = P##b1;                             \
    if (WIDE) {                                                                \
      *reinterpret_cast<u32x4*>(bd_ + 8192) = P##b2;                           \
      *reinterpret_cast<u32x4*>(bd_ + 12288) = P##b3;                          \
    }                                                                          \
  }
#define COMPUTE(BUF)                                                           \
  {                                                                            \
    const char* a_s = smem + (BUF) * 16384;                                    \
    const char* b_s = smem + 32768 + (BUF) * (BN * 128);                       \
    _Pragma("unroll") for (int ks = 0; ks < 2; ++ks) {                         \
      bf16x8 af[4], bfr[BN / 32];                                              \
      _Pragma("unroll") for (int mi = 0; mi < 4; ++mi)                         \
          af[mi] = *reinterpret_cast<const bf16x8*>(a_s + (aoff[mi] ^ (ks * 64)));       \
      _Pragma("unroll") for (int ni = 0; ni < BN / 32; ++ni)                   \
          bfr[ni] = *reinterpret_cast<const bf16x8*>(b_s + (boff[ni] ^ (ks * 64)));      \
      _Pragma("unroll") for (int mi = 0; mi < 4; ++mi)                         \
        _Pragma("unroll") for (int ni = 0; ni < BN / 32; ++ni)                 \
          acc[mi][ni] = __builtin_amdgcn_mfma_f32_16x16x32_bf16(bfr[ni], af[mi], acc[mi][ni], 0, 0, 0); \
    }                                                                          \
  }
  if constexpr (WIDE && false) {
    GLOAD(R, 0);
    SSTORE(R, 0);
    GLOAD(R, 1);
    if (nk > 2) GLOAD(Q, 2);
    __syncthreads();
#pragma unroll 1
    for (int kt = 0; kt < nk; kt += 2) {
      __builtin_amdgcn_sched_barrier(0);
      COMPUTE(0);
      __builtin_amdgcn_sched_barrier(0);
      SSTORE(R, 1);
      if (kt + 3 < nk) GLOAD(R, kt + 3);
      __syncthreads();
      __builtin_amdgcn_sched_barrier(0);
      COMPUTE(1);
      __builtin_amdgcn_sched_barrier(0);
      if (kt + 2 < nk) SSTORE(Q, 0);
      if (kt + 4 < nk) GLOAD(Q, kt + 4);
      __syncthreads();
    }
  } else {
    GLOAD(R, 0);
    SSTORE(R, 0);
    __syncthreads();
#pragma unroll 1
    for (int kt = 0; kt < nk; ++kt) {
      const int buf = kt & 1;
      const bool more = (kt + 1 < nk);
      if (more) GLOAD(R, kt + 1);
      __builtin_amdgcn_sched_barrier(0);
      COMPUTE(buf);
      __builtin_amdgcn_sched_barrier(0);
      if (more) SSTORE(R, buf ^ 1);
      __syncthreads();
    }
  }
#undef GLOAD
#undef SSTORE
#undef COMPUTE
}

template <int BN>
__device__ __forceinline__ void zero_acc(f32x4 (&acc)[4][BN / 32]) {
#pragma unroll
  for (int mi = 0; mi < 4; ++mi)
#pragma unroll
    for (int ni = 0; ni < BN / 32; ++ni) acc[mi][ni] = f32x4{0.f, 0.f, 0.f, 0.f};
}

#define RAW_BARRIER() do { asm volatile("s_waitcnt lgkmcnt(0)" ::: "memory"); __builtin_amdgcn_s_barrier(); } while (0)
template <int MROWS>
__device__ __forceinline__ void gemm_mainloop_glds(f32x4 (&acc)[MROWS / 32][4], const bf16_t* A, int lda, int m0, const bf16_t* Bt,
                                                   int ldb, int n0, int nmax, int K, char* smem, const int tid) {
  constexpr int NA = MROWS / 64;
  constexpr int NMI = MROWS / 32;
  constexpr int STAGE = (MROWS + 128) * 64;
  constexpr int BOFF = MROWS * 64;
  const int lane = tid & 63, wid = tid >> 6, wm = wid >> 1, wn = wid & 1;
  unsigned gA[NA], gB[2];
#pragma unroll
  for (int i = 0; i < NA; ++i) {
    const int row = (wid * NA + i) * 16 + (lane >> 2);
    const int q = (lane & 3) ^ ((row >> 2) & 3);
    gA[i] = ((unsigned)(m0 + row) * (unsigned)lda + (unsigned)q * 8u) * 2u;
  }
#pragma unroll
  for (int i = 0; i < 2; ++i) {
    const int row = (wid * 2 + i) * 16 + (lane >> 2);
    const int q = (lane & 3) ^ ((row >> 2) & 3);
    int grow = n0 + row;
    grow = grow < nmax ? grow : nmax;
    gB[i] = ((unsigned)grow * (unsigned)ldb + (unsigned)q * 8u) * 2u;
  }
  unsigned aoff[NMI], boff[4];
#pragma unroll
  for (int mi = 0; mi < NMI; ++mi) {
    int row = wm * (MROWS / 2) + mi * 16 + (lane & 15);
    aoff[mi] = (unsigned)row * 64u + (unsigned)(((lane >> 4) ^ ((row >> 2) & 3)) << 4);
  }
#pragma unroll
  for (int ni = 0; ni < 4; ++ni) {
    int row = wn * 64 + ni * 16 + (lane & 15);
    boff[ni] = (unsigned)BOFF + (unsigned)row * 64u + (unsigned)(((lane >> 4) ^ ((row >> 2) & 3)) << 4);
  }
  const char* Ab = reinterpret_cast<const char*>(A);
  const char* Bb = reinterpret_cast<const char*>(Bt);
  const int nk = K >> 5;
  char* ldsA = smem + wid * (NA * 1024);
  char* ldsB = smem + BOFF + wid * 2048;
#define BG_GLDS(TILE, ST)                                                                                           \
  {                                                                                                                 \
    const char* Ak_ = Ab + (size_t)(TILE) * 64;                                                                     \
    const char* Bk_ = Bb + (size_t)(TILE) * 64;                                                                     \
    char* la_ = ldsA + (ST) * STAGE;                                                                                \
    char* lb_ = ldsB + (ST) * STAGE;                                                                                \
    _Pragma("unroll") for (int i_ = 0; i_ < NA; ++i_)                                                               \
      __builtin_amdgcn_global_load_lds((const unsigned*)(Ak_ + gA[i_]), (LAS unsigned*)(la_ + i_ * 1024), 16, 0, 0); \
    __builtin_amdgcn_global_load_lds((const unsigned*)(Bk_ + gB[0]), (LAS unsigned*)(lb_), 16, 0, 0);              \
    __builtin_amdgcn_global_load_lds((const unsigned*)(Bk_ + gB[1]), (LAS unsigned*)(lb_ + 1024), 16, 0, 0);       \
  }
#define BG_COMPUTE(ST)                                                                                              \
  {                                                                                                                 \
    const char* s_ = smem + (ST) * STAGE;                                                                           \
    bf16x8 bfr[4], af[NMI];                                                                                         \
    _Pragma("unroll") for (int ni = 0; ni < 4; ++ni) bfr[ni] = *reinterpret_cast<const bf16x8*>(s_ + boff[ni]);     \
    _Pragma("unroll") for (int mi = 0; mi < NMI; ++mi) af[mi] = *reinterpret_cast<const bf16x8*>(s_ + aoff[mi]);    \
    __builtin_amdgcn_sched_barrier(0);                                                                              \
    _Pragma("unroll") for (int mi = 0; mi < NMI; ++mi)                                                              \
      _Pragma("unroll") for (int ni = 0; ni < 4; ++ni)                                                              \
        acc[mi][ni] = __builtin_amdgcn_mfma_f32_16x16x32_bf16(bfr[ni], af[mi], acc[mi][ni], 0, 0, 0);               \
  }
  asm volatile("s_waitcnt vmcnt(0)" ::: "memory");
  BG_GLDS(0, 0);
  BG_GLDS(1, 1);
  int st = 0;
#pragma unroll 1
  for (int kt = 0; kt < nk - 1; ++kt) {
    if constexpr (NA == 4) asm volatile("s_waitcnt vmcnt(6)" ::: "memory");
    else asm volatile("s_waitcnt vmcnt(4)" ::: "memory");
    RAW_BARRIER();
    if (kt + 2 < nk) {
      const int st2 = (st >= 1) ? st - 1 : 2;
      BG_GLDS(kt + 2, st2);
    }
    __builtin_amdgcn_sched_barrier(0);
    BG_COMPUTE(st);
    __builtin_amdgcn_sched_barrier(0);
    st = (st == 2) ? 0 : st + 1;
  }
  asm volatile("s_waitcnt vmcnt(0)" ::: "memory");
  RAW_BARRIER();
  BG_COMPUTE(st);
  RAW_BARRIER();
#undef BG_GLDS
#undef BG_COMPUTE
}
__device__ __forceinline__ void gemm_mainloop_big(f32x4 (&acc)[8][4], const bf16_t* A, int lda, int m0, const bf16_t* Bt,
                                                  int ldb, int n0, int nmax, int K, char* smem, const int tid) {
  gemm_mainloop_glds<256>(acc, A, lda, m0, Bt, ldb, n0, nmax, K, smem, tid);
}

__device__ __forceinline__ void zero_acc_big(f32x4 (&acc)[8][4]) {
#pragma unroll
  for (int mi = 0; mi < 8; ++mi)
#pragma unroll
    for (int ni = 0; ni < 4; ++ni) acc[mi][ni] = f32x4{0.f, 0.f, 0.f, 0.f};
}

__device__ __forceinline__ void conv_tile(const float* src, int ld, int nlimit, int k0, int n0, bf16_t* dst, int Kd, int mode,
                                          char* smem, const int tid) {
  float* sT = reinterpret_cast<float*>(smem);
#pragma unroll
  for (int i = 0; i < 16; ++i) {
    int kk = i * 4 + (tid >> 6), nn = tid & 63;
    float v = (n0 + nn < nlimit) ? src[(size_t)(k0 + kk) * ld + n0 + nn] : 0.f;
    sT[kk * 65 + nn] = v;
  }
  __syncthreads();
  {
    int nn = tid >> 2, kq = tid & 3;
    int n = n0 + nn;
    if (n < nlimit) {
      int drow = n;
      if (mode == 1) {
        if (n < FFH) drow = (n >> 4) * 32 + (n & 15);
        else { int j = n - FFH; drow = (j >> 4) * 32 + 16 + (j & 15); }
      }
      unsigned pk[8];
#pragma unroll
      for (int j = 0; j < 8; ++j) pk[j] = pack2(sT[(kq * 16 + 2 * j) * 65 + nn], sT[(kq * 16 + 2 * j + 1) * 65 + nn]);
      uint4* d = reinterpret_cast<uint4*>(dst + (size_t)drow * Kd + k0 + kq * 16);
      d[0] = uint4{pk[0], pk[1], pk[2], pk[3]};
      d[1] = uint4{pk[4], pk[5], pk[6], pk[7]};
    }
  }
  __syncthreads();
}

__device__ __forceinline__ void rmsnorm_row_to_bf16(const float* x, const float* w, bf16_t* out, const int lane) {
  float4 v[4];
  float ss = 0.f;
#pragma unroll
  for (int i = 0; i < 4; ++i) {
    v[i] = *reinterpret_cast<const float4*>(x + i * 256 + lane * 4);
    ss += v[i].x * v[i].x + v[i].y * v[i].y + v[i].z * v[i].z + v[i].w * v[i].w;
  }
  ss = sum64(ss);
  float rstd = rsqrtf(ss * (1.f / 1024.f) + 1e-6f);
#pragma unroll
  for (int i = 0; i < 4; ++i) {
    float4 ww = *reinterpret_cast<const float4*>(w + i * 256 + lane * 4);
    uint2 o;
    o.x = pack2(v[i].x * rstd * ww.x, v[i].y * rstd * ww.y);
    o.y = pack2(v[i].z * rstd * ww.z, v[i].w * rstd * ww.w);
    *reinterpret_cast<uint2*>(out + i * 256 + lane * 4) = o;
  }
}

constexpr int CT_IN = 157 * 16, CT_BR = 512, CT_OUT = 256, CT_F1 = 88 * 16, CT_F2 = 44 * 16, CT_GLU = 64;
constexpr int CT_TOTAL = CT_IN + CT_BR + CT_OUT + CT_F1 + CT_F2 + CT_GLU;

__device__ __forceinline__ void convert_one(const Params& p, int l, int c, char* smem, const int tid) {
  char* ws = p.ws;
  if (c < CT_IN) {
    int nt = c >> 4, kt = c & 15;
    const float* src = p.in[I_W_IN] + (size_t)l * 1024 * IN_COLS;
    if (nt < 64) conv_tile(src, IN_COLS, IN_COLS, kt * 64, nt * 64, (bf16_t*)(ws + WOFF_GATE(l)), 1024, 0, smem, tid);
    else conv_tile(src + 4096, IN_COLS, IN_COLS - 4096, kt * 64, (nt - 64) * 64, (bf16_t*)(ws + OFF_WTIN), 1024, 0, smem, tid);
    return;
  }
  c -= CT_IN;
  if (c < CT_BR) {
    int kb = c >> 7, r = c & 127, nt = r >> 3, kt = r & 7;
    const float* src = p.in[I_W_BRANCH] + ((size_t)l * 4 + kb) * 512 * 1024;
    conv_tile(src, 1024, 1024, kt * 64, nt * 64, (bf16_t*)(ws + WOFF(OFF_WTBR, l)) + (size_t)kb * 1024 * 512, 512, 0, smem, tid);
    return;
  }
  c -= CT_BR;
  if (c < CT_OUT) {
    int nt = c >> 4, kt = c & 15;
    conv_tile(p.in[I_W_OUT] + (size_t)l * 1024 * 1024, 1024, 1024, kt * 64, nt * 64, (bf16_t*)(ws + WOFF(OFF_WTOUT, l)), 1024, 0, smem, tid);
    return;
  }
  c -= CT_OUT;
  if (c < CT_F1) {
    int nt = c >> 4, kt = c & 15;
    conv_tile(p.in[I_W_FFN_IN] + (size_t)l * 1024 * 5632, 5632, 5632, kt * 64, nt * 64, (bf16_t*)(ws + WOFF(OFF_WTF1, l)), 1024, 1, smem, tid);
    return;
  }
  c -= CT_F1;
  if (c < CT_F2) {
    int nt = c / 44, kt = c % 44;
    conv_tile(p.in[I_W_FFN_OUT] + (size_t)l * FFH * 1024, 1024, 1024, kt * 64, nt * 64, (bf16_t*)(ws + WOFF(OFF_WTF2, l)), FFH, 0, smem, tid);
    return;
  }
  c -= CT_F2;
  {
    int nt = c >> 3, kt = c & 7;
    conv_tile(p.in[I_S5_WGLU] + (size_t)l * 512 * 512, 512, 512, kt * 64, nt * 64, (bf16_t*)(ws + WOFF(OFF_WTGLU, l)), 512, 0, smem, tid);
  }
}

constexpr int CT_LORA = 41;
__device__ __forceinline__ void convert_lora(const Params& p, int l, int c, char* smem, const int tid) {
  char* lo = p.ws + OFF_LORA + (size_t)l * LORA_STRIDE;
  if (c < 16) { int nt = c >> 1, kt = c & 1;
    conv_tile(p.in[I_RW_G2] + (size_t)l * 128 * 512, 512, 512, kt * 64, nt * 64, (bf16_t*)(lo + LO_G2), 128, 0, smem, tid); return; }
  c -= 16;
  if (c < 8) { conv_tile(p.in[I_RW_W2] + (size_t)l * 64 * 512, 512, 512, 0, c * 64, (bf16_t*)(lo + LO_W2), 64, 0, smem, tid); return; }
  c -= 8;
  if (c < 8) { conv_tile(p.in[I_RW_A2] + (size_t)l * 64 * 512, 512, 512, 0, c * 64, (bf16_t*)(lo + LO_A2), 64, 0, smem, tid); return; }
  c -= 8;
  if (l == 0) return;
  if (c < 8) { conv_tile(p.in[I_RW_V1] + (size_t)(l - 1) * 512 * 32, 32, 32, c * 64, 0, (bf16_t*)(lo + LO_V1), 512, 0, smem, tid); return; }
  {
    const float* src = p.in[I_RW_V2] + (size_t)(l - 1) * 32 * 512;
    bf16_t* dst = (bf16_t*)(lo + LO_V2);
    for (int e = tid; e < 32 * 512; e += 256) { int ch = e >> 5, r = e & 31; dst[e] = f2bf(src[r * 512 + ch]); }
  }
}

template <int J>
__device__ __forceinline__ void lora_mfma(const char* sIn, int rowb, const bf16_t* Wt, f32x4 (&acc)[8], const int tid) {
  const int lane = tid & 63, w = tid >> 6;
#pragma unroll
  for (int i = 0; i < 8; ++i) acc[i] = f32x4{0.f, 0.f, 0.f, 0.f};
#pragma unroll
  for (int ks = 0; ks < J / 32; ++ks) {
    const bf16x8 a = *reinterpret_cast<const bf16x8*>(sIn + (lane & 15) * rowb + (ks * 32 + 8 * (lane >> 4)) * 2);
#pragma unroll
    for (int i = 0; i < 8; ++i) {
      const bf16x8 b = *reinterpret_cast<const bf16x8*>(Wt + (size_t)((w * 8 + i) * 16 + (lane & 15)) * J + ks * 32 + 8 * (lane >> 4));
      acc[i] = __builtin_amdgcn_mfma_f32_16x16x32_bf16(a, b, acc[i], 0, 0, 0);
    }
  }
}

__device__ void phase_convert_norm(const Params& p, int l, char* smem) {
  const int tid = opaque_tid();
  constexpr int CT_IN_ONLY = CT_IN - 1024;
  const int nconv = (l == 0) ? CT_IN_ONLY + 2 * CT_LORA : 0;
  const int ntask = nconv + T_TOK / 4;
  const float* xsrc = (l == 0) ? p.in[I_X] : p.out;
  for (int t = blockIdx.x; t < ntask; t += gridDim.x) {
    if (t < nconv) {
      if (t < CT_IN_ONLY) convert_one(p, l, t + 1024, smem, tid);
      else { int c = t - CT_IN_ONLY; convert_lora(p, c / CT_LORA, c % CT_LORA, smem, tid); __syncthreads(); }
    } else {
      int row = (t - nconv) * 4 + (tid >> 6);
      rmsnorm_row_to_bf16(xsrc + (size_t)row * DM, p.in[I_NORM_MIX] + l * DM, (bf16_t*)(p.ws + OFF_U) + (size_t)row * DM, tid & 63);
    }
  }
}

__device__ void phase_norm_only(const Params& p, const float* xsrc, const float* w) {
  const int tid = opaque_tid();
  for (int t = blockIdx.x; t < T_TOK / 4; t += gridDim.x) {
    int row = t * 4 + (tid >> 6);
    rmsnorm_row_to_bf16(xsrc + (size_t)row * DM, w, (bf16_t*)(p.ws + OFF_U) + (size_t)row * DM, tid & 63);
  }
}

__device__ __forceinline__ bool tile_map(int t, int NT, int& mt, int& nt) {
  const int x = t & 7, r = t >> 3;
  const int cnt = (NT + 7) >> 3;
  const int ni = r % cnt;
  mt = r / cnt;
  nt = x + 8 * ni;
  return nt < NT;
}
__device__ __forceinline__ int tile_count(int MT, int NT) { return 8 * MT * ((NT + 7) >> 3); }

__device__ void phase_inproj(const Params& p, char* smem) {
  const bf16_t* U = (const bf16_t*)(p.ws + OFF_U);
  const bf16_t* Wt = (const bf16_t*)(p.ws + OFF_WTIN);
  bf16_t* Z = (bf16_t*)(p.ws + OFF_Z);
  const int tid = opaque_tid();
  const int lane = tid & 63, wid = tid >> 6, wm = wid >> 1, wn = wid & 1;
  constexpr int NT = 47;
  for (int t = blockIdx.x; t < tile_count(64, NT); t += gridDim.x) {
    int mt, nt;
    if (!tile_map(t, NT, mt, nt)) continue;
    f32x4 acc[8][4];
    zero_acc_big(acc);
    gemm_mainloop_big(acc, U, 1024, mt * 256, Wt, 1024, nt * 128, NZ - 1, 1024, smem, tid);
#pragma unroll
    for (int mi = 0; mi < 8; ++mi)
#pragma unroll
      for (int np = 0; np < 2; ++np) {
        const int colb = nt * 128 + wn * 64 + np * 32;
        const int row = mt * 256 + wm * 128 + mi * 16 + (lane & 15);
        uint2 a, b;
        a.x = pack2(acc[mi][2 * np][0], acc[mi][2 * np][1]);
        a.y = pack2(acc[mi][2 * np][2], acc[mi][2 * np][3]);
        b.x = pack2(acc[mi][2 * np + 1][0], acc[mi][2 * np + 1][1]);
        b.y = pack2(acc[mi][2 * np + 1][2], acc[mi][2 * np + 1][3]);
        const int mycol = colb + ((lane >> 4) & 1) * 16 + (lane >> 5) * 8;
        store_pair_bf16(Z + (size_t)row * ZS + colb, lane, a, b, mycol < NZ);
      }
  }
}

template <int J>
__device__ __forceinline__ void lora_mm(const float* sIn, const float* W, float (&a0)[16], float (&a1)[16], const int tid) {
#pragma unroll
  for (int i = 0; i < 16; ++i) { a0[i] = 0.f; a1[i] = 0.f; }
#pragma unroll 8
  for (int j = 0; j < J; ++j) {
    float w0 = W[j * 512 + tid], w1 = W[j * 512 + tid + 256];
    const float4* x4 = reinterpret_cast<const float4*>(sIn + j * 16);
#pragma unroll
    for (int q = 0; q < 4; ++q) {
      float4 x = x4[q];
      a0[q * 4 + 0] = fmaf(w0, x.x, a0[q * 4 + 0]); a1[q * 4 + 0] = fmaf(w1, x.x, a1[q * 4 + 0]);
      a0[q * 4 + 1] = fmaf(w0, x.y, a0[q * 4 + 1]); a1[q * 4 + 1] = fmaf(w1, x.y, a1[q * 4 + 1]);
      a0[q * 4 + 2] = fmaf(w0, x.z, a0[q * 4 + 2]); a1[q * 4 + 2] = fmaf(w1, x.z, a1[q * 4 + 2]);
      a0[q * 4 + 3] = fmaf(w0, x.w, a0[q * 4 + 3]); a1[q * 4 + 3] = fmaf(w1, x.w, a1[q * 4 + 3]);
    }
  }
}

__device__ __forceinline__ float rw_shift(const bf16_t* Z, int row, int s, int rc, float mu) {
  float cur = bf2f(Z[(size_t)row * ZS + ZRW + rc]);
  float prev = (s > 0) ? bf2f(Z[(size_t)(row - 1) * ZS + ZRW + rc]) : 0.f;
  return cur + (prev - cur) * mu;
}

__device__ void phase_rwprep(const Params& p, int l, char* smem) {
  const bf16_t* Z = (const bf16_t*)(p.ws + OFF_Z);
  bf16_t* LW = (bf16_t*)(p.ws + OFF_U);
  bf16_t* LA = LW + (size_t)T_TOK * 512;
  bf16_t* VF = (bf16_t*)(p.ws + OFF_VF);
  const char* lo = p.ws + OFF_LORA + (size_t)l * LORA_STRIDE;
  char* sXw = smem;
  char* sXa = smem + 2304;
  char* sZv = smem + 4608;
  float* sTmpF = reinterpret_cast<float*>(smem + 4608 + 16640);
  char* sTmp = smem + 4608 + 16640 + 4096;
  const float* mu = p.in[I_RW_MU] + l * 1792;
  const int tid = opaque_tid(), lane = tid & 63, w = tid >> 6;
  for (int t = blockIdx.x; t < T_TOK / 16; t += gridDim.x) {
    const int row0 = t * 16;
    for (int e = tid; e < 2048; e += 256) {
      int which = e >> 10, r = e & 1023, tok = r >> 6, j = r & 63;
      int row = row0 + tok, sq = row & (SEQ - 1);
      int rc = 1536 + which * 64 + j;
      float z = rw_shift(Z, row, sq, rc, mu[rc]);
      if (which == 0) *reinterpret_cast<bf16_t*>(sXw + tok * 144 + j * 2) = f2bf(ftanh(z));
      else *reinterpret_cast<bf16_t*>(sXa + tok * 144 + j * 2) = f2bf(z);
    }
    {
      float m0 = mu[1024 + tid], m1 = mu[1024 + tid + 256];
#pragma unroll 4
      for (int tok = 0; tok < 16; ++tok) {
        int row = row0 + tok, sq = row & (SEQ - 1);
        bf16_t z0 = f2bf(rw_shift(Z, row, sq, 1024 + tid, m0));
        bf16_t z1 = f2bf(rw_shift(Z, row, sq, 1024 + tid + 256, m1));
        *reinterpret_cast<bf16_t*>(sZv + tok * 1040 + tid * 2) = z0;
        *reinterpret_cast<bf16_t*>(sZv + tok * 1040 + (tid + 256) * 2) = z1;
        if (l == 0) {
          VF[(size_t)row * 512 + tid] = z0;
          VF[(size_t)row * 512 + tid + 256] = z1;
        }
      }
    }
    __syncthreads();
    f32x4 acc[8];
    lora_mfma<64>(sXw, 144, (const bf16_t*)(lo + LO_W2), acc, tid);
#pragma unroll
    for (int i = 0; i < 8; ++i)
#pragma unroll
      for (int jj = 0; jj < 4; ++jj)
        LW[(size_t)(row0 + (lane >> 4) * 4 + jj) * 512 + (w * 8 + i) * 16 + (lane & 15)] = f2bf(acc[i][jj]);
    lora_mfma<64>(sXa, 144, (const bf16_t*)(lo + LO_A2), acc, tid);
#pragma unroll
    for (int i = 0; i < 8; ++i)
#pragma unroll
      for (int jj = 0; jj < 4; ++jj)
        LA[(size_t)(row0 + (lane >> 4) * 4 + jj) * 512 + (w * 8 + i) * 16 + (lane & 15)] = f2bf(acc[i][jj]);
    if (l > 0) {
      {
        const bf16_t* v1t = (const bf16_t*)(lo + LO_V1);
        const int ntile = w & 1, kh = w >> 1;
        f32x4 tacc = f32x4{0.f, 0.f, 0.f, 0.f};
#pragma unroll
        for (int ks = 0; ks < 8; ++ks) {
          const int k0 = (kh * 8 + ks) * 32 + 8 * (lane >> 4);
          const bf16x8 a = *reinterpret_cast<const bf16x8*>(sZv + (lane & 15) * 1040 + k0 * 2);
          const bf16x8 b = *reinterpret_cast<const bf16x8*>(v1t + (size_t)(ntile * 16 + (lane & 15)) * 512 + k0);
          tacc = __builtin_amdgcn_mfma_f32_16x16x32_bf16(a, b, tacc, 0, 0, 0);
        }
#pragma unroll
        for (int jj = 0; jj < 4; ++jj)
          sTmpF[(kh * 16 + (lane >> 4) * 4 + jj) * 32 + ntile * 16 + (lane & 15)] = tacc[jj];
      }
      __syncthreads();
      for (int e = tid; e < 512; e += 256) {
        int tok = e >> 5, r = e & 31;
        *reinterpret_cast<bf16_t*>(sTmp + tok * 80 + r * 2) = f2bf(sTmpF[tok * 32 + r] + sTmpF[(16 + tok) * 32 + r]);
      }
      __syncthreads();
      lora_mfma<32>(sTmp, 80, (const bf16_t*)(lo + LO_V2), acc, tid);
      const float* v0 = p.in[I_RW_V0] + (size_t)(l - 1) * 512;
#pragma unroll
      for (int i = 0; i < 8; ++i) {
        const int ch = (w * 8 + i) * 16 + (lane & 15);
        const float b0 = v0[ch];
#pragma unroll
        for (int jj = 0; jj < 4; ++jj) {
          const int tok = (lane >> 4) * 4 + jj;
          const float zv = bf2f(*reinterpret_cast<const bf16_t*>(sZv + tok * 1040 + ch * 2));
          const size_t idx = (size_t)(row0 + tok) * 512 + ch;
          const float vf = bf2f(VF[idx]);
          VF[idx] = f2bf(zv + (vf - zv) * fsigmoid(b0 + acc[i][jj]));
        }
      }
    }
    __syncthreads();
  }
}

__device__ void hg_scan(const Params& p, int l, int task, char* smem) {
  const int b = task >> 3, h = (task >> 1) & 3, vg = task & 1;
  float* sFg = reinterpret_cast<float*>(smem);
  float* sQs = sFg + 16 * 128;
  float* sO = sQs + 16 * 128;
  float* sVv = sO + 4 * 16 * 64;
  const int tid = opaque_tid(), w = tid >> 6, lane = tid & 63;
  bf16_t* Z = (bf16_t*)(p.ws + OFF_Z) + (size_t)b * SEQ * ZS;
  const int ks = tid & 127;
  float lb = 0.f;
  if (l > 0) {
    float x0 = p.in[I_HG_LB][h * 128 + ks], x1 = p.in[I_HG_LB][512 + h * 128 + ks];
    float m = fmaxf(x0, x1), e0 = expf(x0 - m), e1 = expf(x1 - m);
    lb = e1 / (e0 + e1);
  }
  float s[32];
#pragma unroll
  for (int j = 0; j < 32; ++j) s[j] = 0.f;
  const int vcol = ZHG + 1024 + h * 128 + vg * 64;
  const int qcol = ZHG + h * 128 + ks;
  bf16_t rq0, rq1, rq2, rq3, rq4, rq5, rq6, rq7, rf0, rf1, rf2, rf3, rf4, rf5, rf6, rf7, rv0, rv1, rv2, rv3;
#define HG_LOAD(T0)                                                                                \
  {                                                                                                \
    const bf16_t* zb = Z + (size_t)((T0) + (tid >> 7)) * ZS + qcol;                                \
    rq0 = zb[0]; rf0 = zb[512]; zb += 2 * ZS; rq1 = zb[0]; rf1 = zb[512]; zb += 2 * ZS;            \
    rq2 = zb[0]; rf2 = zb[512]; zb += 2 * ZS; rq3 = zb[0]; rf3 = zb[512]; zb += 2 * ZS;            \
    rq4 = zb[0]; rf4 = zb[512]; zb += 2 * ZS; rq5 = zb[0]; rf5 = zb[512]; zb += 2 * ZS;            \
    rq6 = zb[0]; rf6 = zb[512]; zb += 2 * ZS; rq7 = zb[0]; rf7 = zb[512];                          \
    const bf16_t* zv = Z + (size_t)((T0) + w) * ZS + vcol + lane;                                  \
    rv0 = zv[0]; rv1 = zv[4 * ZS]; rv2 = zv[8 * ZS]; rv3 = zv[12 * ZS];                            \
  }
#define HG_PUT1(I, RQ, RF)                                                                         \
  {                                                                                                \
    int t = (tid >> 7) + 2 * (I);                                                                  \
    sFg[t * 128 + ks] = fmaxf(lb + (1.f - lb) * fsigmoid(bf2f(RF)), 1e-30f);                       \
    sQs[t * 128 + ks] = fsilu(bf2f(RQ));                                                           \
  }
#define HG_PROCESS()                                                                               \
  {                                                                                                \
    HG_PUT1(0, rq0, rf0) HG_PUT1(1, rq1, rf1) HG_PUT1(2, rq2, rf2) HG_PUT1(3, rq3, rf3)            \
    HG_PUT1(4, rq4, rf4) HG_PUT1(5, rq5, rf5) HG_PUT1(6, rq6, rf6) HG_PUT1(7, rq7, rf7)            \
    sVv[(w)*64 + lane] = bf2f(rv0); sVv[(w + 4) * 64 + lane] = bf2f(rv1);                          \
    sVv[(w + 8) * 64 + lane] = bf2f(rv2); sVv[(w + 12) * 64 + lane] = bf2f(rv3);                   \
  }
  HG_LOAD(0);
  HG_PROCESS();
  __syncthreads();
  constexpr int NCH = SEQ / 16;
#pragma unroll 1
  for (int c = 0; c < NCH; ++c) {
    const int t0 = c * 16;
    const int tn = (c + 1 < NCH) ? t0 + 16 : t0;
    HG_LOAD(tn);
    __builtin_amdgcn_sched_barrier(0);
#pragma unroll 2
    for (int t = 0; t < 16; ++t) {
      const float v = sVv[t * 64 + lane];
      const float opv = (lane < 32) ? sFg[t * 128 + w * 32 + lane] : sQs[t * 128 + w * 32 + (lane - 32)];
      const int opi = __builtin_bit_cast(int, opv);
      float o = 0.f;
#pragma unroll
      for (int j = 0; j < 32; ++j) {
        const float fg = __builtin_bit_cast(float, __builtin_amdgcn_readlane(opi, j));
        const float qq = __builtin_bit_cast(float, __builtin_amdgcn_readlane(opi, 32 + j));
        const float kv = fmaf(-fg, v, v);
        s[j] = fmaf(s[j], fg, kv);
        o = fmaf(qq, s[j], o);
      }
      sO[(w * 16 + t) * 64 + lane] = o;
    }
    __builtin_amdgcn_sched_barrier(0);
    __syncthreads();
    {
      int t = tid >> 4, v4 = (tid & 15) * 4;
      float4 a = *reinterpret_cast<const float4*>(sO + (0 * 16 + t) * 64 + v4);
      float4 bq = *reinterpret_cast<const float4*>(sO + (1 * 16 + t) * 64 + v4);
      float4 cq = *reinterpret_cast<const float4*>(sO + (2 * 16 + t) * 64 + v4);
      float4 d = *reinterpret_cast<const float4*>(sO + (3 * 16 + t) * 64 + v4);
      uint2 o;
      o.x = pack2(a.x + bq.x + cq.x + d.x, a.y + bq.y + cq.y + d.y);
      o.y = pack2(a.z + bq.z + cq.z + d.z, a.w + bq.w + cq.w + d.w);
      *reinterpret_cast<uint2*>(Z + (size_t)(t0 + t) * ZS + vcol + v4) = o;
    }
    HG_PROCESS();
    __syncthreads();
  }
#undef HG_LOAD
#undef HG_PUT1
#undef HG_PROCESS
}

__device__ void mb_scan(const Params& p, int l, int task, char* smem) {
  const int b = task >> 3, hd = task & 7, g = hd >> 2;
  float* sB = reinterpret_cast<float*>(smem);
  float* sC = sB + 16 * 128;
  float* sX = sC + 16 * 128;
  float* sDt = sX + 16 * 64;
  float* sDA = sDt + 16;
  float* sO = sDA + 16;
  const int tid = opaque_tid(), w = tid >> 6, lane = tid & 63;
  bf16_t* Z = (bf16_t*)(p.ws + OFF_Z) + (size_t)b * SEQ * ZS;
  const float* cw = p.in[I_MB_CONVW] + (size_t)l * 4 * 1024;
  const float* cb = p.in[I_MB_CONVB] + (size_t)l * 1024;
  int ci0, ci1;
  {
    int ch = tid;
    ci0 = (ch < 64) ? hd * 64 + ch : (ch < 192 ? 512 + g * 128 + (ch - 64) : 768 + g * 128 + (ch - 192));
    ci1 = 768 + g * 128 + 64 + (tid & 63);
  }
  float* dstA = (tid < 64) ? (sX + tid) : (tid < 192 ? (sB + (tid - 64)) : (sC + (tid - 192)));
  const int strideA = (tid < 64) ? 64 : 128;
  const float w0a = cw[ci0], w1a = cw[1024 + ci0], w2a = cw[2048 + ci0], w3a = cw[3072 + ci0], ba = cb[ci0];
  const float w0b = cw[ci1], w1b = cw[1024 + ci1], w2b = cw[2048 + ci1], w3b = cw[3072 + ci1], bb = cb[ci1];
  const float Aneg = -expf(p.in[I_MB_ALOG][l * 8 + hd]);
  const float dtb = p.in[I_MB_DTB][l * 8 + hd];
  const float Dsk = p.in[I_MB_D][l * 8 + hd];
  float s[32];
#pragma unroll
  for (int j = 0; j < 32; ++j) s[j] = 0.f;
  float pa1 = 0.f, pa2 = 0.f, pa3 = 0.f, pb1 = 0.f, pb2 = 0.f, pb3 = 0.f;
  const int xcol = ZMB + 512;
  const int rt = tid >> 4, rp4 = (tid & 15) * 4;
  bf16_t xa0, xa1, xa2, xa3, xa4, xa5, xa6, xa7, xa8, xa9, xa10, xa11, xa12, xa13, xa14, xa15;
  bf16_t xb0, xb1, xb2, xb3, xb4, xb5, xb6, xb7, xb8, xb9, xb10, xb11, xb12, xb13, xb14, xb15;
  bf16_t rdt;
  uint2 gcur, gnext;
#define MB_LOAD(T0)                                                                                 \
  {                                                                                                 \
    const bf16_t* za = Z + (size_t)(T0) * ZS + xcol + ci0;                                          \
    xa0 = za[0]; xa1 = za[ZS]; xa2 = za[2 * ZS]; xa3 = za[3 * ZS]; xa4 = za[4 * ZS]; xa5 = za[5 * ZS];        \
    xa6 = za[6 * ZS]; xa7 = za[7 * ZS]; xa8 = za[8 * ZS]; xa9 = za[9 * ZS]; xa10 = za[10 * ZS];     \
    xa11 = za[11 * ZS]; xa12 = za[12 * ZS]; xa13 = za[13 * ZS]; xa14 = za[14 * ZS]; xa15 = za[15 * ZS];       \
    if (tid < 64) {                                                                                 \
      const bf16_t* zb = Z + (size_t)(T0) * ZS + xcol + ci1;                                        \
      xb0 = zb[0]; xb1 = zb[ZS]; xb2 = zb[2 * ZS]; xb3 = zb[3 * ZS]; xb4 = zb[4 * ZS]; xb5 = zb[5 * ZS];      \
      xb6 = zb[6 * ZS]; xb7 = zb[7 * ZS]; xb8 = zb[8 * ZS]; xb9 = zb[9 * ZS]; xb10 = zb[10 * ZS];   \
      xb11 = zb[11 * ZS]; xb12 = zb[12 * ZS]; xb13 = zb[13 * ZS]; xb14 = zb[14 * ZS]; xb15 = zb[15 * ZS];     \
    }                                                                                               \
    rdt = Z[(size_t)((T0) + (tid & 15)) * ZS + ZMB + 1536 + hd];                                    \
    gnext = *reinterpret_cast<const uint2*>(Z + (size_t)((T0) + rt) * ZS + ZMB + hd * 64 + rp4);    \
  }
#define MB_CONV_A(T, XR)                                                                            \
  {                                                                                                 \
    float xv = bf2f(XR);                                                                            \
    dstA[(T)*strideA] = fsilu(ba + w0a * pa3 + w1a * pa2 + w2a * pa1 + w3a * xv);                   \
    pa3 = pa2; pa2 = pa1; pa1 = xv;                                                                 \
  }
#define MB_CONV_B(T, XR)                                                                            \
  {                                                                                                 \
    float xv = bf2f(XR);                                                                            \
    sC[(T)*128 + 64 + tid] = fsilu(bb + w0b * pb3 + w1b * pb2 + w2b * pb1 + w3b * xv);              \
    pb3 = pb2; pb2 = pb1; pb1 = xv;                                                                 \
  }
#define MB_PROCESS()                                                                                \
  {                                                                                                 \
    MB_CONV_A(0, xa0) MB_CONV_A(1, xa1) MB_CONV_A(2, xa2) MB_CONV_A(3, xa3) MB_CONV_A(4, xa4)       \
    MB_CONV_A(5, xa5) MB_CONV_A(6, xa6) MB_CONV_A(7, xa7) MB_CONV_A(8, xa8) MB_CONV_A(9, xa9)       \
    MB_CONV_A(10, xa10) MB_CONV_A(11, xa11) MB_CONV_A(12, xa12) MB_CONV_A(13, xa13)                 \
    MB_CONV_A(14, xa14) MB_CONV_A(15, xa15)                                                         \
    if (tid < 64) {                                                                                 \
      MB_CONV_B(0, xb0) MB_CONV_B(1, xb1) MB_CONV_B(2, xb2) MB_CONV_B(3, xb3) MB_CONV_B(4, xb4)     \
      MB_CONV_B(5, xb5) MB_CONV_B(6, xb6) MB_CONV_B(7, xb7) MB_CONV_B(8, xb8) MB_CONV_B(9, xb9)     \
      MB_CONV_B(10, xb10) MB_CONV_B(11, xb11) MB_CONV_B(12, xb12) MB_CONV_B(13, xb13)               \
      MB_CONV_B(14, xb14) MB_CONV_B(15, xb15)                                                       \
    }                                                                                               \
    if (tid < 16) {                                                                                 \
      float dt = fsoftplus(bf2f(rdt) + dtb);                                                        \
      sDt[tid] = dt;                                                                                \
      sDA[tid] = __expf(Aneg * dt);                                                                 \
    }                                                                                               \
    gcur = gnext;                                                                                   \
  }
  MB_LOAD(0);
  MB_PROCESS();
  __syncthreads();
  constexpr int NCH = SEQ / 16;
#pragma unroll 1
  for (int c = 0; c < NCH; ++c) {
    const int t0 = c * 16;
    const bool more = (c + 1 < NCH);
    const int tn = more ? t0 + 16 : t0;
    MB_LOAD(tn);
    __builtin_amdgcn_sched_barrier(0);
#pragma unroll 2
    for (int t = 0; t < 16; ++t) {
      const float dA = sDA[t];
      const float xdt = sX[t * 64 + lane] * sDt[t];
      const float opv = (lane < 32) ? sB[t * 128 + w * 32 + lane] : sC[t * 128 + w * 32 + (lane - 32)];
      const int opi = __builtin_bit_cast(int, opv);
      float y = 0.f;
#pragma unroll
      for (int j = 0; j < 32; ++j) {
        const float bn = __builtin_bit_cast(float, __builtin_amdgcn_readlane(opi, j));
        const float cn = __builtin_bit_cast(float, __builtin_amdgcn_readlane(opi, 32 + j));
        s[j] = fmaf(s[j], dA, bn * xdt);
        y = fmaf(cn, s[j], y);
      }
      sO[(w * 16 + t) * 64 + lane] = y;
    }
    __builtin_amdgcn_sched_barrier(0);
    __syncthreads();
    {
      float4 a = *reinterpret_cast<const float4*>(sO + (0 * 16 + rt) * 64 + rp4);
      float4 bq = *reinterpret_cast<const float4*>(sO + (1 * 16 + rt) * 64 + rp4);
      float4 cq = *reinterpret_cast<const float4*>(sO + (2 * 16 + rt) * 64 + rp4);
      float4 d = *reinterpret_cast<const float4*>(sO + (3 * 16 + rt) * 64 + rp4);
      float4 xs = *reinterpret_cast<const float4*>(sX + rt * 64 + rp4);
      bf16_t* gp = Z + (size_t)(t0 + rt) * ZS + ZMB + hd * 64 + rp4;
      float g0 = bf2f((bf16_t)(gcur.x & 0xffff)), g1 = bf2f((bf16_t)(gcur.x >> 16));
      float g2 = bf2f((bf16_t)(gcur.y & 0xffff)), g3 = bf2f((bf16_t)(gcur.y >> 16));
      float y0 = a.x + bq.x + cq.x + d.x + Dsk * xs.x;
      float y1 = a.y + bq.y + cq.y + d.y + Dsk * xs.y;
      float y2 = a.z + bq.z + cq.z + d.z + Dsk * xs.z;
      float y3 = a.w + bq.w + cq.w + d.w + Dsk * xs.w;
      uint2 o;
      o.x = pack2(y0 * fsilu(g0), y1 * fsilu(g1));
      o.y = pack2(y2 * fsilu(g2), y3 * fsilu(g3));
      *reinterpret_cast<uint2*>(gp) = o;
    }
    __syncthreads();
    if (more) MB_PROCESS();
    __syncthreads();
  }
#undef MB_LOAD
#undef MB_CONV_A
#undef MB_CONV_B
#undef MB_PROCESS
}

__device__ void s5_scan(const Params& p, int l, int task, char* smem) {
  const int tid = opaque_tid(), w = tid >> 6, lane = tid & 63;
  const int b = task >> 3, g = (task & 7) * 4 + w;
  char* base = smem + w * 6144;
  float* sU = reinterpret_cast<float*>(base);
  char* sHb = base + 1024;
  bf16_t* Z = (bf16_t*)(p.ws + OFF_Z) + (size_t)b * SEQ * ZS + ZS5 + g * 16;
  const int n = lane;
  float lr, li, bbr[16], bbi[16];
  bf16x8 Bf0, Bf1, Bf2, Bf3;
  {
    float dt = expf(p.in[I_S5_LOGDT][l * 32 + g]);
    float are = p.in[I_S5_ARE][(l * 32 + g) * 64 + n], aim = p.in[I_S5_AIM][(l * 32 + g) * 64 + n];
    float mag = expf(dt * are);
    lr = mag * cosf(dt * aim); li = mag * sinf(dt * aim);
    float den = are * are + aim * aim;
    float cr = ((lr - 1.f) * are + li * aim) / den;
    float ci = (li * are - (lr - 1.f) * aim) / den;
    const float* bre = p.in[I_S5_BRE] + ((size_t)(l * 32 + g) * 64 + n) * 16;
    const float* bim = p.in[I_S5_BIM] + ((size_t)(l * 32 + g) * 64 + n) * 16;
#pragma unroll
    for (int c = 0; c < 16; ++c) {
      float br = bre[c], bi = bim[c];
      bbr[c] = cr * br - ci * bi;
      bbi[c] = cr * bi + ci * br;
    }
    const float* cre = p.in[I_S5_CRE] + (size_t)(l * 32 + g) * 16 * 64 + (lane & 15) * 64;
    const float* cim = p.in[I_S5_CIM] + (size_t)(l * 32 + g) * 16 * 64 + (lane & 15) * 64;
#pragma unroll
    for (int j = 0; j < 8; ++j) {
      const int kb = 8 * (lane >> 4) + j;
      const int n0 = kb >> 1;
      const bool im = (j & 1);
      Bf0[j] = (short)f2bf(im ? -cim[n0] : cre[n0]);
      Bf1[j] = (short)f2bf(im ? -cim[n0 + 16] : cre[n0 + 16]);
      Bf2[j] = (short)f2bf(im ? -cim[n0 + 32] : cre[n0 + 32]);
      Bf3[j] = (short)f2bf(im ? -cim[n0 + 48] : cre[n0 + 48]);
    }
  }
  const float dsk = p.in[I_S5_D][l * 512 + g * 16 + (lane & 15)];
  const int pt = lane >> 2, pc4 = (lane & 3) * 4;
  float hr = 0.f, hi = 0.f;
  uint2 unext = *reinterpret_cast<const uint2*>(Z + (size_t)pt * ZS + pc4);
  constexpr int NCH = SEQ / 16;
#pragma unroll 1
  for (int c = 0; c < NCH; ++c) {
    const int t0 = c * 16;
    {
      const uint2 ur = unext;
      *reinterpret_cast<float4*>(sU + pt * 16 + pc4) =
          float4{bf2f((bf16_t)(ur.x & 0xffff)), bf2f((bf16_t)(ur.x >> 16)), bf2f((bf16_t)(ur.y & 0xffff)), bf2f((bf16_t)(ur.y >> 16))};
      const int tn = (c + 1 < NCH) ? t0 + 16 : t0;
      unext = *reinterpret_cast<const uint2*>(Z + (size_t)(tn + pt) * ZS + pc4);
    }
    __builtin_amdgcn_sched_barrier(0);
    __syncthreads();
#pragma unroll 2
    for (int t = 0; t < 16; ++t) {
      const float4* u4 = reinterpret_cast<const float4*>(sU + t * 16);
      float bur = 0.f, bui = 0.f;
#pragma unroll
      for (int q = 0; q < 4; ++q) {
        float4 u = u4[q];
        bur = fmaf(bbr[q * 4 + 0], u.x, bur); bui = fmaf(bbi[q * 4 + 0], u.x, bui);
        bur = fmaf(bbr[q * 4 + 1], u.y, bur); bui = fmaf(bbi[q * 4 + 1], u.y, bui);
        bur = fmaf(bbr[q * 4 + 2], u.z, bur); bui = fmaf(bbi[q * 4 + 2], u.z, bui);
        bur = fmaf(bbr[q * 4 + 3], u.w, bur); bui = fmaf(bbi[q * 4 + 3], u.w, bui);
      }
      float nr = lr * hr - li * hi + bur;
      float ni = lr * hi + li * hr + bui;
      hr = nr; hi = ni;
      *reinterpret_cast<unsigned*>(sHb + t * 272 + n * 4) = pack2(hr, hi);
    }
    __syncthreads();
    {
      f32x4 acc = f32x4{0.f, 0.f, 0.f, 0.f};
      const char* ap = sHb + (lane & 15) * 272 + (lane >> 4) * 16;
      acc = __builtin_amdgcn_mfma_f32_16x16x32_bf16(*reinterpret_cast<const bf16x8*>(ap), Bf0, acc, 0, 0, 0);
      acc = __builtin_amdgcn_mfma_f32_16x16x32_bf16(*reinterpret_cast<const bf16x8*>(ap + 64), Bf1, acc, 0, 0, 0);
      acc = __builtin_amdgcn_mfma_f32_16x16x32_bf16(*reinterpret_cast<const bf16x8*>(ap + 128), Bf2, acc, 0, 0, 0);
      acc = __builtin_amdgcn_mfma_f32_16x16x32_bf16(*reinterpret_cast<const bf16x8*>(ap + 192), Bf3, acc, 0, 0, 0);
      const int cc = lane & 15, tb = (lane >> 4) * 4;
#pragma unroll
      for (int jj = 0; jj < 4; ++jj) {
        float y = acc[jj] + dsk * sU[(tb + jj) * 16 + cc];
        Z[(size_t)(t0 + tb + jj) * ZS + cc] = f2bf(fgelu(y));
      }
    }
    __syncthreads();
  }
}

__device__ void rw_scan(const Params& p, int l, int task, char* smem) {
  const int b = task >> 3, h = task & 7;
  float* sR = reinterpret_cast<float*>(smem);
  float* sW = sR + 1024;
  float* sK = sW + 1024;
  float* sA = sK + 1024;
  float* sBb = sA + 1024;
  float* sV = sBb + 1024;
  float* sY = sV + 1024;
  float* sBonus = sY + 1024;
  const int tid = opaque_tid(), w = tid >> 6, lane = tid & 63;
  const size_t tokbase = (size_t)b * SEQ;
  bf16_t* Z = (bf16_t*)(p.ws + OFF_Z) + tokbase * ZS;
  const bf16_t* LW = (const bf16_t*)(p.ws + OFF_U) + tokbase * 512;
  const bf16_t* LA = LW + (size_t)T_TOK * 512;
  const bf16_t* VF = (const bf16_t*)(p.ws + OFF_VF) + tokbase * 512;
  const int st = tid >> 4, c4 = (tid & 15) * 4, ch = h * 64 + c4;
  float mur[4], muk[4], w0[4], a0[4], kk_[4], ka_[4], rk_[4], lnw[4], lnb[4];
#pragma unroll
  for (int e = 0; e < 4; ++e) {
    mur[e] = p.in[I_RW_MU][l * 1792 + ch + e];
    muk[e] = p.in[I_RW_MU][l * 1792 + 512 + ch + e];
    w0[e] = p.in[I_RW_W0][l * 512 + ch + e];
    a0[e] = p.in[I_RW_A0][l * 512 + ch + e];
    kk_[e] = p.in[I_RW_KK][l * 512 + ch + e];
    ka_[e] = p.in[I_RW_KA][l * 512 + ch + e];
    rk_[e] = p.in[I_RW_RK][l * 512 + ch + e];
    lnw[e] = p.in[I_RW_LNW][l * 512 + ch + e];
    lnb[e] = p.in[I_RW_LNB][l * 512 + ch + e];
  }
  const int rg = lane >> 3, kq = lane & 7, vrow = w * 16 + rg * 2;
  float S0[8], S1[8];
#pragma unroll
  for (int j = 0; j < 8; ++j) { S0[j] = 0.f; S1[j] = 0.f; }
  uint2 rc, kc, rp, kp, lwv, lav, vfv;
#define RW_LOAD(T0)                                                                                 \
  {                                                                                                 \
    const int s_ = (T0) + st;                                                                       \
    const bf16_t* zr = Z + (size_t)s_ * ZS + ZRW + ch;                                              \
    rc = *reinterpret_cast<const uint2*>(zr);                                                       \
    kc = *reinterpret_cast<const uint2*>(zr + 512);                                                 \
    rp = uint2{0u, 0u}; kp = uint2{0u, 0u};                                                         \
    if (s_ > 0) { rp = *reinterpret_cast<const uint2*>(zr - ZS); kp = *reinterpret_cast<const uint2*>(zr - ZS + 512); } \
    lwv = *reinterpret_cast<const uint2*>(LW + (size_t)s_ * 512 + ch);                              \
    lav = *reinterpret_cast<const uint2*>(LA + (size_t)s_ * 512 + ch);                              \
    vfv = *reinterpret_cast<const uint2*>(VF + (size_t)s_ * 512 + ch);                              \
  }
#define RW_PROCESS()                                                                                \
  {                                                                                                 \
    float r4[4], k4[4], kkv[4], av[4], wv[4], vv[4];                                                \
    float n2 = 0.f;                                                                                 \
    _Pragma("unroll") for (int e = 0; e < 4; ++e) {                                                 \
      unsigned rcw = (e < 2) ? rc.x : rc.y, kcw = (e < 2) ? kc.x : kc.y, rpw = (e < 2) ? rp.x : rp.y, kpw = (e < 2) ? kp.x : kp.y; \
      unsigned lww = (e < 2) ? lwv.x : lwv.y, law = (e < 2) ? lav.x : lav.y, vfw = (e < 2) ? vfv.x : vfv.y; \
      int sh = (e & 1) * 16;                                                                        \
      float rcur = bf2f((bf16_t)((rcw >> sh) & 0xffff)), rprev = bf2f((bf16_t)((rpw >> sh) & 0xffff)); \
      float kcur = bf2f((bf16_t)((kcw >> sh) & 0xffff)), kprev = bf2f((bf16_t)((kpw >> sh) & 0xffff)); \
      float lwf = bf2f((bf16_t)((lww >> sh) & 0xffff)), laf = bf2f((bf16_t)((law >> sh) & 0xffff)); \
      vv[e] = bf2f((bf16_t)((vfw >> sh) & 0xffff));                                                 \
      r4[e] = rcur + (rprev - rcur) * mur[e];                                                       \
      k4[e] = kcur + (kprev - kcur) * muk[e];                                                       \
      float wlog = -fsoftplus(-(w0[e] + lwf)) - 0.5f;                                               \
      wv[e] = __expf(-__expf(wlog));                                                                \
      av[e] = fsigmoid(a0[e] + laf);                                                                \
      kkv[e] = k4[e] * kk_[e];                                                                      \
      n2 += kkv[e] * kkv[e];                                                                        \
    }                                                                                               \
    n2 = sum16(n2);                                                                                 \
    float inv = 1.f / fmaxf(sqrtf(n2), 1e-12f);                                                     \
    float bon = 0.f;                                                                                \
    float kt4[4], ap4[4], bp4[4];                                                                   \
    _Pragma("unroll") for (int e = 0; e < 4; ++e) {                                                 \
      float kkn = kkv[e] * inv;                                                                     \
      kt4[e] = k4[e] * (1.f + (av[e] - 1.f) * ka_[e]);                                              \
      ap4[e] = -kkn;                                                                                \
      bp4[e] = kkn * av[e];                                                                         \
      bon += r4[e] * kt4[e] * rk_[e];                                                               \
    }                                                                                               \
    bon = sum16(bon);                                                                               \
    *reinterpret_cast<float4*>(sR + st * 64 + c4) = float4{r4[0], r4[1], r4[2], r4[3]};             \
    *reinterpret_cast<float4*>(sW + st * 64 + c4) = float4{wv[0], wv[1], wv[2], wv[3]};             \
    *reinterpret_cast<float4*>(sK + st * 64 + c4) = float4{kt4[0], kt4[1], kt4[2], kt4[3]};         \
    *reinterpret_cast<float4*>(sA + st * 64 + c4) = float4{ap4[0], ap4[1], ap4[2], ap4[3]};         \
    *reinterpret_cast<float4*>(sBb + st * 64 + c4) = float4{bp4[0], bp4[1], bp4[2], bp4[3]};        \
    *reinterpret_cast<float4*>(sV + st * 64 + c4) = float4{vv[0], vv[1], vv[2], vv[3]};             \
    if ((tid & 15) == 0) sBonus[st] = bon;                                                          \
  }
  RW_LOAD(0);
  RW_PROCESS();
  __syncthreads();
  constexpr int NCH = SEQ / 16;
#pragma unroll 1
  for (int c = 0; c < NCH; ++c) {
    const int t0 = c * 16;
    const int tn = (c + 1 < NCH) ? t0 + 16 : t0;
    RW_LOAD(tn);
    __builtin_amdgcn_sched_barrier(0);
#pragma unroll 2
    for (int t = 0; t < 16; ++t) {
      const float4* a4p = reinterpret_cast<const float4*>(sA + t * 64 + kq * 8);
      const float4* w4p = reinterpret_cast<const float4*>(sW + t * 64 + kq * 8);
      const float4* b4p = reinterpret_cast<const float4*>(sBb + t * 64 + kq * 8);
      const float4* k4p = reinterpret_cast<const float4*>(sK + t * 64 + kq * 8);
      const float4* r4p = reinterpret_cast<const float4*>(sR + t * 64 + kq * 8);
      const float2 vv = *reinterpret_cast<const float2*>(sV + t * 64 + vrow);
      float sa0 = 0.f, sa1 = 0.f;
#pragma unroll
      for (int q = 0; q < 2; ++q) {
        float4 a = a4p[q];
        sa0 = fmaf(S0[q * 4 + 0], a.x, sa0); sa1 = fmaf(S1[q * 4 + 0], a.x, sa1);
        sa0 = fmaf(S0[q * 4 + 1], a.y, sa0); sa1 = fmaf(S1[q * 4 + 1], a.y, sa1);
        sa0 = fmaf(S0[q * 4 + 2], a.z, sa0); sa1 = fmaf(S1[q * 4 + 2], a.z, sa1);
        sa0 = fmaf(S0[q * 4 + 3], a.w, sa0); sa1 = fmaf(S1[q * 4 + 3], a.w, sa1);
      }
      sa0 = oct_sum(sa0); sa1 = oct_sum(sa1);
      float y0 = 0.f, y1 = 0.f;
#pragma unroll
      for (int q = 0; q < 2; ++q) {
        float4 ww = w4p[q], bb = b4p[q], kk = k4p[q], rr = r4p[q];
        S0[q * 4 + 0] = fmaf(S0[q * 4 + 0], ww.x, fmaf(sa0, bb.x, vv.x * kk.x)); y0 = fmaf(S0[q * 4 + 0], rr.x, y0);
        S1[q * 4 + 0] = fmaf(S1[q * 4 + 0], ww.x, fmaf(sa1, bb.x, vv.y * kk.x)); y1 = fmaf(S1[q * 4 + 0], rr.x, y1);
        S0[q * 4 + 1] = fmaf(S0[q * 4 + 1], ww.y, fmaf(sa0, bb.y, vv.x * kk.y)); y0 = fmaf(S0[q * 4 + 1], rr.y, y0);
        S1[q * 4 + 1] = fmaf(S1[q * 4 + 1], ww.y, fmaf(sa1, bb.y, vv.y * kk.y)); y1 = fmaf(S1[q * 4 + 1], rr.y, y1);
        S0[q * 4 + 2] = fmaf(S0[q * 4 + 2], ww.z, fmaf(sa0, bb.z, vv.x * kk.z)); y0 = fmaf(S0[q * 4 + 2], rr.z, y0);
        S1[q * 4 + 2] = fmaf(S1[q * 4 + 2], ww.z, fmaf(sa1, bb.z, vv.y * kk.z)); y1 = fmaf(S1[q * 4 + 2], rr.z, y1);
        S0[q * 4 + 3] = fmaf(S0[q * 4 + 3], ww.w, fmaf(sa0, bb.w, vv.x * kk.w)); y0 = fmaf(S0[q * 4 + 3], rr.w, y0);
        S1[q * 4 + 3] = fmaf(S1[q * 4 + 3], ww.w, fmaf(sa1, bb.w, vv.y * kk.w)); y1 = fmaf(S1[q * 4 + 3], rr.w, y1);
      }
      y0 = oct_sum(y0); y1 = oct_sum(y1);
      if (kq == 0) *reinterpret_cast<float2*>(sY + t * 64 + vrow) = float2{y0, y1};
    }
    __builtin_amdgcn_sched_barrier(0);
    __syncthreads();
    {
      float4 y4 = *reinterpret_cast<const float4*>(sY + st * 64 + c4);
      float4 v4 = *reinterpret_cast<const float4*>(sV + st * 64 + c4);
      float bon = sBonus[st];
      float mean = sum16(y4.x + y4.y + y4.z + y4.w) * (1.f / 64.f);
      float dx = y4.x - mean, dy = y4.y - mean, dz = y4.z - mean, dw = y4.w - mean;
      float var = sum16(dx * dx + dy * dy + dz * dz + dw * dw) * (1.f / 64.f);
      float rs = rsqrtf(var + 64e-5f);
      float o0 = dx * rs * lnw[0] + lnb[0] + bon * v4.x;
      float o1 = dy * rs * lnw[1] + lnb[1] + bon * v4.y;
      float o2 = dz * rs * lnw[2] + lnb[2] + bon * v4.z;
      float o3 = dw * rs * lnw[3] + lnb[3] + bon * v4.w;
      uint2 o;
      o.x = pack2(o0, o1); o.y = pack2(o2, o3);
      *reinterpret_cast<uint2*>(Z + (size_t)(t0 + st) * ZS + ZRW + 1024 + ch) = o;
    }
    RW_PROCESS();
    __syncthreads();
  }
#undef RW_LOAD
#undef RW_PROCESS
}

__device__ void phase_scans(const Params& p, int l, char* smem, int scan_mask = 15) {
  for (int t = blockIdx.x; t < 256; t += gridDim.x) {
    int type = t & 3, idx = t >> 2;
    if (!((scan_mask >> type) & 1)) continue;
#ifndef SCM
#define SCM 15
#endif
    if (type == 0) { if (SCM & 1) rw_scan(p, l, idx, smem); }
    else if (type == 1) { if (SCM & 2) hg_scan(p, l, idx, smem); }
    else if (type == 2) { if (SCM & 4) mb_scan(p, l, idx, smem); }
    else { if (SCM & 8) s5_scan(p, l, idx, smem); }
    __syncthreads();
  }
  if (l == 0) {
    const int tid = opaque_tid();
    const int nb = (gridDim.x > 256) ? (int)gridDim.x - 256 : (int)gridDim.x;
    const int b0 = (gridDim.x > 256) ? (int)blockIdx.x - 256 : (int)blockIdx.x;
    constexpr int NREST = CT_TOTAL - (CT_IN - 1024);
    if (b0 >= 0)
      for (int c = b0; c < NREST + CT_TOTAL; c += nb) {
        if (c < NREST) convert_one(p, 0, (c < 1024) ? c : c + (CT_IN - 1024), smem, tid);
        else convert_one(p, 1, c - NREST, smem, tid);
      }
  }
}

__device__ __forceinline__ void unpack8(const uint4& v, float (&f)[8]) {
  f[0] = bf2f((bf16_t)(v.x & 0xffff)); f[1] = bf2f((bf16_t)(v.x >> 16));
  f[2] = bf2f((bf16_t)(v.y & 0xffff)); f[3] = bf2f((bf16_t)(v.y >> 16));
  f[4] = bf2f((bf16_t)(v.z & 0xffff)); f[5] = bf2f((bf16_t)(v.z >> 16));
  f[6] = bf2f((bf16_t)(v.w & 0xffff)); f[7] = bf2f((bf16_t)(v.w >> 16));
}

__device__ void phase_post(const Params& p, int l, char* smem) {
  bf16_t* Z = (bf16_t*)(p.ws + OFF_Z);
  const int tid = opaque_tid(), lane = tid & 63, wid = tid >> 6;
  constexpr int N_ROWT = T_TOK / 4, N_RWT = T_TOK / 16, N_GLU = 128 * 4, N_NORM = T_TOK / 4;
  const float* xsrc = (l == 0) ? p.in[I_X] : p.out;
  for (int t = blockIdx.x; t < N_ROWT + N_RWT + N_GLU + N_NORM; t += gridDim.x) {
    if (t < N_ROWT) {
      const int row = t * 4 + wid;
      {
        bf16_t* op = Z + (size_t)row * ZS + ZHG + 1024 + lane * 8;
        uint4 ov = *reinterpret_cast<const uint4*>(op);
        uint4 gv = *reinterpret_cast<const uint4*>(op + 512);
        float o[8], g[8];
        unpack8(ov, o); unpack8(gv, g);
        float ss = 0.f;
#pragma unroll
        for (int e = 0; e < 8; ++e) ss += o[e] * o[e];
        ss = sum16(ss);
        float rstd = rsqrtf(ss * (1.f / 128.f) + 1e-6f);
        const float* nw = p.in[I_HG_NW] + l * 512 + lane * 8;
        float r[8];
#pragma unroll
        for (int e = 0; e < 8; ++e) r[e] = o[e] * rstd * nw[e] * siluf_(g[e]);
        *reinterpret_cast<uint4*>(op) = uint4{pack2(r[0], r[1]), pack2(r[2], r[3]), pack2(r[4], r[5]), pack2(r[6], r[7])};
      }
      {
        bf16_t* op = Z + (size_t)row * ZS + ZMB + lane * 8;
        uint4 ov = *reinterpret_cast<const uint4*>(op);
        float o[8];
        unpack8(ov, o);
        float ss = 0.f;
#pragma unroll
        for (int e = 0; e < 8; ++e) ss += o[e] * o[e];
        ss = sum64(ss);
        float rstd = rsqrtf(ss * (1.f / 512.f) + 1e-6f);
        const float* nw = p.in[I_MB_NW] + l * 512 + lane * 8;
        float r[8];
#pragma unroll
        for (int e = 0; e < 8; ++e) r[e] = o[e] * rstd * nw[e];
        *reinterpret_cast<uint4*>(op) = uint4{pack2(r[0], r[1]), pack2(r[2], r[3]), pack2(r[4], r[5]), pack2(r[6], r[7])};
      }
    } else if (t < N_ROWT + N_RWT) {
      const int row0 = (t - N_ROWT) * 16;
      char* sXg = smem;
      const float* mu = p.in[I_RW_MU] + l * 1792 + 1664;
      for (int e = tid; e < 2048; e += 256) {
        int tok = e >> 7, j = e & 127;
        int row = row0 + tok, sq = row & (SEQ - 1);
        *reinterpret_cast<bf16_t*>(sXg + tok * 272 + j * 2) = f2bf(fsigmoid(rw_shift(Z, row, sq, 1664 + j, mu[j])));
      }
      __syncthreads();
      f32x4 acc[8];
      lora_mfma<128>(sXg, 272, (const bf16_t*)(p.ws + OFF_LORA + (size_t)l * LORA_STRIDE + LO_G2), acc, tid);
#pragma unroll
      for (int i = 0; i < 8; ++i)
#pragma unroll
        for (int jj = 0; jj < 4; ++jj) {
          bf16_t* yp = Z + (size_t)(row0 + (lane >> 4) * 4 + jj) * ZS + ZRW + 1024 + (wid * 8 + i) * 16 + (lane & 15);
          *yp = f2bf(bf2f(*yp) * acc[i][jj]);
        }
      __syncthreads();
    } else if (t < N_ROWT + N_RWT + N_GLU) {
      const int tt = t - N_ROWT - N_RWT, mt = tt >> 2, nt = tt & 3;
      const int wm = wid >> 1, wn = wid & 1;
      f32x4 acc[4][4];
      zero_acc<128>(acc);
      gemm_mainloop<128>(acc, Z + ZS5, ZS, mt * 128, (const bf16_t*)(p.ws + WOFF(OFF_WTGLU, l)), 512, nt * 128, 511, 512, smem, tid);
      const float* bg = p.in[I_S5_BGLU] + l * 512;
#pragma unroll
      for (int mi = 0; mi < 4; ++mi)
#pragma unroll
        for (int ni = 0; ni < 4; ++ni) {
          int col = nt * 128 + wn * 64 + ni * 16 + (lane >> 4) * 4;
          int row = mt * 128 + wm * 64 + mi * 16 + (lane & 15);
          float4 b4 = *reinterpret_cast<const float4*>(bg + col);
          uint2 yv = *reinterpret_cast<const uint2*>(Z + (size_t)row * ZS + ZS5 + col);
          float y0 = bf2f((bf16_t)(yv.x & 0xffff)), y1 = bf2f((bf16_t)(yv.x >> 16));
          float y2 = bf2f((bf16_t)(yv.y & 0xffff)), y3 = bf2f((bf16_t)(yv.y >> 16));
          uint2 o;
          o.x = pack2(y0 * sigmoidf_(acc[mi][ni][0] + b4.x), y1 * sigmoidf_(acc[mi][ni][1] + b4.y));
          o.y = pack2(y2 * sigmoidf_(acc[mi][ni][2] + b4.z), y3 * sigmoidf_(acc[mi][ni][3] + b4.w));
          *reinterpret_cast<uint2*>(Z + (size_t)row * ZS + ZMB + 1024 + col) = o;
        }
    } else {
      const int row = (t - N_ROWT - N_RWT - N_GLU) * 4 + wid;
      rmsnorm_row_to_bf16(xsrc + (size_t)row * DM, p.in[I_NORM_MIX] + l * DM, (bf16_t*)(p.ws + OFF_U) + (size_t)row * DM, tid & 63);
    }
  }
}

__device__ void phase_merge(const Params& p, int l, char* smem) {
  bf16_t* Z = (bf16_t*)(p.ws + OFF_Z);
  const bf16_t* U = (const bf16_t*)(p.ws + OFF_U);
  const bf16_t* Wg = (const bf16_t*)(p.ws + WOFF_GATE(l));
  const bf16_t* Wb = (const bf16_t*)(p.ws + WOFF(OFF_WTBR, l));
  const int tid = opaque_tid();
  const int lane = tid & 63, wid = tid >> 6, wm = wid >> 1, wn = wid & 1;
  for (int t = blockIdx.x; t < tile_count(128, 8); t += gridDim.x) {
    int mt, nt;
    if (!tile_map(t, 8, mt, nt)) continue;
    f32x4 accm[4][4];
    zero_acc<128>(accm);
    f32x4 a1[4][4];
    zero_acc<128>(a1);
    uint2 sg[4][4];
#pragma unroll
    for (int mi = 0; mi < 4; ++mi)
#pragma unroll
      for (int ni = 0; ni < 4; ++ni) sg[mi][ni] = uint2{0u, 0u};
#pragma unroll 1
    for (int sub = 0; sub < 8; ++sub) {
      const int kb = sub >> 1, which = sub & 1;
      const int ycol = (kb == 0) ? (ZHG + 1024) : (kb == 1) ? (ZRW + 1024) : (kb == 2) ? (ZMB + 1024) : ZMB;
      const bf16_t* Ap = which ? (const bf16_t*)(Z + ycol) : U;
      const int ldap = which ? ZS : 1024;
      const bf16_t* Bp = which ? (Wb + (size_t)kb * 1024 * 512) : (Wg + (size_t)kb * 1024 * 1024);
      const int Kp = which ? 512 : 1024;
      gemm_mainloop_glds<128>(a1, Ap, ldap, mt * 128, Bp, Kp, nt * 128, 1023, Kp, smem, tid);
      if (which == 0) {
#pragma unroll
        for (int mi = 0; mi < 4; ++mi)
#pragma unroll
          for (int ni = 0; ni < 4; ++ni) {
            sg[mi][ni].x = pack2(fsigmoid(a1[mi][ni][0]), fsigmoid(a1[mi][ni][1]));
            sg[mi][ni].y = pack2(fsigmoid(a1[mi][ni][2]), fsigmoid(a1[mi][ni][3]));
            a1[mi][ni] = f32x4{0.f, 0.f, 0.f, 0.f};
          }
      } else {
#pragma unroll
        for (int mi = 0; mi < 4; ++mi)
#pragma unroll
          for (int ni = 0; ni < 4; ++ni) {
            accm[mi][ni][0] = fmaf(bf2f((bf16_t)(sg[mi][ni].x & 0xffff)), a1[mi][ni][0], accm[mi][ni][0]);
            accm[mi][ni][1] = fmaf(bf2f((bf16_t)(sg[mi][ni].x >> 16)), a1[mi][ni][1], accm[mi][ni][1]);
            accm[mi][ni][2] = fmaf(bf2f((bf16_t)(sg[mi][ni].y & 0xffff)), a1[mi][ni][2], accm[mi][ni][2]);
            accm[mi][ni][3] = fmaf(bf2f((bf16_t)(sg[mi][ni].y >> 16)), a1[mi][ni][3], accm[mi][ni][3]);
            a1[mi][ni] = f32x4{0.f, 0.f, 0.f, 0.f};
          }
      }
    }
#pragma unroll
    for (int mi = 0; mi < 4; ++mi)
#pragma unroll
      for (int np = 0; np < 2; ++np) {
        const int colb = nt * 128 + wn * 64 + np * 32;
        const int row = mt * 128 + wm * 64 + mi * 16 + (lane & 15);
        uint2 a, b;
        a.x = pack2(accm[mi][2 * np][0], accm[mi][2 * np][1]);
        a.y = pack2(accm[mi][2 * np][2], accm[mi][2 * np][3]);
        b.x = pack2(accm[mi][2 * np + 1][0], accm[mi][2 * np + 1][1]);
        b.y = pack2(accm[mi][2 * np + 1][2], accm[mi][2 * np + 1][3]);
        store_pair_bf16(Z + (size_t)row * ZS + colb, lane, a, b);
      }
  }
}

__device__ void phase_resid_gemm(const Params& p, const bf16_t* A, int lda, const bf16_t* Wt, int K, const float* xold, char* smem) {
  const int tid = opaque_tid();
  const int lane = tid & 63, wid = tid >> 6, wm = wid >> 1, wn = wid & 1;
  for (int t = blockIdx.x; t < tile_count(64, 8); t += gridDim.x) {
    int mt, nt;
    if (!tile_map(t, 8, mt, nt)) continue;
    f32x4 acc[8][4];
    zero_acc_big(acc);
    gemm_mainloop_big(acc, A, lda, mt * 256, Wt, K, nt * 128, 1023, K, smem, tid);
#pragma unroll
    for (int mi = 0; mi < 8; ++mi)
#pragma unroll
      for (int ni = 0; ni < 4; ++ni) {
        int col = nt * 128 + wn * 64 + ni * 16 + (lane >> 4) * 4;
        int row = mt * 256 + wm * 128 + mi * 16 + (lane & 15);
        size_t o = (size_t)row * DM + col;
        float4 xo = *reinterpret_cast<const float4*>(xold + o);
        float4 r = float4{xo.x + acc[mi][ni][0], xo.y + acc[mi][ni][1], xo.z + acc[mi][ni][2], xo.w + acc[mi][ni][3]};
        *reinterpret_cast<float4*>(p.out + o) = r;
      }
  }
}

__device__ void phase_ffn_in(const Params& p, int l, char* smem) {
  const bf16_t* U = (const bf16_t*)(p.ws + OFF_U);
  const bf16_t* Wt = (const bf16_t*)(p.ws + WOFF(OFF_WTF1, l));
  bf16_t* H = (bf16_t*)(p.ws + OFF_Z);
  const int tid = opaque_tid();
  const int lane = tid & 63, wid = tid >> 6, wm = wid >> 1, wn = wid & 1;
  for (int t = blockIdx.x; t < tile_count(64, 44); t += gridDim.x) {
    int mt, nt;
    if (!tile_map(t, 44, mt, nt)) continue;
    f32x4 acc[8][4];
    zero_acc_big(acc);
    gemm_mainloop_big(acc, U, 1024, mt * 256, Wt, 1024, nt * 128, 5631, 1024, smem, tid);
#pragma unroll
    for (int mi = 0; mi < 8; ++mi) {
      const int hcolb = (nt * 128 + wn * 64) >> 1;
      const int row = mt * 256 + wm * 128 + mi * 16 + (lane & 15);
      uint2 o0, o1;
      o0.x = pack2(fsilu(acc[mi][0][0]) * acc[mi][1][0], fsilu(acc[mi][0][1]) * acc[mi][1][1]);
      o0.y = pack2(fsilu(acc[mi][0][2]) * acc[mi][1][2], fsilu(acc[mi][0][3]) * acc[mi][1][3]);
      o1.x = pack2(fsilu(acc[mi][2][0]) * acc[mi][3][0], fsilu(acc[mi][2][1]) * acc[mi][3][1]);
      o1.y = pack2(fsilu(acc[mi][2][2]) * acc[mi][3][2], fsilu(acc[mi][2][3]) * acc[mi][3][3]);
      store_pair_bf16(H + (size_t)row * FFH + hcolb, lane, o0, o1);
    }
  }
}

__device__ void phase_final(const Params& p) {
  const int tid = opaque_tid();
  const int lane = tid & 63;
  const float* w = p.in[I_NORM_FINAL];
  for (int t = blockIdx.x; t < T_TOK / 4; t += gridDim.x) {
    int row = t * 4 + (tid >> 6);
    float* x = p.out + (size_t)row * DM;
    float4 v[4];
    float ss = 0.f;
#pragma unroll
    for (int i = 0; i < 4; ++i) {
      v[i] = *reinterpret_cast<const float4*>(x + i * 256 + lane * 4);
      ss += v[i].x * v[i].x + v[i].y * v[i].y + v[i].z * v[i].z + v[i].w * v[i].w;
    }
    ss = sum64(ss);
    float rstd = rsqrtf(ss * (1.f / 1024.f) + 1e-6f);
#pragma unroll
    for (int i = 0; i < 4; ++i) {
      float4 ww = *reinterpret_cast<const float4*>(w + i * 256 + lane * 4);
      float4 o = float4{v[i].x * rstd * ww.x, v[i].y * rstd * ww.y, v[i].z * rstd * ww.z, v[i].w * rstd * ww.w};
      *reinterpret_cast<float4*>(x + i * 256 + lane * 4) = o;
    }
  }
}

template <int SUB>
__device__ __forceinline__ void run_phase(const Params& p, int l, char* smem) {
  if (SUB == 0) phase_convert_norm(p, l, smem);
  else if (SUB == 1) phase_inproj(p, smem);
  else if (SUB == 2) phase_rwprep(p, l, smem);
  else if (SUB == 3) phase_scans(p, l, smem);
  else if (SUB == 4) phase_post(p, l, smem);
  else if (SUB == 5) phase_merge(p, l, smem);
  else if (SUB == 6) phase_resid_gemm(p, (const bf16_t*)(p.ws + OFF_Z), ZS, (const bf16_t*)(p.ws + WOFF(OFF_WTOUT, l)), 1024,
                                      (l == 0) ? p.in[I_X] : p.out, smem);
  else if (SUB == 7) phase_norm_only(p, p.out, p.in[I_NORM_FFN] + l * DM);
  else if (SUB == 8) phase_ffn_in(p, l, smem);
  else if (SUB == 9) phase_resid_gemm(p, (const bf16_t*)(p.ws + OFF_Z), FFH, (const bf16_t*)(p.ws + WOFF(OFF_WTF2, l)), FFH, p.out, smem);
  else phase_final(p);
}

#ifndef PHM
#define PHM 0xFFFF
#endif
#define XB_TMO      128
#define XB_XCNT(j)  (256  + 64 * (j))
#define XB_XSUB(j)  (1280 + 64 * (j))
#define XB_XGEN(j)  (2304 + 64 * (j))
#define XB_TOP      3328
#define XB_TOPGEN   3392
#define XCD_BAR_WORDS 3456
#define XB_SPIN_CAP (1u << 18)
#define LAS __attribute__((address_space(3)))

__device__ __forceinline__ unsigned xb_ld(unsigned* p)              { return __hip_atomic_load(p, __ATOMIC_RELAXED, __HIP_MEMORY_SCOPE_AGENT); }
__device__ __forceinline__ unsigned xb_add(unsigned* p, unsigned v) { return __hip_atomic_fetch_add(p, v, __ATOMIC_RELAXED, __HIP_MEMORY_SCOPE_AGENT); }
__device__ __forceinline__ unsigned xb_xcc_id() { return (unsigned)__builtin_amdgcn_s_getreg((3 << 11) | 20) & 0xFu; }
#define XB_SPIN(cond, bar) do { unsigned _sp = 0; while (cond) { __builtin_amdgcn_s_sleep(1); \
    if ((++_sp & 255u) == 0u) { if (xb_ld(&(bar)[XB_TMO])) break; if (_sp > XB_SPIN_CAP) { atomicAdd(&(bar)[XB_TMO], 1u); break; } } } } while (0)

struct XcdBarrier {
    unsigned* bar; unsigned x;
    volatile LAS unsigned* st;
};

__device__ __forceinline__ XcdBarrier xcd_barrier_post(unsigned* bar, volatile LAS unsigned* st) {
    XcdBarrier b; b.bar = bar; b.x = xb_xcc_id(); b.st = st;
    if (threadIdx.x == 0) (void)xb_add(&bar[XB_XCNT(b.x)], 1u);
    return b;
}
__device__ __forceinline__ void xcd_barrier_complete(unsigned* bar, unsigned x, unsigned& nloc, unsigned& nx) {
    const unsigned G = gridDim.x * gridDim.y * gridDim.z;
    unsigned sum, cnt, mine, sp = 0u;
    for (;;) {
        sum = 0u; cnt = 0u; mine = 0u;
#pragma unroll
        for (unsigned j = 0; j < 16; ++j) { const unsigned c = xb_ld(&bar[XB_XCNT(j)]); sum += c; cnt += (c > 0u) ? 1u : 0u; mine = (j == x) ? c : mine; }
        if (sum == G) break;
        __builtin_amdgcn_s_sleep(1);
        if ((++sp & 255u) == 0u) { if (xb_ld(&bar[XB_TMO])) break; if (sp > XB_SPIN_CAP) { atomicAdd(&bar[XB_TMO], 1u); break; } }
    }
    nloc = mine > 0u ? mine : 1u; nx = cnt > 0u ? cnt : 1u;
}

__device__ __forceinline__ void xcd_barrier(const XcdBarrier& b) {
    asm volatile("s_waitcnt vmcnt(0)" ::: "memory");
    __syncthreads();
    if (threadIdx.x == 0) {
        unsigned* bar = b.bar;
        __builtin_amdgcn_s_waitcnt(0);
        unsigned nloc = b.st[0], nx = b.st[1];
        if (nloc == 0u) { xcd_barrier_complete(bar, b.x, nloc, nx); b.st[0] = nloc; b.st[1] = nx; }
        const unsigned old = xb_add(&bar[XB_XSUB(b.x)], 1u);
        const unsigned gen = old / nloc;
        if (old + 1u == (gen + 1u) * nloc) {
            __builtin_amdgcn_fence(__ATOMIC_RELEASE, "agent");
            asm volatile("s_waitcnt vmcnt(0)" ::: "memory");
            const unsigned og = xb_add(&bar[XB_TOP], 1u);
            const unsigned tg = og / nx;
            if (og + 1u == (tg + 1u) * nx) xb_add(&bar[XB_TOPGEN], 1u);
            else XB_SPIN(xb_ld(&bar[XB_TOPGEN]) == tg, bar);
            __builtin_amdgcn_fence(__ATOMIC_ACQUIRE, "agent");
            xb_add(&bar[XB_XGEN(b.x)], 1u);
            asm volatile("s_waitcnt vmcnt(0)" ::: "memory");
        } else {
            XB_SPIN(xb_ld(&bar[XB_XGEN(b.x)]) == gen, bar);
            __builtin_amdgcn_fence(__ATOMIC_ACQUIRE, "agent");
            asm volatile("s_waitcnt vmcnt(0)" ::: "memory");
        }
    }
    __syncthreads();
}


constexpr int LDS_MAIN = 73728;
constexpr int LDS_BYTES = LDS_MAIN + 16;

#if COOP
__global__ void __launch_bounds__(256, 2) fwd_kernel(Params p, int ph0, int ph1, int scan_mask) {
  extern __shared__ __attribute__((aligned(16))) char smem[];
  cg::grid_group grid = cg::this_grid();
  volatile LAS unsigned* xb_st = (volatile LAS unsigned*)(smem + LDS_MAIN);
  if (threadIdx.x == 0) { xb_st[0] = 0u; xb_st[1] = 0u; xb_st[2] = 0u; xb_st[3] = 0u; }
  __syncthreads();
  XcdBarrier xbar = xcd_barrier_post(reinterpret_cast<unsigned*>(p.ws + OFF_BAR), xb_st);
  for (int ph = ph0; ph < ph1; ++ph) {
    if (ph == NPHASES - 1) {
      phase_final(p);
    } else {
      const int l = ph / NPH_LAYER, sub = ph % NPH_LAYER;
      switch (sub) {
        case 0: if (PHM & (1<<0)) run_phase<0>(p, l, smem); break;
        case 1: if (PHM & (1<<1)) run_phase<1>(p, l, smem); break;
        case 2: if (PHM & (1<<2)) run_phase<2>(p, l, smem); break;
        case 3: if (PHM & (1<<3)) phase_scans(p, l, smem, scan_mask); break;
        case 4: if (PHM & (1<<4)) run_phase<4>(p, l, smem); break;
        case 5: if (PHM & (1<<5)) run_phase<5>(p, l, smem); break;
        case 6: if (PHM & (1<<6)) run_phase<6>(p, l, smem); break;
        case 7: if (PHM & (1<<7)) run_phase<7>(p, l, smem); break;
        case 8: if (PHM & (1<<8)) run_phase<8>(p, l, smem); break;
        case 9: if (PHM & (1<<9)) run_phase<9>(p, l, smem); break;
      }
    }
    if (ph + 1 < ph1) {
      if (ph1 > 1000) grid.sync();
      else xcd_barrier(xbar);
    }
  }
}
#else
template <int SUB>
__global__ void __launch_bounds__(256, 2) k_phase(Params p, int l) {
  __shared__ __attribute__((aligned(16))) char smem[65536];
  run_phase<SUB>(p, l, smem);
}
#endif

extern "C" void kernel_launch(void* const* d_in, const int* in_sizes, int n_in, void* d_out, int out_size, void* d_ws,
                              size_t ws_size, hipStream_t stream) {
  if (n_in < 41 || ws_size < WS_NEED) {
    fprintf(stderr, "kernel_launch: bad args n_in=%d ws=%zu need=%zu\n", n_in, ws_size, (size_t)WS_NEED);
    return;
  }
  Params p{};
  for (int i = 0; i < 41; ++i) p.in[i] = (const float*)d_in[i];
  p.out = (float*)d_out;
  p.ws = (char*)d_ws;
#if COOP
  static int grid_blocks = 0;
  if (!grid_blocks) {
    int dev = 0, cus = 0, per_cu = 0;
    hipGetDevice(&dev);
    hipDeviceGetAttribute(&cus, hipDeviceAttributeMultiprocessorCount, dev);
    hipFuncSetAttribute((const void*)fwd_kernel, hipFuncAttributeMaxDynamicSharedMemorySize, LDS_BYTES);
    hipOccupancyMaxActiveBlocksPerMultiprocessor(&per_cu, fwd_kernel, 256, LDS_BYTES);
    if (per_cu > 2) per_cu = 2;
    grid_blocks = cus * per_cu;
  }
#ifdef HYBRID
  for (int ph = 0; ph < NPHASES; ++ph) {
    if (ph % 10 == 3 && ph < 20) {
      const int groups[4] = SCAN_GROUPS;
      for (int gi = 0; gi < 4; ++gi) if (groups[gi]) fwd_kernel<<<grid_blocks, 256, LDS_BYTES, stream>>>(p, ph, ph + 1, groups[gi]);
    } else {
      fwd_kernel<<<grid_blocks, 256, LDS_BYTES, stream>>>(p, ph, ph + 1, 15);
    }
  }
#else
  hipMemsetAsync((char*)d_ws + OFF_BAR, 0, XCD_BAR_WORDS * 4, stream);
  int ph0 = 0, ph1 = NPHASES, smask = 15;
  void* args[] = {&p, &ph0, &ph1, &smask};
  hipError_t e = hipLaunchCooperativeKernel((void*)fwd_kernel, dim3(grid_blocks), dim3(256), args, LDS_BYTES, stream);
  if (e != hipSuccess) fprintf(stderr, "cooperative launch failed: %s (grid %d)\n", hipGetErrorString(e), grid_blocks);
#endif
#else
  const dim3 g(512), b(256);
  for (int l = 0; l < 2; ++l) {
    k_phase<0><<<g, b, 0, stream>>>(p, l);
    k_phase<1><<<g, b, 0, stream>>>(p, l);
    k_phase<2><<<g, b, 0, stream>>>(p, l);
    k_phase<3><<<g, b, 0, stream>>>(p, l);
    k_phase<4><<<g, b, 0, stream>>>(p, l);
    k_phase<5><<<g, b, 0, stream>>>(p, l);
    k_phase<6><<<g, b, 0, stream>>>(p, l);
    k_phase<7><<<g, b, 0, stream>>>(p, l);
    k_phase<8><<<g, b, 0, stream>>>(p, l);
    k_phase<9><<<g, b, 0, stream>>>(p, l);
  }
  k_phase<10><<<g, b, 0, stream>>>(p, 0);
#endif
}
```

```cpp
#include <hip/hip_runtime.h>
#include <hip/hip_cooperative_groups.h>
#include <cstdio>
#include <cstdint>
namespace cg = cooperative_groups;

#ifndef COOP
#define COOP 1
#endif

#define LAS __attribute__((address_space(3)))
typedef unsigned short bf16_t;
typedef __attribute__((ext_vector_type(8))) short bf16x8;
typedef __attribute__((ext_vector_type(4))) float f32x4;
typedef __attribute__((ext_vector_type(4))) unsigned u32x4;

constexpr int T_TOK = 16384, SEQ = 2048, DM = 1024;
constexpr int IN_COLS = 9992, NZ = 5896, ZS = 5904;
constexpr int ZHG = 0, ZRW = 2048, ZS5 = 3840, ZMB = 4352;
constexpr int FFH = 2816;
constexpr int NPH_LAYER = 10, NPHASES = 21;

constexpr size_t OFF_WTIN   = 0;
constexpr size_t OFF_WTGATE = OFF_WTIN + (size_t)5896 * 1024 * 2;
constexpr size_t OFF_WTBR   = OFF_WTGATE + (size_t)4096 * 1024 * 2;
constexpr size_t OFF_WTOUT  = OFF_WTBR + (size_t)4 * 1024 * 512 * 2;
constexpr size_t OFF_WTF1   = OFF_WTOUT + (size_t)1024 * 1024 * 2;
constexpr size_t OFF_WTF2   = OFF_WTF1 + (size_t)5632 * 1024 * 2;
constexpr size_t OFF_WTGLU  = OFF_WTF2 + (size_t)1024 * 2816 * 2;
constexpr size_t OFF_U      = OFF_WTGLU + (size_t)512 * 512 * 2;
constexpr size_t OFF_Z      = OFF_U + (size_t)T_TOK * 1024 * 2;
constexpr size_t OFF_VF     = OFF_Z + (size_t)T_TOK * ZS * 2;
constexpr size_t OFF_BAR    = OFF_VF + (size_t)T_TOK * 512 * 2;
constexpr size_t OFF_WTGATE_B = OFF_BAR + 16384;
constexpr size_t OFF_WB_B     = OFF_WTGATE_B + (size_t)4096 * 1024 * 2;
constexpr size_t OFF_LORA     = OFF_WB_B + (OFF_U - OFF_WTBR);
constexpr size_t LORA_STRIDE  = 524288;
constexpr size_t LO_G2 = 0, LO_W2 = 131072, LO_A2 = 196608, LO_V1 = 262144, LO_V2 = 294912;
constexpr size_t WS_NEED      = OFF_LORA + 2 * LORA_STRIDE;
constexpr size_t DELTA_GATE   = OFF_WTGATE_B - OFF_WTGATE;
constexpr size_t DELTA_WB     = OFF_WB_B - OFF_WTBR;
#define WOFF_GATE(l) (OFF_WTGATE + (size_t)(l) * DELTA_GATE)
#define WOFF(off, l) ((off) + (size_t)(l) * DELTA_WB)

struct Params {
  const float* in[41];
  float* out;
  char* ws;
};

enum { I_X = 0, I_NORM_MIX, I_W_IN, I_W_BRANCH, I_W_OUT, I_NORM_FFN, I_W_FFN_IN, I_W_FFN_OUT, I_NORM_FINAL,
       I_HG_LB, I_HG_NW, I_RW_MU, I_RW_W0, I_RW_W2, I_RW_A0, I_RW_A2, I_RW_G2, I_RW_KK, I_RW_KA, I_RW_RK,
       I_RW_LNW, I_RW_LNB, I_RW_V0, I_RW_V1, I_RW_V2, I_S5_ARE, I_S5_AIM, I_S5_BRE, I_S5_BIM, I_S5_CRE,
       I_S5_CIM, I_S5_D, I_S5_LOGDT, I_S5_WGLU, I_S5_BGLU, I_MB_CONVW, I_MB_CONVB, I_MB_DTB, I_MB_ALOG,
       I_MB_D, I_MB_NW };

__device__ __forceinline__ float bf2f(bf16_t v) { return __uint_as_float(((unsigned)v) << 16); }
typedef __attribute__((ext_vector_type(2))) __bf16 bf16x2_t;
__device__ __forceinline__ unsigned pack2(float a, float b) {
  bf16x2_t v;
  v[0] = (__bf16)a;
  v[1] = (__bf16)b;
  return __builtin_bit_cast(unsigned, v);
}
__device__ __forceinline__ bf16_t f2bf(float f) { return (bf16_t)(pack2(f, 0.f) & 0xffffu); }
__device__ __forceinline__ void store_pair_bf16(bf16_t* p_sub0, const int lane, uint2 a, uint2 b, const bool ok = true) {
  auto rx = __builtin_amdgcn_permlane16_swap(a.x, b.x, false, false);
  auto ry = __builtin_amdgcn_permlane16_swap(a.y, b.y, false, false);
  const int off = ((lane >> 4) & 1) * 16 + (lane >> 5) * 8;
  if (ok) *reinterpret_cast<uint4*>(p_sub0 + off) = uint4{(unsigned)rx[0], (unsigned)ry[0], (unsigned)rx[1], (unsigned)ry[1]};
}
__device__ __forceinline__ float sigmoidf_(float x) { return 1.f / (1.f + __expf(-x)); }
__device__ __forceinline__ float siluf_(float x) { return x / (1.f + __expf(-x)); }
__device__ __forceinline__ float softplusf_(float x) { return x > 20.f ? x : log1pf(__expf(x)); }
__device__ __forceinline__ float gelu_tanh(float x) {
  float u = 0.7978845608028654f * (x + 0.044715f * x * x * x);
  return 0.5f * x * (1.f + tanhf(u));
}
__device__ __forceinline__ float frcp(float x) { return __builtin_amdgcn_rcpf(x); }
__device__ __forceinline__ float fsigmoid(float x) { return frcp(1.f + __expf(-x)); }
__device__ __forceinline__ float fsilu(float x) { return x * frcp(1.f + __expf(-x)); }
__device__ __forceinline__ float fsoftplus(float x) { return x > 20.f ? x : __logf(1.f + __expf(x)); }
__device__ __forceinline__ float ftanh(float x) {
  float e = __expf(2.f * fminf(fmaxf(x, -15.f), 15.f));
  return (e - 1.f) * frcp(e + 1.f);
}
__device__ __forceinline__ float fgelu(float x) {
  float u = 0.7978845608028654f * (x + 0.044715f * x * x * x);
  return 0.5f * x * (1.f + ftanh(u));
}

__device__ __forceinline__ float quad_sum(float x) {
  x += __builtin_bit_cast(float, __builtin_amdgcn_update_dpp(0, __builtin_bit_cast(int, x), 0xB1, 0xF, 0xF, true));
  x += __builtin_bit_cast(float, __builtin_amdgcn_update_dpp(0, __builtin_bit_cast(int, x), 0x4E, 0xF, 0xF, true));
  return x;
}
__device__ __forceinline__ float oct_sum(float x) {
  x = quad_sum(x);
  x += __builtin_bit_cast(float, __builtin_amdgcn_update_dpp(0, __builtin_bit_cast(int, x), 0x141, 0xF, 0xF, true));
  return x;
}
__device__ __forceinline__ float sum16(float x) {
  x += __shfl_xor(x, 1); x += __shfl_xor(x, 2); x += __shfl_xor(x, 4); x += __shfl_xor(x, 8);
  return x;
}
__device__ __forceinline__ float sum64(float x) {
  x = sum16(x); x += __shfl_xor(x, 16); x += __shfl_xor(x, 32);
  return x;
}

__device__ __forceinline__ int opaque_tid() {
  int t = threadIdx.x;
  asm volatile("" : "+v"(t));
  return t;
}

template <int BN>
__device__ __forceinline__ void gemm_mainloop(f32x4 (&acc)[4][BN / 32], const bf16_t* A, int lda, int m0,
                                              const bf16_t* Bt, int ldb, int n0, int nmax, int K, char* smem, const int tid) {
  const int lane = tid & 63, wid = tid >> 6, wm = wid >> 1, wn = wid & 1;
  const int q = tid & 7, r0 = tid >> 3;
  unsigned offA[4], offB[BN / 32];
#pragma unroll
  for (int i = 0; i < 4; ++i) offA[i] = ((unsigned)(m0 + r0 + 32 * i) * (unsigned)lda + (unsigned)q * 8u) * 2u;
#pragma unroll
  for (int i = 0; i < BN / 32; ++i) {
    int row = n0 + r0 + 32 * i;
    row = row < nmax ? row : nmax;
    offB[i] = ((unsigned)row * (unsigned)ldb + (unsigned)q * 8u) * 2u;
  }
  const unsigned sto = (unsigned)r0 * 128u + (unsigned)((q ^ ((r0 >> 1) & 7)) << 4);
  unsigned aoff[4], boff[BN / 32];
#pragma unroll
  for (int mi = 0; mi < 4; ++mi) {
    int row = wm * 64 + mi * 16 + (lane & 15);
    aoff[mi] = (unsigned)row * 128u + (unsigned)(((lane >> 4) ^ ((row >> 1) & 7)) << 4);
  }
#pragma unroll
  for (int ni = 0; ni < BN / 32; ++ni) {
    int row = wn * (BN / 2) + ni * 16 + (lane & 15);
    boff[ni] = (unsigned)row * 128u + (unsigned)(((lane >> 4) ^ ((row >> 1) & 7)) << 4);
  }
  const char* Ab = reinterpret_cast<const char*>(A);
  const char* Bb = reinterpret_cast<const char*>(Bt);
  const int nk = K >> 6;
  constexpr bool WIDE = (BN == 128);
  u32x4 Ra0, Ra1, Ra2, Ra3, Rb0, Rb1, Rb2, Rb3;
  u32x4 Qa0, Qa1, Qa2, Qa3, Qb0, Qb1, Qb2, Qb3;
#define GLOAD(P, TILE)                                                         \
  {                                                                            \
    const char* Ak_ = Ab + (size_t)(TILE) * 128;                               \
    const char* Bk_ = Bb + (size_t)(TILE) * 128;                               \
    P##a0 = *reinterpret_cast<const u32x4*>(Ak_ + offA[0]);                    \
    P##a1 = *reinterpret_cast<const u32x4*>(Ak_ + offA[1]);                    \
    P##a2 = *reinterpret_cast<const u32x4*>(Ak_ + offA[2]);                    \
    P##a3 = *reinterpret_cast<const u32x4*>(Ak_ + offA[3]);                    \
    P##b0 = *reinterpret_cast<const u32x4*>(Bk_ + offB[0]);                    \
    P##b1 = *reinterpret_cast<const u32x4*>(Bk_ + offB[1]);                    \
    if (WIDE) {                                                                \
      P##b2 = *reinterpret_cast<const u32x4*>(Bk_ + offB[BN / 32 - 2]);        \
      P##b3 = *reinterpret_cast<const u32x4*>(Bk_ + offB[BN / 32 - 1]);        \
    }                                                                          \
  }
#define SSTORE(P, BUF)                                                         \
  {                                                                            \
    char* ad_ = smem + (BUF) * 16384 + sto;                                    \
    char* bd_ = smem + 32768 + (BUF) * (BN * 128) + sto;                       \
    *reinterpret_cast<u32x4*>(ad_) = P##a0;                                    \
    *reinterpret_cast<u32x4*>(ad_ + 4096) = P##a1;                             \
    *reinterpret_cast<u32x4*>(ad_ + 8192) = P##a2;                             \
    *reinterpret_cast<u32x4*>(ad_ + 12288) = P##a3;                            \
    *reinterpret_cast<u32x4*>(bd_) = P##b0;                                    \
    *reinterpret_cast<u32x4*>(bd_ + 4096) = P##b1;                             \
    if (WIDE) {                                                                \
      *reinterpret_cast<u32x4*>(bd_ + 8192) = P##b2;                           \
      *reinterpret_cast<u32x4*>(bd_ + 12288) = P##b3;                          \
    }                                                                          \
  }
#define COMPUTE(BUF)                                                           \
  {                                                                            \
    const char* a_s = smem + (BUF) * 16384;                                    \
    const char* b_s = smem + 32768 + (BUF) * (BN * 128);                       \
    _Pragma("unroll") for (int ks = 0; ks < 2; ++ks) {                         \
      bf16x8 af[4], bfr[BN / 32];                                              \
      _Pragma("unroll") for (int mi = 0; mi < 4; ++mi)                         \
          af[mi] = *reinterpret_cast<const bf16x8*>(a_s + (aoff[mi] ^ (ks * 64)));       \
      _Pragma("unroll") for (int ni = 0; ni < BN / 32; ++ni)                   \
          bfr[ni] = *reinterpret_cast<const bf16x8*>(b_s + (boff[ni] ^ (ks * 64)));      \
      _Pragma("unroll") for (int mi = 0; mi < 4; ++mi)                         \
        _Pragma("unroll") for (int ni = 0; ni < BN / 32; ++ni)                 \
          acc[mi][ni] = __builtin_amdgcn_mfma_f32_16x16x32_bf16(bfr[ni], af[mi], acc[mi][ni], 0, 0, 0); \
    }                                                                          \
  }
  if constexpr (WIDE && false) {
    GLOAD(R, 0);
    SSTORE(R, 0);
    GLOAD(R, 1);
    if (nk > 2) GLOAD(Q, 2);
    __syncthreads();
#pragma unroll 1
    for (int kt = 0; kt < nk; kt += 2) {
      __builtin_amdgcn_sched_barrier(0);
      COMPUTE(0);
      __builtin_amdgcn_sched_barrier(0);
      SSTORE(R, 1);
      if (kt + 3 < nk) GLOAD(R, kt + 3);
      __syncthreads();
      __builtin_amdgcn_sched_barrier(0);
      COMPUTE(1);
      __builtin_amdgcn_sched_barrier(0);
      if (kt + 2 < nk) SSTORE(Q, 0);
      if (kt + 4 < nk) GLOAD(Q, kt + 4);
      __syncthreads();
    }
  } else {
    GLOAD(R, 0);
    SSTORE(R, 0);
    __syncthreads();
#pragma unroll 1
    for (int kt = 0; kt < nk; ++kt) {
      const int buf = kt & 1;
      const bool more = (kt + 1 < nk);
      if (more) GLOAD(R, kt + 1);
      __builtin_amdgcn_sched_barrier(0);
      COMPUTE(buf);
      __builtin_amdgcn_sched_barrier(0);
      if (more) SSTORE(R, buf ^ 1);
      __syncthreads();
    }
  }
#undef GLOAD
#undef SSTORE
#undef COMPUTE
}

template <int BN>
__device__ __forceinline__ void zero_acc(f32x4 (&acc)[4][BN / 32]) {
#pragma unroll
  for (int mi = 0; mi < 4; ++mi)
#pragma unroll
    for (int ni = 0; ni < BN / 32; ++ni) acc[mi][ni] = f32x4{0.f, 0.f, 0.f, 0.f};
}

#define RAW_BARRIER() do { asm volatile("s_waitcnt lgkmcnt(0)" ::: "memory"); __builtin_amdgcn_s_barrier(); } while (0)
template <int MROWS>
__device__ __forceinline__ void gemm_mainloop_glds(f32x4 (&acc)[MROWS / 32][4], const bf16_t* A, int lda, int m0, const bf16_t* Bt,
                                                   int ldb, int n0, int nmax, int K, char* smem, const int tid) {
  constexpr int NA = MROWS / 64;
  constexpr int NMI = MROWS / 32;
  constexpr int STAGE = (MROWS + 128) * 64;
  constexpr int BOFF = MROWS * 64;
  const int lane = tid & 63, wid = tid >> 6, wm = wid >> 1, wn = wid & 1;
  unsigned gA[NA], gB[2];
#pragma unroll
  for (int i = 0; i < NA; ++i) {
    const int row = (wid * NA + i) * 16 + (lane >> 2);
    const int q = (lane & 3) ^ ((row >> 2) & 3);
    gA[i] = ((unsigned)(m0 + row) * (unsigned)lda + (unsigned)q * 8u) * 2u;
  }
#pragma unroll
  for (int i = 0; i < 2; ++i) {
    const int row = (wid * 2 + i) * 16 + (lane >> 2);
    const int q = (lane & 3) ^ ((row >> 2) & 3);
    int grow = n0 + row;
    grow = grow < nmax ? grow : nmax;
    gB[i] = ((unsigned)grow * (unsigned)ldb + (unsigned)q * 8u) * 2u;
  }
  unsigned aoff[NMI], boff[4];
#pragma unroll
  for (int mi = 0; mi < NMI; ++mi) {
    int row = wm * (MROWS / 2) + mi * 16 + (lane & 15);
    aoff[mi] = (unsigned)row * 64u + (unsigned)(((lane >> 4) ^ ((row >> 2) & 3)) << 4);
  }
#pragma unroll
  for (int ni = 0; ni < 4; ++ni) {
    int row = wn * 64 + ni * 16 + (lane & 15);
    boff[ni] = (unsigned)BOFF + (unsigned)row * 64u + (unsigned)(((lane >> 4) ^ ((row >> 2) & 3)) << 4);
  }
  const char* Ab = reinterpret_cast<const char*>(A);
  const char* Bb = reinterpret_cast<const char*>(Bt);
  const int nk = K >> 5;
  char* ldsA = smem + wid * (NA * 1024);
  char* ldsB = smem + BOFF + wid * 2048;
#define BG_GLDS(TILE, ST)                                                                                           \
  {                                                                                                                 \
    const char* Ak_ = Ab + (size_t)(TILE) * 64;                                                                     \
    const char* Bk_ = Bb + (size_t)(TILE) * 64;                                                                     \
    char* la_ = ldsA + (ST) * STAGE;                                                                                \
    char* lb_ = ldsB + (ST) * STAGE;                                                                                \
    _Pragma("unroll") for (int i_ = 0; i_ < NA; ++i_)                                                               \
      __builtin_amdgcn_global_load_lds((const unsigned*)(Ak_ + gA[i_]), (LAS unsigned*)(la_ + i_ * 1024), 16, 0, 0); \
    __builtin_amdgcn_global_load_lds((const unsigned*)(Bk_ + gB[0]), (LAS unsigned*)(lb_), 16, 0, 0);              \
    __builtin_amdgcn_global_load_lds((const unsigned*)(Bk_ + gB[1]), (LAS unsigned*)(lb_ + 1024), 16, 0, 0);       \
  }
#define BG_COMPUTE(ST)                                                                                              \
  {                                                                                                                 \
    const char* s_ = smem + (ST) * STAGE;                                                                           \
    bf16x8 bfr[4], af[NMI];                                                                                         \
    _Pragma("unroll") for (int ni = 0; ni < 4; ++ni) bfr[ni] = *reinterpret_cast<const bf16x8*>(s_ + boff[ni]);     \
    _Pragma("unroll") for (int mi = 0; mi < NMI; ++mi) af[mi] = *reinterpret_cast<const bf16x8*>(s_ + aoff[mi]);    \
    __builtin_amdgcn_sched_barrier(0);                                                                              \
    _Pragma("unroll") for (int mi = 0; mi < NMI; ++mi)                                                              \
      _Pragma("unroll") for (int ni = 0; ni < 4; ++ni)                                                              \
        acc[mi][ni] = __builtin_amdgcn_mfma_f32_16x16x32_bf16(bfr[ni], af[mi], acc[mi][ni], 0, 0, 0);               \
  }
  asm volatile("s_waitcnt vmcnt(0)" ::: "memory");
  BG_GLDS(0, 0);
  BG_GLDS(1, 1);
  int st = 0;
#pragma unroll 1
  for (int kt = 0; kt < nk - 1; ++kt) {
    if constexpr (NA == 4) asm volatile("s_waitcnt vmcnt(6)" ::: "memory");
    else asm volatile("s_waitcnt vmcnt(4)" ::: "memory");
    RAW_BARRIER();
    if (kt + 2 < nk) {
      const int st2 = (st >= 1) ? st - 1 : 2;
      BG_GLDS(kt + 2, st2);
    }
    __builtin_amdgcn_sched_barrier(0);
    BG_COMPUTE(st);
    __builtin_amdgcn_sched_barrier(0);
    st = (st == 2) ? 0 : st + 1;
  }
  asm volatile("s_waitcnt vmcnt(0)" ::: "memory");
  RAW_BARRIER();
  BG_COMPUTE(st);
  RAW_BARRIER();
#undef BG_GLDS
#undef BG_COMPUTE
}
__device__ __forceinline__ void gemm_mainloop_big(f32x4 (&acc)[8][4], const bf16_t* A, int lda, int m0, const bf16_t* Bt,
                                                  int ldb, int n0, int nmax, int K, char* smem, const int tid) {
  gemm_mainloop_glds<256>(acc, A, lda, m0, Bt, ldb, n0, nmax, K, smem, tid);
}

__device__ __forceinline__ void zero_acc_big(f32x4 (&acc)[8][4]) {
#pragma unroll
  for (int mi = 0; mi < 8; ++mi)
#pragma unroll
    for (int ni = 0; ni < 4; ++ni) acc[mi][ni] = f32x4{0.f, 0.f, 0.f, 0.f};
}

__device__ __forceinline__ void conv_tile(const float* src, int ld, int nlimit, int k0, int n0, bf16_t* dst, int Kd, int mode,
                                          char* smem, const int tid) {
  float* sT = reinterpret_cast<float*>(smem);
#pragma unroll
  for (int i = 0; i < 16; ++i) {
    int kk = i * 4 + (tid >> 6), nn = tid & 63;
    float v = (n0 + nn < nlimit) ? src[(size_t)(k0 + kk) * ld + n0 + nn] : 0.f;
    sT[kk * 65 + nn] = v;
  }
  __syncthreads();
  {
    int nn = tid >> 2, kq = tid & 3;
    int n = n0 + nn;
    if (n < nlimit) {
      int drow = n;
      if (mode == 1) {
        if (n < FFH) drow = (n >> 4) * 32 + (n & 15);
        else { int j = n - FFH; drow = (j >> 4) * 32 + 16 + (j & 15); }
      }
      unsigned pk[8];
#pragma unroll
      for (int j = 0; j < 8; ++j) pk[j] = pack2(sT[(kq * 16 + 2 * j) * 65 + nn], sT[(kq * 16 + 2 * j + 1) * 65 + nn]);
      uint4* d = reinterpret_cast<uint4*>(dst + (size_t)drow * Kd + k0 + kq * 16);
      d[0] = uint4{pk[0], pk[1], pk[2], pk[3]};
      d[1] = uint4{pk[4], pk[5], pk[6], pk[7]};
    }
  }
  __syncthreads();
}

__device__ __forceinline__ void rmsnorm_row_to_bf16(const float* x, const float* w, bf16_t* out, const int lane) {
  float4 v[4];
  float ss = 0.f;
#pragma unroll
  for (int i = 0; i < 4; ++i) {
    v[i] = *reinterpret_cast<const float4*>(x + i * 256 + lane * 4);
    ss += v[i].x * v[i].x + v[i].y * v[i].y + v[i].z * v[i].z + v[i].w * v[i].w;
  }
  ss = sum64(ss);
  float rstd = rsqrtf(ss * (1.f / 1024.f) + 1e-6f);
#pragma unroll
  for (int i = 0; i < 4; ++i) {
    float4 ww = *reinterpret_cast<const float4*>(w + i * 256 + lane * 4);
    uint2 o;
    o.x = pack2(v[i].x * rstd * ww.x, v[i].y * rstd * ww.y);
    o.y = pack2(v[i].z * rstd * ww.z, v[i].w * rstd * ww.w);
    *reinterpret_cast<uint2*>(out + i * 256 + lane * 4) = o;
  }
}

constexpr int CT_IN = 157 * 16, CT_BR = 512, CT_OUT = 256, CT_F1 = 88 * 16, CT_F2 = 44 * 16, CT_GLU = 64;
constexpr int CT_TOTAL = CT_IN + CT_BR + CT_OUT + CT_F1 + CT_F2 + CT_GLU;

__device__ __forceinline__ void convert_one(const Params& p, int l, int c, char* smem, const int tid) {
  char* ws = p.ws;
  if (c < CT_IN) {
    int nt = c >> 4, kt = c & 15;
    const float* src = p.in[I_W_IN] + (size_t)l * 1024 * IN_COLS;
    if (nt < 64) conv_tile(src, IN_COLS, IN_COLS, kt * 64, nt * 64, (bf16_t*)(ws + WOFF_GATE(l)), 1024, 0, smem, tid);
    else conv_tile(src + 4096, IN_COLS, IN_COLS - 4096, kt * 64, (nt - 64) * 64, (bf16_t*)(ws + OFF_WTIN), 1024, 0, smem, tid);
    return;
  }
  c -= CT_IN;
  if (c < CT_BR) {
    int kb = c >> 7, r = c & 127, nt = r >> 3, kt = r & 7;
    const float* src = p.in[I_W_BRANCH] + ((size_t)l * 4 + kb) * 512 * 1024;
    conv_tile(src, 1024, 1024, kt * 64, nt * 64, (bf16_t*)(ws + WOFF(OFF_WTBR, l)) + (size_t)kb * 1024 * 512, 512, 0, smem, tid);
    return;
  }
  c -= CT_BR;
  if (c < CT_OUT) {
    int nt = c >> 4, kt = c & 15;
    conv_tile(p.in[I_W_OUT] + (size_t)l * 1024 * 1024, 1024, 1024, kt * 64, nt * 64, (bf16_t*)(ws + WOFF(OFF_WTOUT, l)), 1024, 0, smem, tid);
    return;
  }
  c -= CT_OUT;
  if (c < CT_F1) {
    int nt = c >> 4, kt = c & 15;
    conv_tile(p.in[I_W_FFN_IN] + (size_t)l * 1024 * 5632, 5632, 5632, kt * 64, nt * 64, (bf16_t*)(ws + WOFF(OFF_WTF1, l)), 1024, 1, smem, tid);
    return;
  }
  c -= CT_F1;
  if (c < CT_F2) {
    int nt = c / 44, kt = c % 44;
    conv_tile(p.in[I_W_FFN_OUT] + (size_t)l * FFH * 1024, 1024, 1024, kt * 64, nt * 64, (bf16_t*)(ws + WOFF(OFF_WTF2, l)), FFH, 0, smem, tid);
    return;
  }
  c -= CT_F2;
  {
    int nt = c >> 3, kt = c & 7;
    conv_tile(p.in[I_S5_WGLU] + (size_t)l * 512 * 512, 512, 512, kt * 64, nt * 64, (bf16_t*)(ws + WOFF(OFF_WTGLU, l)), 512, 0, smem, tid);
  }
}

constexpr int CT_LORA = 41;
__device__ __forceinline__ void convert_lora(const Params& p, int l, int c, char* smem, const int tid) {
  char* lo = p.ws + OFF_LORA + (size_t)l * LORA_STRIDE;
  if (c < 16) { int nt = c >> 1, kt = c & 1;
    conv_tile(p.in[I_RW_G2] + (size_t)l * 128 * 512, 512, 512, kt * 64, nt * 64, (bf16_t*)(lo + LO_G2), 128, 0, smem, tid); return; }
  c -= 16;
  if (c < 8) { conv_tile(p.in[I_RW_W2] + (size_t)l * 64 * 512, 512, 512, 0, c * 64, (bf16_t*)(lo + LO_W2), 64, 0, smem, tid); return; }
  c -= 8;
  if (c < 8) { conv_tile(p.in[I_RW_A2] + (size_t)l * 64 * 512, 512, 512, 0, c * 64, (bf16_t*)(lo + LO_A2), 64, 0, smem, tid); return; }
  c -= 8;
  if (l == 0) return;
  if (c < 8) { conv_tile(p.in[I_RW_V1] + (size_t)(l - 1) * 512 * 32, 32, 32, c * 64, 0, (bf16_t*)(lo + LO_V1), 512, 0, smem, tid); return; }
  {
    const float* src = p.in[I_RW_V2] + (size_t)(l - 1) * 32 * 512;
    bf16_t* dst = (bf16_t*)(lo + LO_V2);
    for (int e = tid; e < 32 * 512; e += 256) { int ch = e >> 5, r = e & 31; dst[e] = f2bf(src[r * 512 + ch]); }
  }
}

template <int J>
__device__ __forceinline__ void lora_mfma(const char* sIn, int rowb, const bf16_t* Wt, f32x4 (&acc)[8], const int tid) {
  const int lane = tid & 63, w = tid >> 6;
#pragma unroll
  for (int i = 0; i < 8; ++i) acc[i] = f32x4{0.f, 0.f, 0.f, 0.f};
#pragma unroll
  for (int ks = 0; ks < J / 32; ++ks) {
    const bf16x8 a = *reinterpret_cast<const bf16x8*>(sIn + (lane & 15) * rowb + (ks * 32 + 8 * (lane >> 4)) * 2);
#pragma unroll
    for (int i = 0; i < 8; ++i) {
      const bf16x8 b = *reinterpret_cast<const bf16x8*>(Wt + (size_t)((w * 8 + i) * 16 + (lane & 15)) * J + ks * 32 + 8 * (lane >> 4));
      acc[i] = __builtin_amdgcn_mfma_f32_16x16x32_bf16(a, b, acc[i], 0, 0, 0);
    }
  }
}

__device__ void phase_convert_norm(const Params& p, int l, char* smem) {
  const int tid = opaque_tid();
  constexpr int CT_IN_ONLY = CT_IN - 1024;
  const int nconv = (l == 0) ? CT_IN_ONLY + 2 * CT_LORA : 0;
  const int ntask = nconv + T_TOK / 4;
  const float* xsrc = (l == 0) ? p.in[I_X] : p.out;
  for (int t = blockIdx.x; t < ntask; t += gridDim.x) {
    if (t < nconv) {
      if (t < CT_IN_ONLY) convert_one(p, l, t + 1024, smem, tid);
      else { int c = t - CT_IN_ONLY; convert_lora(p, c / CT_LORA, c % CT_LORA, smem, tid); __syncthreads(); }
    } else {
      int row = (t - nconv) * 4 + (tid >> 6);
      rmsnorm_row_to_bf16(xsrc + (size_t)row * DM, p.in[I_NORM_MIX] + l * DM, (bf16_t*)(p.ws + OFF_U) + (size_t)row * DM, tid & 63);
    }
  }
}

__device__ void phase_norm_only(const Params& p, const float* xsrc, const float* w) {
  const int tid = opaque_tid();
  for (int t = blockIdx.x; t < T_TOK / 4; t += gridDim.x) {
    int row = t * 4 + (tid >> 6);
    rmsnorm_row_to_bf16(xsrc + (size_t)row * DM, w, (bf16_t*)(p.ws + OFF_U) + (size_t)row * DM, tid & 63);
  }
}

__device__ __forceinline__ bool tile_map(int t, int NT, int& mt, int& nt) {
  const int x = t & 7, r = t >> 3;
  const int cnt = (NT + 7) >> 3;
  const int ni = r % cnt;
  mt = r / cnt;
  nt = x + 8 * ni;
  return nt < NT;
}
__device__ __forceinline__ int tile_count(int MT, int NT) { return 8 * MT * ((NT + 7) >> 3); }

__device__ void phase_inproj(const Params& p, char* smem) {
  const bf16_t* U = (const bf16_t*)(p.ws + OFF_U);
  const bf16_t* Wt = (const bf16_t*)(p.ws + OFF_WTIN);
  bf16_t* Z = (bf16_t*)(p.ws + OFF_Z);
  const int tid = opaque_tid();
  const int lane = tid & 63, wid = tid >> 6, wm = wid >> 1, wn = wid & 1;
  constexpr int NT = 47;
  for (int t = blockIdx.x; t < tile_count(64, NT); t += gridDim.x) {
    int mt, nt;
    if (!tile_map(t, NT, mt, nt)) continue;
    f32x4 acc[8][4];
    zero_acc_big(acc);
    gemm_mainloop_big(acc, U, 1024, mt * 256, Wt, 1024, nt * 128, NZ - 1, 1024, smem, tid);
#pragma unroll
    for (int mi = 0; mi < 8; ++mi)
#pragma unroll
      for (int np = 0; np < 2; ++np) {
        const int colb = nt * 128 + wn * 64 + np * 32;
        const int row = mt * 256 + wm * 128 + mi * 16 + (lane & 15);
        uint2 a, b;
        a.x = pack2(acc[mi][2 * np][0], acc[mi][2 * np][1]);
        a.y = pack2(acc[mi][2 * np][2], acc[mi][2 * np][3]);
        b.x = pack2(acc[mi][2 * np + 1][0], acc[mi][2 * np + 1][1]);
        b.y = pack2(acc[mi][2 * np + 1][2], acc[mi][2 * np + 1][3]);
        const int mycol = colb + ((lane >> 4) & 1) * 16 + (lane >> 5) * 8;
        store_pair_bf16(Z + (size_t)row * ZS + colb, lane, a, b, mycol < NZ);
      }
  }
}

template <int J>
__device__ __forceinline__ void lora_mm(const float* sIn, const float* W, float (&a0)[16], float (&a1)[16], const int tid) {
#pragma unroll
  for (int i = 0; i < 16; ++i) { a0[i] = 0.f; a1[i] = 0.f; }
#pragma unroll 8
  for (int j = 0; j < J; ++j) {
    float w0 = W[j * 512 + tid], w1 = W[j * 512 + tid + 256];
    const float4* x4 = reinterpret_cast<const float4*>(sIn + j * 16);
#pragma unroll
    for (int q = 0; q < 4; ++q) {
      float4 x = x4[q];
      a0[q * 4 + 0] = fmaf(w0, x.x, a0[q * 4 + 0]); a1[q * 4 + 0] = fmaf(w1, x.x, a1[q * 4 + 0]);
      a0[q * 4 + 1] = fmaf(w0, x.y, a0[q * 4 + 1]); a1[q * 4 + 1] = fmaf(w1, x.y, a1[q * 4 + 1]);
      a0[q * 4 + 2] = fmaf(w0, x.z, a0[q * 4 + 2]); a1[q * 4 + 2] = fmaf(w1, x.z, a1[q * 4 + 2]);
      a0[q * 4 + 3] = fmaf(w0, x.w, a0[q * 4 + 3]); a1[q * 4 + 3] = fmaf(w1, x.w, a1[q * 4 + 3]);
    }
  }
}

__device__ __forceinline__ float rw_shift(const bf16_t* Z, int row, int s, int rc, float mu) {
  float cur = bf2f(Z[(size_t)row * ZS + ZRW + rc]);
  float prev = (s > 0) ? bf2f(Z[(size_t)(row - 1) * ZS + ZRW + rc]) : 0.f;
  return cur + (prev - cur) * mu;
}

__device__ void phase_rwprep(const Params& p, int l, char* smem) {
  const bf16_t* Z = (const bf16_t*)(p.ws + OFF_Z);
  bf16_t* LW = (bf16_t*)(p.ws + OFF_U);
  bf16_t* LA = LW + (size_t)T_TOK * 512;
  bf16_t* VF = (bf16_t*)(p.ws + OFF_VF);
  const char* lo = p.ws + OFF_LORA + (size_t)l * LORA_STRIDE;
  char* sXw = smem;
  char* sXa = smem + 2304;
  char* sZv = smem + 4608;
  float* sTmpF = reinterpret_cast<float*>(smem + 4608 + 16640);
  char* sTmp = smem + 4608 + 16640 + 4096;
  const float* mu = p.in[I_RW_MU] + l * 1792;
  const int tid = opaque_tid(), lane = tid & 63, w = tid >> 6;
  for (int t = blockIdx.x; t < T_TOK / 16; t += gridDim.x) {
    const int row0 = t * 16;
    for (int e = tid; e < 2048; e += 256) {
      int which = e >> 10, r = e & 1023, tok = r >> 6, j = r & 63;
      int row = row0 + tok, sq = row & (SEQ - 1);
      int rc = 1536 + which * 64 + j;
      float z = rw_shift(Z, row, sq, rc, mu[rc]);
      if (which == 0) *reinterpret_cast<bf16_t*>(sXw + tok * 144 + j * 2) = f2bf(ftanh(z));
      else *reinterpret_cast<bf16_t*>(sXa + tok * 144 + j * 2) = f2bf(z);
    }
    {
      float m0 = mu[1024 + tid], m1 = mu[1024 + tid + 256];
#pragma unroll 4
      for (int tok = 0; tok < 16; ++tok) {
        int row = row0 + tok, sq = row & (SEQ - 1);
        bf16_t z0 = f2bf(rw_shift(Z, row, sq, 1024 + tid, m0));
        bf16_t z1 = f2bf(rw_shift(Z, row, sq, 1024 + tid + 256, m1));
        *reinterpret_cast<bf16_t*>(sZv + tok * 1040 + tid * 2) = z0;
        *reinterpret_cast<bf16_t*>(sZv + tok * 1040 + (tid + 256) * 2) = z1;
        if (l == 0) {
          VF[(size_t)row * 512 + tid] = z0;
          VF[(size_t)row * 512 + tid + 256] = z1;
        }
      }
    }
    __syncthreads();
    f32x4 acc[8];
    lora_mfma<64>(sXw, 144, (const bf16_t*)(lo + LO_W2), acc, tid);
#pragma unroll
    for (int i = 0; i < 8; ++i)
#pragma unroll
      for (int jj = 0; jj < 4; ++jj)
        LW[(size_t)(row0 + (lane >> 4) * 4 + jj) * 512 + (w * 8 + i) * 16 + (lane & 15)] = f2bf(acc[i][jj]);
    lora_mfma<64>(sXa, 144, (const bf16_t*)(lo + LO_A2), acc, tid);
#pragma unroll
    for (int i = 0; i < 8; ++i)
#pragma unroll
      for (int jj = 0; jj < 4; ++jj)
        LA[(size_t)(row0 + (lane >> 4) * 4 + jj) * 512 + (w * 8 + i) * 16 + (lane & 15)] = f2bf(acc[i][jj]);
    if (l > 0) {
      {
        const bf16_t* v1t = (const bf16_t*)(lo + LO_V1);
        const int ntile = w & 1, kh = w >> 1;
        f32x4 tacc = f32x4{0.f, 0.f, 0.f, 0.f};
#pragma unroll
        for (int ks = 0; ks < 8; ++ks) {
          const int k0 = (kh * 8 + ks) * 32 + 8 * (lane >> 4);
          const bf16x8 a = *reinterpret_cast<const bf16x8*>(sZv + (lane & 15) * 1040 + k0 * 2);
          const bf16x8 b = *reinterpret_cast<const bf16x8*>(v1t + (size_t)(ntile * 16 + (lane & 15)) * 512 + k0);
          tacc = __builtin_amdgcn_mfma_f32_16x16x32_bf16(a, b, tacc, 0, 0, 0);
        }
#pragma unroll
        for (int jj = 0; jj < 4; ++jj)
          sTmpF[(kh * 16 + (lane >> 4) * 4 + jj) * 32 + ntile * 16 + (lane & 15)] = tacc[jj];
      }
      __syncthreads();
      for (int e = tid; e < 512; e += 256) {
        int tok = e >> 5, r = e & 31;
        *reinterpret_cast<bf16_t*>(sTmp + tok * 80 + r * 2) = f2bf(sTmpF[tok * 32 + r] + sTmpF[(16 + tok) * 32 + r]);
      }
      __syncthreads();
      lora_mfma<32>(sTmp, 80, (const bf16_t*)(lo + LO_V2), acc, tid);
      const float* v0 = p.in[I_RW_V0] + (size_t)(l - 1) * 512;
#pragma unroll
      for (int i = 0; i < 8; ++i) {
        const int ch = (w * 8 + i) * 16 + (lane & 15);
        const float b0 = v0[ch];
#pragma unroll
        for (int jj = 0; jj < 4; ++jj) {
          const int tok = (lane >> 4) * 4 + jj;
          const float zv = bf2f(*reinterpret_cast<const bf16_t*>(sZv + tok * 1040 + ch * 2));
          const size_t idx = (size_t)(row0 + tok) * 512 + ch;
          const float vf = bf2f(VF[idx]);
          VF[idx] = f2bf(zv + (vf - zv) * fsigmoid(b0 + acc[i][jj]));
        }
      }
    }
    __syncthreads();
  }
}

__device__ void hg_scan(const Params& p, int l, int task, char* smem) {
  const int b = task >> 3, h = (task >> 1) & 3, vg = task & 1;
  float* sFg = reinterpret_cast<float*>(smem);
  float* sQs = sFg + 16 * 128;
  float* sO = sQs + 16 * 128;
  float* sVv = sO + 4 * 16 * 64;
  const int tid = opaque_tid(), w = tid >> 6, lane = tid & 63;
  bf16_t* Z = (bf16_t*)(p.ws + OFF_Z) + (size_t)b * SEQ * ZS;
  const int ks = tid & 127;
  float lb = 0.f;
  if (l > 0) {
    float x0 = p.in[I_HG_LB][h * 128 + ks], x1 = p.in[I_HG_LB][512 + h * 128 + ks];
    float m = fmaxf(x0, x1), e0 = expf(x0 - m), e1 = expf(x1 - m);
    lb = e1 / (e0 + e1);
  }
  float s[32];
#pragma unroll
  for (int j = 0; j < 32; ++j) s[j] = 0.f;
  const int vcol = ZHG + 1024 + h * 128 + vg * 64;
  const int qcol = ZHG + h * 128 + ks;
  bf16_t rq0, rq1, rq2, rq3, rq4, rq5, rq6, rq7, rf0, rf1, rf2, rf3, rf4, rf5, rf6, rf7, rv0, rv1, rv2, rv3;
#define HG_LOAD(T0)                                                                                \
  {                                                                                                \
    const bf16_t* zb = Z + (size_t)((T0) + (tid >> 7)) * ZS + qcol;                                \
    rq0 = zb[0]; rf0 = zb[512]; zb += 2 * ZS; rq1 = zb[0]; rf1 = zb[512]; zb += 2 * ZS;            \
    rq2 = zb[0]; rf2 = zb[512]; zb += 2 * ZS; rq3 = zb[0]; rf3 = zb[512]; zb += 2 * ZS;            \
    rq4 = zb[0]; rf4 = zb[512]; zb += 2 * ZS; rq5 = zb[0]; rf5 = zb[512]; zb += 2 * ZS;            \
    rq6 = zb[0]; rf6 = zb[512]; zb += 2 * ZS; rq7 = zb[0]; rf7 = zb[512];                          \
    const bf16_t* zv = Z + (size_t)((T0) + w) * ZS + vcol + lane;                                  \
    rv0 = zv[0]; rv1 = zv[4 * ZS]; rv2 = zv[8 * ZS]; rv3 = zv[12 * ZS];                            \
  }
#define HG_PUT1(I, RQ, RF)                                                                         \
  {                                                                                                \
    int t = (tid >> 7) + 2 * (I);                                                                  \
    sFg[t * 128 + ks] = fmaxf(lb + (1.f - lb) * fsigmoid(bf2f(RF)), 1e-30f);                       \
    sQs[t * 128 + ks] = fsilu(bf2f(RQ));                                                           \
  }
#define HG_PROCESS()                                                                               \
  {                                                                                                \
    HG_PUT1(0, rq0, rf0) HG_PUT1(1, rq1, rf1) HG_PUT1(2, rq2, rf2) HG_PUT1(3, rq3, rf3)            \
    HG_PUT1(4, rq4, rf4) HG_PUT1(5, rq5, rf5) HG_PUT1(6, rq6, rf6) HG_PUT1(7, rq7, rf7)            \
    sVv[(w)*64 + lane] = bf2f(rv0); sVv[(w + 4) * 64 + lane] = bf2f(rv1);                          \
    sVv[(w + 8) * 64 + lane] = bf2f(rv2); sVv[(w + 12) * 64 + lane] = bf2f(rv3);                   \
  }
  HG_LOAD(0);
  HG_PROCESS();
  __syncthreads();
  constexpr int NCH = SEQ / 16;
#pragma unroll 1
  for (int c = 0; c < NCH; ++c) {
    const int t0 = c * 16;
    const int tn = (c + 1 < NCH) ? t0 + 16 : t0;
    HG_LOAD(tn);
    __builtin_amdgcn_sched_barrier(0);
#pragma unroll 2
    for (int t = 0; t < 16; ++t) {
      const float v = sVv[t * 64 + lane];
      const float opv = (lane < 32) ? sFg[t * 128 + w * 32 + lane] : sQs[t * 128 + w * 32 + (lane - 32)];
      const int opi = __builtin_bit_cast(int, opv);
      float o = 0.f;
#pragma unroll
      for (int j = 0; j < 32; ++j) {
        const float fg = __builtin_bit_cast(float, __builtin_amdgcn_readlane(opi, j));
        const float qq = __builtin_bit_cast(float, __builtin_amdgcn_readlane(opi, 32 + j));
        const float kv = fmaf(-fg, v, v);
        s[j] = fmaf(s[j], fg, kv);
        o = fmaf(qq, s[j], o);
      }
      sO[(w * 16 + t) * 64 + lane] = o;
    }
    __builtin_amdgcn_sched_barrier(0);
    __syncthreads();
    {
      int t = tid >> 4, v4 = (tid & 15) * 4;
      float4 a = *reinterpret_cast<const float4*>(sO + (0 * 16 + t) * 64 + v4);
      float4 bq = *reinterpret_cast<const float4*>(sO + (1 * 16 + t) * 64 + v4);
      float4 cq = *reinterpret_cast<const float4*>(sO + (2 * 16 + t) * 64 + v4);
      float4 d = *reinterpret_cast<const float4*>(sO + (3 * 16 + t) * 64 + v4);
      uint2 o;
      o.x = pack2(a.x + bq.x + cq.x + d.x, a.y + bq.y + cq.y + d.y);
      o.y = pack2(a.z + bq.z + cq.z + d.z, a.w + bq.w + cq.w + d.w);
      *reinterpret_cast<uint2*>(Z + (size_t)(t0 + t) * ZS + vcol + v4) = o;
    }
    HG_PROCESS();
    __syncthreads();
  }
#undef HG_LOAD
#undef HG_PUT1
#undef HG_PROCESS
}

__device__ void mb_scan(const Params& p, int l, int task, char* smem) {
  const int b = task >> 3, hd = task & 7, g = hd >> 2;
  float* sB = reinterpret_cast<float*>(smem);
  float* sC = sB + 16 * 128;
  float* sX = sC + 16 * 128;
  float* sDt = sX + 16 * 64;
  float* sDA = sDt + 16;
  float* sO = sDA + 16;
  const int tid = opaque_tid(), w = tid >> 6, lane = tid & 63;
  bf16_t* Z = (bf16_t*)(p.ws + OFF_Z) + (size_t)b * SEQ * ZS;
  const float* cw = p.in[I_MB_CONVW] + (size_t)l * 4 * 1024;
  const float* cb = p.in[I_MB_CONVB] + (size_t)l * 1024;
  int ci0, ci1;
  {
    int ch = tid;
    ci0 = (ch < 64) ? hd * 64 + ch : (ch < 192 ? 512 + g * 128 + (ch - 64) : 768 + g * 128 + (ch - 192));
    ci1 = 768 + g * 128 + 64 + (tid & 63);
  }
  float* dstA = (tid < 64) ? (sX + tid) : (tid < 192 ? (sB + (tid - 64)) : (sC + (tid - 192)));
  const int strideA = (tid < 64) ? 64 : 128;
  const float w0a = cw[ci0], w1a = cw[1024 + ci0], w2a = cw[2048 + ci0], w3a = cw[3072 + ci0], ba = cb[ci0];
  const float w0b = cw[ci1], w1b = cw[1024 + ci1], w2b = cw[2048 + ci1], w3b = cw[3072 + ci1], bb = cb[ci1];
  const float Aneg = -expf(p.in[I_MB_ALOG][l * 8 + hd]);
  const float dtb = p.in[I_MB_DTB][l * 8 + hd];
  const float Dsk = p.in[I_MB_D][l * 8 + hd];
  float s[32];
#pragma unroll
  for (int j = 0; j < 32; ++j) s[j] = 0.f;
  float pa1 = 0.f, pa2 = 0.f, pa3 = 0.f, pb1 = 0.f, pb2 = 0.f, pb3 = 0.f;
  const int xcol = ZMB + 512;
  const int rt = tid >> 4, rp4 = (tid & 15) * 4;
  bf16_t xa0, xa1, xa2, xa3, xa4, xa5, xa6, xa7, xa8, xa9, xa10, xa11, xa12, xa13, xa14, xa15;
  bf16_t xb0, xb1, xb2, xb3, xb4, xb5, xb6, xb7, xb8, xb9, xb10, xb11, xb12, xb13, xb14, xb15;
  bf16_t rdt;
  uint2 gcur, gnext;
#define MB_LOAD(T0)                                                                                 \
  {                                                                                                 \
    const bf16_t* za = Z + (size_t)(T0) * ZS + xcol + ci0;                                          \
    xa0 = za[0]; xa1 = za[ZS]; xa2 = za[2 * ZS]; xa3 = za[3 * ZS]; xa4 = za[4 * ZS]; xa5 = za[5 * ZS];        \
    xa6 = za[6 * ZS]; xa7 = za[7 * ZS]; xa8 = za[8 * ZS]; xa9 = za[9 * ZS]; xa10 = za[10 * ZS];     \
    xa11 = za[11 * ZS]; xa12 = za[12 * ZS]; xa13 = za[13 * ZS]; xa14 = za[14 * ZS]; xa15 = za[15 * ZS];       \
    if (tid < 64) {                                                                                 \
      const bf16_t* zb = Z + (size_t)(T0) * ZS + xcol + ci1;                                        \
      xb0 = zb[0]; xb1 = zb[ZS]; xb2 = zb[2 * ZS]; xb3 = zb[3 * ZS]; xb4 = zb[4 * ZS]; xb5 = zb[5 * ZS];      \
      xb6 = zb[6 * ZS]; xb7 = zb[7 * ZS]; xb8 = zb[8 * ZS]; xb9 = zb[9 * ZS]; xb10 = zb[10 * ZS];   \
      xb11 = zb[11 * ZS]; xb12 = zb[12 * ZS]; xb13 = zb[13 * ZS]; xb14 = zb[14 * ZS]; xb15 = zb[15 * ZS];     \
    }                                                                                               \
    rdt = Z[(size_t)((T0) + (tid & 15)) * ZS + ZMB + 1536 + hd];                                    \
    gnext = *reinterpret_cast<const uint2*>(Z + (size_t)((T0) + rt) * ZS + ZMB + hd * 64 + rp4);    \
  }
#define MB_CONV_A(T, XR)                                                                            \
  {                                                                                                 \
    float xv = bf2f(XR);                                                                            \
    dstA[(T)*strideA] = fsilu(ba + w0a * pa3 + w1a * pa2 + w2a * pa1 + w3a * xv);                   \
    pa3 = pa2; pa2 = pa1; pa1 = xv;                                                                 \
  }
#define MB_CONV_B(T, XR)                                                                            \
  {                                                                                                 \
    float xv = bf2f(XR);                                                                            \
    sC[(T)*128 + 64 + tid] = fsilu(bb + w0b * pb3 + w1b * pb2 + w2b * pb1 + w3b * xv);              \
    pb3 = pb2; pb2 = pb1; pb1 = xv;                                                                 \
  }
#define MB_PROCESS()                                                                                \
  {                                                                                                 \
    MB_CONV_A(0, xa0) MB_CONV_A(1, xa1) MB_CONV_A(2, xa2) MB_CONV_A(3, xa3) MB_CONV_A(4, xa4)       \
    MB_CONV_A(5, xa5) MB_CONV_A(6, xa6) MB_CONV_A(7, xa7) MB_CONV_A(8, xa8) MB_CONV_A(9, xa9)       \
    MB_CONV_A(10, xa10) MB_CONV_A(11, xa11) MB_CONV_A(12, xa12) MB_CONV_A(13, xa13)                 \
    MB_CONV_A(14, xa14) MB_CONV_A(15, xa15)                                                         \
    if (tid < 64) {                                                                                 \
      MB_CONV_B(0, xb0) MB_CONV_B(1, xb1) MB_CONV_B(2, xb2) MB_CONV_B(3, xb3) MB_CONV_B(4, xb4)     \
      MB_CONV_B(5, xb5) MB_CONV_B(6, xb6) MB_CONV_B(7, xb7) MB_CONV_B(8, xb8) MB_CONV_B(9, xb9)     \
      MB_CONV_B(10, xb10) MB_CONV_B(11, xb11) MB_CONV_B(12, xb12) MB_CONV_B(13, xb13)               \
      MB_CONV_B(14, xb14) MB_CONV_B(15, xb15)                                                       \
    }                                                                                               \
    if (tid < 16) {                                                                                 \
      float dt = fsoftplus(bf2f(rdt) + dtb);                                                        \
      sDt[tid] = dt;                                                                                \
      sDA[tid] = __expf(Aneg * dt);                                                                 \
    }                                                                                               \
    gcur = gnext;                                                                                   \
  }
  MB_LOAD(0);
  MB_PROCESS();
  __syncthreads();
  constexpr int NCH = SEQ / 16;
#pragma unroll 1
  for (int c = 0; c < NCH; ++c) {
    const int t0 = c * 16;
    const bool more = (c + 1 < NCH);
    const int tn = more ? t0 + 16 : t0;
    MB_LOAD(tn);
    __builtin_amdgcn_sched_barrier(0);
#pragma unroll 2
    for (int t = 0; t < 16; ++t) {
      const float dA = sDA[t];
      const float xdt = sX[t * 64 + lane] * sDt[t];
      const float opv = (lane < 32) ? sB[t * 128 + w * 32 + lane] : sC[t * 128 + w * 32 + (lane - 32)];
      const int opi = __builtin_bit_cast(int, opv);
      float y = 0.f;
#pragma unroll
      for (int j = 0; j < 32; ++j) {
        const float bn = __builtin_bit_cast(float, __builtin_amdgcn_readlane(opi, j));
        const float cn = __builtin_bit_cast(float, __builtin_amdgcn_readlane(opi, 32 + j));
        s[j] = fmaf(s[j], dA, bn * xdt);
        y = fmaf(cn, s[j], y);
      }
      sO[(w * 16 + t) * 64 + lane] = y;
    }
    __builtin_amdgcn_sched_barrier(0);
    __syncthreads();
    {
      float4 a = *reinterpret_cast<const float4*>(sO + (0 * 16 + rt) * 64 + rp4);
      float4 bq = *reinterpret_cast<const float4*>(sO + (1 * 16 + rt) * 64 + rp4);
      float4 cq = *reinterpret_cast<const float4*>(sO + (2 * 16 + rt) * 64 + rp4);
      float4 d = *reinterpret_cast<const float4*>(sO + (3 * 16 + rt) * 64 + rp4);
      float4 xs = *reinterpret_cast<const float4*>(sX + rt * 64 + rp4);
      bf16_t* gp = Z + (size_t)(t0 + rt) * ZS + ZMB + hd * 64 + rp4;
      float g0 = bf2f((bf16_t)(gcur.x & 0xffff)), g1 = bf2f((bf16_t)(gcur.x >> 16));
      float g2 = bf2f((bf16_t)(gcur.y & 0xffff)), g3 = bf2f((bf16_t)(gcur.y >> 16));
      float y0 = a.x + bq.x + cq.x + d.x + Dsk * xs.x;
      float y1 = a.y + bq.y + cq.y + d.y + Dsk * xs.y;
      float y2 = a.z + bq.z + cq.z + d.z + Dsk * xs.z;
      float y3 = a.w + bq.w + cq.w + d.w + Dsk * xs.w;
      uint2 o;
      o.x = pack2(y0 * fsilu(g0), y1 * fsilu(g1));
      o.y = pack2(y2 * fsilu(g2), y3 * fsilu(g3));
      *reinterpret_cast<uint2*>(gp) = o;
    }
    __syncthreads();
    if (more) MB_PROCESS();
    __syncthreads();
  }
#undef MB_LOAD
#undef MB_CONV_A
#undef MB_CONV_B
#undef MB_PROCESS
}

__device__ void s5_scan(const Params& p, int l, int task, char* smem) {
  const int tid = opaque_tid(), w = tid >> 6, lane = tid & 63;
  const int b = task >> 3, g = (task & 7) * 4 + w;
  char* base = smem + w * 6144;
  float* sU = reinterpret_cast<float*>(base);
  char* sHb = base + 1024;
  bf16_t* Z = (bf16_t*)(p.ws + OFF_Z) + (size_t)b * SEQ * ZS + ZS5 + g * 16;
  const int n = lane;
  float lr, li, bbr[16], bbi[16];
  bf16x8 Bf0, Bf1, Bf2, Bf3;
  {
    float dt = expf(p.in[I_S5_LOGDT][l * 32 + g]);
    float are = p.in[I_S5_ARE][(l * 32 + g) * 64 + n], aim = p.in[I_S5_AIM][(l * 32 + g) * 64 + n];
    float mag = expf(dt * are);
    lr = mag * cosf(dt * aim); li = mag * sinf(dt * aim);
    float den = are * are + aim * aim;
    float cr = ((lr - 1.f) * are + li * aim) / den;
    float ci = (li * are - (lr - 1.f) * aim) / den;
    const float* bre = p.in[I_S5_BRE] + ((size_t)(l * 32 + g) * 64 + n) * 16;
    const float* bim = p.in[I_S5_BIM] + ((size_t)(l * 32 + g) * 64 + n) * 16;
#pragma unroll
    for (int c = 0; c < 16; ++c) {
      float br = bre[c], bi = bim[c];
      bbr[c] = cr * br - ci * bi;
      bbi[c] = cr * bi + ci * br;
    }
    const float* cre = p.in[I_S5_CRE] + (size_t)(l * 32 + g) * 16 * 64 + (lane & 15) * 64;
    const float* cim = p.in[I_S5_CIM] + (size_t)(l * 32 + g) * 16 * 64 + (lane & 15) * 64;
#pragma unroll
    for (int j = 0; j < 8; ++j) {
      const int kb = 8 * (lane >> 4) + j;
      const int n0 = kb >> 1;
      const bool im = (j & 1);
      Bf0[j] = (short)f2bf(im ? -cim[n0] : cre[n0]);
      Bf1[j] = (short)f2bf(im ? -cim[n0 + 16] : cre[n0 + 16]);
      Bf2[j] = (short)f2bf(im ? -cim[n0 + 32] : cre[n0 + 32]);
      Bf3[j] = (short)f2bf(im ? -cim[n0 + 48] : cre[n0 + 48]);
    }
  }
  const float dsk = p.in[I_S5_D][l * 512 + g * 16 + (lane & 15)];
  const int pt = lane >> 2, pc4 = (lane & 3) * 4;
  float hr = 0.f, hi = 0.f;
  uint2 unext = *reinterpret_cast<const uint2*>(Z + (size_t)pt * ZS + pc4);
  constexpr int NCH = SEQ / 16;
#pragma unroll 1
  for (int c = 0; c < NCH; ++c) {
    const int t0 = c * 16;
    {
      const uint2 ur = unext;
      *reinterpret_cast<float4*>(sU + pt * 16 + pc4) =
          float4{bf2f((bf16_t)(ur.x & 0xffff)), bf2f((bf16_t)(ur.x >> 16)), bf2f((bf16_t)(ur.y & 0xffff)), bf2f((bf16_t)(ur.y >> 16))};
      const int tn = (c + 1 < NCH) ? t0 + 16 : t0;
      unext = *reinterpret_cast<const uint2*>(Z + (size_t)(tn + pt) * ZS + pc4);
    }
    __builtin_amdgcn_sched_barrier(0);
    __syncthreads();
#pragma unroll 2
    for (int t = 0; t < 16; ++t) {
      const float4* u4 = reinterpret_cast<const float4*>(sU + t * 16);
      float bur = 0.f, bui = 0.f;
#pragma unroll
      for (int q = 0; q < 4; ++q) {
        float4 u = u4[q];
        bur = fmaf(bbr[q * 4 + 0], u.x, bur); bui = fmaf(bbi[q * 4 + 0], u.x, bui);
        bur = fmaf(bbr[q * 4 + 1], u.y, bur); bui = fmaf(bbi[q * 4 + 1], u.y, bui);
        bur = fmaf(bbr[q * 4 + 2], u.z, bur); bui = fmaf(bbi[q * 4 + 2], u.z, bui);
        bur = fmaf(bbr[q * 4 + 3], u.w, bur); bui = fmaf(bbi[q * 4 + 3], u.w, bui);
      }
      float nr = lr * hr - li * hi + bur;
      float ni = lr * hi + li * hr + bui;
      hr = nr; hi = ni;
      *reinterpret_cast<unsigned*>(sHb + t * 272 + n * 4) = pack2(hr, hi);
    }
    __syncthreads();
    {
      f32x4 acc = f32x4{0.f, 0.f, 0.f, 0.f};
      const char* ap = sHb + (lane & 15) * 272 + (lane >> 4) * 16;
      acc = __builtin_amdgcn_mfma_f32_16x16x32_bf16(*reinterpret_cast<const bf16x8*>(ap), Bf0, acc, 0, 0, 0);
      acc = __builtin_amdgcn_mfma_f32_16x16x32_bf16(*reinterpret_cast<const bf16x8*>(ap + 64), Bf1, acc, 0, 0, 0);
      acc = __builtin_amdgcn_mfma_f32_16x16x32_bf16(*reinterpret_cast<const bf16x8*>(ap + 128), Bf2, acc, 0, 0, 0);
      acc = __builtin_amdgcn_mfma_f32_16x16x32_bf16(*reinterpret_cast<const bf16x8*>(ap + 192), Bf3, acc, 0, 0, 0);
      const int cc = lane & 15, tb = (lane >> 4) * 4;
#pragma unroll
      for (int jj = 0; jj < 4; ++jj) {
        float y = acc[jj] + dsk * sU[(tb + jj) * 16 + cc];
        Z[(size_t)(t0 + tb + jj) * ZS + cc] = f2bf(fgelu(y));
      }
    }
    __syncthreads();
  }
}

__device__ void rw_scan(const Params& p, int l, int task, char* smem) {
  const int b = task >> 3, h = task & 7;
  float* sR = reinterpret_cast<float*>(smem);
  float* sW = sR + 1024;
  float* sK = sW + 1024;
  float* sA = sK + 1024;
  float* sBb = sA + 1024;
  float* sV = sBb + 1024;
  float* sY = sV + 1024;
  float* sBonus = sY + 1024;
  const int tid = opaque_tid(), w = tid >> 6, lane = tid & 63;
  const size_t tokbase = (size_t)b * SEQ;
  bf16_t* Z = (bf16_t*)(p.ws + OFF_Z) + tokbase * ZS;
  const bf16_t* LW = (const bf16_t*)(p.ws + OFF_U) + tokbase * 512;
  const bf16_t* LA = LW + (size_t)T_TOK * 512;
  const bf16_t* VF = (const bf16_t*)(p.ws + OFF_VF) + tokbase * 512;
  const int st = tid >> 4, c4 = (tid & 15) * 4, ch = h * 64 + c4;
  float mur[4], muk[4], w0[4], a0[4], kk_[4], ka_[4], rk_[4], lnw[4], lnb[4];
#pragma unroll
  for (int e = 0; e < 4; ++e) {
    mur[e] = p.in[I_RW_MU][l * 1792 + ch + e];
    muk[e] = p.in[I_RW_MU][l * 1792 + 512 + ch + e];
    w0[e] = p.in[I_RW_W0][l * 512 + ch + e];
    a0[e] = p.in[I_RW_A0][l * 512 + ch + e];
    kk_[e] = p.in[I_RW_KK][l * 512 + ch + e];
    ka_[e] = p.in[I_RW_KA][l * 512 + ch + e];
    rk_[e] = p.in[I_RW_RK][l * 512 + ch + e];
    lnw[e] = p.in[I_RW_LNW][l * 512 + ch + e];
    lnb[e] = p.in[I_RW_LNB][l * 512 + ch + e];
  }
  const int rg = lane >> 3, kq = lane & 7, vrow = w * 16 + rg * 2;
  float S0[8], S1[8];
#pragma unroll
  for (int j = 0; j < 8; ++j) { S0[j] = 0.f; S1[j] = 0.f; }
  uint2 rc, kc, rp, kp, lwv, lav, vfv;
#define RW_LOAD(T0)                                                                                 \
  {                                                                                                 \
    const int s_ = (T0) + st;                                                                       \
    const bf16_t* zr = Z + (size_t)s_ * ZS + ZRW + ch;                                              \
    rc = *reinterpret_cast<const uint2*>(zr);                                                       \
    kc = *reinterpret_cast<const uint2*>(zr + 512);                                                 \
    rp = uint2{0u, 0u}; kp = uint2{0u, 0u};                                                         \
    if (s_ > 0) { rp = *reinterpret_cast<const uint2*>(zr - ZS); kp = *reinterpret_cast<const uint2*>(zr - ZS + 512); } \
    lwv = *reinterpret_cast<const uint2*>(LW + (size_t)s_ * 512 + ch);                              \
    lav = *reinterpret_cast<const uint2*>(LA + (size_t)s_ * 512 + ch);                              \
    vfv = *reinterpret_cast<const uint2*>(VF + (size_t)s_ * 512 + ch);                              \
  }
#define RW_PROCESS()                                                                                \
  {                                                                                                 \
    float r4[4], k4[4], kkv[4], av[4], wv[4], vv[4];                                                \
    float n2 = 0.f;                                                                                 \
    _Pragma("unroll") for (int e = 0; e < 4; ++e) {                                                 \
      unsigned rcw = (e < 2) ? rc.x : rc.y, kcw = (e < 2) ? kc.x : kc.y, rpw = (e < 2) ? rp.x : rp.y, kpw = (e < 2) ? kp.x : kp.y; \
      unsigned lww = (e < 2) ? lwv.x : lwv.y, law = (e < 2) ? lav.x : lav.y, vfw = (e < 2) ? vfv.x : vfv.y; \
      int sh = (e & 1) * 16;                                                                        \
      float rcur = bf2f((bf16_t)((rcw >> sh) & 0xffff)), rprev = bf2f((bf16_t)((rpw >> sh) & 0xffff)); \
      float kcur = bf2f((bf16_t)((kcw >> sh) & 0xffff)), kprev = bf2f((bf16_t)((kpw >> sh) & 0xffff)); \
      float lwf = bf2f((bf16_t)((lww >> sh) & 0xffff)), laf = bf2f((bf16_t)((law >> sh) & 0xffff)); \
      vv[e] = bf2f((bf16_t)((vfw >> sh) & 0xffff));                                                 \
      r4[e] = rcur + (rprev - rcur) * mur[e];                                                       \
      k4[e] = kcur + (kprev - kcur) * muk[e];                                                       \
      float wlog = -fsoftplus(-(w0[e] + lwf)) - 0.5f;                                               \
      wv[e] = __expf(-__expf(wlog));                                                                \
      av[e] = fsigmoid(a0[e] + laf);                                                                \
      kkv[e] = k4[e] * kk_[e];                                                                      \
      n2 += kkv[e] * kkv[e];                                                                        \
    }                                                                                               \
    n2 = sum16(n2);                                                                                 \
    float inv = 1.f / fmaxf(sqrtf(n2), 1e-12f);                                                     \
    float bon = 0.f;                                                                                \
    float kt4[4], ap4[4], bp4[4];                                                                   \
    _Pragma("unroll") for (int e = 0; e < 4; ++e) {                                                 \
      float kkn = kkv[e] * inv;                                                                     \
      kt4[e] = k4[e] * (1.f + (av[e] - 1.f) * ka_[e]);                                              \
      ap4[e] = -kkn;                                                                                \
      bp4[e] = kkn * av[e];                                                                         \
      bon += r4[e] * kt4[e] * rk_[e];                                                               \
    }                                                                                               \
    bon = sum16(bon);                                                                               \
    *reinterpret_cast<float4*>(sR + st * 64 + c4) = float4{r4[0], r4[1], r4[2], r4[3]};             \
    *reinterpret_cast<float4*>(sW + st * 64 + c4) = float4{wv[0], wv[1], wv[2], wv[3]};             \
    *reinterpret_cast<float4*>(sK + st * 64 + c4) = float4{kt4[0], kt4[1], kt4[2], kt4[3]};         \
    *reinterpret_cast<float4*>(sA + st * 64 + c4) = float4{ap4[0], ap4[1], ap4[2], ap4[3]};         \
    *reinterpret_cast<float4*>(sBb + st * 64 + c4) = float4{bp4[0], bp4[1], bp4[2], bp4[3]};        \
    *reinterpret_cast<float4*>(sV + st * 64 + c4) = float4{vv[0], vv[1], vv[2], vv[3]};             \
    if ((tid & 15) == 0) sBonus[st] = bon;                                                          \
  }
  RW_LOAD(0);
  RW_PROCESS();
  __syncthreads();
  constexpr int NCH = SEQ / 16;
#pragma unroll 1
  for (int c = 0; c < NCH; ++c) {
    const int t0 = c * 16;
    const int tn = (c + 1 < NCH) ? t0 + 16 : t0;
    RW_LOAD(tn);
    __builtin_amdgcn_sched_barrier(0);
#pragma unroll 2
    for (int t = 0; t < 16; ++t) {
      const float4* a4p = reinterpret_cast<const float4*>(sA + t * 64 + kq * 8);
      const float4* w4p = reinterpret_cast<const float4*>(sW + t * 64 + kq * 8);
      const float4* b4p = reinterpret_cast<const float4*>(sBb + t * 64 + kq * 8);
      const float4* k4p = reinterpret_cast<const float4*>(sK + t * 64 + kq * 8);
      const float4* r4p = reinterpret_cast<const float4*>(sR + t * 64 + kq * 8);
      const float2 vv = *reinterpret_cast<const float2*>(sV + t * 64 + vrow);
      float sa0 = 0.f, sa1 = 0.f;
#pragma unroll
      for (int q = 0; q < 2; ++q) {
        float4 a = a4p[q];
        sa0 = fmaf(S0[q * 4 + 0], a.x, sa0); sa1 = fmaf(S1[q * 4 + 0], a.x, sa1);
        sa0 = fmaf(S0[q * 4 + 1], a.y, sa0); sa1 = fmaf(S1[q * 4 + 1], a.y, sa1);
        sa0 = fmaf(S0[q * 4 + 2], a.z, sa0); sa1 = fmaf(S1[q * 4 + 2], a.z, sa1);
        sa0 = fmaf(S0[q * 4 + 3], a.w, sa0); sa1 = fmaf(S1[q * 4 + 3], a.w, sa1);
      }
      sa0 = oct_sum(sa0); sa1 = oct_sum(sa1);
      float y0 = 0.f, y1 = 0.f;
#pragma unroll
      for (int q = 0; q < 2; ++q) {
        float4 ww = w4p[q], bb = b4p[q], kk = k4p[q], rr = r4p[q];
        S0[q * 4 + 0] = fmaf(S0[q * 4 + 0], ww.x, fmaf(sa0, bb.x, vv.x * kk.x)); y0 = fmaf(S0[q * 4 + 0], rr.x, y0);
        S1[q * 4 + 0] = fmaf(S1[q * 4 + 0], ww.x, fmaf(sa1, bb.x, vv.y * kk.x)); y1 = fmaf(S1[q * 4 + 0], rr.x, y1);
        S0[q * 4 + 1] = fmaf(S0[q * 4 + 1], ww.y, fmaf(sa0, bb.y, vv.x * kk.y)); y0 = fmaf(S0[q * 4 + 1], rr.y, y0);
        S1[q * 4 + 1] = fmaf(S1[q * 4 + 1], ww.y, fmaf(sa1, bb.y, vv.y * kk.y)); y1 = fmaf(S1[q * 4 + 1], rr.y, y1);
        S0[q * 4 + 2] = fmaf(S0[q * 4 + 2], ww.z, fmaf(sa0, bb.z, vv.x * kk.z)); y0 = fmaf(S0[q * 4 + 2], rr.z, y0);
        S1[q * 4 + 2] = fmaf(S1[q * 4 + 2], ww.z, fmaf(sa1, bb.z, vv.y * kk.z)); y1 = fmaf(S1[q * 4 + 2], rr.z, y1);
        S0[q * 4 + 3] = fmaf(S0[q * 4 + 3], ww.w, fmaf(sa0, bb.w, vv.x * kk.w)); y0 = fmaf(S0[q * 4 + 3], rr.w, y0);
        S1[q * 4 + 3] = fmaf(S1[q * 4 + 3], ww.w, fmaf(sa1, bb.w, vv.y * kk.w)); y1 = fmaf(S1[q * 4 + 3], rr.w, y1);
      }
      y0 = oct_sum(y0); y1 = oct_sum(y1);
      if (kq == 0) *reinterpret_cast<float2*>(sY + t * 64 + vrow) = float2{y0, y1};
    }
    __builtin_amdgcn_sched_barrier(0);
    __syncthreads();
    {
      float4 y4 = *reinterpret_cast<const float4*>(sY + st * 64 + c4);
      float4 v4 = *reinterpret_cast<const float4*>(sV + st * 64 + c4);
      float bon = sBonus[st];
      float mean = sum16(y4.x + y4.y + y4.z + y4.w) * (1.f / 64.f);
      float dx = y4.x - mean, dy = y4.y - mean, dz = y4.z - mean, dw = y4.w - mean;
      float var = sum16(dx * dx + dy * dy + dz * dz + dw * dw) * (1.f / 64.f);
      float rs = rsqrtf(var + 64e-5f);
      float o0 = dx * rs * lnw[0] + lnb[0] + bon * v4.x;
      float o1 = dy * rs * lnw[1] + lnb[1] + bon * v4.y;
      float o2 = dz * rs * lnw[2] + lnb[2] + bon * v4.z;
      float o3 = dw * rs * lnw[3] + lnb[3] + bon * v4.w;
      uint2 o;
      o.x = pack2(o0, o1); o.y = pack2(o2, o3);
      *reinterpret_cast<uint2*>(Z + (size_t)(t0 + st) * ZS + ZRW + 1024 + ch) = o;
    }
    RW_PROCESS();
    __syncthreads();
  }
#undef RW_LOAD
#undef RW_PROCESS
}

__device__ void phase_scans(const Params& p, int l, char* smem, int scan_mask = 15) {
  for (int t = blockIdx.x; t < 256; t += gridDim.x) {
    int type = t & 3, idx = t >> 2;
    if (!((scan_mask >> type) & 1)) continue;
#ifndef SCM
#define SCM 15
#endif
    if (type == 0) { if (SCM & 1) rw_scan(p, l, idx, smem); }
    else if (type == 1) { if (SCM & 2) hg_scan(p, l, idx, smem); }
    else if (type == 2) { if (SCM & 4) mb_scan(p, l, idx, smem); }
    else { if (SCM & 8) s5_scan(p, l, idx, smem); }
    __syncthreads();
  }
  if (l == 0) {
    const int tid = opaque_tid();
    const int nb = (gridDim.x > 256) ? (int)gridDim.x - 256 : (int)gridDim.x;
    const int b0 = (gridDim.x > 256) ? (int)blockIdx.x - 256 : (int)blockIdx.x;
    constexpr int NREST = CT_TOTAL - (CT_IN - 1024);
    if (b0 >= 0)
      for (int c = b0; c < NREST + CT_TOTAL; c += nb) {
        if (c < NREST) convert_one(p, 0, (c < 1024) ? c : c + (CT_IN - 1024), smem, tid);
        else convert_one(p, 1, c - NREST, smem, tid);
      }
  }
}

__device__ __forceinline__ void unpack8(const uint4& v, float (&f)[8]) {
  f[0] = bf2f((bf16_t)(v.x & 0xffff)); f[1] = bf2f((bf16_t)(v.x >> 16));
  f[2] = bf2f((bf16_t)(v.y & 0xffff)); f[3] = bf2f((bf16_t)(v.y >> 16));
  f[4] = bf2f((bf16_t)(v.z & 0xffff)); f[5] = bf2f((bf16_t)(v.z >> 16));
  f[6] = bf2f((bf16_t)(v.w & 0xffff)); f[7] = bf2f((bf16_t)(v.w >> 16));
}

__device__ void phase_post(const Params& p, int l, char* smem) {
  bf16_t* Z = (bf16_t*)(p.ws + OFF_Z);
  const int tid = opaque_tid(), lane = tid & 63, wid = tid >> 6;
  constexpr int N_ROWT = T_TOK / 4, N_RWT = T_TOK / 16, N_GLU = 128 * 4, N_NORM = T_TOK / 4;
  const float* xsrc = (l == 0) ? p.in[I_X] : p.out;
  for (int t = blockIdx.x; t < N_ROWT + N_RWT + N_GLU + N_NORM; t += gridDim.x) {
    if (t < N_ROWT) {
      const int row = t * 4 + wid;
      {
        bf16_t* op = Z + (size_t)row * ZS + ZHG + 1024 + lane * 8;
        uint4 ov = *reinterpret_cast<const uint4*>(op);
        uint4 gv = *reinterpret_cast<const uint4*>(op + 512);
        float o[8], g[8];
        unpack8(ov, o); unpack8(gv, g);
        float ss = 0.f;
#pragma unroll
        for (int e = 0; e < 8; ++e) ss += o[e] * o[e];
        ss = sum16(ss);
        float rstd = rsqrtf(ss * (1.f / 128.f) + 1e-6f);
        const float* nw = p.in[I_HG_NW] + l * 512 + lane * 8;
        float r[8];
#pragma unroll
        for (int e = 0; e < 8; ++e) r[e] = o[e] * rstd * nw[e] * siluf_(g[e]);
        *reinterpret_cast<uint4*>(op) = uint4{pack2(r[0], r[1]), pack2(r[2], r[3]), pack2(r[4], r[5]), pack2(r[6], r[7])};
      }
      {
        bf16_t* op = Z + (size_t)row * ZS + ZMB + lane * 8;
        uint4 ov = *reinterpret_cast<const uint4*>(op);
        float o[8];
        unpack8(ov, o);
        float ss = 0.f;
#pragma unroll
        for (int e = 0; e < 8; ++e) ss += o[e] * o[e];
        ss = sum64(ss);
        float rstd = rsqrtf(ss * (1.f / 512.f) + 1e-6f);
        const float* nw = p.in[I_MB_NW] + l * 512 + lane * 8;
        float r[8];
#pragma unroll
        for (int e = 0; e < 8; ++e) r[e] = o[e] * rstd * nw[e];
        *reinterpret_cast<uint4*>(op) = uint4{pack2(r[0], r[1]), pack2(r[2], r[3]), pack2(r[4], r[5]), pack2(r[6], r[7])};
      }
    } else if (t < N_ROWT + N_RWT) {
      const int row0 = (t - N_ROWT) * 16;
      char* sXg = smem;
      const float* mu = p.in[I_RW_MU] + l * 1792 + 1664;
      for (int e = tid; e < 2048; e += 256) {
        int tok = e >> 7, j = e & 127;
        int row = row0 + tok, sq = row & (SEQ - 1);
        *reinterpret_cast<bf16_t*>(sXg + tok * 272 + j * 2) = f2bf(fsigmoid(rw_shift(Z, row, sq, 1664 + j, mu[j])));
      }
      __syncthreads();
      f32x4 acc[8];
      lora_mfma<128>(sXg, 272, (const bf16_t*)(p.ws + OFF_LORA + (size_t)l * LORA_STRIDE + LO_G2), acc, tid);
#pragma unroll
      for (int i = 0; i < 8; ++i)
#pragma unroll
        for (int jj = 0; jj < 4; ++jj) {
          bf16_t* yp = Z + (size_t)(row0 + (lane >> 4) * 4 + jj) * ZS + ZRW + 1024 + (wid * 8 + i) * 16 + (lane & 15);
          *yp = f2bf(bf2f(*yp) * acc[i][jj]);
        }
      __syncthreads();
    } else if (t < N_ROWT + N_RWT + N_GLU) {
      const int tt = t - N_ROWT - N_RWT, mt = tt >> 2, nt = tt & 3;
      const int wm = wid >> 1, wn = wid & 1;
      f32x4 acc[4][4];
      zero_acc<128>(acc);
      gemm_mainloop<128>(acc, Z + ZS5, ZS, mt * 128, (const bf16_t*)(p.ws + WOFF(OFF_WTGLU, l)), 512, nt * 128, 511, 512, smem, tid);
      const float* bg = p.in[I_S5_BGLU] + l * 512;
#pragma unroll
      for (int mi = 0; mi < 4; ++mi)
#pragma unroll
        for (int ni = 0; ni < 4; ++ni) {
          int col = nt * 128 + wn * 64 + ni * 16 + (lane >> 4) * 4;
          int row = mt * 128 + wm * 64 + mi * 16 + (lane & 15);
          float4 b4 = *reinterpret_cast<const float4*>(bg + col);
          uint2 yv = *reinterpret_cast<const uint2*>(Z + (size_t)row * ZS + ZS5 + col);
          float y0 = bf2f((bf16_t)(yv.x & 0xffff)), y1 = bf2f((bf16_t)(yv.x >> 16));
          float y2 = bf2f((bf16_t)(yv.y & 0xffff)), y3 = bf2f((bf16_t)(yv.y >> 16));
          uint2 o;
          o.x = pack2(y0 * sigmoidf_(acc[mi][ni][0] + b4.x), y1 * sigmoidf_(acc[mi][ni][1] + b4.y));
          o.y = pack2(y2 * sigmoidf_(acc[mi][ni][2] + b4.z), y3 * sigmoidf_(acc[mi][ni][3] + b4.w));
          *reinterpret_cast<uint2*>(Z + (size_t)row * ZS + ZMB + 1024 + col) = o;
        }
    } else {
      const int row = (t - N_ROWT - N_RWT - N_GLU) * 4 + wid;
      rmsnorm_row_to_bf16(xsrc + (size_t)row * DM, p.in[I_NORM_MIX] + l * DM, (bf16_t*)(p.ws + OFF_U) + (size_t)row * DM, tid & 63);
    }
  }
}

__device__ void phase_merge(const Params& p, int l, char* smem) {
  bf16_t* Z = (bf16_t*)(p.ws + OFF_Z);
  const bf16_t* U = (const bf16_t*)(p.ws + OFF_U);
  const bf16_t* Wg = (const bf16_t*)(p.ws + WOFF_GATE(l));
  const bf16_t* Wb = (const bf16_t*)(p.ws + WOFF(OFF_WTBR, l));
  const int tid = opaque_tid();
  const int lane = tid & 63, wid = tid >> 6, wm = wid >> 1, wn = wid & 1;
  for (int t = blockIdx.x; t < tile_count(128, 8); t += gridDim.x) {
    int mt, nt;
    if (!tile_map(t, 8, mt, nt)) continue;
    f32x4 accm[4][4];
    zero_acc<128>(accm);
    f32x4 a1[4][4];
    zero_acc<128>(a1);
    uint2 sg[4][4];
#pragma unroll
    for (int mi = 0; mi < 4; ++mi)
#pragma unroll
      for (int ni = 0; ni < 4; ++ni) sg[mi][ni] = uint2{0u, 0u};
#pragma unroll 1
    for (int sub = 0; sub < 8; ++sub) {
      const int kb = sub >> 1, which = sub & 1;
      const int ycol = (kb == 0) ? (ZHG + 1024) : (kb == 1) ? (ZRW + 1024) : (kb == 2) ? (ZMB + 1024) : ZMB;
      const bf16_t* Ap = which ? (const bf16_t*)(Z + ycol) : U;
      const int ldap = which ? ZS : 1024;
      const bf16_t* Bp = which ? (Wb + (size_t)kb * 1024 * 512) : (Wg + (size_t)kb * 1024 * 1024);
      const int Kp = which ? 512 : 1024;
      gemm_mainloop_glds<128>(a1, Ap, ldap, mt * 128, Bp, Kp, nt * 128, 1023, Kp, smem, tid);
      if (which == 0) {
#pragma unroll
        for (int mi = 0; mi < 4; ++mi)
#pragma unroll
          for (int ni = 0; ni < 4; ++ni) {
            sg[mi][ni].x = pack2(fsigmoid(a1[mi][ni][0]), fsigmoid(a1[mi][ni][1]));
            sg[mi][ni].y = pack2(fsigmoid(a1[mi][ni][2]), fsigmoid(a1[mi][ni][3]));
            a1[mi][ni] = f32x4{0.f, 0.f, 0.f, 0.f};
          }
      } else {
#pragma unroll
        for (int mi = 0; mi < 4; ++mi)
#pragma unroll
          for (int ni = 0; ni < 4; ++ni) {
            accm[mi][ni][0] = fmaf(bf2f((bf16_t)(sg[mi][ni].x & 0xffff)), a1[mi][ni][0], accm[mi][ni][0]);
            accm[mi][ni][1] = fmaf(bf2f((bf16_t)(sg[mi][ni].x >> 16)), a1[mi][ni][1], accm[mi][ni][1]);
            accm[mi][ni][2] = fmaf(bf2f((bf16_t)(sg[mi][ni].y & 0xffff)), a1[mi][ni][2], accm[mi][ni][2]);
            accm[mi][ni][3] = fmaf(bf2f((bf16_t)(sg[mi][ni].y >> 16)), a1[mi][ni][3], accm[mi][ni][3]);
            a1[mi][ni] = f32x4{0.f, 0.f, 0.f, 0.f};
          }
      }
    }
#pragma unroll
    for (int mi = 0; mi < 4; ++mi)
#pragma unroll
      for (int np = 0; np < 2; ++np) {
        const int colb = nt * 128 + wn * 64 + np * 32;
        const int row = mt * 128 + wm * 64 + mi * 16 + (lane & 15);
        uint2 a, b;
        a.x = pack2(accm[mi][2 * np][0], accm[mi][2 * np][1]);
        a.y = pack2(accm[mi][2 * np][2], accm[mi][2 * np][3]);
        b.x = pack2(accm[mi][2 * np + 1][0], accm[mi][2 * np + 1][1]);
        b.y = pack2(accm[mi][2 * np + 1][2], accm[mi][2 * np + 1][3]);
        store_pair_bf16(Z + (size_t)row * ZS + colb, lane, a, b);
      }
  }
}

__device__ void phase_resid_gemm(const Params& p, const bf16_t* A, int lda, const bf16_t* Wt, int K, const float* xold, char* smem) {
  const int tid = opaque_tid();
  const int lane = tid & 63, wid = tid >> 6, wm = wid >> 1, wn = wid & 1;
  for (int t = blockIdx.x; t < tile_count(64, 8); t += gridDim.x) {
    int mt, nt;
    if (!tile_map(t, 8, mt, nt)) continue;
    f32x4 acc[8][4];
    zero_acc_big(acc);
    gemm_mainloop_big(acc, A, lda, mt * 256, Wt, K, nt * 128, 1023, K, smem, tid);
#pragma unroll
    for (int mi = 0; mi < 8; ++mi)
#pragma unroll
      for (int ni = 0; ni < 4; ++ni) {
        int col = nt * 128 + wn * 64 + ni * 16 + (lane >> 4) * 4;
        int row = mt * 256 + wm * 128 + mi * 16 + (lane & 15);
        size_t o = (size_t)row * DM + col;
        float4 xo = *reinterpret_cast<const float4*>(xold + o);
        float4 r = float4{xo.x + acc[mi][ni][0], xo.y + acc[mi][ni][1], xo.z + acc[mi][ni][2], xo.w + acc[mi][ni][3]};
        *reinterpret_cast<float4*>(p.out + o) = r;
      }
  }
}

__device__ void phase_ffn_in(const Params& p, int l, char* smem) {
  const bf16_t* U = (const bf16_t*)(p.ws + OFF_U);
  const bf16_t* Wt = (const bf16_t*)(p.ws + WOFF(OFF_WTF1, l));
  bf16_t* H = (bf16_t*)(p.ws + OFF_Z);
  const int tid = opaque_tid();
  const int lane = tid & 63, wid = tid >> 6, wm = wid >> 1, wn = wid & 1;
  for (int t = blockIdx.x; t < tile_count(64, 40); t += gridDim.x) {
    int mt, nt;
    if (!tile_map(t, 40, mt, nt)) continue;
    f32x4 acc[8][4];
    zero_acc_big(acc);
    gemm_mainloop_big(acc, U, 1024, mt * 256, Wt, 1024, nt * 128, 5631, 1024, smem, tid);
#pragma unroll
    for (int mi = 0; mi < 8; ++mi) {
      const int hcolb = (nt * 128 + wn * 64) >> 1;
      const int row = mt * 256 + wm * 128 + mi * 16 + (lane & 15);
      uint2 o0, o1;
      o0.x = pack2(fsilu(acc[mi][0][0]) * acc[mi][1][0], fsilu(acc[mi][0][1]) * acc[mi][1][1]);
      o0.y = pack2(fsilu(acc[mi][0][2]) * acc[mi][1][2], fsilu(acc[mi][0][3]) * acc[mi][1][3]);
      o1.x = pack2(fsilu(acc[mi][2][0]) * acc[mi][3][0], fsilu(acc[mi][2][1]) * acc[mi][3][1]);
      o1.y = pack2(fsilu(acc[mi][2][2]) * acc[mi][3][2], fsilu(acc[mi][2][3]) * acc[mi][3][3]);
      store_pair_bf16(H + (size_t)row * FFH + hcolb, lane, o0, o1);
    }
  }
  for (int t2 = blockIdx.x; t2 < 512; t2 += gridDim.x) {
    const int nt = 40 + (t2 & 3), mt = t2 >> 2;
    f32x4 acc[4][4];
    zero_acc<128>(acc);
    gemm_mainloop_glds<128>(acc, U, 1024, mt * 128, Wt, 1024, nt * 128, 5631, 1024, smem, tid);
#pragma unroll
    for (int mi = 0; mi < 4; ++mi) {
      const int hcolb = (nt * 128 + wn * 64) >> 1;
      const int row = mt * 128 + wm * 64 + mi * 16 + (lane & 15);
      uint2 o0, o1;
      o0.x = pack2(fsilu(acc[mi][0][0]) * acc[mi][1][0], fsilu(acc[mi][0][1]) * acc[mi][1][1]);
      o0.y = pack2(fsilu(acc[mi][0][2]) * acc[mi][1][2], fsilu(acc[mi][0][3]) * acc[mi][1][3]);
      o1.x = pack2(fsilu(acc[mi][2][0]) * acc[mi][3][0], fsilu(acc[mi][2][1]) * acc[mi][3][1]);
      o1.y = pack2(fsilu(acc[mi][2][2]) * acc[mi][3][2], fsilu(acc[mi][2][3]) * acc[mi][3][3]);
      store_pair_bf16(H + (size_t)row * FFH + hcolb, lane, o0, o1);
    }
  }
}

__device__ void phase_final(const Params& p) {
  const int tid = opaque_tid();
  const int lane = tid & 63;
  const float* w = p.in[I_NORM_FINAL];
  for (int t = blockIdx.x; t < T_TOK / 4; t += gridDim.x) {
    int row = t * 4 + (tid >> 6);
    float* x = p.out + (size_t)row * DM;
    float4 v[4];
    float ss = 0.f;
#pragma unroll
    for (int i = 0; i < 4; ++i) {
      v[i] = *reinterpret_cast<const float4*>(x + i * 256 + lane * 4);
      ss += v[i].x * v[i].x + v[i].y * v[i].y + v[i].z * v[i].z + v[i].w * v[i].w;
    }
    ss = sum64(ss);
    float rstd = rsqrtf(ss * (1.f / 1024.f) + 1e-6f);
#pragma unroll
    for (int i = 0; i < 4; ++i) {
      float4 ww = *reinterpret_cast<const float4*>(w + i * 256 + lane * 4);
      float4 o = float4{v[i].x * rstd * ww.x, v[i].y * rstd * ww.y, v[i].z * rstd * ww.z, v[i].w * rstd * ww.w};
      *reinterpret_cast<float4*>(x + i * 256 + lane * 4) = o;
    }
  }
}

template <int SUB>
__device__ __forceinline__ void run_phase(const Params& p, int l, char* smem) {
  if (SUB == 0) phase_convert_norm(p, l, smem);
  else if (SUB == 1) phase_inproj(p, smem);
  else if (SUB == 2) phase_rwprep(p, l, smem);
  else if (SUB == 3) phase_scans(p, l, smem);
  else if (SUB == 4) phase_post(p, l, smem);
  else if (SUB == 5) phase_merge(p, l, smem);
  else if (SUB == 6) phase_resid_gemm(p, (const bf16_t*)(p.ws + OFF_Z), ZS, (const bf16_t*)(p.ws + WOFF(OFF_WTOUT, l)), 1024,
                                      (l == 0) ? p.in[I_X] : p.out, smem);
  else if (SUB == 7) phase_norm_only(p, p.out, p.in[I_NORM_FFN] + l * DM);
  else if (SUB == 8) phase_ffn_in(p, l, smem);
  else if (SUB == 9) phase_resid_gemm(p, (const bf16_t*)(p.ws + OFF_Z), FFH, (const bf16_t*)(p.ws + WOFF(OFF_WTF2, l)), FFH, p.out, smem);
  else phase_final(p);
}

#ifndef PHM
#define PHM 0xFFFF
#endif
#define XB_TMO      128
#define XB_XCNT(j)  (256  + 64 * (j))
#define XB_XSUB(j)  (1280 + 64 * (j))
#define XB_XGEN(j)  (2304 + 64 * (j))
#define XB_TOP      3328
#define XB_TOPGEN   3392
#define XCD_BAR_WORDS 3456
#define XB_SPIN_CAP (1u << 18)
#define LAS __attribute__((address_space(3)))

__device__ __forceinline__ unsigned xb_ld(unsigned* p)              { return __hip_atomic_load(p, __ATOMIC_RELAXED, __HIP_MEMORY_SCOPE_AGENT); }
__device__ __forceinline__ unsigned xb_add(unsigned* p, unsigned v) { return __hip_atomic_fetch_add(p, v, __ATOMIC_RELAXED, __HIP_MEMORY_SCOPE_AGENT); }
__device__ __forceinline__ unsigned xb_xcc_id() { return (unsigned)__builtin_amdgcn_s_getreg((3 << 11) | 20) & 0xFu; }
#define XB_SPIN(cond, bar) do { unsigned _sp = 0; while (cond) { __builtin_amdgcn_s_sleep(1); \
    if ((++_sp & 255u) == 0u) { if (xb_ld(&(bar)[XB_TMO])) break; if (_sp > XB_SPIN_CAP) { atomicAdd(&(bar)[XB_TMO], 1u); break; } } } } while (0)

struct XcdBarrier {
    unsigned* bar; unsigned x;
    volatile LAS unsigned* st;
};

__device__ __forceinline__ XcdBarrier xcd_barrier_post(unsigned* bar, volatile LAS unsigned* st) {
    XcdBarrier b; b.bar = bar; b.x = xb_xcc_id(); b.st = st;
    if (threadIdx.x == 0) (void)xb_add(&bar[XB_XCNT(b.x)], 1u);
    return b;
}
__device__ __forceinline__ void xcd_barrier_complete(unsigned* bar, unsigned x, unsigned& nloc, unsigned& nx) {
    const unsigned G = gridDim.x * gridDim.y * gridDim.z;
    unsigned sum, cnt, mine, sp = 0u;
    for (;;) {
        sum = 0u; cnt = 0u; mine = 0u;
#pragma unroll
        for (unsigned j = 0; j < 16; ++j) { const unsigned c = xb_ld(&bar[XB_XCNT(j)]); sum += c; cnt += (c > 0u) ? 1u : 0u; mine = (j == x) ? c : mine; }
        if (sum == G) break;
        __builtin_amdgcn_s_sleep(1);
        if ((++sp & 255u) == 0u) { if (xb_ld(&bar[XB_TMO])) break; if (sp > XB_SPIN_CAP) { atomicAdd(&bar[XB_TMO], 1u); break; } }
    }
    nloc = mine > 0u ? mine : 1u; nx = cnt > 0u ? cnt : 1u;
}

__device__ __forceinline__ void xcd_barrier(const XcdBarrier& b) {
    asm volatile("s_waitcnt vmcnt(0)" ::: "memory");
    __syncthreads();
    if (threadIdx.x == 0) {
        unsigned* bar = b.bar;
        __builtin_amdgcn_s_waitcnt(0);
        unsigned nloc = b.st[0], nx = b.st[1];
        if (nloc == 0u) { xcd_barrier_complete(bar, b.x, nloc, nx); b.st[0] = nloc; b.st[1] = nx; }
        const unsigned old = xb_add(&bar[XB_XSUB(b.x)], 1u);
        const unsigned gen = old / nloc;
        if (old + 1u == (gen + 1u) * nloc) {
            __builtin_amdgcn_fence(__ATOMIC_RELEASE, "agent");
            asm volatile("s_waitcnt vmcnt(0)" ::: "memory");
            const unsigned og = xb_add(&bar[XB_TOP], 1u);
            const unsigned tg = og / nx;
            if (og + 1u == (tg + 1u) * nx) xb_add(&bar[XB_TOPGEN], 1u);
            else XB_SPIN(xb_ld(&bar[XB_TOPGEN]) == tg, bar);
            __builtin_amdgcn_fence(__ATOMIC_ACQUIRE, "agent");
            xb_add(&bar[XB_XGEN(b.x)], 1u);
            asm volatile("s_waitcnt vmcnt(0)" ::: "memory");
        } else {
            XB_SPIN(xb_ld(&bar[XB_XGEN(b.x)]) == gen, bar);
            __builtin_amdgcn_fence(__ATOMIC_ACQUIRE, "agent");
            asm volatile("s_waitcnt vmcnt(0)" ::: "memory");
        }
    }
    __syncthreads();
}


constexpr int LDS_MAIN = 73728;
constexpr int LDS_BYTES = LDS_MAIN + 16;

#if COOP
__global__ void __launch_bounds__(256, 2) fwd_kernel(Params p, int ph0, int ph1, int scan_mask) {
  extern __shared__ __attribute__((aligned(16))) char smem[];
  cg::grid_group grid = cg::this_grid();
  volatile LAS unsigned* xb_st = (volatile LAS unsigned*)(smem + LDS_MAIN);
  if (threadIdx.x == 0) { xb_st[0] = 0u; xb_st[1] = 0u; xb_st[2] = 0u; xb_st[3] = 0u; }
  __syncthreads();
  XcdBarrier xbar = xcd_barrier_post(reinterpret_cast<unsigned*>(p.ws + OFF_BAR), xb_st);
  for (int ph = ph0; ph < ph1; ++ph) {
    if (ph == NPHASES - 1) {
      phase_final(p);
    } else {
      const int l = ph / NPH_LAYER, sub = ph % NPH_LAYER;
      switch (sub) {
        case 0: if (PHM & (1<<0)) run_phase<0>(p, l, smem); break;
        case 1: if (PHM & (1<<1)) run_phase<1>(p, l, smem); break;
        case 2: if (PHM & (1<<2)) run_phase<2>(p, l, smem); break;
        case 3: if (PHM & (1<<3)) phase_scans(p, l, smem, scan_mask); break;
        case 4: if (PHM & (1<<4)) run_phase<4>(p, l, smem); break;
        case 5: if (PHM & (1<<5)) run_phase<5>(p, l, smem); break;
        case 6: if (PHM & (1<<6)) run_phase<6>(p, l, smem); break;
        case 7: if (PHM & (1<<7)) run_phase<7>(p, l, smem); break;
        case 8: if (PHM & (1<<8)) run_phase<8>(p, l, smem); break;
        case 9: if (PHM & (1<<9)) run_phase<9>(p, l, smem); break;
      }
    }
    if (ph + 1 < ph1) {
      if (ph1 > 1000) grid.sync();
      else xcd_barrier(xbar);
    }
  }
}
#else
template <int SUB>
__global__ void __launch_bounds__(256, 2) k_phase(Params p, int l) {
  __shared__ __attribute__((aligned(16))) char smem[65536];
  run_phase<SUB>(p, l, smem);
}
#endif

extern "C" void kernel_launch(void* const* d_in, const int* in_sizes, int n_in, void* d_out, int out_size, void* d_ws,
                              size_t ws_size, hipStream_t stream) {
  if (n_in < 41 || ws_size < WS_NEED) {
    fprintf(stderr, "kernel_launch: bad args n_in=%d ws=%zu need=%zu\n", n_in, ws_size, (size_t)WS_NEED);
    return;
  }
  Params p{};
  for (int i = 0; i < 41; ++i) p.in[i] = (const float*)d_in[i];
  p.out = (float*)d_out;
  p.ws = (char*)d_ws;
#if COOP
  static int grid_blocks = 0;
  if (!grid_blocks) {
    int dev = 0, cus = 0, per_cu = 0;
    hipGetDevice(&dev);
    hipDeviceGetAttribute(&cus, hipDeviceAttributeMultiprocessorCount, dev);
    hipFuncSetAttribute((const void*)fwd_kernel, hipFuncAttributeMaxDynamicSharedMemorySize, LDS_BYTES);
    hipOccupancyMaxActiveBlocksPerMultiprocessor(&per_cu, fwd_kernel, 256, LDS_BYTES);
    if (per_cu > 2) per_cu = 2;
    grid_blocks = cus * per_cu;
  }
#ifdef HYBRID
  for (int ph = 0; ph < NPHASES; ++ph) {
    if (ph % 10 == 3 && ph < 20) {
      const int groups[4] = SCAN_GROUPS;
      for (int gi = 0; gi < 4; ++gi) if (groups[gi]) fwd_kernel<<<grid_blocks, 256, LDS_BYTES, stream>>>(p, ph, ph + 1, groups[gi]);
    } else {
      fwd_kernel<<<grid_blocks, 256, LDS_BYTES, stream>>>(p, ph, ph + 1, 15);
    }
  }
#else
  hipMemsetAsync((char*)d_ws + OFF_BAR, 0, XCD_BAR_WORDS * 4, stream);
  int ph0 = 0, ph1 = NPHASES, smask = 15;
  void* args[] = {&p, &ph0, &ph1, &smask};
  hipError_t e = hipLaunchCooperativeKernel((void*)fwd_kernel, dim3(grid_blocks), dim3(256), args, LDS_BYTES, stream);
  if (e != hipSuccess) fprintf(stderr, "cooperative launch failed: %s (grid %d)\n", hipGetErrorString(e), grid_blocks);
#endif
#else
  const dim3 g(512), b(256);
  for (int l = 0; l < 2; ++l) {
    k_phase<0><<<g, b, 0, stream>>>(p, l);
    k_phase<1><<<g, b, 0, stream>>>(p, l);
    k_phase<2><<<g, b, 0, stream>>>(p, l);
    k_phase<3><<<g, b, 0, stream>>>(p, l);
    k_phase<4><<<g, b, 0, stream>>>(p, l);
    k_phase<5><<<g, b, 0, stream>>>(p, l);
    k_phase<6><<<g, b, 0, stream>>>(p, l);
    k_phase<7><<<g, b, 0, stream>>>(p, l);
    k_phase<8><<<g, b, 0, stream>>>(p, l);
    k_phase<9><<<g, b, 0, stream>>>(p, l);
  }
  k_phase<10><<<g, b, 0, stream>>>(p, 0);
#endif
}
```

```cpp
#include <hip/hip_runtime.h>
#include <hip/hip_cooperative_groups.h>
#include <cstdio>
#include <cstdint>
namespace cg = cooperative_groups;

#ifndef COOP
#define COOP 1
#endif

#define LAS __attribute__((address_space(3)))
typedef unsigned short bf16_t;
typedef __attribute__((ext_vector_type(8))) short bf16x8;
typedef __attribute__((ext_vector_type(4))) float f32x4;
typedef __attribute__((ext_vector_type(4))) unsigned u32x4;

constexpr int T_TOK = 16384, SEQ = 2048, DM = 1024;
constexpr int IN_COLS = 9992, NZ = 5896, ZS = 5904;
constexpr int ZHG = 0, ZRW = 2048, ZS5 = 3840, ZMB = 4352;
constexpr int FFH = 2816;
constexpr int NPH_LAYER = 10, NPHASES = 21;

constexpr size_t OFF_WTIN   = 0;
constexpr size_t OFF_WTGATE = OFF_WTIN + (size_t)5896 * 1024 * 2;
constexpr size_t OFF_WTBR   = OFF_WTGATE + (size_t)4096 * 1024 * 2;
constexpr size_t OFF_WTOUT  = OFF_WTBR + (size_t)4 * 1024 * 512 * 2;
constexpr size_t OFF_WTF1   = OFF_WTOUT + (size_t)1024 * 1024 * 2;
constexpr size_t OFF_WTF2   = OFF_WTF1 + (size_t)5632 * 1024 * 2;
constexpr size_t OFF_WTGLU  = OFF_WTF2 + (size_t)1024 * 2816 * 2;
constexpr size_t OFF_U      = OFF_WTGLU + (size_t)512 * 512 * 2;
constexpr size_t OFF_Z      = OFF_U + (size_t)T_TOK * 1024 * 2;
constexpr size_t OFF_VF     = OFF_Z + (size_t)T_TOK * ZS * 2;
constexpr size_t OFF_BAR    = OFF_VF + (size_t)T_TOK * 512 * 2;
constexpr size_t OFF_WTGATE_B = OFF_BAR + 16384;
constexpr size_t OFF_WB_B     = OFF_WTGATE_B + (size_t)4096 * 1024 * 2;
constexpr size_t OFF_LORA     = OFF_WB_B + (OFF_U - OFF_WTBR);
constexpr size_t LORA_STRIDE  = 524288;
constexpr size_t LO_G2 = 0, LO_W2 = 131072, LO_A2 = 196608, LO_V1 = 262144, LO_V2 = 294912;
constexpr size_t WS_NEED      = OFF_LORA + 2 * LORA_STRIDE;
constexpr size_t DELTA_GATE   = OFF_WTGATE_B - OFF_WTGATE;
constexpr size_t DELTA_WB     = OFF_WB_B - OFF_WTBR;
#define WOFF_GATE(l) (OFF_WTGATE + (size_t)(l) * DELTA_GATE)
#define WOFF(off, l) ((off) + (size_t)(l) * DELTA_WB)

struct Params {
  const float* in[41];
  float* out;
  char* ws;
};

enum { I_X = 0, I_NORM_MIX, I_W_IN, I_W_BRANCH, I_W_OUT, I_NORM_FFN, I_W_FFN_IN, I_W_FFN_OUT, I_NORM_FINAL,
       I_HG_LB, I_HG_NW, I_RW_MU, I_RW_W0, I_RW_W2, I_RW_A0, I_RW_A2, I_RW_G2, I_RW_KK, I_RW_KA, I_RW_RK,
       I_RW_LNW, I_RW_LNB, I_RW_V0, I_RW_V1, I_RW_V2, I_S5_ARE, I_S5_AIM, I_S5_BRE, I_S5_BIM, I_S5_CRE,
       I_S5_CIM, I_S5_D, I_S5_LOGDT, I_S5_WGLU, I_S5_BGLU, I_MB_CONVW, I_MB_CONVB, I_MB_DTB, I_MB_ALOG,
       I_MB_D, I_MB_NW };

__device__ __forceinline__ float bf2f(bf16_t v) { return __uint_as_float(((unsigned)v) << 16); }
typedef __attribute__((ext_vector_type(2))) __bf16 bf16x2_t;
__device__ __forceinline__ unsigned pack2(float a, float b) {
  bf16x2_t v;
  v[0] = (__bf16)a;
  v[1] = (__bf16)b;
  return __builtin_bit_cast(unsigned, v);
}
__device__ __forceinline__ bf16_t f2bf(float f) { return (bf16_t)(pack2(f, 0.f) & 0xffffu); }
__device__ __forceinline__ void store_pair_bf16(bf16_t* p_sub0, const int lane, uint2 a, uint2 b, const bool ok = true) {
  auto rx = __builtin_amdgcn_permlane16_swap(a.x, b.x, false, false);
  auto ry = __builtin_amdgcn_permlane16_swap(a.y, b.y, false, false);
  const int off = ((lane >> 4) & 1) * 16 + (lane >> 5) * 8;
  if (ok) *reinterpret_cast<uint4*>(p_sub0 + off) = uint4{(unsigned)rx[0], (unsigned)ry[0], (unsigned)rx[1], (unsigned)ry[1]};
}
__device__ __forceinline__ float sigmoidf_(float x) { return 1.f / (1.f + __expf(-x)); }
__device__ __forceinline__ float siluf_(float x) { return x / (1.f + __expf(-x)); }
__device__ __forceinline__ float softplusf_(float x) { return x > 20.f ? x : log1pf(__expf(x)); }
__device__ __forceinline__ float gelu_tanh(float x) {
  float u = 0.7978845608028654f * (x + 0.044715f * x * x * x);
  return 0.5f * x * (1.f + tanhf(u));
}
__device__ __forceinline__ float frcp(float x) { return __builtin_amdgcn_rcpf(x); }
__device__ __forceinline__ float fsigmoid(float x) { return frcp(1.f + __expf(-x)); }
__device__ __forceinline__ float fsilu(float x) { return x * frcp(1.f + __expf(-x)); }
__device__ __forceinline__ float fsoftplus(float x) { return x > 20.f ? x : __logf(1.f + __expf(x)); }
__device__ __forceinline__ float ftanh(float x) {
  float e = __expf(2.f * fminf(fmaxf(x, -15.f), 15.f));
  return (e - 1.f) * frcp(e + 1.f);
}
__device__ __forceinline__ float fgelu(float x) {
  float u = 0.7978845608028654f * (x + 0.044715f * x * x * x);
  return 0.5f * x * (1.f + ftanh(u));
}

__device__ __forceinline__ float quad_sum(float x) {
  x += __builtin_bit_cast(float, __builtin_amdgcn_update_dpp(0, __builtin_bit_cast(int, x), 0xB1, 0xF, 0xF, true));
  x += __builtin_bit_cast(float, __builtin_amdgcn_update_dpp(0, __builtin_bit_cast(int, x), 0x4E, 0xF, 0xF, true));
  return x;
}
__device__ __forceinline__ float oct_sum(float x) {
  x = quad_sum(x);
  x += __builtin_bit_cast(float, __builtin_amdgcn_update_dpp(0, __builtin_bit_cast(int, x), 0x141, 0xF, 0xF, true));
  return x;
}
__device__ __forceinline__ float sum16(float x) {
  x = oct_sum(x);
  x += __builtin_bit_cast(float, __builtin_amdgcn_update_dpp(0, __builtin_bit_cast(int, x), 0x140, 0xF, 0xF, true));
  return x;
}
__device__ __forceinline__ float sum64(float x) {
  x = sum16(x); x += __shfl_xor(x, 16); x += __shfl_xor(x, 32);
  return x;
}

__device__ __forceinline__ int opaque_tid() {
  int t = threadIdx.x;
  asm volatile("" : "+v"(t));
  return t;
}

template <int BN>
__device__ __forceinline__ void gemm_mainloop(f32x4 (&acc)[4][BN / 32], const bf16_t* A, int lda, int m0,
                                              const bf16_t* Bt, int ldb, int n0, int nmax, int K, char* smem, const int tid) {
  const int lane = tid & 63, wid = tid >> 6, wm = wid >> 1, wn = wid & 1;
  const int q = tid & 7, r0 = tid >> 3;
  unsigned offA[4], offB[BN / 32];
#pragma unroll
  for (int i = 0; i < 4; ++i) offA[i] = ((unsigned)(m0 + r0 + 32 * i) * (unsigned)lda + (unsigned)q * 8u) * 2u;
#pragma unroll
  for (int i = 0; i < BN / 32; ++i) {
    int row = n0 + r0 + 32 * i;
    row = row < nmax ? row : nmax;
    offB[i] = ((unsigned)row * (unsigned)ldb + (unsigned)q * 8u) * 2u;
  }
  const unsigned sto = (unsigned)r0 * 128u + (unsigned)((q ^ ((r0 >> 1) & 7)) << 4);
  unsigned aoff[4], boff[BN / 32];
#pragma unroll
  for (int mi = 0; mi < 4; ++mi) {
    int row = wm * 64 + mi * 16 + (lane & 15);
    aoff[mi] = (unsigned)row * 128u + (unsigned)(((lane >> 4) ^ ((row >> 1) & 7)) << 4);
  }
#pragma unroll
  for (int ni = 0; ni < BN / 32; ++ni) {
    int row = wn * (BN / 2) + ni * 16 + (lane & 15);
    boff[ni] = (unsigned)row * 128u + (unsigned)(((lane >> 4) ^ ((row >> 1) & 7)) << 4);
  }
  const char* Ab = reinterpret_cast<const char*>(A);
  const char* Bb = reinterpret_cast<const char*>(Bt);
  const int nk = K >> 6;
  constexpr bool WIDE = (BN == 128);
  u32x4 Ra0, Ra1, Ra2, Ra3, Rb0, Rb1, Rb2, Rb3;
  u32x4 Qa0, Qa1, Qa2, Qa3, Qb0, Qb1, Qb2, Qb3;
#define GLOAD(P, TILE)                                                         \
  {                                                                            \
    const char* Ak_ = Ab + (size_t)(TILE) * 128;                               \
    const char* Bk_ = Bb + (size_t)(TILE) * 128;                               \
    P##a0 = *reinterpret_cast<const u32x4*>(Ak_ + offA[0]);                    \
    P##a1 = *reinterpret_cast<const u32x4*>(Ak_ + offA[1]);                    \
    P##a2 = *reinterpret_cast<const u32x4*>(Ak_ + offA[2]);                    \
    P##a3 = *reinterpret_cast<const u32x4*>(Ak_ + offA[3]);                    \
    P##b0 = *reinterpret_cast<const u32x4*>(Bk_ + offB[0]);                    \
    P##b1 = *reinterpret_cast<const u32x4*>(Bk_ + offB[1]);                    \
    if (WIDE) {                                                                \
      P##b2 = *reinterpret_cast<const u32x4*>(Bk_ + offB[BN / 32 - 2]);        \
      P##b3 = *reinterpret_cast<const u32x4*>(Bk_ + offB[BN / 32 - 1]);        \
    }                                                                          \
  }
#define SSTORE(P, BUF)                                                         \
  {                                                                            \
    char* ad_ = smem + (BUF) * 16384 + sto;                                    \
    char* bd_ = smem + 32768 + (BUF) * (BN * 128) + sto;                       \
    *reinterpret_cast<u32x4*>(ad_) = P##a0;                                    \
    *reinterpret_cast<u32x4*>(ad_ + 4096) = P##a1;                             \
    *reinterpret_cast<u32x4*>(ad_ + 8192) = P##a2;                             \
    *reinterpret_cast<u32x4*>(ad_ + 12288) = P##a3;                            \
    *reinterpret_cast<u32x4*>(bd_) = P##b0;                                    \
    *reinterpret_cast<u32x4*>(bd_ + 4096) = P##b1;                             \
    if (WIDE) {                                                                \
      *reinterpret_cast<u32x4*>(bd_ + 8192) = P##b2;                           \
      *reinterpret_cast<u32x4*>(bd_ + 12288) = P##b3;                          \
    }                                                                          \
  }
#define COMPUTE(BUF)                                                           \
  {                                                                            \
    const char* a_s = smem + (BUF) * 16384;                                    \
    const char* b_s = smem + 32768 + (BUF) * (BN * 128);                       \
    _Pragma("unroll") for (int ks = 0; ks < 2; ++ks) {                         \
      bf16x8 af[4], bfr[BN / 32];                                              \
      _Pragma("unroll") for (int mi = 0; mi < 4; ++mi)                         \
          af[mi] = *reinterpret_cast<const bf16x8*>(a_s + (aoff[mi] ^ (ks * 64)));       \
      _Pragma("unroll") for (int ni = 0; ni < BN / 32; ++ni)                   \
          bfr[ni] = *reinterpret_cast<const bf16x8*>(b_s + (boff[ni] ^ (ks * 64)));      \
      _Pragma("unroll") for (int mi = 0; mi < 4; ++mi)                         \
        _Pragma("unroll") for (int ni = 0; ni < BN / 32; ++ni)                 \
          acc[mi][ni] = __builtin_amdgcn_mfma_f32_16x16x32_bf16(bfr[ni], af[mi], acc[mi][ni], 0, 0, 0); \
    }                                                                          \
  }
  if constexpr (WIDE && false) {
    GLOAD(R, 0);
    SSTORE(R, 0);
    GLOAD(R, 1);
    if (nk > 2) GLOAD(Q, 2);
    __syncthreads();
#pragma unroll 1
    for (int kt = 0; kt < nk; kt += 2) {
      __builtin_amdgcn_sched_barrier(0);
      COMPUTE(0);
      __builtin_amdgcn_sched_barrier(0);
      SSTORE(R, 1);
      if (kt + 3 < nk) GLOAD(R, kt + 3);
      __syncthreads();
      __builtin_amdgcn_sched_barrier(0);
      COMPUTE(1);
      __builtin_amdgcn_sched_barrier(0);
      if (kt + 2 < nk) SSTORE(Q, 0);
      if (kt + 4 < nk) GLOAD(Q, kt + 4);
      __syncthreads();
    }
  } else {
    GLOAD(R, 0);
    SSTORE(R, 0);
    __syncthreads();
#pragma unroll 1
    for (int kt = 0; kt < nk; ++kt) {
      const int buf = kt & 1;
      const bool more = (kt + 1 < nk);
      if (more) GLOAD(R, kt + 1);
      __builtin_amdgcn_sched_barrier(0);
      COMPUTE(buf);
      __builtin_amdgcn_sched_barrier(0);
      if (more) SSTORE(R, buf ^ 1);
      __syncthreads();
    }
  }
#undef GLOAD
#undef SSTORE
#undef COMPUTE
}

template <int BN>
__device__ __forceinline__ void zero_acc(f32x4 (&acc)[4][BN / 32]) {
#pragma unroll
  for (int mi = 0; mi < 4; ++mi)
#pragma unroll
    for (int ni = 0; ni < BN / 32; ++ni) acc[mi][ni] = f32x4{0.f, 0.f, 0.f, 0.f};
}

#define RAW_BARRIER() do { asm volatile("s_waitcnt lgkmcnt(0)" ::: "memory"); __builtin_amdgcn_s_barrier(); } while (0)
template <int MROWS>
__device__ __forceinline__ void gemm_mainloop_glds(f32x4 (&acc)[MROWS / 32][4], const bf16_t* A, int lda, int m0, const bf16_t* Bt,
                                                   int ldb, int n0, int nmax, int K, char* smem, const int tid) {
  constexpr int NA = MROWS / 64;
  constexpr int NMI = MROWS / 32;
  constexpr int STAGE = (MROWS + 128) * 64;
  constexpr int BOFF = MROWS * 64;
  const int lane = tid & 63, wid = tid >> 6, wm = wid >> 1, wn = wid & 1;
  unsigned gA[NA], gB[2];
#pragma unroll
  for (int i = 0; i < NA; ++i) {
    const int row = (wid * NA + i) * 16 + (lane >> 2);
    const int q = (lane & 3) ^ ((row >> 2) & 3);
    gA[i] = ((unsigned)(m0 + row) * (unsigned)lda + (unsigned)q * 8u) * 2u;
  }
#pragma unroll
  for (int i = 0; i < 2; ++i) {
    const int row = (wid * 2 + i) * 16 + (lane >> 2);
    const int q = (lane & 3) ^ ((row >> 2) & 3);
    int grow = n0 + row;
    grow = grow < nmax ? grow : nmax;
    gB[i] = ((unsigned)grow * (unsigned)ldb + (unsigned)q * 8u) * 2u;
  }
  unsigned aoff[NMI], boff[4];
#pragma unroll
  for (int mi = 0; mi < NMI; ++mi) {
    int row = wm * (MROWS / 2) + mi * 16 + (lane & 15);
    aoff[mi] = (unsigned)row * 64u + (unsigned)(((lane >> 4) ^ ((row >> 2) & 3)) << 4);
  }
#pragma unroll
  for (int ni = 0; ni < 4; ++ni) {
    int row = wn * 64 + ni * 16 + (lane & 15);
    boff[ni] = (unsigned)BOFF + (unsigned)row * 64u + (unsigned)(((lane >> 4) ^ ((row >> 2) & 3)) << 4);
  }
  const char* Ab = reinterpret_cast<const char*>(A);
  const char* Bb = reinterpret_cast<const char*>(Bt);
  const int nk = K >> 5;
  char* ldsA = smem + wid * (NA * 1024);
  char* ldsB = smem + BOFF + wid * 2048;
#define BG_GLDS(TILE, ST)                                                                                           \
  {                                                                                                                 \
    const char* Ak_ = Ab + (size_t)(TILE) * 64;                                                                     \
    const char* Bk_ = Bb + (size_t)(TILE) * 64;                                                                     \
    char* la_ = ldsA + (ST) * STAGE;                                                                                \
    char* lb_ = ldsB + (ST) * STAGE;                                                                                \
    _Pragma("unroll") for (int i_ = 0; i_ < NA; ++i_)                                                               \
      __builtin_amdgcn_global_load_lds((const unsigned*)(Ak_ + gA[i_]), (LAS unsigned*)(la_ + i_ * 1024), 16, 0, 0); \
    __builtin_amdgcn_global_load_lds((const unsigned*)(Bk_ + gB[0]), (LAS unsigned*)(lb_), 16, 0, 0);              \
    __builtin_amdgcn_global_load_lds((const unsigned*)(Bk_ + gB[1]), (LAS unsigned*)(lb_ + 1024), 16, 0, 0);       \
  }
#define BG_COMPUTE(ST)                                                                                              \
  {                                                                                                                 \
    const char* s_ = smem + (ST) * STAGE;                                                                           \
    bf16x8 bfr[4], af[NMI];                                                                                         \
    _Pragma("unroll") for (int ni = 0; ni < 4; ++ni) bfr[ni] = *reinterpret_cast<const bf16x8*>(s_ + boff[ni]);     \
    _Pragma("unroll") for (int mi = 0; mi < NMI; ++mi) af[mi] = *reinterpret_cast<const bf16x8*>(s_ + aoff[mi]);    \
    __builtin_amdgcn_sched_barrier(0);                                                                              \
    _Pragma("unroll") for (int mi = 0; mi < NMI; ++mi)                                                              \
      _Pragma("unroll") for (int ni = 0; ni < 4; ++ni)                                                              \
        acc[mi][ni] = __builtin_amdgcn_mfma_f32_16x16x32_bf16(bfr[ni], af[mi], acc[mi][ni], 0, 0, 0);               \
  }
  asm volatile("s_waitcnt vmcnt(0)" ::: "memory");
  BG_GLDS(0, 0);
  BG_GLDS(1, 1);
  int st = 0;
#pragma unroll 1
  for (int kt = 0; kt < nk - 1; ++kt) {
    if constexpr (NA == 4) asm volatile("s_waitcnt vmcnt(6)" ::: "memory");
    else asm volatile("s_waitcnt vmcnt(4)" ::: "memory");
    RAW_BARRIER();
    if (kt + 2 < nk) {
      const int st2 = (st >= 1) ? st - 1 : 2;
      BG_GLDS(kt + 2, st2);
    }
    __builtin_amdgcn_sched_barrier(0);
    BG_COMPUTE(st);
    __builtin_amdgcn_sched_barrier(0);
    st = (st == 2) ? 0 : st + 1;
  }
  asm volatile("s_waitcnt vmcnt(0)" ::: "memory");
  RAW_BARRIER();
  BG_COMPUTE(st);
  RAW_BARRIER();
#undef BG_GLDS
#undef BG_COMPUTE
}
__device__ __forceinline__ void gemm_mainloop_big(f32x4 (&acc)[8][4], const bf16_t* A, int lda, int m0, const bf16_t* Bt,
                                                  int ldb, int n0, int nmax, int K, char* smem, const int tid) {
  gemm_mainloop_glds<256>(acc, A, lda, m0, Bt, ldb, n0, nmax, K, smem, tid);
}

__device__ __forceinline__ void zero_acc_big(f32x4 (&acc)[8][4]) {
#pragma unroll
  for (int mi = 0; mi < 8; ++mi)
#pragma unroll
    for (int ni = 0; ni < 4; ++ni) acc[mi][ni] = f32x4{0.f, 0.f, 0.f, 0.f};
}

__device__ __forceinline__ void conv_tile(const float* src, int ld, int nlimit, int k0, int n0, bf16_t* dst, int Kd, int mode,
                                          char* smem, const int tid) {
  float* sT = reinterpret_cast<float*>(smem);
#pragma unroll
  for (int i = 0; i < 16; ++i) {
    int kk = i * 4 + (tid >> 6), nn = tid & 63;
    float v = (n0 + nn < nlimit) ? src[(size_t)(k0 + kk) * ld + n0 + nn] : 0.f;
    sT[kk * 65 + nn] = v;
  }
  __syncthreads();
  {
    int nn = tid >> 2, kq = tid & 3;
    int n = n0 + nn;
    if (n < nlimit) {
      int drow = n;
      if (mode == 1) {
        if (n < FFH) drow = (n >> 4) * 32 + (n & 15);
        else { int j = n - FFH; drow = (j >> 4) * 32 + 16 + (j & 15); }
      }
      unsigned pk[8];
#pragma unroll
      for (int j = 0; j < 8; ++j) pk[j] = pack2(sT[(kq * 16 + 2 * j) * 65 + nn], sT[(kq * 16 + 2 * j + 1) * 65 + nn]);
      uint4* d = reinterpret_cast<uint4*>(dst + (size_t)drow * Kd + k0 + kq * 16);
      d[0] = uint4{pk[0], pk[1], pk[2], pk[3]};
      d[1] = uint4{pk[4], pk[5], pk[6], pk[7]};
    }
  }
  __syncthreads();
}

__device__ __forceinline__ void rmsnorm_row_to_bf16(const float* x, const float* w, bf16_t* out, const int lane) {
  float4 v[4];
  float ss = 0.f;
#pragma unroll
  for (int i = 0; i < 4; ++i) {
    v[i] = *reinterpret_cast<const float4*>(x + i * 256 + lane * 4);
    ss += v[i].x * v[i].x + v[i].y * v[i].y + v[i].z * v[i].z + v[i].w * v[i].w;
  }
  ss = sum64(ss);
  float rstd = rsqrtf(ss * (1.f / 1024.f) + 1e-6f);
#pragma unroll
  for (int i = 0; i < 4; ++i) {
    float4 ww = *reinterpret_cast<const float4*>(w + i * 256 + lane * 4);
    uint2 o;
    o.x = pack2(v[i].x * rstd * ww.x, v[i].y * rstd * ww.y);
    o.y = pack2(v[i].z * rstd * ww.z, v[i].w * rstd * ww.w);
    *reinterpret_cast<uint2*>(out + i * 256 + lane * 4) = o;
  }
}

constexpr int CT_IN = 157 * 16, CT_BR = 512, CT_OUT = 256, CT_F1 = 88 * 16, CT_F2 = 44 * 16, CT_GLU = 64;
constexpr int CT_TOTAL = CT_IN + CT_BR + CT_OUT + CT_F1 + CT_F2 + CT_GLU;

__device__ __forceinline__ void convert_one(const Params& p, int l, int c, char* smem, const int tid) {
  char* ws = p.ws;
  if (c < CT_IN) {
    int nt = c >> 4, kt = c & 15;
    const float* src = p.in[I_W_IN] + (size_t)l * 1024 * IN_COLS;
    if (nt < 64) conv_tile(src, IN_COLS, IN_COLS, kt * 64, nt * 64, (bf16_t*)(ws + WOFF_GATE(l)), 1024, 0, smem, tid);
    else conv_tile(src + 4096, IN_COLS, IN_COLS - 4096, kt * 64, (nt - 64) * 64, (bf16_t*)(ws + OFF_WTIN), 1024, 0, smem, tid);
    return;
  }
  c -= CT_IN;
  if (c < CT_BR) {
    int kb = c >> 7, r = c & 127, nt = r >> 3, kt = r & 7;
    const float* src = p.in[I_W_BRANCH] + ((size_t)l * 4 + kb) * 512 * 1024;
    conv_tile(src, 1024, 1024, kt * 64, nt * 64, (bf16_t*)(ws + WOFF(OFF_WTBR, l)) + (size_t)kb * 1024 * 512, 512, 0, smem, tid);
    return;
  }
  c -= CT_BR;
  if (c < CT_OUT) {
    int nt = c >> 4, kt = c & 15;
    conv_tile(p.in[I_W_OUT] + (size_t)l * 1024 * 1024, 1024, 1024, kt * 64, nt * 64, (bf16_t*)(ws + WOFF(OFF_WTOUT, l)), 1024, 0, smem, tid);
    return;
  }
  c -= CT_OUT;
  if (c < CT_F1) {
    int nt = c >> 4, kt = c & 15;
    conv_tile(p.in[I_W_FFN_IN] + (size_t)l * 1024 * 5632, 5632, 5632, kt * 64, nt * 64, (bf16_t*)(ws + WOFF(OFF_WTF1, l)), 1024, 1, smem, tid);
    return;
  }
  c -= CT_F1;
  if (c < CT_F2) {
    int nt = c / 44, kt = c % 44;
    conv_tile(p.in[I_W_FFN_OUT] + (size_t)l * FFH * 1024, 1024, 1024, kt * 64, nt * 64, (bf16_t*)(ws + WOFF(OFF_WTF2, l)), FFH, 0, smem, tid);
    return;
  }
  c -= CT_F2;
  {
    int nt = c >> 3, kt = c & 7;
    conv_tile(p.in[I_S5_WGLU] + (size_t)l * 512 * 512, 512, 512, kt * 64, nt * 64, (bf16_t*)(ws + WOFF(OFF_WTGLU, l)), 512, 0, smem, tid);
  }
}

constexpr int CT_LORA = 41;
__device__ __forceinline__ void convert_lora(const Params& p, int l, int c, char* smem, const int tid) {
  char* lo = p.ws + OFF_LORA + (size_t)l * LORA_STRIDE;
  if (c < 16) { int nt = c >> 1, kt = c & 1;
    conv_tile(p.in[I_RW_G2] + (size_t)l * 128 * 512, 512, 512, kt * 64, nt * 64, (bf16_t*)(lo + LO_G2), 128, 0, smem, tid); return; }
  c -= 16;
  if (c < 8) { conv_tile(p.in[I_RW_W2] + (size_t)l * 64 * 512, 512, 512, 0, c * 64, (bf16_t*)(lo + LO_W2), 64, 0, smem, tid); return; }
  c -= 8;
  if (c < 8) { conv_tile(p.in[I_RW_A2] + (size_t)l * 64 * 512, 512, 512, 0, c * 64, (bf16_t*)(lo + LO_A2), 64, 0, smem, tid); return; }
  c -= 8;
  if (l == 0) return;
  if (c < 8) { conv_tile(p.in[I_RW_V1] + (size_t)(l - 1) * 512 * 32, 32, 32, c * 64, 0, (bf16_t*)(lo + LO_V1), 512, 0, smem, tid); return; }
  {
    const float* src = p.in[I_RW_V2] + (size_t)(l - 1) * 32 * 512;
    bf16_t* dst = (bf16_t*)(lo + LO_V2);
    for (int e = tid; e < 32 * 512; e += 256) { int ch = e >> 5, r = e & 31; dst[e] = f2bf(src[r * 512 + ch]); }
  }
}

template <int J>
__device__ __forceinline__ void lora_mfma(const char* sIn, int rowb, const bf16_t* Wt, f32x4 (&acc)[8], const int tid) {
  const int lane = tid & 63, w = tid >> 6;
#pragma unroll
  for (int i = 0; i < 8; ++i) acc[i] = f32x4{0.f, 0.f, 0.f, 0.f};
#pragma unroll
  for (int ks = 0; ks < J / 32; ++ks) {
    const bf16x8 a = *reinterpret_cast<const bf16x8*>(sIn + (lane & 15) * rowb + (ks * 32 + 8 * (lane >> 4)) * 2);
#pragma unroll
    for (int i = 0; i < 8; ++i) {
      const bf16x8 b = *reinterpret_cast<const bf16x8*>(Wt + (size_t)((w * 8 + i) * 16 + (lane & 15)) * J + ks * 32 + 8 * (lane >> 4));
      acc[i] = __builtin_amdgcn_mfma_f32_16x16x32_bf16(a, b, acc[i], 0, 0, 0);
    }
  }
}

__device__ void phase_convert_norm(const Params& p, int l, char* smem) {
  const int tid = opaque_tid();
  constexpr int CT_IN_ONLY = CT_IN - 1024;
  const int nconv = (l == 0) ? CT_IN_ONLY + 2 * CT_LORA : 0;
  const int ntask = nconv + T_TOK / 4;
  const float* xsrc = (l == 0) ? p.in[I_X] : p.out;
  for (int t = blockIdx.x; t < ntask; t += gridDim.x) {
    if (t < nconv) {
      if (t < CT_IN_ONLY) convert_one(p, l, t + 1024, smem, tid);
      else { int c = t - CT_IN_ONLY; convert_lora(p, c / CT_LORA, c % CT_LORA, smem, tid); __syncthreads(); }
    } else {
      int row = (t - nconv) * 4 + (tid >> 6);
      rmsnorm_row_to_bf16(xsrc + (size_t)row * DM, p.in[I_NORM_MIX] + l * DM, (bf16_t*)(p.ws + OFF_U) + (size_t)row * DM, tid & 63);
    }
  }
}

__device__ void phase_norm_only(const Params& p, const float* xsrc, const float* w) {
  const int tid = opaque_tid();
  for (int t = blockIdx.x; t < T_TOK / 4; t += gridDim.x) {
    int row = t * 4 + (tid >> 6);
    rmsnorm_row_to_bf16(xsrc + (size_t)row * DM, w, (bf16_t*)(p.ws + OFF_U) + (size_t)row * DM, tid & 63);
  }
}

__device__ __forceinline__ bool tile_map(int t, int NT, int& mt, int& nt) {
  const int x = t & 7, r = t >> 3;
  const int cnt = (NT + 7) >> 3;
  const int ni = r % cnt;
  mt = r / cnt;
  nt = x + 8 * ni;
  return nt < NT;
}
__device__ __forceinline__ int tile_count(int MT, int NT) { return 8 * MT * ((NT + 7) >> 3); }

__device__ void phase_inproj(const Params& p, char* smem) {
  const bf16_t* U = (const bf16_t*)(p.ws + OFF_U);
  const bf16_t* Wt = (const bf16_t*)(p.ws + OFF_WTIN);
  bf16_t* Z = (bf16_t*)(p.ws + OFF_Z);
  const int tid = opaque_tid();
  const int lane = tid & 63, wid = tid >> 6, wm = wid >> 1, wn = wid & 1;
  constexpr int NT = 47;
  for (int t = blockIdx.x; t < tile_count(64, NT); t += gridDim.x) {
    int mt, nt;
    if (!tile_map(t, NT, mt, nt)) continue;
    f32x4 acc[8][4];
    zero_acc_big(acc);
    gemm_mainloop_big(acc, U, 1024, mt * 256, Wt, 1024, nt * 128, NZ - 1, 1024, smem, tid);
#pragma unroll
    for (int mi = 0; mi < 8; ++mi)
#pragma unroll
      for (int np = 0; np < 2; ++np) {
        const int colb = nt * 128 + wn * 64 + np * 32;
        const int row = mt * 256 + wm * 128 + mi * 16 + (lane & 15);
        uint2 a, b;
        a.x = pack2(acc[mi][2 * np][0], acc[mi][2 * np][1]);
        a.y = pack2(acc[mi][2 * np][2], acc[mi][2 * np][3]);
        b.x = pack2(acc[mi][2 * np + 1][0], acc[mi][2 * np + 1][1]);
        b.y = pack2(acc[mi][2 * np + 1][2], acc[mi][2 * np + 1][3]);
        const int mycol = colb + ((lane >> 4) & 1) * 16 + (lane >> 5) * 8;
        store_pair_bf16(Z + (size_t)row * ZS + colb, lane, a, b, mycol < NZ);
      }
  }
}

template <int J>
__device__ __forceinline__ void lora_mm(const float* sIn, const float* W, float (&a0)[16], float (&a1)[16], const int tid) {
#pragma unroll
  for (int i = 0; i < 16; ++i) { a0[i] = 0.f; a1[i] = 0.f; }
#pragma unroll 8
  for (int j = 0; j < J; ++j) {
    float w0 = W[j * 512 + tid], w1 = W[j * 512 + tid + 256];
    const float4* x4 = reinterpret_cast<const float4*>(sIn + j * 16);
#pragma unroll
    for (int q = 0; q < 4; ++q) {
      float4 x = x4[q];
      a0[q * 4 + 0] = fmaf(w0, x.x, a0[q * 4 + 0]); a1[q * 4 + 0] = fmaf(w1, x.x, a1[q * 4 + 0]);
      a0[q * 4 + 1] = fmaf(w0, x.y, a0[q * 4 + 1]); a1[q * 4 + 1] = fmaf(w1, x.y, a1[q * 4 + 1]);
      a0[q * 4 + 2] = fmaf(w0, x.z, a0[q * 4 + 2]); a1[q * 4 + 2] = fmaf(w1, x.z, a1[q * 4 + 2]);
      a0[q * 4 + 3] = fmaf(w0, x.w, a0[q * 4 + 3]); a1[q * 4 + 3] = fmaf(w1, x.w, a1[q * 4 + 3]);
    }
  }
}

__device__ __forceinline__ float rw_shift(const bf16_t* Z, int row, int s, int rc, float mu) {
  float cur = bf2f(Z[(size_t)row * ZS + ZRW + rc]);
  float prev = (s > 0) ? bf2f(Z[(size_t)(row - 1) * ZS + ZRW + rc]) : 0.f;
  return cur + (prev - cur) * mu;
}

__device__ void phase_rwprep(const Params& p, int l, char* smem) {
  const bf16_t* Z = (const bf16_t*)(p.ws + OFF_Z);
  bf16_t* LW = (bf16_t*)(p.ws + OFF_U);
  bf16_t* LA = LW + (size_t)T_TOK * 512;
  bf16_t* VF = (bf16_t*)(p.ws + OFF_VF);
  const char* lo = p.ws + OFF_LORA + (size_t)l * LORA_STRIDE;
  char* sXw = smem;
  char* sXa = smem + 2304;
  char* sZv = smem + 4608;
  float* sTmpF = reinterpret_cast<float*>(smem + 4608 + 16640);
  char* sTmp = smem + 4608 + 16640 + 4096;
  const float* mu = p.in[I_RW_MU] + l * 1792;
  const int tid = opaque_tid(), lane = tid & 63, w = tid >> 6;
  for (int t = blockIdx.x; t < T_TOK / 16; t += gridDim.x) {
    const int row0 = t * 16;
    for (int e = tid; e < 2048; e += 256) {
      int which = e >> 10, r = e & 1023, tok = r >> 6, j = r & 63;
      int row = row0 + tok, sq = row & (SEQ - 1);
      int rc = 1536 + which * 64 + j;
      float z = rw_shift(Z, row, sq, rc, mu[rc]);
      if (which == 0) *reinterpret_cast<bf16_t*>(sXw + tok * 144 + j * 2) = f2bf(ftanh(z));
      else *reinterpret_cast<bf16_t*>(sXa + tok * 144 + j * 2) = f2bf(z);
    }
    {
      float m0 = mu[1024 + tid], m1 = mu[1024 + tid + 256];
#pragma unroll 4
      for (int tok = 0; tok < 16; ++tok) {
        int row = row0 + tok, sq = row & (SEQ - 1);
        bf16_t z0 = f2bf(rw_shift(Z, row, sq, 1024 + tid, m0));
        bf16_t z1 = f2bf(rw_shift(Z, row, sq, 1024 + tid + 256, m1));
        *reinterpret_cast<bf16_t*>(sZv + tok * 1040 + tid * 2) = z0;
        *reinterpret_cast<bf16_t*>(sZv + tok * 1040 + (tid + 256) * 2) = z1;
        if (l == 0) {
          VF[(size_t)row * 512 + tid] = z0;
          VF[(size_t)row * 512 + tid + 256] = z1;
        }
      }
    }
    __syncthreads();
    f32x4 acc[8];
    lora_mfma<64>(sXw, 144, (const bf16_t*)(lo + LO_W2), acc, tid);
#pragma unroll
    for (int i = 0; i < 8; ++i)
#pragma unroll
      for (int jj = 0; jj < 4; ++jj)
        LW[(size_t)(row0 + (lane >> 4) * 4 + jj) * 512 + (w * 8 + i) * 16 + (lane & 15)] = f2bf(acc[i][jj]);
    lora_mfma<64>(sXa, 144, (const bf16_t*)(lo + LO_A2), acc, tid);
#pragma unroll
    for (int i = 0; i < 8; ++i)
#pragma unroll
      for (int jj = 0; jj < 4; ++jj)
        LA[(size_t)(row0 + (lane >> 4) * 4 + jj) * 512 + (w * 8 + i) * 16 + (lane & 15)] = f2bf(acc[i][jj]);
    if (l > 0) {
      {
        const bf16_t* v1t = (const bf16_t*)(lo + LO_V1);
        const int ntile = w & 1, kh = w >> 1;
        f32x4 tacc = f32x4{0.f, 0.f, 0.f, 0.f};
#pragma unroll
        for (int ks = 0; ks < 8; ++ks) {
          const int k0 = (kh * 8 + ks) * 32 + 8 * (lane >> 4);
          const bf16x8 a = *reinterpret_cast<const bf16x8*>(sZv + (lane & 15) * 1040 + k0 * 2);
          const bf16x8 b = *reinterpret_cast<const bf16x8*>(v1t + (size_t)(ntile * 16 + (lane & 15)) * 512 + k0);
          tacc = __builtin_amdgcn_mfma_f32_16x16x32_bf16(a, b, tacc, 0, 0, 0);
        }
#pragma unroll
        for (int jj = 0; jj < 4; ++jj)
          sTmpF[(kh * 16 + (lane >> 4) * 4 + jj) * 32 + ntile * 16 + (lane & 15)] = tacc[jj];
      }
      __syncthreads();
      for (int e = tid; e < 512; e += 256) {
        int tok = e >> 5, r = e & 31;
        *reinterpret_cast<bf16_t*>(sTmp + tok * 80 + r * 2) = f2bf(sTmpF[tok * 32 + r] + sTmpF[(16 + tok) * 32 + r]);
      }
      __syncthreads();
      lora_mfma<32>(sTmp, 80, (const bf16_t*)(lo + LO_V2), acc, tid);
      const float* v0 = p.in[I_RW_V0] + (size_t)(l - 1) * 512;
#pragma unroll
      for (int i = 0; i < 8; ++i) {
        const int ch = (w * 8 + i) * 16 + (lane & 15);
        const float b0 = v0[ch];
#pragma unroll
        for (int jj = 0; jj < 4; ++jj) {
          const int tok = (lane >> 4) * 4 + jj;
          const float zv = bf2f(*reinterpret_cast<const bf16_t*>(sZv + tok * 1040 + ch * 2));
          const size_t idx = (size_t)(row0 + tok) * 512 + ch;
          const float vf = bf2f(VF[idx]);
          VF[idx] = f2bf(zv + (vf - zv) * fsigmoid(b0 + acc[i][jj]));
        }
      }
    }
    __syncthreads();
  }
}

__device__ void hg_scan(const Params& p, int l, int task, char* smem) {
  const int b = task >> 3, h = (task >> 1) & 3, vg = task & 1;
  float* sFg = reinterpret_cast<float*>(smem);
  float* sQs = sFg + 16 * 128;
  float* sO = sQs + 16 * 128;
  float* sVv = sO + 4 * 16 * 64;
  const int tid = opaque_tid(), w = tid >> 6, lane = tid & 63;
  bf16_t* Z = (bf16_t*)(p.ws + OFF_Z) + (size_t)b * SEQ * ZS;
  const int ks = tid & 127;
  float lb = 0.f;
  if (l > 0) {
    float x0 = p.in[I_HG_LB][h * 128 + ks], x1 = p.in[I_HG_LB][512 + h * 128 + ks];
    float m = fmaxf(x0, x1), e0 = expf(x0 - m), e1 = expf(x1 - m);
    lb = e1 / (e0 + e1);
  }
  float s[32];
#pragma unroll
  for (int j = 0; j < 32; ++j) s[j] = 0.f;
  const int vcol = ZHG + 1024 + h * 128 + vg * 64;
  const int qcol = ZHG + h * 128 + ks;
  bf16_t rq0, rq1, rq2, rq3, rq4, rq5, rq6, rq7, rf0, rf1, rf2, rf3, rf4, rf5, rf6, rf7, rv0, rv1, rv2, rv3;
#define HG_LOAD(T0)                                                                                \
  {                                                                                                \
    const bf16_t* zb = Z + (size_t)((T0) + (tid >> 7)) * ZS + qcol;                                \
    rq0 = zb[0]; rf0 = zb[512]; zb += 2 * ZS; rq1 = zb[0]; rf1 = zb[512]; zb += 2 * ZS;            \
    rq2 = zb[0]; rf2 = zb[512]; zb += 2 * ZS; rq3 = zb[0]; rf3 = zb[512]; zb += 2 * ZS;            \
    rq4 = zb[0]; rf4 = zb[512]; zb += 2 * ZS; rq5 = zb[0]; rf5 = zb[512]; zb += 2 * ZS;            \
    rq6 = zb[0]; rf6 = zb[512]; zb += 2 * ZS; rq7 = zb[0]; rf7 = zb[512];                          \
    const bf16_t* zv = Z + (size_t)((T0) + w) * ZS + vcol + lane;                                  \
    rv0 = zv[0]; rv1 = zv[4 * ZS]; rv2 = zv[8 * ZS]; rv3 = zv[12 * ZS];                            \
  }
#define HG_PUT1(I, RQ, RF)                                                                         \
  {                                                                                                \
    int t = (tid >> 7) + 2 * (I);                                                                  \
    sFg[t * 128 + ks] = fmaxf(lb + (1.f - lb) * fsigmoid(bf2f(RF)), 1e-30f);                       \
    sQs[t * 128 + ks] = fsilu(bf2f(RQ));                                                           \
  }
#define HG_PROCESS()                                                                               \
  {                                                                                                \
    HG_PUT1(0, rq0, rf0) HG_PUT1(1, rq1, rf1) HG_PUT1(2, rq2, rf2) HG_PUT1(3, rq3, rf3)            \
    HG_PUT1(4, rq4, rf4) HG_PUT1(5, rq5, rf5) HG_PUT1(6, rq6, rf6) HG_PUT1(7, rq7, rf7)            \
    sVv[(w)*64 + lane] = bf2f(rv0); sVv[(w + 4) * 64 + lane] = bf2f(rv1);                          \
    sVv[(w + 8) * 64 + lane] = bf2f(rv2); sVv[(w + 12) * 64 + lane] = bf2f(rv3);                   \
  }
  HG_LOAD(0);
  HG_PROCESS();
  __syncthreads();
  constexpr int NCH = SEQ / 16;
#pragma unroll 1
  for (int c = 0; c < NCH; ++c) {
    const int t0 = c * 16;
    const int tn = (c + 1 < NCH) ? t0 + 16 : t0;
    HG_LOAD(tn);
    __builtin_amdgcn_sched_barrier(0);
#pragma unroll 2
    for (int t = 0; t < 16; ++t) {
      const float v = sVv[t * 64 + lane];
      const float opv = (lane < 32) ? sFg[t * 128 + w * 32 + lane] : sQs[t * 128 + w * 32 + (lane - 32)];
      const int opi = __builtin_bit_cast(int, opv);
      float o = 0.f;
#pragma unroll
      for (int j = 0; j < 32; ++j) {
        const float fg = __builtin_bit_cast(float, __builtin_amdgcn_readlane(opi, j));
        const float qq = __builtin_bit_cast(float, __builtin_amdgcn_readlane(opi, 32 + j));
        const float kv = fmaf(-fg, v, v);
        s[j] = fmaf(s[j], fg, kv);
        o = fmaf(qq, s[j], o);
      }
      sO[(w * 16 + t) * 64 + lane] = o;
    }
    __builtin_amdgcn_sched_barrier(0);
    __syncthreads();
    {
      int t = tid >> 4, v4 = (tid & 15) * 4;
      float4 a = *reinterpret_cast<const float4*>(sO + (0 * 16 + t) * 64 + v4);
      float4 bq = *reinterpret_cast<const float4*>(sO + (1 * 16 + t) * 64 + v4);
      float4 cq = *reinterpret_cast<const float4*>(sO + (2 * 16 + t) * 64 + v4);
      float4 d = *reinterpret_cast<const float4*>(sO + (3 * 16 + t) * 64 + v4);
      uint2 o;
      o.x = pack2(a.x + bq.x + cq.x + d.x, a.y + bq.y + cq.y + d.y);
      o.y = pack2(a.z + bq.z + cq.z + d.z, a.w + bq.w + cq.w + d.w);
      *reinterpret_cast<uint2*>(Z + (size_t)(t0 + t) * ZS + vcol + v4) = o;
    }
    HG_PROCESS();
    __syncthreads();
  }
#undef HG_LOAD
#undef HG_PUT1
#undef HG_PROCESS
}

__device__ void mb_scan(const Params& p, int l, int task, char* smem) {
  const int b = task >> 3, hd = task & 7, g = hd >> 2;
  float* sB = reinterpret_cast<float*>(smem);
  float* sC = sB + 16 * 128;
  float* sX = sC + 16 * 128;
  float* sDt = sX + 16 * 64;
  float* sDA = sDt + 16;
  float* sO = sDA + 16;
  const int tid = opaque_tid(), w = tid >> 6, lane = tid & 63;
  bf16_t* Z = (bf16_t*)(p.ws + OFF_Z) + (size_t)b * SEQ * ZS;
  const float* cw = p.in[I_MB_CONVW] + (size_t)l * 4 * 1024;
  const float* cb = p.in[I_MB_CONVB] + (size_t)l * 1024;
  int ci0, ci1;
  {
    int ch = tid;
    ci0 = (ch < 64) ? hd * 64 + ch : (ch < 192 ? 512 + g * 128 + (ch - 64) : 768 + g * 128 + (ch - 192));
    ci1 = 768 + g * 128 + 64 + (tid & 63);
  }
  float* dstA = (tid < 64) ? (sX + tid) : (tid < 192 ? (sB + (tid - 64)) : (sC + (tid - 192)));
  const int strideA = (tid < 64) ? 64 : 128;
  const float w0a = cw[ci0], w1a = cw[1024 + ci0], w2a = cw[2048 + ci0], w3a = cw[3072 + ci0], ba = cb[ci0];
  const float w0b = cw[ci1], w1b = cw[1024 + ci1], w2b = cw[2048 + ci1], w3b = cw[3072 + ci1], bb = cb[ci1];
  const float Aneg = -expf(p.in[I_MB_ALOG][l * 8 + hd]);
  const float dtb = p.in[I_MB_DTB][l * 8 + hd];
  const float Dsk = p.in[I_MB_D][l * 8 + hd];
  float s[32];
#pragma unroll
  for (int j = 0; j < 32; ++j) s[j] = 0.f;
  float pa1 = 0.f, pa2 = 0.f, pa3 = 0.f;
  const int tq = (tid >> 6) * 4;
  const int xcol = ZMB + 512;
  const int rt = tid >> 4, rp4 = (tid & 15) * 4;
  bf16_t xa0, xa1, xa2, xa3, xa4, xa5, xa6, xa7, xa8, xa9, xa10, xa11, xa12, xa13, xa14, xa15;
  bf16_t xb0, xb1, xb2, xb3, xb4, xb5, xb6;
  bf16_t rdt;
  uint2 gcur, gnext;
#define MB_LOAD(T0)                                                                                 \
  {                                                                                                 \
    const bf16_t* za = Z + (size_t)(T0) * ZS + xcol + ci0;                                          \
    xa0 = za[0]; xa1 = za[ZS]; xa2 = za[2 * ZS]; xa3 = za[3 * ZS]; xa4 = za[4 * ZS]; xa5 = za[5 * ZS];        \
    xa6 = za[6 * ZS]; xa7 = za[7 * ZS]; xa8 = za[8 * ZS]; xa9 = za[9 * ZS]; xa10 = za[10 * ZS];     \
    xa11 = za[11 * ZS]; xa12 = za[12 * ZS]; xa13 = za[13 * ZS]; xa14 = za[14 * ZS]; xa15 = za[15 * ZS];       \
    {                                                                                               \
      const int r0_ = (T0) + tq - 3;                                                                \
      const bf16_t* zb = Z + (ptrdiff_t)r0_ * ZS + xcol + ci1;                                      \
      xb0 = (r0_ >= 0) ? zb[0] : (bf16_t)0; xb1 = (r0_ + 1 >= 0) ? zb[ZS] : (bf16_t)0;              \
      xb2 = (r0_ + 2 >= 0) ? zb[2 * ZS] : (bf16_t)0;                                                \
      xb3 = zb[3 * ZS]; xb4 = zb[4 * ZS]; xb5 = zb[5 * ZS]; xb6 = zb[6 * ZS];                       \
    }                                                                                               \
    rdt = Z[(size_t)((T0) + (tid & 15)) * ZS + ZMB + 1536 + hd];                                    \
    gnext = *reinterpret_cast<const uint2*>(Z + (size_t)((T0) + rt) * ZS + ZMB + hd * 64 + rp4);    \
  }
#define MB_CONV_A(T, XR)                                                                            \
  {                                                                                                 \
    float xv = bf2f(XR);                                                                            \
    dstA[(T)*strideA] = fsilu(ba + w0a * pa3 + w1a * pa2 + w2a * pa1 + w3a * xv);                   \
    pa3 = pa2; pa2 = pa1; pa1 = xv;                                                                 \
  }
#define MB_CONV_B(J, X0, X1, X2, X3)                                                                \
  sC[(tq + (J)) * 128 + 64 + (tid & 63)] = fsilu(bb + w0b * bf2f(X0) + w1b * bf2f(X1) + w2b * bf2f(X2) + w3b * bf2f(X3));
#define MB_PROCESS()                                                                                \
  {                                                                                                 \
    MB_CONV_A(0, xa0) MB_CONV_A(1, xa1) MB_CONV_A(2, xa2) MB_CONV_A(3, xa3) MB_CONV_A(4, xa4)       \
    MB_CONV_A(5, xa5) MB_CONV_A(6, xa6) MB_CONV_A(7, xa7) MB_CONV_A(8, xa8) MB_CONV_A(9, xa9)       \
    MB_CONV_A(10, xa10) MB_CONV_A(11, xa11) MB_CONV_A(12, xa12) MB_CONV_A(13, xa13)                 \
    MB_CONV_A(14, xa14) MB_CONV_A(15, xa15)                                                         \
    MB_CONV_B(0, xb0, xb1, xb2, xb3) MB_CONV_B(1, xb1, xb2, xb3, xb4)                               \
    MB_CONV_B(2, xb2, xb3, xb4, xb5) MB_CONV_B(3, xb3, xb4, xb5, xb6)                               \
    if (tid < 16) {                                                                                 \
      float dt = fsoftplus(bf2f(rdt) + dtb);                                                        \
      sDt[tid] = dt;                                                                                \
      sDA[tid] = __expf(Aneg * dt);                                                                 \
    }                                                                                               \
    gcur = gnext;                                                                                   \
  }
  MB_LOAD(0);
  MB_PROCESS();
  __syncthreads();
  constexpr int NCH = SEQ / 16;
#pragma unroll 1
  for (int c = 0; c < NCH; ++c) {
    const int t0 = c * 16;
    const bool more = (c + 1 < NCH);
    const int tn = more ? t0 + 16 : t0;
    MB_LOAD(tn);
    __builtin_amdgcn_sched_barrier(0);
#pragma unroll 2
    for (int t = 0; t < 16; ++t) {
      const float dA = sDA[t];
      const float xs_ = sX[t * 64 + lane];
      const float xdt = xs_ * sDt[t];
      const float opv = (lane < 32) ? sB[t * 128 + w * 32 + lane] : sC[t * 128 + w * 32 + (lane - 32)];
      const int opi = __builtin_bit_cast(int, opv);
      float y = (w == 0) ? Dsk * xs_ : 0.f;
#pragma unroll
      for (int j = 0; j < 32; ++j) {
        const float bn = __builtin_bit_cast(float, __builtin_amdgcn_readlane(opi, j));
        const float cn = __builtin_bit_cast(float, __builtin_amdgcn_readlane(opi, 32 + j));
        s[j] = fmaf(s[j], dA, bn * xdt);
        y = fmaf(cn, s[j], y);
      }
      sO[(w * 16 + t) * 64 + lane] = y;
    }
    __builtin_amdgcn_sched_barrier(0);
    __syncthreads();
    {
      float4 a = *reinterpret_cast<const float4*>(sO + (0 * 16 + rt) * 64 + rp4);
      float4 bq = *reinterpret_cast<const float4*>(sO + (1 * 16 + rt) * 64 + rp4);
      float4 cq = *reinterpret_cast<const float4*>(sO + (2 * 16 + rt) * 64 + rp4);
      float4 d = *reinterpret_cast<const float4*>(sO + (3 * 16 + rt) * 64 + rp4);
      bf16_t* gp = Z + (size_t)(t0 + rt) * ZS + ZMB + hd * 64 + rp4;
      float g0 = bf2f((bf16_t)(gcur.x & 0xffff)), g1 = bf2f((bf16_t)(gcur.x >> 16));
      float g2 = bf2f((bf16_t)(gcur.y & 0xffff)), g3 = bf2f((bf16_t)(gcur.y >> 16));
      float y0 = a.x + bq.x + cq.x + d.x;
      float y1 = a.y + bq.y + cq.y + d.y;
      float y2 = a.z + bq.z + cq.z + d.z;
      float y3 = a.w + bq.w + cq.w + d.w;
      uint2 o;
      o.x = pack2(y0 * fsilu(g0), y1 * fsilu(g1));
      o.y = pack2(y2 * fsilu(g2), y3 * fsilu(g3));
      *reinterpret_cast<uint2*>(gp) = o;
    }
    if (more) MB_PROCESS();
    __syncthreads();
  }
#undef MB_LOAD
#undef MB_CONV_A
#undef MB_CONV_B
#undef MB_PROCESS
}

__device__ void s5_scan(const Params& p, int l, int task, char* smem) {
  const int tid = opaque_tid(), w = tid >> 6, lane = tid & 63;
  const int b = task >> 3, g = (task & 7) * 4 + w;
  char* base = smem + w * 6144;
  float* sU = reinterpret_cast<float*>(base);
  char* sHb = base + 1024;
  bf16_t* Z = (bf16_t*)(p.ws + OFF_Z) + (size_t)b * SEQ * ZS + ZS5 + g * 16;
  const int n = lane;
  float lr, li, bbr[16], bbi[16];
  bf16x8 Bf0, Bf1, Bf2, Bf3;
  {
    float dt = expf(p.in[I_S5_LOGDT][l * 32 + g]);
    float are = p.in[I_S5_ARE][(l * 32 + g) * 64 + n], aim = p.in[I_S5_AIM][(l * 32 + g) * 64 + n];
    float mag = expf(dt * are);
    lr = mag * cosf(dt * aim); li = mag * sinf(dt * aim);
    float den = are * are + aim * aim;
    float cr = ((lr - 1.f) * are + li * aim) / den;
    float ci = (li * are - (lr - 1.f) * aim) / den;
    const float* bre = p.in[I_S5_BRE] + ((size_t)(l * 32 + g) * 64 + n) * 16;
    const float* bim = p.in[I_S5_BIM] + ((size_t)(l * 32 + g) * 64 + n) * 16;
#pragma unroll
    for (int c = 0; c < 16; ++c) {
      float br = bre[c], bi = bim[c];
      bbr[c] = cr * br - ci * bi;
      bbi[c] = cr * bi + ci * br;
    }
    const float* cre = p.in[I_S5_CRE] + (size_t)(l * 32 + g) * 16 * 64 + (lane & 15) * 64;
    const float* cim = p.in[I_S5_CIM] + (size_t)(l * 32 + g) * 16 * 64 + (lane & 15) * 64;
#pragma unroll
    for (int j = 0; j < 8; ++j) {
      const int kb = 8 * (lane >> 4) + j;
      const int n0 = kb >> 1;
      const bool im = (j & 1);
      Bf0[j] = (short)f2bf(im ? -cim[n0] : cre[n0]);
      Bf1[j] = (short)f2bf(im ? -cim[n0 + 16] : cre[n0 + 16]);
      Bf2[j] = (short)f2bf(im ? -cim[n0 + 32] : cre[n0 + 32]);
      Bf3[j] = (short)f2bf(im ? -cim[n0 + 48] : cre[n0 + 48]);
    }
  }
  const float dsk = p.in[I_S5_D][l * 512 + g * 16 + (lane & 15)];
  const int pt = lane >> 2, pc4 = (lane & 3) * 4;
  float hr = 0.f, hi = 0.f;
  uint2 unext = *reinterpret_cast<const uint2*>(Z + (size_t)pt * ZS + pc4);
  constexpr int NCH = SEQ / 16;
#pragma unroll 1
  for (int c = 0; c < NCH; ++c) {
    const int t0 = c * 16;
    {
      const uint2 ur = unext;
      *reinterpret_cast<float4*>(sU + pt * 16 + pc4) =
          float4{bf2f((bf16_t)(ur.x & 0xffff)), bf2f((bf16_t)(ur.x >> 16)), bf2f((bf16_t)(ur.y & 0xffff)), bf2f((bf16_t)(ur.y >> 16))};
      const int tn = (c + 1 < NCH) ? t0 + 16 : t0;
      unext = *reinterpret_cast<const uint2*>(Z + (size_t)(tn + pt) * ZS + pc4);
    }
    __builtin_amdgcn_sched_barrier(0);
    __syncthreads();
#pragma unroll 2
    for (int t = 0; t < 16; ++t) {
      const float4* u4 = reinterpret_cast<const float4*>(sU + t * 16);
      float bur = 0.f, bui = 0.f;
#pragma unroll
      for (int q = 0; q < 4; ++q) {
        float4 u = u4[q];
        bur = fmaf(bbr[q * 4 + 0], u.x, bur); bui = fmaf(bbi[q * 4 + 0], u.x, bui);
        bur = fmaf(bbr[q * 4 + 1], u.y, bur); bui = fmaf(bbi[q * 4 + 1], u.y, bui);
        bur = fmaf(bbr[q * 4 + 2], u.z, bur); bui = fmaf(bbi[q * 4 + 2], u.z, bui);
        bur = fmaf(bbr[q * 4 + 3], u.w, bur); bui = fmaf(bbi[q * 4 + 3], u.w, bui);
      }
      float nr = lr * hr - li * hi + bur;
      float ni = lr * hi + li * hr + bui;
      hr = nr; hi = ni;
      *reinterpret_cast<unsigned*>(sHb + t * 272 + n * 4) = pack2(hr, hi);
    }
    __syncthreads();
    {
      f32x4 acc = f32x4{0.f, 0.f, 0.f, 0.f};
      const char* ap = sHb + (lane & 15) * 272 + (lane >> 4) * 16;
      acc = __builtin_amdgcn_mfma_f32_16x16x32_bf16(*reinterpret_cast<const bf16x8*>(ap), Bf0, acc, 0, 0, 0);
      acc = __builtin_amdgcn_mfma_f32_16x16x32_bf16(*reinterpret_cast<const bf16x8*>(ap + 64), Bf1, acc, 0, 0, 0);
      acc = __builtin_amdgcn_mfma_f32_16x16x32_bf16(*reinterpret_cast<const bf16x8*>(ap + 128), Bf2, acc, 0, 0, 0);
      acc = __builtin_amdgcn_mfma_f32_16x16x32_bf16(*reinterpret_cast<const bf16x8*>(ap + 192), Bf3, acc, 0, 0, 0);
      const int cc = lane & 15, tb = (lane >> 4) * 4;
#pragma unroll
      for (int jj = 0; jj < 4; ++jj) {
        float y = acc[jj] + dsk * sU[(tb + jj) * 16 + cc];
        Z[(size_t)(t0 + tb + jj) * ZS + cc] = f2bf(fgelu(y));
      }
    }
    __syncthreads();
  }
}

__device__ void rw_scan(const Params& p, int l, int task, char* smem) {
  const int b = task >> 3, h = task & 7;
  float* sR = reinterpret_cast<float*>(smem);
  float* sW = sR + 1024;
  float* sK = sW + 1024;
  float* sA = sK + 1024;
  float* sBb = sA + 1024;
  float* sV = sBb + 1024;
  float* sY = sV + 1024;
  float* sBonus = sY + 1024;
  const int tid = opaque_tid(), w = tid >> 6, lane = tid & 63;
  const size_t tokbase = (size_t)b * SEQ;
  bf16_t* Z = (bf16_t*)(p.ws + OFF_Z) + tokbase * ZS;
  const bf16_t* LW = (const bf16_t*)(p.ws + OFF_U) + tokbase * 512;
  const bf16_t* LA = LW + (size_t)T_TOK * 512;
  const bf16_t* VF = (const bf16_t*)(p.ws + OFF_VF) + tokbase * 512;
  const int st = tid >> 4, c4 = (tid & 15) * 4, ch = h * 64 + c4;
  float mur[4], muk[4], w0[4], a0[4], kk_[4], ka_[4], rk_[4], lnw[4], lnb[4];
#pragma unroll
  for (int e = 0; e < 4; ++e) {
    mur[e] = p.in[I_RW_MU][l * 1792 + ch + e];
    muk[e] = p.in[I_RW_MU][l * 1792 + 512 + ch + e];
    w0[e] = p.in[I_RW_W0][l * 512 + ch + e];
    a0[e] = p.in[I_RW_A0][l * 512 + ch + e];
    kk_[e] = p.in[I_RW_KK][l * 512 + ch + e];
    ka_[e] = p.in[I_RW_KA][l * 512 + ch + e];
    rk_[e] = p.in[I_RW_RK][l * 512 + ch + e];
    lnw[e] = p.in[I_RW_LNW][l * 512 + ch + e];
    lnb[e] = p.in[I_RW_LNB][l * 512 + ch + e];
  }
  const int rg = lane >> 3, kq = lane & 7, vrow = w * 16 + rg * 2;
  float S0[8], S1[8];
#pragma unroll
  for (int j = 0; j < 8; ++j) { S0[j] = 0.f; S1[j] = 0.f; }
  uint2 rc, kc, rp, kp, lwv, lav, vfv;
#define RW_LOAD(T0)                                                                                 \
  {                                                                                                 \
    const int s_ = (T0) + st;                                                                       \
    const bf16_t* zr = Z + (size_t)s_ * ZS + ZRW + ch;                                              \
    rc = *reinterpret_cast<const uint2*>(zr);                                                       \
    kc = *reinterpret_cast<const uint2*>(zr + 512);                                                 \
    rp = uint2{0u, 0u}; kp = uint2{0u, 0u};                                                         \
    if (s_ > 0) { rp = *reinterpret_cast<const uint2*>(zr - ZS); kp = *reinterpret_cast<const uint2*>(zr - ZS + 512); } \
    lwv = *reinterpret_cast<const uint2*>(LW + (size_t)s_ * 512 + ch);                              \
    lav = *reinterpret_cast<const uint2*>(LA + (size_t)s_ * 512 + ch);                              \
    vfv = *reinterpret_cast<const uint2*>(VF + (size_t)s_ * 512 + ch);                              \
  }
#define RW_PROCESS()                                                                                \
  {                                                                                                 \
    float r4[4], k4[4], kkv[4], av[4], wv[4], vv[4];                                                \
    float n2 = 0.f;                                                                                 \
    _Pragma("unroll") for (int e = 0; e < 4; ++e) {                                                 \
      unsigned rcw = (e < 2) ? rc.x : rc.y, kcw = (e < 2) ? kc.x : kc.y, rpw = (e < 2) ? rp.x : rp.y, kpw = (e < 2) ? kp.x : kp.y; \
      unsigned lww = (e < 2) ? lwv.x : lwv.y, law = (e < 2) ? lav.x : lav.y, vfw = (e < 2) ? vfv.x : vfv.y; \
      int sh = (e & 1) * 16;                                                                        \
      float rcur = bf2f((bf16_t)((rcw >> sh) & 0xffff)), rprev = bf2f((bf16_t)((rpw >> sh) & 0xffff)); \
      float kcur = bf2f((bf16_t)((kcw >> sh) & 0xffff)), kprev = bf2f((bf16_t)((kpw >> sh) & 0xffff)); \
      float lwf = bf2f((bf16_t)((lww >> sh) & 0xffff)), laf = bf2f((bf16_t)((law >> sh) & 0xffff)); \
      vv[e] = bf2f((bf16_t)((vfw >> sh) & 0xffff));                                                 \
      r4[e] = rcur + (rprev - rcur) * mur[e];                                                       \
      k4[e] = kcur + (kprev - kcur) * muk[e];                                                       \
      float wlog = -fsoftplus(-(w0[e] + lwf)) - 0.5f;                                               \
      wv[e] = __expf(-__expf(wlog));                                                                \
      av[e] = fsigmoid(a0[e] + laf);                                                                \
      kkv[e] = k4[e] * kk_[e];                                                                      \
      n2 += kkv[e] * kkv[e];                                                                        \
    }                                                                                               \
    n2 = sum16(n2);                                                                                 \
    float inv = 1.f / fmaxf(sqrtf(n2), 1e-12f);                                                     \
    float bon = 0.f;                                                                                \
    float kt4[4], ap4[4], bp4[4];                                                                   \
    _Pragma("unroll") for (int e = 0; e < 4; ++e) {                                                 \
      float kkn = kkv[e] * inv;                                                                     \
      kt4[e] = k4[e] * (1.f + (av[e] - 1.f) * ka_[e]);                                              \
      ap4[e] = -kkn;                                                                                \
      bp4[e] = kkn * av[e];                                                                         \
      bon += r4[e] * kt4[e] * rk_[e];                                                               \
    }                                                                                               \
    bon = sum16(bon);                                                                               \
    *reinterpret_cast<float4*>(sR + st * 64 + c4) = float4{r4[0], r4[1], r4[2], r4[3]};             \
    *reinterpret_cast<float4*>(sW + st * 64 + c4) = float4{wv[0], wv[1], wv[2], wv[3]};             \
    *reinterpret_cast<float4*>(sK + st * 64 + c4) = float4{kt4[0], kt4[1], kt4[2], kt4[3]};         \
    *reinterpret_cast<float4*>(sA + st * 64 + c4) = float4{ap4[0], ap4[1], ap4[2], ap4[3]};         \
    *reinterpret_cast<float4*>(sBb + st * 64 + c4) = float4{bp4[0], bp4[1], bp4[2], bp4[3]};        \
    *reinterpret_cast<float4*>(sV + st * 64 + c4) = float4{vv[0], vv[1], vv[2], vv[3]};             \
    if ((tid & 15) == 0) sBonus[st] = bon;                                                          \
  }
  RW_LOAD(0);
  RW_PROCESS();
  __syncthreads();
  constexpr int NCH = SEQ / 16;
#pragma unroll 1
  for (int c = 0; c < NCH; ++c) {
    const int t0 = c * 16;
    const int tn = (c + 1 < NCH) ? t0 + 16 : t0;
    RW_LOAD(tn);
    __builtin_amdgcn_sched_barrier(0);
#pragma unroll 2
    for (int t = 0; t < 16; ++t) {
      const float4* a4p = reinterpret_cast<const float4*>(sA + t * 64 + kq * 8);
      const float4* w4p = reinterpret_cast<const float4*>(sW + t * 64 + kq * 8);
      const float4* b4p = reinterpret_cast<const float4*>(sBb + t * 64 + kq * 8);
      const float4* k4p = reinterpret_cast<const float4*>(sK + t * 64 + kq * 8);
      const float4* r4p = reinterpret_cast<const float4*>(sR + t * 64 + kq * 8);
      const float2 vv = *reinterpret_cast<const float2*>(sV + t * 64 + vrow);
      float sa0 = 0.f, sa1 = 0.f;
#pragma unroll
      for (int q = 0; q < 2; ++q) {
        float4 a = a4p[q];
        sa0 = fmaf(S0[q * 4 + 0], a.x, sa0); sa1 = fmaf(S1[q * 4 + 0], a.x, sa1);
        sa0 = fmaf(S0[q * 4 + 1], a.y, sa0); sa1 = fmaf(S1[q * 4 + 1], a.y, sa1);
        sa0 = fmaf(S0[q * 4 + 2], a.z, sa0); sa1 = fmaf(S1[q * 4 + 2], a.z, sa1);
        sa0 = fmaf(S0[q * 4 + 3], a.w, sa0); sa1 = fmaf(S1[q * 4 + 3], a.w, sa1);
      }
      sa0 = oct_sum(sa0); sa1 = oct_sum(sa1);
      float y0 = 0.f, y1 = 0.f;
#pragma unroll
      for (int q = 0; q < 2; ++q) {
        float4 ww = w4p[q], bb = b4p[q], kk = k4p[q], rr = r4p[q];
        S0[q * 4 + 0] = fmaf(S0[q * 4 + 0], ww.x, fmaf(sa0, bb.x, vv.x * kk.x)); y0 = fmaf(S0[q * 4 + 0], rr.x, y0);
        S1[q * 4 + 0] = fmaf(S1[q * 4 + 0], ww.x, fmaf(sa1, bb.x, vv.y * kk.x)); y1 = fmaf(S1[q * 4 + 0], rr.x, y1);
        S0[q * 4 + 1] = fmaf(S0[q * 4 + 1], ww.y, fmaf(sa0, bb.y, vv.x * kk.y)); y0 = fmaf(S0[q * 4 + 1], rr.y, y0);
        S1[q * 4 + 1] = fmaf(S1[q * 4 + 1], ww.y, fmaf(sa1, bb.y, vv.y * kk.y)); y1 = fmaf(S1[q * 4 + 1], rr.y, y1);
        S0[q * 4 + 2] = fmaf(S0[q * 4 + 2], ww.z, fmaf(sa0, bb.z, vv.x * kk.z)); y0 = fmaf(S0[q * 4 + 2], rr.z, y0);
        S1[q * 4 + 2] = fmaf(S1[q * 4 + 2], ww.z, fmaf(sa1, bb.z, vv.y * kk.z)); y1 = fmaf(S1[q * 4 + 2], rr.z, y1);
        S0[q * 4 + 3] = fmaf(S0[q * 4 + 3], ww.w, fmaf(sa0, bb.w, vv.x * kk.w)); y0 = fmaf(S0[q * 4 + 3], rr.w, y0);
        S1[q * 4 + 3] = fmaf(S1[q * 4 + 3], ww.w, fmaf(sa1, bb.w, vv.y * kk.w)); y1 = fmaf(S1[q * 4 + 3], rr.w, y1);
      }
      y0 = oct_sum(y0); y1 = oct_sum(y1);
      if (kq == 0) *reinterpret_cast<float2*>(sY + t * 64 + vrow) = float2{y0, y1};
    }
    __builtin_amdgcn_sched_barrier(0);
    __syncthreads();
    {
      float4 y4 = *reinterpret_cast<const float4*>(sY + st * 64 + c4);
      float4 v4 = *reinterpret_cast<const float4*>(sV + st * 64 + c4);
      float bon = sBonus[st];
      float mean = sum16(y4.x + y4.y + y4.z + y4.w) * (1.f / 64.f);
      float dx = y4.x - mean, dy = y4.y - mean, dz = y4.z - mean, dw = y4.w - mean;
      float var = sum16(dx * dx + dy * dy + dz * dz + dw * dw) * (1.f / 64.f);
      float rs = rsqrtf(var + 64e-5f);
      float o0 = dx * rs * lnw[0] + lnb[0] + bon * v4.x;
      float o1 = dy * rs * lnw[1] + lnb[1] + bon * v4.y;
      float o2 = dz * rs * lnw[2] + lnb[2] + bon * v4.z;
      float o3 = dw * rs * lnw[3] + lnb[3] + bon * v4.w;
      uint2 o;
      o.x = pack2(o0, o1); o.y = pack2(o2, o3);
      *reinterpret_cast<uint2*>(Z + (size_t)(t0 + st) * ZS + ZRW + 1024 + ch) = o;
    }
    RW_PROCESS();
    __syncthreads();
  }
#undef RW_LOAD
#undef RW_PROCESS
}

__device__ void phase_scans(const Params& p, int l, char* smem, int scan_mask = 15) {
  for (int t = blockIdx.x; t < 256; t += gridDim.x) {
    int type = t & 3, idx = t >> 2;
    if (!((scan_mask >> type) & 1)) continue;
#ifndef SCM
#define SCM 15
#endif
    if (type == 0) { if (SCM & 1) rw_scan(p, l, idx, smem); }
    else if (type == 1) { if (SCM & 2) hg_scan(p, l, idx, smem); }
    else if (type == 2) { if (SCM & 4) mb_scan(p, l, idx, smem); }
    else { if (SCM & 8) s5_scan(p, l, idx, smem); }
    __syncthreads();
  }
  if (l == 0) {
    const int tid = opaque_tid();
    const int nb = (gridDim.x > 256) ? (int)gridDim.x - 256 : (int)gridDim.x;
    const int b0 = (gridDim.x > 256) ? (int)blockIdx.x - 256 : (int)blockIdx.x;
    constexpr int NREST = CT_TOTAL - (CT_IN - 1024);
    if (b0 >= 0)
      for (int c = b0; c < NREST + CT_TOTAL; c += nb) {
        if (c < NREST) convert_one(p, 0, (c < 1024) ? c : c + (CT_IN - 1024), smem, tid);
        else convert_one(p, 1, c - NREST, smem, tid);
      }
  }
}

__device__ __forceinline__ void unpack8(const uint4& v, float (&f)[8]) {
  f[0] = bf2f((bf16_t)(v.x & 0xffff)); f[1] = bf2f((bf16_t)(v.x >> 16));
  f[2] = bf2f((bf16_t)(v.y & 0xffff)); f[3] = bf2f((bf16_t)(v.y >> 16));
  f[4] = bf2f((bf16_t)(v.z & 0xffff)); f[5] = bf2f((bf16_t)(v.z >> 16));
  f[6] = bf2f((bf16_t)(v.w & 0xffff)); f[7] = bf2f((bf16_t)(v.w >> 16));
}

__device__ void phase_post(const Params& p, int l, char* smem) {
  bf16_t* Z = (bf16_t*)(p.ws + OFF_Z);
  const int tid = opaque_tid(), lane = tid & 63, wid = tid >> 6;
  constexpr int N_ROWT = T_TOK / 4, N_RWT = T_TOK / 16, N_GLU = 128 * 4, N_NORM = T_TOK / 4;
  const float* xsrc = (l == 0) ? p.in[I_X] : p.out;
  for (int t = blockIdx.x; t < N_ROWT + N_RWT + N_GLU + N_NORM; t += gridDim.x) {
    if (t < N_ROWT) {
      const int row = t * 4 + wid;
      {
        bf16_t* op = Z + (size_t)row * ZS + ZHG + 1024 + lane * 8;
        uint4 ov = *reinterpret_cast<const uint4*>(op);
        uint4 gv = *reinterpret_cast<const uint4*>(op + 512);
        float o[8], g[8];
        unpack8(ov, o); unpack8(gv, g);
        float ss = 0.f;
#pragma unroll
        for (int e = 0; e < 8; ++e) ss += o[e] * o[e];
        ss = sum16(ss);
        float rstd = rsqrtf(ss * (1.f / 128.f) + 1e-6f);
        const float* nw = p.in[I_HG_NW] + l * 512 + lane * 8;
        float r[8];
#pragma unroll
        for (int e = 0; e < 8; ++e) r[e] = o[e] * rstd * nw[e] * siluf_(g[e]);
        *reinterpret_cast<uint4*>(op) = uint4{pack2(r[0], r[1]), pack2(r[2], r[3]), pack2(r[4], r[5]), pack2(r[6], r[7])};
      }
      {
        bf16_t* op = Z + (size_t)row * ZS + ZMB + lane * 8;
        uint4 ov = *reinterpret_cast<const uint4*>(op);
        float o[8];
        unpack8(ov, o);
        float ss = 0.f;
#pragma unroll
        for (int e = 0; e < 8; ++e) ss += o[e] * o[e];
        ss = sum64(ss);
        float rstd = rsqrtf(ss * (1.f / 512.f) + 1e-6f);
        const float* nw = p.in[I_MB_NW] + l * 512 + lane * 8;
        float r[8];
#pragma unroll
        for (int e = 0; e < 8; ++e) r[e] = o[e] * rstd * nw[e];
        *reinterpret_cast<uint4*>(op) = uint4{pack2(r[0], r[1]), pack2(r[2], r[3]), pack2(r[4], r[5]), pack2(r[6], r[7])};
      }
    } else if (t < N_ROWT + N_RWT) {
      const int row0 = (t - N_ROWT) * 16;
      char* sXg = smem;
      const float* mu = p.in[I_RW_MU] + l * 1792 + 1664;
      for (int e = tid; e < 2048; e += 256) {
        int tok = e >> 7, j = e & 127;
        int row = row0 + tok, sq = row & (SEQ - 1);
        *reinterpret_cast<bf16_t*>(sXg + tok * 272 + j * 2) = f2bf(fsigmoid(rw_shift(Z, row, sq, 1664 + j, mu[j])));
      }
      __syncthreads();
      f32x4 acc[8];
      lora_mfma<128>(sXg, 272, (const bf16_t*)(p.ws + OFF_LORA + (size_t)l * LORA_STRIDE + LO_G2), acc, tid);
#pragma unroll
      for (int i = 0; i < 8; ++i)
#pragma unroll
        for (int jj = 0; jj < 4; ++jj) {
          bf16_t* yp = Z + (size_t)(row0 + (lane >> 4) * 4 + jj) * ZS + ZRW + 1024 + (wid * 8 + i) * 16 + (lane & 15);
          *yp = f2bf(bf2f(*yp) * acc[i][jj]);
        }
      __syncthreads();
    } else if (t < N_ROWT + N_RWT + N_GLU) {
      const int tt = t - N_ROWT - N_RWT, mt = tt >> 2, nt = tt & 3;
      const int wm = wid >> 1, wn = wid & 1;
      f32x4 acc[4][4];
      zero_acc<128>(acc);
      gemm_mainloop<128>(acc, Z + ZS5, ZS, mt * 128, (const bf16_t*)(p.ws + WOFF(OFF_WTGLU, l)), 512, nt * 128, 511, 512, smem, tid);
      const float* bg = p.in[I_S5_BGLU] + l * 512;
#pragma unroll
      for (int mi = 0; mi < 4; ++mi)
#pragma unroll
        for (int ni = 0; ni < 4; ++ni) {
          int col = nt * 128 + wn * 64 + ni * 16 + (lane >> 4) * 4;
          int row = mt * 128 + wm * 64 + mi * 16 + (lane & 15);
          float4 b4 = *reinterpret_cast<const float4*>(bg + col);
          uint2 yv = *reinterpret_cast<const uint2*>(Z + (size_t)row * ZS + ZS5 + col);
          float y0 = bf2f((bf16_t)(yv.x & 0xffff)), y1 = bf2f((bf16_t)(yv.x >> 16));
          float y2 = bf2f((bf16_t)(yv.y & 0xffff)), y3 = bf2f((bf16_t)(yv.y >> 16));
          uint2 o;
          o.x = pack2(y0 * sigmoidf_(acc[mi][ni][0] + b4.x), y1 * sigmoidf_(acc[mi][ni][1] + b4.y));
          o.y = pack2(y2 * sigmoidf_(acc[mi][ni][2] + b4.z), y3 * sigmoidf_(acc[mi][ni][3] + b4.w));
          *reinterpret_cast<uint2*>(Z + (size_t)row * ZS + ZMB + 1024 + col) = o;
        }
    } else {
      const int row = (t - N_ROWT - N_RWT - N_GLU) * 4 + wid;
      rmsnorm_row_to_bf16(xsrc + (size_t)row * DM, p.in[I_NORM_MIX] + l * DM, (bf16_t*)(p.ws + OFF_U) + (size_t)row * DM, tid & 63);
    }
  }
}

__device__ void phase_merge(const Params& p, int l, char* smem) {
  bf16_t* Z = (bf16_t*)(p.ws + OFF_Z);
  const bf16_t* U = (const bf16_t*)(p.ws + OFF_U);
  const bf16_t* Wg = (const bf16_t*)(p.ws + WOFF_GATE(l));
  const bf16_t* Wb = (const bf16_t*)(p.ws + WOFF(OFF_WTBR, l));
  const int tid = opaque_tid();
  const int lane = tid & 63, wid = tid >> 6, wm = wid >> 1, wn = wid & 1;
  for (int t = blockIdx.x; t < tile_count(128, 8); t += gridDim.x) {
    int mt, nt;
    if (!tile_map(t, 8, mt, nt)) continue;
    f32x4 accm[4][4];
    zero_acc<128>(accm);
    f32x4 a1[4][4];
    zero_acc<128>(a1);
    uint2 sg[4][4];
#pragma unroll
    for (int mi = 0; mi < 4; ++mi)
#pragma unroll
      for (int ni = 0; ni < 4; ++ni) sg[mi][ni] = uint2{0u, 0u};
#pragma unroll 1
    for (int sub = 0; sub < 8; ++sub) {
      const int kb = sub >> 1, which = sub & 1;
      const int ycol = (kb == 0) ? (ZHG + 1024) : (kb == 1) ? (ZRW + 1024) : (kb == 2) ? (ZMB + 1024) : ZMB;
      const bf16_t* Ap = which ? (const bf16_t*)(Z + ycol) : U;
      const int ldap = which ? ZS : 1024;
      const bf16_t* Bp = which ? (Wb + (size_t)kb * 1024 * 512) : (Wg + (size_t)kb * 1024 * 1024);
      const int Kp = which ? 512 : 1024;
      gemm_mainloop_glds<128>(a1, Ap, ldap, mt * 128, Bp, Kp, nt * 128, 1023, Kp, smem, tid);
      if (which == 0) {
#pragma unroll
        for (int mi = 0; mi < 4; ++mi)
#pragma unroll
          for (int ni = 0; ni < 4; ++ni) {
            sg[mi][ni].x = pack2(fsigmoid(a1[mi][ni][0]), fsigmoid(a1[mi][ni][1]));
            sg[mi][ni].y = pack2(fsigmoid(a1[mi][ni][2]), fsigmoid(a1[mi][ni][3]));
            a1[mi][ni] = f32x4{0.f, 0.f, 0.f, 0.f};
          }
      } else {
#pragma unroll
        for (int mi = 0; mi < 4; ++mi)
#pragma unroll
          for (int ni = 0; ni < 4; ++ni) {
            accm[mi][ni][0] = fmaf(bf2f((bf16_t)(sg[mi][ni].x & 0xffff)), a1[mi][ni][0], accm[mi][ni][0]);
            accm[mi][ni][1] = fmaf(bf2f((bf16_t)(sg[mi][ni].x >> 16)), a1[mi][ni][1], accm[mi][ni][1]);
            accm[mi][ni][2] = fmaf(bf2f((bf16_t)(sg[mi][ni].y & 0xffff)), a1[mi][ni][2], accm[mi][ni][2]);
            accm[mi][ni][3] = fmaf(bf2f((bf16_t)(sg[mi][ni].y >> 16)), a1[mi][ni][3], accm[mi][ni][3]);
            a1[mi][ni] = f32x4{0.f, 0.f, 0.f, 0.f};
          }
      }
    }
#pragma unroll
    for (int mi = 0; mi < 4; ++mi)
#pragma unroll
      for (int np = 0; np < 2; ++np) {
        const int colb = nt * 128 + wn * 64 + np * 32;
        const int row = mt * 128 + wm * 64 + mi * 16 + (lane & 15);
        uint2 a, b;
        a.x = pack2(accm[mi][2 * np][0], accm[mi][2 * np][1]);
        a.y = pack2(accm[mi][2 * np][2], accm[mi][2 * np][3]);
        b.x = pack2(accm[mi][2 * np + 1][0], accm[mi][2 * np + 1][1]);
        b.y = pack2(accm[mi][2 * np + 1][2], accm[mi][2 * np + 1][3]);
        store_pair_bf16(Z + (size_t)row * ZS + colb, lane, a, b);
      }
  }
}

__device__ void phase_resid_gemm(const Params& p, const bf16_t* A, int lda, const bf16_t* Wt, int K, const float* xold, char* smem) {
  const int tid = opaque_tid();
  const int lane = tid & 63, wid = tid >> 6, wm = wid >> 1, wn = wid & 1;
  for (int t = blockIdx.x; t < tile_count(64, 8); t += gridDim.x) {
    int mt, nt;
    if (!tile_map(t, 8, mt, nt)) continue;
    f32x4 acc[8][4];
    zero_acc_big(acc);
    gemm_mainloop_big(acc, A, lda, mt * 256, Wt, K, nt * 128, 1023, K, smem, tid);
#pragma unroll
    for (int mi = 0; mi < 8; ++mi)
#pragma unroll
      for (int ni = 0; ni < 4; ++ni) {
        int col = nt * 128 + wn * 64 + ni * 16 + (lane >> 4) * 4;
        int row = mt * 256 + wm * 128 + mi * 16 + (lane & 15);
        size_t o = (size_t)row * DM + col;
        float4 xo = *reinterpret_cast<const float4*>(xold + o);
        float4 r = float4{xo.x + acc[mi][ni][0], xo.y + acc[mi][ni][1], xo.z + acc[mi][ni][2], xo.w + acc[mi][ni][3]};
        *reinterpret_cast<float4*>(p.out + o) = r;
      }
  }
}

__device__ void phase_ffn_in(const Params& p, int l, char* smem) {
  const bf16_t* U = (const bf16_t*)(p.ws + OFF_U);
  const bf16_t* Wt = (const bf16_t*)(p.ws + WOFF(OFF_WTF1, l));
  bf16_t* H = (bf16_t*)(p.ws + OFF_Z);
  const int tid = opaque_tid();
  const int lane = tid & 63, wid = tid >> 6, wm = wid >> 1, wn = wid & 1;
  for (int t = blockIdx.x; t < tile_count(64, 40); t += gridDim.x) {
    int mt, nt;
    if (!tile_map(t, 40, mt, nt)) continue;
    f32x4 acc[8][4];
    zero_acc_big(acc);
    gemm_mainloop_big(acc, U, 1024, mt * 256, Wt, 1024, nt * 128, 5631, 1024, smem, tid);
#pragma unroll
    for (int mi = 0; mi < 8; ++mi) {
      const int hcolb = (nt * 128 + wn * 64) >> 1;
      const int row = mt * 256 + wm * 128 + mi * 16 + (lane & 15);
      uint2 o0, o1;
      o0.x = pack2(fsilu(acc[mi][0][0]) * acc[mi][1][0], fsilu(acc[mi][0][1]) * acc[mi][1][1]);
      o0.y = pack2(fsilu(acc[mi][0][2]) * acc[mi][1][2], fsilu(acc[mi][0][3]) * acc[mi][1][3]);
      o1.x = pack2(fsilu(acc[mi][2][0]) * acc[mi][3][0], fsilu(acc[mi][2][1]) * acc[mi][3][1]);
      o1.y = pack2(fsilu(acc[mi][2][2]) * acc[mi][3][2], fsilu(acc[mi][2][3]) * acc[mi][3][3]);
      store_pair_bf16(H + (size_t)row * FFH + hcolb, lane, o0, o1);
    }
  }
  for (int t2 = blockIdx.x; t2 < 512; t2 += gridDim.x) {
    const int nt = 40 + (t2 & 3), mt = t2 >> 2;
    f32x4 acc[4][4];
    zero_acc<128>(acc);
    gemm_mainloop_glds<128>(acc, U, 1024, mt * 128, Wt, 1024, nt * 128, 5631, 1024, smem, tid);
#pragma unroll
    for (int mi = 0; mi < 4; ++mi) {
      const int hcolb = (nt * 128 + wn * 64) >> 1;
      const int row = mt * 128 + wm * 64 + mi * 16 + (lane & 15);
      uint2 o0, o1;
      o0.x = pack2(fsilu(acc[mi][0][0]) * acc[mi][1][0], fsilu(acc[mi][0][1]) * acc[mi][1][1]);
      o0.y = pack2(fsilu(acc[mi][0][2]) * acc[mi][1][2], fsilu(acc[mi][0][3]) * acc[mi][1][3]);
      o1.x = pack2(fsilu(acc[mi][2][0]) * acc[mi][3][0], fsilu(acc[mi][2][1]) * acc[mi][3][1]);
      o1.y = pack2(fsilu(acc[mi][2][2]) * acc[mi][3][2], fsilu(acc[mi][2][3]) * acc[mi][3][3]);
      store_pair_bf16(H + (size_t)row * FFH + hcolb, lane, o0, o1);
    }
  }
}

__device__ void phase_final(const Params& p) {
  const int tid = opaque_tid();
  const int lane = tid & 63;
  const float* w = p.in[I_NORM_FINAL];
  for (int t = blockIdx.x; t < T_TOK / 4; t += gridDim.x) {
    int row = t * 4 + (tid >> 6);
    float* x = p.out + (size_t)row * DM;
    float4 v[4];
    float ss = 0.f;
#pragma unroll
    for (int i = 0; i < 4; ++i) {
      v[i] = *reinterpret_cast<const float4*>(x + i * 256 + lane * 4);
      ss += v[i].x * v[i].x + v[i].y * v[i].y + v[i].z * v[i].z + v[i].w * v[i].w;
    }
    ss = sum64(ss);
    float rstd = rsqrtf(ss * (1.f / 1024.f) + 1e-6f);
#pragma unroll
    for (int i = 0; i < 4; ++i) {
      float4 ww = *reinterpret_cast<const float4*>(w + i * 256 + lane * 4);
      float4 o = float4{v[i].x * rstd * ww.x, v[i].y * rstd * ww.y, v[i].z * rstd * ww.z, v[i].w * rstd * ww.w};
      *reinterpret_cast<float4*>(x + i * 256 + lane * 4) = o;
    }
  }
}

template <int SUB>
__device__ __forceinline__ void run_phase(const Params& p, int l, char* smem) {
  if (SUB == 0) phase_convert_norm(p, l, smem);
  else if (SUB == 1) phase_inproj(p, smem);
  else if (SUB == 2) phase_rwprep(p, l, smem);
  else if (SUB == 3) phase_scans(p, l, smem);
  else if (SUB == 4) phase_post(p, l, smem);
  else if (SUB == 5) phase_merge(p, l, smem);
  else if (SUB == 6) phase_resid_gemm(p, (const bf16_t*)(p.ws + OFF_Z), ZS, (const bf16_t*)(p.ws + WOFF(OFF_WTOUT, l)), 1024,
                                      (l == 0) ? p.in[I_X] : p.out, smem);
  else if (SUB == 7) phase_norm_only(p, p.out, p.in[I_NORM_FFN] + l * DM);
  else if (SUB == 8) phase_ffn_in(p, l, smem);
  else if (SUB == 9) phase_resid_gemm(p, (const bf16_t*)(p.ws + OFF_Z), FFH, (const bf16_t*)(p.ws + WOFF(OFF_WTF2, l)), FFH, p.out, smem);
  else phase_final(p);
}

#ifndef PHM
#define PHM 0xFFFF
#endif
#define XB_TMO      128
#define XB_XCNT(j)  (256  + 64 * (j))
#define XB_XSUB(j)  (1280 + 64 * (j))
#define XB_XGEN(j)  (2304 + 64 * (j))
#define XB_TOP      3328
#define XB_TOPGEN   3392
#define XCD_BAR_WORDS 3456
#define XB_SPIN_CAP (1u << 18)
#define LAS __attribute__((address_space(3)))

__device__ __forceinline__ unsigned xb_ld(unsigned* p)              { return __hip_atomic_load(p, __ATOMIC_RELAXED, __HIP_MEMORY_SCOPE_AGENT); }
__device__ __forceinline__ unsigned xb_add(unsigned* p, unsigned v) { return __hip_atomic_fetch_add(p, v, __ATOMIC_RELAXED, __HIP_MEMORY_SCOPE_AGENT); }
__device__ __forceinline__ unsigned xb_xcc_id() { return (unsigned)__builtin_amdgcn_s_getreg((3 << 11) | 20) & 0xFu; }
#define XB_SPIN(cond, bar) do { unsigned _sp = 0; while (cond) { __builtin_amdgcn_s_sleep(1); \
    if ((++_sp & 255u) == 0u) { if (xb_ld(&(bar)[XB_TMO])) break; if (_sp > XB_SPIN_CAP) { atomicAdd(&(bar)[XB_TMO], 1u); break; } } } } while (0)

struct XcdBarrier {
    unsigned* bar; unsigned x;
    volatile LAS unsigned* st;
};

__device__ __forceinline__ XcdBarrier xcd_barrier_post(unsigned* bar, volatile LAS unsigned* st) {
    XcdBarrier b; b.bar = bar; b.x = xb_xcc_id(); b.st = st;
    if (threadIdx.x == 0) (void)xb_add(&bar[XB_XCNT(b.x)], 1u);
    return b;
}
__device__ __forceinline__ void xcd_barrier_complete(unsigned* bar, unsigned x, unsigned& nloc, unsigned& nx) {
    const unsigned G = gridDim.x * gridDim.y * gridDim.z;
    unsigned sum, cnt, mine, sp = 0u;
    for (;;) {
        sum = 0u; cnt = 0u; mine = 0u;
#pragma unroll
        for (unsigned j = 0; j < 16; ++j) { const unsigned c = xb_ld(&bar[XB_XCNT(j)]); sum += c; cnt += (c > 0u) ? 1u : 0u; mine = (j == x) ? c : mine; }
        if (sum == G) break;
        __builtin_amdgcn_s_sleep(1);
        if ((++sp & 255u) == 0u) { if (xb_ld(&bar[XB_TMO])) break; if (sp > XB_SPIN_CAP) { atomicAdd(&bar[XB_TMO], 1u); break; } }
    }
    nloc = mine > 0u ? mine : 1u; nx = cnt > 0u ? cnt : 1u;
}

__device__ __forceinline__ void xcd_barrier(const XcdBarrier& b) {
    asm volatile("s_waitcnt vmcnt(0)" ::: "memory");
    __syncthreads();
    if (threadIdx.x == 0) {
        unsigned* bar = b.bar;
        __builtin_amdgcn_s_waitcnt(0);
        unsigned nloc = b.st[0], nx = b.st[1];
        if (nloc == 0u) { xcd_barrier_complete(bar, b.x, nloc, nx); b.st[0] = nloc; b.st[1] = nx; }
        const unsigned old = xb_add(&bar[XB_XSUB(b.x)], 1u);
        const unsigned gen = old / nloc;
        if (old + 1u == (gen + 1u) * nloc) {
            __builtin_amdgcn_fence(__ATOMIC_RELEASE, "agent");
            asm volatile("s_waitcnt vmcnt(0)" ::: "memory");
            const unsigned og = xb_add(&bar[XB_TOP], 1u);
            const unsigned tg = og / nx;
            if (og + 1u == (tg + 1u) * nx) xb_add(&bar[XB_TOPGEN], 1u);
            else XB_SPIN(xb_ld(&bar[XB_TOPGEN]) == tg, bar);
            __builtin_amdgcn_fence(__ATOMIC_ACQUIRE, "agent");
            xb_add(&bar[XB_XGEN(b.x)], 1u);
            asm volatile("s_waitcnt vmcnt(0)" ::: "memory");
        } else {
            XB_SPIN(xb_ld(&bar[XB_XGEN(b.x)]) == gen, bar);
            __builtin_amdgcn_fence(__ATOMIC_ACQUIRE, "agent");
            asm volatile("s_waitcnt vmcnt(0)" ::: "memory");
        }
    }
    __syncthreads();
}


constexpr int LDS_MAIN = 73728;
constexpr int LDS_BYTES = LDS_MAIN + 16;

#if COOP
__global__ void __launch_bounds__(256, 2) fwd_kernel(Params p, int ph0, int ph1, int scan_mask) {
  extern __shared__ __attribute__((aligned(16))) char smem[];
  cg::grid_group grid = cg::this_grid();
  volatile LAS unsigned* xb_st = (volatile LAS unsigned*)(smem + LDS_MAIN);
  if (threadIdx.x == 0) { xb_st[0] = 0u; xb_st[1] = 0u; xb_st[2] = 0u; xb_st[3] = 0u; }
  __syncthreads();
  XcdBarrier xbar = xcd_barrier_post(reinterpret_cast<unsigned*>(p.ws + OFF_BAR), xb_st);
  for (int ph = ph0; ph < ph1; ++ph) {
    if (ph == NPHASES - 1) {
      phase_final(p);
    } else {
      const int l = ph / NPH_LAYER, sub = ph % NPH_LAYER;
      switch (sub) {
        case 0: if (PHM & (1<<0)) run_phase<0>(p, l, smem); break;
        case 1: if (PHM & (1<<1)) run_phase<1>(p, l, smem); break;
        case 2: if (PHM & (1<<2)) run_phase<2>(p, l, smem); break;
        case 3: if (PHM & (1<<3)) phase_scans(p, l, smem, scan_mask); break;
        case 4: if (PHM & (1<<4)) run_phase<4>(p, l, smem); break;
        case 5: if (PHM & (1<<5)) run_phase<5>(p, l, smem); break;
        case 6: if (PHM & (1<<6)) run_phase<6>(p, l, smem); break;
        case 7: if (PHM & (1<<7)) run_phase<7>(p, l, smem); break;
        case 8: if (PHM & (1<<8)) run_phase<8>(p, l, smem); break;
        case 9: if (PHM & (1<<9)) run_phase<9>(p, l, smem); break;
      }
    }
    if (ph + 1 < ph1) {
      if (ph1 > 1000) grid.sync();
      else xcd_barrier(xbar);
    }
  }
}
#else
template <int SUB>
__global__ void __launch_bounds__(256, 2) k_phase(Params p, int l) {
  __shared__ __attribute__((aligned(16))) char smem[65536];
  run_phase<SUB>(p, l, smem);
}
#endif

extern "C" void kernel_launch(void* const* d_in, const int* in_sizes, int n_in, void* d_out, int out_size, void* d_ws,
                              size_t ws_size, hipStream_t stream) {
  if (n_in < 41 || ws_size < WS_NEED) {
    fprintf(stderr, "kernel_launch: bad args n_in=%d ws=%zu need=%zu\n", n_in, ws_size, (size_t)WS_NEED);
    return;
  }
  Params p{};
  for (int i = 0; i < 41; ++i) p.in[i] = (const float*)d_in[i];
  p.out = (float*)d_out;
  p.ws = (char*)d_ws;
#if COOP
  static int grid_blocks = 0;
  if (!grid_blocks) {
    int dev = 0, cus = 0, per_cu = 0;
    hipGetDevice(&dev);
    hipDeviceGetAttribute(&cus, hipDeviceAttributeMultiprocessorCount, dev);
    hipFuncSetAttribute((const void*)fwd_kernel, hipFuncAttributeMaxDynamicSharedMemorySize, LDS_BYTES);
    hipOccupancyMaxActiveBlocksPerMultiprocessor(&per_cu, fwd_kernel, 256, LDS_BYTES);
    if (per_cu > 2) per_cu = 2;
    grid_blocks = cus * per_cu;
  }
#ifdef HYBRID
  for (int ph = 0; ph < NPHASES; ++ph) {
    if (ph % 10 == 3 && ph < 20) {
      const int groups[4] = SCAN_GROUPS;
      for (int gi = 0; gi < 4; ++gi) if (groups[gi]) fwd_kernel<<<grid_blocks, 256, LDS_BYTES, stream>>>(p, ph, ph + 1, groups[gi]);
    } else {
      fwd_kernel<<<grid_blocks, 256, LDS_BYTES, stream>>>(p, ph, ph + 1, 15);
    }
  }
#else
  hipMemsetAsync((char*)d_ws + OFF_BAR, 0, XCD_BAR_WORDS * 4, stream);
  int ph0 = 0, ph1 = NPHASES, smask = 15;
  void* args[] = {&p, &ph0, &ph1, &smask};
  hipError_t e = hipLaunchCooperativeKernel((void*)fwd_kernel, dim3(grid_blocks), dim3(256), args, LDS_BYTES, stream);
  if (e != hipSuccess) fprintf(stderr, "cooperative launch failed: %s (grid %d)\n", hipGetErrorString(e), grid_blocks);
#endif
#else
  const dim3 g(512), b(256);
  for (int l = 0; l < 2; ++l) {
    k_phase<0><<<g, b, 0, stream>>>(p, l);
    k_phase<1><<<g, b, 0, stream>>>(p, l);
    k_phase<2><<<g, b, 0, stream>>>(p, l);
    k_phase<3><<<g, b, 0, stream>>>(p, l);
    k_phase<4><<<g, b, 0, stream>>>(p, l);
    k_phase<5><<<g, b, 0, stream>>>(p, l);
    k_phase<6><<<g, b, 0, stream>>>(p, l);
    k_phase<7><<<g, b, 0, stream>>>(p, l);
    k_phase<8><<<g, b, 0, stream>>>(p, l);
    k_phase<9><<<g, b, 0, stream>>>(p, l);
  }
  k_phase<10><<<g, b, 0, stream>>>(p, 0);
#endif
}
```

```cpp
#include <hip/hip_runtime.h>
#include <hip/hip_cooperative_groups.h>
#include <cstdio>
#include <cstdint>
namespace cg = cooperative_groups;

#ifndef COOP
#define COOP 1
#endif

#define LAS __attribute__((address_space(3)))
typedef unsigned short bf16_t;
typedef __attribute__((ext_vector_type(8))) short bf16x8;
typedef __attribute__((ext_vector_type(4))) float f32x4;
typedef __attribute__((ext_vector_type(4))) unsigned u32x4;

constexpr int T_TOK = 16384, SEQ = 2048, DM = 1024;
constexpr int IN_COLS = 9992, NZ = 5896, ZS = 5904;
constexpr int ZHG = 0, ZRW = 2048, ZS5 = 3840, ZMB = 4352;
constexpr int FFH = 2816;
constexpr int NPH_LAYER = 10, NPHASES = 21;

constexpr size_t OFF_WTIN   = 0;
constexpr size_t OFF_WTGATE = OFF_WTIN + (size_t)5896 * 1024 * 2;
constexpr size_t OFF_WTBR   = OFF_WTGATE + (size_t)4096 * 1024 * 2;
constexpr size_t OFF_WTOUT  = OFF_WTBR + (size_t)4 * 1024 * 512 * 2;
constexpr size_t OFF_WTF1   = OFF_WTOUT + (size_t)1024 * 1024 * 2;
constexpr size_t OFF_WTF2   = OFF_WTF1 + (size_t)5632 * 1024 * 2;
constexpr size_t OFF_WTGLU  = OFF_WTF2 + (size_t)1024 * 2816 * 2;
constexpr size_t OFF_U      = OFF_WTGLU + (size_t)512 * 512 * 2;
constexpr size_t OFF_Z      = OFF_U + (size_t)T_TOK * 1024 * 2;
constexpr size_t OFF_VF     = OFF_Z + (size_t)T_TOK * ZS * 2;
constexpr size_t OFF_BAR    = OFF_VF + (size_t)T_TOK * 512 * 2;
constexpr size_t OFF_WTGATE_B = OFF_BAR + 16384;
constexpr size_t OFF_WB_B     = OFF_WTGATE_B + (size_t)4096 * 1024 * 2;
constexpr size_t OFF_LORA     = OFF_WB_B + (OFF_U - OFF_WTBR);
constexpr size_t LORA_STRIDE  = 524288;
constexpr size_t LO_G2 = 0, LO_W2 = 131072, LO_A2 = 196608, LO_V1 = 262144, LO_V2 = 294912;
constexpr size_t WS_NEED      = OFF_LORA + 2 * LORA_STRIDE;
constexpr size_t DELTA_GATE   = OFF_WTGATE_B - OFF_WTGATE;
constexpr size_t DELTA_WB     = OFF_WB_B - OFF_WTBR;
#define WOFF_GATE(l) (OFF_WTGATE + (size_t)(l) * DELTA_GATE)
#define WOFF(off, l) ((off) + (size_t)(l) * DELTA_WB)

struct Params {
  const float* in[41];
  float* out;
  char* ws;
};

enum { I_X = 0, I_NORM_MIX, I_W_IN, I_W_BRANCH, I_W_OUT, I_NORM_FFN, I_W_FFN_IN, I_W_FFN_OUT, I_NORM_FINAL,
       I_HG_LB, I_HG_NW, I_RW_MU, I_RW_W0, I_RW_W2, I_RW_A0, I_RW_A2, I_RW_G2, I_RW_KK, I_RW_KA, I_RW_RK,
       I_RW_LNW, I_RW_LNB, I_RW_V0, I_RW_V1, I_RW_V2, I_S5_ARE, I_S5_AIM, I_S5_BRE, I_S5_BIM, I_S5_CRE,
       I_S5_CIM, I_S5_D, I_S5_LOGDT, I_S5_WGLU, I_S5_BGLU, I_MB_CONVW, I_MB_CONVB, I_MB_DTB, I_MB_ALOG,
       I_MB_D, I_MB_NW };

__device__ __forceinline__ float bf2f(bf16_t v) { return __uint_as_float(((unsigned)v) << 16); }
typedef __attribute__((ext_vector_type(2))) __bf16 bf16x2_t;
__device__ __forceinline__ unsigned pack2(float a, float b) {
  bf16x2_t v;
  v[0] = (__bf16)a;
  v[1] = (__bf16)b;
  return __builtin_bit_cast(unsigned, v);
}
__device__ __forceinline__ bf16_t f2bf(float f) { return (bf16_t)(pack2(f, 0.f) & 0xffffu); }
__device__ __forceinline__ void store_pair_bf16(bf16_t* p_sub0, const int lane, uint2 a, uint2 b, const bool ok = true) {
  auto rx = __builtin_amdgcn_permlane16_swap(a.x, b.x, false, false);
  auto ry = __builtin_amdgcn_permlane16_swap(a.y, b.y, false, false);
  const int off = ((lane >> 4) & 1) * 16 + (lane >> 5) * 8;
  if (ok) *reinterpret_cast<uint4*>(p_sub0 + off) = uint4{(unsigned)rx[0], (unsigned)ry[0], (unsigned)rx[1], (unsigned)ry[1]};
}
__device__ __forceinline__ float sigmoidf_(float x) { return 1.f / (1.f + __expf(-x)); }
__device__ __forceinline__ float siluf_(float x) { return x / (1.f + __expf(-x)); }
__device__ __forceinline__ float softplusf_(float x) { return x > 20.f ? x : log1pf(__expf(x)); }
__device__ __forceinline__ float gelu_tanh(float x) {
  float u = 0.7978845608028654f * (x + 0.044715f * x * x * x);
  return 0.5f * x * (1.f + tanhf(u));
}
__device__ __forceinline__ float frcp(float x) { return __builtin_amdgcn_rcpf(x); }
__device__ __forceinline__ float fsigmoid(float x) { return frcp(1.f + __expf(-x)); }
__device__ __forceinline__ float fsilu(float x) { return x * frcp(1.f + __expf(-x)); }
__device__ __forceinline__ float fsoftplus(float x) { return x > 20.f ? x : __logf(1.f + __expf(x)); }
__device__ __forceinline__ float ftanh(float x) {
  float e = __expf(2.f * fminf(fmaxf(x, -15.f), 15.f));
  return (e - 1.f) * frcp(e + 1.f);
}
__device__ __forceinline__ float fgelu(float x) {
  float u = 0.7978845608028654f * (x + 0.044715f * x * x * x);
  return 0.5f * x * (1.f + ftanh(u));
}

__device__ __forceinline__ float quad_sum(float x) {
  x += __builtin_bit_cast(float, __builtin_amdgcn_update_dpp(0, __builtin_bit_cast(int, x), 0xB1, 0xF, 0xF, true));
  x += __builtin_bit_cast(float, __builtin_amdgcn_update_dpp(0, __builtin_bit_cast(int, x), 0x4E, 0xF, 0xF, true));
  return x;
}
__device__ __forceinline__ float oct_sum(float x) {
  x = quad_sum(x);
  x += __builtin_bit_cast(float, __builtin_amdgcn_update_dpp(0, __builtin_bit_cast(int, x), 0x141, 0xF, 0xF, true));
  return x;
}
__device__ __forceinline__ float sum16(float x) {
  x = oct_sum(x);
  x += __builtin_bit_cast(float, __builtin_amdgcn_update_dpp(0, __builtin_bit_cast(int, x), 0x140, 0xF, 0xF, true));
  return x;
}
__device__ __forceinline__ float sum64(float x) {
  x = sum16(x); x += __shfl_xor(x, 16); x += __shfl_xor(x, 32);
  return x;
}

__device__ __forceinline__ int opaque_tid() {
  int t = threadIdx.x;
  asm volatile("" : "+v"(t));
  return t;
}

template <int BN>
__device__ __forceinline__ void gemm_mainloop(f32x4 (&acc)[4][BN / 32], const bf16_t* A, int lda, int m0,
                                              const bf16_t* Bt, int ldb, int n0, int nmax, int K, char* smem, const int tid) {
  const int lane = tid & 63, wid = tid >> 6, wm = wid >> 1, wn = wid & 1;
  const int q = tid & 7, r0 = tid >> 3;
  unsigned offA[4], offB[BN / 32];
#pragma unroll
  for (int i = 0; i < 4; ++i) offA[i] = ((unsigned)(m0 + r0 + 32 * i) * (unsigned)lda + (unsigned)q * 8u) * 2u;
#pragma unroll
  for (int i = 0; i < BN / 32; ++i) {
    int row = n0 + r0 + 32 * i;
    row = row < nmax ? row : nmax;
    offB[i] = ((unsigned)row * (unsigned)ldb + (unsigned)q * 8u) * 2u;
  }
  const unsigned sto = (unsigned)r0 * 128u + (unsigned)((q ^ ((r0 >> 1) & 7)) << 4);
  unsigned aoff[4], boff[BN / 32];
#pragma unroll
  for (int mi = 0; mi < 4; ++mi) {
    int row = wm * 64 + mi * 16 + (lane & 15);
    aoff[mi] = (unsigned)row * 128u + (unsigned)(((lane >> 4) ^ ((row >> 1) & 7)) << 4);
  }
#pragma unroll
  for (int ni = 0; ni < BN / 32; ++ni) {
    int row = wn * (BN / 2) + ni * 16 + (lane & 15);
    boff[ni] = (unsigned)row * 128u + (unsigned)(((lane >> 4) ^ ((row >> 1) & 7)) << 4);
  }
  const char* Ab = reinterpret_cast<const char*>(A);
  const char* Bb = reinterpret_cast<const char*>(Bt);
  const int nk = K >> 6;
  constexpr bool WIDE = (BN == 128);
  u32x4 Ra0, Ra1, Ra2, Ra3, Rb0, Rb1, Rb2, Rb3;
  u32x4 Qa0, Qa1, Qa2, Qa3, Qb0, Qb1, Qb2, Qb3;
#define GLOAD(P, TILE)                                                         \
  {                                                                            \
    const char* Ak_ = Ab + (size_t)(TILE) * 128;                               \
    const char* Bk_ = Bb + (size_t)(TILE) * 128;                               \
    P##a0 = *reinterpret_cast<const u32x4*>(Ak_ + offA[0]);                    \
    P##a1 = *reinterpret_cast<const u32x4*>(Ak_ + offA[1]);                    \
    P##a2 = *reinterpret_cast<const u32x4*>(Ak_ + offA[2]);                    \
    P##a3 = *reinterpret_cast<const u32x4*>(Ak_ + offA[3]);                    \
    P##b0 = *reinterpret_cast<const u32x4*>(Bk_ + offB[0]);                    \
    P##b1 = *reinterpret_cast<const u32x4*>(Bk_ + offB[1]);                    \
    if (WIDE) {                                                                \
      P##b2 = *reinterpret_cast<const u32x4*>(Bk_ + offB[BN / 32 - 2]);        \
      P##b3 = *reinterpret_cast<const u32x4*>(Bk_ + offB[BN / 32 - 1]);        \
    }                                                                          \
  }
#define SSTORE(P, BUF)                                                         \
  {                                                                            \
    char* ad_ = smem + (BUF) * 16384 + sto;                                    \
    char* bd_ = smem + 32768 + (BUF) * (BN * 128) + sto;                       \
    *reinterpret_cast<u32x4*>(ad_) = P##a0;                                    \
    *reinterpret_cast<u32x4*>(ad_ + 4096) = P##a1;                             \
    *reinterpret_cast<u32x4*>(ad_ + 8192) = P##a2;                             \
    *reinterpret_cast<u32x4*>(ad_ + 12288) = P##a3;                            \
    *reinterpret_cast<u32x4*>(bd_) = P##b0;                                    \
    *reinterpret_cast<u32x4*>(bd_ + 4096) = P##b1;                             \
    if (WIDE) {                                                                \
      *reinterpret_cast<u32x4*>(bd_ + 8192) = P##b2;                           \
      *reinterpret_cast<u32x4*>(bd_ + 12288) = P##b3;                          \
    }                                                                          \
  }
#define COMPUTE(BUF)                                                           \
  {                                                                            \
    const char* a_s = smem + (BUF) * 16384;                                    \
    const char* b_s = smem + 32768 + (BUF) * (BN * 128);                       \
    _Pragma("unroll") for (int ks = 0; ks < 2; ++ks) {                         \
      bf16x8 af[4], bfr[BN / 32];                                              \
      _Pragma("unroll") for (int mi = 0; mi < 4; ++mi)                         \
          af[mi] = *reinterpret_cast<const bf16x8*>(a_s + (aoff[mi] ^ (ks * 64)));       \
      _Pragma("unroll") for (int ni = 0; ni < BN / 32; ++ni)                   \
          bfr[ni] = *reinterpret_cast<const bf16x8*>(b_s + (boff[ni] ^ (ks * 64)));      \
      _Pragma("unroll") for (int mi = 0; mi < 4; ++mi)                         \
        _Pragma("unroll") for (int ni = 0; ni < BN / 32; ++ni)                 \
          acc[mi][ni] = __builtin_amdgcn_mfma_f32_16x16x32_bf16(bfr[ni], af[mi], acc[mi][ni], 0, 0, 0); \
    }                                                                          \
  }
  if constexpr (WIDE && false) {
    GLOAD(R, 0);
    SSTORE(R, 0);
    GLOAD(R, 1);
    if (nk > 2) GLOAD(Q, 2);
    __syncthreads();
#pragma unroll 1
    for (int kt = 0; kt < nk; kt += 2) {
      __builtin_amdgcn_sched_barrier(0);
      COMPUTE(0);
      __builtin_amdgcn_sched_barrier(0);
      SSTORE(R, 1);
      if (kt + 3 < nk) GLOAD(R, kt + 3);
      __syncthreads();
      __builtin_amdgcn_sched_barrier(0);
      COMPUTE(1);
      __builtin_amdgcn_sched_barrier(0);
      if (kt + 2 < nk) SSTORE(Q, 0);
      if (kt + 4 < nk) GLOAD(Q, kt + 4);
      __syncthreads();
    }
  } else {
    GLOAD(R, 0);
    SSTORE(R, 0);
    __syncthreads();
#pragma unroll 1
    for (int kt = 0; kt < nk; ++kt) {
      const int buf = kt & 1;
      const bool more = (kt + 1 < nk);
      if (more) GLOAD(R, kt + 1);
      __builtin_amdgcn_sched_barrier(0);
      COMPUTE(buf);
      __builtin_amdgcn_sched_barrier(0);
      if (more) SSTORE(R, buf ^ 1);
      __syncthreads();
    }
  }
#undef GLOAD
#undef SSTORE
#undef COMPUTE
}

template <int BN>
__device__ __forceinline__ void zero_acc(f32x4 (&acc)[4][BN / 32]) {
#pragma unroll
  for (int mi = 0; mi < 4; ++mi)
#pragma unroll
    for (int ni = 0; ni < BN / 32; ++ni) acc[mi][ni] = f32x4{0.f, 0.f, 0.f, 0.f};
}

#define RAW_BARRIER() do { asm volatile("s_waitcnt lgkmcnt(0)" ::: "memory"); __builtin_amdgcn_s_barrier(); } while (0)
template <int MROWS>
__device__ __forceinline__ void gemm_mainloop_glds(f32x4 (&acc)[MROWS / 32][4], const bf16_t* A, int lda, int m0, const bf16_t* Bt,
                                                   int ldb, int n0, int nmax, int K, char* smem, const int tid) {
  constexpr int NA = MROWS / 64;
  constexpr int NMI = MROWS / 32;
  constexpr int STAGE = (MROWS + 128) * 64;
  constexpr int BOFF = MROWS * 64;
  const int lane = tid & 63, wid = tid >> 6, wm = wid >> 1, wn = wid & 1;
  unsigned gA[NA], gB[2];
#pragma unroll
  for (int i = 0; i < NA; ++i) {
    const int row = (wid * NA + i) * 16 + (lane >> 2);
    const int q = (lane & 3) ^ ((row >> 2) & 3);
    gA[i] = ((unsigned)(m0 + row) * (unsigned)lda + (unsigned)q * 8u) * 2u;
  }
#pragma unroll
  for (int i = 0; i < 2; ++i) {
    const int row = (wid * 2 + i) * 16 + (lane >> 2);
    const int q = (lane & 3) ^ ((row >> 2) & 3);
    int grow = n0 + row;
    grow = grow < nmax ? grow : nmax;
    gB[i] = ((unsigned)grow * (unsigned)ldb + (unsigned)q * 8u) * 2u;
  }
  unsigned aoff[NMI], boff[4];
#pragma unroll
  for (int mi = 0; mi < NMI; ++mi) {
    int row = wm * (MROWS / 2) + mi * 16 + (lane & 15);
    aoff[mi] = (unsigned)row * 64u + (unsigned)(((lane >> 4) ^ ((row >> 2) & 3)) << 4);
  }
#pragma unroll
  for (int ni = 0; ni < 4; ++ni) {
    int row = wn * 64 + ni * 16 + (lane & 15);
    boff[ni] = (unsigned)BOFF + (unsigned)row * 64u + (unsigned)(((lane >> 4) ^ ((row >> 2) & 3)) << 4);
  }
  const char* Ab = reinterpret_cast<const char*>(A);
  const char* Bb = reinterpret_cast<const char*>(Bt);
  const int nk = K >> 5;
  char* ldsA = smem + wid * (NA * 1024);
  char* ldsB = smem + BOFF + wid * 2048;
#define BG_GLDS(TILE, ST)                                                                                           \
  {                                                                                                                 \
    const char* Ak_ = Ab + (size_t)(TILE) * 64;                                                                     \
    const char* Bk_ = Bb + (size_t)(TILE) * 64;                                                                     \
    char* la_ = ldsA + (ST) * STAGE;                                                                                \
    char* lb_ = ldsB + (ST) * STAGE;                                                                                \
    _Pragma("unroll") for (int i_ = 0; i_ < NA; ++i_)                                                               \
      __builtin_amdgcn_global_load_lds((const unsigned*)(Ak_ + gA[i_]), (LAS unsigned*)(la_ + i_ * 1024), 16, 0, 0); \
    __builtin_amdgcn_global_load_lds((const unsigned*)(Bk_ + gB[0]), (LAS unsigned*)(lb_), 16, 0, 0);              \
    __builtin_amdgcn_global_load_lds((const unsigned*)(Bk_ + gB[1]), (LAS unsigned*)(lb_ + 1024), 16, 0, 0);       \
  }
#define BG_COMPUTE(ST)                                                                                              \
  {                                                                                                                 \
    const char* s_ = smem + (ST) * STAGE;                                                                           \
    bf16x8 bfr[4], af[NMI];                                                                                         \
    _Pragma("unroll") for (int ni = 0; ni < 4; ++ni) bfr[ni] = *reinterpret_cast<const bf16x8*>(s_ + boff[ni]);     \
    _Pragma("unroll") for (int mi = 0; mi < NMI; ++mi) af[mi] = *reinterpret_cast<const bf16x8*>(s_ + aoff[mi]);    \
    __builtin_amdgcn_sched_barrier(0);                                                                              \
    _Pragma("unroll") for (int mi = 0; mi < NMI; ++mi)                                                              \
      _Pragma("unroll") for (int ni = 0; ni < 4; ++ni)                                                              \
        acc[mi][ni] = __builtin_amdgcn_mfma_f32_16x16x32_bf16(bfr[ni], af[mi], acc[mi][ni], 0, 0, 0);               \
  }
  asm volatile("s_waitcnt vmcnt(0)" ::: "memory");
  BG_GLDS(0, 0);
  BG_GLDS(1, 1);
  int st = 0;
#pragma unroll 1
  for (int kt = 0; kt < nk - 1; ++kt) {
    if constexpr (NA == 4) asm volatile("s_waitcnt vmcnt(6)" ::: "memory");
    else asm volatile("s_waitcnt vmcnt(4)" ::: "memory");
    RAW_BARRIER();
    if (kt + 2 < nk) {
      const int st2 = (st >= 1) ? st - 1 : 2;
      BG_GLDS(kt + 2, st2);
    }
    __builtin_amdgcn_sched_barrier(0);
    BG_COMPUTE(st);
    __builtin_amdgcn_sched_barrier(0);
    st = (st == 2) ? 0 : st + 1;
  }
  asm volatile("s_waitcnt vmcnt(0)" ::: "memory");
  RAW_BARRIER();
  BG_COMPUTE(st);
  RAW_BARRIER();
#undef BG_GLDS
#undef BG_COMPUTE
}
__device__ __forceinline__ void gemm_mainloop_big(f32x4 (&acc)[8][4], const bf16_t* A, int lda, int m0, const bf16_t* Bt,
                                                  int ldb, int n0, int nmax, int K, char* smem, const int tid) {
  gemm_mainloop_glds<256>(acc, A, lda, m0, Bt, ldb, n0, nmax, K, smem, tid);
}

__device__ __forceinline__ void zero_acc_big(f32x4 (&acc)[8][4]) {
#pragma unroll
  for (int mi = 0; mi < 8; ++mi)
#pragma unroll
    for (int ni = 0; ni < 4; ++ni) acc[mi][ni] = f32x4{0.f, 0.f, 0.f, 0.f};
}

__device__ __forceinline__ void conv_tile(const float* src, int ld, int nlimit, int k0, int n0, bf16_t* dst, int Kd, int mode,
                                          char* smem, const int tid) {
  float* sT = reinterpret_cast<float*>(smem);
#pragma unroll
  for (int i = 0; i < 16; ++i) {
    int kk = i * 4 + (tid >> 6), nn = tid & 63;
    float v = (n0 + nn < nlimit) ? src[(size_t)(k0 + kk) * ld + n0 + nn] : 0.f;
    sT[kk * 65 + nn] = v;
  }
  __syncthreads();
  {
    int nn = tid >> 2, kq = tid & 3;
    int n = n0 + nn;
    if (n < nlimit) {
      int drow = n;
      if (mode == 1) {
        if (n < FFH) drow = (n >> 4) * 32 + (n & 15);
        else { int j = n - FFH; drow = (j >> 4) * 32 + 16 + (j & 15); }
      }
      unsigned pk[8];
#pragma unroll
      for (int j = 0; j < 8; ++j) pk[j] = pack2(sT[(kq * 16 + 2 * j) * 65 + nn], sT[(kq * 16 + 2 * j + 1) * 65 + nn]);
      uint4* d = reinterpret_cast<uint4*>(dst + (size_t)drow * Kd + k0 + kq * 16);
      d[0] = uint4{pk[0], pk[1], pk[2], pk[3]};
      d[1] = uint4{pk[4], pk[5], pk[6], pk[7]};
    }
  }
  __syncthreads();
}

__device__ __forceinline__ void rmsnorm_row_to_bf16(const float* x, const float* w, bf16_t* out, const int lane) {
  float4 v[4];
  float ss = 0.f;
#pragma unroll
  for (int i = 0; i < 4; ++i) {
    v[i] = *reinterpret_cast<const float4*>(x + i * 256 + lane * 4);
    ss += v[i].x * v[i].x + v[i].y * v[i].y + v[i].z * v[i].z + v[i].w * v[i].w;
  }
  ss = sum64(ss);
  float rstd = rsqrtf(ss * (1.f / 1024.f) + 1e-6f);
#pragma unroll
  for (int i = 0; i < 4; ++i) {
    float4 ww = *reinterpret_cast<const float4*>(w + i * 256 + lane * 4);
    uint2 o;
    o.x = pack2(v[i].x * rstd * ww.x, v[i].y * rstd * ww.y);
    o.y = pack2(v[i].z * rstd * ww.z, v[i].w * rstd * ww.w);
    *reinterpret_cast<uint2*>(out + i * 256 + lane * 4) = o;
  }
}

constexpr int CT_IN = 157 * 16, CT_BR = 512, CT_OUT = 256, CT_F1 = 88 * 16, CT_F2 = 44 * 16, CT_GLU = 64;
constexpr int CT_TOTAL = CT_IN + CT_BR + CT_OUT + CT_F1 + CT_F2 + CT_GLU;

__device__ __forceinline__ void convert_one(const Params& p, int l, int c, char* smem, const int tid) {
  char* ws = p.ws;
  if (c < CT_IN) {
    int nt = c >> 4, kt = c & 15;
    const float* src = p.in[I_W_IN] + (size_t)l * 1024 * IN_COLS;
    if (nt < 64) conv_tile(src, IN_COLS, IN_COLS, kt * 64, nt * 64, (bf16_t*)(ws + WOFF_GATE(l)), 1024, 0, smem, tid);
    else conv_tile(src + 4096, IN_COLS, IN_COLS - 4096, kt * 64, (nt - 64) * 64, (bf16_t*)(ws + OFF_WTIN), 1024, 0, smem, tid);
    return;
  }
  c -= CT_IN;
  if (c < CT_BR) {
    int kb = c >> 7, r = c & 127, nt = r >> 3, kt = r & 7;
    const float* src = p.in[I_W_BRANCH] + ((size_t)l * 4 + kb) * 512 * 1024;
    conv_tile(src, 1024, 1024, kt * 64, nt * 64, (bf16_t*)(ws + WOFF(OFF_WTBR, l)) + (size_t)kb * 1024 * 512, 512, 0, smem, tid);
    return;
  }
  c -= CT_BR;
  if (c < CT_OUT) {
    int nt = c >> 4, kt = c & 15;
    conv_tile(p.in[I_W_OUT] + (size_t)l * 1024 * 1024, 1024, 1024, kt * 64, nt * 64, (bf16_t*)(ws + WOFF(OFF_WTOUT, l)), 1024, 0, smem, tid);
    return;
  }
  c -= CT_OUT;
  if (c < CT_F1) {
    int nt = c >> 4, kt = c & 15;
    conv_tile(p.in[I_W_FFN_IN] + (size_t)l * 1024 * 5632, 5632, 5632, kt * 64, nt * 64, (bf16_t*)(ws + WOFF(OFF_WTF1, l)), 1024, 1, smem, tid);
    return;
  }
  c -= CT_F1;
  if (c < CT_F2) {
    int nt = c / 44, kt = c % 44;
    conv_tile(p.in[I_W_FFN_OUT] + (size_t)l * FFH * 1024, 1024, 1024, kt * 64, nt * 64, (bf16_t*)(ws + WOFF(OFF_WTF2, l)), FFH, 0, smem, tid);
    return;
  }
  c -= CT_F2;
  {
    int nt = c >> 3, kt = c & 7;
    conv_tile(p.in[I_S5_WGLU] + (size_t)l * 512 * 512, 512, 512, kt * 64, nt * 64, (bf16_t*)(ws + WOFF(OFF_WTGLU, l)), 512, 0, smem, tid);
  }
}

constexpr int CT_LORA = 41;
__device__ __forceinline__ void convert_lora(const Params& p, int l, int c, char* smem, const int tid) {
  char* lo = p.ws + OFF_LORA + (size_t)l * LORA_STRIDE;
  if (c < 16) { int nt = c >> 1, kt = c & 1;
    conv_tile(p.in[I_RW_G2] + (size_t)l * 128 * 512, 512, 512, kt * 64, nt * 64, (bf16_t*)(lo + LO_G2), 128, 0, smem, tid); return; }
  c -= 16;
  if (c < 8) { conv_tile(p.in[I_RW_W2] + (size_t)l * 64 * 512, 512, 512, 0, c * 64, (bf16_t*)(lo + LO_W2), 64, 0, smem, tid); return; }
  c -= 8;
  if (c < 8) { conv_tile(p.in[I_RW_A2] + (size_t)l * 64 * 512, 512, 512, 0, c * 64, (bf16_t*)(lo + LO_A2), 64, 0, smem, tid); return; }
  c -= 8;
  if (l == 0) return;
  if (c < 8) { conv_tile(p.in[I_RW_V1] + (size_t)(l - 1) * 512 * 32, 32, 32, c * 64, 0, (bf16_t*)(lo + LO_V1), 512, 0, smem, tid); return; }
  {
    const float* src = p.in[I_RW_V2] + (size_t)(l - 1) * 32 * 512;
    bf16_t* dst = (bf16_t*)(lo + LO_V2);
    for (int e = tid; e < 32 * 512; e += 256) { int ch = e >> 5, r = e & 31; dst[e] = f2bf(src[r * 512 + ch]); }
  }
}

template <int J>
__device__ __forceinline__ void lora_mfma(const char* sIn, int rowb, const bf16_t* Wt, f32x4 (&acc)[8], const int tid) {
  const int lane = tid & 63, w = tid >> 6;
#pragma unroll
  for (int i = 0; i < 8; ++i) acc[i] = f32x4{0.f, 0.f, 0.f, 0.f};
#pragma unroll
  for (int ks = 0; ks < J / 32; ++ks) {
    const bf16x8 a = *reinterpret_cast<const bf16x8*>(sIn + (lane & 15) * rowb + (ks * 32 + 8 * (lane >> 4)) * 2);
#pragma unroll
    for (int i = 0; i < 8; ++i) {
      const bf16x8 b = *reinterpret_cast<const bf16x8*>(Wt + (size_t)((w * 8 + i) * 16 + (lane & 15)) * J + ks * 32 + 8 * (lane >> 4));
      acc[i] = __builtin_amdgcn_mfma_f32_16x16x32_bf16(b, a, acc[i], 0, 0, 0);
    }
  }
}

__device__ void phase_convert_norm(const Params& p, int l, char* smem) {
  const int tid = opaque_tid();
  constexpr int CT_IN_ONLY = CT_IN - 1024;
  const int nconv = (l == 0) ? CT_IN_ONLY + 2 * CT_LORA : 0;
  const int ntask = nconv + T_TOK / 4;
  const float* xsrc = (l == 0) ? p.in[I_X] : p.out;
  for (int t = blockIdx.x; t < ntask; t += gridDim.x) {
    if (t < nconv) {
      if (t < CT_IN_ONLY) convert_one(p, l, t + 1024, smem, tid);
      else { int c = t - CT_IN_ONLY; convert_lora(p, c / CT_LORA, c % CT_LORA, smem, tid); __syncthreads(); }
    } else {
      int row = (t - nconv) * 4 + (tid >> 6);
      rmsnorm_row_to_bf16(xsrc + (size_t)row * DM, p.in[I_NORM_MIX] + l * DM, (bf16_t*)(p.ws + OFF_U) + (size_t)row * DM, tid & 63);
    }
  }
}

__device__ void phase_norm_only(const Params& p, const float* xsrc, const float* w) {
  const int tid = opaque_tid();
  for (int t = blockIdx.x; t < T_TOK / 4; t += gridDim.x) {
    int row = t * 4 + (tid >> 6);
    rmsnorm_row_to_bf16(xsrc + (size_t)row * DM, w, (bf16_t*)(p.ws + OFF_U) + (size_t)row * DM, tid & 63);
  }
}

__device__ __forceinline__ bool tile_map(int t, int NT, int& mt, int& nt) {
  const int x = t & 7, r = t >> 3;
  const int cnt = (NT + 7) >> 3;
  const int ni = r % cnt;
  mt = r / cnt;
  nt = x + 8 * ni;
  return nt < NT;
}
__device__ __forceinline__ int tile_count(int MT, int NT) { return 8 * MT * ((NT + 7) >> 3); }

__device__ void phase_inproj(const Params& p, char* smem) {
  const bf16_t* U = (const bf16_t*)(p.ws + OFF_U);
  const bf16_t* Wt = (const bf16_t*)(p.ws + OFF_WTIN);
  bf16_t* Z = (bf16_t*)(p.ws + OFF_Z);
  const int tid = opaque_tid();
  const int lane = tid & 63, wid = tid >> 6, wm = wid >> 1, wn = wid & 1;
  constexpr int NT = 47;
  for (int t = blockIdx.x; t < tile_count(64, NT); t += gridDim.x) {
    int mt, nt;
    if (!tile_map(t, NT, mt, nt)) continue;
    f32x4 acc[8][4];
    zero_acc_big(acc);
    gemm_mainloop_big(acc, U, 1024, mt * 256, Wt, 1024, nt * 128, NZ - 1, 1024, smem, tid);
#pragma unroll
    for (int mi = 0; mi < 8; ++mi)
#pragma unroll
      for (int np = 0; np < 2; ++np) {
        const int colb = nt * 128 + wn * 64 + np * 32;
        const int row = mt * 256 + wm * 128 + mi * 16 + (lane & 15);
        uint2 a, b;
        a.x = pack2(acc[mi][2 * np][0], acc[mi][2 * np][1]);
        a.y = pack2(acc[mi][2 * np][2], acc[mi][2 * np][3]);
        b.x = pack2(acc[mi][2 * np + 1][0], acc[mi][2 * np + 1][1]);
        b.y = pack2(acc[mi][2 * np + 1][2], acc[mi][2 * np + 1][3]);
        const int mycol = colb + ((lane >> 4) & 1) * 16 + (lane >> 5) * 8;
        store_pair_bf16(Z + (size_t)row * ZS + colb, lane, a, b, mycol < NZ);
      }
  }
}

template <int J>
__device__ __forceinline__ void lora_mm(const float* sIn, const float* W, float (&a0)[16], float (&a1)[16], const int tid) {
#pragma unroll
  for (int i = 0; i < 16; ++i) { a0[i] = 0.f; a1[i] = 0.f; }
#pragma unroll 8
  for (int j = 0; j < J; ++j) {
    float w0 = W[j * 512 + tid], w1 = W[j * 512 + tid + 256];
    const float4* x4 = reinterpret_cast<const float4*>(sIn + j * 16);
#pragma unroll
    for (int q = 0; q < 4; ++q) {
      float4 x = x4[q];
      a0[q * 4 + 0] = fmaf(w0, x.x, a0[q * 4 + 0]); a1[q * 4 + 0] = fmaf(w1, x.x, a1[q * 4 + 0]);
      a0[q * 4 + 1] = fmaf(w0, x.y, a0[q * 4 + 1]); a1[q * 4 + 1] = fmaf(w1, x.y, a1[q * 4 + 1]);
      a0[q * 4 + 2] = fmaf(w0, x.z, a0[q * 4 + 2]); a1[q * 4 + 2] = fmaf(w1, x.z, a1[q * 4 + 2]);
      a0[q * 4 + 3] = fmaf(w0, x.w, a0[q * 4 + 3]); a1[q * 4 + 3] = fmaf(w1, x.w, a1[q * 4 + 3]);
    }
  }
}

__device__ __forceinline__ float rw_shift(const bf16_t* Z, int row, int s, int rc, float mu) {
  float cur = bf2f(Z[(size_t)row * ZS + ZRW + rc]);
  float prev = (s > 0) ? bf2f(Z[(size_t)(row - 1) * ZS + ZRW + rc]) : 0.f;
  return cur + (prev - cur) * mu;
}

__device__ __forceinline__ void unpack8(const uint4& v, float (&f)[8]) {
  f[0] = bf2f((bf16_t)(v.x & 0xffff)); f[1] = bf2f((bf16_t)(v.x >> 16));
  f[2] = bf2f((bf16_t)(v.y & 0xffff)); f[3] = bf2f((bf16_t)(v.y >> 16));
  f[4] = bf2f((bf16_t)(v.z & 0xffff)); f[5] = bf2f((bf16_t)(v.z >> 16));
  f[6] = bf2f((bf16_t)(v.w & 0xffff)); f[7] = bf2f((bf16_t)(v.w >> 16));
}
__device__ __forceinline__ void rw_shift8(const uint4& cur, const uint4& prev, const float* mu8, float (&out)[8]) {
  float c[8], q[8];
  unpack8(cur, c); unpack8(prev, q);
#pragma unroll
  for (int e = 0; e < 8; ++e) out[e] = c[e] + (q[e] - c[e]) * mu8[e];
}

__device__ void phase_rwprep(const Params& p, int l, char* smem) {
  const bf16_t* Z = (const bf16_t*)(p.ws + OFF_Z);
  bf16_t* LW = (bf16_t*)(p.ws + OFF_U);
  bf16_t* LA = LW + (size_t)T_TOK * 512;
  bf16_t* VF = (bf16_t*)(p.ws + OFF_VF);
  const char* lo = p.ws + OFF_LORA + (size_t)l * LORA_STRIDE;
  char* sXw = smem;
  char* sXa = smem + 2304;
  char* sZv = smem + 4608;
  float* sTmpF = reinterpret_cast<float*>(smem + 4608 + 16640);
  char* sTmp = smem + 4608 + 16640 + 4096;
  const float* mu = p.in[I_RW_MU] + l * 1792;
  const int tid = opaque_tid(), lane = tid & 63, w = tid >> 6;
  for (int t = blockIdx.x; t < T_TOK / 16; t += gridDim.x) {
    const int row0 = t * 16;
    {
      const int tok = tid >> 4, j8 = (tid & 15) * 8;
      const int row = row0 + tok, sq = row & (SEQ - 1);
      const bf16_t* zp = Z + (size_t)row * ZS + ZRW + 1536 + j8;
      const uint4 cur = *reinterpret_cast<const uint4*>(zp);
      uint4 prev = uint4{0u, 0u, 0u, 0u};
      if (sq > 0) prev = *reinterpret_cast<const uint4*>(zp - ZS);
      float z[8];
      rw_shift8(cur, prev, mu + 1536 + j8, z);
      if (j8 < 64) {
        *reinterpret_cast<uint4*>(sXw + tok * 144 + j8 * 2) =
            uint4{pack2(ftanh(z[0]), ftanh(z[1])), pack2(ftanh(z[2]), ftanh(z[3])), pack2(ftanh(z[4]), ftanh(z[5])), pack2(ftanh(z[6]), ftanh(z[7]))};
      } else {
        *reinterpret_cast<uint4*>(sXa + tok * 144 + (j8 - 64) * 2) =
            uint4{pack2(z[0], z[1]), pack2(z[2], z[3]), pack2(z[4], z[5]), pack2(z[6], z[7])};
      }
    }
    {
      const int c8 = (tid & 63) * 8, tg = tid >> 6;
      const float* mu8 = mu + 1024 + c8;
      const int rowa = row0 + tg * 4;
      const bf16_t* zp = Z + (size_t)rowa * ZS + ZRW + 1024 + c8;
      uint4 prev = uint4{0u, 0u, 0u, 0u};
      if ((rowa & (SEQ - 1)) > 0) prev = *reinterpret_cast<const uint4*>(zp - ZS);
#pragma unroll
      for (int k = 0; k < 4; ++k) {
        const uint4 cur = *reinterpret_cast<const uint4*>(zp + (size_t)k * ZS);
        float z[8];
        rw_shift8(cur, prev, mu8, z);
        const uint4 o = uint4{pack2(z[0], z[1]), pack2(z[2], z[3]), pack2(z[4], z[5]), pack2(z[6], z[7])};
        *reinterpret_cast<uint4*>(sZv + (tg * 4 + k) * 1040 + c8 * 2) = o;
        if (l == 0) *reinterpret_cast<uint4*>(VF + (size_t)(rowa + k) * 512 + c8) = o;
        prev = cur;
      }
    }
    __syncthreads();
    f32x4 acc[8];
    lora_mfma<64>(sXw, 144, (const bf16_t*)(lo + LO_W2), acc, tid);
#pragma unroll
    for (int i = 0; i < 8; ++i)
      *reinterpret_cast<uint2*>(LW + (size_t)(row0 + (lane & 15)) * 512 + (w * 8 + i) * 16 + (lane >> 4) * 4) =
          uint2{pack2(acc[i][0], acc[i][1]), pack2(acc[i][2], acc[i][3])};
    lora_mfma<64>(sXa, 144, (const bf16_t*)(lo + LO_A2), acc, tid);
#pragma unroll
    for (int i = 0; i < 8; ++i)
      *reinterpret_cast<uint2*>(LA + (size_t)(row0 + (lane & 15)) * 512 + (w * 8 + i) * 16 + (lane >> 4) * 4) =
          uint2{pack2(acc[i][0], acc[i][1]), pack2(acc[i][2], acc[i][3])};
    if (l > 0) {
      {
        const bf16_t* v1t = (const bf16_t*)(lo + LO_V1);
        const int ntile = w & 1, kh = w >> 1;
        f32x4 tacc = f32x4{0.f, 0.f, 0.f, 0.f};
#pragma unroll
        for (int ks = 0; ks < 8; ++ks) {
          const int k0 = (kh * 8 + ks) * 32 + 8 * (lane >> 4);
          const bf16x8 a = *reinterpret_cast<const bf16x8*>(sZv + (lane & 15) * 1040 + k0 * 2);
          const bf16x8 b = *reinterpret_cast<const bf16x8*>(v1t + (size_t)(ntile * 16 + (lane & 15)) * 512 + k0);
          tacc = __builtin_amdgcn_mfma_f32_16x16x32_bf16(a, b, tacc, 0, 0, 0);
        }
#pragma unroll
        for (int jj = 0; jj < 4; ++jj)
          sTmpF[(kh * 16 + (lane >> 4) * 4 + jj) * 32 + ntile * 16 + (lane & 15)] = tacc[jj];
      }
      __syncthreads();
      for (int e = tid; e < 512; e += 256) {
        int tok = e >> 5, r = e & 31;
        *reinterpret_cast<bf16_t*>(sTmp + tok * 80 + r * 2) = f2bf(sTmpF[tok * 32 + r] + sTmpF[(16 + tok) * 32 + r]);
      }
      __syncthreads();
      lora_mfma<32>(sTmp, 80, (const bf16_t*)(lo + LO_V2), acc, tid);
      const float* v0 = p.in[I_RW_V0] + (size_t)(l - 1) * 512;
#pragma unroll
      for (int i = 0; i < 8; ++i) {
        const int tok = lane & 15, ch0 = (w * 8 + i) * 16 + (lane >> 4) * 4;
        const float4 b4 = *reinterpret_cast<const float4*>(v0 + ch0);
        const uint2 zr = *reinterpret_cast<const uint2*>(sZv + tok * 1040 + ch0 * 2);
        bf16_t* vp = VF + (size_t)(row0 + tok) * 512 + ch0;
        const uint2 vr = *reinterpret_cast<const uint2*>(vp);
        const float z0 = bf2f((bf16_t)(zr.x & 0xffff)), z1 = bf2f((bf16_t)(zr.x >> 16));
        const float z2 = bf2f((bf16_t)(zr.y & 0xffff)), z3 = bf2f((bf16_t)(zr.y >> 16));
        const float f0 = bf2f((bf16_t)(vr.x & 0xffff)), f1 = bf2f((bf16_t)(vr.x >> 16));
        const float f2 = bf2f((bf16_t)(vr.y & 0xffff)), f3 = bf2f((bf16_t)(vr.y >> 16));
        uint2 o;
        o.x = pack2(z0 + (f0 - z0) * fsigmoid(b4.x + acc[i][0]), z1 + (f1 - z1) * fsigmoid(b4.y + acc[i][1]));
        o.y = pack2(z2 + (f2 - z2) * fsigmoid(b4.z + acc[i][2]), z3 + (f3 - z3) * fsigmoid(b4.w + acc[i][3]));
        *reinterpret_cast<uint2*>(vp) = o;
      }
    }
    __syncthreads();
  }
}

__device__ void hg_scan(const Params& p, int l, int task, char* smem) {
  const int b = task >> 3, h = (task >> 1) & 3, vg = task & 1;
  float* sFg = reinterpret_cast<float*>(smem);
  float* sQs = sFg + 16 * 128;
  float* sO = sQs + 16 * 128;
  float* sVv = sO + 4 * 16 * 64;
  const int tid = opaque_tid(), w = tid >> 6, lane = tid & 63;
  bf16_t* Z = (bf16_t*)(p.ws + OFF_Z) + (size_t)b * SEQ * ZS;
  const int ks = tid & 127;
  float lb = 0.f;
  if (l > 0) {
    float x0 = p.in[I_HG_LB][h * 128 + ks], x1 = p.in[I_HG_LB][512 + h * 128 + ks];
    float m = fmaxf(x0, x1), e0 = expf(x0 - m), e1 = expf(x1 - m);
    lb = e1 / (e0 + e1);
  }
  float s[32];
#pragma unroll
  for (int j = 0; j < 32; ++j) s[j] = 0.f;
  const int vcol = ZHG + 1024 + h * 128 + vg * 64;
  const int qcol = ZHG + h * 128 + ks;
  bf16_t rq0, rq1, rq2, rq3, rq4, rq5, rq6, rq7, rf0, rf1, rf2, rf3, rf4, rf5, rf6, rf7, rv0, rv1, rv2, rv3;
#define HG_LOAD(T0)                                                                                \
  {                                                                                                \
    const bf16_t* zb = Z + (size_t)((T0) + (tid >> 7)) * ZS + qcol;                                \
    rq0 = zb[0]; rf0 = zb[512]; zb += 2 * ZS; rq1 = zb[0]; rf1 = zb[512]; zb += 2 * ZS;            \
    rq2 = zb[0]; rf2 = zb[512]; zb += 2 * ZS; rq3 = zb[0]; rf3 = zb[512]; zb += 2 * ZS;            \
    rq4 = zb[0]; rf4 = zb[512]; zb += 2 * ZS; rq5 = zb[0]; rf5 = zb[512]; zb += 2 * ZS;            \
    rq6 = zb[0]; rf6 = zb[512]; zb += 2 * ZS; rq7 = zb[0]; rf7 = zb[512];                          \
    const bf16_t* zv = Z + (size_t)((T0) + w) * ZS + vcol + lane;                                  \
    rv0 = zv[0]; rv1 = zv[4 * ZS]; rv2 = zv[8 * ZS]; rv3 = zv[12 * ZS];                            \
  }
#define HG_PUT1(I, RQ, RF)                                                                         \
  {                                                                                                \
    int t = (tid >> 7) + 2 * (I);                                                                  \
    sFg[t * 128 + ks] = fmaxf(lb + (1.f - lb) * fsigmoid(bf2f(RF)), 1e-30f);                       \
    sQs[t * 128 + ks] = fsilu(bf2f(RQ));                                                           \
  }
#define HG_PROCESS()                                                                               \
  {                                                                                                \
    HG_PUT1(0, rq0, rf0) HG_PUT1(1, rq1, rf1) HG_PUT1(2, rq2, rf2) HG_PUT1(3, rq3, rf3)            \
    HG_PUT1(4, rq4, rf4) HG_PUT1(5, rq5, rf5) HG_PUT1(6, rq6, rf6) HG_PUT1(7, rq7, rf7)            \
    sVv[(w)*64 + lane] = bf2f(rv0); sVv[(w + 4) * 64 + lane] = bf2f(rv1);                          \
    sVv[(w + 8) * 64 + lane] = bf2f(rv2); sVv[(w + 12) * 64 + lane] = bf2f(rv3);                   \
  }
  HG_LOAD(0);
  HG_PROCESS();
  __syncthreads();
  constexpr int NCH = SEQ / 16;
#pragma unroll 1
  for (int c = 0; c < NCH; ++c) {
    const int t0 = c * 16;
    const int tn = (c + 1 < NCH) ? t0 + 16 : t0;
    HG_LOAD(tn);
    __builtin_amdgcn_sched_barrier(0);
#pragma unroll 2
    for (int t = 0; t < 16; ++t) {
      const float v = sVv[t * 64 + lane];
      const float opv = (lane < 32) ? sFg[t * 128 + w * 32 + lane] : sQs[t * 128 + w * 32 + (lane - 32)];
      const int opi = __builtin_bit_cast(int, opv);
      float o = 0.f;
#pragma unroll
      for (int j = 0; j < 32; ++j) {
        const float fg = __builtin_bit_cast(float, __builtin_amdgcn_readlane(opi, j));
        const float qq = __builtin_bit_cast(float, __builtin_amdgcn_readlane(opi, 32 + j));
        const float kv = fmaf(-fg, v, v);
        s[j] = fmaf(s[j], fg, kv);
        o = fmaf(qq, s[j], o);
      }
      sO[(w * 16 + t) * 64 + lane] = o;
    }
    __builtin_amdgcn_sched_barrier(0);
    __syncthreads();
    {
      int t = tid >> 4, v4 = (tid & 15) * 4;
      float4 a = *reinterpret_cast<const float4*>(sO + (0 * 16 + t) * 64 + v4);
      float4 bq = *reinterpret_cast<const float4*>(sO + (1 * 16 + t) * 64 + v4);
      float4 cq = *reinterpret_cast<const float4*>(sO + (2 * 16 + t) * 64 + v4);
      float4 d = *reinterpret_cast<const float4*>(sO + (3 * 16 + t) * 64 + v4);
      uint2 o;
      o.x = pack2(a.x + bq.x + cq.x + d.x, a.y + bq.y + cq.y + d.y);
      o.y = pack2(a.z + bq.z + cq.z + d.z, a.w + bq.w + cq.w + d.w);
      *reinterpret_cast<uint2*>(Z + (size_t)(t0 + t) * ZS + vcol + v4) = o;
    }
    HG_PROCESS();
    __syncthreads();
  }
#undef HG_LOAD
#undef HG_PUT1
#undef HG_PROCESS
}

__device__ void mb_scan(const Params& p, int l, int task, char* smem) {
  const int b = task >> 3, hd = task & 7, g = hd >> 2;
  float* sB = reinterpret_cast<float*>(smem);
  float* sC = sB + 16 * 128;
  float* sX = sC + 16 * 128;
  float* sDt = sX + 16 * 64;
  float* sDA = sDt + 16;
  float* sO = sDA + 16;
  const int tid = opaque_tid(), w = tid >> 6, lane = tid & 63;
  bf16_t* Z = (bf16_t*)(p.ws + OFF_Z) + (size_t)b * SEQ * ZS;
  const float* cw = p.in[I_MB_CONVW] + (size_t)l * 4 * 1024;
  const float* cb = p.in[I_MB_CONVB] + (size_t)l * 1024;
  int ci0, ci1;
  {
    int ch = tid;
    ci0 = (ch < 64) ? hd * 64 + ch : (ch < 192 ? 512 + g * 128 + (ch - 64) : 768 + g * 128 + (ch - 192));
    ci1 = 768 + g * 128 + 64 + (tid & 63);
  }
  float* dstA = (tid < 64) ? (sX + tid) : (tid < 192 ? (sB + (tid - 64)) : (sC + (tid - 192)));
  const int strideA = (tid < 64) ? 64 : 128;
  const float w0a = cw[ci0], w1a = cw[1024 + ci0], w2a = cw[2048 + ci0], w3a = cw[3072 + ci0], ba = cb[ci0];
  const float w0b = cw[ci1], w1b = cw[1024 + ci1], w2b = cw[2048 + ci1], w3b = cw[3072 + ci1], bb = cb[ci1];
  const float Aneg = -expf(p.in[I_MB_ALOG][l * 8 + hd]);
  const float dtb = p.in[I_MB_DTB][l * 8 + hd];
  const float Dsk = p.in[I_MB_D][l * 8 + hd];
  float s[32];
#pragma unroll
  for (int j = 0; j < 32; ++j) s[j] = 0.f;
  float pa1 = 0.f, pa2 = 0.f, pa3 = 0.f;
  const int tq = (tid >> 6) * 4;
  const int xcol = ZMB + 512;
  const int rt = tid >> 4, rp4 = (tid & 15) * 4;
  bf16_t xa0, xa1, xa2, xa3, xa4, xa5, xa6, xa7, xa8, xa9, xa10, xa11, xa12, xa13, xa14, xa15;
  bf16_t xb0, xb1, xb2, xb3, xb4, xb5, xb6;
  bf16_t rdt;
  uint2 gcur, gnext;
#define MB_LOAD(T0)                                                                                 \
  {                                                                                                 \
    const bf16_t* za = Z + (size_t)(T0) * ZS + xcol + ci0;                                          \
    xa0 = za[0]; xa1 = za[ZS]; xa2 = za[2 * ZS]; xa3 = za[3 * ZS]; xa4 = za[4 * ZS]; xa5 = za[5 * ZS];        \
    xa6 = za[6 * ZS]; xa7 = za[7 * ZS]; xa8 = za[8 * ZS]; xa9 = za[9 * ZS]; xa10 = za[10 * ZS];     \
    xa11 = za[11 * ZS]; xa12 = za[12 * ZS]; xa13 = za[13 * ZS]; xa14 = za[14 * ZS]; xa15 = za[15 * ZS];       \
    {                                                                                               \
      const int r0_ = (T0) + tq - 3;                                                                \
      const bf16_t* zb = Z + (ptrdiff_t)r0_ * ZS + xcol + ci1;                                      \
      xb0 = (r0_ >= 0) ? zb[0] : (bf16_t)0; xb1 = (r0_ + 1 >= 0) ? zb[ZS] : (bf16_t)0;              \
      xb2 = (r0_ + 2 >= 0) ? zb[2 * ZS] : (bf16_t)0;                                                \
      xb3 = zb[3 * ZS]; xb4 = zb[4 * ZS]; xb5 = zb[5 * ZS]; xb6 = zb[6 * ZS];                       \
    }                                                                                               \
    rdt = Z[(size_t)((T0) + (tid & 15)) * ZS + ZMB + 1536 + hd];                                    \
    gnext = *reinterpret_cast<const uint2*>(Z + (size_t)((T0) + rt) * ZS + ZMB + hd * 64 + rp4);    \
  }
#define MB_CONV_A(T, XR)                                                                            \
  {                                                                                                 \
    float xv = bf2f(XR);                                                                            \
    dstA[(T)*strideA] = fsilu(ba + w0a * pa3 + w1a * pa2 + w2a * pa1 + w3a * xv);                   \
    pa3 = pa2; pa2 = pa1; pa1 = xv;                                                                 \
  }
#define MB_CONV_B(J, X0, X1, X2, X3)                                                                \
  sC[(tq + (J)) * 128 + 64 + (tid & 63)] = fsilu(bb + w0b * bf2f(X0) + w1b * bf2f(X1) + w2b * bf2f(X2) + w3b * bf2f(X3));
#define MB_PROCESS()                                                                                \
  {                                                                                                 \
    MB_CONV_A(0, xa0) MB_CONV_A(1, xa1) MB_CONV_A(2, xa2) MB_CONV_A(3, xa3) MB_CONV_A(4, xa4)       \
    MB_CONV_A(5, xa5) MB_CONV_A(6, xa6) MB_CONV_A(7, xa7) MB_CONV_A(8, xa8) MB_CONV_A(9, xa9)       \
    MB_CONV_A(10, xa10) MB_CONV_A(11, xa11) MB_CONV_A(12, xa12) MB_CONV_A(13, xa13)                 \
    MB_CONV_A(14, xa14) MB_CONV_A(15, xa15)                                                         \
    MB_CONV_B(0, xb0, xb1, xb2, xb3) MB_CONV_B(1, xb1, xb2, xb3, xb4)                               \
    MB_CONV_B(2, xb2, xb3, xb4, xb5) MB_CONV_B(3, xb3, xb4, xb5, xb6)                               \
    if (tid < 16) {                                                                                 \
      float dt = fsoftplus(bf2f(rdt) + dtb);                                                        \
      sDt[tid] = dt;                                                                                \
      sDA[tid] = __expf(Aneg * dt);                                                                 \
    }                                                                                               \
    gcur = gnext;                                                                                   \
  }
  MB_LOAD(0);
  MB_PROCESS();
  __syncthreads();
  constexpr int NCH = SEQ / 16;
#pragma unroll 1
  for (int c = 0; c < NCH; ++c) {
    const int t0 = c * 16;
    const bool more = (c + 1 < NCH);
    const int tn = more ? t0 + 16 : t0;
    MB_LOAD(tn);
    __builtin_amdgcn_sched_barrier(0);
#pragma unroll 2
    for (int t = 0; t < 16; ++t) {
      const float dA = sDA[t];
      const float xs_ = sX[t * 64 + lane];
      const float xdt = xs_ * sDt[t];
      const float opv = (lane < 32) ? sB[t * 128 + w * 32 + lane] : sC[t * 128 + w * 32 + (lane - 32)];
      const int opi = __builtin_bit_cast(int, opv);
      float y = (w == 0) ? Dsk * xs_ : 0.f;
#pragma unroll
      for (int j = 0; j < 32; ++j) {
        const float bn = __builtin_bit_cast(float, __builtin_amdgcn_readlane(opi, j));
        const float cn = __builtin_bit_cast(float, __builtin_amdgcn_readlane(opi, 32 + j));
        s[j] = fmaf(s[j], dA, bn * xdt);
        y = fmaf(cn, s[j], y);
      }
      sO[(w * 16 + t) * 64 + lane] = y;
    }
    __builtin_amdgcn_sched_barrier(0);
    __syncthreads();
    {
      float4 a = *reinterpret_cast<const float4*>(sO + (0 * 16 + rt) * 64 + rp4);
      float4 bq = *reinterpret_cast<const float4*>(sO + (1 * 16 + rt) * 64 + rp4);
      float4 cq = *reinterpret_cast<const float4*>(sO + (2 * 16 + rt) * 64 + rp4);
      float4 d = *reinterpret_cast<const float4*>(sO + (3 * 16 + rt) * 64 + rp4);
      bf16_t* gp = Z + (size_t)(t0 + rt) * ZS + ZMB + hd * 64 + rp4;
      float g0 = bf2f((bf16_t)(gcur.x & 0xffff)), g1 = bf2f((bf16_t)(gcur.x >> 16));
      float g2 = bf2f((bf16_t)(gcur.y & 0xffff)), g3 = bf2f((bf16_t)(gcur.y >> 16));
      float y0 = a.x + bq.x + cq.x + d.x;
      float y1 = a.y + bq.y + cq.y + d.y;
      float y2 = a.z + bq.z + cq.z + d.z;
      float y3 = a.w + bq.w + cq.w + d.w;
      uint2 o;
      o.x = pack2(y0 * fsilu(g0), y1 * fsilu(g1));
      o.y = pack2(y2 * fsilu(g2), y3 * fsilu(g3));
      *reinterpret_cast<uint2*>(gp) = o;
    }
    if (more) MB_PROCESS();
    __syncthreads();
  }
#undef MB_LOAD
#undef MB_CONV_A
#undef MB_CONV_B
#undef MB_PROCESS
}

__device__ void s5_scan(const Params& p, int l, int task, char* smem) {
  const int tid = opaque_tid(), w = tid >> 6, lane = tid & 63;
  const int b = task >> 3, g = (task & 7) * 4 + w;
  char* base = smem + w * 6144;
  float* sU = reinterpret_cast<float*>(base);
  char* sHb = base + 1024;
  bf16_t* Z = (bf16_t*)(p.ws + OFF_Z) + (size_t)b * SEQ * ZS + ZS5 + g * 16;
  const int n = lane;
  float lr, li, bbr[16], bbi[16];
  bf16x8 Bf0, Bf1, Bf2, Bf3;
  {
    float dt = expf(p.in[I_S5_LOGDT][l * 32 + g]);
    float are = p.in[I_S5_ARE][(l * 32 + g) * 64 + n], aim = p.in[I_S5_AIM][(l * 32 + g) * 64 + n];
    float mag = expf(dt * are);
    lr = mag * cosf(dt * aim); li = mag * sinf(dt * aim);
    float den = are * are + aim * aim;
    float cr = ((lr - 1.f) * are + li * aim) / den;
    float ci = (li * are - (lr - 1.f) * aim) / den;
    const float* bre = p.in[I_S5_BRE] + ((size_t)(l * 32 + g) * 64 + n) * 16;
    const float* bim = p.in[I_S5_BIM] + ((size_t)(l * 32 + g) * 64 + n) * 16;
#pragma unroll
    for (int c = 0; c < 16; ++c) {
      float br = bre[c], bi = bim[c];
      bbr[c] = cr * br - ci * bi;
      bbi[c] = cr * bi + ci * br;
    }
    const float* cre = p.in[I_S5_CRE] + (size_t)(l * 32 + g) * 16 * 64 + (lane & 15) * 64;
    const float* cim = p.in[I_S5_CIM] + (size_t)(l * 32 + g) * 16 * 64 + (lane & 15) * 64;
#pragma unroll
    for (int j = 0; j < 8; ++j) {
      const int kb = 8 * (lane >> 4) + j;
      const int n0 = kb >> 1;
      const bool im = (j & 1);
      Bf0[j] = (short)f2bf(im ? -cim[n0] : cre[n0]);
      Bf1[j] = (short)f2bf(im ? -cim[n0 + 16] : cre[n0 + 16]);
      Bf2[j] = (short)f2bf(im ? -cim[n0 + 32] : cre[n0 + 32]);
      Bf3[j] = (short)f2bf(im ? -cim[n0 + 48] : cre[n0 + 48]);
    }
  }
  const float dsk = p.in[I_S5_D][l * 512 + g * 16 + (lane & 15)];
  const int pt = lane >> 2, pc4 = (lane & 3) * 4;
  float hr = 0.f, hi = 0.f;
  uint2 unext = *reinterpret_cast<const uint2*>(Z + (size_t)pt * ZS + pc4);
  constexpr int NCH = SEQ / 16;
#pragma unroll 1
  for (int c = 0; c < NCH; ++c) {
    const int t0 = c * 16;
    {
      const uint2 ur = unext;
      *reinterpret_cast<float4*>(sU + pt * 16 + pc4) =
          float4{bf2f((bf16_t)(ur.x & 0xffff)), bf2f((bf16_t)(ur.x >> 16)), bf2f((bf16_t)(ur.y & 0xffff)), bf2f((bf16_t)(ur.y >> 16))};
      const int tn = (c + 1 < NCH) ? t0 + 16 : t0;
      unext = *reinterpret_cast<const uint2*>(Z + (size_t)(tn + pt) * ZS + pc4);
    }
    __builtin_amdgcn_sched_barrier(0);
    __syncthreads();
#pragma unroll 2
    for (int t = 0; t < 16; ++t) {
      const float4* u4 = reinterpret_cast<const float4*>(sU + t * 16);
      float bur = 0.f, bui = 0.f;
#pragma unroll
      for (int q = 0; q < 4; ++q) {
        float4 u = u4[q];
        bur = fmaf(bbr[q * 4 + 0], u.x, bur); bui = fmaf(bbi[q * 4 + 0], u.x, bui);
        bur = fmaf(bbr[q * 4 + 1], u.y, bur); bui = fmaf(bbi[q * 4 + 1], u.y, bui);
        bur = fmaf(bbr[q * 4 + 2], u.z, bur); bui = fmaf(bbi[q * 4 + 2], u.z, bui);
        bur = fmaf(bbr[q * 4 + 3], u.w, bur); bui = fmaf(bbi[q * 4 + 3], u.w, bui);
      }
      float nr = lr * hr - li * hi + bur;
      float ni = lr * hi + li * hr + bui;
      hr = nr; hi = ni;
      *reinterpret_cast<unsigned*>(sHb + t * 272 + n * 4) = pack2(hr, hi);
    }
    __syncthreads();
    {
      f32x4 acc = f32x4{0.f, 0.f, 0.f, 0.f};
      const char* ap = sHb + (lane & 15) * 272 + (lane >> 4) * 16;
      acc = __builtin_amdgcn_mfma_f32_16x16x32_bf16(*reinterpret_cast<const bf16x8*>(ap), Bf0, acc, 0, 0, 0);
      acc = __builtin_amdgcn_mfma_f32_16x16x32_bf16(*reinterpret_cast<const bf16x8*>(ap + 64), Bf1, acc, 0, 0, 0);
      acc = __builtin_amdgcn_mfma_f32_16x16x32_bf16(*reinterpret_cast<const bf16x8*>(ap + 128), Bf2, acc, 0, 0, 0);
      acc = __builtin_amdgcn_mfma_f32_16x16x32_bf16(*reinterpret_cast<const bf16x8*>(ap + 192), Bf3, acc, 0, 0, 0);
      const int cc = lane & 15, tb = (lane >> 4) * 4;
#pragma unroll
      for (int jj = 0; jj < 4; ++jj) {
        float y = acc[jj] + dsk * sU[(tb + jj) * 16 + cc];
        Z[(size_t)(t0 + tb + jj) * ZS + cc] = f2bf(fgelu(y));
      }
    }
    __syncthreads();
  }
}

__device__ void rw_scan(const Params& p, int l, int task, char* smem) {
  const int b = task >> 3, h = task & 7;
  float* sR = reinterpret_cast<float*>(smem);
  float* sW = sR + 1024;
  float* sK = sW + 1024;
  float* sA = sK + 1024;
  float* sBb = sA + 1024;
  float* sV = sBb + 1024;
  float* sY = sV + 1024;
  float* sBonus = sY + 1024;
  const int tid = opaque_tid(), w = tid >> 6, lane = tid & 63;
  const size_t tokbase = (size_t)b * SEQ;
  bf16_t* Z = (bf16_t*)(p.ws + OFF_Z) + tokbase * ZS;
  const bf16_t* LW = (const bf16_t*)(p.ws + OFF_U) + tokbase * 512;
  const bf16_t* LA = LW + (size_t)T_TOK * 512;
  const bf16_t* VF = (const bf16_t*)(p.ws + OFF_VF) + tokbase * 512;
  const int st = tid >> 4, c4 = (tid & 15) * 4, ch = h * 64 + c4;
  float mur[4], muk[4], w0[4], a0[4], kk_[4], ka_[4], rk_[4], lnw[4], lnb[4];
#pragma unroll
  for (int e = 0; e < 4; ++e) {
    mur[e] = p.in[I_RW_MU][l * 1792 + ch + e];
    muk[e] = p.in[I_RW_MU][l * 1792 + 512 + ch + e];
    w0[e] = p.in[I_RW_W0][l * 512 + ch + e];
    a0[e] = p.in[I_RW_A0][l * 512 + ch + e];
    kk_[e] = p.in[I_RW_KK][l * 512 + ch + e];
    ka_[e] = p.in[I_RW_KA][l * 512 + ch + e];
    rk_[e] = p.in[I_RW_RK][l * 512 + ch + e];
    lnw[e] = p.in[I_RW_LNW][l * 512 + ch + e];
    lnb[e] = p.in[I_RW_LNB][l * 512 + ch + e];
  }
  const int rg = lane >> 3, kq = lane & 7, vrow = w * 16 + rg * 2;
  float S0[8], S1[8];
#pragma unroll
  for (int j = 0; j < 8; ++j) { S0[j] = 0.f; S1[j] = 0.f; }
  uint2 rc, kc, rp, kp, lwv, lav, vfv;
#define RW_LOAD(T0)                                                                                 \
  {                                                                                                 \
    const int s_ = (T0) + st;                                                                       \
    const bf16_t* zr = Z + (size_t)s_ * ZS + ZRW + ch;                                              \
    rc = *reinterpret_cast<const uint2*>(zr);                                                       \
    kc = *reinterpret_cast<const uint2*>(zr + 512);                                                 \
    rp = uint2{0u, 0u}; kp = uint2{0u, 0u};                                                         \
    if (s_ > 0) { rp = *reinterpret_cast<const uint2*>(zr - ZS); kp = *reinterpret_cast<const uint2*>(zr - ZS + 512); } \
    lwv = *reinterpret_cast<const uint2*>(LW + (size_t)s_ * 512 + ch);                              \
    lav = *reinterpret_cast<const uint2*>(LA + (size_t)s_ * 512 + ch);                              \
    vfv = *reinterpret_cast<const uint2*>(VF + (size_t)s_ * 512 + ch);                              \
  }
#define RW_PROCESS()                                                                                \
  {                                                                                                 \
    float r4[4], k4[4], kkv[4], av[4], wv[4], vv[4];                                                \
    float n2 = 0.f;                                                                                 \
    _Pragma("unroll") for (int e = 0; e < 4; ++e) {                                                 \
      unsigned rcw = (e < 2) ? rc.x : rc.y, kcw = (e < 2) ? kc.x : kc.y, rpw = (e < 2) ? rp.x : rp.y, kpw = (e < 2) ? kp.x : kp.y; \
      unsigned lww = (e < 2) ? lwv.x : lwv.y, law = (e < 2) ? lav.x : lav.y, vfw = (e < 2) ? vfv.x : vfv.y; \
      int sh = (e & 1) * 16;                                                                        \
      float rcur = bf2f((bf16_t)((rcw >> sh) & 0xffff)), rprev = bf2f((bf16_t)((rpw >> sh) & 0xffff)); \
      float kcur = bf2f((bf16_t)((kcw >> sh) & 0xffff)), kprev = bf2f((bf16_t)((kpw >> sh) & 0xffff)); \
      float lwf = bf2f((bf16_t)((lww >> sh) & 0xffff)), laf = bf2f((bf16_t)((law >> sh) & 0xffff)); \
      vv[e] = bf2f((bf16_t)((vfw >> sh) & 0xffff));                                                 \
      r4[e] = rcur + (rprev - rcur) * mur[e];                                                       \
      k4[e] = kcur + (kprev - kcur) * muk[e];                                                       \
      float wlog = -fsoftplus(-(w0[e] + lwf)) - 0.5f;                                               \
      wv[e] = __expf(-__expf(wlog));                                                                \
      av[e] = fsigmoid(a0[e] + laf);                                                                \
      kkv[e] = k4[e] * kk_[e];                                                                      \
      n2 += kkv[e] * kkv[e];                                                                        \
    }                                                                                               \
    n2 = sum16(n2);                                                                                 \
    float inv = 1.f / fmaxf(sqrtf(n2), 1e-12f);                                                     \
    float bon = 0.f;                                                                                \
    float kt4[4], ap4[4], bp4[4];                                                                   \
    _Pragma("unroll") for (int e = 0; e < 4; ++e) {                                                 \
      float kkn = kkv[e] * inv;                                                                     \
      kt4[e] = k4[e] * (1.f + (av[e] - 1.f) * ka_[e]);                                              \
      ap4[e] = -kkn;                                                                                \
      bp4[e] = kkn * av[e];                                                                         \
      bon += r4[e] * kt4[e] * rk_[e];                                                               \
    }                                                                                               \
    bon = sum16(bon);                                                                               \
    *reinterpret_cast<float4*>(sR + st * 64 + c4) = float4{r4[0], r4[1], r4[2], r4[3]};             \
    *reinterpret_cast<float4*>(sW + st * 64 + c4) = float4{wv[0], wv[1], wv[2], wv[3]};             \
    *reinterpret_cast<float4*>(sK + st * 64 + c4) = float4{kt4[0], kt4[1], kt4[2], kt4[3]};         \
    *reinterpret_cast<float4*>(sA + st * 64 + c4) = float4{ap4[0], ap4[1], ap4[2], ap4[3]};         \
    *reinterpret_cast<float4*>(sBb + st * 64 + c4) = float4{bp4[0], bp4[1], bp4[2], bp4[3]};        \
    *reinterpret_cast<float4*>(sV + st * 64 + c4) = float4{vv[0], vv[1], vv[2], vv[3]};             \
    if ((tid & 15) == 0) sBonus[st] = bon;                                                          \
  }
  RW_LOAD(0);
  RW_PROCESS();
  __syncthreads();
  constexpr int NCH = SEQ / 16;
#pragma unroll 1
  for (int c = 0; c < NCH; ++c) {
    const int t0 = c * 16;
    const int tn = (c + 1 < NCH) ? t0 + 16 : t0;
    RW_LOAD(tn);
    __builtin_amdgcn_sched_barrier(0);
#pragma unroll 2
    for (int t = 0; t < 16; ++t) {
      const float4* a4p = reinterpret_cast<const float4*>(sA + t * 64 + kq * 8);
      const float4* w4p = reinterpret_cast<const float4*>(sW + t * 64 + kq * 8);
      const float4* b4p = reinterpret_cast<const float4*>(sBb + t * 64 + kq * 8);
      const float4* k4p = reinterpret_cast<const float4*>(sK + t * 64 + kq * 8);
      const float4* r4p = reinterpret_cast<const float4*>(sR + t * 64 + kq * 8);
      const float2 vv = *reinterpret_cast<const float2*>(sV + t * 64 + vrow);
      float sa0 = 0.f, sa1 = 0.f;
#pragma unroll
      for (int q = 0; q < 2; ++q) {
        float4 a = a4p[q];
        sa0 = fmaf(S0[q * 4 + 0], a.x, sa0); sa1 = fmaf(S1[q * 4 + 0], a.x, sa1);
        sa0 = fmaf(S0[q * 4 + 1], a.y, sa0); sa1 = fmaf(S1[q * 4 + 1], a.y, sa1);
        sa0 = fmaf(S0[q * 4 + 2], a.z, sa0); sa1 = fmaf(S1[q * 4 + 2], a.z, sa1);
        sa0 = fmaf(S0[q * 4 + 3], a.w, sa0); sa1 = fmaf(S1[q * 4 + 3], a.w, sa1);
      }
      sa0 = oct_sum(sa0); sa1 = oct_sum(sa1);
      float y0 = 0.f, y1 = 0.f;
#pragma unroll
      for (int q = 0; q < 2; ++q) {
        float4 ww = w4p[q], bb = b4p[q], kk = k4p[q], rr = r4p[q];
        S0[q * 4 + 0] = fmaf(S0[q * 4 + 0], ww.x, fmaf(sa0, bb.x, vv.x * kk.x)); y0 = fmaf(S0[q * 4 + 0], rr.x, y0);
        S1[q * 4 + 0] = fmaf(S1[q * 4 + 0], ww.x, fmaf(sa1, bb.x, vv.y * kk.x)); y1 = fmaf(S1[q * 4 + 0], rr.x, y1);
        S0[q * 4 + 1] = fmaf(S0[q * 4 + 1], ww.y, fmaf(sa0, bb.y, vv.x * kk.y)); y0 = fmaf(S0[q * 4 + 1], rr.y, y0);
        S1[q * 4 + 1] = fmaf(S1[q * 4 + 1], ww.y, fmaf(sa1, bb.y, vv.y * kk.y)); y1 = fmaf(S1[q * 4 + 1], rr.y, y1);
        S0[q * 4 + 2] = fmaf(S0[q * 4 + 2], ww.z, fmaf(sa0, bb.z, vv.x * kk.z)); y0 = fmaf(S0[q * 4 + 2], rr.z, y0);
        S1[q * 4 + 2] = fmaf(S1[q * 4 + 2], ww.z, fmaf(sa1, bb.z, vv.y * kk.z)); y1 = fmaf(S1[q * 4 + 2], rr.z, y1);
        S0[q * 4 + 3] = fmaf(S0[q * 4 + 3], ww.w, fmaf(sa0, bb.w, vv.x * kk.w)); y0 = fmaf(S0[q * 4 + 3], rr.w, y0);
        S1[q * 4 + 3] = fmaf(S1[q * 4 + 3], ww.w, fmaf(sa1, bb.w, vv.y * kk.w)); y1 = fmaf(S1[q * 4 + 3], rr.w, y1);
      }
      y0 = oct_sum(y0); y1 = oct_sum(y1);
      if (kq == 0) *reinterpret_cast<float2*>(sY + t * 64 + vrow) = float2{y0, y1};
    }
    __builtin_amdgcn_sched_barrier(0);
    __syncthreads();
    {
      float4 y4 = *reinterpret_cast<const float4*>(sY + st * 64 + c4);
      float4 v4 = *reinterpret_cast<const float4*>(sV + st * 64 + c4);
      float bon = sBonus[st];
      float mean = sum16(y4.x + y4.y + y4.z + y4.w) * (1.f / 64.f);
      float dx = y4.x - mean, dy = y4.y - mean, dz = y4.z - mean, dw = y4.w - mean;
      float var = sum16(dx * dx + dy * dy + dz * dz + dw * dw) * (1.f / 64.f);
      float rs = rsqrtf(var + 64e-5f);
      float o0 = dx * rs * lnw[0] + lnb[0] + bon * v4.x;
      float o1 = dy * rs * lnw[1] + lnb[1] + bon * v4.y;
      float o2 = dz * rs * lnw[2] + lnb[2] + bon * v4.z;
      float o3 = dw * rs * lnw[3] + lnb[3] + bon * v4.w;
      uint2 o;
      o.x = pack2(o0, o1); o.y = pack2(o2, o3);
      *reinterpret_cast<uint2*>(Z + (size_t)(t0 + st) * ZS + ZRW + 1024 + ch) = o;
    }
    RW_PROCESS();
    __syncthreads();
  }
#undef RW_LOAD
#undef RW_PROCESS
}

__device__ void phase_scans(const Params& p, int l, char* smem, int scan_mask = 15) {
  for (int t = blockIdx.x; t < 256; t += gridDim.x) {
    int type = t & 3, idx = t >> 2;
    if (!((scan_mask >> type) & 1)) continue;
#ifndef SCM
#define SCM 15
#endif
    if (type == 0) { if (SCM & 1) rw_scan(p, l, idx, smem); }
    else if (type == 1) { if (SCM & 2) hg_scan(p, l, idx, smem); }
    else if (type == 2) { if (SCM & 4) mb_scan(p, l, idx, smem); }
    else { if (SCM & 8) s5_scan(p, l, idx, smem); }
    __syncthreads();
  }
  if (l == 0) {
    const int tid = opaque_tid();
    const int nb = (gridDim.x > 256) ? (int)gridDim.x - 256 : (int)gridDim.x;
    const int b0 = (gridDim.x > 256) ? (int)blockIdx.x - 256 : (int)blockIdx.x;
    constexpr int NREST = CT_TOTAL - (CT_IN - 1024);
    if (b0 >= 0)
      for (int c = b0; c < NREST + CT_TOTAL; c += nb) {
        if (c < NREST) convert_one(p, 0, (c < 1024) ? c : c + (CT_IN - 1024), smem, tid);
        else convert_one(p, 1, c - NREST, smem, tid);
      }
  }
}


__device__ void phase_post(const Params& p, int l, char* smem) {
  bf16_t* Z = (bf16_t*)(p.ws + OFF_Z);
  const int tid = opaque_tid(), lane = tid & 63, wid = tid >> 6;
  constexpr int N_ROWT = T_TOK / 4, N_RWT = T_TOK / 16, N_GLU = 128 * 4, N_NORM = T_TOK / 4;
  const float* xsrc = (l == 0) ? p.in[I_X] : p.out;
  for (int t = blockIdx.x; t < N_ROWT + N_RWT + N_GLU + N_NORM; t += gridDim.x) {
    if (t < N_ROWT) {
      const int row = t * 4 + wid;
      {
        bf16_t* op = Z + (size_t)row * ZS + ZHG + 1024 + lane * 8;
        uint4 ov = *reinterpret_cast<const uint4*>(op);
        uint4 gv = *reinterpret_cast<const uint4*>(op + 512);
        float o[8], g[8];
        unpack8(ov, o); unpack8(gv, g);
        float ss = 0.f;
#pragma unroll
        for (int e = 0; e < 8; ++e) ss += o[e] * o[e];
        ss = sum16(ss);
        float rstd = rsqrtf(ss * (1.f / 128.f) + 1e-6f);
        const float* nw = p.in[I_HG_NW] + l * 512 + lane * 8;
        float r[8];
#pragma unroll
        for (int e = 0; e < 8; ++e) r[e] = o[e] * rstd * nw[e] * siluf_(g[e]);
        *reinterpret_cast<uint4*>(op) = uint4{pack2(r[0], r[1]), pack2(r[2], r[3]), pack2(r[4], r[5]), pack2(r[6], r[7])};
      }
      {
        bf16_t* op = Z + (size_t)row * ZS + ZMB + lane * 8;
        uint4 ov = *reinterpret_cast<const uint4*>(op);
        float o[8];
        unpack8(ov, o);
        float ss = 0.f;
#pragma unroll
        for (int e = 0; e < 8; ++e) ss += o[e] * o[e];
        ss = sum64(ss);
        float rstd = rsqrtf(ss * (1.f / 512.f) + 1e-6f);
        const float* nw = p.in[I_MB_NW] + l * 512 + lane * 8;
        float r[8];
#pragma unroll
        for (int e = 0; e < 8; ++e) r[e] = o[e] * rstd * nw[e];
        *reinterpret_cast<uint4*>(op) = uint4{pack2(r[0], r[1]), pack2(r[2], r[3]), pack2(r[4], r[5]), pack2(r[6], r[7])};
      }
    } else if (t < N_ROWT + N_RWT) {
      const int row0 = (t - N_ROWT) * 16;
      char* sXg = smem;
      const float* mu = p.in[I_RW_MU] + l * 1792 + 1664;
      {
        const int tok = tid >> 4, j8 = (tid & 15) * 8;
        const int row = row0 + tok, sq = row & (SEQ - 1);
        const bf16_t* zp = Z + (size_t)row * ZS + ZRW + 1664 + j8;
        const uint4 cur = *reinterpret_cast<const uint4*>(zp);
        uint4 prev = uint4{0u, 0u, 0u, 0u};
        if (sq > 0) prev = *reinterpret_cast<const uint4*>(zp - ZS);
        float z[8];
        rw_shift8(cur, prev, mu + j8, z);
        *reinterpret_cast<uint4*>(sXg + tok * 272 + j8 * 2) =
            uint4{pack2(fsigmoid(z[0]), fsigmoid(z[1])), pack2(fsigmoid(z[2]), fsigmoid(z[3])),
                  pack2(fsigmoid(z[4]), fsigmoid(z[5])), pack2(fsigmoid(z[6]), fsigmoid(z[7]))};
      }
      __syncthreads();
      f32x4 acc[8];
      lora_mfma<128>(sXg, 272, (const bf16_t*)(p.ws + OFF_LORA + (size_t)l * LORA_STRIDE + LO_G2), acc, tid);
#pragma unroll
      for (int i = 0; i < 8; ++i) {
        bf16_t* yp = Z + (size_t)(row0 + (lane & 15)) * ZS + ZRW + 1024 + (wid * 8 + i) * 16 + (lane >> 4) * 4;
        const uint2 yr = *reinterpret_cast<const uint2*>(yp);
        uint2 o;
        o.x = pack2(bf2f((bf16_t)(yr.x & 0xffff)) * acc[i][0], bf2f((bf16_t)(yr.x >> 16)) * acc[i][1]);
        o.y = pack2(bf2f((bf16_t)(yr.y & 0xffff)) * acc[i][2], bf2f((bf16_t)(yr.y >> 16)) * acc[i][3]);
        *reinterpret_cast<uint2*>(yp) = o;
      }
      __syncthreads();
    } else if (t < N_ROWT + N_RWT + N_GLU) {
      const int tt = t - N_ROWT - N_RWT, mt = tt >> 2, nt = tt & 3;
      const int wm = wid >> 1, wn = wid & 1;
      f32x4 acc[4][4];
      zero_acc<128>(acc);
      gemm_mainloop<128>(acc, Z + ZS5, ZS, mt * 128, (const bf16_t*)(p.ws + WOFF(OFF_WTGLU, l)), 512, nt * 128, 511, 512, smem, tid);
      const float* bg = p.in[I_S5_BGLU] + l * 512;
#pragma unroll
      for (int mi = 0; mi < 4; ++mi)
#pragma unroll
        for (int ni = 0; ni < 4; ++ni) {
          int col = nt * 128 + wn * 64 + ni * 16 + (lane >> 4) * 4;
          int row = mt * 128 + wm * 64 + mi * 16 + (lane & 15);
          float4 b4 = *reinterpret_cast<const float4*>(bg + col);
          uint2 yv = *reinterpret_cast<const uint2*>(Z + (size_t)row * ZS + ZS5 + col);
          float y0 = bf2f((bf16_t)(yv.x & 0xffff)), y1 = bf2f((bf16_t)(yv.x >> 16));
          float y2 = bf2f((bf16_t)(yv.y & 0xffff)), y3 = bf2f((bf16_t)(yv.y >> 16));
          uint2 o;
          o.x = pack2(y0 * sigmoidf_(acc[mi][ni][0] + b4.x), y1 * sigmoidf_(acc[mi][ni][1] + b4.y));
          o.y = pack2(y2 * sigmoidf_(acc[mi][ni][2] + b4.z), y3 * sigmoidf_(acc[mi][ni][3] + b4.w));
          *reinterpret_cast<uint2*>(Z + (size_t)row * ZS + ZMB + 1024 + col) = o;
        }
    } else {
      const int row = (t - N_ROWT - N_RWT - N_GLU) * 4 + wid;
      rmsnorm_row_to_bf16(xsrc + (size_t)row * DM, p.in[I_NORM_MIX] + l * DM, (bf16_t*)(p.ws + OFF_U) + (size_t)row * DM, tid & 63);
    }
  }
}

__device__ void phase_merge(const Params& p, int l, char* smem) {
  bf16_t* Z = (bf16_t*)(p.ws + OFF_Z);
  const bf16_t* U = (const bf16_t*)(p.ws + OFF_U);
  const bf16_t* Wg = (const bf16_t*)(p.ws + WOFF_GATE(l));
  const bf16_t* Wb = (const bf16_t*)(p.ws + WOFF(OFF_WTBR, l));
  const int tid = opaque_tid();
  const int lane = tid & 63, wid = tid >> 6, wm = wid >> 1, wn = wid & 1;
  for (int t = blockIdx.x; t < tile_count(128, 8); t += gridDim.x) {
    int mt, nt;
    if (!tile_map(t, 8, mt, nt)) continue;
    f32x4 accm[4][4];
    zero_acc<128>(accm);
    f32x4 a1[4][4];
    zero_acc<128>(a1);
    uint2 sg[4][4];
#pragma unroll
    for (int mi = 0; mi < 4; ++mi)
#pragma unroll
      for (int ni = 0; ni < 4; ++ni) sg[mi][ni] = uint2{0u, 0u};
#pragma unroll 1
    for (int sub = 0; sub < 8; ++sub) {
      const int kb = sub >> 1, which = sub & 1;
      const int ycol = (kb == 0) ? (ZHG + 1024) : (kb == 1) ? (ZRW + 1024) : (kb == 2) ? (ZMB + 1024) : ZMB;
      const bf16_t* Ap = which ? (const bf16_t*)(Z + ycol) : U;
      const int ldap = which ? ZS : 1024;
      const bf16_t* Bp = which ? (Wb + (size_t)kb * 1024 * 512) : (Wg + (size_t)kb * 1024 * 1024);
      const int Kp = which ? 512 : 1024;
      gemm_mainloop_glds<128>(a1, Ap, ldap, mt * 128, Bp, Kp, nt * 128, 1023, Kp, smem, tid);
      if (which == 0) {
#pragma unroll
        for (int mi = 0; mi < 4; ++mi)
#pragma unroll
          for (int ni = 0; ni < 4; ++ni) {
            sg[mi][ni].x = pack2(fsigmoid(a1[mi][ni][0]), fsigmoid(a1[mi][ni][1]));
            sg[mi][ni].y = pack2(fsigmoid(a1[mi][ni][2]), fsigmoid(a1[mi][ni][3]));
            a1[mi][ni] = f32x4{0.f, 0.f, 0.f, 0.f};
          }
      } else {
#pragma unroll
        for (int mi = 0; mi < 4; ++mi)
#pragma unroll
          for (int ni = 0; ni < 4; ++ni) {
            accm[mi][ni][0] = fmaf(bf2f((bf16_t)(sg[mi][ni].x & 0xffff)), a1[mi][ni][0], accm[mi][ni][0]);
            accm[mi][ni][1] = fmaf(bf2f((bf16_t)(sg[mi][ni].x >> 16)), a1[mi][ni][1], accm[mi][ni][1]);
            accm[mi][ni][2] = fmaf(bf2f((bf16_t)(sg[mi][ni].y & 0xffff)), a1[mi][ni][2], accm[mi][ni][2]);
            accm[mi][ni][3] = fmaf(bf2f((bf16_t)(sg[mi][ni].y >> 16)), a1[mi][ni][3], accm[mi][ni][3]);
            a1[mi][ni] = f32x4{0.f, 0.f, 0.f, 0.f};
          }
      }
    }
#pragma unroll
    for (int mi = 0; mi < 4; ++mi)
#pragma unroll
      for (int np = 0; np < 2; ++np) {
        const int colb = nt * 128 + wn * 64 + np * 32;
        const int row = mt * 128 + wm * 64 + mi * 16 + (lane & 15);
        uint2 a, b;
        a.x = pack2(accm[mi][2 * np][0], accm[mi][2 * np][1]);
        a.y = pack2(accm[mi][2 * np][2], accm[mi][2 * np][3]);
        b.x = pack2(accm[mi][2 * np + 1][0], accm[mi][2 * np + 1][1]);
        b.y = pack2(accm[mi][2 * np + 1][2], accm[mi][2 * np + 1][3]);
        store_pair_bf16(Z + (size_t)row * ZS + colb, lane, a, b);
      }
  }
}

__device__ void phase_resid_gemm(const Params& p, const bf16_t* A, int lda, const bf16_t* Wt, int K, const float* xold, char* smem) {
  const int tid = opaque_tid();
  const int lane = tid & 63, wid = tid >> 6, wm = wid >> 1, wn = wid & 1;
  for (int t = blockIdx.x; t < tile_count(64, 8); t += gridDim.x) {
    int mt, nt;
    if (!tile_map(t, 8, mt, nt)) continue;
    f32x4 acc[8][4];
    zero_acc_big(acc);
    gemm_mainloop_big(acc, A, lda, mt * 256, Wt, K, nt * 128, 1023, K, smem, tid);
#pragma unroll
    for (int mi = 0; mi < 8; ++mi)
#pragma unroll
      for (int ni = 0; ni < 4; ++ni) {
        int col = nt * 128 + wn * 64 + ni * 16 + (lane >> 4) * 4;
        int row = mt * 256 + wm * 128 + mi * 16 + (lane & 15);
        size_t o = (size_t)row * DM + col;
        float4 xo = *reinterpret_cast<const float4*>(xold + o);
        float4 r = float4{xo.x + acc[mi][ni][0], xo.y + acc[mi][ni][1], xo.z + acc[mi][ni][2], xo.w + acc[mi][ni][3]};
        *reinterpret_cast<float4*>(p.out + o) = r;
      }
  }
}

__device__ void phase_ffn_in(const Params& p, int l, char* smem) {
  const bf16_t* U = (const bf16_t*)(p.ws + OFF_U);
  const bf16_t* Wt = (const bf16_t*)(p.ws + WOFF(OFF_WTF1, l));
  bf16_t* H = (bf16_t*)(p.ws + OFF_Z);
  const int tid = opaque_tid();
  const int lane = tid & 63, wid = tid >> 6, wm = wid >> 1, wn = wid & 1;
  for (int t = blockIdx.x; t < tile_count(64, 40); t += gridDim.x) {
    int mt, nt;
    if (!tile_map(t, 40, mt, nt)) continue;
    f32x4 acc[8][4];
    zero_acc_big(acc);
    gemm_mainloop_big(acc, U, 1024, mt * 256, Wt, 1024, nt * 128, 5631, 1024, smem, tid);
#pragma unroll
    for (int mi = 0; mi < 8; ++mi) {
      const int hcolb = (nt * 128 + wn * 64) >> 1;
      const int row = mt * 256 + wm * 128 + mi * 16 + (lane & 15);
      uint2 o0, o1;
      o0.x = pack2(fsilu(acc[mi][0][0]) * acc[mi][1][0], fsilu(acc[mi][0][1]) * acc[mi][1][1]);
      o0.y = pack2(fsilu(acc[mi][0][2]) * acc[mi][1][2], fsilu(acc[mi][0][3]) * acc[mi][1][3]);
      o1.x = pack2(fsilu(acc[mi][2][0]) * acc[mi][3][0], fsilu(acc[mi][2][1]) * acc[mi][3][1]);
      o1.y = pack2(fsilu(acc[mi][2][2]) * acc[mi][3][2], fsilu(acc[mi][2][3]) * acc[mi][3][3]);
      store_pair_bf16(H + (size_t)row * FFH + hcolb, lane, o0, o1);
    }
  }
  for (int t2 = blockIdx.x; t2 < 512; t2 += gridDim.x) {
    const int nt = 40 + (t2 & 3), mt = t2 >> 2;
    f32x4 acc[4][4];
    zero_acc<128>(acc);
    gemm_mainloop_glds<128>(acc, U, 1024, mt * 128, Wt, 1024, nt * 128, 5631, 1024, smem, tid);
#pragma unroll
    for (int mi = 0; mi < 4; ++mi) {
      const int hcolb = (nt * 128 + wn * 64) >> 1;
      const int row = mt * 128 + wm * 64 + mi * 16 + (lane & 15);
      uint2 o0, o1;
      o0.x = pack2(fsilu(acc[mi][0][0]) * acc[mi][1][0], fsilu(acc[mi][0][1]) * acc[mi][1][1]);
      o0.y = pack2(fsilu(acc[mi][0][2]) * acc[mi][1][2], fsilu(acc[mi][0][3]) * acc[mi][1][3]);
      o1.x = pack2(fsilu(acc[mi][2][0]) * acc[mi][3][0], fsilu(acc[mi][2][1]) * acc[mi][3][1]);
      o1.y = pack2(fsilu(acc[mi][2][2]) * acc[mi][3][2], fsilu(acc[mi][2][3]) * acc[mi][3][3]);
      store_pair_bf16(H + (size_t)row * FFH + hcolb, lane, o0, o1);
    }
  }
}

__device__ void phase_final(const Params& p) {
  const int tid = opaque_tid();
  const int lane = tid & 63;
  const float* w = p.in[I_NORM_FINAL];
  for (int t = blockIdx.x; t < T_TOK / 4; t += gridDim.x) {
    int row = t * 4 + (tid >> 6);
    float* x = p.out + (size_t)row * DM;
    float4 v[4];
    float ss = 0.f;
#pragma unroll
    for (int i = 0; i < 4; ++i) {
      v[i] = *reinterpret_cast<const float4*>(x + i * 256 + lane * 4);
      ss += v[i].x * v[i].x + v[i].y * v[i].y + v[i].z * v[i].z + v[i].w * v[i].w;
    }
    ss = sum64(ss);
    float rstd = rsqrtf(ss * (1.f / 1024.f) + 1e-6f);
#pragma unroll
    for (int i = 0; i < 4; ++i) {
      float4 ww = *reinterpret_cast<const float4*>(w + i * 256 + lane * 4);
      float4 o = float4{v[i].x * rstd * ww.x, v[i].y * rstd * ww.y, v[i].z * rstd * ww.z, v[i].w * rstd * ww.w};
      *reinterpret_cast<float4*>(x + i * 256 + lane * 4) = o;
    }
  }
}

template <int SUB>
__device__ __forceinline__ void run_phase(const Params& p, int l, char* smem) {
  if (SUB == 0) phase_convert_norm(p, l, smem);
  else if (SUB == 1) phase_inproj(p, smem);
  else if (SUB == 2) phase_rwprep(p, l, smem);
  else if (SUB == 3) phase_scans(p, l, smem);
  else if (SUB == 4) phase_post(p, l, smem);
  else if (SUB == 5) phase_merge(p, l, smem);
  else if (SUB == 6) phase_resid_gemm(p, (const bf16_t*)(p.ws + OFF_Z), ZS, (const bf16_t*)(p.ws + WOFF(OFF_WTOUT, l)), 1024,
                                      (l == 0) ? p.in[I_X] : p.out, smem);
  else if (SUB == 7) phase_norm_only(p, p.out, p.in[I_NORM_FFN] + l * DM);
  else if (SUB == 8) phase_ffn_in(p, l, smem);
  else if (SUB == 9) phase_resid_gemm(p, (const bf16_t*)(p.ws + OFF_Z), FFH, (const bf16_t*)(p.ws + WOFF(OFF_WTF2, l)), FFH, p.out, smem);
  else phase_final(p);
}

#ifndef PHM
#define PHM 0xFFFF
#endif
#define XB_TMO      128
#define XB_XCNT(j)  (256  + 64 * (j))
#define XB_XSUB(j)  (1280 + 64 * (j))
#define XB_XGEN(j)  (2304 + 64 * (j))
#define XB_TOP      3328
#define XB_TOPGEN   3392
#define XCD_BAR_WORDS 3456
#define XB_SPIN_CAP (1u << 18)
#define LAS __attribute__((address_space(3)))

__device__ __forceinline__ unsigned xb_ld(unsigned* p)              { return __hip_atomic_load(p, __ATOMIC_RELAXED, __HIP_MEMORY_SCOPE_AGENT); }
__device__ __forceinline__ unsigned xb_add(unsigned* p, unsigned v) { return __hip_atomic_fetch_add(p, v, __ATOMIC_RELAXED, __HIP_MEMORY_SCOPE_AGENT); }
__device__ __forceinline__ unsigned xb_xcc_id() { return (unsigned)__builtin_amdgcn_s_getreg((3 << 11) | 20) & 0xFu; }
#define XB_SPIN(cond, bar) do { unsigned _sp = 0; while (cond) { __builtin_amdgcn_s_sleep(1); \
    if ((++_sp & 255u) == 0u) { if (xb_ld(&(bar)[XB_TMO])) break; if (_sp > XB_SPIN_CAP) { atomicAdd(&(bar)[XB_TMO], 1u); break; } } } } while (0)

struct XcdBarrier {
    unsigned* bar; unsigned x;
    volatile LAS unsigned* st;
};

__device__ __forceinline__ XcdBarrier xcd_barrier_post(unsigned* bar, volatile LAS unsigned* st) {
    XcdBarrier b; b.bar = bar; b.x = xb_xcc_id(); b.st = st;
    if (threadIdx.x == 0) (void)xb_add(&bar[XB_XCNT(b.x)], 1u);
    return b;
}
__device__ __forceinline__ void xcd_barrier_complete(unsigned* bar, unsigned x, unsigned& nloc, unsigned& nx) {
    const unsigned G = gridDim.x * gridDim.y * gridDim.z;
    unsigned sum, cnt, mine, sp = 0u;
    for (;;) {
        sum = 0u; cnt = 0u; mine = 0u;
#pragma unroll
        for (unsigned j = 0; j < 16; ++j) { const unsigned c = xb_ld(&bar[XB_XCNT(j)]); sum += c; cnt += (c > 0u) ? 1u : 0u; mine = (j == x) ? c : mine; }
        if (sum == G) break;
        __builtin_amdgcn_s_sleep(1);
        if ((++sp & 255u) == 0u) { if (xb_ld(&bar[XB_TMO])) break; if (sp > XB_SPIN_CAP) { atomicAdd(&bar[XB_TMO], 1u); break; } }
    }
    nloc = mine > 0u ? mine : 1u; nx = cnt > 0u ? cnt : 1u;
}

__device__ __forceinline__ void xcd_barrier(const XcdBarrier& b) {
    asm volatile("s_waitcnt vmcnt(0)" ::: "memory");
    __syncthreads();
    if (threadIdx.x == 0) {
        unsigned* bar = b.bar;
        __builtin_amdgcn_s_waitcnt(0);
        unsigned nloc = b.st[0], nx = b.st[1];
        if (nloc == 0u) { xcd_barrier_complete(bar, b.x, nloc, nx); b.st[0] = nloc; b.st[1] = nx; }
        const unsigned old = xb_add(&bar[XB_XSUB(b.x)], 1u);
        const unsigned gen = old / nloc;
        if (old + 1u == (gen + 1u) * nloc) {
            __builtin_amdgcn_fence(__ATOMIC_RELEASE, "agent");
            asm volatile("s_waitcnt vmcnt(0)" ::: "memory");
            const unsigned og = xb_add(&bar[XB_TOP], 1u);
            const unsigned tg = og / nx;
            if (og + 1u == (tg + 1u) * nx) xb_add(&bar[XB_TOPGEN], 1u);
            else XB_SPIN(xb_ld(&bar[XB_TOPGEN]) == tg, bar);
            __builtin_amdgcn_fence(__ATOMIC_ACQUIRE, "agent");
            xb_add(&bar[XB_XGEN(b.x)], 1u);
            asm volatile("s_waitcnt vmcnt(0)" ::: "memory");
        } else {
            XB_SPIN(xb_ld(&bar[XB_XGEN(b.x)]) == gen, bar);
            __builtin_amdgcn_fence(__ATOMIC_ACQUIRE, "agent");
            asm volatile("s_waitcnt vmcnt(0)" ::: "memory");
        }
    }
    __syncthreads();
}


constexpr int LDS_MAIN = 73728;
constexpr int LDS_BYTES = LDS_MAIN + 16;

#if COOP
__global__ void __launch_bounds__(256, 2) fwd_kernel(Params p, int ph0, int ph1, int scan_mask) {
  extern __shared__ __attribute__((aligned(16))) char smem[];
  cg::grid_group grid = cg::this_grid();
  volatile LAS unsigned* xb_st = (volatile LAS unsigned*)(smem + LDS_MAIN);
  if (threadIdx.x == 0) { xb_st[0] = 0u; xb_st[1] = 0u; xb_st[2] = 0u; xb_st[3] = 0u; }
  __syncthreads();
  XcdBarrier xbar = xcd_barrier_post(reinterpret_cast<unsigned*>(p.ws + OFF_BAR), xb_st);
  for (int ph = ph0; ph < ph1; ++ph) {
    if (ph == NPHASES - 1) {
      phase_final(p);
    } else {
      const int l = ph / NPH_LAYER, sub = ph % NPH_LAYER;
      switch (sub) {
        case 0: if (PHM & (1<<0)) run_phase<0>(p, l, smem); break;
        case 1: if (PHM & (1<<1)) run_phase<1>(p, l, smem); break;
        case 2: if (PHM & (1<<2)) run_phase<2>(p, l, smem); break;
        case 3: if (PHM & (1<<3)) phase_scans(p, l, smem, scan_mask); break;
        case 4: if (PHM & (1<<4)) run_phase<4>(p, l, smem); break;
        case 5: if (PHM & (1<<5)) run_phase<5>(p, l, smem); break;
        case 6: if (PHM & (1<<6)) run_phase<6>(p, l, smem); break;
        case 7: if (PHM & (1<<7)) run_phase<7>(p, l, smem); break;
        case 8: if (PHM & (1<<8)) run_phase<8>(p, l, smem); break;
        case 9: if (PHM & (1<<9)) run_phase<9>(p, l, smem); break;
      }
    }
    if (ph + 1 < ph1) {
      if (ph1 > 1000) grid.sync();
      else xcd_barrier(xbar);
    }
  }
}
#else
template <int SUB>
__global__ void __launch_bounds__(256, 2) k_phase(Params p, int l) {
  __shared__ __attribute__((aligned(16))) char smem[65536];
  run_phase<SUB>(p, l, smem);
}
#endif

extern "C" void kernel_launch(void* const* d_in, const int* in_sizes, int n_in, void* d_out, int out_size, void* d_ws,
                              size_t ws_size, hipStream_t stream) {
  if (n_in < 41 || ws_size < WS_NEED) {
    fprintf(stderr, "kernel_launch: bad args n_in=%d ws=%zu need=%zu\n", n_in, ws_size, (size_t)WS_NEED);
    return;
  }
  Params p{};
  for (int i = 0; i < 41; ++i) p.in[i] = (const float*)d_in[i];
  p.out = (float*)d_out;
  p.ws = (char*)d_ws;
#if COOP
  static int grid_blocks = 0;
  if (!grid_blocks) {
    int dev = 0, cus = 0, per_cu = 0;
    hipGetDevice(&dev);
    hipDeviceGetAttribute(&cus, hipDeviceAttributeMultiprocessorCount, dev);
    hipFuncSetAttribute((const void*)fwd_kernel, hipFuncAttributeMaxDynamicSharedMemorySize, LDS_BYTES);
    hipOccupancyMaxActiveBlocksPerMultiprocessor(&per_cu, fwd_kernel, 256, LDS_BYTES);
    if (per_cu > 2) per_cu = 2;
    grid_blocks = cus * per_cu;
  }
#ifdef HYBRID
  for (int ph = 0; ph < NPHASES; ++ph) {
    if (ph % 10 == 3 && ph < 20) {
      const int groups[4] = SCAN_GROUPS;
      for (int gi = 0; gi < 4; ++gi) if (groups[gi]) fwd_kernel<<<grid_blocks, 256, LDS_BYTES, stream>>>(p, ph, ph + 1, groups[gi]);
    } else {
      fwd_kernel<<<grid_blocks, 256, LDS_BYTES, stream>>>(p, ph, ph + 1, 15);
    }
  }
#else
  hipMemsetAsync((char*)d_ws + OFF_BAR, 0, XCD_BAR_WORDS * 4, stream);
  int ph0 = 0, ph1 = NPHASES, smask = 15;
  void* args[] = {&p, &ph0, &ph1, &smask};
  hipError_t e = hipLaunchCooperativeKernel((void*)fwd_kernel, dim3(grid_blocks), dim3(256), args, LDS_BYTES, stream);
  if (e != hipSuccess) fprintf(stderr, "cooperative launch failed: %s (grid %d)\n", hipGetErrorString(e), grid_blocks);
#endif
#else
  const dim3 g(512), b(256);
  for (int l = 0; l < 2; ++l) {
    k_phase<0><<<g, b, 0, stream>>>(p, l);
    k_phase<1><<<g, b, 0, stream>>>(p, l);
    k_phase<2><<<g, b, 0, stream>>>(p, l);
    k_phase<3><<<g, b, 0, stream>>>(p, l);
    k_phase<4><<<g, b, 0, stream>>>(p, l);
    k_phase<5><<<g, b, 0, stream>>>(p, l);
    k_phase<6><<<g, b, 0, stream>>>(p, l);
    k_phase<7><<<g, b, 0, stream>>>(p, l);
    k_phase<8><<<g, b, 0, stream>>>(p, l);
    k_phase<9><<<g, b, 0, stream>>>(p, l);
  }
  k_phase<10><<<g, b, 0, stream>>>(p, 0);
#endif
}
```

```cpp
#include <hip/hip_runtime.h>
#include <hip/hip_cooperative_groups.h>
#include <cstdio>
#include <cstdint>
namespace cg = cooperative_groups;

#ifndef COOP
#define COOP 1
#endif

#define LAS __attribute__((address_space(3)))
typedef unsigned short bf16_t;
typedef __attribute__((ext_vector_type(8))) short bf16x8;
typedef __attribute__((ext_vector_type(4))) float f32x4;
typedef __attribute__((ext_vector_type(4))) unsigned u32x4;

constexpr int T_TOK = 16384, SEQ = 2048, DM = 1024;
constexpr int IN_COLS = 9992, NZ = 5896, ZS = 5904;
constexpr int ZHG = 0, ZRW = 2048, ZS5 = 3840, ZMB = 4352;
constexpr int FFH = 2816;
constexpr int NPH_LAYER = 10, NPHASES = 21;

constexpr size_t OFF_WTIN   = 0;
constexpr size_t OFF_WTGATE = OFF_WTIN + (size_t)5896 * 1024 * 2;
constexpr size_t OFF_WTBR   = OFF_WTGATE + (size_t)4096 * 1024 * 2;
constexpr size_t OFF_WTOUT  = OFF_WTBR + (size_t)4 * 1024 * 512 * 2;
constexpr size_t OFF_WTF1   = OFF_WTOUT + (size_t)1024 * 1024 * 2;
constexpr size_t OFF_WTF2   = OFF_WTF1 + (size_t)5632 * 1024 * 2;
constexpr size_t OFF_WTGLU  = OFF_WTF2 + (size_t)1024 * 2816 * 2;
constexpr size_t OFF_U      = OFF_WTGLU + (size_t)512 * 512 * 2;
constexpr size_t OFF_Z      = OFF_U + (size_t)T_TOK * 1024 * 2;
constexpr size_t OFF_VF     = OFF_Z + (size_t)T_TOK * ZS * 2;
constexpr size_t OFF_BAR    = OFF_VF + (size_t)T_TOK * 512 * 2;
constexpr size_t OFF_WTGATE_B = OFF_BAR + 16384;
constexpr size_t OFF_WB_B     = OFF_WTGATE_B + (size_t)4096 * 1024 * 2;
constexpr size_t OFF_LORA     = OFF_WB_B + (OFF_U - OFF_WTBR);
constexpr size_t LORA_STRIDE  = 524288;
constexpr size_t LO_G2 = 0, LO_W2 = 131072, LO_A2 = 196608, LO_V1 = 262144, LO_V2 = 294912;
constexpr size_t WS_NEED      = OFF_LORA + 2 * LORA_STRIDE;
constexpr size_t DELTA_GATE   = OFF_WTGATE_B - OFF_WTGATE;
constexpr size_t DELTA_WB     = OFF_WB_B - OFF_WTBR;
#define WOFF_GATE(l) (OFF_WTGATE + (size_t)(l) * DELTA_GATE)
#define WOFF(off, l) ((off) + (size_t)(l) * DELTA_WB)

struct Params {
  const float* in[41];
  float* out;
  char* ws;
};

enum { I_X = 0, I_NORM_MIX, I_W_IN, I_W_BRANCH, I_W_OUT, I_NORM_FFN, I_W_FFN_IN, I_W_FFN_OUT, I_NORM_FINAL,
       I_HG_LB, I_HG_NW, I_RW_MU, I_RW_W0, I_RW_W2, I_RW_A0, I_RW_A2, I_RW_G2, I_RW_KK, I_RW_KA, I_RW_RK,
       I_RW_LNW, I_RW_LNB, I_RW_V0, I_RW_V1, I_RW_V2, I_S5_ARE, I_S5_AIM, I_S5_BRE, I_S5_BIM, I_S5_CRE,
       I_S5_CIM, I_S5_D, I_S5_LOGDT, I_S5_WGLU, I_S5_BGLU, I_MB_CONVW, I_MB_CONVB, I_MB_DTB, I_MB_ALOG,
       I_MB_D, I_MB_NW };

__device__ __forceinline__ float bf2f(bf16_t v) { return __uint_as_float(((unsigned)v) << 16); }
typedef __attribute__((ext_vector_type(2))) __bf16 bf16x2_t;
__device__ __forceinline__ unsigned pack2(float a, float b) {
  bf16x2_t v;
  v[0] = (__bf16)a;
  v[1] = (__bf16)b;
  return __builtin_bit_cast(unsigned, v);
}
__device__ __forceinline__ bf16_t f2bf(float f) { return (bf16_t)(pack2(f, 0.f) & 0xffffu); }
__device__ __forceinline__ void store_pair_bf16(bf16_t* p_sub0, const int lane, uint2 a, uint2 b, const bool ok = true) {
  auto rx = __builtin_amdgcn_permlane16_swap(a.x, b.x, false, false);
  auto ry = __builtin_amdgcn_permlane16_swap(a.y, b.y, false, false);
  const int off = ((lane >> 4) & 1) * 16 + (lane >> 5) * 8;
  if (ok) *reinterpret_cast<uint4*>(p_sub0 + off) = uint4{(unsigned)rx[0], (unsigned)ry[0], (unsigned)rx[1], (unsigned)ry[1]};
}
__device__ __forceinline__ float sigmoidf_(float x) { return 1.f / (1.f + __expf(-x)); }
__device__ __forceinline__ float siluf_(float x) { return x / (1.f + __expf(-x)); }
__device__ __forceinline__ float softplusf_(float x) { return x > 20.f ? x : log1pf(__expf(x)); }
__device__ __forceinline__ float gelu_tanh(float x) {
  float u = 0.7978845608028654f * (x + 0.044715f * x * x * x);
  return 0.5f * x * (1.f + tanhf(u));
}
__device__ __forceinline__ float frcp(float x) { return __builtin_amdgcn_rcpf(x); }
__device__ __forceinline__ float fsigmoid(float x) { return frcp(1.f + __expf(-x)); }
__device__ __forceinline__ float fsilu(float x) { return x * frcp(1.f + __expf(-x)); }
__device__ __forceinline__ float fsoftplus(float x) { return x > 20.f ? x : __logf(1.f + __expf(x)); }
__device__ __forceinline__ float ftanh(float x) {
  float e = __expf(2.f * fminf(fmaxf(x, -15.f), 15.f));
  return (e - 1.f) * frcp(e + 1.f);
}
__device__ __forceinline__ float fgelu(float x) {
  float u = 0.7978845608028654f * (x + 0.044715f * x * x * x);
  return 0.5f * x * (1.f + ftanh(u));
}

__device__ __forceinline__ float quad_sum(float x) {
  x += __builtin_bit_cast(float, __builtin_amdgcn_update_dpp(0, __builtin_bit_cast(int, x), 0xB1, 0xF, 0xF, true));
  x += __builtin_bit_cast(float, __builtin_amdgcn_update_dpp(0, __builtin_bit_cast(int, x), 0x4E, 0xF, 0xF, true));
  return x;
}
__device__ __forceinline__ float oct_sum(float x) {
  x = quad_sum(x);
  x += __builtin_bit_cast(float, __builtin_amdgcn_update_dpp(0, __builtin_bit_cast(int, x), 0x141, 0xF, 0xF, true));
  return x;
}
__device__ __forceinline__ float sum16(float x) {
  x = oct_sum(x);
  x += __builtin_bit_cast(float, __builtin_amdgcn_update_dpp(0, __builtin_bit_cast(int, x), 0x140, 0xF, 0xF, true));
  return x;
}
__device__ __forceinline__ float sum64(float x) {
  x = sum16(x); x += __shfl_xor(x, 16); x += __shfl_xor(x, 32);
  return x;
}

__device__ __forceinline__ int opaque_tid() {
  int t = threadIdx.x;
  asm volatile("" : "+v"(t));
  return t;
}

template <int BN>
__device__ __forceinline__ void gemm_mainloop(f32x4 (&acc)[4][BN / 32], const bf16_t* A, int lda, int m0,
                                              const bf16_t* Bt, int ldb, int n0, int nmax, int K, char* smem, const int tid) {
  const int lane = tid & 63, wid = tid >> 6, wm = wid >> 1, wn = wid & 1;
  const int q = tid & 7, r0 = tid >> 3;
  unsigned offA[4], offB[BN / 32];
#pragma unroll
  for (int i = 0; i < 4; ++i) offA[i] = ((unsigned)(m0 + r0 + 32 * i) * (unsigned)lda + (unsigned)q * 8u) * 2u;
#pragma unroll
  for (int i = 0; i < BN / 32; ++i) {
    int row = n0 + r0 + 32 * i;
    row = row < nmax ? row : nmax;
    offB[i] = ((unsigned)row * (unsigned)ldb + (unsigned)q * 8u) * 2u;
  }
  const unsigned sto = (unsigned)r0 * 128u + (unsigned)((q ^ ((r0 >> 1) & 7)) << 4);
  unsigned aoff[4], boff[BN / 32];
#pragma unroll
  for (int mi = 0; mi < 4; ++mi) {
    int row = wm * 64 + mi * 16 + (lane & 15);
    aoff[mi] = (unsigned)row * 128u + (unsigned)(((lane >> 4) ^ ((row >> 1) & 7)) << 4);
  }
#pragma unroll
  for (int ni = 0; ni < BN / 32; ++ni) {
    int row = wn * (BN / 2) + ni * 16 + (lane & 15);
    boff[ni] = (unsigned)row * 128u + (unsigned)(((lane >> 4) ^ ((row >> 1) & 7)) << 4);
  }
  const char* Ab = reinterpret_cast<const char*>(A);
  const char* Bb = reinterpret_cast<const char*>(Bt);
  const int nk = K >> 6;
  constexpr bool WIDE = (BN == 128);
  u32x4 Ra0, Ra1, Ra2, Ra3, Rb0, Rb1, Rb2, Rb3;
  u32x4 Qa0, Qa1, Qa2, Qa3, Qb0, Qb1, Qb2, Qb3;
#define GLOAD(P, TILE)                                                         \
  {                                                                            \
    const char* Ak_ = Ab + (size_t)(TILE) * 128;                               \
    const char* Bk_ = Bb + (size_t)(TILE) * 128;                               \
    P##a0 = *reinterpret_cast<const u32x4*>(Ak_ + offA[0]);                    \
    P##a1 = *reinterpret_cast<const u32x4*>(Ak_ + offA[1]);                    \
    P##a2 = *reinterpret_cast<const u32x4*>(Ak_ + offA[2]);                    \
    P##a3 = *reinterpret_cast<const u32x4*>(Ak_ + offA[3]);                    \
    P##b0 = *reinterpret_cast<const u32x4*>(Bk_ + offB[0]);                    \
    P##b1 = *reinterpret_cast<const u32x4*>(Bk_ + offB[1]);                    \
    if (WIDE) {                                                                \
      P##b2 = *reinterpret_cast<const u32x4*>(Bk_ + offB[BN / 32 - 2]);        \
      P##b3 = *reinterpret_cast<const u32x4*>(Bk_ + offB[BN / 32 - 1]);        \
    }                                                                          \
  }
#define SSTORE(P, BUF)                                                         \
  {                                                                            \
    char* ad_ = smem + (BUF) * 16384 + sto;                                    \
    char* bd_ = smem + 32768 + (BUF) * (BN * 128) + sto;                       \
    *reinterpret_cast<u32x4*>(ad_) = P##a0;                                    \
    *reinterpret_cast<u32x4*>(ad_ + 4096) = P##a1;                             \
    *reinterpret_cast<u32x4*>(ad_ + 8192) = P##a2;                             \
    *reinterpret_cast<u32x4*>(ad_ + 12288) = P##a3;                            \
    *reinterpret_cast<u32x4*>(bd_) = P##b0;                                    \
    *reinterpret_cast<u32x4*>(bd_ + 4096) = P##b1;                             \
    if (WIDE) {                                                                \
      *reinterpret_cast<u32x4*>(bd_ + 8192) = P##b2;                           \
      *reinterpret_cast<u32x4*>(bd_ + 12288) = P##b3;                          \
    }                                                                          \
  }
#define COMPUTE(BUF)                                                           \
  {                                                                            \
    const char* a_s = smem + (BUF) * 16384;                                    \
    const char* b_s = smem + 32768 + (BUF) * (BN * 128);                       \
    _Pragma("unroll") for (int ks = 0; ks < 2; ++ks) {                         \
      bf16x8 af[4], bfr[BN / 32];                                              \
      _Pragma("unroll") for (int mi = 0; mi < 4; ++mi)                         \
          af[mi] = *reinterpret_cast<const bf16x8*>(a_s + (aoff[mi] ^ (ks * 64)));       \
      _Pragma("unroll") for (int ni = 0; ni < BN / 32; ++ni)                   \
          bfr[ni] = *reinterpret_cast<const bf16x8*>(b_s + (boff[ni] ^ (ks * 64)));      \
      _Pragma("unroll") for (int mi = 0; mi < 4; ++mi)                         \
        _Pragma("unroll") for (int ni = 0; ni < BN / 32; ++ni)                 \
          acc[mi][ni] = __builtin_amdgcn_mfma_f32_16x16x32_bf16(bfr[ni], af[mi], acc[mi][ni], 0, 0, 0); \
    }                                                                          \
  }
  if constexpr (WIDE && false) {
    GLOAD(R, 0);
    SSTORE(R, 0);
    GLOAD(R, 1);
    if (nk > 2) GLOAD(Q, 2);
    __syncthreads();
#pragma unroll 1
    for (int kt = 0; kt < nk; kt += 2) {
      __builtin_amdgcn_sched_barrier(0);
      COMPUTE(0);
      __builtin_amdgcn_sched_barrier(0);
      SSTORE(R, 1);
      if (kt + 3 < nk) GLOAD(R, kt + 3);
      __syncthreads();
      __builtin_amdgcn_sched_barrier(0);
      COMPUTE(1);
      __builtin_amdgcn_sched_barrier(0);
      if (kt + 2 < nk) SSTORE(Q, 0);
      if (kt + 4 < nk) GLOAD(Q, kt + 4);
      __syncthreads();
    }
  } else {
    GLOAD(R, 0);
    SSTORE(R, 0);
    __syncthreads();
#pragma unroll 1
    for (int kt = 0; kt < nk; ++kt) {
      const int buf = kt & 1;
      const bool more = (kt + 1 < nk);
      if (more) GLOAD(R, kt + 1);
      __builtin_amdgcn_sched_barrier(0);
      COMPUTE(buf);
      __builtin_amdgcn_sched_barrier(0);
      if (more) SSTORE(R, buf ^ 1);
      __syncthreads();
    }
  }
#undef GLOAD
#undef SSTORE
#undef COMPUTE
}

template <int BN>
__device__ __forceinline__ void zero_acc(f32x4 (&acc)[4][BN / 32]) {
#pragma unroll
  for (int mi = 0; mi < 4; ++mi)
#pragma unroll
    for (int ni = 0; ni < BN / 32; ++ni) acc[mi][ni] = f32x4{0.f, 0.f, 0.f, 0.f};
}

#define RAW_BARRIER() do { asm volatile("s_waitcnt lgkmcnt(0)" ::: "memory"); __builtin_amdgcn_s_barrier(); } while (0)
template <int MROWS>
__device__ __forceinline__ void gemm_mainloop_glds(f32x4 (&acc)[MROWS / 32][4], const bf16_t* A, int lda, int m0, const bf16_t* Bt,
                                                   int ldb, int n0, int nmax, int K, char* smem, const int tid) {
  constexpr int NA = MROWS / 64;
  constexpr int NMI = MROWS / 32;
  constexpr int STAGE = (MROWS + 128) * 64;
  constexpr int BOFF = MROWS * 64;
  const int lane = tid & 63, wid = tid >> 6, wm = wid >> 1, wn = wid & 1;
  unsigned gA[NA], gB[2];
#pragma unroll
  for (int i = 0; i < NA; ++i) {
    const int row = (wid * NA + i) * 16 + (lane >> 2);
    const int q = (lane & 3) ^ ((row >> 2) & 3);
    gA[i] = ((unsigned)(m0 + row) * (unsigned)lda + (unsigned)q * 8u) * 2u;
  }
#pragma unroll
  for (int i = 0; i < 2; ++i) {
    const int row = (wid * 2 + i) * 16 + (lane >> 2);
    const int q = (lane & 3) ^ ((row >> 2) & 3);
    int grow = n0 + row;
    grow = grow < nmax ? grow : nmax;
    gB[i] = ((unsigned)grow * (unsigned)ldb + (unsigned)q * 8u) * 2u;
  }
  unsigned aoff[NMI], boff[4];
#pragma unroll
  for (int mi = 0; mi < NMI; ++mi) {
    int row = wm * (MROWS / 2) + mi * 16 + (lane & 15);
    aoff[mi] = (unsigned)row * 64u + (unsigned)(((lane >> 4) ^ ((row >> 2) & 3)) << 4);
  }
#pragma unroll
  for (int ni = 0; ni < 4; ++ni) {
    int row = wn * 64 + ni * 16 + (lane & 15);
    boff[ni] = (unsigned)BOFF + (unsigned)row * 64u + (unsigned)(((lane >> 4) ^ ((row >> 2) & 3)) << 4);
  }
  const char* Ab = reinterpret_cast<const char*>(A);
  const char* Bb = reinterpret_cast<const char*>(Bt);
  const int nk = K >> 5;
  char* ldsA = smem + wid * (NA * 1024);
  char* ldsB = smem + BOFF + wid * 2048;
#define BG_GLDS(TILE, ST)                                                                                           \
  {                                                                                                                 \
    const char* Ak_ = Ab + (size_t)(TILE) * 64;                                                                     \
    const char* Bk_ = Bb + (size_t)(TILE) * 64;                                                                     \
    char* la_ = ldsA + (ST) * STAGE;                                                                                \
    char* lb_ = ldsB + (ST) * STAGE;                                                                                \
    _Pragma("unroll") for (int i_ = 0; i_ < NA; ++i_)                                                               \
      __builtin_amdgcn_global_load_lds((const unsigned*)(Ak_ + gA[i_]), (LAS unsigned*)(la_ + i_ * 1024), 16, 0, 0); \
    __builtin_amdgcn_global_load_lds((const unsigned*)(Bk_ + gB[0]), (LAS unsigned*)(lb_), 16, 0, 0);              \
    __builtin_amdgcn_global_load_lds((const unsigned*)(Bk_ + gB[1]), (LAS unsigned*)(lb_ + 1024), 16, 0, 0);       \
  }
#define BG_COMPUTE(ST)                                                                                              \
  {                                                                                                                 \
    const char* s_ = smem + (ST) * STAGE;                                                                           \
    bf16x8 bfr[4], af[NMI];                                                                                         \
    _Pragma("unroll") for (int ni = 0; ni < 4; ++ni) bfr[ni] = *reinterpret_cast<const bf16x8*>(s_ + boff[ni]);     \
    _Pragma("unroll") for (int mi = 0; mi < NMI; ++mi) af[mi] = *reinterpret_cast<const bf16x8*>(s_ + aoff[mi]);    \
    __builtin_amdgcn_sched_barrier(0);                                                                              \
    _Pragma("unroll") for (int mi = 0; mi < NMI; ++mi)                                                              \
      _Pragma("unroll") for (int ni = 0; ni < 4; ++ni)                                                              \
        acc[mi][ni] = __builtin_amdgcn_mfma_f32_16x16x32_bf16(bfr[ni], af[mi], acc[mi][ni], 0, 0, 0);               \
  }
  asm volatile("s_waitcnt vmcnt(0)" ::: "memory");
  BG_GLDS(0, 0);
  BG_GLDS(1, 1);
  int st = 0;
#pragma unroll 1
  for (int kt = 0; kt < nk - 1; ++kt) {
    if constexpr (NA == 4) asm volatile("s_waitcnt vmcnt(6)" ::: "memory");
    else asm volatile("s_waitcnt vmcnt(4)" ::: "memory");
    RAW_BARRIER();
    if (kt + 2 < nk) {
      const int st2 = (st >= 1) ? st - 1 : 2;
      BG_GLDS(kt + 2, st2);
    }
    __builtin_amdgcn_sched_barrier(0);
    BG_COMPUTE(st);
    __builtin_amdgcn_sched_barrier(0);
    st = (st == 2) ? 0 : st + 1;
  }
  asm volatile("s_waitcnt vmcnt(0)" ::: "memory");
  RAW_BARRIER();
  BG_COMPUTE(st);
  RAW_BARRIER();
#undef BG_GLDS
#undef BG_COMPUTE
}
__device__ __forceinline__ void gemm_mainloop_big(f32x4 (&acc)[8][4], const bf16_t* A, int lda, int m0, const bf16_t* Bt,
                                                  int ldb, int n0, int nmax, int K, char* smem, const int tid) {
  gemm_mainloop_glds<256>(acc, A, lda, m0, Bt, ldb, n0, nmax, K, smem, tid);
}

__device__ __forceinline__ void zero_acc_big(f32x4 (&acc)[8][4]) {
#pragma unroll
  for (int mi = 0; mi < 8; ++mi)
#pragma unroll
    for (int ni = 0; ni < 4; ++ni) acc[mi][ni] = f32x4{0.f, 0.f, 0.f, 0.f};
}

__device__ __forceinline__ void conv_tile(const float* src, int ld, int nlimit, int k0, int n0, bf16_t* dst, int Kd, int mode,
                                          char* smem, const int tid) {
  float* sT = reinterpret_cast<float*>(smem);
#pragma unroll
  for (int i = 0; i < 16; ++i) {
    int kk = i * 4 + (tid >> 6), nn = tid & 63;
    float v = (n0 + nn < nlimit) ? src[(size_t)(k0 + kk) * ld + n0 + nn] : 0.f;
    sT[kk * 65 + nn] = v;
  }
  __syncthreads();
  {
    int nn = tid >> 2, kq = tid & 3;
    int n = n0 + nn;
    if (n < nlimit) {
      int drow = n;
      if (mode == 1) {
        if (n < FFH) drow = (n >> 4) * 32 + (n & 15);
        else { int j = n - FFH; drow = (j >> 4) * 32 + 16 + (j & 15); }
      }
      unsigned pk[8];
#pragma unroll
      for (int j = 0; j < 8; ++j) pk[j] = pack2(sT[(kq * 16 + 2 * j) * 65 + nn], sT[(kq * 16 + 2 * j + 1) * 65 + nn]);
      uint4* d = reinterpret_cast<uint4*>(dst + (size_t)drow * Kd + k0 + kq * 16);
      d[0] = uint4{pk[0], pk[1], pk[2], pk[3]};
      d[1] = uint4{pk[4], pk[5], pk[6], pk[7]};
    }
  }
  __syncthreads();
}

__device__ __forceinline__ void rmsnorm_row_to_bf16(const float* x, const float* w, bf16_t* out, const int lane) {
  float4 v[4];
  float ss = 0.f;
#pragma unroll
  for (int i = 0; i < 4; ++i) {
    v[i] = *reinterpret_cast<const float4*>(x + i * 256 + lane * 4);
    ss += v[i].x * v[i].x + v[i].y * v[i].y + v[i].z * v[i].z + v[i].w * v[i].w;
  }
  ss = sum64(ss);
  float rstd = rsqrtf(ss * (1.f / 1024.f) + 1e-6f);
#pragma unroll
  for (int i = 0; i < 4; ++i) {
    float4 ww = *reinterpret_cast<const float4*>(w + i * 256 + lane * 4);
    uint2 o;
    o.x = pack2(v[i].x * rstd * ww.x, v[i].y * rstd * ww.y);
    o.y = pack2(v[i].z * rstd * ww.z, v[i].w * rstd * ww.w);
    *reinterpret_cast<uint2*>(out + i * 256 + lane * 4) = o;
  }
}

constexpr int CT_IN = 157 * 16, CT_BR = 512, CT_OUT = 256, CT_F1 = 88 * 16, CT_F2 = 44 * 16, CT_GLU = 64;
constexpr int CT_TOTAL = CT_IN + CT_BR + CT_OUT + CT_F1 + CT_F2 + CT_GLU;

__device__ __forceinline__ void convert_one(const Params& p, int l, int c, char* smem, const int tid) {
  char* ws = p.ws;
  if (c < CT_IN) {
    int nt = c >> 4, kt = c & 15;
    const float* src = p.in[I_W_IN] + (size_t)l * 1024 * IN_COLS;
    if (nt < 64) conv_tile(src, IN_COLS, IN_COLS, kt * 64, nt * 64, (bf16_t*)(ws + WOFF_GATE(l)), 1024, 0, smem, tid);
    else conv_tile(src + 4096, IN_COLS, IN_COLS - 4096, kt * 64, (nt - 64) * 64, (bf16_t*)(ws + OFF_WTIN), 1024, 0, smem, tid);
    return;
  }
  c -= CT_IN;
  if (c < CT_BR) {
    int kb = c >> 7, r = c & 127, nt = r >> 3, kt = r & 7;
    const float* src = p.in[I_W_BRANCH] + ((size_t)l * 4 + kb) * 512 * 1024;
    conv_tile(src, 1024, 1024, kt * 64, nt * 64, (bf16_t*)(ws + WOFF(OFF_WTBR, l)) + (size_t)kb * 1024 * 512, 512, 0, smem, tid);
    return;
  }
  c -= CT_BR;
  if (c < CT_OUT) {
    int nt = c >> 4, kt = c & 15;
    conv_tile(p.in[I_W_OUT] + (size_t)l * 1024 * 1024, 1024, 1024, kt * 64, nt * 64, (bf16_t*)(ws + WOFF(OFF_WTOUT, l)), 1024, 0, smem, tid);
    return;
  }
  c -= CT_OUT;
  if (c < CT_F1) {
    int nt = c >> 4, kt = c & 15;
    conv_tile(p.in[I_W_FFN_IN] + (size_t)l * 1024 * 5632, 5632, 5632, kt * 64, nt * 64, (bf16_t*)(ws + WOFF(OFF_WTF1, l)), 1024, 1, smem, tid);
    return;
  }
  c -= CT_F1;
  if (c < CT_F2) {
    int nt = c / 44, kt = c % 44;
    conv_tile(p.in[I_W_FFN_OUT] + (size_t)l * FFH * 1024, 1024, 1024, kt * 64, nt * 64, (bf16_t*)(ws + WOFF(OFF_WTF2, l)), FFH, 0, smem, tid);
    return;
  }
  c -= CT_F2;
  {
    int nt = c >> 3, kt = c & 7;
    conv_tile(p.in[I_S5_WGLU] + (size_t)l * 512 * 512, 512, 512, kt * 64, nt * 64, (bf16_t*)(ws + WOFF(OFF_WTGLU, l)), 512, 0, smem, tid);
  }
}

constexpr int CT_LORA = 41;
__device__ __forceinline__ void convert_lora(const Params& p, int l, int c, char* smem, const int tid) {
  char* lo = p.ws + OFF_LORA + (size_t)l * LORA_STRIDE;
  if (c < 16) { int nt = c >> 1, kt = c & 1;
    conv_tile(p.in[I_RW_G2] + (size_t)l * 128 * 512, 512, 512, kt * 64, nt * 64, (bf16_t*)(lo + LO_G2), 128, 0, smem, tid); return; }
  c -= 16;
  if (c < 8) { conv_tile(p.in[I_RW_W2] + (size_t)l * 64 * 512, 512, 512, 0, c * 64, (bf16_t*)(lo + LO_W2), 64, 0, smem, tid); return; }
  c -= 8;
  if (c < 8) { conv_tile(p.in[I_RW_A2] + (size_t)l * 64 * 512, 512, 512, 0, c * 64, (bf16_t*)(lo + LO_A2), 64, 0, smem, tid); return; }
  c -= 8;
  if (l == 0) return;
  if (c < 8) { conv_tile(p.in[I_RW_V1] + (size_t)(l - 1) * 512 * 32, 32, 32, c * 64, 0, (bf16_t*)(lo + LO_V1), 512, 0, smem, tid); return; }
  {
    const float* src = p.in[I_RW_V2] + (size_t)(l - 1) * 32 * 512;
    bf16_t* dst = (bf16_t*)(lo + LO_V2);
    for (int e = tid; e < 32 * 512; e += 256) { int ch = e >> 5, r = e & 31; dst[e] = f2bf(src[r * 512 + ch]); }
  }
}

template <int J>
__device__ __forceinline__ void lora_mfma(const char* sIn, int rowb, const bf16_t* Wt, f32x4 (&acc)[8], const int tid) {
  const int lane = tid & 63, w = tid >> 6;
#pragma unroll
  for (int i = 0; i < 8; ++i) acc[i] = f32x4{0.f, 0.f, 0.f, 0.f};
#pragma unroll
  for (int ks = 0; ks < J / 32; ++ks) {
    const bf16x8 a = *reinterpret_cast<const bf16x8*>(sIn + (lane & 15) * rowb + (ks * 32 + 8 * (lane >> 4)) * 2);
#pragma unroll
    for (int i = 0; i < 8; ++i) {
      const bf16x8 b = *reinterpret_cast<const bf16x8*>(Wt + (size_t)((w * 8 + i) * 16 + (lane & 15)) * J + ks * 32 + 8 * (lane >> 4));
      acc[i] = __builtin_amdgcn_mfma_f32_16x16x32_bf16(b, a, acc[i], 0, 0, 0);
    }
  }
}

__device__ void phase_convert_norm(const Params& p, int l, char* smem) {
  const int tid = opaque_tid();
  constexpr int CT_IN_ONLY = CT_IN - 1024;
  const int nconv = (l == 0) ? CT_IN_ONLY + 2 * CT_LORA : 0;
  const int ntask = nconv + T_TOK / 4;
  const float* xsrc = (l == 0) ? p.in[I_X] : p.out;
  for (int t = blockIdx.x; t < ntask; t += gridDim.x) {
    if (t < nconv) {
      if (t < CT_IN_ONLY) convert_one(p, l, t + 1024, smem, tid);
      else { int c = t - CT_IN_ONLY; convert_lora(p, c / CT_LORA, c % CT_LORA, smem, tid); __syncthreads(); }
    } else {
      int row = (t - nconv) * 4 + (tid >> 6);
      rmsnorm_row_to_bf16(xsrc + (size_t)row * DM, p.in[I_NORM_MIX] + l * DM, (bf16_t*)(p.ws + OFF_U) + (size_t)row * DM, tid & 63);
    }
  }
}

__device__ void phase_norm_only(const Params& p, const float* xsrc, const float* w) {
  const int tid = opaque_tid();
  for (int t = blockIdx.x; t < T_TOK / 4; t += gridDim.x) {
    int row = t * 4 + (tid >> 6);
    rmsnorm_row_to_bf16(xsrc + (size_t)row * DM, w, (bf16_t*)(p.ws + OFF_U) + (size_t)row * DM, tid & 63);
  }
}

__device__ __forceinline__ bool tile_map(int t, int NT, int& mt, int& nt) {
  const int x = t & 7, r = t >> 3;
  const int cnt = (NT + 7) >> 3;
  const int ni = r % cnt;
  mt = r / cnt;
  nt = x + 8 * ni;
  return nt < NT;
}
__device__ __forceinline__ int tile_count(int MT, int NT) { return 8 * MT * ((NT + 7) >> 3); }

__device__ void phase_inproj(const Params& p, char* smem) {
  const bf16_t* U = (const bf16_t*)(p.ws + OFF_U);
  const bf16_t* Wt = (const bf16_t*)(p.ws + OFF_WTIN);
  bf16_t* Z = (bf16_t*)(p.ws + OFF_Z);
  const int tid = opaque_tid();
  const int lane = tid & 63, wid = tid >> 6, wm = wid >> 1, wn = wid & 1;
  constexpr int NT = 47;
  for (int t = blockIdx.x; t < tile_count(64, NT); t += gridDim.x) {
    int mt, nt;
    if (!tile_map(t, NT, mt, nt)) continue;
    f32x4 acc[8][4];
    zero_acc_big(acc);
    gemm_mainloop_big(acc, U, 1024, mt * 256, Wt, 1024, nt * 128, NZ - 1, 1024, smem, tid);
#pragma unroll
    for (int mi = 0; mi < 8; ++mi)
#pragma unroll
      for (int np = 0; np < 2; ++np) {
        const int colb = nt * 128 + wn * 64 + np * 32;
        const int row = mt * 256 + wm * 128 + mi * 16 + (lane & 15);
        uint2 a, b;
        a.x = pack2(acc[mi][2 * np][0], acc[mi][2 * np][1]);
        a.y = pack2(acc[mi][2 * np][2], acc[mi][2 * np][3]);
        b.x = pack2(acc[mi][2 * np + 1][0], acc[mi][2 * np + 1][1]);
        b.y = pack2(acc[mi][2 * np + 1][2], acc[mi][2 * np + 1][3]);
        const int mycol = colb + ((lane >> 4) & 1) * 16 + (lane >> 5) * 8;
        store_pair_bf16(Z + (size_t)row * ZS + colb, lane, a, b, mycol < NZ);
      }
  }
}

template <int J>
__device__ __forceinline__ void lora_mm(const float* sIn, const float* W, float (&a0)[16], float (&a1)[16], const int tid) {
#pragma unroll
  for (int i = 0; i < 16; ++i) { a0[i] = 0.f; a1[i] = 0.f; }
#pragma unroll 8
  for (int j = 0; j < J; ++j) {
    float w0 = W[j * 512 + tid], w1 = W[j * 512 + tid + 256];
    const float4* x4 = reinterpret_cast<const float4*>(sIn + j * 16);
#pragma unroll
    for (int q = 0; q < 4; ++q) {
      float4 x = x4[q];
      a0[q * 4 + 0] = fmaf(w0, x.x, a0[q * 4 + 0]); a1[q * 4 + 0] = fmaf(w1, x.x, a1[q * 4 + 0]);
      a0[q * 4 + 1] = fmaf(w0, x.y, a0[q * 4 + 1]); a1[q * 4 + 1] = fmaf(w1, x.y, a1[q * 4 + 1]);
      a0[q * 4 + 2] = fmaf(w0, x.z, a0[q * 4 + 2]); a1[q * 4 + 2] = fmaf(w1, x.z, a1[q * 4 + 2]);
      a0[q * 4 + 3] = fmaf(w0, x.w, a0[q * 4 + 3]); a1[q * 4 + 3] = fmaf(w1, x.w, a1[q * 4 + 3]);
    }
  }
}

__device__ __forceinline__ float rw_shift(const bf16_t* Z, int row, int s, int rc, float mu) {
  float cur = bf2f(Z[(size_t)row * ZS + ZRW + rc]);
  float prev = (s > 0) ? bf2f(Z[(size_t)(row - 1) * ZS + ZRW + rc]) : 0.f;
  return cur + (prev - cur) * mu;
}

__device__ __forceinline__ void unpack8(const uint4& v, float (&f)[8]) {
  f[0] = bf2f((bf16_t)(v.x & 0xffff)); f[1] = bf2f((bf16_t)(v.x >> 16));
  f[2] = bf2f((bf16_t)(v.y & 0xffff)); f[3] = bf2f((bf16_t)(v.y >> 16));
  f[4] = bf2f((bf16_t)(v.z & 0xffff)); f[5] = bf2f((bf16_t)(v.z >> 16));
  f[6] = bf2f((bf16_t)(v.w & 0xffff)); f[7] = bf2f((bf16_t)(v.w >> 16));
}
__device__ __forceinline__ void rw_shift8(const uint4& cur, const uint4& prev, const float* mu8, float (&out)[8]) {
  float c[8], q[8];
  unpack8(cur, c); unpack8(prev, q);
#pragma unroll
  for (int e = 0; e < 8; ++e) out[e] = c[e] + (q[e] - c[e]) * mu8[e];
}

__device__ void phase_rwprep(const Params& p, int l, char* smem) {
  const bf16_t* Z = (const bf16_t*)(p.ws + OFF_Z);
  bf16_t* LW = (bf16_t*)(p.ws + OFF_U);
  bf16_t* LA = LW + (size_t)T_TOK * 512;
  bf16_t* VF = (bf16_t*)(p.ws + OFF_VF);
  const char* lo = p.ws + OFF_LORA + (size_t)l * LORA_STRIDE;
  char* sXw = smem;
  char* sXa = smem + 2304;
  char* sZv = smem + 4608;
  float* sTmpF = reinterpret_cast<float*>(smem + 4608 + 16640);
  char* sTmp = smem + 4608 + 16640 + 4096;
  const float* mu = p.in[I_RW_MU] + l * 1792;
  const int tid = opaque_tid(), lane = tid & 63, w = tid >> 6;
  for (int t = blockIdx.x; t < T_TOK / 16; t += gridDim.x) {
    const int row0 = t * 16;
    {
      const int tok = tid >> 4, j8 = (tid & 15) * 8;
      const int row = row0 + tok, sq = row & (SEQ - 1);
      const bf16_t* zp = Z + (size_t)row * ZS + ZRW + 1536 + j8;
      const uint4 cur = *reinterpret_cast<const uint4*>(zp);
      uint4 prev = uint4{0u, 0u, 0u, 0u};
      if (sq > 0) prev = *reinterpret_cast<const uint4*>(zp - ZS);
      float z[8];
      rw_shift8(cur, prev, mu + 1536 + j8, z);
      if (j8 < 64) {
        *reinterpret_cast<uint4*>(sXw + tok * 144 + j8 * 2) =
            uint4{pack2(ftanh(z[0]), ftanh(z[1])), pack2(ftanh(z[2]), ftanh(z[3])), pack2(ftanh(z[4]), ftanh(z[5])), pack2(ftanh(z[6]), ftanh(z[7]))};
      } else {
        *reinterpret_cast<uint4*>(sXa + tok * 144 + (j8 - 64) * 2) =
            uint4{pack2(z[0], z[1]), pack2(z[2], z[3]), pack2(z[4], z[5]), pack2(z[6], z[7])};
      }
    }
    {
      const int c8 = (tid & 63) * 8, tg = tid >> 6;
      const float* mu8 = mu + 1024 + c8;
      const int rowa = row0 + tg * 4;
      const bf16_t* zp = Z + (size_t)rowa * ZS + ZRW + 1024 + c8;
      uint4 prev = uint4{0u, 0u, 0u, 0u};
      if ((rowa & (SEQ - 1)) > 0) prev = *reinterpret_cast<const uint4*>(zp - ZS);
#pragma unroll
      for (int k = 0; k < 4; ++k) {
        const uint4 cur = *reinterpret_cast<const uint4*>(zp + (size_t)k * ZS);
        float z[8];
        rw_shift8(cur, prev, mu8, z);
        const uint4 o = uint4{pack2(z[0], z[1]), pack2(z[2], z[3]), pack2(z[4], z[5]), pack2(z[6], z[7])};
        *reinterpret_cast<uint4*>(sZv + (tg * 4 + k) * 1040 + c8 * 2) = o;
        if (l == 0) *reinterpret_cast<uint4*>(VF + (size_t)(rowa + k) * 512 + c8) = o;
        prev = cur;
      }
    }
    __syncthreads();
    f32x4 acc[8];
    lora_mfma<64>(sXw, 144, (const bf16_t*)(lo + LO_W2), acc, tid);
#pragma unroll
    for (int i = 0; i < 8; ++i)
      *reinterpret_cast<uint2*>(LW + (size_t)(row0 + (lane & 15)) * 512 + (w * 8 + i) * 16 + (lane >> 4) * 4) =
          uint2{pack2(acc[i][0], acc[i][1]), pack2(acc[i][2], acc[i][3])};
    lora_mfma<64>(sXa, 144, (const bf16_t*)(lo + LO_A2), acc, tid);
#pragma unroll
    for (int i = 0; i < 8; ++i)
      *reinterpret_cast<uint2*>(LA + (size_t)(row0 + (lane & 15)) * 512 + (w * 8 + i) * 16 + (lane >> 4) * 4) =
          uint2{pack2(acc[i][0], acc[i][1]), pack2(acc[i][2], acc[i][3])};
    if (l > 0) {
      {
        const bf16_t* v1t = (const bf16_t*)(lo + LO_V1);
        const int ntile = w & 1, kh = w >> 1;
        f32x4 tacc = f32x4{0.f, 0.f, 0.f, 0.f};
#pragma unroll
        for (int ks = 0; ks < 8; ++ks) {
          const int k0 = (kh * 8 + ks) * 32 + 8 * (lane >> 4);
          const bf16x8 a = *reinterpret_cast<const bf16x8*>(sZv + (lane & 15) * 1040 + k0 * 2);
          const bf16x8 b = *reinterpret_cast<const bf16x8*>(v1t + (size_t)(ntile * 16 + (lane & 15)) * 512 + k0);
          tacc = __builtin_amdgcn_mfma_f32_16x16x32_bf16(a, b, tacc, 0, 0, 0);
        }
#pragma unroll
        for (int jj = 0; jj < 4; ++jj)
          sTmpF[(kh * 16 + (lane >> 4) * 4 + jj) * 32 + ntile * 16 + (lane & 15)] = tacc[jj];
      }
      __syncthreads();
      for (int e = tid; e < 512; e += 256) {
        int tok = e >> 5, r = e & 31;
        *reinterpret_cast<bf16_t*>(sTmp + tok * 80 + r * 2) = f2bf(sTmpF[tok * 32 + r] + sTmpF[(16 + tok) * 32 + r]);
      }
      __syncthreads();
      lora_mfma<32>(sTmp, 80, (const bf16_t*)(lo + LO_V2), acc, tid);
      const float* v0 = p.in[I_RW_V0] + (size_t)(l - 1) * 512;
#pragma unroll
      for (int i = 0; i < 8; ++i) {
        const int tok = lane & 15, ch0 = (w * 8 + i) * 16 + (lane >> 4) * 4;
        const float4 b4 = *reinterpret_cast<const float4*>(v0 + ch0);
        const uint2 zr = *reinterpret_cast<const uint2*>(sZv + tok * 1040 + ch0 * 2);
        bf16_t* vp = VF + (size_t)(row0 + tok) * 512 + ch0;
        const uint2 vr = *reinterpret_cast<const uint2*>(vp);
        const float z0 = bf2f((bf16_t)(zr.x & 0xffff)), z1 = bf2f((bf16_t)(zr.x >> 16));
        const float z2 = bf2f((bf16_t)(zr.y & 0xffff)), z3 = bf2f((bf16_t)(zr.y >> 16));
        const float f0 = bf2f((bf16_t)(vr.x & 0xffff)), f1 = bf2f((bf16_t)(vr.x >> 16));
        const float f2 = bf2f((bf16_t)(vr.y & 0xffff)), f3 = bf2f((bf16_t)(vr.y >> 16));
        uint2 o;
        o.x = pack2(z0 + (f0 - z0) * fsigmoid(b4.x + acc[i][0]), z1 + (f1 - z1) * fsigmoid(b4.y + acc[i][1]));
        o.y = pack2(z2 + (f2 - z2) * fsigmoid(b4.z + acc[i][2]), z3 + (f3 - z3) * fsigmoid(b4.w + acc[i][3]));
        *reinterpret_cast<uint2*>(vp) = o;
      }
    }
    __syncthreads();
  }
}

__device__ void hg_scan(const Params& p, int l, int task, char* smem) {
  const int b = task >> 3, h = (task >> 1) & 3, vg = task & 1;
  float* sFg = reinterpret_cast<float*>(smem);
  float* sQs = sFg + 16 * 128;
  float* sO = sQs + 16 * 128;
  float* sVv = sO + 4 * 16 * 64;
  const int tid = opaque_tid(), w = tid >> 6, lane = tid & 63;
  bf16_t* Z = (bf16_t*)(p.ws + OFF_Z) + (size_t)b * SEQ * ZS;
  const int ks = tid & 127;
  float lb = 0.f;
  if (l > 0) {
    float x0 = p.in[I_HG_LB][h * 128 + ks], x1 = p.in[I_HG_LB][512 + h * 128 + ks];
    float m = fmaxf(x0, x1), e0 = expf(x0 - m), e1 = expf(x1 - m);
    lb = e1 / (e0 + e1);
  }
  float s[32];
#pragma unroll
  for (int j = 0; j < 32; ++j) s[j] = 0.f;
  const int vcol = ZHG + 1024 + h * 128 + vg * 64;
  const int qcol = ZHG + h * 128 + ks;
  bf16_t rq0, rq1, rq2, rq3, rq4, rq5, rq6, rq7, rf0, rf1, rf2, rf3, rf4, rf5, rf6, rf7, rv0, rv1, rv2, rv3;
#define HG_LOAD(T0)                                                                                \
  {                                                                                                \
    const bf16_t* zb = Z + (size_t)((T0) + (tid >> 7)) * ZS + qcol;                                \
    rq0 = zb[0]; rf0 = zb[512]; zb += 2 * ZS; rq1 = zb[0]; rf1 = zb[512]; zb += 2 * ZS;            \
    rq2 = zb[0]; rf2 = zb[512]; zb += 2 * ZS; rq3 = zb[0]; rf3 = zb[512]; zb += 2 * ZS;            \
    rq4 = zb[0]; rf4 = zb[512]; zb += 2 * ZS; rq5 = zb[0]; rf5 = zb[512]; zb += 2 * ZS;            \
    rq6 = zb[0]; rf6 = zb[512]; zb += 2 * ZS; rq7 = zb[0]; rf7 = zb[512];                          \
    const bf16_t* zv = Z + (size_t)((T0) + w) * ZS + vcol + lane;                                  \
    rv0 = zv[0]; rv1 = zv[4 * ZS]; rv2 = zv[8 * ZS]; rv3 = zv[12 * ZS];                            \
  }
#define HG_PUT1(I, RQ, RF)                                                                         \
  {                                                                                                \
    int t = (tid >> 7) + 2 * (I);                                                                  \
    sFg[t * 128 + ks] = fmaxf(lb + (1.f - lb) * fsigmoid(bf2f(RF)), 1e-30f);                       \
    sQs[t * 128 + ks] = fsilu(bf2f(RQ));                                                           \
  }
#define HG_PROCESS()                                                                               \
  {                                                                                                \
    HG_PUT1(0, rq0, rf0) HG_PUT1(1, rq1, rf1) HG_PUT1(2, rq2, rf2) HG_PUT1(3, rq3, rf3)            \
    HG_PUT1(4, rq4, rf4) HG_PUT1(5, rq5, rf5) HG_PUT1(6, rq6, rf6) HG_PUT1(7, rq7, rf7)            \
    sVv[(w)*64 + lane] = bf2f(rv0); sVv[(w + 4) * 64 + lane] = bf2f(rv1);                          \
    sVv[(w + 8) * 64 + lane] = bf2f(rv2); sVv[(w + 12) * 64 + lane] = bf2f(rv3);                   \
  }
  HG_LOAD(0);
  HG_PROCESS();
  __syncthreads();
  constexpr int NCH = SEQ / 16;
#pragma unroll 1
  for (int c = 0; c < NCH; ++c) {
    const int t0 = c * 16;
    const int tn = (c + 1 < NCH) ? t0 + 16 : t0;
    HG_LOAD(tn);
    __builtin_amdgcn_sched_barrier(0);
#pragma unroll 2
    for (int t = 0; t < 16; ++t) {
      const float v = sVv[t * 64 + lane];
      const float opv = (lane < 32) ? sFg[t * 128 + w * 32 + lane] : sQs[t * 128 + w * 32 + (lane - 32)];
      const int opi = __builtin_bit_cast(int, opv);
      float o = 0.f;
#pragma unroll
      for (int j = 0; j < 32; ++j) {
        const float fg = __builtin_bit_cast(float, __builtin_amdgcn_readlane(opi, j));
        const float qq = __builtin_bit_cast(float, __builtin_amdgcn_readlane(opi, 32 + j));
        const float kv = fmaf(-fg, v, v);
        s[j] = fmaf(s[j], fg, kv);
        o = fmaf(qq, s[j], o);
      }
      sO[(w * 16 + t) * 64 + lane] = o;
    }
    __builtin_amdgcn_sched_barrier(0);
    __syncthreads();
    {
      int t = tid >> 4, v4 = (tid & 15) * 4;
      float4 a = *reinterpret_cast<const float4*>(sO + (0 * 16 + t) * 64 + v4);
      float4 bq = *reinterpret_cast<const float4*>(sO + (1 * 16 + t) * 64 + v4);
      float4 cq = *reinterpret_cast<const float4*>(sO + (2 * 16 + t) * 64 + v4);
      float4 d = *reinterpret_cast<const float4*>(sO + (3 * 16 + t) * 64 + v4);
      uint2 o;
      o.x = pack2(a.x + bq.x + cq.x + d.x, a.y + bq.y + cq.y + d.y);
      o.y = pack2(a.z + bq.z + cq.z + d.z, a.w + bq.w + cq.w + d.w);
      *reinterpret_cast<uint2*>(Z + (size_t)(t0 + t) * ZS + vcol + v4) = o;
    }
    HG_PROCESS();
    __syncthreads();
  }
#undef HG_LOAD
#undef HG_PUT1
#undef HG_PROCESS
}

__device__ void mb_scan(const Params& p, int l, int task, char* smem) {
  const int b = task >> 3, hd = task & 7, g = hd >> 2;
  float* sB = reinterpret_cast<float*>(smem);
  float* sC = sB + 16 * 128;
  float* sX = sC + 16 * 128;
  float* sDt = sX + 16 * 64;
  float* sDA = sDt + 16;
  float* sO = sDA + 16;
  const int tid = opaque_tid(), w = tid >> 6, lane = tid & 63;
  bf16_t* Z = (bf16_t*)(p.ws + OFF_Z) + (size_t)b * SEQ * ZS;
  const float* cw = p.in[I_MB_CONVW] + (size_t)l * 4 * 1024;
  const float* cb = p.in[I_MB_CONVB] + (size_t)l * 1024;
  int ci0, ci1;
  {
    int ch = tid;
    ci0 = (ch < 64) ? hd * 64 + ch : (ch < 192 ? 512 + g * 128 + (ch - 64) : 768 + g * 128 + (ch - 192));
    ci1 = 768 + g * 128 + 64 + (tid & 63);
  }
  float* dstA = (tid < 64) ? (sX + tid) : (tid < 192 ? (sB + (tid - 64)) : (sC + (tid - 192)));
  const int strideA = (tid < 64) ? 64 : 128;
  const float w0a = cw[ci0], w1a = cw[1024 + ci0], w2a = cw[2048 + ci0], w3a = cw[3072 + ci0], ba = cb[ci0];
  const float w0b = cw[ci1], w1b = cw[1024 + ci1], w2b = cw[2048 + ci1], w3b = cw[3072 + ci1], bb = cb[ci1];
  const float Aneg = -expf(p.in[I_MB_ALOG][l * 8 + hd]);
  const float dtb = p.in[I_MB_DTB][l * 8 + hd];
  const float Dsk = p.in[I_MB_D][l * 8 + hd];
  float s[32];
#pragma unroll
  for (int j = 0; j < 32; ++j) s[j] = 0.f;
  float pa1 = 0.f, pa2 = 0.f, pa3 = 0.f;
  const int tq = (tid >> 6) * 4;
  const int xcol = ZMB + 512;
  const int rt = tid >> 4, rp4 = (tid & 15) * 4;
  bf16_t xa0, xa1, xa2, xa3, xa4, xa5, xa6, xa7, xa8, xa9, xa10, xa11, xa12, xa13, xa14, xa15;
  bf16_t xb0, xb1, xb2, xb3, xb4, xb5, xb6;
  bf16_t rdt;
  uint2 gcur, gnext;
#define MB_LOAD(T0)                                                                                 \
  {                                                                                                 \
    const bf16_t* za = Z + (size_t)(T0) * ZS + xcol + ci0;                                          \
    xa0 = za[0]; xa1 = za[ZS]; xa2 = za[2 * ZS]; xa3 = za[3 * ZS]; xa4 = za[4 * ZS]; xa5 = za[5 * ZS];        \
    xa6 = za[6 * ZS]; xa7 = za[7 * ZS]; xa8 = za[8 * ZS]; xa9 = za[9 * ZS]; xa10 = za[10 * ZS];     \
    xa11 = za[11 * ZS]; xa12 = za[12 * ZS]; xa13 = za[13 * ZS]; xa14 = za[14 * ZS]; xa15 = za[15 * ZS];       \
    {                                                                                               \
      const int r0_ = (T0) + tq - 3;                                                                \
      const bf16_t* zb = Z + (ptrdiff_t)r0_ * ZS + xcol + ci1;                                      \
      xb0 = (r0_ >= 0) ? zb[0] : (bf16_t)0; xb1 = (r0_ + 1 >= 0) ? zb[ZS] : (bf16_t)0;              \
      xb2 = (r0_ + 2 >= 0) ? zb[2 * ZS] : (bf16_t)0;                                                \
      xb3 = zb[3 * ZS]; xb4 = zb[4 * ZS]; xb5 = zb[5 * ZS]; xb6 = zb[6 * ZS];                       \
    }                                                                                               \
    rdt = Z[(size_t)((T0) + (tid & 15)) * ZS + ZMB + 1536 + hd];                                    \
    gnext = *reinterpret_cast<const uint2*>(Z + (size_t)((T0) + rt) * ZS + ZMB + hd * 64 + rp4);    \
  }
#define MB_CONV_A(T, XR)                                                                            \
  {                                                                                                 \
    float xv = bf2f(XR);                                                                            \
    dstA[(T)*strideA] = fsilu(ba + w0a * pa3 + w1a * pa2 + w2a * pa1 + w3a * xv);                   \
    pa3 = pa2; pa2 = pa1; pa1 = xv;                                                                 \
  }
#define MB_CONV_B(J, X0, X1, X2, X3)                                                                \
  sC[(tq + (J)) * 128 + 64 + (tid & 63)] = fsilu(bb + w0b * bf2f(X0) + w1b * bf2f(X1) + w2b * bf2f(X2) + w3b * bf2f(X3));
#define MB_PROCESS()                                                                                \
  {                                                                                                 \
    MB_CONV_A(0, xa0) MB_CONV_A(1, xa1) MB_CONV_A(2, xa2) MB_CONV_A(3, xa3) MB_CONV_A(4, xa4)       \
    MB_CONV_A(5, xa5) MB_CONV_A(6, xa6) MB_CONV_A(7, xa7) MB_CONV_A(8, xa8) MB_CONV_A(9, xa9)       \
    MB_CONV_A(10, xa10) MB_CONV_A(11, xa11) MB_CONV_A(12, xa12) MB_CONV_A(13, xa13)                 \
    MB_CONV_A(14, xa14) MB_CONV_A(15, xa15)                                                         \
    MB_CONV_B(0, xb0, xb1, xb2, xb3) MB_CONV_B(1, xb1, xb2, xb3, xb4)                               \
    MB_CONV_B(2, xb2, xb3, xb4, xb5) MB_CONV_B(3, xb3, xb4, xb5, xb6)                               \
    if (tid < 16) {                                                                                 \
      float dt = fsoftplus(bf2f(rdt) + dtb);                                                        \
      sDt[tid] = dt;                                                                                \
      sDA[tid] = __expf(Aneg * dt);                                                                 \
    }                                                                                               \
    gcur = gnext;                                                                                   \
  }
  MB_LOAD(0);
  MB_PROCESS();
  __syncthreads();
  constexpr int NCH = SEQ / 16;
#pragma unroll 1
  for (int c = 0; c < NCH; ++c) {
    const int t0 = c * 16;
    const bool more = (c + 1 < NCH);
    const int tn = more ? t0 + 16 : t0;
    MB_LOAD(tn);
    __builtin_amdgcn_sched_barrier(0);
#pragma unroll 2
    for (int t = 0; t < 16; ++t) {
      const float dA = sDA[t];
      const float xs_ = sX[t * 64 + lane];
      const float xdt = xs_ * sDt[t];
      const float opv = (lane < 32) ? sB[t * 128 + w * 32 + lane] : sC[t * 128 + w * 32 + (lane - 32)];
      const int opi = __builtin_bit_cast(int, opv);
      float y = (w == 0) ? Dsk * xs_ : 0.f;
#pragma unroll
      for (int j = 0; j < 32; ++j) {
        const float bn = __builtin_bit_cast(float, __builtin_amdgcn_readlane(opi, j));
        const float cn = __builtin_bit_cast(float, __builtin_amdgcn_readlane(opi, 32 + j));
        s[j] = fmaf(s[j], dA, bn * xdt);
        y = fmaf(cn, s[j], y);
      }
      sO[(w * 16 + t) * 64 + lane] = y;
    }
    __builtin_amdgcn_sched_barrier(0);
    __syncthreads();
    {
      float4 a = *reinterpret_cast<const float4*>(sO + (0 * 16 + rt) * 64 + rp4);
      float4 bq = *reinterpret_cast<const float4*>(sO + (1 * 16 + rt) * 64 + rp4);
      float4 cq = *reinterpret_cast<const float4*>(sO + (2 * 16 + rt) * 64 + rp4);
      float4 d = *reinterpret_cast<const float4*>(sO + (3 * 16 + rt) * 64 + rp4);
      bf16_t* gp = Z + (size_t)(t0 + rt) * ZS + ZMB + hd * 64 + rp4;
      float g0 = bf2f((bf16_t)(gcur.x & 0xffff)), g1 = bf2f((bf16_t)(gcur.x >> 16));
      float g2 = bf2f((bf16_t)(gcur.y & 0xffff)), g3 = bf2f((bf16_t)(gcur.y >> 16));
      float y0 = a.x + bq.x + cq.x + d.x;
      float y1 = a.y + bq.y + cq.y + d.y;
      float y2 = a.z + bq.z + cq.z + d.z;
      float y3 = a.w + bq.w + cq.w + d.w;
      uint2 o;
      o.x = pack2(y0 * fsilu(g0), y1 * fsilu(g1));
      o.y = pack2(y2 * fsilu(g2), y3 * fsilu(g3));
      *reinterpret_cast<uint2*>(gp) = o;
    }
    if (more) MB_PROCESS();
    __syncthreads();
  }
#undef MB_LOAD
#undef MB_CONV_A
#undef MB_CONV_B
#undef MB_PROCESS
}

__device__ void s5_scan(const Params& p, int l, int task, char* smem) {
  const int tid = opaque_tid(), w = tid >> 6, lane = tid & 63;
  const int b = task >> 3, g = (task & 7) * 4 + w;
  char* base = smem + w * 6144;
  float* sU = reinterpret_cast<float*>(base);
  char* sHb = base + 1024;
  bf16_t* Z = (bf16_t*)(p.ws + OFF_Z) + (size_t)b * SEQ * ZS + ZS5 + g * 16;
  const int n = lane;
  float lr, li, bbr[16], bbi[16];
  bf16x8 Bf0, Bf1, Bf2, Bf3;
  {
    float dt = expf(p.in[I_S5_LOGDT][l * 32 + g]);
    float are = p.in[I_S5_ARE][(l * 32 + g) * 64 + n], aim = p.in[I_S5_AIM][(l * 32 + g) * 64 + n];
    float mag = expf(dt * are);
    lr = mag * cosf(dt * aim); li = mag * sinf(dt * aim);
    float den = are * are + aim * aim;
    float cr = ((lr - 1.f) * are + li * aim) / den;
    float ci = (li * are - (lr - 1.f) * aim) / den;
    const float* bre = p.in[I_S5_BRE] + ((size_t)(l * 32 + g) * 64 + n) * 16;
    const float* bim = p.in[I_S5_BIM] + ((size_t)(l * 32 + g) * 64 + n) * 16;
#pragma unroll
    for (int c = 0; c < 16; ++c) {
      float br = bre[c], bi = bim[c];
      bbr[c] = cr * br - ci * bi;
      bbi[c] = cr * bi + ci * br;
    }
    const float* cre = p.in[I_S5_CRE] + (size_t)(l * 32 + g) * 16 * 64 + (lane & 15) * 64;
    const float* cim = p.in[I_S5_CIM] + (size_t)(l * 32 + g) * 16 * 64 + (lane & 15) * 64;
#pragma unroll
    for (int j = 0; j < 8; ++j) {
      const int kb = 8 * (lane >> 4) + j;
      const int n0 = kb >> 1;
      const bool im = (j & 1);
      Bf0[j] = (short)f2bf(im ? -cim[n0] : cre[n0]);
      Bf1[j] = (short)f2bf(im ? -cim[n0 + 16] : cre[n0 + 16]);
      Bf2[j] = (short)f2bf(im ? -cim[n0 + 32] : cre[n0 + 32]);
      Bf3[j] = (short)f2bf(im ? -cim[n0 + 48] : cre[n0 + 48]);
    }
  }
  const float dsk = p.in[I_S5_D][l * 512 + g * 16 + (lane & 15)];
  const int pt = lane >> 2, pc4 = (lane & 3) * 4;
  float hr = 0.f, hi = 0.f;
  uint2 unext = *reinterpret_cast<const uint2*>(Z + (size_t)pt * ZS + pc4);
  constexpr int NCH = SEQ / 16;
#pragma unroll 1
  for (int c = 0; c < NCH; ++c) {
    const int t0 = c * 16;
    {
      const uint2 ur = unext;
      *reinterpret_cast<float4*>(sU + pt * 16 + pc4) =
          float4{bf2f((bf16_t)(ur.x & 0xffff)), bf2f((bf16_t)(ur.x >> 16)), bf2f((bf16_t)(ur.y & 0xffff)), bf2f((bf16_t)(ur.y >> 16))};
      const int tn = (c + 1 < NCH) ? t0 + 16 : t0;
      unext = *reinterpret_cast<const uint2*>(Z + (size_t)(tn + pt) * ZS + pc4);
    }
    __builtin_amdgcn_sched_barrier(0);
    __syncthreads();
#pragma unroll 2
    for (int t = 0; t < 16; ++t) {
      const float4* u4 = reinterpret_cast<const float4*>(sU + t * 16);
      float bur = 0.f, bui = 0.f;
#pragma unroll
      for (int q = 0; q < 4; ++q) {
        float4 u = u4[q];
        bur = fmaf(bbr[q * 4 + 0], u.x, bur); bui = fmaf(bbi[q * 4 + 0], u.x, bui);
        bur = fmaf(bbr[q * 4 + 1], u.y, bur); bui = fmaf(bbi[q * 4 + 1], u.y, bui);
        bur = fmaf(bbr[q * 4 + 2], u.z, bur); bui = fmaf(bbi[q * 4 + 2], u.z, bui);
        bur = fmaf(bbr[q * 4 + 3], u.w, bur); bui = fmaf(bbi[q * 4 + 3], u.w, bui);
      }
      float nr = lr * hr - li * hi + bur;
      float ni = lr * hi + li * hr + bui;
      hr = nr; hi = ni;
      *reinterpret_cast<unsigned*>(sHb + t * 272 + n * 4) = pack2(hr, hi);
    }
    __syncthreads();
    {
      f32x4 acc = f32x4{0.f, 0.f, 0.f, 0.f};
      const char* ap = sHb + (lane & 15) * 272 + (lane >> 4) * 16;
      acc = __builtin_amdgcn_mfma_f32_16x16x32_bf16(*reinterpret_cast<const bf16x8*>(ap), Bf0, acc, 0, 0, 0);
      acc = __builtin_amdgcn_mfma_f32_16x16x32_bf16(*reinterpret_cast<const bf16x8*>(ap + 64), Bf1, acc, 0, 0, 0);
      acc = __builtin_amdgcn_mfma_f32_16x16x32_bf16(*reinterpret_cast<const bf16x8*>(ap + 128), Bf2, acc, 0, 0, 0);
      acc = __builtin_amdgcn_mfma_f32_16x16x32_bf16(*reinterpret_cast<const bf16x8*>(ap + 192), Bf3, acc, 0, 0, 0);
      const int cc = lane & 15, tb = (lane >> 4) * 4;
#pragma unroll
      for (int jj = 0; jj < 4; ++jj) {
        float y = acc[jj] + dsk * sU[(tb + jj) * 16 + cc];
        Z[(size_t)(t0 + tb + jj) * ZS + cc] = f2bf(fgelu(y));
      }
    }
    __syncthreads();
  }
}

__device__ void rw_scan(const Params& p, int l, int task, char* smem) {
  const int b = task >> 3, h = task & 7;
  float* sR = reinterpret_cast<float*>(smem);
  float* sW = sR + 1024;
  float* sK = sW + 1024;
  float* sA = sK + 1024;
  float* sBb = sA + 1024;
  float* sV = sBb + 1024;
  float* sY = sV + 1024;
  float* sBonus = sY + 1024;
  const int tid = opaque_tid(), w = tid >> 6, lane = tid & 63;
  const size_t tokbase = (size_t)b * SEQ;
  bf16_t* Z = (bf16_t*)(p.ws + OFF_Z) + tokbase * ZS;
  const bf16_t* LW = (const bf16_t*)(p.ws + OFF_U) + tokbase * 512;
  const bf16_t* LA = LW + (size_t)T_TOK * 512;
  const bf16_t* VF = (const bf16_t*)(p.ws + OFF_VF) + tokbase * 512;
  const int st = tid >> 4, c4 = (tid & 15) * 4, ch = h * 64 + c4;
  float mur[4], muk[4], w0[4], a0[4], kk_[4], ka_[4], rk_[4], lnw[4], lnb[4];
#pragma unroll
  for (int e = 0; e < 4; ++e) {
    mur[e] = p.in[I_RW_MU][l * 1792 + ch + e];
    muk[e] = p.in[I_RW_MU][l * 1792 + 512 + ch + e];
    w0[e] = p.in[I_RW_W0][l * 512 + ch + e];
    a0[e] = p.in[I_RW_A0][l * 512 + ch + e];
    kk_[e] = p.in[I_RW_KK][l * 512 + ch + e];
    ka_[e] = p.in[I_RW_KA][l * 512 + ch + e];
    rk_[e] = p.in[I_RW_RK][l * 512 + ch + e];
    lnw[e] = p.in[I_RW_LNW][l * 512 + ch + e];
    lnb[e] = p.in[I_RW_LNB][l * 512 + ch + e];
  }
  const int rg = lane >> 3, kq = lane & 7, vrow = w * 16 + rg * 2;
  float S0[8], S1[8];
#pragma unroll
  for (int j = 0; j < 8; ++j) { S0[j] = 0.f; S1[j] = 0.f; }
  uint2 rc, kc, rp, kp, lwv, lav, vfv;
#define RW_LOAD(T0)                                                                                 \
  {                                                                                                 \
    const int s_ = (T0) + st;                                                                       \
    const bf16_t* zr = Z + (size_t)s_ * ZS + ZRW + ch;                                              \
    rc = *reinterpret_cast<const uint2*>(zr);                                                       \
    kc = *reinterpret_cast<const uint2*>(zr + 512);                                                 \
    rp = uint2{0u, 0u}; kp = uint2{0u, 0u};                                                         \
    if (s_ > 0) { rp = *reinterpret_cast<const uint2*>(zr - ZS); kp = *reinterpret_cast<const uint2*>(zr - ZS + 512); } \
    lwv = *reinterpret_cast<const uint2*>(LW + (size_t)s_ * 512 + ch);                              \
    lav = *reinterpret_cast<const uint2*>(LA + (size_t)s_ * 512 + ch);                              \
    vfv = *reinterpret_cast<const uint2*>(VF + (size_t)s_ * 512 + ch);                              \
  }
#define RW_PROCESS()                                                                                \
  {                                                                                                 \
    float r4[4], k4[4], kkv[4], av[4], wv[4], vv[4];                                                \
    float n2 = 0.f;                                                                                 \
    _Pragma("unroll") for (int e = 0; e < 4; ++e) {                                                 \
      unsigned rcw = (e < 2) ? rc.x : rc.y, kcw = (e < 2) ? kc.x : kc.y, rpw = (e < 2) ? rp.x : rp.y, kpw = (e < 2) ? kp.x : kp.y; \
      unsigned lww = (e < 2) ? lwv.x : lwv.y, law = (e < 2) ? lav.x : lav.y, vfw = (e < 2) ? vfv.x : vfv.y; \
      int sh = (e & 1) * 16;                                                                        \
      float rcur = bf2f((bf16_t)((rcw >> sh) & 0xffff)), rprev = bf2f((bf16_t)((rpw >> sh) & 0xffff)); \
      float kcur = bf2f((bf16_t)((kcw >> sh) & 0xffff)), kprev = bf2f((bf16_t)((kpw >> sh) & 0xffff)); \
      float lwf = bf2f((bf16_t)((lww >> sh) & 0xffff)), laf = bf2f((bf16_t)((law >> sh) & 0xffff)); \
      vv[e] = bf2f((bf16_t)((vfw >> sh) & 0xffff));                                                 \
      r4[e] = rcur + (rprev - rcur) * mur[e];                                                       \
      k4[e] = kcur + (kprev - kcur) * muk[e];                                                       \
      float wlog = -fsoftplus(-(w0[e] + lwf)) - 0.5f;                                               \
      wv[e] = __expf(-__expf(wlog));                                                                \
      av[e] = fsigmoid(a0[e] + laf);                                                                \
      kkv[e] = k4[e] * kk_[e];                                                                      \
      n2 += kkv[e] * kkv[e];                                                                        \
    }                                                                                               \
    n2 = sum16(n2);                                                                                 \
    float inv = 1.f / fmaxf(sqrtf(n2), 1e-12f);                                                     \
    float bon = 0.f;                                                                                \
    float kt4[4], ap4[4], bp4[4];                                                                   \
    _Pragma("unroll") for (int e = 0; e < 4; ++e) {                                                 \
      float kkn = kkv[e] * inv;                                                                     \
      kt4[e] = k4[e] * (1.f + (av[e] - 1.f) * ka_[e]);                                              \
      ap4[e] = -kkn;                                                                                \
      bp4[e] = kkn * av[e];                                                                         \
      bon += r4[e] * kt4[e] * rk_[e];                                                               \
    }                                                                                               \
    bon = sum16(bon);                                                                               \
    *reinterpret_cast<float4*>(sR + st * 64 + c4) = float4{r4[0], r4[1], r4[2], r4[3]};             \
    *reinterpret_cast<float4*>(sW + st * 64 + c4) = float4{wv[0], wv[1], wv[2], wv[3]};             \
    *reinterpret_cast<float4*>(sK + st * 64 + c4) = float4{kt4[0], kt4[1], kt4[2], kt4[3]};         \
    *reinterpret_cast<float4*>(sA + st * 64 + c4) = float4{ap4[0], ap4[1], ap4[2], ap4[3]};         \
    *reinterpret_cast<float4*>(sBb + st * 64 + c4) = float4{bp4[0], bp4[1], bp4[2], bp4[3]};        \
    *reinterpret_cast<float4*>(sV + st * 64 + c4) = float4{vv[0], vv[1], vv[2], vv[3]};             \
    if ((tid & 15) == 0) sBonus[st] = bon;                                                          \
  }
  RW_LOAD(0);
  RW_PROCESS();
  __syncthreads();
  constexpr int NCH = SEQ / 16;
#pragma unroll 1
  for (int c = 0; c < NCH; ++c) {
    const int t0 = c * 16;
    const int tn = (c + 1 < NCH) ? t0 + 16 : t0;
    RW_LOAD(tn);
    __builtin_amdgcn_sched_barrier(0);
#pragma unroll 2
    for (int t = 0; t < 16; ++t) {
      const float4* a4p = reinterpret_cast<const float4*>(sA + t * 64 + kq * 8);
      const float4* w4p = reinterpret_cast<const float4*>(sW + t * 64 + kq * 8);
      const float4* b4p = reinterpret_cast<const float4*>(sBb + t * 64 + kq * 8);
      const float4* k4p = reinterpret_cast<const float4*>(sK + t * 64 + kq * 8);
      const float4* r4p = reinterpret_cast<const float4*>(sR + t * 64 + kq * 8);
      const float2 vv = *reinterpret_cast<const float2*>(sV + t * 64 + vrow);
      float sa0 = 0.f, sa1 = 0.f;
#pragma unroll
      for (int q = 0; q < 2; ++q) {
        float4 a = a4p[q];
        sa0 = fmaf(S0[q * 4 + 0], a.x, sa0); sa1 = fmaf(S1[q * 4 + 0], a.x, sa1);
        sa0 = fmaf(S0[q * 4 + 1], a.y, sa0); sa1 = fmaf(S1[q * 4 + 1], a.y, sa1);
        sa0 = fmaf(S0[q * 4 + 2], a.z, sa0); sa1 = fmaf(S1[q * 4 + 2], a.z, sa1);
        sa0 = fmaf(S0[q * 4 + 3], a.w, sa0); sa1 = fmaf(S1[q * 4 + 3], a.w, sa1);
      }
      sa0 = oct_sum(sa0); sa1 = oct_sum(sa1);
      float y0 = 0.f, y1 = 0.f;
#pragma unroll
      for (int q = 0; q < 2; ++q) {
        float4 ww = w4p[q], bb = b4p[q], kk = k4p[q], rr = r4p[q];
        S0[q * 4 + 0] = fmaf(S0[q * 4 + 0], ww.x, fmaf(sa0, bb.x, vv.x * kk.x)); y0 = fmaf(S0[q * 4 + 0], rr.x, y0);
        S1[q * 4 + 0] = fmaf(S1[q * 4 + 0], ww.x, fmaf(sa1, bb.x, vv.y * kk.x)); y1 = fmaf(S1[q * 4 + 0], rr.x, y1);
        S0[q * 4 + 1] = fmaf(S0[q * 4 + 1], ww.y, fmaf(sa0, bb.y, vv.x * kk.y)); y0 = fmaf(S0[q * 4 + 1], rr.y, y0);
        S1[q * 4 + 1] = fmaf(S1[q * 4 + 1], ww.y, fmaf(sa1, bb.y, vv.y * kk.y)); y1 = fmaf(S1[q * 4 + 1], rr.y, y1);
        S0[q * 4 + 2] = fmaf(S0[q * 4 + 2], ww.z, fmaf(sa0, bb.z, vv.x * kk.z)); y0 = fmaf(S0[q * 4 + 2], rr.z, y0);
        S1[q * 4 + 2] = fmaf(S1[q * 4 + 2], ww.z, fmaf(sa1, bb.z, vv.y * kk.z)); y1 = fmaf(S1[q * 4 + 2], rr.z, y1);
        S0[q * 4 + 3] = fmaf(S0[q * 4 + 3], ww.w, fmaf(sa0, bb.w, vv.x * kk.w)); y0 = fmaf(S0[q * 4 + 3], rr.w, y0);
        S1[q * 4 + 3] = fmaf(S1[q * 4 + 3], ww.w, fmaf(sa1, bb.w, vv.y * kk.w)); y1 = fmaf(S1[q * 4 + 3], rr.w, y1);
      }
      y0 = oct_sum(y0); y1 = oct_sum(y1);
      if (kq == 0) *reinterpret_cast<float2*>(sY + t * 64 + vrow) = float2{y0, y1};
    }
    __builtin_amdgcn_sched_barrier(0);
    __syncthreads();
    {
      float4 y4 = *reinterpret_cast<const float4*>(sY + st * 64 + c4);
      float4 v4 = *reinterpret_cast<const float4*>(sV + st * 64 + c4);
      float bon = sBonus[st];
      float mean = sum16(y4.x + y4.y + y4.z + y4.w) * (1.f / 64.f);
      float dx = y4.x - mean, dy = y4.y - mean, dz = y4.z - mean, dw = y4.w - mean;
      float var = sum16(dx * dx + dy * dy + dz * dz + dw * dw) * (1.f / 64.f);
      float rs = rsqrtf(var + 64e-5f);
      float o0 = dx * rs * lnw[0] + lnb[0] + bon * v4.x;
      float o1 = dy * rs * lnw[1] + lnb[1] + bon * v4.y;
      float o2 = dz * rs * lnw[2] + lnb[2] + bon * v4.z;
      float o3 = dw * rs * lnw[3] + lnb[3] + bon * v4.w;
      uint2 o;
      o.x = pack2(o0, o1); o.y = pack2(o2, o3);
      *reinterpret_cast<uint2*>(Z + (size_t)(t0 + st) * ZS + ZRW + 1024 + ch) = o;
    }
    RW_PROCESS();
    __syncthreads();
  }
#undef RW_LOAD
#undef RW_PROCESS
}

__device__ void phase_scans(const Params& p, int l, char* smem, int scan_mask = 15) {
  for (int t = blockIdx.x; t < 256; t += gridDim.x) {
    int type = t & 3, idx = t >> 2;
    if (!((scan_mask >> type) & 1)) continue;
#ifndef SCM
#define SCM 15
#endif
    if (type == 0) { if (SCM & 1) rw_scan(p, l, idx, smem); }
    else if (type == 1) { if (SCM & 2) hg_scan(p, l, idx, smem); }
    else if (type == 2) { if (SCM & 4) mb_scan(p, l, idx, smem); }
    else { if (SCM & 8) s5_scan(p, l, idx, smem); }
    __syncthreads();
  }
  if (l == 0) {
    const int tid = opaque_tid();
    const int nb = (gridDim.x > 256) ? (int)gridDim.x - 256 : (int)gridDim.x;
    const int b0 = (gridDim.x > 256) ? (int)blockIdx.x - 256 : (int)blockIdx.x;
    constexpr int NREST = CT_TOTAL - (CT_IN - 1024);
    if (b0 >= 0)
      for (int c = b0; c < NREST + CT_TOTAL; c += nb) {
        if (c < NREST) convert_one(p, 0, (c < 1024) ? c : c + (CT_IN - 1024), smem, tid);
        else convert_one(p, 1, c - NREST, smem, tid);
      }
  }
}


__device__ void phase_post(const Params& p, int l, char* smem) {
  bf16_t* Z = (bf16_t*)(p.ws + OFF_Z);
  const int tid = opaque_tid(), lane = tid & 63, wid = tid >> 6;
  constexpr int N_ROWT = T_TOK / 4, N_RWT = T_TOK / 16, N_GLU = 128 * 4, N_NORM = T_TOK / 4;
  const float* xsrc = (l == 0) ? p.in[I_X] : p.out;
  for (int t = blockIdx.x; t < N_ROWT + N_RWT + N_GLU + N_NORM; t += gridDim.x) {
    if (t < N_ROWT) {
      const int row = t * 4 + wid;
      {
        bf16_t* op = Z + (size_t)row * ZS + ZHG + 1024 + lane * 8;
        uint4 ov = *reinterpret_cast<const uint4*>(op);
        uint4 gv = *reinterpret_cast<const uint4*>(op + 512);
        float o[8], g[8];
        unpack8(ov, o); unpack8(gv, g);
        float ss = 0.f;
#pragma unroll
        for (int e = 0; e < 8; ++e) ss += o[e] * o[e];
        ss = sum16(ss);
        float rstd = rsqrtf(ss * (1.f / 128.f) + 1e-6f);
        const float* nw = p.in[I_HG_NW] + l * 512 + lane * 8;
        float r[8];
#pragma unroll
        for (int e = 0; e < 8; ++e) r[e] = o[e] * rstd * nw[e] * siluf_(g[e]);
        *reinterpret_cast<uint4*>(op) = uint4{pack2(r[0], r[1]), pack2(r[2], r[3]), pack2(r[4], r[5]), pack2(r[6], r[7])};
      }
      {
        bf16_t* op = Z + (size_t)row * ZS + ZMB + lane * 8;
        uint4 ov = *reinterpret_cast<const uint4*>(op);
        float o[8];
        unpack8(ov, o);
        float ss = 0.f;
#pragma unroll
        for (int e = 0; e < 8; ++e) ss += o[e] * o[e];
        ss = sum64(ss);
        float rstd = rsqrtf(ss * (1.f / 512.f) + 1e-6f);
        const float* nw = p.in[I_MB_NW] + l * 512 + lane * 8;
        float r[8];
#pragma unroll
        for (int e = 0; e < 8; ++e) r[e] = o[e] * rstd * nw[e];
        *reinterpret_cast<uint4*>(op) = uint4{pack2(r[0], r[1]), pack2(r[2], r[3]), pack2(r[4], r[5]), pack2(r[6], r[7])};
      }
    } else if (t < N_ROWT + N_RWT) {
      const int row0 = (t - N_ROWT) * 16;
      char* sXg = smem;
      const float* mu = p.in[I_RW_MU] + l * 1792 + 1664;
      {
        const int tok = tid >> 4, j8 = (tid & 15) * 8;
        const int row = row0 + tok, sq = row & (SEQ - 1);
        const bf16_t* zp = Z + (size_t)row * ZS + ZRW + 1664 + j8;
        const uint4 cur = *reinterpret_cast<const uint4*>(zp);
        uint4 prev = uint4{0u, 0u, 0u, 0u};
        if (sq > 0) prev = *reinterpret_cast<const uint4*>(zp - ZS);
        float z[8];
        rw_shift8(cur, prev, mu + j8, z);
        *reinterpret_cast<uint4*>(sXg + tok * 272 + j8 * 2) =
            uint4{pack2(fsigmoid(z[0]), fsigmoid(z[1])), pack2(fsigmoid(z[2]), fsigmoid(z[3])),
                  pack2(fsigmoid(z[4]), fsigmoid(z[5])), pack2(fsigmoid(z[6]), fsigmoid(z[7]))};
      }
      __syncthreads();
      f32x4 acc[8];
      lora_mfma<128>(sXg, 272, (const bf16_t*)(p.ws + OFF_LORA + (size_t)l * LORA_STRIDE + LO_G2), acc, tid);
#pragma unroll
      for (int i = 0; i < 8; ++i) {
        bf16_t* yp = Z + (size_t)(row0 + (lane & 15)) * ZS + ZRW + 1024 + (wid * 8 + i) * 16 + (lane >> 4) * 4;
        const uint2 yr = *reinterpret_cast<const uint2*>(yp);
        uint2 o;
        o.x = pack2(bf2f((bf16_t)(yr.x & 0xffff)) * acc[i][0], bf2f((bf16_t)(yr.x >> 16)) * acc[i][1]);
        o.y = pack2(bf2f((bf16_t)(yr.y & 0xffff)) * acc[i][2], bf2f((bf16_t)(yr.y >> 16)) * acc[i][3]);
        *reinterpret_cast<uint2*>(yp) = o;
      }
      __syncthreads();
    } else if (t < N_ROWT + N_RWT + N_GLU) {
      const int tt = t - N_ROWT - N_RWT, mt = tt >> 2, nt = tt & 3;
      const int wm = wid >> 1, wn = wid & 1;
      f32x4 acc[4][4];
      zero_acc<128>(acc);
      gemm_mainloop<128>(acc, Z + ZS5, ZS, mt * 128, (const bf16_t*)(p.ws + WOFF(OFF_WTGLU, l)), 512, nt * 128, 511, 512, smem, tid);
      const float* bg = p.in[I_S5_BGLU] + l * 512;
#pragma unroll
      for (int mi = 0; mi < 4; ++mi)
#pragma unroll
        for (int ni = 0; ni < 4; ++ni) {
          int col = nt * 128 + wn * 64 + ni * 16 + (lane >> 4) * 4;
          int row = mt * 128 + wm * 64 + mi * 16 + (lane & 15);
          float4 b4 = *reinterpret_cast<const float4*>(bg + col);
          uint2 yv = *reinterpret_cast<const uint2*>(Z + (size_t)row * ZS + ZS5 + col);
          float y0 = bf2f((bf16_t)(yv.x & 0xffff)), y1 = bf2f((bf16_t)(yv.x >> 16));
          float y2 = bf2f((bf16_t)(yv.y & 0xffff)), y3 = bf2f((bf16_t)(yv.y >> 16));
          uint2 o;
          o.x = pack2(y0 * sigmoidf_(acc[mi][ni][0] + b4.x), y1 * sigmoidf_(acc[mi][ni][1] + b4.y));
          o.y = pack2(y2 * sigmoidf_(acc[mi][ni][2] + b4.z), y3 * sigmoidf_(acc[mi][ni][3] + b4.w));
          *reinterpret_cast<uint2*>(Z + (size_t)row * ZS + ZMB + 1024 + col) = o;
        }
    } else {
      const int row = (t - N_ROWT - N_RWT - N_GLU) * 4 + wid;
      rmsnorm_row_to_bf16(xsrc + (size_t)row * DM, p.in[I_NORM_MIX] + l * DM, (bf16_t*)(p.ws + OFF_U) + (size_t)row * DM, tid & 63);
    }
  }
}

__device__ void phase_merge(const Params& p, int l, char* smem) {
  bf16_t* Z = (bf16_t*)(p.ws + OFF_Z);
  const bf16_t* U = (const bf16_t*)(p.ws + OFF_U);
  const bf16_t* Wg = (const bf16_t*)(p.ws + WOFF_GATE(l));
  const bf16_t* Wb = (const bf16_t*)(p.ws + WOFF(OFF_WTBR, l));
  const int tid = opaque_tid();
  const int lane = tid & 63, wid = tid >> 6, wm = wid >> 1, wn = wid & 1;
  for (int t = blockIdx.x; t < tile_count(128, 8); t += gridDim.x) {
    int mt, nt;
    if (!tile_map(t, 8, mt, nt)) continue;
    f32x4 accm[4][4];
    zero_acc<128>(accm);
    f32x4 a1[4][4];
    zero_acc<128>(a1);
    uint2 sg[4][4];
#pragma unroll
    for (int mi = 0; mi < 4; ++mi)
#pragma unroll
      for (int ni = 0; ni < 4; ++ni) sg[mi][ni] = uint2{0u, 0u};
#pragma unroll 1
    for (int sub = 0; sub < 8; ++sub) {
      const int kb = sub >> 1, which = sub & 1;
      const int ycol = (kb == 0) ? (ZHG + 1024) : (kb == 1) ? (ZRW + 1024) : (kb == 2) ? (ZMB + 1024) : ZMB;
      const bf16_t* Ap = which ? (const bf16_t*)(Z + ycol) : U;
      const int ldap = which ? ZS : 1024;
      const bf16_t* Bp = which ? (Wb + (size_t)kb * 1024 * 512) : (Wg + (size_t)kb * 1024 * 1024);
      const int Kp = which ? 512 : 1024;
      gemm_mainloop_glds<128>(a1, Ap, ldap, mt * 128, Bp, Kp, nt * 128, 1023, Kp, smem, tid);
      if (which == 0) {
#pragma unroll
        for (int mi = 0; mi < 4; ++mi)
#pragma unroll
          for (int ni = 0; ni < 4; ++ni) {
            sg[mi][ni].x = pack2(fsigmoid(a1[mi][ni][0]), fsigmoid(a1[mi][ni][1]));
            sg[mi][ni].y = pack2(fsigmoid(a1[mi][ni][2]), fsigmoid(a1[mi][ni][3]));
            a1[mi][ni] = f32x4{0.f, 0.f, 0.f, 0.f};
          }
      } else {
#pragma unroll
        for (int mi = 0; mi < 4; ++mi)
#pragma unroll
          for (int ni = 0; ni < 4; ++ni) {
            accm[mi][ni][0] = fmaf(bf2f((bf16_t)(sg[mi][ni].x & 0xffff)), a1[mi][ni][0], accm[mi][ni][0]);
            accm[mi][ni][1] = fmaf(bf2f((bf16_t)(sg[mi][ni].x >> 16)), a1[mi][ni][1], accm[mi][ni][1]);
            accm[mi][ni][2] = fmaf(bf2f((bf16_t)(sg[mi][ni].y & 0xffff)), a1[mi][ni][2], accm[mi][ni][2]);
            accm[mi][ni][3] = fmaf(bf2f((bf16_t)(sg[mi][ni].y >> 16)), a1[mi][ni][3], accm[mi][ni][3]);
            a1[mi][ni] = f32x4{0.f, 0.f, 0.f, 0.f};
          }
      }
    }
#pragma unroll
    for (int mi = 0; mi < 4; ++mi)
#pragma unroll
      for (int np = 0; np < 2; ++np) {
        const int colb = nt * 128 + wn * 64 + np * 32;
        const int row = mt * 128 + wm * 64 + mi * 16 + (lane & 15);
        uint2 a, b;
        a.x = pack2(accm[mi][2 * np][0], accm[mi][2 * np][1]);
        a.y = pack2(accm[mi][2 * np][2], accm[mi][2 * np][3]);
        b.x = pack2(accm[mi][2 * np + 1][0], accm[mi][2 * np + 1][1]);
        b.y = pack2(accm[mi][2 * np + 1][2], accm[mi][2 * np + 1][3]);
        store_pair_bf16(Z + (size_t)row * ZS + colb, lane, a, b);
      }
  }
}

__device__ void phase_resid_gemm(const Params& p, const bf16_t* A, int lda, const bf16_t* Wt, int K, const float* xold, char* smem) {
  const int tid = opaque_tid();
  const int lane = tid & 63, wid = tid >> 6, wm = wid >> 1, wn = wid & 1;
  for (int t = blockIdx.x; t < tile_count(64, 8); t += gridDim.x) {
    int mt, nt;
    if (!tile_map(t, 8, mt, nt)) continue;
    f32x4 acc[8][4];
    zero_acc_big(acc);
    gemm_mainloop_big(acc, A, lda, mt * 256, Wt, K, nt * 128, 1023, K, smem, tid);
#pragma unroll
    for (int mi = 0; mi < 8; ++mi)
#pragma unroll
      for (int ni = 0; ni < 4; ++ni) {
        int col = nt * 128 + wn * 64 + ni * 16 + (lane >> 4) * 4;
        int row = mt * 256 + wm * 128 + mi * 16 + (lane & 15);
        size_t o = (size_t)row * DM + col;
        float4 xo = *reinterpret_cast<const float4*>(xold + o);
        float4 r = float4{xo.x + acc[mi][ni][0], xo.y + acc[mi][ni][1], xo.z + acc[mi][ni][2], xo.w + acc[mi][ni][3]};
        *reinterpret_cast<float4*>(p.out + o) = r;
      }
  }
}

__device__ void phase_ffn_in(const Params& p, int l, char* smem) {
  const bf16_t* U = (const bf16_t*)(p.ws + OFF_U);
  const bf16_t* Wt = (const bf16_t*)(p.ws + WOFF(OFF_WTF1, l));
  bf16_t* H = (bf16_t*)(p.ws + OFF_Z);
  const int tid = opaque_tid();
  const int lane = tid & 63, wid = tid >> 6, wm = wid >> 1, wn = wid & 1;
  for (int t = blockIdx.x; t < tile_count(64, 40); t += gridDim.x) {
    int mt, nt;
    if (!tile_map(t, 40, mt, nt)) continue;
    f32x4 acc[8][4];
    zero_acc_big(acc);
    gemm_mainloop_big(acc, U, 1024, mt * 256, Wt, 1024, nt * 128, 5631, 1024, smem, tid);
#pragma unroll
    for (int mi = 0; mi < 8; ++mi) {
      const int hcolb = (nt * 128 + wn * 64) >> 1;
      const int row = mt * 256 + wm * 128 + mi * 16 + (lane & 15);
      uint2 o0, o1;
      o0.x = pack2(fsilu(acc[mi][0][0]) * acc[mi][1][0], fsilu(acc[mi][0][1]) * acc[mi][1][1]);
      o0.y = pack2(fsilu(acc[mi][0][2]) * acc[mi][1][2], fsilu(acc[mi][0][3]) * acc[mi][1][3]);
      o1.x = pack2(fsilu(acc[mi][2][0]) * acc[mi][3][0], fsilu(acc[mi][2][1]) * acc[mi][3][1]);
      o1.y = pack2(fsilu(acc[mi][2][2]) * acc[mi][3][2], fsilu(acc[mi][2][3]) * acc[mi][3][3]);
      store_pair_bf16(H + (size_t)row * FFH + hcolb, lane, o0, o1);
    }
  }
  for (int t2 = blockIdx.x; t2 < 512; t2 += gridDim.x) {
    const int nt = 40 + (t2 & 3), mt = t2 >> 2;
    f32x4 acc[4][4];
    zero_acc<128>(acc);
    gemm_mainloop_glds<128>(acc, U, 1024, mt * 128, Wt, 1024, nt * 128, 5631, 1024, smem, tid);
#pragma unroll
    for (int mi = 0; mi < 4; ++mi) {
      const int hcolb = (nt * 128 + wn * 64) >> 1;
      const int row = mt * 128 + wm * 64 + mi * 16 + (lane & 15);
      uint2 o0, o1;
      o0.x = pack2(fsilu(acc[mi][0][0]) * acc[mi][1][0], fsilu(acc[mi][0][1]) * acc[mi][1][1]);
      o0.y = pack2(fsilu(acc[mi][0][2]) * acc[mi][1][2], fsilu(acc[mi][0][3]) * acc[mi][1][3]);
      o1.x = pack2(fsilu(acc[mi][2][0]) * acc[mi][3][0], fsilu(acc[mi][2][1]) * acc[mi][3][1]);
      o1.y = pack2(fsilu(acc[mi][2][2]) * acc[mi][3][2], fsilu(acc[mi][2][3]) * acc[mi][3][3]);
      store_pair_bf16(H + (size_t)row * FFH + hcolb, lane, o0, o1);
    }
  }
}

__device__ void phase_final(const Params& p) {
  const int tid = opaque_tid();
  const int lane = tid & 63;
  const float* w = p.in[I_NORM_FINAL];
  for (int t = blockIdx.x; t < T_TOK / 4; t += gridDim.x) {
    int row = t * 4 + (tid >> 6);
    float* x = p.out + (size_t)row * DM;
    float4 v[4];
    float ss = 0.f;
#pragma unroll
    for (int i = 0; i < 4; ++i) {
      v[i] = *reinterpret_cast<const float4*>(x + i * 256 + lane * 4);
      ss += v[i].x * v[i].x + v[i].y * v[i].y + v[i].z * v[i].z + v[i].w * v[i].w;
    }
    ss = sum64(ss);
    float rstd = rsqrtf(ss * (1.f / 1024.f) + 1e-6f);
#pragma unroll
    for (int i = 0; i < 4; ++i) {
      float4 ww = *reinterpret_cast<const float4*>(w + i * 256 + lane * 4);
      float4 o = float4{v[i].x * rstd * ww.x, v[i].y * rstd * ww.y, v[i].z * rstd * ww.z, v[i].w * rstd * ww.w};
      *reinterpret_cast<float4*>(x + i * 256 + lane * 4) = o;
    }
  }
}

template <int SUB>
__device__ __forceinline__ void run_phase(const Params& p, int l, char* smem) {
  if (SUB == 0) phase_convert_norm(p, l, smem);
  else if (SUB == 1) phase_inproj(p, smem);
  else if (SUB == 2) phase_rwprep(p, l, smem);
  else if (SUB == 3) phase_scans(p, l, smem);
  else if (SUB == 4) phase_post(p, l, smem);
  else if (SUB == 5) phase_merge(p, l, smem);
  else if (SUB == 6) phase_resid_gemm(p, (const bf16_t*)(p.ws + OFF_Z), ZS, (const bf16_t*)(p.ws + WOFF(OFF_WTOUT, l)), 1024,
                                      (l == 0) ? p.in[I_X] : p.out, smem);
  else if (SUB == 7) phase_norm_only(p, p.out, p.in[I_NORM_FFN] + l * DM);
  else if (SUB == 8) phase_ffn_in(p, l, smem);
  else if (SUB == 9) phase_resid_gemm(p, (const bf16_t*)(p.ws + OFF_Z), FFH, (const bf16_t*)(p.ws + WOFF(OFF_WTF2, l)), FFH, p.out, smem);
  else phase_final(p);
}

#ifndef PHM
#define PHM 0xFFFF
#endif
#define XB_TMO      128
#define XB_XCNT(j)  (256  + 64 * (j))
#define XB_XSUB(j)  (1280 + 64 * (j))
#define XB_XGEN(j)  (2304 + 64 * (j))
#define XB_TOP      3328
#define XB_TOPGEN   3392
#define XCD_BAR_WORDS 3456
#define XB_SPIN_CAP (1u << 18)
#define LAS __attribute__((address_space(3)))

__device__ __forceinline__ unsigned xb_ld(unsigned* p)              { return __hip_atomic_load(p, __ATOMIC_RELAXED, __HIP_MEMORY_SCOPE_AGENT); }
__device__ __forceinline__ unsigned xb_add(unsigned* p, unsigned v) { return __hip_atomic_fetch_add(p, v, __ATOMIC_RELAXED, __HIP_MEMORY_SCOPE_AGENT); }
__device__ __forceinline__ unsigned xb_xcc_id() { return (unsigned)__builtin_amdgcn_s_getreg((3 << 11) | 20) & 0xFu; }
#define XB_SPIN(cond, bar) do { unsigned _sp = 0; while (cond) { __builtin_amdgcn_s_sleep(8); \
    if ((++_sp & 255u) == 0u) { if (xb_ld(&(bar)[XB_TMO])) break; if (_sp > XB_SPIN_CAP) { atomicAdd(&(bar)[XB_TMO], 1u); break; } } } } while (0)

struct XcdBarrier {
    unsigned* bar; unsigned x;
    volatile LAS unsigned* st;
};

__device__ __forceinline__ XcdBarrier xcd_barrier_post(unsigned* bar, volatile LAS unsigned* st) {
    XcdBarrier b; b.bar = bar; b.x = xb_xcc_id(); b.st = st;
    if (threadIdx.x == 0) (void)xb_add(&bar[XB_XCNT(b.x)], 1u);
    return b;
}
__device__ __forceinline__ void xcd_barrier_complete(unsigned* bar, unsigned x, unsigned& nloc, unsigned& nx) {
    const unsigned G = gridDim.x * gridDim.y * gridDim.z;
    unsigned sum, cnt, mine, sp = 0u;
    for (;;) {
        sum = 0u; cnt = 0u; mine = 0u;
#pragma unroll
        for (unsigned j = 0; j < 16; ++j) { const unsigned c = xb_ld(&bar[XB_XCNT(j)]); sum += c; cnt += (c > 0u) ? 1u : 0u; mine = (j == x) ? c : mine; }
        if (sum == G) break;
        __builtin_amdgcn_s_sleep(1);
        if ((++sp & 255u) == 0u) { if (xb_ld(&bar[XB_TMO])) break; if (sp > XB_SPIN_CAP) { atomicAdd(&bar[XB_TMO], 1u); break; } }
    }
    nloc = mine > 0u ? mine : 1u; nx = cnt > 0u ? cnt : 1u;
}

__device__ __forceinline__ void xcd_barrier(const XcdBarrier& b) {
    asm volatile("s_waitcnt vmcnt(0)" ::: "memory");
    __syncthreads();
    if (threadIdx.x == 0) {
        unsigned* bar = b.bar;
        __builtin_amdgcn_s_waitcnt(0);
        unsigned nloc = b.st[0], nx = b.st[1];
        if (nloc == 0u) { xcd_barrier_complete(bar, b.x, nloc, nx); b.st[0] = nloc; b.st[1] = nx; }
        const unsigned old = xb_add(&bar[XB_XSUB(b.x)], 1u);
        const unsigned gen = old / nloc;
        if (old + 1u == (gen + 1u) * nloc) {
            __builtin_amdgcn_fence(__ATOMIC_RELEASE, "agent");
            asm volatile("s_waitcnt vmcnt(0)" ::: "memory");
            const unsigned og = xb_add(&bar[XB_TOP], 1u);
            const unsigned tg = og / nx;
            if (og + 1u == (tg + 1u) * nx) xb_add(&bar[XB_TOPGEN], 1u);
            else XB_SPIN(xb_ld(&bar[XB_TOPGEN]) == tg, bar);
            __builtin_amdgcn_fence(__ATOMIC_ACQUIRE, "agent");
            xb_add(&bar[XB_XGEN(b.x)], 1u);
            asm volatile("s_waitcnt vmcnt(0)" ::: "memory");
        } else {
            XB_SPIN(xb_ld(&bar[XB_XGEN(b.x)]) == gen, bar);
            __builtin_amdgcn_fence(__ATOMIC_ACQUIRE, "agent");
            asm volatile("s_waitcnt vmcnt(0)" ::: "memory");
        }
    }
    __syncthreads();
}


constexpr int LDS_MAIN = 73728;
constexpr int LDS_BYTES = LDS_MAIN + 16;

#if COOP
__global__ void __launch_bounds__(256, 2) fwd_kernel(Params p, int ph0, int ph1, int scan_mask) {
  extern __shared__ __attribute__((aligned(16))) char smem[];
  cg::grid_group grid = cg::this_grid();
  volatile LAS unsigned* xb_st = (volatile LAS unsigned*)(smem + LDS_MAIN);
  if (threadIdx.x == 0) { xb_st[0] = 0u; xb_st[1] = 0u; xb_st[2] = 0u; xb_st[3] = 0u; }
  __syncthreads();
  XcdBarrier xbar = xcd_barrier_post(reinterpret_cast<unsigned*>(p.ws + OFF_BAR), xb_st);
  for (int ph = ph0; ph < ph1; ++ph) {
    if (ph == NPHASES - 1) {
      phase_final(p);
    } else {
      const int l = ph / NPH_LAYER, sub = ph % NPH_LAYER;
      switch (sub) {
        case 0: if (PHM & (1<<0)) run_phase<0>(p, l, smem); break;
        case 1: if (PHM & (1<<1)) run_phase<1>(p, l, smem); break;
        case 2: if (PHM & (1<<2)) run_phase<2>(p, l, smem); break;
        case 3: if (PHM & (1<<3)) phase_scans(p, l, smem, scan_mask); break;
        case 4: if (PHM & (1<<4)) run_phase<4>(p, l, smem); break;
        case 5: if (PHM & (1<<5)) run_phase<5>(p, l, smem); break;
        case 6: if (PHM & (1<<6)) run_phase<6>(p, l, smem); break;
        case 7: if (PHM & (1<<7)) run_phase<7>(p, l, smem); break;
        case 8: if (PHM & (1<<8)) run_phase<8>(p, l, smem); break;
        case 9: if (PHM & (1<<9)) run_phase<9>(p, l, smem); break;
      }
    }
    if (ph + 1 < ph1) {
      if (ph1 > 1000) grid.sync();
      else xcd_barrier(xbar);
    }
  }
}
#else
template <int SUB>
__global__ void __launch_bounds__(256, 2) k_phase(Params p, int l) {
  __shared__ __attribute__((aligned(16))) char smem[65536];
  run_phase<SUB>(p, l, smem);
}
#endif

extern "C" void kernel_launch(void* const* d_in, const int* in_sizes, int n_in, void* d_out, int out_size, void* d_ws,
                              size_t ws_size, hipStream_t stream) {
  if (n_in < 41 || ws_size < WS_NEED) {
    fprintf(stderr, "kernel_launch: bad args n_in=%d ws=%zu need=%zu\n", n_in, ws_size, (size_t)WS_NEED);
    return;
  }
  Params p{};
  for (int i = 0; i < 41; ++i) p.in[i] = (const float*)d_in[i];
  p.out = (float*)d_out;
  p.ws = (char*)d_ws;
#if COOP
  static int grid_blocks = 0;
  if (!grid_blocks) {
    int dev = 0, cus = 0, per_cu = 0;
    hipGetDevice(&dev);
    hipDeviceGetAttribute(&cus, hipDeviceAttributeMultiprocessorCount, dev);
    hipFuncSetAttribute((const void*)fwd_kernel, hipFuncAttributeMaxDynamicSharedMemorySize, LDS_BYTES);
    hipOccupancyMaxActiveBlocksPerMultiprocessor(&per_cu, fwd_kernel, 256, LDS_BYTES);
    if (per_cu > 2) per_cu = 2;
    grid_blocks = cus * per_cu;
  }
#ifdef HYBRID
  for (int ph = 0; ph < NPHASES; ++ph) {
    if (ph % 10 == 3 && ph < 20) {
      const int groups[4] = SCAN_GROUPS;
      for (int gi = 0; gi < 4; ++gi) if (groups[gi]) fwd_kernel<<<grid_blocks, 256, LDS_BYTES, stream>>>(p, ph, ph + 1, groups[gi]);
    } else {
      fwd_kernel<<<grid_blocks, 256, LDS_BYTES, stream>>>(p, ph, ph + 1, 15);
    }
  }
#else
  hipMemsetAsync((char*)d_ws + OFF_BAR, 0, XCD_BAR_WORDS * 4, stream);
  int ph0 = 0, ph1 = NPHASES, smask = 15;
  void* args[] = {&p, &ph0, &ph1, &smask};
  hipError_t e = hipLaunchCooperativeKernel((void*)fwd_kernel, dim3(grid_blocks), dim3(256), args, LDS_BYTES, stream);
  if (e != hipSuccess) fprintf(stderr, "cooperative launch failed: %s (grid %d)\n", hipGetErrorString(e), grid_blocks);
#endif
#else
  const dim3 g(512), b(256);
  for (int l = 0; l < 2; ++l) {
    k_phase<0><<<g, b, 0, stream>>>(p, l);
    k_phase<1><<<g, b, 0, stream>>>(p, l);
    k_phase<2><<<g, b, 0, stream>>>(p, l);
    k_phase<3><<<g, b, 0, stream>>>(p, l);
    k_phase<4><<<g, b, 0, stream>>>(p, l);
    k_phase<5><<<g, b, 0, stream>>>(p, l);
    k_phase<6><<<g, b, 0, stream>>>(p, l);
    k_phase<7><<<g, b, 0, stream>>>(p, l);
    k_phase<8><<<g, b, 0, stream>>>(p, l);
    k_phase<9><<<g, b, 0, stream>>>(p, l);
  }
  k_phase<10><<<g, b, 0, stream>>>(p, 0);
#endif
}
```
